# Optimizing an MI355X kernel written in HIP

```python
import math
import jax, jax.numpy as jnp
from jax import lax
import numpy as np

D_MODEL = 1024
BATCH = 1
SEQ = 16384
DEPTH = 1

PLE_DIM = 256
HEAD_DIM = 64
NSA_HEADS = 8
NSA_KV_GROUPS = 2
NSA_GROUP_SIZE = NSA_HEADS // NSA_KV_GROUPS
NSA_CMP_LEN = 32
NSA_CMP_STRIDE = 16
NSA_SLC_BLOCK = 64
NSA_SLC_TOPK = 16
NSA_LOCAL_BLOCKS = 2
NSA_WINDOW = 512
DSA_HEADS = 8
IDX_HEADS = 8
IDX_DIM = 32
DSA_TOPK_MAX = 256
Q_BLOCK = 128
REL_BUCKETS = 32
REL_MAX_EXACT = 16
REL_MAX_DIST = 128
N_EXPERTS = 32
TOP_K = 4
D_FF = 1024
SWIGLU_LIMIT = 7.0
SWIGLU_ALPHA = 1.702
MOE_ROWS = 256
EPS = 1e-6
NEG_INF = -1e30

NSA_W = NSA_HEADS * HEAD_DIM
DSA_W = DSA_HEADS * HEAD_DIM
IN_SPLITS = (NSA_W, 6 * NSA_KV_GROUPS * HEAD_DIM, 3 * NSA_HEADS, DSA_W, DSA_W, DSA_W,
             IDX_HEADS * IDX_DIM, IDX_DIM, IDX_HEADS, D_MODEL, D_MODEL)
D_IN = sum(IN_SPLITS)

kernel_name = "hybrid_nsa_dsa_moe_block"


def rmsnorm(x, g):
    xf = x.astype(jnp.float32)
    y = xf * lax.rsqrt(jnp.mean(xf * xf, axis=-1, keepdims=True) + EPS)
    return (y * g.astype(jnp.float32)).astype(x.dtype)


def rel_bucket(dist):
    n = jnp.maximum(dist, 0)
    nf = jnp.maximum(n, 1).astype(jnp.float32)
    large = REL_MAX_EXACT + (jnp.log(nf / REL_MAX_EXACT) / math.log(REL_MAX_DIST / REL_MAX_EXACT)
                             * (REL_BUCKETS - REL_MAX_EXACT)).astype(jnp.int32)
    large = jnp.minimum(large, REL_BUCKETS - 1)
    return jnp.where(n < REL_MAX_EXACT, n, large)


def masked_softmax(logits, mask):
    logits = jnp.where(mask, logits.astype(jnp.float32), NEG_INF)
    m = jnp.max(logits, axis=-1, keepdims=True)
    e = jnp.where(mask, jnp.exp(logits - m), 0.0)
    return e / jnp.maximum(jnp.sum(e, axis=-1, keepdims=True), 1e-30)


def split_cols(z, sizes):
    out, o = [], 0
    for s in sizes:
        out.append(z[..., o:o + s])
        o += s
    return out


def nsa_mixer(q, kv, gate_logits, pe_ck, w_ck1, w_ck2, pe_cv, w_cv1, w_cv2, g_q, g_k, rel_tab):
    B, S, _ = q.shape
    G, R, dh = NSA_KV_GROUPS, NSA_GROUP_SIZE, HEAD_DIM
    q = rmsnorm(q.reshape(B, S, G, R, dh), g_q) * (dh ** -0.5)
    kv = kv.reshape(B, S, 6, G, dh)
    k_cmp_raw, v_cmp_raw, k_slc, v_slc, k_win, v_win = [kv[:, :, j] for j in range(6)]

    n_cmp = (S - NSA_CMP_LEN) // NSA_CMP_STRIDE + 1
    cmp_start = jnp.arange(n_cmp) * NSA_CMP_STRIDE
    cmp_tok = cmp_start[:, None] + jnp.arange(NSA_CMP_LEN)[None, :]
    cmp_end = cmp_start + NSA_CMP_LEN - 1

    def compress(z, pe, w1, w2):
        zb = z[:, cmp_tok] + pe[None, None, :, None, :]
        hdn = jax.nn.silu(jnp.einsum('bclgd,lde->bcge', zb, w1))
        return jnp.einsum('bcge,ed->bcgd', hdn, w2)

    k_cmp = rmsnorm(compress(k_cmp_raw, pe_ck, w_ck1, w_ck2), g_k)
    v_cmp = compress(v_cmp_raw, pe_cv, w_cv1, w_cv2)

    n_slc = S // NSA_SLC_BLOCK
    slc_start = jnp.arange(n_slc) * NSA_SLC_BLOCK
    overlap = jnp.maximum(
        jnp.minimum(cmp_start[:, None] + NSA_CMP_LEN, slc_start[None, :] + NSA_SLC_BLOCK)
        - jnp.maximum(cmp_start[:, None], slc_start[None, :]), 0).astype(jnp.float32) / NSA_CMP_LEN
    n_sel = min(NSA_SLC_TOPK, n_slc)
    n_ar = jnp.arange(n_slc)

    k_slc = rmsnorm(k_slc, g_k).transpose(0, 2, 1, 3)
    v_slc = v_slc.transpose(0, 2, 1, 3)
    pad = ((0, 0), (0, 0), (NSA_WINDOW, 0), (0, 0))
    k_win = jnp.pad(rmsnorm(k_win, g_k).transpose(0, 2, 1, 3), pad)
    v_win = jnp.pad(v_win.transpose(0, 2, 1, 3), pad)
    gates = jax.nn.sigmoid(gate_logits.astype(jnp.float32)).astype(q.dtype).reshape(B, S, G, R, 3)

    tab = rel_tab.reshape(REL_BUCKETS, G, R).transpose(1, 2, 0)
    b_ix = jnp.arange(B)[:, None, None, None]
    g_ix = jnp.arange(G)[None, :, None, None]
    g5 = jnp.arange(G)[None, :, None, None, None]
    r5 = jnp.arange(R)[None, None, :, None, None]

    def block(blk):
        t0 = blk * Q_BLOCK
        t = t0 + jnp.arange(Q_BLOCK)
        qb = lax.dynamic_slice_in_dim(q, t0, Q_BLOCK, axis=1)
        gb = lax.dynamic_slice_in_dim(gates, t0, Q_BLOCK, axis=1)

        mask_c = cmp_end[None, :] <= t[:, None]
        lc = (jnp.einsum('btgrd,bcgd->bgrtc', qb, k_cmp).astype(jnp.float32)
              + tab[:, :, rel_bucket(t[:, None] - cmp_end[None, :])])
        pc = masked_softmax(lc, mask_c)
        o_c = jnp.einsum('bgrtc,bcgd->btgrd', pc.astype(v_cmp.dtype), v_cmp)

        imp = jnp.einsum('bgrtc,cn->bgtn', pc, overlap)
        cur = t // NSA_SLC_BLOCK
        valid = slc_start[None, :] <= t[:, None]
        forced = valid & ((n_ar[None, :] == 0) | (n_ar[None, :] > cur[:, None] - NSA_LOCAL_BLOCKS))
        score = jnp.where(forced, jnp.inf, jnp.where(valid, imp, -jnp.inf))
        _, sel = lax.top_k(score, n_sel)
        tok = (sel[..., None] * NSA_SLC_BLOCK + jnp.arange(NSA_SLC_BLOCK)).reshape(
            B, G, Q_BLOCK, n_sel * NSA_SLC_BLOCK)
        ks = k_slc[b_ix, g_ix, tok]
        vs = v_slc[b_ix, g_ix, tok]
        ls = (jnp.einsum('btgrd,bgtkd->bgrtk', qb, ks).astype(jnp.float32)
              + tab[g5, r5, rel_bucket(t[:, None] - tok)[:, :, None]])
        ps = masked_softmax(ls, (tok <= t[:, None])[:, :, None])
        o_s = jnp.einsum('bgrtk,bgtkd->btgrd', ps.astype(vs.dtype), vs)

        kw = lax.dynamic_slice_in_dim(k_win, t0, Q_BLOCK + NSA_WINDOW, axis=2)
        vw = lax.dynamic_slice_in_dim(v_win, t0, Q_BLOCK + NSA_WINDOW, axis=2)
        s = t0 - NSA_WINDOW + jnp.arange(Q_BLOCK + NSA_WINDOW)
        d = t[:, None] - s[None, :]
        mask_w = (d >= 0) & (d < NSA_WINDOW) & (s[None, :] >= 0)
        lw = jnp.einsum('btgrd,bgsd->bgrts', qb, kw).astype(jnp.float32) + tab[:, :, rel_bucket(d)]
        pw = masked_softmax(lw, mask_w)
        o_w = jnp.einsum('bgrts,bgsd->btgrd', pw.astype(vw.dtype), vw)

        o = gb[..., 0:1] * o_c + gb[..., 1:2] * o_s + gb[..., 2:3] * o_w
        return o.reshape(B, Q_BLOCK, NSA_W)

    out = lax.map(block, jnp.arange(S // Q_BLOCK))
    return out.transpose(1, 0, 2, 3).reshape(B, S, NSA_W)


def dsa_mixer(q, k, v, iq, ik, iw, g_q, g_k, rel_tab):
    B, S, _ = q.shape
    H, dh = DSA_HEADS, HEAD_DIM
    q = rmsnorm(q.reshape(B, S, H, dh), g_q) * (dh ** -0.5)
    k = rmsnorm(k.reshape(B, S, H, dh), g_k)
    v = v.reshape(B, S, H, dh)
    iq = iq.reshape(B, S, IDX_HEADS, IDX_DIM) * (IDX_DIM ** -0.5)
    iw = iw * (IDX_HEADS ** -0.5)
    n_keep = min(DSA_TOPK_MAX, S // 4)
    s_ar = jnp.arange(S)
    b_ix = jnp.arange(B)[:, None, None]

    def block(blk):
        t0 = blk * Q_BLOCK
        t = t0 + jnp.arange(Q_BLOCK)
        qi = lax.dynamic_slice_in_dim(iq, t0, Q_BLOCK, axis=1)
        wi = lax.dynamic_slice_in_dim(iw, t0, Q_BLOCK, axis=1)
        idx_score = jnp.einsum('bth,bths->bts', wi.astype(jnp.float32),
                               jax.nn.relu(jnp.einsum('bthd,bsd->bths', qi, ik).astype(jnp.float32)))
        idx_score = jnp.where(s_ar[None, :] <= t[:, None], idx_score, -jnp.inf)
        _, sel = lax.top_k(idx_score, n_keep)
        kg = k[b_ix, sel]
        vg = v[b_ix, sel]
        qb = lax.dynamic_slice_in_dim(q, t0, Q_BLOCK, axis=1)
        dist = t[:, None] - sel
        logits = (jnp.einsum('bthd,btkhd->bhtk', qb, kg).astype(jnp.float32)
                  + jnp.moveaxis(rel_tab[rel_bucket(dist)], -1, 1))
        pr = masked_softmax(logits, (dist >= 0)[:, None])
        o = jnp.einsum('bhtk,btkhd->bthd', pr.astype(vg.dtype), vg)
        return o.reshape(B, Q_BLOCK, DSA_W)

    out = lax.map(block, jnp.arange(S // Q_BLOCK))
    return out.transpose(1, 0, 2, 3).reshape(B, S, DSA_W)


def moe_ffn(h, w_r, b_r, w1, b1, w2, b2):
    B, S, D = h.shape
    N = B * S
    hf = h.reshape(N, D)
    logits = (hf @ w_r + b_r).astype(jnp.float32)
    top_val, top_idx = lax.top_k(logits, TOP_K)
    top_w = jax.nn.softmax(top_val, axis=-1)
    e_flat = top_idx.reshape(-1)
    tok_flat = jnp.repeat(jnp.arange(N, dtype=jnp.int32), TOP_K)
    w_flat = top_w.reshape(-1)
    order = jnp.argsort(e_flat)
    e_sorted, tok_sorted, w_sorted = e_flat[order], tok_flat[order], w_flat[order]
    counts = jnp.bincount(e_flat, length=N_EXPERTS)
    padded = (counts + MOE_ROWS - 1) // MOE_ROWS * MOE_ROWS
    pad_end = jnp.cumsum(padded)
    pad_start = pad_end - padded
    start = jnp.cumsum(counts) - counts
    dest = pad_start[e_sorted] + jnp.arange(N * TOP_K) - start[e_sorted]
    n_chunks = -(-(N * TOP_K) // MOE_ROWS) + N_EXPERTS
    P = n_chunks * MOE_ROWS
    row_tok = jnp.full((P,), N, jnp.int32).at[dest].set(tok_sorted)
    row_w = jnp.zeros((P,), jnp.float32).at[dest].set(w_sorted)
    chunk_e = jnp.minimum(jnp.searchsorted(pad_end, jnp.arange(n_chunks) * MOE_ROWS, side='right'),
                          N_EXPERTS - 1)
    h_pad = jnp.concatenate([hf, jnp.zeros((1, D), hf.dtype)], axis=0)

    def expert_rows(args):
        tok, e = args
        xe = h_pad[tok]
        gu = xe @ w1[e] + b1[e]
        gate = jnp.minimum(gu[:, :D_FF], SWIGLU_LIMIT)
        lin = jnp.clip(gu[:, D_FF:], -SWIGLU_LIMIT, SWIGLU_LIMIT)
        act = (lin + 1) * gate * jax.nn.sigmoid(SWIGLU_ALPHA * gate)
        return act @ w2[e] + b2[e]

    rows = lax.map(expert_rows, (row_tok.reshape(n_chunks, MOE_ROWS), chunk_e))
    rows = rows.reshape(P, D) * row_w[:, None].astype(rows.dtype)
    y = jax.ops.segment_sum(rows, row_tok, num_segments=N + 1)[:N]
    return y.reshape(B, S, D)


def setup_inputs(seed: int = 0) -> dict:
    key = jax.random.key(seed)
    ks = jax.random.split(key, 32)
    f32 = jnp.float32

    def nrm(k, shape, fan_in):
        return jax.random.normal(k, shape, f32) * (fan_in ** -0.5)

    def gain(k, shape):
        return 1.0 + 0.1 * jax.random.normal(k, shape, f32)

    L, dh = DEPTH, HEAD_DIM
    return {
        "x": jax.random.normal(ks[0], (BATCH, SEQ, D_MODEL), f32),
        "p": jax.random.normal(ks[1], (DEPTH, BATCH, SEQ, PLE_DIM), f32),
        "w_in": nrm(ks[2], (L, D_MODEL, D_IN), D_MODEL),
        "g_mix": gain(ks[3], (L, D_MODEL)),
        "g_q_nsa": gain(ks[4], (L, dh)),
        "g_k_nsa": gain(ks[5], (L, dh)),
        "g_q_dsa": gain(ks[6], (L, dh)),
        "g_k_dsa": gain(ks[7], (L, dh)),
        "pe_ck": 0.5 * jax.random.normal(ks[8], (L, NSA_CMP_LEN, dh), f32),
        "w_ck1": nrm(ks[9], (L, NSA_CMP_LEN, dh, dh), NSA_CMP_LEN * dh),
        "w_ck2": nrm(ks[10], (L, dh, dh), dh),
        "pe_cv": 0.5 * jax.random.normal(ks[11], (L, NSA_CMP_LEN, dh), f32),
        "w_cv1": nrm(ks[12], (L, NSA_CMP_LEN, dh, dh), NSA_CMP_LEN * dh),
        "w_cv2": nrm(ks[13], (L, dh, dh), dh),
        "w_branch_a": nrm(ks[14], (L, NSA_W, D_MODEL), NSA_W),
        "w_branch_b": nrm(ks[15], (L, DSA_W, D_MODEL), DSA_W),
        "w_out": nrm(ks[16], (L, D_MODEL, D_MODEL), D_MODEL),
        "rel_bias": 0.5 * jax.random.normal(ks[17], (REL_BUCKETS, NSA_HEADS + DSA_HEADS), f32),
        "g_ffn": gain(ks[18], (L, D_MODEL)),
        "w_router": nrm(ks[19], (L, D_MODEL, N_EXPERTS), D_MODEL),
        "b_router": 0.01 * jax.random.normal(ks[20], (L, N_EXPERTS), f32),
        "w_e1": nrm(ks[21], (L, N_EXPERTS, D_MODEL, 2 * D_FF), D_MODEL),
        "b_e1": 0.01 * jax.random.normal(ks[22], (L, N_EXPERTS, 2 * D_FF), f32),
        "w_e2": nrm(ks[23], (L, N_EXPERTS, D_FF, D_MODEL), D_FF),
        "b_e2": 0.01 * jax.random.normal(ks[24], (L, N_EXPERTS, D_MODEL), f32),
        "g_ple": gain(ks[25], (L, D_MODEL)),
        "w_ple": nrm(ks[26], (L, PLE_DIM, D_MODEL), PLE_DIM),
        "w_ple_gate": nrm(ks[27], (L, D_MODEL, D_MODEL), D_MODEL),
    }


def reference(x, p, w_in, g_mix, g_q_nsa, g_k_nsa, g_q_dsa, g_k_dsa, pe_ck, w_ck1, w_ck2,
              pe_cv, w_cv1, w_cv2, w_branch_a, w_branch_b, w_out, rel_bias, g_ffn, w_router,
              b_router, w_e1, b_e1, w_e2, b_e2, g_ple, w_ple, w_ple_gate):
    rel_nsa = rel_bias[:, :NSA_HEADS]
    rel_dsa = rel_bias[:, NSA_HEADS:]
    for i in range(DEPTH):
        h = rmsnorm(x, g_mix[i])
        z = h @ w_in[i]
        nq, nkv, ngate, dq, dk, dv, iq, ik, iw, ga, gb = split_cols(z, IN_SPLITS)
        o_a = nsa_mixer(nq, nkv, ngate, pe_ck[i], w_ck1[i], w_ck2[i], pe_cv[i], w_cv1[i], w_cv2[i],
                        g_q_nsa[i], g_k_nsa[i], rel_nsa)
        o_b = dsa_mixer(dq, dk, dv, iq, ik, iw, g_q_dsa[i], g_k_dsa[i], rel_dsa)
        merged = (jax.nn.sigmoid(ga) * (o_a @ w_branch_a[i])
                  + jax.nn.sigmoid(gb) * (o_b @ w_branch_b[i]))
        x = x + merged @ w_out[i]
        x = x + moe_ffn(rmsnorm(x, g_ffn[i]), w_router[i], b_router[i],
                        w_e1[i], b_e1[i], w_e2[i], b_e2[i])
        x = x + jax.nn.sigmoid(rmsnorm(x, g_ple[i]) @ w_ple_gate[i]) * (p[i] @ w_ple[i])
    return x
```

```cpp
#include <hip/hip_runtime.h>
#include <hip/hip_cooperative_groups.h>
#include <cstdio>
#include <cstdint>
namespace cg = cooperative_groups;

#ifndef SINGLE_LAUNCH
#define SINGLE_LAUNCH 0
#endif

constexpr int S = 16384;
constexpr int D = 1024;
constexpr int DIN = 5184;
constexpr int NCMP = 1023;
constexpr int NSLC = 256;
constexpr int NEXP = 32;
constexpr int DFF = 1024;
constexpr float EPS = 1e-6f;
constexpr int Z_NQ = 0, Z_NKV = 512, Z_NGATE = 1280, Z_DQ = 1304, Z_DK = 1816, Z_DV = 2328, Z_IQ = 2840, Z_IK = 3096,
              Z_IW = 3128, Z_GA = 3136, Z_GB = 4160;

constexpr int NT = 256;
constexpr int SMEM_BYTES = 73728;

typedef unsigned short bf16_t;
typedef short bf16x8 __attribute__((ext_vector_type(8)));
typedef float f32x4 __attribute__((ext_vector_type(4)));

constexpr size_t MBy = 1ull << 20;
constexpr size_t WS_CTL = 0;
constexpr size_t WS_HB = 1 * MBy;
constexpr size_t WS_OA = WS_HB + (size_t)S * D * 2;
constexpr size_t WS_OB = WS_OA + (size_t)S * 512 * 2;
constexpr size_t WS_MERGED = WS_OB + (size_t)S * 512 * 2;
constexpr size_t WS_X1 = WS_MERGED + (size_t)S * D * 2;
constexpr size_t WS_TOPI = WS_X1 + (size_t)S * D * 4;
constexpr size_t WS_TOPW = WS_TOPI + (size_t)S * 4 * 4;
constexpr size_t WS_PPOS = WS_TOPW + (size_t)S * 4 * 4;
constexpr size_t WS_ROWTOK = WS_PPOS + (size_t)S * 4 * 4;
constexpr size_t WS_KC = WS_ROWTOK + (size_t)65536 * 4;
constexpr size_t WS_VC = WS_KC + (size_t)1024 * 128 * 4;
constexpr size_t WS_PB = WS_VC + (size_t)1024 * 128 * 4;
constexpr size_t WS_REG = WS_PB + (size_t)S * 256 * 2;
constexpr size_t WS_Z = WS_REG;
constexpr size_t WS_QN = WS_Z + (size_t)S * DIN * 4;
constexpr size_t WS_KSL = WS_QN + (size_t)S * 512 * 4;
constexpr size_t WS_VSL = WS_KSL + (size_t)S * 128 * 4;
constexpr size_t WS_KWN = WS_VSL + (size_t)S * 128 * 4;
constexpr size_t WS_VWN = WS_KWN + (size_t)S * 128 * 4;
constexpr size_t WS_GT = WS_VWN + (size_t)S * 128 * 4;
constexpr size_t WS_DQN = WS_GT + (size_t)S * 32 * 4;
constexpr size_t WS_DKN = WS_DQN + (size_t)S * 512 * 4;
constexpr size_t WS_DVN = WS_DKN + (size_t)S * 512 * 4;
constexpr size_t WS_IQS = WS_DVN + (size_t)S * 512 * 4;
constexpr size_t WS_IKS = WS_IQS + (size_t)S * 256 * 4;
constexpr size_t WS_IWS = WS_IKS + (size_t)S * 32 * 4;
constexpr size_t WS_ENDA = WS_IWS + (size_t)S * 8 * 4;
constexpr size_t WS_ACT = WS_REG;
constexpr size_t WS_YROWS = WS_ACT + (size_t)(65536 + 128) * DFF * 2;
constexpr size_t WS_ENDB = WS_YROWS + (size_t)(65536 + 128) * D * 4;
constexpr size_t WS_END = WS_ENDA > WS_ENDB ? WS_ENDA : WS_ENDB;

struct Params {
    const float* in[28];
    float* out;
    unsigned char* ws;
};

__device__ __forceinline__ unsigned f2bf(float f) {
    unsigned u = __builtin_bit_cast(unsigned, f);
    return (u + 0x7fffu + ((u >> 16) & 1u)) >> 16;
}
__device__ __forceinline__ unsigned pk2(float lo, float hi) { return f2bf(lo) | (f2bf(hi) << 16); }
__device__ __forceinline__ float bf2f(unsigned short b) { return __builtin_bit_cast(float, (unsigned)b << 16); }
__device__ __forceinline__ float wave_sum(float v) {
#pragma unroll
    for (int o = 1; o < 64; o <<= 1) v += __shfl_xor(v, o);
    return v;
}
__device__ __forceinline__ float wave_max(float v) {
#pragma unroll
    for (int o = 1; o < 64; o <<= 1) v = fmaxf(v, __shfl_xor(v, o));
    return v;
}
__device__ __forceinline__ float sigmoidf_(float x) { return 1.f / (1.f + __expf(-x)); }
__device__ __forceinline__ int bucket_of(int n) {
    if (n < 16) return n;
    int b = 16;
    b += (n >= 19) + (n >= 21) + (n >= 24) + (n >= 27) + (n >= 31) + (n >= 35) + (n >= 40) + (n >= 46) + (n >= 52) + (n >= 59) +
         (n >= 67) + (n >= 77) + (n >= 87) + (n >= 99) + (n >= 113);
    return b;
}

constexpr int LDS_STRIDE = 40;
template <bool A_F32, bool GATHER>
__device__ __forceinline__ void gemm_tile(const void* __restrict__ Aptr, int lda, const int* __restrict__ rowidx, int m0, int mrows,
                                          const float* __restrict__ B, int ldb, int n0, int split_off, int ncols, int K,
                                          unsigned char* smem, f32x4 (&acc)[2][8]) {
    bf16_t* As = (bf16_t*)smem;
    bf16_t* Bs = As + 128 * LDS_STRIDE;
    const int tid = threadIdx.x, lane = tid & 63, wave = tid >> 6;
#pragma unroll
    for (int i = 0; i < 2; ++i)
#pragma unroll
        for (int j = 0; j < 8; ++j) acc[i][j] = (f32x4){0.f, 0.f, 0.f, 0.f};

    const int ar = tid >> 2, ach = tid & 3;
    const unsigned char* arow[2];
    bool aval[2];
#pragma unroll
    for (int i = 0; i < 2; ++i) {
        int r = ar + 64 * i;
        aval[i] = r < mrows;
        long src = 0;
        if (aval[i]) src = GATHER ? (long)rowidx[m0 + r] : (long)(m0 + r);
        arow[i] = (const unsigned char*)Aptr + (size_t)src * lda * (A_F32 ? 4 : 2) + (size_t)ach * 8 * (A_F32 ? 4 : 2);
    }
    const int nq = tid & 31, kq = tid >> 5;
    const int jn = 4 * nq;
    const bool bval = jn < ncols;
    const float* bptr = B + (size_t)(4 * kq) * ldb + n0 + jn + (jn >= 64 ? split_off : 0);

    uint4 areg[2];
    float4 af[2][2];
    float4 breg[4];
    auto load_g = [&](int k0) {
#pragma unroll
        for (int i = 0; i < 2; ++i) {
            if (A_F32) {
                if (aval[i]) {
                    const float4* s = (const float4*)(arow[i] + (size_t)k0 * 4);
                    af[i][0] = s[0]; af[i][1] = s[1];
                } else { af[i][0] = make_float4(0, 0, 0, 0); af[i][1] = af[i][0]; }
            } else {
                if (aval[i]) areg[i] = *(const uint4*)(arow[i] + (size_t)k0 * 2);
                else areg[i] = make_uint4(0, 0, 0, 0);
            }
        }
#pragma unroll
        for (int kk = 0; kk < 4; ++kk) {
            if (bval) breg[kk] = *(const float4*)(bptr + (size_t)(k0 + kk) * ldb);
            else breg[kk] = make_float4(0, 0, 0, 0);
        }
    };
    auto store_l = [&]() {
#pragma unroll
        for (int i = 0; i < 2; ++i) {
            uint4 v;
            if (A_F32) {
                v.x = pk2(af[i][0].x, af[i][0].y); v.y = pk2(af[i][0].z, af[i][0].w);
                v.z = pk2(af[i][1].x, af[i][1].y); v.w = pk2(af[i][1].z, af[i][1].w);
            } else v = areg[i];
            *(uint4*)(As + (ar + 64 * i) * LDS_STRIDE + ach * 8) = v;
        }
        {
            uint2 v;
            v.x = pk2(breg[0].x, breg[1].x); v.y = pk2(breg[2].x, breg[3].x);
            *(uint2*)(Bs + (jn + 0) * LDS_STRIDE + 4 * kq) = v;
            v.x = pk2(breg[0].y, breg[1].y); v.y = pk2(breg[2].y, breg[3].y);
            *(uint2*)(Bs + (jn + 1) * LDS_STRIDE + 4 * kq) = v;
            v.x = pk2(breg[0].z, breg[1].z); v.y = pk2(breg[2].z, breg[3].z);
            *(uint2*)(Bs + (jn + 2) * LDS_STRIDE + 4 * kq) = v;
            v.x = pk2(breg[0].w, breg[1].w); v.y = pk2(breg[2].w, breg[3].w);
            *(uint2*)(Bs + (jn + 3) * LDS_STRIDE + 4 * kq) = v;
        }
    };
    const int nk = K / 32;
    __syncthreads();
    load_g(0);
    store_l();
    __syncthreads();
    const int fr = lane & 15, fq = lane >> 4;
    for (int kt = 0; kt < nk; ++kt) {
        if (kt + 1 < nk) load_g((kt + 1) * 32);
        bf16x8 a[2], b[8];
#pragma unroll
        for (int i = 0; i < 2; ++i) a[i] = *(const bf16x8*)(As + (wave * 32 + i * 16 + fr) * LDS_STRIDE + fq * 8);
#pragma unroll
        for (int j = 0; j < 8; ++j) b[j] = *(const bf16x8*)(Bs + (j * 16 + fr) * LDS_STRIDE + fq * 8);
#pragma unroll
        for (int i = 0; i < 2; ++i)
#pragma unroll
            for (int j = 0; j < 8; ++j) acc[i][j] = __builtin_amdgcn_mfma_f32_16x16x32_bf16(a[i], b[j], acc[i][j], 0, 0, 0);
        __syncthreads();
        if (kt + 1 < nk) {
            store_l();
            __syncthreads();
        }
    }
}

__device__ __forceinline__ void phase_prep(const Params& p, int bid, int nb) {
    const int lane = threadIdx.x & 63, wave = threadIdx.x >> 6;
    if (bid == 0 && threadIdx.x < 64) ((int*)(p.ws + WS_CTL))[threadIdx.x] = 0;
    const float* x = p.in[0];
    const float* g = p.in[3];
    bf16_t* hb = (bf16_t*)(p.ws + WS_HB);
    for (int t = bid * 4 + wave; t < S; t += nb * 4) {
        const float4* xr = (const float4*)(x + (size_t)t * D);
        float4 v[4];
        float ss = 0.f;
#pragma unroll
        for (int j = 0; j < 4; ++j) { v[j] = xr[lane + 64 * j]; ss += v[j].x * v[j].x + v[j].y * v[j].y + v[j].z * v[j].z + v[j].w * v[j].w; }
        ss = wave_sum(ss);
        const float rstd = rsqrtf(ss * (1.f / D) + EPS);
#pragma unroll
        for (int j = 0; j < 4; ++j) {
            const float4 gg = ((const float4*)g)[lane + 64 * j];
            uint2 o;
            o.x = pk2(v[j].x * rstd * gg.x, v[j].y * rstd * gg.y);
            o.y = pk2(v[j].z * rstd * gg.z, v[j].w * rstd * gg.w);
            ((uint2*)(hb + (size_t)t * D))[lane + 64 * j] = o;
        }
    }
}

__device__ __forceinline__ void phase_inproj(const Params& p, int bid, int nb, unsigned char* smem) {
    const bf16_t* hb = (const bf16_t*)(p.ws + WS_HB);
    float* z = (float*)(p.ws + WS_Z);
    const int lane = threadIdx.x & 63, wave = threadIdx.x >> 6;
    constexpr int NTN = (DIN + 127) / 128;
    for (int w = bid; w < 128 * NTN; w += nb) {
        const int mt = w % 128, nt = w / 128;
        const int m0 = mt * 128, n0 = nt * 128;
        const int ncols = (DIN - n0) < 128 ? (DIN - n0) : 128;
        f32x4 acc[2][8];
        gemm_tile<false, false>(hb, D, nullptr, m0, 128, p.in[2], DIN, n0, 0, ncols, D, smem, acc);
#pragma unroll
        for (int i = 0; i < 2; ++i)
#pragma unroll
            for (int j = 0; j < 8; ++j) {
                const int col = n0 + j * 16 + (lane & 15);
                if (j * 16 < ncols) {
#pragma unroll
                    for (int r = 0; r < 4; ++r) {
                        const int row = m0 + wave * 32 + i * 16 + 4 * (lane >> 4) + r;
                        z[(size_t)row * DIN + col] = acc[i][j][r];
                    }
                }
            }
    }
}

__device__ __forceinline__ float rms64(float v) { return rsqrtf(wave_sum(v * v) * (1.f / 64.f) + EPS); }
__device__ __forceinline__ void phase_post(const Params& p, int bid, int nb) {
    const int lane = threadIdx.x & 63, wave = threadIdx.x >> 6;
    const float* z = (const float*)(p.ws + WS_Z);
    float* qn = (float*)(p.ws + WS_QN);
    float* ksl = (float*)(p.ws + WS_KSL);
    float* vsl = (float*)(p.ws + WS_VSL);
    float* kwn = (float*)(p.ws + WS_KWN);
    float* vwn = (float*)(p.ws + WS_VWN);
    float* gt = (float*)(p.ws + WS_GT);
    float* dqn = (float*)(p.ws + WS_DQN);
    float* dkn = (float*)(p.ws + WS_DKN);
    float* dvn = (float*)(p.ws + WS_DVN);
    float* iqs = (float*)(p.ws + WS_IQS);
    float* iks = (float*)(p.ws + WS_IKS);
    float* iws = (float*)(p.ws + WS_IWS);
    const float gqn = p.in[4][lane], gkn = p.in[5][lane], gqd = p.in[6][lane], gkd = p.in[7][lane];
    for (int t = bid * 4 + wave; t < S; t += nb * 4) {
        const float* zr = z + (size_t)t * DIN;
#pragma unroll
        for (int h = 0; h < 8; ++h) {
            const float v = zr[Z_NQ + h * 64 + lane];
            qn[(size_t)t * 512 + h * 64 + lane] = v * rms64(v) * gqn * 0.125f;
        }
#pragma unroll
        for (int g = 0; g < 2; ++g) {
            float v = zr[Z_NKV + 2 * 128 + g * 64 + lane];
            ksl[((size_t)g * S + t) * 64 + lane] = v * rms64(v) * gkn;
            v = zr[Z_NKV + 3 * 128 + g * 64 + lane];
            vsl[((size_t)g * S + t) * 64 + lane] = v;
            v = zr[Z_NKV + 4 * 128 + g * 64 + lane];
            kwn[((size_t)g * S + t) * 64 + lane] = v * rms64(v) * gkn;
            v = zr[Z_NKV + 5 * 128 + g * 64 + lane];
            vwn[((size_t)g * S + t) * 64 + lane] = v;
        }
        if (lane < 24) gt[(size_t)t * 32 + lane] = sigmoidf_(zr[Z_NGATE + lane]);
#pragma unroll
        for (int h = 0; h < 8; ++h) {
            float v = zr[Z_DQ + h * 64 + lane];
            dqn[(size_t)t * 512 + h * 64 + lane] = v * rms64(v) * gqd * 0.125f;
            v = zr[Z_DK + h * 64 + lane];
            dkn[(size_t)t * 512 + h * 64 + lane] = v * rms64(v) * gkd;
            dvn[(size_t)t * 512 + h * 64 + lane] = zr[Z_DV + h * 64 + lane];
        }
#pragma unroll
        for (int j = 0; j < 4; ++j) iqs[(size_t)t * 256 + j * 64 + lane] = zr[Z_IQ + j * 64 + lane] * 0.17677669529663687f;
        if (lane < 32) iks[(size_t)t * 32 + lane] = zr[Z_IK + lane];
        if (lane < 8) iws[(size_t)t * 8 + lane] = zr[Z_IW + lane] * 0.35355339059327373f;
    }
}

__device__ __forceinline__ void phase_compress(const Params& p, int bid, int nb) {
    const int lane = threadIdx.x & 63, wave = threadIdx.x >> 6;
    const float* z = (const float*)(p.ws + WS_Z);
    float* kc = (float*)(p.ws + WS_KC);
    float* vc = (float*)(p.ws + WS_VC);
    const float gkn = p.in[5][lane];
    for (int it = bid * 4 + wave; it < NCMP * 4; it += nb * 4) {
        const int kind = it & 1, g = (it >> 1) & 1, c = it >> 2;
        const float* pe = p.in[kind ? 11 : 8];
        const float* w1 = p.in[kind ? 12 : 9];
        const float* w2 = p.in[kind ? 13 : 10];
        float acc = 0.f;
        for (int l = 0; l < 32; ++l) {
            const float* zr = z + (size_t)(16 * c + l) * DIN + Z_NKV + kind * 128 + g * 64;
            const float zin = zr[lane] + pe[l * 64 + lane];
            const float* w1l = w1 + (size_t)l * 64 * 64;
#pragma unroll 8
            for (int d = 0; d < 64; ++d) acc += __shfl(zin, d) * w1l[d * 64 + lane];
        }
        const float hid = acc * sigmoidf_(acc);
        float o = 0.f;
#pragma unroll 8
        for (int e = 0; e < 64; ++e) o += __shfl(hid, e) * w2[e * 64 + lane];
        if (kind == 0) {
            o = o * rms64(o) * gkn;
            kc[((size_t)c * 2 + g) * 64 + lane] = o;
        } else vc[((size_t)c * 2 + g) * 64 + lane] = o;
    }
}

__device__ __forceinline__ float dot64(const float (&q)[64], const float* kp_) {
    const float4* kp = (const float4*)kp_;
    float dsum = 0.f;
#pragma unroll
    for (int d = 0; d < 16; ++d) { const float4 kv = kp[d]; dsum += q[4 * d] * kv.x + q[4 * d + 1] * kv.y + q[4 * d + 2] * kv.z + q[4 * d + 3] * kv.w; }
    return dsum;
}
__device__ __forceinline__ void wave_softmax_lds(float* pr, int n, int npad, int lane, float mx) {
    mx = wave_max(mx);
    float sum = 0.f;
#pragma unroll 1
    for (int k = lane; k < n; k += 64) { const float v = pr[k]; const float e = (v > -1e29f) ? __expf(v - mx) : 0.f; pr[k] = e; sum += e; }
    sum = wave_sum(sum);
    const float inv = 1.f / fmaxf(sum, 1e-30f);
#pragma unroll 1
    for (int k = lane; k < npad; k += 64) pr[k] = (k < n) ? pr[k] * inv : 0.f;
}
__device__ __forceinline__ void nsa_item(const Params& p, int t, int g, unsigned char* smem) {
    const int tid = threadIdx.x, lane = tid & 63, r = tid >> 6;
    float* pl = (float*)smem;
    float* lut = pl + 4 * 1024;
    float* sc = lut + 4 * 128;
    int* sel = (int*)(sc + 256);
    const float* qn = (const float*)(p.ws + WS_QN);
    const float* kc = (const float*)(p.ws + WS_KC);
    const float* vc = (const float*)(p.ws + WS_VC);
    const float* ksl = (const float*)(p.ws + WS_KSL) + (size_t)g * S * 64;
    const float* vsl = (const float*)(p.ws + WS_VSL) + (size_t)g * S * 64;
    const float* kwn = (const float*)(p.ws + WS_KWN) + (size_t)g * S * 64;
    const float* vwn = (const float*)(p.ws + WS_VWN) + (size_t)g * S * 64;
    const float* gt = (const float*)(p.ws + WS_GT);
    const float* relb = p.in[17];
    const int h = g * 4 + r;
    __syncthreads();
    for (int i = tid; i < 512; i += NT) { const int hh = i >> 7, n = i & 127; lut[i] = relb[bucket_of(n) * 16 + g * 4 + hh]; }
    float q[64];
    {
        const float4* qp = (const float4*)(qn + (size_t)t * 512 + h * 64);
#pragma unroll
        for (int d = 0; d < 16; ++d) { const float4 v = qp[d]; q[4 * d] = v.x; q[4 * d + 1] = v.y; q[4 * d + 2] = v.z; q[4 * d + 3] = v.w; }
    }
    __syncthreads();
    const float* mylut = lut + r * 128;
    float* pr = pl + r * 1024;
    const int nv = (t >= 31) ? ((t - 31) >> 4) + 1 : 0;
    float mx = -1e30f;
#pragma unroll 1
    for (int c = lane; c < nv; c += 64) {
        int dist = t - (16 * c + 31); dist = dist > 127 ? 127 : dist;
        const float v = dot64(q, kc + ((size_t)c * 2 + g) * 64) + mylut[dist];
        pr[c] = v; mx = fmaxf(mx, v);
    }
    wave_softmax_lds(pr, nv, 1024, lane, mx);
    __syncthreads();
    float oc = 0.f;
#pragma unroll 4
    for (int c = 0; c < nv; ++c) oc += pr[c] * vc[((size_t)c * 2 + g) * 64 + lane];
    {
        const int n = tid;
        float imp = 0.f;
#pragma unroll
        for (int rr = 0; rr < 4; ++rr) {
            const float* prr = pl + rr * 1024;
            float v = prr[4 * n] + prr[4 * n + 1] + prr[4 * n + 2];
            if (4 * n + 3 < NCMP) v += 0.5f * prr[4 * n + 3];
            if (n > 0) v += 0.5f * prr[4 * n - 1];
            imp += v;
        }
        const int cur = t >> 6;
        const bool valid = n <= cur;
        const bool forced = valid && (n == 0 || n > cur - 2);
        sc[n] = forced ? __builtin_inff() : (valid ? imp : -__builtin_inff());
    }
    __syncthreads();
    {
        const int n = tid;
        const float my = sc[n];
        int rank = 0;
#pragma unroll 8
        for (int m = 0; m < 256; ++m) { const float o = sc[m]; rank += (o > my) || (o == my && m < n); }
        if (rank < 16) sel[rank] = n;
    }
    __syncthreads();
    mx = -1e30f;
#pragma unroll 1
    for (int j = 0; j < 16; ++j) {
        const int tok = sel[j] * 64 + lane;
        float v = -1e30f;
        if (tok <= t) {
            int dist = t - tok; dist = dist > 127 ? 127 : dist;
            v = dot64(q, ksl + (size_t)tok * 64) + mylut[dist];
        }
        pr[j * 64 + lane] = v; mx = fmaxf(mx, v);
    }
    wave_softmax_lds(pr, 1024, 1024, lane, mx);
    float os = 0.f;
#pragma unroll 1
    for (int j = 0; j < 16; ++j) {
        const int base = sel[j] * 64;
        if (base <= t) {
            const int lim = (t - base) < 63 ? (t - base) : 63;
#pragma unroll 4
            for (int k = 0; k <= lim; ++k) os += pr[j * 64 + k] * vsl[(size_t)(base + k) * 64 + lane];
        }
    }
    const int s0 = t - 511;
    mx = -1e30f;
#pragma unroll 1
    for (int k = lane; k < 512; k += 64) {
        const int s = s0 + k;
        float v = -1e30f;
        if (s >= 0) {
            int dist = t - s; dist = dist > 127 ? 127 : dist;
            v = dot64(q, kwn + (size_t)s * 64) + mylut[dist];
        }
        pr[k] = v; mx = fmaxf(mx, v);
    }
    wave_softmax_lds(pr, 512, 512, lane, mx);
    float ow = 0.f;
    {
        const int kb = s0 < 0 ? -s0 : 0;
#pragma unroll 4
        for (int k = kb; k < 512; ++k) ow += pr[k] * vwn[(size_t)(s0 + k) * 64 + lane];
    }
    const float g0 = gt[(size_t)t * 32 + h * 3 + 0], g1 = gt[(size_t)t * 32 + h * 3 + 1], g2 = gt[(size_t)t * 32 + h * 3 + 2];
    const float o = g0 * oc + g1 * os + g2 * ow;
    ((bf16_t*)(p.ws + WS_OA))[(size_t)t * 512 + h * 64 + lane] = (bf16_t)f2bf(o);
}

__device__ __forceinline__ void dsa_item(const Params& p, int t, unsigned char* smem) {
    const int tid = threadIdx.x, lane = tid & 63, wave = tid >> 6;
    unsigned* keys = (unsigned*)smem;
    float* pbuf = (float*)smem;
    unsigned* hist = keys + 16384;
    int* sel = (int*)(hist + 256);
    float* qi = (float*)(sel + 256);
    float* lut = qi + 256;
    float* wi = lut + 1024;
    int* misc = (int*)(wi + 8);
    const float* iqs = (const float*)(p.ws + WS_IQS);
    const float* iks = (const float*)(p.ws + WS_IKS);
    const float* iws = (const float*)(p.ws + WS_IWS);
    const float* dqn = (const float*)(p.ws + WS_DQN);
    const float* dkn = (const float*)(p.ws + WS_DKN);
    const float* dvn = (const float*)(p.ws + WS_DVN);
    const float* relb = p.in[17];
    __syncthreads();
    qi[tid] = iqs[(size_t)t * 256 + tid];
    if (tid < 8) wi[tid] = iws[(size_t)t * 8 + tid];
    for (int i = tid; i < 1024; i += NT) { const int hh = i >> 7, n = i & 127; lut[i] = relb[bucket_of(n) * 16 + 8 + hh]; }
    if (tid == 0) misc[0] = 0;
    __syncthreads();
    const int n = t + 1;
    int nsel;
    if (n <= 256) {
        if (tid < n) sel[tid] = tid;
        nsel = n;
    } else {
#pragma unroll 1
        for (int s = tid; s < n; s += NT) {
            asm volatile("" ::: "memory");
            const float4* kp = (const float4*)(iks + (size_t)s * 32);
            float kk[32];
#pragma unroll
            for (int d = 0; d < 8; ++d) { const float4 v = kp[d]; kk[4 * d] = v.x; kk[4 * d + 1] = v.y; kk[4 * d + 2] = v.z; kk[4 * d + 3] = v.w; }
            float score = 0.f;
#pragma unroll
            for (int hh = 0; hh < 8; ++hh) {
                float dsum = 0.f;
#pragma unroll
                for (int d = 0; d < 32; ++d) dsum += qi[hh * 32 + d] * kk[d];
                score += wi[hh] * fmaxf(dsum, 0.f);
            }
            score += 0.0f;
            const unsigned u = __builtin_bit_cast(unsigned, score);
            keys[s] = (u & 0x80000000u) ? ~u : (u | 0x80000000u);
        }
        unsigned prefix = 0, mask = 0;
        int need = 256;
#pragma unroll 1
        for (int pass = 3; pass >= 0; --pass) {
            hist[tid] = 0;
            __syncthreads();
#pragma unroll 1
            for (int s = tid; s < n; s += NT) { const unsigned k = keys[s]; if ((k & mask) == prefix) atomicAdd(&hist[(k >> (8 * pass)) & 255u], 1u); }
            __syncthreads();
            {
                unsigned above = 0;
                for (int b = tid + 1; b < 256; ++b) above += hist[b];
                const unsigned mine = hist[tid];
                if ((int)above < need && (int)(above + mine) >= need) { misc[1] = tid; misc[2] = need - (int)above; misc[3] = (int)mine; }
            }
            __syncthreads();
            prefix |= (unsigned)misc[1] << (8 * pass);
            mask |= 0xFFu << (8 * pass);
            need = misc[2];
            __syncthreads();
        }
        const unsigned T = prefix;
        const int ties = misc[3];
        if (ties == need) {
#pragma unroll 1
            for (int s = tid; s < n; s += NT) { const unsigned k = keys[s]; if (k >= T) { const int pos = atomicAdd(&misc[0], 1); sel[pos] = s; } }
        } else {
#pragma unroll 1
            for (int s = tid; s < n; s += NT) { const unsigned k = keys[s]; if (k > T) { const int pos = atomicAdd(&misc[0], 1); sel[pos] = s; } }
            __syncthreads();
            if (tid == 0) {
                int pos = misc[0], got = 0;
                for (int s = 0; s < n && got < need; ++s) if (keys[s] == T) { sel[pos++] = s; ++got; }
            }
        }
        nsel = 256;
    }
    __syncthreads();
#pragma unroll 1
    for (int hh = wave * 2; hh < wave * 2 + 2; ++hh) {
        float q[64];
        {
            const float4* qp = (const float4*)(dqn + (size_t)t * 512 + hh * 64);
#pragma unroll
            for (int d = 0; d < 16; ++d) { const float4 v = qp[d]; q[4 * d] = v.x; q[4 * d + 1] = v.y; q[4 * d + 2] = v.z; q[4 * d + 3] = v.w; }
        }
        float* pr = pbuf + hh * 256;
        float mx = -1e30f;
#pragma unroll 1
        for (int k = lane; k < nsel; k += 64) {
            const int s = sel[k];
            int dist = t - s; dist = dist > 127 ? 127 : dist;
            const float v = dot64(q, dkn + (size_t)s * 512 + hh * 64) + lut[hh * 128 + dist];
            pr[k] = v; mx = fmaxf(mx, v);
        }
        wave_softmax_lds(pr, nsel, nsel, lane, mx);
        float o = 0.f;
#pragma unroll 4
        for (int k = 0; k < nsel; ++k) o += pr[k] * dvn[(size_t)sel[k] * 512 + hh * 64 + lane];
        ((bf16_t*)(p.ws + WS_OB))[(size_t)t * 512 + hh * 64 + lane] = (bf16_t)f2bf(o);
    }
}

__device__ __forceinline__ void phase_attn(const Params& p, int bid, int nb, unsigned char* smem) {
    for (int w = bid; w < S + 2 * S; w += nb) {
        if (w < S) dsa_item(p, S - 1 - w, smem);
        else { const int i = w - S; nsa_item(p, i >> 1, i & 1, smem); }
    }
}

__device__ __forceinline__ void phase_merge(const Params& p, int bid, int nb, unsigned char* smem) {
    const float* z = (const float*)(p.ws + WS_Z);
    bf16_t* merged = (bf16_t*)(p.ws + WS_MERGED);
    float* tmp = (float*)(p.ws + WS_X1);
    const int lane = threadIdx.x & 63, wave = threadIdx.x >> 6;
    for (int w = bid; w < 128 * 8; w += nb) {
        const int mt = w % 128, nt = w / 128;
        const int m0 = mt * 128, n0 = nt * 128;
#pragma unroll 1
        for (int pass = 0; pass < 2; ++pass) {
            f32x4 acc[2][8];
            const bf16_t* A = (const bf16_t*)(p.ws + (pass ? WS_OB : WS_OA));
            const float* Bw = pass ? p.in[15] : p.in[14];
            const int zoff = pass ? Z_GB : Z_GA;
            gemm_tile<false, false>(A, 512, nullptr, m0, 128, Bw, D, n0, 0, 128, 512, smem, acc);
#pragma unroll
            for (int i = 0; i < 2; ++i)
#pragma unroll
                for (int r = 0; r < 4; ++r) {
                    const int row = m0 + wave * 32 + i * 16 + 4 * (lane >> 4) + r;
                    const float* zr = z + (size_t)row * DIN + zoff + n0 + (lane & 15);
                    float* tr = tmp + (size_t)row * D + n0 + (lane & 15);
                    bf16_t* mr = merged + (size_t)row * D + n0 + (lane & 15);
#pragma unroll
                    for (int j = 0; j < 8; ++j) {
                        const float v = sigmoidf_(zr[j * 16]) * acc[i][j][r];
                        if (pass == 0) tr[j * 16] = v;
                        else mr[j * 16] = (bf16_t)f2bf(tr[j * 16] + v);
                    }
                    asm volatile("" ::: "memory");
                }
        }
    }
}

__device__ __forceinline__ void phase_outproj(const Params& p, int bid, int nb, unsigned char* smem) {
    const bf16_t* merged = (const bf16_t*)(p.ws + WS_MERGED);
    const float* x = p.in[0];
    float* x1 = (float*)(p.ws + WS_X1);
    const int lane = threadIdx.x & 63, wave = threadIdx.x >> 6;
    for (int w = bid; w < 128 * 8; w += nb) {
        const int mt = w % 128, nt = w / 128;
        const int m0 = mt * 128, n0 = nt * 128;
        f32x4 acc[2][8];
        gemm_tile<false, false>(merged, D, nullptr, m0, 128, p.in[16], D, n0, 0, 128, D, smem, acc);
#pragma unroll
        for (int i = 0; i < 2; ++i)
#pragma unroll
            for (int j = 0; j < 8; ++j)
#pragma unroll
                for (int r = 0; r < 4; ++r) {
                    const int row = m0 + wave * 32 + i * 16 + 4 * (lane >> 4) + r, col = n0 + j * 16 + (lane & 15);
                    x1[(size_t)row * D + col] = x[(size_t)row * D + col] + acc[i][j][r];
                }
    }
}

__device__ __forceinline__ void phase_route(const Params& p, int bid, int nb) {
    const int lane = threadIdx.x & 63, wave = threadIdx.x >> 6;
    const float* x1 = (const float*)(p.ws + WS_X1);
    const float* g = p.in[18];
    const float* wr = p.in[19];
    const float* br = p.in[20];
    bf16_t* hb = (bf16_t*)(p.ws + WS_HB);
    int* topi = (int*)(p.ws + WS_TOPI);
    float* topw = (float*)(p.ws + WS_TOPW);
    int* cnt = (int*)(p.ws + WS_CTL);
    for (int t = bid * 4 + wave; t < S; t += nb * 4) {
        const float4* xr = (const float4*)(x1 + (size_t)t * D);
        float4 v[4];
        float ss = 0.f;
#pragma unroll
        for (int j = 0; j < 4; ++j) { v[j] = xr[lane + 64 * j]; ss += v[j].x * v[j].x + v[j].y * v[j].y + v[j].z * v[j].z + v[j].w * v[j].w; }
        ss = wave_sum(ss);
        const float rstd = rsqrtf(ss * (1.f / D) + EPS);
        float lg[32];
#pragma unroll
        for (int e = 0; e < 32; ++e) lg[e] = 0.f;
#pragma unroll
        for (int j = 0; j < 4; ++j) {
            const float4 gg = ((const float4*)g)[lane + 64 * j];
            const float h0 = v[j].x * rstd * gg.x, h1 = v[j].y * rstd * gg.y, h2 = v[j].z * rstd * gg.z, h3 = v[j].w * rstd * gg.w;
            uint2 o; o.x = pk2(h0, h1); o.y = pk2(h2, h3);
            ((uint2*)(hb + (size_t)t * D))[lane + 64 * j] = o;
            const int k = 4 * (lane + 64 * j);
            const float4* w0 = (const float4*)(wr + (size_t)k * 32);
#pragma unroll
            for (int e4 = 0; e4 < 8; ++e4) {
                const float4 a = w0[e4], b = w0[8 + e4], c = w0[16 + e4], d = w0[24 + e4];
                lg[4 * e4 + 0] += h0 * a.x + h1 * b.x + h2 * c.x + h3 * d.x;
                lg[4 * e4 + 1] += h0 * a.y + h1 * b.y + h2 * c.y + h3 * d.y;
                lg[4 * e4 + 2] += h0 * a.z + h1 * b.z + h2 * c.z + h3 * d.z;
                lg[4 * e4 + 3] += h0 * a.w + h1 * b.w + h2 * c.w + h3 * d.w;
            }
        }
#pragma unroll
        for (int e = 0; e < 32; ++e) lg[e] = wave_sum(lg[e]) + br[e];
        int idx[4]; float val[4];
        unsigned used = 0;
#pragma unroll
        for (int k = 0; k < 4; ++k) {
            float best = -__builtin_inff(); int bi = 0;
#pragma unroll
            for (int e = 0; e < 32; ++e) { const bool ok = !((used >> e) & 1u) && (lg[e] > best); best = ok ? lg[e] : best; bi = ok ? e : bi; }
            idx[k] = bi; val[k] = best; used |= 1u << bi;
        }
        const float e0 = 1.f, e1 = __expf(val[1] - val[0]), e2 = __expf(val[2] - val[0]), e3 = __expf(val[3] - val[0]);
        const float inv = 1.f / (e0 + e1 + e2 + e3);
        if (lane == 0) {
            topi[t * 4 + 0] = idx[0]; topi[t * 4 + 1] = idx[1]; topi[t * 4 + 2] = idx[2]; topi[t * 4 + 3] = idx[3];
            topw[t * 4 + 0] = e0 * inv; topw[t * 4 + 1] = e1 * inv; topw[t * 4 + 2] = e2 * inv; topw[t * 4 + 3] = e3 * inv;
            atomicAdd(&cnt[idx[0]], 1); atomicAdd(&cnt[idx[1]], 1); atomicAdd(&cnt[idx[2]], 1); atomicAdd(&cnt[idx[3]], 1);
        }
    }
}

__device__ __forceinline__ void phase_place(const Params& p, int bid, int nb, unsigned char* smem) {
    int* off = (int*)smem;
    const int* cnt = (const int*)(p.ws + WS_CTL);
    int* cur = (int*)(p.ws + WS_CTL) + 32;
    const int* topi = (const int*)(p.ws + WS_TOPI);
    int* ppos = (int*)(p.ws + WS_PPOS);
    int* rowtok = (int*)(p.ws + WS_ROWTOK);
    __syncthreads();
    if (threadIdx.x == 0) { int a = 0; for (int e = 0; e < NEXP; ++e) { off[e] = a; a += cnt[e]; } }
    __syncthreads();
    for (int i = bid * NT + threadIdx.x; i < S * 4; i += nb * NT) {
        const int e = topi[i];
        const int pos = off[e] + atomicAdd(&cur[e], 1);
        ppos[i] = pos;
        rowtok[pos] = i >> 2;
    }
}

__device__ __forceinline__ void moe_tile_map(const int* cnt, int* sm, int& total_mt) {
    __syncthreads();
    if (threadIdx.x == 0) {
        int a = 0, b = 0;
        for (int e = 0; e < NEXP; ++e) { sm[e] = a; sm[33 + e] = b; a += (cnt[e] + 127) >> 7; b += cnt[e]; }
        sm[32] = a; sm[65] = b;
    }
    __syncthreads();
    total_mt = sm[32];
}
__device__ __forceinline__ void phase_moe1(const Params& p, int bid, int nb, unsigned char* smem) {
    int* sm = (int*)(smem + 32768);
    const int* cnt = (const int*)(p.ws + WS_CTL);
    const int* rowtok = (const int*)(p.ws + WS_ROWTOK);
    const bf16_t* hb = (const bf16_t*)(p.ws + WS_HB);
    bf16_t* act = (bf16_t*)(p.ws + WS_ACT);
    const int lane = threadIdx.x & 63, wave = threadIdx.x >> 6;
    int total_mt;
    moe_tile_map(cnt, sm, total_mt);
    for (int w = bid; w < total_mt * 16; w += nb) {
        const int tm = w >> 4, nt = w & 15;
        int e = 0;
        while (e < NEXP - 1 && sm[e + 1] <= tm) ++e;
        const int mt = tm - sm[e];
        const int rbase = sm[33 + e] + mt * 128;
        const int mrows = min(128, cnt[e] - mt * 128);
        const int n0 = nt * 64;
        f32x4 acc[2][8];
        gemm_tile<false, true>(hb, D, rowtok, rbase, mrows, p.in[21] + (size_t)e * D * 2 * DFF, 2 * DFF, n0, DFF - 64, 128, D, smem, acc);
        const float* b1 = p.in[22] + (size_t)e * 2 * DFF;
#pragma unroll
        for (int i = 0; i < 2; ++i)
#pragma unroll
            for (int j = 0; j < 4; ++j) {
                const int col = n0 + j * 16 + (lane & 15);
                const float bg = b1[col], bl = b1[DFF + col];
#pragma unroll
                for (int r = 0; r < 4; ++r) {
                    const int rl = wave * 32 + i * 16 + 4 * (lane >> 4) + r;
                    if (rl < mrows) {
                        const float gate = fminf(acc[i][j][r] + bg, 7.f);
                        const float lin = fminf(fmaxf(acc[i][j + 4][r] + bl, -7.f), 7.f);
                        const float a = (lin + 1.f) * gate * sigmoidf_(1.702f * gate);
                        act[(size_t)(rbase + rl) * DFF + col] = (bf16_t)f2bf(a);
                    }
                }
            }
    }
}
__device__ __forceinline__ void phase_moe2(const Params& p, int bid, int nb, unsigned char* smem) {
    int* sm = (int*)(smem + 32768);
    const int* cnt = (const int*)(p.ws + WS_CTL);
    const bf16_t* act = (const bf16_t*)(p.ws + WS_ACT);
    float* yrows = (float*)(p.ws + WS_YROWS);
    const int lane = threadIdx.x & 63, wave = threadIdx.x >> 6;
    int total_mt;
    moe_tile_map(cnt, sm, total_mt);
    for (int w = bid; w < total_mt * 8; w += nb) {
        const int tm = w >> 3, nt = w & 7;
        int e = 0;
        while (e < NEXP - 1 && sm[e + 1] <= tm) ++e;
        const int mt = tm - sm[e];
        const int rbase = sm[33 + e] + mt * 128;
        const int mrows = min(128, cnt[e] - mt * 128);
        const int n0 = nt * 128;
        f32x4 acc[2][8];
        gemm_tile<false, false>(act, DFF, nullptr, rbase, mrows, p.in[23] + (size_t)e * DFF * D, D, n0, 0, 128, DFF, smem, acc);
        const float* b2 = p.in[24] + (size_t)e * D;
#pragma unroll
        for (int i = 0; i < 2; ++i)
#pragma unroll
            for (int j = 0; j < 8; ++j) {
                const int col = n0 + j * 16 + (lane & 15);
                const float bb = b2[col];
#pragma unroll
                for (int r = 0; r < 4; ++r) {
                    const int rl = wave * 32 + i * 16 + 4 * (lane >> 4) + r;
                    if (rl < mrows) yrows[(size_t)(rbase + rl) * D + col] = acc[i][j][r] + bb;
                }
            }
    }
}

__device__ __forceinline__ void phase_combine(const Params& p, int bid, int nb) {
    const int lane = threadIdx.x & 63, wave = threadIdx.x >> 6;
    const float* x1 = (const float*)(p.ws + WS_X1);
    const float* yrows = (const float*)(p.ws + WS_YROWS);
    const int* ppos = (const int*)(p.ws + WS_PPOS);
    const float* topw = (const float*)(p.ws + WS_TOPW);
    const float* g = p.in[25];
    bf16_t* hb = (bf16_t*)(p.ws + WS_HB);
    bf16_t* pb = (bf16_t*)(p.ws + WS_PB);
    for (int t = bid * 4 + wave; t < S; t += nb * 4) {
        {
            const float4 pv = ((const float4*)(p.in[1] + (size_t)t * 256))[lane];
            uint2 o; o.x = pk2(pv.x, pv.y); o.y = pk2(pv.z, pv.w);
            ((uint2*)(pb + (size_t)t * 256))[lane] = o;
        }
        float4 v[4];
#pragma unroll
        for (int j = 0; j < 4; ++j) v[j] = ((const float4*)(x1 + (size_t)t * D))[lane + 64 * j];
#pragma unroll
        for (int k = 0; k < 4; ++k) {
            const float wk = topw[t * 4 + k];
            const float4* yr = (const float4*)(yrows + (size_t)ppos[t * 4 + k] * D);
#pragma unroll
            for (int j = 0; j < 4; ++j) { const float4 y = yr[lane + 64 * j]; v[j].x += wk * y.x; v[j].y += wk * y.y; v[j].z += wk * y.z; v[j].w += wk * y.w; }
        }
        float ss = 0.f;
#pragma unroll
        for (int j = 0; j < 4; ++j) ss += v[j].x * v[j].x + v[j].y * v[j].y + v[j].z * v[j].z + v[j].w * v[j].w;
        ss = wave_sum(ss);
        const float rstd = rsqrtf(ss * (1.f / D) + EPS);
#pragma unroll
        for (int j = 0; j < 4; ++j) {
            ((float4*)(p.out + (size_t)t * D))[lane + 64 * j] = v[j];
            const float4 gg = ((const float4*)g)[lane + 64 * j];
            uint2 o;
            o.x = pk2(v[j].x * rstd * gg.x, v[j].y * rstd * gg.y);
            o.y = pk2(v[j].z * rstd * gg.z, v[j].w * rstd * gg.w);
            ((uint2*)(hb + (size_t)t * D))[lane + 64 * j] = o;
        }
    }
}

__device__ __forceinline__ void phase_ple(const Params& p, int bid, int nb, unsigned char* smem) {
    float* tmp = (float*)(p.ws + WS_X1);
    const int lane = threadIdx.x & 63, wave = threadIdx.x >> 6;
    for (int w = bid; w < 128 * 8; w += nb) {
        const int mt = w % 128, nt = w / 128;
        const int m0 = mt * 128, n0 = nt * 128;
#pragma unroll 1
        for (int pass = 0; pass < 2; ++pass) {
            f32x4 acc[2][8];
            const bf16_t* A = (const bf16_t*)(p.ws + (pass ? WS_PB : WS_HB));
            const float* Bw = pass ? p.in[26] : p.in[27];
            const int K = pass ? 256 : D;
            gemm_tile<false, false>(A, K, nullptr, m0, 128, Bw, D, n0, 0, 128, K, smem, acc);
#pragma unroll
            for (int i = 0; i < 2; ++i)
#pragma unroll
                for (int r = 0; r < 4; ++r) {
                    const int row = m0 + wave * 32 + i * 16 + 4 * (lane >> 4) + r;
                    float* tr = tmp + (size_t)row * D + n0 + (lane & 15);
                    float* orow = p.out + (size_t)row * D + n0 + (lane & 15);
#pragma unroll
                    for (int j = 0; j < 8; ++j) {
                        if (pass == 0) tr[j * 16] = sigmoidf_(acc[i][j][r]);
                        else orow[j * 16] = orow[j * 16] + tr[j * 16] * acc[i][j][r];
                    }
                    asm volatile("" ::: "memory");
                }
        }
    }
}

template <int PH>
__device__ __forceinline__ void run_phase(const Params& p, int bid, int nb, unsigned char* smem) {
    if (PH == 0) phase_prep(p, bid, nb);
    if (PH == 1) phase_inproj(p, bid, nb, smem);
    if (PH == 2) phase_post(p, bid, nb);
    if (PH == 3) phase_compress(p, bid, nb);
    if (PH == 4) phase_attn(p, bid, nb, smem);
    if (PH == 5) phase_merge(p, bid, nb, smem);
    if (PH == 6) phase_outproj(p, bid, nb, smem);
    if (PH == 7) phase_route(p, bid, nb);
    if (PH == 8) phase_place(p, bid, nb, smem);
    if (PH == 9) phase_moe1(p, bid, nb, smem);
    if (PH == 10) phase_moe2(p, bid, nb, smem);
    if (PH == 11) phase_combine(p, bid, nb);
    if (PH == 12) phase_ple(p, bid, nb, smem);
}

#if SINGLE_LAUNCH
__global__ void __launch_bounds__(NT, 2) fwd_mega(Params p) {
    __shared__ __attribute__((aligned(16))) unsigned char smem[SMEM_BYTES];
    cg::grid_group grid = cg::this_grid();
    const int bid = blockIdx.x, nb = gridDim.x;
    run_phase<0>(p, bid, nb, smem); grid.sync();
    run_phase<1>(p, bid, nb, smem); grid.sync();
    run_phase<2>(p, bid, nb, smem); grid.sync();
    run_phase<3>(p, bid, nb, smem); grid.sync();
    run_phase<4>(p, bid, nb, smem); grid.sync();
    run_phase<5>(p, bid, nb, smem); grid.sync();
    run_phase<6>(p, bid, nb, smem); grid.sync();
    run_phase<7>(p, bid, nb, smem); grid.sync();
    run_phase<8>(p, bid, nb, smem); grid.sync();
    run_phase<9>(p, bid, nb, smem); grid.sync();
    run_phase<10>(p, bid, nb, smem); grid.sync();
    run_phase<11>(p, bid, nb, smem); grid.sync();
    run_phase<12>(p, bid, nb, smem);
}
#else
template <int PH>
__global__ void __launch_bounds__(NT, 2) k_phase(Params p) {
    __shared__ __attribute__((aligned(16))) unsigned char smem[SMEM_BYTES];
    run_phase<PH>(p, blockIdx.x, gridDim.x, smem);
}
#endif

extern "C" void kernel_launch(void* const* d_in, const int* in_sizes, int n_in, void* d_out, int out_size, void* d_ws, size_t ws_size,
                              hipStream_t stream) {
    if (n_in != 28 || ws_size < WS_END) { fprintf(stderr, "kernel_launch: unexpected n_in %d or ws_size %zu (< %zu)\n", n_in, ws_size, (size_t)WS_END); return; }
    Params p{};
    for (int i = 0; i < 28; ++i) p.in[i] = (const float*)d_in[i];
    p.out = (float*)d_out;
    p.ws = (unsigned char*)d_ws;
#if SINGLE_LAUNCH
    static int grid_blocks = 0;
    if (!grid_blocks) {
        int dev = 0, cus = 0, per_cu = 0;
        hipGetDevice(&dev);
        hipDeviceGetAttribute(&cus, hipDeviceAttributeMultiprocessorCount, dev);
        hipOccupancyMaxActiveBlocksPerMultiprocessor(&per_cu, fwd_mega, NT, 0);
        if (per_cu > 2) per_cu = 2;
        if (per_cu < 1) per_cu = 1;
        grid_blocks = cus * per_cu;
    }
    void* args[] = {&p};
    hipError_t e = hipLaunchCooperativeKernel((void*)fwd_mega, dim3(grid_blocks), dim3(NT), args, 0, stream);
    if (e != hipSuccess) fprintf(stderr, "cooperative launch failed: %s (grid %d)\n", hipGetErrorString(e), grid_blocks);
#else
    const int G = 512;
    k_phase<0><<<G, NT, 0, stream>>>(p);
    k_phase<1><<<G, NT, 0, stream>>>(p);
    k_phase<2><<<G, NT, 0, stream>>>(p);
    k_phase<3><<<G, NT, 0, stream>>>(p);
    k_phase<4><<<G, NT, 0, stream>>>(p);
    k_phase<5><<<G, NT, 0, stream>>>(p);
    k_phase<6><<<G, NT, 0, stream>>>(p);
    k_phase<7><<<G, NT, 0, stream>>>(p);
    k_phase<8><<<G, NT, 0, stream>>>(p);
    k_phase<9><<<G, NT, 0, stream>>>(p);
    k_phase<10><<<G, NT, 0, stream>>>(p);
    k_phase<11><<<G, NT, 0, stream>>>(p);
    k_phase<12><<<G, NT, 0, stream>>>(p);
#endif
}
```

```cpp
#include <hip/hip_runtime.h>
#include <hip/hip_cooperative_groups.h>
#include <cstdio>
#include <cstdint>
namespace cg = cooperative_groups;

#ifndef SINGLE_LAUNCH
#define SINGLE_LAUNCH 1
#endif

constexpr int S = 16384;
constexpr int D = 1024;
constexpr int DIN = 5184;
constexpr int NCMP = 1023;
constexpr int NSLC = 256;
constexpr int NEXP = 32;
constexpr int DFF = 1024;
constexpr float EPS = 1e-6f;
constexpr int Z_NQ = 0, Z_NKV = 512, Z_NGATE = 1280, Z_DQ = 1304, Z_DK = 1816, Z_DV = 2328, Z_IQ = 2840, Z_IK = 3096,
              Z_IW = 3128, Z_GA = 3136, Z_GB = 4160;

constexpr int NT = 256;
constexpr int SMEM_BYTES = 73728;

typedef unsigned short bf16_t;
typedef short bf16x8 __attribute__((ext_vector_type(8)));
typedef float f32x4 __attribute__((ext_vector_type(4)));

constexpr size_t MBy = 1ull << 20;
constexpr size_t WS_CTL = 0;
constexpr size_t WS_HB = 1 * MBy;
constexpr size_t WS_OA = WS_HB + (size_t)S * D * 2;
constexpr size_t WS_OB = WS_OA + (size_t)S * 512 * 2;
constexpr size_t WS_MERGED = WS_OB + (size_t)S * 512 * 2;
constexpr size_t WS_X1 = WS_MERGED + (size_t)S * D * 2;
constexpr size_t WS_TOPI = WS_X1 + (size_t)S * D * 4;
constexpr size_t WS_TOPW = WS_TOPI + (size_t)S * 4 * 4;
constexpr size_t WS_PPOS = WS_TOPW + (size_t)S * 4 * 4;
constexpr size_t WS_ROWTOK = WS_PPOS + (size_t)S * 4 * 4;
constexpr size_t WS_KC = WS_ROWTOK + (size_t)65536 * 4;
constexpr size_t WS_VC = WS_KC + (size_t)1024 * 128 * 4;
constexpr size_t WS_PB = WS_VC + (size_t)1024 * 128 * 4;
constexpr size_t WS_REG = WS_PB + (size_t)S * 256 * 2;
constexpr size_t WS_Z = WS_REG;
constexpr size_t WS_QN = WS_Z + (size_t)S * DIN * 4;
constexpr size_t WS_KSL = WS_QN + (size_t)S * 512 * 4;
constexpr size_t WS_VSL = WS_KSL + (size_t)S * 128 * 4;
constexpr size_t WS_KWN = WS_VSL + (size_t)S * 128 * 4;
constexpr size_t WS_VWN = WS_KWN + (size_t)S * 128 * 4;
constexpr size_t WS_GT = WS_VWN + (size_t)S * 128 * 4;
constexpr size_t WS_DQN = WS_GT + (size_t)S * 32 * 4;
constexpr size_t WS_DKN = WS_DQN + (size_t)S * 512 * 4;
constexpr size_t WS_DVN = WS_DKN + (size_t)S * 512 * 4;
constexpr size_t WS_IQS = WS_DVN + (size_t)S * 512 * 4;
constexpr size_t WS_IKS = WS_IQS + (size_t)S * 256 * 4;
constexpr size_t WS_IWS = WS_IKS + (size_t)S * 32 * 4;
constexpr size_t WS_ENDA = WS_IWS + (size_t)S * 8 * 4;
constexpr size_t WS_ACT = WS_REG;
constexpr size_t WS_YROWS = WS_ACT + (size_t)(65536 + 128) * DFF * 2;
constexpr size_t WS_ENDB = WS_YROWS + (size_t)(65536 + 128) * D * 4;
constexpr size_t WS_END = WS_ENDA > WS_ENDB ? WS_ENDA : WS_ENDB;

struct Params {
    const float* in[28];
    float* out;
    unsigned char* ws;
};

__device__ __forceinline__ unsigned f2bf(float f) {
    unsigned u = __builtin_bit_cast(unsigned, f);
    return (u + 0x7fffu + ((u >> 16) & 1u)) >> 16;
}
__device__ __forceinline__ unsigned pk2(float lo, float hi) { return f2bf(lo) | (f2bf(hi) << 16); }
__device__ __forceinline__ float bf2f(unsigned short b) { return __builtin_bit_cast(float, (unsigned)b << 16); }
__device__ __forceinline__ float wave_sum(float v) {
#pragma unroll
    for (int o = 1; o < 64; o <<= 1) v += __shfl_xor(v, o);
    return v;
}
__device__ __forceinline__ float wave_max(float v) {
#pragma unroll
    for (int o = 1; o < 64; o <<= 1) v = fmaxf(v, __shfl_xor(v, o));
    return v;
}
__device__ __forceinline__ float sigmoidf_(float x) { return 1.f / (1.f + __expf(-x)); }
__device__ __forceinline__ int bucket_of(int n) {
    if (n < 16) return n;
    int b = 16;
    b += (n >= 19) + (n >= 21) + (n >= 24) + (n >= 27) + (n >= 31) + (n >= 35) + (n >= 40) + (n >= 46) + (n >= 52) + (n >= 59) +
         (n >= 67) + (n >= 77) + (n >= 87) + (n >= 99) + (n >= 113);
    return b;
}

constexpr int LDS_STRIDE = 40;
template <bool A_F32, bool GATHER>
__device__ __forceinline__ void gemm_tile(const void* __restrict__ Aptr, int lda, const int* __restrict__ rowidx, int m0, int mrows,
                                          const float* __restrict__ B, int ldb, int n0, int split_off, int ncols, int K,
                                          unsigned char* smem, f32x4 (&acc)[2][8]) {
    bf16_t* As = (bf16_t*)smem;
    bf16_t* Bs = As + 128 * LDS_STRIDE;
    const int tid = threadIdx.x, lane = tid & 63, wave = tid >> 6;
#pragma unroll
    for (int i = 0; i < 2; ++i)
#pragma unroll
        for (int j = 0; j < 8; ++j) acc[i][j] = (f32x4){0.f, 0.f, 0.f, 0.f};

    const int ar = tid >> 2, ach = tid & 3;
    const unsigned char* arow[2];
    bool aval[2];
#pragma unroll
    for (int i = 0; i < 2; ++i) {
        int r = ar + 64 * i;
        aval[i] = r < mrows;
        long src = 0;
        if (aval[i]) src = GATHER ? (long)rowidx[m0 + r] : (long)(m0 + r);
        arow[i] = (const unsigned char*)Aptr + (size_t)src * lda * (A_F32 ? 4 : 2) + (size_t)ach * 8 * (A_F32 ? 4 : 2);
    }
    const int nq = tid & 31, kq = tid >> 5;
    const int jn = 4 * nq;
    const bool bval = jn < ncols;
    const float* bptr = B + (size_t)(4 * kq) * ldb + n0 + jn + (jn >= 64 ? split_off : 0);

    uint4 areg[2];
    float4 af[2][2];
    float4 breg[4];
    auto load_g = [&](int k0) {
#pragma unroll
        for (int i = 0; i < 2; ++i) {
            if (A_F32) {
                if (aval[i]) {
                    const float4* s = (const float4*)(arow[i] + (size_t)k0 * 4);
                    af[i][0] = s[0]; af[i][1] = s[1];
                } else { af[i][0] = make_float4(0, 0, 0, 0); af[i][1] = af[i][0]; }
            } else {
                if (aval[i]) areg[i] = *(const uint4*)(arow[i] + (size_t)k0 * 2);
                else areg[i] = make_uint4(0, 0, 0, 0);
            }
        }
#pragma unroll
        for (int kk = 0; kk < 4; ++kk) {
            if (bval) breg[kk] = *(const float4*)(bptr + (size_t)(k0 + kk) * ldb);
            else breg[kk] = make_float4(0, 0, 0, 0);
        }
    };
    auto store_l = [&]() {
#pragma unroll
        for (int i = 0; i < 2; ++i) {
            uint4 v;
            if (A_F32) {
                v.x = pk2(af[i][0].x, af[i][0].y); v.y = pk2(af[i][0].z, af[i][0].w);
                v.z = pk2(af[i][1].x, af[i][1].y); v.w = pk2(af[i][1].z, af[i][1].w);
            } else v = areg[i];
            *(uint4*)(As + (ar + 64 * i) * LDS_STRIDE + ach * 8) = v;
        }
        {
            uint2 v;
            v.x = pk2(breg[0].x, breg[1].x); v.y = pk2(breg[2].x, breg[3].x);
            *(uint2*)(Bs + (jn + 0) * LDS_STRIDE + 4 * kq) = v;
            v.x = pk2(breg[0].y, breg[1].y); v.y = pk2(breg[2].y, breg[3].y);
            *(uint2*)(Bs + (jn + 1) * LDS_STRIDE + 4 * kq) = v;
            v.x = pk2(breg[0].z, breg[1].z); v.y = pk2(breg[2].z, breg[3].z);
            *(uint2*)(Bs + (jn + 2) * LDS_STRIDE + 4 * kq) = v;
            v.x = pk2(breg[0].w, breg[1].w); v.y = pk2(breg[2].w, breg[3].w);
            *(uint2*)(Bs + (jn + 3) * LDS_STRIDE + 4 * kq) = v;
        }
    };
    const int nk = K / 32;
    __syncthreads();
    load_g(0);
    store_l();
    __syncthreads();
    const int fr = lane & 15, fq = lane >> 4;
    for (int kt = 0; kt < nk; ++kt) {
        if (kt + 1 < nk) load_g((kt + 1) * 32);
        bf16x8 a[2], b[8];
#pragma unroll
        for (int i = 0; i < 2; ++i) a[i] = *(const bf16x8*)(As + (wave * 32 + i * 16 + fr) * LDS_STRIDE + fq * 8);
#pragma unroll
        for (int j = 0; j < 8; ++j) b[j] = *(const bf16x8*)(Bs + (j * 16 + fr) * LDS_STRIDE + fq * 8);
#pragma unroll
        for (int i = 0; i < 2; ++i)
#pragma unroll
            for (int j = 0; j < 8; ++j) acc[i][j] = __builtin_amdgcn_mfma_f32_16x16x32_bf16(a[i], b[j], acc[i][j], 0, 0, 0);
        __syncthreads();
        if (kt + 1 < nk) {
            store_l();
            __syncthreads();
        }
    }
}

__device__ __forceinline__ void phase_prep(const Params& p, int bid, int nb) {
    const int lane = threadIdx.x & 63, wave = threadIdx.x >> 6;
    if (bid == 0 && threadIdx.x < 64) ((int*)(p.ws + WS_CTL))[threadIdx.x] = 0;
    const float* x = p.in[0];
    const float* g = p.in[3];
    bf16_t* hb = (bf16_t*)(p.ws + WS_HB);
    for (int t = bid * 4 + wave; t < S; t += nb * 4) {
        const float4* xr = (const float4*)(x + (size_t)t * D);
        float4 v[4];
        float ss = 0.f;
#pragma unroll
        for (int j = 0; j < 4; ++j) { v[j] = xr[lane + 64 * j]; ss += v[j].x * v[j].x + v[j].y * v[j].y + v[j].z * v[j].z + v[j].w * v[j].w; }
        ss = wave_sum(ss);
        const float rstd = rsqrtf(ss * (1.f / D) + EPS);
#pragma unroll
        for (int j = 0; j < 4; ++j) {
            const float4 gg = ((const float4*)g)[lane + 64 * j];
            uint2 o;
            o.x = pk2(v[j].x * rstd * gg.x, v[j].y * rstd * gg.y);
            o.y = pk2(v[j].z * rstd * gg.z, v[j].w * rstd * gg.w);
            ((uint2*)(hb + (size_t)t * D))[lane + 64 * j] = o;
        }
    }
}

__device__ __forceinline__ void phase_inproj(const Params& p, int bid, int nb, unsigned char* smem) {
    const bf16_t* hb = (const bf16_t*)(p.ws + WS_HB);
    float* z = (float*)(p.ws + WS_Z);
    const int lane = threadIdx.x & 63, wave = threadIdx.x >> 6;
    constexpr int NTN = (DIN + 127) / 128;
    for (int w = bid; w < 128 * NTN; w += nb) {
        const int mt = w % 128, nt = w / 128;
        const int m0 = mt * 128, n0 = nt * 128;
        const int ncols = (DIN - n0) < 128 ? (DIN - n0) : 128;
        f32x4 acc[2][8];
        gemm_tile<false, false>(hb, D, nullptr, m0, 128, p.in[2], DIN, n0, 0, ncols, D, smem, acc);
#pragma unroll
        for (int i = 0; i < 2; ++i)
#pragma unroll
            for (int j = 0; j < 8; ++j) {
                const int col = n0 + j * 16 + (lane & 15);
                if (j * 16 < ncols) {
#pragma unroll
                    for (int r = 0; r < 4; ++r) {
                        const int row = m0 + wave * 32 + i * 16 + 4 * (lane >> 4) + r;
                        z[(size_t)row * DIN + col] = acc[i][j][r];
                    }
                }
            }
    }
}

__device__ __forceinline__ float rms64(float v) { return rsqrtf(wave_sum(v * v) * (1.f / 64.f) + EPS); }
__device__ __forceinline__ void phase_post(const Params& p, int bid, int nb) {
    const int lane = threadIdx.x & 63, wave = threadIdx.x >> 6;
    const float* z = (const float*)(p.ws + WS_Z);
    float* qn = (float*)(p.ws + WS_QN);
    float* ksl = (float*)(p.ws + WS_KSL);
    float* vsl = (float*)(p.ws + WS_VSL);
    float* kwn = (float*)(p.ws + WS_KWN);
    float* vwn = (float*)(p.ws + WS_VWN);
    float* gt = (float*)(p.ws + WS_GT);
    float* dqn = (float*)(p.ws + WS_DQN);
    float* dkn = (float*)(p.ws + WS_DKN);
    float* dvn = (float*)(p.ws + WS_DVN);
    float* iqs = (float*)(p.ws + WS_IQS);
    float* iks = (float*)(p.ws + WS_IKS);
    float* iws = (float*)(p.ws + WS_IWS);
    const float gqn = p.in[4][lane], gkn = p.in[5][lane], gqd = p.in[6][lane], gkd = p.in[7][lane];
    for (int t = bid * 4 + wave; t < S; t += nb * 4) {
        const float* zr = z + (size_t)t * DIN;
#pragma unroll
        for (int h = 0; h < 8; ++h) {
            const float v = zr[Z_NQ + h * 64 + lane];
            qn[(size_t)t * 512 + h * 64 + lane] = v * rms64(v) * gqn * 0.125f;
        }
#pragma unroll
        for (int g = 0; g < 2; ++g) {
            float v = zr[Z_NKV + 2 * 128 + g * 64 + lane];
            ksl[((size_t)g * S + t) * 64 + lane] = v * rms64(v) * gkn;
            v = zr[Z_NKV + 3 * 128 + g * 64 + lane];
            vsl[((size_t)g * S + t) * 64 + lane] = v;
            v = zr[Z_NKV + 4 * 128 + g * 64 + lane];
            kwn[((size_t)g * S + t) * 64 + lane] = v * rms64(v) * gkn;
            v = zr[Z_NKV + 5 * 128 + g * 64 + lane];
            vwn[((size_t)g * S + t) * 64 + lane] = v;
        }
        if (lane < 24) gt[(size_t)t * 32 + lane] = sigmoidf_(zr[Z_NGATE + lane]);
#pragma unroll
        for (int h = 0; h < 8; ++h) {
            float v = zr[Z_DQ + h * 64 + lane];
            dqn[(size_t)t * 512 + h * 64 + lane] = v * rms64(v) * gqd * 0.125f;
            v = zr[Z_DK + h * 64 + lane];
            dkn[(size_t)t * 512 + h * 64 + lane] = v * rms64(v) * gkd;
            dvn[(size_t)t * 512 + h * 64 + lane] = zr[Z_DV + h * 64 + lane];
        }
#pragma unroll
        for (int j = 0; j < 4; ++j) iqs[(size_t)t * 256 + j * 64 + lane] = zr[Z_IQ + j * 64 + lane] * 0.17677669529663687f;
        if (lane < 32) iks[(size_t)t * 32 + lane] = zr[Z_IK + lane];
        if (lane < 8) iws[(size_t)t * 8 + lane] = zr[Z_IW + lane] * 0.35355339059327373f;
    }
}

__device__ __forceinline__ void phase_compress(const Params& p, int bid, int nb) {
    const int lane = threadIdx.x & 63, wave = threadIdx.x >> 6;
    const float* z = (const float*)(p.ws + WS_Z);
    float* kc = (float*)(p.ws + WS_KC);
    float* vc = (float*)(p.ws + WS_VC);
    const float gkn = p.in[5][lane];
    for (int it = bid * 4 + wave; it < NCMP * 4; it += nb * 4) {
        const int kind = it & 1, g = (it >> 1) & 1, c = it >> 2;
        const float* pe = p.in[kind ? 11 : 8];
        const float* w1 = p.in[kind ? 12 : 9];
        const float* w2 = p.in[kind ? 13 : 10];
        float acc = 0.f;
        for (int l = 0; l < 32; ++l) {
            const float* zr = z + (size_t)(16 * c + l) * DIN + Z_NKV + kind * 128 + g * 64;
            const float zin = zr[lane] + pe[l * 64 + lane];
            const float* w1l = w1 + (size_t)l * 64 * 64;
#pragma unroll 8
            for (int d = 0; d < 64; ++d) acc += __shfl(zin, d) * w1l[d * 64 + lane];
        }
        const float hid = acc * sigmoidf_(acc);
        float o = 0.f;
#pragma unroll 8
        for (int e = 0; e < 64; ++e) o += __shfl(hid, e) * w2[e * 64 + lane];
        if (kind == 0) {
            o = o * rms64(o) * gkn;
            kc[((size_t)c * 2 + g) * 64 + lane] = o;
        } else vc[((size_t)c * 2 + g) * 64 + lane] = o;
    }
}

__device__ __forceinline__ float dot64(const float (&q)[64], const float* kp_) {
    const float4* kp = (const float4*)kp_;
    float dsum = 0.f;
#pragma unroll
    for (int d = 0; d < 16; ++d) { const float4 kv = kp[d]; dsum += q[4 * d] * kv.x + q[4 * d + 1] * kv.y + q[4 * d + 2] * kv.z + q[4 * d + 3] * kv.w; }
    return dsum;
}
__device__ __forceinline__ void wave_softmax_lds(float* pr, int n, int npad, int lane, float mx) {
    mx = wave_max(mx);
    float sum = 0.f;
#pragma unroll 1
    for (int k = lane; k < n; k += 64) { const float v = pr[k]; const float e = (v > -1e29f) ? __expf(v - mx) : 0.f; pr[k] = e; sum += e; }
    sum = wave_sum(sum);
    const float inv = 1.f / fmaxf(sum, 1e-30f);
#pragma unroll 1
    for (int k = lane; k < npad; k += 64) pr[k] = (k < n) ? pr[k] * inv : 0.f;
}
__device__ __forceinline__ void nsa_item(const Params& p, int t, int g, unsigned char* smem) {
    const int tid = threadIdx.x, lane = tid & 63, r = tid >> 6;
    float* pl = (float*)smem;
    float* lut = pl + 4 * 1024;
    float* sc = lut + 4 * 128;
    int* sel = (int*)(sc + 256);
    const float* qn = (const float*)(p.ws + WS_QN);
    const float* kc = (const float*)(p.ws + WS_KC);
    const float* vc = (const float*)(p.ws + WS_VC);
    const float* ksl = (const float*)(p.ws + WS_KSL) + (size_t)g * S * 64;
    const float* vsl = (const float*)(p.ws + WS_VSL) + (size_t)g * S * 64;
    const float* kwn = (const float*)(p.ws + WS_KWN) + (size_t)g * S * 64;
    const float* vwn = (const float*)(p.ws + WS_VWN) + (size_t)g * S * 64;
    const float* gt = (const float*)(p.ws + WS_GT);
    const float* relb = p.in[17];
    const int h = g * 4 + r;
    __syncthreads();
    for (int i = tid; i < 512; i += NT) { const int hh = i >> 7, n = i & 127; lut[i] = relb[bucket_of(n) * 16 + g * 4 + hh]; }
    float q[64];
    {
        const float4* qp = (const float4*)(qn + (size_t)t * 512 + h * 64);
#pragma unroll
        for (int d = 0; d < 16; ++d) { const float4 v = qp[d]; q[4 * d] = v.x; q[4 * d + 1] = v.y; q[4 * d + 2] = v.z; q[4 * d + 3] = v.w; }
    }
    __syncthreads();
    const float* mylut = lut + r * 128;
    float* pr = pl + r * 1024;
    const int nv = (t >= 31) ? ((t - 31) >> 4) + 1 : 0;
    float mx = -1e30f;
#pragma unroll 1
    for (int c = lane; c < nv; c += 64) {
        int dist = t - (16 * c + 31); dist = dist > 127 ? 127 : dist;
        const float v = dot64(q, kc + ((size_t)c * 2 + g) * 64) + mylut[dist];
        pr[c] = v; mx = fmaxf(mx, v);
    }
    wave_softmax_lds(pr, nv, 1024, lane, mx);
    __syncthreads();
    float oc = 0.f;
#pragma unroll 4
    for (int c = 0; c < nv; ++c) oc += pr[c] * vc[((size_t)c * 2 + g) * 64 + lane];
    {
        const int n = tid;
        float imp = 0.f;
#pragma unroll
        for (int rr = 0; rr < 4; ++rr) {
            const float* prr = pl + rr * 1024;
            float v = prr[4 * n] + prr[4 * n + 1] + prr[4 * n + 2];
            if (4 * n + 3 < NCMP) v += 0.5f * prr[4 * n + 3];
            if (n > 0) v += 0.5f * prr[4 * n - 1];
            imp += v;
        }
        const int cur = t >> 6;
        const bool valid = n <= cur;
        const bool forced = valid && (n == 0 || n > cur - 2);
        sc[n] = forced ? __builtin_inff() : (valid ? imp : -__builtin_inff());
    }
    __syncthreads();
    {
        const int n = tid;
        const float my = sc[n];
        int rank = 0;
#pragma unroll 8
        for (int m = 0; m < 256; ++m) { const float o = sc[m]; rank += (o > my) || (o == my && m < n); }
        if (rank < 16) sel[rank] = n;
    }
    __syncthreads();
    mx = -1e30f;
#pragma unroll 1
    for (int j = 0; j < 16; ++j) {
        const int tok = sel[j] * 64 + lane;
        float v = -1e30f;
        if (tok <= t) {
            int dist = t - tok; dist = dist > 127 ? 127 : dist;
            v = dot64(q, ksl + (size_t)tok * 64) + mylut[dist];
        }
        pr[j * 64 + lane] = v; mx = fmaxf(mx, v);
    }
    wave_softmax_lds(pr, 1024, 1024, lane, mx);
    float os = 0.f;
#pragma unroll 1
    for (int j = 0; j < 16; ++j) {
        const int base = sel[j] * 64;
        if (base <= t) {
            const int lim = (t - base) < 63 ? (t - base) : 63;
#pragma unroll 4
            for (int k = 0; k <= lim; ++k) os += pr[j * 64 + k] * vsl[(size_t)(base + k) * 64 + lane];
        }
    }
    const int s0 = t - 511;
    mx = -1e30f;
#pragma unroll 1
    for (int k = lane; k < 512; k += 64) {
        const int s = s0 + k;
        float v = -1e30f;
        if (s >= 0) {
            int dist = t - s; dist = dist > 127 ? 127 : dist;
            v = dot64(q, kwn + (size_t)s * 64) + mylut[dist];
        }
        pr[k] = v; mx = fmaxf(mx, v);
    }
    wave_softmax_lds(pr, 512, 512, lane, mx);
    float ow = 0.f;
    {
        const int kb = s0 < 0 ? -s0 : 0;
#pragma unroll 4
        for (int k = kb; k < 512; ++k) ow += pr[k] * vwn[(size_t)(s0 + k) * 64 + lane];
    }
    const float g0 = gt[(size_t)t * 32 + h * 3 + 0], g1 = gt[(size_t)t * 32 + h * 3 + 1], g2 = gt[(size_t)t * 32 + h * 3 + 2];
    const float o = g0 * oc + g1 * os + g2 * ow;
    ((bf16_t*)(p.ws + WS_OA))[(size_t)t * 512 + h * 64 + lane] = (bf16_t)f2bf(o);
}

__device__ __forceinline__ void dsa_item(const Params& p, int t, unsigned char* smem) {
    const int tid = threadIdx.x, lane = tid & 63, wave = tid >> 6;
    unsigned* keys = (unsigned*)smem;
    float* pbuf = (float*)smem;
    unsigned* hist = keys + 16384;
    int* sel = (int*)(hist + 256);
    float* qi = (float*)(sel + 256);
    float* lut = qi + 256;
    float* wi = lut + 1024;
    int* misc = (int*)(wi + 8);
    const float* iqs = (const float*)(p.ws + WS_IQS);
    const float* iks = (const float*)(p.ws + WS_IKS);
    const float* iws = (const float*)(p.ws + WS_IWS);
    const float* dqn = (const float*)(p.ws + WS_DQN);
    const float* dkn = (const float*)(p.ws + WS_DKN);
    const float* dvn = (const float*)(p.ws + WS_DVN);
    const float* relb = p.in[17];
    __syncthreads();
    qi[tid] = iqs[(size_t)t * 256 + tid];
    if (tid < 8) wi[tid] = iws[(size_t)t * 8 + tid];
    for (int i = tid; i < 1024; i += NT) { const int hh = i >> 7, n = i & 127; lut[i] = relb[bucket_of(n) * 16 + 8 + hh]; }
    if (tid == 0) misc[0] = 0;
    __syncthreads();
    const int n = t + 1;
    int nsel;
    if (n <= 256) {
        if (tid < n) sel[tid] = tid;
        nsel = n;
    } else {
#pragma unroll 1
        for (int s = tid; s < n; s += NT) {
            asm volatile("" ::: "memory");
            const float4* kp = (const float4*)(iks + (size_t)s * 32);
            float kk[32];
#pragma unroll
            for (int d = 0; d < 8; ++d) { const float4 v = kp[d]; kk[4 * d] = v.x; kk[4 * d + 1] = v.y; kk[4 * d + 2] = v.z; kk[4 * d + 3] = v.w; }
            float score = 0.f;
#pragma unroll
            for (int hh = 0; hh < 8; ++hh) {
                float dsum = 0.f;
#pragma unroll
                for (int d = 0; d < 32; ++d) dsum += qi[hh * 32 + d] * kk[d];
                score += wi[hh] * fmaxf(dsum, 0.f);
            }
            score += 0.0f;
            const unsigned u = __builtin_bit_cast(unsigned, score);
            keys[s] = (u & 0x80000000u) ? ~u : (u | 0x80000000u);
        }
        unsigned prefix = 0, mask = 0;
        int need = 256;
#pragma unroll 1
        for (int pass = 3; pass >= 0; --pass) {
            hist[tid] = 0;
            __syncthreads();
#pragma unroll 1
            for (int s = tid; s < n; s += NT) { const unsigned k = keys[s]; if ((k & mask) == prefix) atomicAdd(&hist[(k >> (8 * pass)) & 255u], 1u); }
            __syncthreads();
            {
                unsigned above = 0;
                for (int b = tid + 1; b < 256; ++b) above += hist[b];
                const unsigned mine = hist[tid];
                if ((int)above < need && (int)(above + mine) >= need) { misc[1] = tid; misc[2] = need - (int)above; misc[3] = (int)mine; }
            }
            __syncthreads();
            prefix |= (unsigned)misc[1] << (8 * pass);
            mask |= 0xFFu << (8 * pass);
            need = misc[2];
            __syncthreads();
        }
        const unsigned T = prefix;
        const int ties = misc[3];
        if (ties == need) {
#pragma unroll 1
            for (int s = tid; s < n; s += NT) { const unsigned k = keys[s]; if (k >= T) { const int pos = atomicAdd(&misc[0], 1); sel[pos] = s; } }
        } else {
#pragma unroll 1
            for (int s = tid; s < n; s += NT) { const unsigned k = keys[s]; if (k > T) { const int pos = atomicAdd(&misc[0], 1); sel[pos] = s; } }
            __syncthreads();
            if (tid == 0) {
                int pos = misc[0], got = 0;
                for (int s = 0; s < n && got < need; ++s) if (keys[s] == T) { sel[pos++] = s; ++got; }
            }
        }
        nsel = 256;
    }
    __syncthreads();
#pragma unroll 1
    for (int hh = wave * 2; hh < wave * 2 + 2; ++hh) {
        float q[64];
        {
            const float4* qp = (const float4*)(dqn + (size_t)t * 512 + hh * 64);
#pragma unroll
            for (int d = 0; d < 16; ++d) { const float4 v = qp[d]; q[4 * d] = v.x; q[4 * d + 1] = v.y; q[4 * d + 2] = v.z; q[4 * d + 3] = v.w; }
        }
        float* pr = pbuf + hh * 256;
        float mx = -1e30f;
#pragma unroll 1
        for (int k = lane; k < nsel; k += 64) {
            const int s = sel[k];
            int dist = t - s; dist = dist > 127 ? 127 : dist;
            const float v = dot64(q, dkn + (size_t)s * 512 + hh * 64) + lut[hh * 128 + dist];
            pr[k] = v; mx = fmaxf(mx, v);
        }
        wave_softmax_lds(pr, nsel, nsel, lane, mx);
        float o = 0.f;
#pragma unroll 4
        for (int k = 0; k < nsel; ++k) o += pr[k] * dvn[(size_t)sel[k] * 512 + hh * 64 + lane];
        ((bf16_t*)(p.ws + WS_OB))[(size_t)t * 512 + hh * 64 + lane] = (bf16_t)f2bf(o);
    }
}

__device__ __forceinline__ void phase_attn(const Params& p, int bid, int nb, unsigned char* smem) {
    for (int w = bid; w < S + 2 * S; w += nb) {
        if (w < S) dsa_item(p, S - 1 - w, smem);
        else { const int i = w - S; nsa_item(p, i >> 1, i & 1, smem); }
    }
}

__device__ __forceinline__ void phase_merge(const Params& p, int bid, int nb, unsigned char* smem) {
    const float* z = (const float*)(p.ws + WS_Z);
    bf16_t* merged = (bf16_t*)(p.ws + WS_MERGED);
    float* tmp = (float*)(p.ws + WS_X1);
    const int lane = threadIdx.x & 63, wave = threadIdx.x >> 6;
    for (int w = bid; w < 128 * 8; w += nb) {
        const int mt = w % 128, nt = w / 128;
        const int m0 = mt * 128, n0 = nt * 128;
#pragma unroll 1
        for (int pass = 0; pass < 2; ++pass) {
            f32x4 acc[2][8];
            const bf16_t* A = (const bf16_t*)(p.ws + (pass ? WS_OB : WS_OA));
            const float* Bw = pass ? p.in[15] : p.in[14];
            const int zoff = pass ? Z_GB : Z_GA;
            gemm_tile<false, false>(A, 512, nullptr, m0, 128, Bw, D, n0, 0, 128, 512, smem, acc);
#pragma unroll
            for (int i = 0; i < 2; ++i)
#pragma unroll
                for (int r = 0; r < 4; ++r) {
                    const int row = m0 + wave * 32 + i * 16 + 4 * (lane >> 4) + r;
                    const float* zr = z + (size_t)row * DIN + zoff + n0 + (lane & 15);
                    float* tr = tmp + (size_t)row * D + n0 + (lane & 15);
                    bf16_t* mr = merged + (size_t)row * D + n0 + (lane & 15);
#pragma unroll
                    for (int j = 0; j < 8; ++j) {
                        const float v = sigmoidf_(zr[j * 16]) * acc[i][j][r];
                        if (pass == 0) tr[j * 16] = v;
                        else mr[j * 16] = (bf16_t)f2bf(tr[j * 16] + v);
                    }
                    asm volatile("" ::: "memory");
                }
        }
    }
}

__device__ __forceinline__ void phase_outproj(const Params& p, int bid, int nb, unsigned char* smem) {
    const bf16_t* merged = (const bf16_t*)(p.ws + WS_MERGED);
    const float* x = p.in[0];
    float* x1 = (float*)(p.ws + WS_X1);
    const int lane = threadIdx.x & 63, wave = threadIdx.x >> 6;
    for (int w = bid; w < 128 * 8; w += nb) {
        const int mt = w % 128, nt = w / 128;
        const int m0 = mt * 128, n0 = nt * 128;
        f32x4 acc[2][8];
        gemm_tile<false, false>(merged, D, nullptr, m0, 128, p.in[16], D, n0, 0, 128, D, smem, acc);
#pragma unroll
        for (int i = 0; i < 2; ++i)
#pragma unroll
            for (int j = 0; j < 8; ++j)
#pragma unroll
                for (int r = 0; r < 4; ++r) {
                    const int row = m0 + wave * 32 + i * 16 + 4 * (lane >> 4) + r, col = n0 + j * 16 + (lane & 15);
                    x1[(size_t)row * D + col] = x[(size_t)row * D + col] + acc[i][j][r];
                }
    }
}

__device__ __forceinline__ void phase_route(const Params& p, int bid, int nb) {
    const int lane = threadIdx.x & 63, wave = threadIdx.x >> 6;
    const float* x1 = (const float*)(p.ws + WS_X1);
    const float* g = p.in[18];
    const float* wr = p.in[19];
    const float* br = p.in[20];
    bf16_t* hb = (bf16_t*)(p.ws + WS_HB);
    int* topi = (int*)(p.ws + WS_TOPI);
    float* topw = (float*)(p.ws + WS_TOPW);
    int* cnt = (int*)(p.ws + WS_CTL);
    for (int t = bid * 4 + wave; t < S; t += nb * 4) {
        const float4* xr = (const float4*)(x1 + (size_t)t * D);
        float4 v[4];
        float ss = 0.f;
#pragma unroll
        for (int j = 0; j < 4; ++j) { v[j] = xr[lane + 64 * j]; ss += v[j].x * v[j].x + v[j].y * v[j].y + v[j].z * v[j].z + v[j].w * v[j].w; }
        ss = wave_sum(ss);
        const float rstd = rsqrtf(ss * (1.f / D) + EPS);
        float lg[32];
#pragma unroll
        for (int e = 0; e < 32; ++e) lg[e] = 0.f;
#pragma unroll
        for (int j = 0; j < 4; ++j) {
            const float4 gg = ((const float4*)g)[lane + 64 * j];
            const float h0 = v[j].x * rstd * gg.x, h1 = v[j].y * rstd * gg.y, h2 = v[j].z * rstd * gg.z, h3 = v[j].w * rstd * gg.w;
            uint2 o; o.x = pk2(h0, h1); o.y = pk2(h2, h3);
            ((uint2*)(hb + (size_t)t * D))[lane + 64 * j] = o;
            const int k = 4 * (lane + 64 * j);
            const float4* w0 = (const float4*)(wr + (size_t)k * 32);
#pragma unroll
            for (int e4 = 0; e4 < 8; ++e4) {
                const float4 a = w0[e4], b = w0[8 + e4], c = w0[16 + e4], d = w0[24 + e4];
                lg[4 * e4 + 0] += h0 * a.x + h1 * b.x + h2 * c.x + h3 * d.x;
                lg[4 * e4 + 1] += h0 * a.y + h1 * b.y + h2 * c.y + h3 * d.y;
                lg[4 * e4 + 2] += h0 * a.z + h1 * b.z + h2 * c.z + h3 * d.z;
                lg[4 * e4 + 3] += h0 * a.w + h1 * b.w + h2 * c.w + h3 * d.w;
            }
        }
#pragma unroll
        for (int e = 0; e < 32; ++e) lg[e] = wave_sum(lg[e]) + br[e];
        int idx[4]; float val[4];
        unsigned used = 0;
#pragma unroll
        for (int k = 0; k < 4; ++k) {
            float best = -__builtin_inff(); int bi = 0;
#pragma unroll
            for (int e = 0; e < 32; ++e) { const bool ok = !((used >> e) & 1u) && (lg[e] > best); best = ok ? lg[e] : best; bi = ok ? e : bi; }
            idx[k] = bi; val[k] = best; used |= 1u << bi;
        }
        const float e0 = 1.f, e1 = __expf(val[1] - val[0]), e2 = __expf(val[2] - val[0]), e3 = __expf(val[3] - val[0]);
        const float inv = 1.f / (e0 + e1 + e2 + e3);
        if (lane == 0) {
            topi[t * 4 + 0] = idx[0]; topi[t * 4 + 1] = idx[1]; topi[t * 4 + 2] = idx[2]; topi[t * 4 + 3] = idx[3];
            topw[t * 4 + 0] = e0 * inv; topw[t * 4 + 1] = e1 * inv; topw[t * 4 + 2] = e2 * inv; topw[t * 4 + 3] = e3 * inv;
            atomicAdd(&cnt[idx[0]], 1); atomicAdd(&cnt[idx[1]], 1); atomicAdd(&cnt[idx[2]], 1); atomicAdd(&cnt[idx[3]], 1);
        }
    }
}

__device__ __forceinline__ void phase_place(const Params& p, int bid, int nb, unsigned char* smem) {
    int* off = (int*)smem;
    const int* cnt = (const int*)(p.ws + WS_CTL);
    int* cur = (int*)(p.ws + WS_CTL) + 32;
    const int* topi = (const int*)(p.ws + WS_TOPI);
    int* ppos = (int*)(p.ws + WS_PPOS);
    int* rowtok = (int*)(p.ws + WS_ROWTOK);
    __syncthreads();
    if (threadIdx.x == 0) { int a = 0; for (int e = 0; e < NEXP; ++e) { off[e] = a; a += cnt[e]; } }
    __syncthreads();
    for (int i = bid * NT + threadIdx.x; i < S * 4; i += nb * NT) {
        const int e = topi[i];
        const int pos = off[e] + atomicAdd(&cur[e], 1);
        ppos[i] = pos;
        rowtok[pos] = i >> 2;
    }
}

__device__ __forceinline__ void moe_tile_map(const int* cnt, int* sm, int& total_mt) {
    __syncthreads();
    if (threadIdx.x == 0) {
        int a = 0, b = 0;
        for (int e = 0; e < NEXP; ++e) { sm[e] = a; sm[33 + e] = b; a += (cnt[e] + 127) >> 7; b += cnt[e]; }
        sm[32] = a; sm[65] = b;
    }
    __syncthreads();
    total_mt = sm[32];
}
__device__ __forceinline__ void phase_moe1(const Params& p, int bid, int nb, unsigned char* smem) {
    int* sm = (int*)(smem + 32768);
    const int* cnt = (const int*)(p.ws + WS_CTL);
    const int* rowtok = (const int*)(p.ws + WS_ROWTOK);
    const bf16_t* hb = (const bf16_t*)(p.ws + WS_HB);
    bf16_t* act = (bf16_t*)(p.ws + WS_ACT);
    const int lane = threadIdx.x & 63, wave = threadIdx.x >> 6;
    int total_mt;
    moe_tile_map(cnt, sm, total_mt);
    for (int w = bid; w < total_mt * 16; w += nb) {
        const int tm = w >> 4, nt = w & 15;
        int e = 0;
        while (e < NEXP - 1 && sm[e + 1] <= tm) ++e;
        const int mt = tm - sm[e];
        const int rbase = sm[33 + e] + mt * 128;
        const int mrows = min(128, cnt[e] - mt * 128);
        const int n0 = nt * 64;
        f32x4 acc[2][8];
        gemm_tile<false, true>(hb, D, rowtok, rbase, mrows, p.in[21] + (size_t)e * D * 2 * DFF, 2 * DFF, n0, DFF - 64, 128, D, smem, acc);
        const float* b1 = p.in[22] + (size_t)e * 2 * DFF;
#pragma unroll
        for (int i = 0; i < 2; ++i)
#pragma unroll
            for (int j = 0; j < 4; ++j) {
                const int col = n0 + j * 16 + (lane & 15);
                const float bg = b1[col], bl = b1[DFF + col];
#pragma unroll
                for (int r = 0; r < 4; ++r) {
                    const int rl = wave * 32 + i * 16 + 4 * (lane >> 4) + r;
                    if (rl < mrows) {
                        const float gate = fminf(acc[i][j][r] + bg, 7.f);
                        const float lin = fminf(fmaxf(acc[i][j + 4][r] + bl, -7.f), 7.f);
                        const float a = (lin + 1.f) * gate * sigmoidf_(1.702f * gate);
                        act[(size_t)(rbase + rl) * DFF + col] = (bf16_t)f2bf(a);
                    }
                }
            }
    }
}
__device__ __forceinline__ void phase_moe2(const Params& p, int bid, int nb, unsigned char* smem) {
    int* sm = (int*)(smem + 32768);
    const int* cnt = (const int*)(p.ws + WS_CTL);
    const bf16_t* act = (const bf16_t*)(p.ws + WS_ACT);
    float* yrows = (float*)(p.ws + WS_YROWS);
    const int lane = threadIdx.x & 63, wave = threadIdx.x >> 6;
    int total_mt;
    moe_tile_map(cnt, sm, total_mt);
    for (int w = bid; w < total_mt * 8; w += nb) {
        const int tm = w >> 3, nt = w & 7;
        int e = 0;
        while (e < NEXP - 1 && sm[e + 1] <= tm) ++e;
        const int mt = tm - sm[e];
        const int rbase = sm[33 + e] + mt * 128;
        const int mrows = min(128, cnt[e] - mt * 128);
        const int n0 = nt * 128;
        f32x4 acc[2][8];
        gemm_tile<false, false>(act, DFF, nullptr, rbase, mrows, p.in[23] + (size_t)e * DFF * D, D, n0, 0, 128, DFF, smem, acc);
        const float* b2 = p.in[24] + (size_t)e * D;
#pragma unroll
        for (int i = 0; i < 2; ++i)
#pragma unroll
            for (int j = 0; j < 8; ++j) {
                const int col = n0 + j * 16 + (lane & 15);
                const float bb = b2[col];
#pragma unroll
                for (int r = 0; r < 4; ++r) {
                    const int rl = wave * 32 + i * 16 + 4 * (lane >> 4) + r;
                    if (rl < mrows) yrows[(size_t)(rbase + rl) * D + col] = acc[i][j][r] + bb;
                }
            }
    }
}

__device__ __forceinline__ void phase_combine(const Params& p, int bid, int nb) {
    const int lane = threadIdx.x & 63, wave = threadIdx.x >> 6;
    const float* x1 = (const float*)(p.ws + WS_X1);
    const float* yrows = (const float*)(p.ws + WS_YROWS);
    const int* ppos = (const int*)(p.ws + WS_PPOS);
    const float* topw = (const float*)(p.ws + WS_TOPW);
    const float* g = p.in[25];
    bf16_t* hb = (bf16_t*)(p.ws + WS_HB);
    bf16_t* pb = (bf16_t*)(p.ws + WS_PB);
    for (int t = bid * 4 + wave; t < S; t += nb * 4) {
        {
            const float4 pv = ((const float4*)(p.in[1] + (size_t)t * 256))[lane];
            uint2 o; o.x = pk2(pv.x, pv.y); o.y = pk2(pv.z, pv.w);
            ((uint2*)(pb + (size_t)t * 256))[lane] = o;
        }
        float4 v[4];
#pragma unroll
        for (int j = 0; j < 4; ++j) v[j] = ((const float4*)(x1 + (size_t)t * D))[lane + 64 * j];
#pragma unroll
        for (int k = 0; k < 4; ++k) {
            const float wk = topw[t * 4 + k];
            const float4* yr = (const float4*)(yrows + (size_t)ppos[t * 4 + k] * D);
#pragma unroll
            for (int j = 0; j < 4; ++j) { const float4 y = yr[lane + 64 * j]; v[j].x += wk * y.x; v[j].y += wk * y.y; v[j].z += wk * y.z; v[j].w += wk * y.w; }
        }
        float ss = 0.f;
#pragma unroll
        for (int j = 0; j < 4; ++j) ss += v[j].x * v[j].x + v[j].y * v[j].y + v[j].z * v[j].z + v[j].w * v[j].w;
        ss = wave_sum(ss);
        const float rstd = rsqrtf(ss * (1.f / D) + EPS);
#pragma unroll
        for (int j = 0; j < 4; ++j) {
            ((float4*)(p.out + (size_t)t * D))[lane + 64 * j] = v[j];
            const float4 gg = ((const float4*)g)[lane + 64 * j];
            uint2 o;
            o.x = pk2(v[j].x * rstd * gg.x, v[j].y * rstd * gg.y);
            o.y = pk2(v[j].z * rstd * gg.z, v[j].w * rstd * gg.w);
            ((uint2*)(hb + (size_t)t * D))[lane + 64 * j] = o;
        }
    }
}

__device__ __forceinline__ void phase_ple(const Params& p, int bid, int nb, unsigned char* smem) {
    float* tmp = (float*)(p.ws + WS_X1);
    const int lane = threadIdx.x & 63, wave = threadIdx.x >> 6;
    for (int w = bid; w < 128 * 8; w += nb) {
        const int mt = w % 128, nt = w / 128;
        const int m0 = mt * 128, n0 = nt * 128;
#pragma unroll 1
        for (int pass = 0; pass < 2; ++pass) {
            f32x4 acc[2][8];
            const bf16_t* A = (const bf16_t*)(p.ws + (pass ? WS_PB : WS_HB));
            const float* Bw = pass ? p.in[26] : p.in[27];
            const int K = pass ? 256 : D;
            gemm_tile<false, false>(A, K, nullptr, m0, 128, Bw, D, n0, 0, 128, K, smem, acc);
#pragma unroll
            for (int i = 0; i < 2; ++i)
#pragma unroll
                for (int r = 0; r < 4; ++r) {
                    const int row = m0 + wave * 32 + i * 16 + 4 * (lane >> 4) + r;
                    float* tr = tmp + (size_t)row * D + n0 + (lane & 15);
                    float* orow = p.out + (size_t)row * D + n0 + (lane & 15);
#pragma unroll
                    for (int j = 0; j < 8; ++j) {
                        if (pass == 0) tr[j * 16] = sigmoidf_(acc[i][j][r]);
                        else orow[j * 16] = orow[j * 16] + tr[j * 16] * acc[i][j][r];
                    }
                    asm volatile("" ::: "memory");
                }
        }
    }
}

template <int PH>
__device__ __forceinline__ void run_phase(const Params& p, int bid, int nb, unsigned char* smem) {
    if (PH == 0) phase_prep(p, bid, nb);
    if (PH == 1) phase_inproj(p, bid, nb, smem);
    if (PH == 2) phase_post(p, bid, nb);
    if (PH == 3) phase_compress(p, bid, nb);
    if (PH == 4) phase_attn(p, bid, nb, smem);
    if (PH == 5) phase_merge(p, bid, nb, smem);
    if (PH == 6) phase_outproj(p, bid, nb, smem);
    if (PH == 7) phase_route(p, bid, nb);
    if (PH == 8) phase_place(p, bid, nb, smem);
    if (PH == 9) phase_moe1(p, bid, nb, smem);
    if (PH == 10) phase_moe2(p, bid, nb, smem);
    if (PH == 11) phase_combine(p, bid, nb);
    if (PH == 12) phase_ple(p, bid, nb, smem);
}

#if SINGLE_LAUNCH
__global__ void __launch_bounds__(NT, 2) fwd_mega(Params p) {
    __shared__ __attribute__((aligned(16))) unsigned char smem[SMEM_BYTES];
    cg::grid_group grid = cg::this_grid();
    const int bid = blockIdx.x, nb = gridDim.x;
    run_phase<0>(p, bid, nb, smem); grid.sync();
    run_phase<1>(p, bid, nb, smem); grid.sync();
    run_phase<2>(p, bid, nb, smem); grid.sync();
    run_phase<3>(p, bid, nb, smem); grid.sync();
    run_phase<4>(p, bid, nb, smem); grid.sync();
    run_phase<5>(p, bid, nb, smem); grid.sync();
    run_phase<6>(p, bid, nb, smem); grid.sync();
    run_phase<7>(p, bid, nb, smem); grid.sync();
    run_phase<8>(p, bid, nb, smem); grid.sync();
    run_phase<9>(p, bid, nb, smem); grid.sync();
    run_phase<10>(p, bid, nb, smem); grid.sync();
    run_phase<11>(p, bid, nb, smem); grid.sync();
    run_phase<12>(p, bid, nb, smem);
}
#else
template <int PH>
__global__ void __launch_bounds__(NT, 2) k_phase(Params p) {
    __shared__ __attribute__((aligned(16))) unsigned char smem[SMEM_BYTES];
    run_phase<PH>(p, blockIdx.x, gridDim.x, smem);
}
#endif

extern "C" void kernel_launch(void* const* d_in, const int* in_sizes, int n_in, void* d_out, int out_size, void* d_ws, size_t ws_size,
                              hipStream_t stream) {
    if (n_in != 28 || ws_size < WS_END) { fprintf(stderr, "kernel_launch: unexpected n_in %d or ws_size %zu (< %zu)\n", n_in, ws_size, (size_t)WS_END); return; }
    Params p{};
    for (int i = 0; i < 28; ++i) p.in[i] = (const float*)d_in[i];
    p.out = (float*)d_out;
    p.ws = (unsigned char*)d_ws;
#if SINGLE_LAUNCH
    static int grid_blocks = 0;
    if (!grid_blocks) {
        int dev = 0, cus = 0, per_cu = 0;
        hipGetDevice(&dev);
        hipDeviceGetAttribute(&cus, hipDeviceAttributeMultiprocessorCount, dev);
        hipOccupancyMaxActiveBlocksPerMultiprocessor(&per_cu, fwd_mega, NT, 0);
        if (per_cu > 2) per_cu = 2;
        if (per_cu < 1) per_cu = 1;
        grid_blocks = cus * per_cu;
    }
    void* args[] = {&p};
    hipError_t e = hipLaunchCooperativeKernel((void*)fwd_mega, dim3(grid_blocks), dim3(NT), args, 0, stream);
    if (e != hipSuccess) fprintf(stderr, "cooperative launch failed: %s (grid %d)\n", hipGetErrorString(e), grid_blocks);
#else
    const int G = 512;
    k_phase<0><<<G, NT, 0, stream>>>(p);
    k_phase<1><<<G, NT, 0, stream>>>(p);
    k_phase<2><<<G, NT, 0, stream>>>(p);
    k_phase<3><<<G, NT, 0, stream>>>(p);
    k_phase<4><<<G, NT, 0, stream>>>(p);
    k_phase<5><<<G, NT, 0, stream>>>(p);
    k_phase<6><<<G, NT, 0, stream>>>(p);
    k_phase<7><<<G, NT, 0, stream>>>(p);
    k_phase<8><<<G, NT, 0, stream>>>(p);
    k_phase<9><<<G, NT, 0, stream>>>(p);
    k_phase<10><<<G, NT, 0, stream>>>(p);
    k_phase<11><<<G, NT, 0, stream>>>(p);
    k_phase<12><<<G, NT, 0, stream>>>(p);
#endif
}
```

```cpp
#include <hip/hip_runtime.h>
#include <hip/hip_cooperative_groups.h>
#include <cstdio>
#include <cstdint>
namespace cg = cooperative_groups;

#ifndef SINGLE_LAUNCH
#define SINGLE_LAUNCH 1
#endif

constexpr int S = 16384;
constexpr int D = 1024;
constexpr int DIN = 5184;
constexpr int NCMP = 1023;
constexpr int NSLC = 256;
constexpr int NEXP = 32;
constexpr int DFF = 1024;
constexpr float EPS = 1e-6f;
constexpr int Z_NQ = 0, Z_NKV = 512, Z_NGATE = 1280, Z_DQ = 1304, Z_DK = 1816, Z_DV = 2328, Z_IQ = 2840, Z_IK = 3096,
              Z_IW = 3128, Z_GA = 3136, Z_GB = 4160;

constexpr int NT = 256;
constexpr int SMEM_BYTES = 73728;

typedef unsigned short bf16_t;
typedef short bf16x8 __attribute__((ext_vector_type(8)));
typedef float f32x4 __attribute__((ext_vector_type(4)));
typedef short s16x4 __attribute__((ext_vector_type(4)));
typedef __attribute__((address_space(3))) s16x4* lds_s16x4_ptr;
__device__ __forceinline__ s16x4 lds_tr16(const void* p) {
    return __builtin_amdgcn_ds_read_tr16_b64_v4i16((lds_s16x4_ptr)(uintptr_t)p);
}

constexpr size_t MBy = 1ull << 20;
constexpr size_t WS_CTL = 0;
constexpr size_t WS_HB = 1 * MBy;
constexpr size_t WS_OA = WS_HB + (size_t)S * D * 2;
constexpr size_t WS_OB = WS_OA + (size_t)S * 512 * 2;
constexpr size_t WS_MERGED = WS_OB + (size_t)S * 512 * 2;
constexpr size_t WS_X1 = WS_MERGED + (size_t)S * D * 2;
constexpr size_t WS_TOPI = WS_X1 + (size_t)S * D * 4;
constexpr size_t WS_TOPW = WS_TOPI + (size_t)S * 4 * 4;
constexpr size_t WS_PPOS = WS_TOPW + (size_t)S * 4 * 4;
constexpr size_t WS_ROWTOK = WS_PPOS + (size_t)S * 4 * 4;
constexpr size_t WS_KC = WS_ROWTOK + (size_t)65536 * 4;
constexpr size_t WS_VC = WS_KC + (size_t)1024 * 128 * 4;
constexpr size_t WS_PB = WS_VC + (size_t)1024 * 128 * 4;
constexpr size_t WS_REG = WS_PB + (size_t)S * 256 * 2;
constexpr size_t WS_Z = WS_REG;
constexpr size_t WS_QN = WS_Z + (size_t)S * DIN * 4;
constexpr size_t WS_KSL = WS_QN + (size_t)S * 512 * 4;
constexpr size_t WS_VSL = WS_KSL + (size_t)S * 128 * 4;
constexpr size_t WS_KWN = WS_VSL + (size_t)S * 128 * 4;
constexpr size_t WS_VWN = WS_KWN + (size_t)S * 128 * 4;
constexpr size_t WS_GT = WS_VWN + (size_t)S * 128 * 4;
constexpr size_t WS_DQN = WS_GT + (size_t)S * 32 * 4;
constexpr size_t WS_DKN = WS_DQN + (size_t)S * 512 * 4;
constexpr size_t WS_DVN = WS_DKN + (size_t)S * 512 * 4;
constexpr size_t WS_IQS = WS_DVN + (size_t)S * 512 * 4;
constexpr size_t WS_IKS = WS_IQS + (size_t)S * 256 * 4;
constexpr size_t WS_IWS = WS_IKS + (size_t)S * 32 * 4;
constexpr size_t WS_ENDA = WS_IWS + (size_t)S * 8 * 4;
constexpr size_t WS_ACT = WS_REG;
constexpr size_t WS_YROWS = WS_ACT + (size_t)(65536 + 128) * DFF * 2;
constexpr size_t WS_ENDB = WS_YROWS + (size_t)(65536 + 128) * D * 4;
constexpr size_t WS_END0 = WS_ENDA > WS_ENDB ? WS_ENDA : WS_ENDB;
constexpr size_t WB_IN = WS_END0;
constexpr size_t WB_A = WB_IN + (size_t)D * DIN * 2;
constexpr size_t WB_B = WB_A + (size_t)512 * D * 2;
constexpr size_t WB_OUT = WB_B + (size_t)512 * D * 2;
constexpr size_t WB_E1 = WB_OUT + (size_t)D * D * 2;
constexpr size_t WB_E2 = WB_E1 + (size_t)NEXP * D * 2 * DFF * 2;
constexpr size_t WB_PLE = WB_E2 + (size_t)NEXP * DFF * D * 2;
constexpr size_t WB_PLEG = WB_PLE + (size_t)256 * D * 2;
constexpr size_t WS_END = WB_PLEG + (size_t)D * D * 2;

struct Params {
    const float* in[28];
    float* out;
    unsigned char* ws;
};

__device__ __forceinline__ unsigned f2bf(float f) {
    unsigned u = __builtin_bit_cast(unsigned, f);
    return (u + 0x7fffu + ((u >> 16) & 1u)) >> 16;
}
__device__ __forceinline__ unsigned pk2(float lo, float hi) { return f2bf(lo) | (f2bf(hi) << 16); }
__device__ __forceinline__ float bf2f(unsigned short b) { return __builtin_bit_cast(float, (unsigned)b << 16); }
__device__ __forceinline__ float wave_sum(float v) {
#pragma unroll
    for (int o = 1; o < 64; o <<= 1) v += __shfl_xor(v, o);
    return v;
}
__device__ __forceinline__ float wave_max(float v) {
#pragma unroll
    for (int o = 1; o < 64; o <<= 1) v = fmaxf(v, __shfl_xor(v, o));
    return v;
}
__device__ __forceinline__ float sigmoidf_(float x) { return 1.f / (1.f + __expf(-x)); }
__device__ __forceinline__ int bucket_of(int n) {
    if (n < 16) return n;
    int b = 16;
    b += (n >= 19) + (n >= 21) + (n >= 24) + (n >= 27) + (n >= 31) + (n >= 35) + (n >= 40) + (n >= 46) + (n >= 52) + (n >= 59) +
         (n >= 67) + (n >= 77) + (n >= 87) + (n >= 99) + (n >= 113);
    return b;
}

constexpr int LDS_STRIDE = 40;
constexpr int BTR_STRIDE = 136;
template <bool A_F32, bool GATHER, bool SPLIT = false, bool BTR = true>
__device__ __forceinline__ void gemm_tile(const void* __restrict__ Aptr, int lda, const int* __restrict__ rowidx, int m0, int mrows,
                                          const float* __restrict__ B, int ldb, int n0, int split_off, int ncols, int K,
                                          unsigned char* smem, f32x4 (&acc)[2][8]) {
    bf16_t* As = (bf16_t*)smem;
    bf16_t* Bs = As + 128 * LDS_STRIDE;
    bf16_t* AsL = Bs + 128 * LDS_STRIDE;
    bf16_t* BsL = AsL + 128 * LDS_STRIDE;
    const int tid = threadIdx.x, lane = tid & 63, wave = tid >> 6;
#pragma unroll
    for (int i = 0; i < 2; ++i)
#pragma unroll
        for (int j = 0; j < 8; ++j) acc[i][j] = (f32x4){0.f, 0.f, 0.f, 0.f};
    auto lo = [](float v) { return v - bf2f((unsigned short)f2bf(v)); };

    const int ar = tid >> 2, ach = tid & 3;
    const unsigned char* arow[2];
    bool aval[2];
#pragma unroll
    for (int i = 0; i < 2; ++i) {
        int r = ar + 64 * i;
        aval[i] = r < mrows;
        long src = 0;
        if (aval[i]) src = GATHER ? (long)rowidx[m0 + r] : (long)(m0 + r);
        arow[i] = (const unsigned char*)Aptr + (size_t)src * lda * (A_F32 ? 4 : 2) + (size_t)ach * 8 * (A_F32 ? 4 : 2);
    }
    const int nq = tid & 31, kq = tid >> 5;
    const int jn = 4 * nq;
    const bool bval = jn < ncols;
    const float* bptr = B + (size_t)(4 * kq) * ldb + n0 + jn + (jn >= 64 ? split_off : 0);

    uint4 areg[2];
    float4 af0a, af0b, af1a, af1b;
    float4 breg[4];
    auto load_g = [&](int k0) {
#pragma unroll
        for (int i = 0; i < 2; ++i) {
            if (A_F32) {
                float4 t0 = make_float4(0, 0, 0, 0), t1 = t0;
                if (aval[i]) {
                    const float4* s = (const float4*)(arow[i] + (size_t)k0 * 4);
                    t0 = s[0]; t1 = s[1];
                }
                if (i == 0) { af0a = t0; af0b = t1; } else { af1a = t0; af1b = t1; }
            } else {
                if (aval[i]) areg[i] = *(const uint4*)(arow[i] + (size_t)k0 * 2);
                else areg[i] = make_uint4(0, 0, 0, 0);
            }
        }
#pragma unroll
        for (int kk = 0; kk < 4; ++kk) {
            if (bval) breg[kk] = *(const float4*)(bptr + (size_t)(k0 + kk) * ldb);
            else breg[kk] = make_float4(0, 0, 0, 0);
        }
    };
    auto store_l = [&]() {
#pragma unroll
        for (int i = 0; i < 2; ++i) {
            uint4 v;
            const float4 t0 = (i == 0) ? af0a : af1a, t1 = (i == 0) ? af0b : af1b;
            if (A_F32) {
                v.x = pk2(t0.x, t0.y); v.y = pk2(t0.z, t0.w);
                v.z = pk2(t1.x, t1.y); v.w = pk2(t1.z, t1.w);
            } else v = areg[i];
            *(uint4*)(As + (ar + 64 * i) * LDS_STRIDE + ach * 8) = v;
            if (SPLIT && A_F32) {
                v.x = pk2(lo(t0.x), lo(t0.y)); v.y = pk2(lo(t0.z), lo(t0.w));
                v.z = pk2(lo(t1.x), lo(t1.y)); v.w = pk2(lo(t1.z), lo(t1.w));
                *(uint4*)(AsL + (ar + 64 * i) * LDS_STRIDE + ach * 8) = v;
            }
        }
        if (SPLIT) {
            uint2 v;
            v.x = pk2(lo(breg[0].x), lo(breg[1].x)); v.y = pk2(lo(breg[2].x), lo(breg[3].x));
            *(uint2*)(BsL + (jn + 0) * LDS_STRIDE + 4 * kq) = v;
            v.x = pk2(lo(breg[0].y), lo(breg[1].y)); v.y = pk2(lo(breg[2].y), lo(breg[3].y));
            *(uint2*)(BsL + (jn + 1) * LDS_STRIDE + 4 * kq) = v;
            v.x = pk2(lo(breg[0].z), lo(breg[1].z)); v.y = pk2(lo(breg[2].z), lo(breg[3].z));
            *(uint2*)(BsL + (jn + 2) * LDS_STRIDE + 4 * kq) = v;
            v.x = pk2(lo(breg[0].w), lo(breg[1].w)); v.y = pk2(lo(breg[2].w), lo(breg[3].w));
            *(uint2*)(BsL + (jn + 3) * LDS_STRIDE + 4 * kq) = v;
        }
        if (BTR && !SPLIT) {
#pragma unroll
            for (int kk = 0; kk < 4; ++kk) {
                uint2 v; v.x = pk2(breg[kk].x, breg[kk].y); v.y = pk2(breg[kk].z, breg[kk].w);
                *(uint2*)(Bs + (4 * kq + kk) * BTR_STRIDE + jn) = v;
            }
        } else {
            uint2 v;
            v.x = pk2(breg[0].x, breg[1].x); v.y = pk2(breg[2].x, breg[3].x);
            *(uint2*)(Bs + (jn + 0) * LDS_STRIDE + 4 * kq) = v;
            v.x = pk2(breg[0].y, breg[1].y); v.y = pk2(breg[2].y, breg[3].y);
            *(uint2*)(Bs + (jn + 1) * LDS_STRIDE + 4 * kq) = v;
            v.x = pk2(breg[0].z, breg[1].z); v.y = pk2(breg[2].z, breg[3].z);
            *(uint2*)(Bs + (jn + 2) * LDS_STRIDE + 4 * kq) = v;
            v.x = pk2(breg[0].w, breg[1].w); v.y = pk2(breg[2].w, breg[3].w);
            *(uint2*)(Bs + (jn + 3) * LDS_STRIDE + 4 * kq) = v;
        }
    };
    const int nk = K / 32;
    __syncthreads();
    load_g(0);
    store_l();
    __syncthreads();
    const int fr = lane & 15, fq = lane >> 4;
    for (int kt = 0; kt < nk; ++kt) {
        if (kt + 1 < nk) load_g((kt + 1) * 32);
        bf16x8 a[2];
#pragma unroll
        for (int i = 0; i < 2; ++i) a[i] = *(const bf16x8*)(As + (wave * 32 + i * 16 + fr) * LDS_STRIDE + fq * 8);
        if (!SPLIT) {
            bf16x8 b[8];
#pragma unroll
            for (int j = 0; j < 8; ++j) {
                if (BTR && !SPLIT) {
                    const bf16_t* bp = Bs + (8 * fq + (fr >> 2)) * BTR_STRIDE + 16 * j + 4 * (fr & 3);
                    const s16x4 lo4 = lds_tr16(bp), hi4 = lds_tr16(bp + 4 * BTR_STRIDE);
                    b[j] = (bf16x8){lo4[0], lo4[1], lo4[2], lo4[3], hi4[0], hi4[1], hi4[2], hi4[3]};
                } else b[j] = *(const bf16x8*)(Bs + (j * 16 + fr) * LDS_STRIDE + fq * 8);
            }
#pragma unroll
            for (int i = 0; i < 2; ++i)
#pragma unroll
                for (int j = 0; j < 8; ++j) acc[i][j] = __builtin_amdgcn_mfma_f32_16x16x32_bf16(a[i], b[j], acc[i][j], 0, 0, 0);
        } else {
            bf16x8 al[2];
#pragma unroll
            for (int i = 0; i < 2; ++i) al[i] = *(const bf16x8*)(AsL + (wave * 32 + i * 16 + fr) * LDS_STRIDE + fq * 8);
#pragma unroll
            for (int j = 0; j < 8; ++j) {
                const bf16x8 bh = *(const bf16x8*)(Bs + (j * 16 + fr) * LDS_STRIDE + fq * 8);
                const bf16x8 bl = *(const bf16x8*)(BsL + (j * 16 + fr) * LDS_STRIDE + fq * 8);
#pragma unroll
                for (int i = 0; i < 2; ++i) {
                    acc[i][j] = __builtin_amdgcn_mfma_f32_16x16x32_bf16(a[i], bh, acc[i][j], 0, 0, 0);
                    acc[i][j] = __builtin_amdgcn_mfma_f32_16x16x32_bf16(a[i], bl, acc[i][j], 0, 0, 0);
                    acc[i][j] = __builtin_amdgcn_mfma_f32_16x16x32_bf16(al[i], bh, acc[i][j], 0, 0, 0);
                }
            }
        }
        __syncthreads();
        if (kt + 1 < nk) {
            store_l();
            __syncthreads();
        }
    }
}


constexpr int ASTR = 72;
constexpr int BSTR = 136;
template <bool GATHER, bool PAIR>
__device__ __forceinline__ void gemm2(const bf16_t* __restrict__ A, int lda, const int* __restrict__ rowidx, int m0, int mrows,
                                      const bf16_t* __restrict__ B, int ldb, int n0, int ncols, int K, unsigned char* smem,
                                      f32x4 (&acc)[4][4]) {
    bf16_t* As = (bf16_t*)smem;
    bf16_t* Bs = As + 128 * ASTR;
    const int tid = threadIdx.x, lane = tid & 63, wave = tid >> 6, wm = wave >> 1, wn = wave & 1;
#pragma unroll
    for (int i = 0; i < 4; ++i)
#pragma unroll
        for (int j = 0; j < 4; ++j) acc[i][j] = (f32x4){0.f, 0.f, 0.f, 0.f};
    const int arl = tid >> 1, ahalf = tid & 1;
    const int arc = arl < mrows ? arl : mrows - 1;
    const long asrc = GATHER ? (long)rowidx[m0 + arc] : (long)(m0 + arc);
    const bf16_t* ap = A + (size_t)asrc * lda + ahalf * 32;
    const int brow = tid >> 2, bq = tid & 3;
    const bf16_t* bp = B + (size_t)brow * ldb + n0 + (PAIR ? bq * 16 : bq * 32);
    const int boff1 = 8, boff2 = PAIR ? 1024 : 16, boff3 = PAIR ? 1032 : 24;
    bf16_t* asd = As + arl * ASTR + ahalf * 32;
    bf16_t* bsd = Bs + brow * BSTR + bq * 32;
    uint4 a0, a1, a2, a3, b0, b1, b2, b3;
#define G2_LOAD(k0)                                                                                       \
    do {                                                                                                  \
        const bf16_t* ap_ = ap + (k0);                                                                    \
        a0 = *(const uint4*)(ap_); a1 = *(const uint4*)(ap_ + 8);                                         \
        a2 = *(const uint4*)(ap_ + 16); a3 = *(const uint4*)(ap_ + 24);                                   \
        const bf16_t* bp_ = bp + (size_t)(k0) * ldb;                                                      \
        b0 = *(const uint4*)(bp_); b1 = *(const uint4*)(bp_ + boff1);                                     \
        b2 = *(const uint4*)(bp_ + boff2); b3 = *(const uint4*)(bp_ + boff3);                             \
    } while (0)
#define G2_STORE()                                                                                        \
    do {                                                                                                  \
        *(uint4*)(asd) = a0; *(uint4*)(asd + 8) = a1; *(uint4*)(asd + 16) = a2; *(uint4*)(asd + 24) = a3; \
        *(uint4*)(bsd) = b0; *(uint4*)(bsd + 8) = b1; *(uint4*)(bsd + 16) = b2; *(uint4*)(bsd + 24) = b3; \
    } while (0)
    const int nk = K / 64;
    __syncthreads();
    G2_LOAD(0);
    G2_STORE();
    __syncthreads();
    const int fr = lane & 15, fq = lane >> 4;
    const bf16_t* afp = As + (wm * 64 + fr) * ASTR + fq * 8;
    const bf16_t* bfp = Bs + (8 * fq + (fr >> 2)) * BSTR + wn * 64 + 4 * (fr & 3);
    for (int kt = 0; kt < nk; ++kt) {
        if (kt + 1 < nk) G2_LOAD((kt + 1) * 64);
#pragma unroll
        for (int kh = 0; kh < 2; ++kh) {
            bf16x8 a[4], b[4];
#pragma unroll
            for (int i = 0; i < 4; ++i) a[i] = *(const bf16x8*)(afp + i * 16 * ASTR + kh * 32);
#pragma unroll
            for (int j = 0; j < 4; ++j) {
                const bf16_t* q = bfp + kh * 32 * BSTR + j * 16;
                const s16x4 lo4 = lds_tr16(q), hi4 = lds_tr16(q + 4 * BSTR);
                b[j] = (bf16x8){lo4[0], lo4[1], lo4[2], lo4[3], hi4[0], hi4[1], hi4[2], hi4[3]};
            }
#pragma unroll
            for (int i = 0; i < 4; ++i)
#pragma unroll
                for (int j = 0; j < 4; ++j) acc[i][j] = __builtin_amdgcn_mfma_f32_16x16x32_bf16(a[i], b[j], acc[i][j], 0, 0, 0);
        }
        __syncthreads();
        if (kt + 1 < nk) {
            G2_STORE();
            __syncthreads();
        }
    }
#undef G2_LOAD
#undef G2_STORE
}
#define G2_ROW(i, r) ((threadIdx.x >> 7) * 64 + (i) * 16 + 4 * ((threadIdx.x & 63) >> 4) + (r))
#define G2_COL(j) (((((threadIdx.x >> 6) & 1) * 4 + (j)) * 16) + (threadIdx.x & 15))

__device__ __forceinline__ void cvt_weights(const float* __restrict__ src, bf16_t* __restrict__ dst, size_t n, int bid, int nb) {
    const size_t n8 = n >> 3;
    for (size_t i = (size_t)bid * NT + threadIdx.x; i < n8; i += (size_t)nb * NT) {
        const float4 u = ((const float4*)src)[2 * i], v = ((const float4*)src)[2 * i + 1];
        uint4 o; o.x = pk2(u.x, u.y); o.y = pk2(u.z, u.w); o.z = pk2(v.x, v.y); o.w = pk2(v.z, v.w);
        ((uint4*)dst)[i] = o;
    }
}
__device__ __forceinline__ void phase_prep(const Params& p, int bid, int nb) {
    const int lane = threadIdx.x & 63, wave = threadIdx.x >> 6;
    if (bid == 0 && threadIdx.x < 64) ((int*)(p.ws + WS_CTL))[threadIdx.x] = 0;
    cvt_weights(p.in[2], (bf16_t*)(p.ws + WB_IN), (size_t)D * DIN, bid, nb);
    cvt_weights(p.in[14], (bf16_t*)(p.ws + WB_A), (size_t)512 * D, bid, nb);
    cvt_weights(p.in[15], (bf16_t*)(p.ws + WB_B), (size_t)512 * D, bid, nb);
    cvt_weights(p.in[16], (bf16_t*)(p.ws + WB_OUT), (size_t)D * D, bid, nb);
    cvt_weights(p.in[21], (bf16_t*)(p.ws + WB_E1), (size_t)NEXP * D * 2 * DFF, bid, nb);
    cvt_weights(p.in[23], (bf16_t*)(p.ws + WB_E2), (size_t)NEXP * DFF * D, bid, nb);
    cvt_weights(p.in[26], (bf16_t*)(p.ws + WB_PLE), (size_t)256 * D, bid, nb);
    cvt_weights(p.in[27], (bf16_t*)(p.ws + WB_PLEG), (size_t)D * D, bid, nb);
    const float* x = p.in[0];
    const float* g = p.in[3];
    bf16_t* hb = (bf16_t*)(p.ws + WS_HB);
    for (int t = bid * 4 + wave; t < S; t += nb * 4) {
        const float4* xr = (const float4*)(x + (size_t)t * D);
        float4 v[4];
        float ss = 0.f;
#pragma unroll
        for (int j = 0; j < 4; ++j) { v[j] = xr[lane + 64 * j]; ss += v[j].x * v[j].x + v[j].y * v[j].y + v[j].z * v[j].z + v[j].w * v[j].w; }
        ss = wave_sum(ss);
        const float rstd = rsqrtf(ss * (1.f / D) + EPS);
#pragma unroll
        for (int j = 0; j < 4; ++j) {
            const float4 gg = ((const float4*)g)[lane + 64 * j];
            uint2 o;
            o.x = pk2(v[j].x * rstd * gg.x, v[j].y * rstd * gg.y);
            o.y = pk2(v[j].z * rstd * gg.z, v[j].w * rstd * gg.w);
            ((uint2*)(hb + (size_t)t * D))[lane + 64 * j] = o;
        }
    }
}

__device__ __forceinline__ void phase_inproj(const Params& p, int bid, int nb, unsigned char* smem) {
    const bf16_t* hb = (const bf16_t*)(p.ws + WS_HB);
    float* z = (float*)(p.ws + WS_Z);
    constexpr int NTN = (DIN + 127) / 128;
    for (int w = bid; w < 128 * NTN; w += nb) {
        const int mt = w % 128, nt = w / 128;
        const int m0 = mt * 128, n0 = nt * 128;
        const int ncols = (DIN - n0) < 128 ? (DIN - n0) : 128;
        f32x4 acc[4][4];
        gemm2<false, false>(hb, D, nullptr, m0, 128, (const bf16_t*)(p.ws + WB_IN), DIN, n0, ncols, D, smem, acc);
#pragma unroll
        for (int i = 0; i < 4; ++i)
#pragma unroll
            for (int r = 0; r < 4; ++r) {
                float* zr = z + (size_t)(m0 + G2_ROW(i, r)) * DIN + n0;
#pragma unroll
                for (int j = 0; j < 4; ++j) { const int c = G2_COL(j); if (c < ncols) zr[c] = acc[i][j][r]; }
            }
    }
}

__device__ __forceinline__ float rms64(float v) { return rsqrtf(wave_sum(v * v) * (1.f / 64.f) + EPS); }
__device__ __forceinline__ void phase_post(const Params& p, int bid, int nb) {
    const int lane = threadIdx.x & 63, wave = threadIdx.x >> 6;
    const float* z = (const float*)(p.ws + WS_Z);
    float* qn = (float*)(p.ws + WS_QN);
    float* ksl = (float*)(p.ws + WS_KSL);
    float* vsl = (float*)(p.ws + WS_VSL);
    float* kwn = (float*)(p.ws + WS_KWN);
    float* vwn = (float*)(p.ws + WS_VWN);
    float* gt = (float*)(p.ws + WS_GT);
    float* dqn = (float*)(p.ws + WS_DQN);
    float* dkn = (float*)(p.ws + WS_DKN);
    float* dvn = (float*)(p.ws + WS_DVN);
    float* iqs = (float*)(p.ws + WS_IQS);
    float* iks = (float*)(p.ws + WS_IKS);
    float* iws = (float*)(p.ws + WS_IWS);
    const float gqn = p.in[4][lane], gkn = p.in[5][lane], gqd = p.in[6][lane], gkd = p.in[7][lane];
    for (int t = bid * 4 + wave; t < S; t += nb * 4) {
        const float* zr = z + (size_t)t * DIN;
#pragma unroll
        for (int h = 0; h < 8; ++h) {
            const float v = zr[Z_NQ + h * 64 + lane];
            qn[(size_t)t * 512 + h * 64 + lane] = v * rms64(v) * gqn * 0.125f;
        }
#pragma unroll
        for (int g = 0; g < 2; ++g) {
            float v = zr[Z_NKV + 2 * 128 + g * 64 + lane];
            ksl[((size_t)g * S + t) * 64 + lane] = v * rms64(v) * gkn;
            v = zr[Z_NKV + 3 * 128 + g * 64 + lane];
            vsl[((size_t)g * S + t) * 64 + lane] = v;
            v = zr[Z_NKV + 4 * 128 + g * 64 + lane];
            kwn[((size_t)g * S + t) * 64 + lane] = v * rms64(v) * gkn;
            v = zr[Z_NKV + 5 * 128 + g * 64 + lane];
            vwn[((size_t)g * S + t) * 64 + lane] = v;
        }
        if (lane < 24) gt[(size_t)t * 32 + lane] = sigmoidf_(zr[Z_NGATE + lane]);
#pragma unroll
        for (int h = 0; h < 8; ++h) {
            float v = zr[Z_DQ + h * 64 + lane];
            dqn[(size_t)t * 512 + h * 64 + lane] = v * rms64(v) * gqd * 0.125f;
            v = zr[Z_DK + h * 64 + lane];
            dkn[(size_t)t * 512 + h * 64 + lane] = v * rms64(v) * gkd;
            dvn[(size_t)t * 512 + h * 64 + lane] = zr[Z_DV + h * 64 + lane];
        }
#pragma unroll
        for (int j = 0; j < 4; ++j) iqs[(size_t)t * 256 + j * 64 + lane] = zr[Z_IQ + j * 64 + lane] * 0.17677669529663687f;
        if (lane < 32) iks[(size_t)t * 32 + lane] = zr[Z_IK + lane];
        if (lane < 8) iws[(size_t)t * 8 + lane] = zr[Z_IW + lane] * 0.35355339059327373f;
    }
}

__device__ __forceinline__ void phase_compress(const Params& p, int bid, int nb) {
    const int lane = threadIdx.x & 63, wave = threadIdx.x >> 6;
    const float* z = (const float*)(p.ws + WS_Z);
    float* kc = (float*)(p.ws + WS_KC);
    float* vc = (float*)(p.ws + WS_VC);
    const float gkn = p.in[5][lane];
    for (int it = bid * 4 + wave; it < NCMP * 4; it += nb * 4) {
        const int kind = it & 1, g = (it >> 1) & 1, c = it >> 2;
        const float* pe = p.in[kind ? 11 : 8];
        const float* w1 = p.in[kind ? 12 : 9];
        const float* w2 = p.in[kind ? 13 : 10];
        float acc = 0.f;
        for (int l = 0; l < 32; ++l) {
            const float* zr = z + (size_t)(16 * c + l) * DIN + Z_NKV + kind * 128 + g * 64;
            const float zin = zr[lane] + pe[l * 64 + lane];
            const float* w1l = w1 + (size_t)l * 64 * 64;
#pragma unroll 8
            for (int d = 0; d < 64; ++d) acc += __shfl(zin, d) * w1l[d * 64 + lane];
        }
        const float hid = acc * sigmoidf_(acc);
        float o = 0.f;
#pragma unroll 8
        for (int e = 0; e < 64; ++e) o += __shfl(hid, e) * w2[e * 64 + lane];
        if (kind == 0) {
            o = o * rms64(o) * gkn;
            kc[((size_t)c * 2 + g) * 64 + lane] = o;
        } else vc[((size_t)c * 2 + g) * 64 + lane] = o;
    }
}

__device__ __forceinline__ float dot64(const float (&q)[64], const float* kp_) {
    const float4* kp = (const float4*)kp_;
    float dsum = 0.f;
#pragma unroll
    for (int d = 0; d < 16; ++d) { const float4 kv = kp[d]; dsum += q[4 * d] * kv.x + q[4 * d + 1] * kv.y + q[4 * d + 2] * kv.z + q[4 * d + 3] * kv.w; }
    return dsum;
}
__device__ __forceinline__ void wave_softmax_lds(float* pr, int n, int npad, int lane, float mx) {
    mx = wave_max(mx);
    float sum = 0.f;
#pragma unroll 1
    for (int k = lane; k < n; k += 64) { const float v = pr[k]; const float e = (v > -1e29f) ? __expf(v - mx) : 0.f; pr[k] = e; sum += e; }
    sum = wave_sum(sum);
    const float inv = 1.f / fmaxf(sum, 1e-30f);
#pragma unroll 1
    for (int k = lane; k < npad; k += 64) pr[k] = (k < n) ? pr[k] * inv : 0.f;
}
__device__ __forceinline__ void nsa_item(const Params& p, int t, int g, unsigned char* smem) {
    const int tid = threadIdx.x, lane = tid & 63, r = tid >> 6;
    float* pl = (float*)smem;
    float* lut = pl + 4 * 1024;
    float* sc = lut + 4 * 128;
    int* sel = (int*)(sc + 256);
    const float* qn = (const float*)(p.ws + WS_QN);
    const float* kc = (const float*)(p.ws + WS_KC);
    const float* vc = (const float*)(p.ws + WS_VC);
    const float* ksl = (const float*)(p.ws + WS_KSL) + (size_t)g * S * 64;
    const float* vsl = (const float*)(p.ws + WS_VSL) + (size_t)g * S * 64;
    const float* kwn = (const float*)(p.ws + WS_KWN) + (size_t)g * S * 64;
    const float* vwn = (const float*)(p.ws + WS_VWN) + (size_t)g * S * 64;
    const float* gt = (const float*)(p.ws + WS_GT);
    const float* relb = p.in[17];
    const int h = g * 4 + r;
    __syncthreads();
    for (int i = tid; i < 512; i += NT) { const int hh = i >> 7, n = i & 127; lut[i] = relb[bucket_of(n) * 16 + g * 4 + hh]; }
    float q[64];
    {
        const float4* qp = (const float4*)(qn + (size_t)t * 512 + h * 64);
#pragma unroll
        for (int d = 0; d < 16; ++d) { const float4 v = qp[d]; q[4 * d] = v.x; q[4 * d + 1] = v.y; q[4 * d + 2] = v.z; q[4 * d + 3] = v.w; }
    }
    __syncthreads();
    const float* mylut = lut + r * 128;
    float* pr = pl + r * 1024;
    const int nv = (t >= 31) ? ((t - 31) >> 4) + 1 : 0;
    float mx = -1e30f;
#pragma unroll 1
    for (int c = lane; c < nv; c += 64) {
        int dist = t - (16 * c + 31); dist = dist > 127 ? 127 : dist;
        const float v = dot64(q, kc + ((size_t)c * 2 + g) * 64) + mylut[dist];
        pr[c] = v; mx = fmaxf(mx, v);
    }
    wave_softmax_lds(pr, nv, 1024, lane, mx);
    __syncthreads();
    float oc = 0.f;
#pragma unroll 4
    for (int c = 0; c < nv; ++c) oc += pr[c] * vc[((size_t)c * 2 + g) * 64 + lane];
    {
        const int n = tid;
        float imp = 0.f;
#pragma unroll
        for (int rr = 0; rr < 4; ++rr) {
            const float* prr = pl + rr * 1024;
            float v = prr[4 * n] + prr[4 * n + 1] + prr[4 * n + 2];
            if (4 * n + 3 < NCMP) v += 0.5f * prr[4 * n + 3];
            if (n > 0) v += 0.5f * prr[4 * n - 1];
            imp += v;
        }
        const int cur = t >> 6;
        const bool valid = n <= cur;
        const bool forced = valid && (n == 0 || n > cur - 2);
        sc[n] = forced ? __builtin_inff() : (valid ? imp : -__builtin_inff());
    }
    __syncthreads();
    {
        const int n = tid;
        const float my = sc[n];
        int rank = 0;
#pragma unroll 8
        for (int m = 0; m < 256; ++m) { const float o = sc[m]; rank += (o > my) || (o == my && m < n); }
        if (rank < 16) sel[rank] = n;
    }
    __syncthreads();
    mx = -1e30f;
#pragma unroll 1
    for (int j = 0; j < 16; ++j) {
        const int tok = sel[j] * 64 + lane;
        float v = -1e30f;
        if (tok <= t) {
            int dist = t - tok; dist = dist > 127 ? 127 : dist;
            v = dot64(q, ksl + (size_t)tok * 64) + mylut[dist];
        }
        pr[j * 64 + lane] = v; mx = fmaxf(mx, v);
    }
    wave_softmax_lds(pr, 1024, 1024, lane, mx);
    float os = 0.f;
#pragma unroll 1
    for (int j = 0; j < 16; ++j) {
        const int base = sel[j] * 64;
        if (base <= t) {
            const int lim = (t - base) < 63 ? (t - base) : 63;
#pragma unroll 4
            for (int k = 0; k <= lim; ++k) os += pr[j * 64 + k] * vsl[(size_t)(base + k) * 64 + lane];
        }
    }
    const int s0 = t - 511;
    mx = -1e30f;
#pragma unroll 1
    for (int k = lane; k < 512; k += 64) {
        const int s = s0 + k;
        float v = -1e30f;
        if (s >= 0) {
            int dist = t - s; dist = dist > 127 ? 127 : dist;
            v = dot64(q, kwn + (size_t)s * 64) + mylut[dist];
        }
        pr[k] = v; mx = fmaxf(mx, v);
    }
    wave_softmax_lds(pr, 512, 512, lane, mx);
    float ow = 0.f;
    {
        const int kb = s0 < 0 ? -s0 : 0;
#pragma unroll 4
        for (int k = kb; k < 512; ++k) ow += pr[k] * vwn[(size_t)(s0 + k) * 64 + lane];
    }
    const float g0 = gt[(size_t)t * 32 + h * 3 + 0], g1 = gt[(size_t)t * 32 + h * 3 + 1], g2 = gt[(size_t)t * 32 + h * 3 + 2];
    const float o = g0 * oc + g1 * os + g2 * ow;
    ((bf16_t*)(p.ws + WS_OA))[(size_t)t * 512 + h * 64 + lane] = (bf16_t)f2bf(o);
}

__device__ __forceinline__ void dsa_item(const Params& p, int t, unsigned char* smem) {
    const int tid = threadIdx.x, lane = tid & 63, wave = tid >> 6;
    unsigned* keys = (unsigned*)smem;
    float* pbuf = (float*)smem;
    unsigned* hist = keys + 16384;
    int* sel = (int*)(hist + 256);
    float* qi = (float*)(sel + 256);
    float* lut = qi + 256;
    float* wi = lut + 1024;
    int* misc = (int*)(wi + 8);
    const float* iqs = (const float*)(p.ws + WS_IQS);
    const float* iks = (const float*)(p.ws + WS_IKS);
    const float* iws = (const float*)(p.ws + WS_IWS);
    const float* dqn = (const float*)(p.ws + WS_DQN);
    const float* dkn = (const float*)(p.ws + WS_DKN);
    const float* dvn = (const float*)(p.ws + WS_DVN);
    const float* relb = p.in[17];
    __syncthreads();
    qi[tid] = iqs[(size_t)t * 256 + tid];
    if (tid < 8) wi[tid] = iws[(size_t)t * 8 + tid];
    for (int i = tid; i < 1024; i += NT) { const int hh = i >> 7, n = i & 127; lut[i] = relb[bucket_of(n) * 16 + 8 + hh]; }
    if (tid == 0) misc[0] = 0;
    __syncthreads();
    const int n = t + 1;
    int nsel;
    if (n <= 256) {
        if (tid < n) sel[tid] = tid;
        nsel = n;
    } else {
#pragma unroll 1
        for (int s = tid; s < n; s += NT) {
            asm volatile("" ::: "memory");
            const float4* kp = (const float4*)(iks + (size_t)s * 32);
            float kk[32];
#pragma unroll
            for (int d = 0; d < 8; ++d) { const float4 v = kp[d]; kk[4 * d] = v.x; kk[4 * d + 1] = v.y; kk[4 * d + 2] = v.z; kk[4 * d + 3] = v.w; }
            float score = 0.f;
#pragma unroll
            for (int hh = 0; hh < 8; ++hh) {
                float dsum = 0.f;
#pragma unroll
                for (int d = 0; d < 32; ++d) dsum += qi[hh * 32 + d] * kk[d];
                score += wi[hh] * fmaxf(dsum, 0.f);
            }
            score += 0.0f;
            const unsigned u = __builtin_bit_cast(unsigned, score);
            keys[s] = (u & 0x80000000u) ? ~u : (u | 0x80000000u);
        }
        unsigned prefix = 0, mask = 0;
        int need = 256;
#pragma unroll 1
        for (int pass = 3; pass >= 0; --pass) {
            hist[tid] = 0;
            __syncthreads();
#pragma unroll 1
            for (int s = tid; s < n; s += NT) { const unsigned k = keys[s]; if ((k & mask) == prefix) atomicAdd(&hist[(k >> (8 * pass)) & 255u], 1u); }
            __syncthreads();
            {
                unsigned above = 0;
                for (int b = tid + 1; b < 256; ++b) above += hist[b];
                const unsigned mine = hist[tid];
                if ((int)above < need && (int)(above + mine) >= need) { misc[1] = tid; misc[2] = need - (int)above; misc[3] = (int)mine; }
            }
            __syncthreads();
            prefix |= (unsigned)misc[1] << (8 * pass);
            mask |= 0xFFu << (8 * pass);
            need = misc[2];
            __syncthreads();
        }
        const unsigned T = prefix;
        const int ties = misc[3];
        if (ties == need) {
#pragma unroll 1
            for (int s = tid; s < n; s += NT) { const unsigned k = keys[s]; if (k >= T) { const int pos = atomicAdd(&misc[0], 1); sel[pos] = s; } }
        } else {
#pragma unroll 1
            for (int s = tid; s < n; s += NT) { const unsigned k = keys[s]; if (k > T) { const int pos = atomicAdd(&misc[0], 1); sel[pos] = s; } }
            __syncthreads();
            if (tid == 0) {
                int pos = misc[0], got = 0;
                for (int s = 0; s < n && got < need; ++s) if (keys[s] == T) { sel[pos++] = s; ++got; }
            }
        }
        nsel = 256;
    }
    __syncthreads();
#pragma unroll 1
    for (int hh = wave * 2; hh < wave * 2 + 2; ++hh) {
        float q[64];
        {
            const float4* qp = (const float4*)(dqn + (size_t)t * 512 + hh * 64);
#pragma unroll
            for (int d = 0; d < 16; ++d) { const float4 v = qp[d]; q[4 * d] = v.x; q[4 * d + 1] = v.y; q[4 * d + 2] = v.z; q[4 * d + 3] = v.w; }
        }
        float* pr = pbuf + hh * 256;
        float mx = -1e30f;
#pragma unroll 1
        for (int k = lane; k < nsel; k += 64) {
            const int s = sel[k];
            int dist = t - s; dist = dist > 127 ? 127 : dist;
            const float v = dot64(q, dkn + (size_t)s * 512 + hh * 64) + lut[hh * 128 + dist];
            pr[k] = v; mx = fmaxf(mx, v);
        }
        wave_softmax_lds(pr, nsel, nsel, lane, mx);
        float o = 0.f;
#pragma unroll 4
        for (int k = 0; k < nsel; ++k) o += pr[k] * dvn[(size_t)sel[k] * 512 + hh * 64 + lane];
        ((bf16_t*)(p.ws + WS_OB))[(size_t)t * 512 + hh * 64 + lane] = (bf16_t)f2bf(o);
    }
}

__device__ __forceinline__ void phase_attn(const Params& p, int bid, int nb, unsigned char* smem) {
    for (int w = bid; w < S + 2 * S; w += nb) {
        if (w < S) dsa_item(p, S - 1 - w, smem);
        else { const int i = w - S; nsa_item(p, i >> 1, i & 1, smem); }
    }
}

template <int PASS>
__device__ __forceinline__ void phase_merge(const Params& p, int bid, int nb, unsigned char* smem) {
    const float* z = (const float*)(p.ws + WS_Z);
    bf16_t* merged = (bf16_t*)(p.ws + WS_MERGED);
    float* tmp = (float*)(p.ws + WS_X1);
    const bf16_t* A = (const bf16_t*)(p.ws + (PASS ? WS_OB : WS_OA));
    const bf16_t* Bw = (const bf16_t*)(p.ws + (PASS ? WB_B : WB_A));
    constexpr int zoff = PASS ? Z_GB : Z_GA;
    for (int w = bid; w < 128 * 8; w += nb) {
        const int mt = w % 128, nt = w / 128;
        const int m0 = mt * 128, n0 = nt * 128;
        f32x4 acc[4][4];
        gemm2<false, false>(A, 512, nullptr, m0, 128, Bw, D, n0, 128, 512, smem, acc);
#pragma unroll
        for (int i = 0; i < 4; ++i)
#pragma unroll
            for (int r = 0; r < 4; ++r) {
                const int row = m0 + G2_ROW(i, r);
                const float* zr = z + (size_t)row * DIN + zoff + n0 + G2_COL(0);
                float* tr = tmp + (size_t)row * D + n0 + G2_COL(0);
                bf16_t* mr = merged + (size_t)row * D + n0 + G2_COL(0);
#pragma unroll
                for (int j = 0; j < 4; ++j) {
                    const float v = sigmoidf_(zr[j * 16]) * acc[i][j][r];
                    if (PASS == 0) tr[j * 16] = v;
                    else mr[j * 16] = (bf16_t)f2bf(tr[j * 16] + v);
                }
            }
    }
}

__device__ __forceinline__ void phase_outproj(const Params& p, int bid, int nb, unsigned char* smem) {
    const bf16_t* merged = (const bf16_t*)(p.ws + WS_MERGED);
    const float* x = p.in[0];
    float* x1 = (float*)(p.ws + WS_X1);
    for (int w = bid; w < 128 * 8; w += nb) {
        const int mt = w % 128, nt = w / 128;
        const int m0 = mt * 128, n0 = nt * 128;
        f32x4 acc[4][4];
        gemm2<false, false>(merged, D, nullptr, m0, 128, (const bf16_t*)(p.ws + WB_OUT), D, n0, 128, D, smem, acc);
#pragma unroll
        for (int i = 0; i < 4; ++i)
#pragma unroll
            for (int r = 0; r < 4; ++r) {
                const size_t ro = (size_t)(m0 + G2_ROW(i, r)) * D + n0;
#pragma unroll
                for (int j = 0; j < 4; ++j) { const int c = G2_COL(j); x1[ro + c] = x[ro + c] + acc[i][j][r]; }
            }
    }
}

__device__ __forceinline__ void phase_route(const Params& p, int bid, int nb) {
    const int lane = threadIdx.x & 63, wave = threadIdx.x >> 6;
    const float* x1 = (const float*)(p.ws + WS_X1);
    const float* g = p.in[18];
    const float* wr = p.in[19];
    const float* br = p.in[20];
    bf16_t* hb = (bf16_t*)(p.ws + WS_HB);
    int* topi = (int*)(p.ws + WS_TOPI);
    float* topw = (float*)(p.ws + WS_TOPW);
    int* cnt = (int*)(p.ws + WS_CTL);
    for (int t = bid * 4 + wave; t < S; t += nb * 4) {
        const float4* xr = (const float4*)(x1 + (size_t)t * D);
        float4 v[4];
        float ss = 0.f;
#pragma unroll
        for (int j = 0; j < 4; ++j) { v[j] = xr[lane + 64 * j]; ss += v[j].x * v[j].x + v[j].y * v[j].y + v[j].z * v[j].z + v[j].w * v[j].w; }
        ss = wave_sum(ss);
        const float rstd = rsqrtf(ss * (1.f / D) + EPS);
        float lg[32];
#pragma unroll
        for (int e = 0; e < 32; ++e) lg[e] = 0.f;
#pragma unroll
        for (int j = 0; j < 4; ++j) {
            const float4 gg = ((const float4*)g)[lane + 64 * j];
            const float h0 = v[j].x * rstd * gg.x, h1 = v[j].y * rstd * gg.y, h2 = v[j].z * rstd * gg.z, h3 = v[j].w * rstd * gg.w;
            uint2 o; o.x = pk2(h0, h1); o.y = pk2(h2, h3);
            ((uint2*)(hb + (size_t)t * D))[lane + 64 * j] = o;
            const int k = 4 * (lane + 64 * j);
            const float4* w0 = (const float4*)(wr + (size_t)k * 32);
#pragma unroll
            for (int e4 = 0; e4 < 8; ++e4) {
                const float4 a = w0[e4], b = w0[8 + e4], c = w0[16 + e4], d = w0[24 + e4];
                lg[4 * e4 + 0] += h0 * a.x + h1 * b.x + h2 * c.x + h3 * d.x;
                lg[4 * e4 + 1] += h0 * a.y + h1 * b.y + h2 * c.y + h3 * d.y;
                lg[4 * e4 + 2] += h0 * a.z + h1 * b.z + h2 * c.z + h3 * d.z;
                lg[4 * e4 + 3] += h0 * a.w + h1 * b.w + h2 * c.w + h3 * d.w;
            }
        }
#pragma unroll
        for (int e = 0; e < 32; ++e) lg[e] = wave_sum(lg[e]) + br[e];
        int idx[4]; float val[4];
        unsigned used = 0;
#pragma unroll
        for (int k = 0; k < 4; ++k) {
            float best = -__builtin_inff(); int bi = 0;
#pragma unroll
            for (int e = 0; e < 32; ++e) { const bool ok = !((used >> e) & 1u) && (lg[e] > best); best = ok ? lg[e] : best; bi = ok ? e : bi; }
            idx[k] = bi; val[k] = best; used |= 1u << bi;
        }
        const float e0 = 1.f, e1 = __expf(val[1] - val[0]), e2 = __expf(val[2] - val[0]), e3 = __expf(val[3] - val[0]);
        const float inv = 1.f / (e0 + e1 + e2 + e3);
        if (lane == 0) {
            topi[t * 4 + 0] = idx[0]; topi[t * 4 + 1] = idx[1]; topi[t * 4 + 2] = idx[2]; topi[t * 4 + 3] = idx[3];
            topw[t * 4 + 0] = e0 * inv; topw[t * 4 + 1] = e1 * inv; topw[t * 4 + 2] = e2 * inv; topw[t * 4 + 3] = e3 * inv;
            atomicAdd(&cnt[idx[0]], 1); atomicAdd(&cnt[idx[1]], 1); atomicAdd(&cnt[idx[2]], 1); atomicAdd(&cnt[idx[3]], 1);
        }
    }
}

__device__ __forceinline__ void phase_place(const Params& p, int bid, int nb, unsigned char* smem) {
    int* off = (int*)smem;
    const int* cnt = (const int*)(p.ws + WS_CTL);
    int* cur = (int*)(p.ws + WS_CTL) + 32;
    const int* topi = (const int*)(p.ws + WS_TOPI);
    int* ppos = (int*)(p.ws + WS_PPOS);
    int* rowtok = (int*)(p.ws + WS_ROWTOK);
    __syncthreads();
    if (threadIdx.x == 0) { int a = 0; for (int e = 0; e < NEXP; ++e) { off[e] = a; a += cnt[e]; } }
    __syncthreads();
    for (int i = bid * NT + threadIdx.x; i < S * 4; i += nb * NT) {
        const int e = topi[i];
        const int pos = off[e] + atomicAdd(&cur[e], 1);
        ppos[i] = pos;
        rowtok[pos] = i >> 2;
    }
}

__device__ __forceinline__ void moe_tile_map(const int* cnt, int* sm, int& total_mt) {
    __syncthreads();
    if (threadIdx.x == 0) {
        int a = 0, b = 0;
        for (int e = 0; e < NEXP; ++e) { sm[e] = a; sm[33 + e] = b; a += (cnt[e] + 127) >> 7; b += cnt[e]; }
        sm[32] = a; sm[65] = b;
    }
    __syncthreads();
    total_mt = sm[32];
}
__device__ __forceinline__ void phase_moe1(const Params& p, int bid, int nb, unsigned char* smem) {
    int* sm = (int*)(smem + 65536);
    const int* cnt = (const int*)(p.ws + WS_CTL);
    const int* rowtok = (const int*)(p.ws + WS_ROWTOK);
    const bf16_t* hb = (const bf16_t*)(p.ws + WS_HB);
    bf16_t* act = (bf16_t*)(p.ws + WS_ACT);
    const int lane = threadIdx.x & 63, wave = threadIdx.x >> 6;
    int total_mt;
    moe_tile_map(cnt, sm, total_mt);
    for (int w = bid; w < total_mt * 16; w += nb) {
        const int tm = w >> 4, nt = w & 15;
        int e = 0;
        while (e < NEXP - 1 && sm[e + 1] <= tm) ++e;
        const int mt = tm - sm[e];
        const int rbase = sm[33 + e] + mt * 128;
        const int mrows = min(128, cnt[e] - mt * 128);
        const int n0 = nt * 64;
        f32x4 acc[4][4];
        gemm2<true, true>(hb, D, rowtok, rbase, mrows, (const bf16_t*)(p.ws + WB_E1) + (size_t)e * D * 2 * DFF, 2 * DFF, n0, 128, D, smem, acc);
        const float* b1 = p.in[22] + (size_t)e * 2 * DFF;
        const int wn_ = (threadIdx.x >> 6) & 1;
#pragma unroll
        for (int i = 0; i < 4; ++i)
#pragma unroll
            for (int jp = 0; jp < 2; ++jp) {
                const int col = n0 + (wn_ * 2 + jp) * 16 + (threadIdx.x & 15);
                const float bg = b1[col], bl = b1[DFF + col];
#pragma unroll
                for (int r = 0; r < 4; ++r) {
                    const int rl = G2_ROW(i, r);
                    if (rl < mrows) {
                        const float gate = fminf(acc[i][2 * jp][r] + bg, 7.f);
                        const float lin = fminf(fmaxf(acc[i][2 * jp + 1][r] + bl, -7.f), 7.f);
                        const float a_ = (lin + 1.f) * gate * sigmoidf_(1.702f * gate);
                        act[(size_t)(rbase + rl) * DFF + col] = (bf16_t)f2bf(a_);
                    }
                }
            }
    }
}
__device__ __forceinline__ void phase_moe2(const Params& p, int bid, int nb, unsigned char* smem) {
    int* sm = (int*)(smem + 65536);
    const int* cnt = (const int*)(p.ws + WS_CTL);
    const bf16_t* act = (const bf16_t*)(p.ws + WS_ACT);
    float* yrows = (float*)(p.ws + WS_YROWS);
    const int lane = threadIdx.x & 63, wave = threadIdx.x >> 6;
    int total_mt;
    moe_tile_map(cnt, sm, total_mt);
    for (int w = bid; w < total_mt * 8; w += nb) {
        const int tm = w >> 3, nt = w & 7;
        int e = 0;
        while (e < NEXP - 1 && sm[e + 1] <= tm) ++e;
        const int mt = tm - sm[e];
        const int rbase = sm[33 + e] + mt * 128;
        const int mrows = min(128, cnt[e] - mt * 128);
        const int n0 = nt * 128;
        f32x4 acc[4][4];
        gemm2<false, false>(act, DFF, nullptr, rbase, mrows, (const bf16_t*)(p.ws + WB_E2) + (size_t)e * DFF * D, D, n0, 128, DFF, smem, acc);
        const float* b2 = p.in[24] + (size_t)e * D + n0;
#pragma unroll
        for (int i = 0; i < 4; ++i)
#pragma unroll
            for (int r = 0; r < 4; ++r) {
                const int rl = G2_ROW(i, r);
                if (rl < mrows) {
                    float* yr = yrows + (size_t)(rbase + rl) * D + n0;
#pragma unroll
                    for (int j = 0; j < 4; ++j) { const int c = G2_COL(j); yr[c] = acc[i][j][r] + b2[c]; }
                }
            }
    }
}

__device__ __forceinline__ void phase_combine(const Params& p, int bid, int nb) {
    const int lane = threadIdx.x & 63, wave = threadIdx.x >> 6;
    const float* x1 = (const float*)(p.ws + WS_X1);
    const float* yrows = (const float*)(p.ws + WS_YROWS);
    const int* ppos = (const int*)(p.ws + WS_PPOS);
    const float* topw = (const float*)(p.ws + WS_TOPW);
    const float* g = p.in[25];
    bf16_t* hb = (bf16_t*)(p.ws + WS_HB);
    bf16_t* pb = (bf16_t*)(p.ws + WS_PB);
    for (int t = bid * 4 + wave; t < S; t += nb * 4) {
        {
            const float4 pv = ((const float4*)(p.in[1] + (size_t)t * 256))[lane];
            uint2 o; o.x = pk2(pv.x, pv.y); o.y = pk2(pv.z, pv.w);
            ((uint2*)(pb + (size_t)t * 256))[lane] = o;
        }
        float4 v[4];
#pragma unroll
        for (int j = 0; j < 4; ++j) v[j] = ((const float4*)(x1 + (size_t)t * D))[lane + 64 * j];
#pragma unroll
        for (int k = 0; k < 4; ++k) {
            const float wk = topw[t * 4 + k];
            const float4* yr = (const float4*)(yrows + (size_t)ppos[t * 4 + k] * D);
#pragma unroll
            for (int j = 0; j < 4; ++j) { const float4 y = yr[lane + 64 * j]; v[j].x += wk * y.x; v[j].y += wk * y.y; v[j].z += wk * y.z; v[j].w += wk * y.w; }
        }
        float ss = 0.f;
#pragma unroll
        for (int j = 0; j < 4; ++j) ss += v[j].x * v[j].x + v[j].y * v[j].y + v[j].z * v[j].z + v[j].w * v[j].w;
        ss = wave_sum(ss);
        const float rstd = rsqrtf(ss * (1.f / D) + EPS);
#pragma unroll
        for (int j = 0; j < 4; ++j) {
            ((float4*)(p.out + (size_t)t * D))[lane + 64 * j] = v[j];
            const float4 gg = ((const float4*)g)[lane + 64 * j];
            uint2 o;
            o.x = pk2(v[j].x * rstd * gg.x, v[j].y * rstd * gg.y);
            o.y = pk2(v[j].z * rstd * gg.z, v[j].w * rstd * gg.w);
            ((uint2*)(hb + (size_t)t * D))[lane + 64 * j] = o;
        }
    }
}

template <int PASS>
__device__ __forceinline__ void phase_ple(const Params& p, int bid, int nb, unsigned char* smem) {
    float* tmp = (float*)(p.ws + WS_X1);
    const bf16_t* A = (const bf16_t*)(p.ws + (PASS ? WS_PB : WS_HB));
    const bf16_t* Bw = (const bf16_t*)(p.ws + (PASS ? WB_PLE : WB_PLEG));
    constexpr int K = PASS ? 256 : D;
    for (int w = bid; w < 128 * 8; w += nb) {
        const int mt = w % 128, nt = w / 128;
        const int m0 = mt * 128, n0 = nt * 128;
        f32x4 acc[4][4];
        gemm2<false, false>(A, K, nullptr, m0, 128, Bw, D, n0, 128, K, smem, acc);
#pragma unroll
        for (int i = 0; i < 4; ++i)
#pragma unroll
            for (int r = 0; r < 4; ++r) {
                const size_t ro = (size_t)(m0 + G2_ROW(i, r)) * D + n0 + G2_COL(0);
                float* tr = tmp + ro;
                float* orow = p.out + ro;
#pragma unroll
                for (int j = 0; j < 4; ++j) {
                    if (PASS == 0) tr[j * 16] = sigmoidf_(acc[i][j][r]);
                    else orow[j * 16] = orow[j * 16] + tr[j * 16] * acc[i][j][r];
                }
            }
    }
}

template <int PH>
__device__ __forceinline__ void run_phase(const Params& p, int bid, int nb, unsigned char* smem) {
    if (PH == 0) phase_prep(p, bid, nb);
    if (PH == 1) phase_inproj(p, bid, nb, smem);
    if (PH == 2) phase_post(p, bid, nb);
    if (PH == 3) phase_compress(p, bid, nb);
    if (PH == 4) phase_attn(p, bid, nb, smem);
    if (PH == 5) phase_merge<0>(p, bid, nb, smem);
    if (PH == 13) phase_merge<1>(p, bid, nb, smem);
    if (PH == 6) phase_outproj(p, bid, nb, smem);
    if (PH == 7) phase_route(p, bid, nb);
    if (PH == 8) phase_place(p, bid, nb, smem);
    if (PH == 9) phase_moe1(p, bid, nb, smem);
    if (PH == 10) phase_moe2(p, bid, nb, smem);
    if (PH == 11) phase_combine(p, bid, nb);
    if (PH == 12) phase_ple<0>(p, bid, nb, smem);
    if (PH == 14) phase_ple<1>(p, bid, nb, smem);
}

#if SINGLE_LAUNCH
__global__ void __launch_bounds__(NT, 2) fwd_mega(Params p) {
    __shared__ __attribute__((aligned(16))) unsigned char smem[SMEM_BYTES];
    cg::grid_group grid = cg::this_grid();
    const int bid = blockIdx.x, nb = gridDim.x;
    run_phase<0>(p, bid, nb, smem); grid.sync();
    run_phase<1>(p, bid, nb, smem); grid.sync();
    run_phase<2>(p, bid, nb, smem); grid.sync();
    run_phase<3>(p, bid, nb, smem); grid.sync();
    run_phase<4>(p, bid, nb, smem); grid.sync();
    run_phase<5>(p, bid, nb, smem); grid.sync();
    run_phase<13>(p, bid, nb, smem); grid.sync();
    run_phase<6>(p, bid, nb, smem); grid.sync();
    run_phase<7>(p, bid, nb, smem); grid.sync();
    run_phase<8>(p, bid, nb, smem); grid.sync();
    run_phase<9>(p, bid, nb, smem); grid.sync();
    run_phase<10>(p, bid, nb, smem); grid.sync();
    run_phase<11>(p, bid, nb, smem); grid.sync();
    run_phase<12>(p, bid, nb, smem); grid.sync();
    run_phase<14>(p, bid, nb, smem);
}
#else
template <int PH>
__global__ void __launch_bounds__(NT, 2) k_phase(Params p) {
    __shared__ __attribute__((aligned(16))) unsigned char smem[SMEM_BYTES];
    run_phase<PH>(p, blockIdx.x, gridDim.x, smem);
}
#endif

extern "C" void kernel_launch(void* const* d_in, const int* in_sizes, int n_in, void* d_out, int out_size, void* d_ws, size_t ws_size,
                              hipStream_t stream) {
    if (n_in != 28 || ws_size < WS_END) { fprintf(stderr, "kernel_launch: unexpected n_in %d or ws_size %zu (< %zu)\n", n_in, ws_size, (size_t)WS_END); return; }
    Params p{};
    for (int i = 0; i < 28; ++i) p.in[i] = (const float*)d_in[i];
    p.out = (float*)d_out;
    p.ws = (unsigned char*)d_ws;
#if SINGLE_LAUNCH
    static int grid_blocks = 0;
    if (!grid_blocks) {
        int dev = 0, cus = 0, per_cu = 0;
        hipGetDevice(&dev);
        hipDeviceGetAttribute(&cus, hipDeviceAttributeMultiprocessorCount, dev);
        hipOccupancyMaxActiveBlocksPerMultiprocessor(&per_cu, fwd_mega, NT, 0);
        if (per_cu > 2) per_cu = 2;
        if (per_cu < 1) per_cu = 1;
        grid_blocks = cus * per_cu;
    }
    void* args[] = {&p};
    hipError_t e = hipLaunchCooperativeKernel((void*)fwd_mega, dim3(grid_blocks), dim3(NT), args, 0, stream);
    if (e != hipSuccess) fprintf(stderr, "cooperative launch failed: %s (grid %d)\n", hipGetErrorString(e), grid_blocks);
#else
    const int G = 512;
    k_phase<0><<<G, NT, 0, stream>>>(p);
    k_phase<1><<<G, NT, 0, stream>>>(p);
    k_phase<2><<<G, NT, 0, stream>>>(p);
    k_phase<3><<<G, NT, 0, stream>>>(p);
    k_phase<4><<<G, NT, 0, stream>>>(p);
    k_phase<5><<<G, NT, 0, stream>>>(p);
    k_phase<13><<<G, NT, 0, stream>>>(p);
    k_phase<6><<<G, NT, 0, stream>>>(p);
    k_phase<7><<<G, NT, 0, stream>>>(p);
    k_phase<8><<<G, NT, 0, stream>>>(p);
    k_phase<9><<<G, NT, 0, stream>>>(p);
    k_phase<10><<<G, NT, 0, stream>>>(p);
    k_phase<11><<<G, NT, 0, stream>>>(p);
    k_phase<12><<<G, NT, 0, stream>>>(p);
    k_phase<14><<<G, NT, 0, stream>>>(p);
#endif
}
```

```cpp
#include <hip/hip_runtime.h>
#include <hip/hip_cooperative_groups.h>
#include <cstdio>
#include <cstdint>
namespace cg = cooperative_groups;

#ifndef SINGLE_LAUNCH
#define SINGLE_LAUNCH 1
#endif

constexpr int S = 16384;
constexpr int D = 1024;
constexpr int DIN = 5184;
constexpr int NCMP = 1023;
constexpr int NSLC = 256;
constexpr int NEXP = 32;
constexpr int DFF = 1024;
constexpr float EPS = 1e-6f;
constexpr float LOG2E = 1.4426950408889634f;
constexpr int Z_NQ = 0, Z_NKV = 512, Z_NGATE = 1280, Z_DQ = 1304, Z_DK = 1816, Z_DV = 2328, Z_IQ = 2840, Z_IK = 3096,
              Z_IW = 3128, Z_GA = 3136, Z_GB = 4160;

constexpr int NT = 256;
constexpr int SMEM_BYTES = 73728;

typedef unsigned short bf16_t;
typedef short bf16x8 __attribute__((ext_vector_type(8)));
typedef float f32x4 __attribute__((ext_vector_type(4)));
typedef short s16x4 __attribute__((ext_vector_type(4)));
typedef __attribute__((address_space(3))) s16x4* lds_s16x4_ptr;
__device__ __forceinline__ s16x4 lds_tr16(const void* p) {
    return __builtin_amdgcn_ds_read_tr16_b64_v4i16((lds_s16x4_ptr)(uintptr_t)p);
}

constexpr size_t MBy = 1ull << 20;
constexpr size_t WS_CTL = 0;
constexpr size_t WS_HB = 1 * MBy;
constexpr size_t WS_OA = WS_HB + (size_t)S * D * 2;
constexpr size_t WS_OB = WS_OA + (size_t)S * 512 * 2;
constexpr size_t WS_MERGED = WS_OB + (size_t)S * 512 * 2;
constexpr size_t WS_X1 = WS_MERGED + (size_t)S * D * 2;
constexpr size_t WS_TOPI = WS_X1 + (size_t)S * D * 4;
constexpr size_t WS_TOPW = WS_TOPI + (size_t)S * 4 * 4;
constexpr size_t WS_PPOS = WS_TOPW + (size_t)S * 4 * 4;
constexpr size_t WS_ROWTOK = WS_PPOS + (size_t)S * 4 * 4;
constexpr size_t WS_KC = WS_ROWTOK + (size_t)65536 * 4;
constexpr size_t WS_VC = WS_KC + (size_t)1024 * 128 * 4;
constexpr size_t WS_PB = WS_VC + (size_t)1024 * 128 * 4;
constexpr size_t WS_REG = WS_PB + (size_t)S * 256 * 2;
constexpr size_t WS_Z = WS_REG;
constexpr size_t WS_QN = WS_Z + (size_t)S * DIN * 4;
constexpr size_t WS_KSL = WS_QN + (size_t)S * 512 * 4;
constexpr size_t WS_VSL = WS_KSL + (size_t)S * 128 * 4;
constexpr size_t WS_KWN = WS_VSL + (size_t)S * 128 * 4;
constexpr size_t WS_VWN = WS_KWN + (size_t)S * 128 * 4;
constexpr size_t WS_GT = WS_VWN + (size_t)S * 128 * 4;
constexpr size_t WS_DQN = WS_GT + (size_t)S * 32 * 4;
constexpr size_t WS_DKN = WS_DQN + (size_t)S * 512 * 4;
constexpr size_t WS_DVN = WS_DKN + (size_t)S * 512 * 4;
constexpr size_t WS_IQS = WS_DVN + (size_t)S * 512 * 4;
constexpr size_t WS_IKS = WS_IQS + (size_t)S * 256 * 4;
constexpr size_t WS_IWS = WS_IKS + (size_t)S * 32 * 4;
constexpr size_t WS_ENDA = WS_IWS + (size_t)S * 8 * 4;
constexpr size_t WS_ACT = WS_REG;
constexpr size_t WS_YROWS = WS_ACT + (size_t)(65536 + 128) * DFF * 2;
constexpr size_t WS_ENDB = WS_YROWS + (size_t)(65536 + 128) * D * 4;
constexpr size_t WS_END0 = WS_ENDA > WS_ENDB ? WS_ENDA : WS_ENDB;
constexpr size_t WB_IN = WS_END0;
constexpr size_t WB_A = WB_IN + (size_t)D * DIN * 2;
constexpr size_t WB_B = WB_A + (size_t)512 * D * 2;
constexpr size_t WB_OUT = WB_B + (size_t)512 * D * 2;
constexpr size_t WB_E1 = WB_OUT + (size_t)D * D * 2;
constexpr size_t WB_E2 = WB_E1 + (size_t)NEXP * D * 2 * DFF * 2;
constexpr size_t WB_PLE = WB_E2 + (size_t)NEXP * DFF * D * 2;
constexpr size_t WB_PLEG = WB_PLE + (size_t)256 * D * 2;
constexpr size_t WS_QNB = WB_PLEG + (size_t)D * D * 2;
constexpr size_t WS_KSLB = WS_QNB + (size_t)S * 512 * 2;
constexpr size_t WS_VSLB = WS_KSLB + (size_t)S * 128 * 2;
constexpr size_t WS_KWNB = WS_VSLB + (size_t)S * 128 * 2;
constexpr size_t WS_VWNB = WS_KWNB + (size_t)S * 128 * 2;
constexpr size_t WS_KCB = WS_VWNB + (size_t)S * 128 * 2;
constexpr size_t WS_VCB = WS_KCB + (size_t)2 * 1024 * 64 * 2;
constexpr size_t WS_END = WS_VCB + (size_t)2 * 1024 * 64 * 2;

struct Params {
    const float* in[28];
    float* out;
    unsigned char* ws;
};

__device__ __forceinline__ unsigned f2bf(float f) {
    unsigned u = __builtin_bit_cast(unsigned, f);
    return (u + 0x7fffu + ((u >> 16) & 1u)) >> 16;
}
__device__ __forceinline__ unsigned pk2(float lo, float hi) { return f2bf(lo) | (f2bf(hi) << 16); }
__device__ __forceinline__ float bf2f(unsigned short b) { return __builtin_bit_cast(float, (unsigned)b << 16); }
__device__ __forceinline__ float wave_sum(float v) {
#pragma unroll
    for (int o = 1; o < 64; o <<= 1) v += __shfl_xor(v, o);
    return v;
}
__device__ __forceinline__ float wave_max(float v) {
#pragma unroll
    for (int o = 1; o < 64; o <<= 1) v = fmaxf(v, __shfl_xor(v, o));
    return v;
}
__device__ __forceinline__ float sigmoidf_(float x) { return 1.f / (1.f + __expf(-x)); }
__device__ __forceinline__ int bucket_of(int n) {
    if (n < 16) return n;
    int b = 16;
    b += (n >= 19) + (n >= 21) + (n >= 24) + (n >= 27) + (n >= 31) + (n >= 35) + (n >= 40) + (n >= 46) + (n >= 52) + (n >= 59) +
         (n >= 67) + (n >= 77) + (n >= 87) + (n >= 99) + (n >= 113);
    return b;
}

constexpr int LDS_STRIDE = 40;
constexpr int BTR_STRIDE = 136;
template <bool A_F32, bool GATHER, bool SPLIT = false, bool BTR = true>
__device__ __forceinline__ void gemm_tile(const void* __restrict__ Aptr, int lda, const int* __restrict__ rowidx, int m0, int mrows,
                                          const float* __restrict__ B, int ldb, int n0, int split_off, int ncols, int K,
                                          unsigned char* smem, f32x4 (&acc)[2][8]) {
    bf16_t* As = (bf16_t*)smem;
    bf16_t* Bs = As + 128 * LDS_STRIDE;
    bf16_t* AsL = Bs + 128 * LDS_STRIDE;
    bf16_t* BsL = AsL + 128 * LDS_STRIDE;
    const int tid = threadIdx.x, lane = tid & 63, wave = tid >> 6;
#pragma unroll
    for (int i = 0; i < 2; ++i)
#pragma unroll
        for (int j = 0; j < 8; ++j) acc[i][j] = (f32x4){0.f, 0.f, 0.f, 0.f};
    auto lo = [](float v) { return v - bf2f((unsigned short)f2bf(v)); };

    const int ar = tid >> 2, ach = tid & 3;
    const unsigned char* arow[2];
    bool aval[2];
#pragma unroll
    for (int i = 0; i < 2; ++i) {
        int r = ar + 64 * i;
        aval[i] = r < mrows;
        long src = 0;
        if (aval[i]) src = GATHER ? (long)rowidx[m0 + r] : (long)(m0 + r);
        arow[i] = (const unsigned char*)Aptr + (size_t)src * lda * (A_F32 ? 4 : 2) + (size_t)ach * 8 * (A_F32 ? 4 : 2);
    }
    const int nq = tid & 31, kq = tid >> 5;
    const int jn = 4 * nq;
    const bool bval = jn < ncols;
    const float* bptr = B + (size_t)(4 * kq) * ldb + n0 + jn + (jn >= 64 ? split_off : 0);

    uint4 areg[2];
    float4 af0a, af0b, af1a, af1b;
    float4 breg[4];
    auto load_g = [&](int k0) {
#pragma unroll
        for (int i = 0; i < 2; ++i) {
            if (A_F32) {
                float4 t0 = make_float4(0, 0, 0, 0), t1 = t0;
                if (aval[i]) {
                    const float4* s = (const float4*)(arow[i] + (size_t)k0 * 4);
                    t0 = s[0]; t1 = s[1];
                }
                if (i == 0) { af0a = t0; af0b = t1; } else { af1a = t0; af1b = t1; }
            } else {
                if (aval[i]) areg[i] = *(const uint4*)(arow[i] + (size_t)k0 * 2);
                else areg[i] = make_uint4(0, 0, 0, 0);
            }
        }
#pragma unroll
        for (int kk = 0; kk < 4; ++kk) {
            if (bval) breg[kk] = *(const float4*)(bptr + (size_t)(k0 + kk) * ldb);
            else breg[kk] = make_float4(0, 0, 0, 0);
        }
    };
    auto store_l = [&]() {
#pragma unroll
        for (int i = 0; i < 2; ++i) {
            uint4 v;
            const float4 t0 = (i == 0) ? af0a : af1a, t1 = (i == 0) ? af0b : af1b;
            if (A_F32) {
                v.x = pk2(t0.x, t0.y); v.y = pk2(t0.z, t0.w);
                v.z = pk2(t1.x, t1.y); v.w = pk2(t1.z, t1.w);
            } else v = areg[i];
            *(uint4*)(As + (ar + 64 * i) * LDS_STRIDE + ach * 8) = v;
            if (SPLIT && A_F32) {
                v.x = pk2(lo(t0.x), lo(t0.y)); v.y = pk2(lo(t0.z), lo(t0.w));
                v.z = pk2(lo(t1.x), lo(t1.y)); v.w = pk2(lo(t1.z), lo(t1.w));
                *(uint4*)(AsL + (ar + 64 * i) * LDS_STRIDE + ach * 8) = v;
            }
        }
        if (SPLIT) {
            uint2 v;
            v.x = pk2(lo(breg[0].x), lo(breg[1].x)); v.y = pk2(lo(breg[2].x), lo(breg[3].x));
            *(uint2*)(BsL + (jn + 0) * LDS_STRIDE + 4 * kq) = v;
            v.x = pk2(lo(breg[0].y), lo(breg[1].y)); v.y = pk2(lo(breg[2].y), lo(breg[3].y));
            *(uint2*)(BsL + (jn + 1) * LDS_STRIDE + 4 * kq) = v;
            v.x = pk2(lo(breg[0].z), lo(breg[1].z)); v.y = pk2(lo(breg[2].z), lo(breg[3].z));
            *(uint2*)(BsL + (jn + 2) * LDS_STRIDE + 4 * kq) = v;
            v.x = pk2(lo(breg[0].w), lo(breg[1].w)); v.y = pk2(lo(breg[2].w), lo(breg[3].w));
            *(uint2*)(BsL + (jn + 3) * LDS_STRIDE + 4 * kq) = v;
        }
        if (BTR && !SPLIT) {
#pragma unroll
            for (int kk = 0; kk < 4; ++kk) {
                uint2 v; v.x = pk2(breg[kk].x, breg[kk].y); v.y = pk2(breg[kk].z, breg[kk].w);
                *(uint2*)(Bs + (4 * kq + kk) * BTR_STRIDE + jn) = v;
            }
        } else {
            uint2 v;
            v.x = pk2(breg[0].x, breg[1].x); v.y = pk2(breg[2].x, breg[3].x);
            *(uint2*)(Bs + (jn + 0) * LDS_STRIDE + 4 * kq) = v;
            v.x = pk2(breg[0].y, breg[1].y); v.y = pk2(breg[2].y, breg[3].y);
            *(uint2*)(Bs + (jn + 1) * LDS_STRIDE + 4 * kq) = v;
            v.x = pk2(breg[0].z, breg[1].z); v.y = pk2(breg[2].z, breg[3].z);
            *(uint2*)(Bs + (jn + 2) * LDS_STRIDE + 4 * kq) = v;
            v.x = pk2(breg[0].w, breg[1].w); v.y = pk2(breg[2].w, breg[3].w);
            *(uint2*)(Bs + (jn + 3) * LDS_STRIDE + 4 * kq) = v;
        }
    };
    const int nk = K / 32;
    __syncthreads();
    load_g(0);
    store_l();
    __syncthreads();
    const int fr = lane & 15, fq = lane >> 4;
    for (int kt = 0; kt < nk; ++kt) {
        if (kt + 1 < nk) load_g((kt + 1) * 32);
        bf16x8 a[2];
#pragma unroll
        for (int i = 0; i < 2; ++i) a[i] = *(const bf16x8*)(As + (wave * 32 + i * 16 + fr) * LDS_STRIDE + fq * 8);
        if (!SPLIT) {
            bf16x8 b[8];
#pragma unroll
            for (int j = 0; j < 8; ++j) {
                if (BTR && !SPLIT) {
                    const bf16_t* bp = Bs + (8 * fq + (fr >> 2)) * BTR_STRIDE + 16 * j + 4 * (fr & 3);
                    const s16x4 lo4 = lds_tr16(bp), hi4 = lds_tr16(bp + 4 * BTR_STRIDE);
                    b[j] = (bf16x8){lo4[0], lo4[1], lo4[2], lo4[3], hi4[0], hi4[1], hi4[2], hi4[3]};
                } else b[j] = *(const bf16x8*)(Bs + (j * 16 + fr) * LDS_STRIDE + fq * 8);
            }
#pragma unroll
            for (int i = 0; i < 2; ++i)
#pragma unroll
                for (int j = 0; j < 8; ++j) acc[i][j] = __builtin_amdgcn_mfma_f32_16x16x32_bf16(a[i], b[j], acc[i][j], 0, 0, 0);
        } else {
            bf16x8 al[2];
#pragma unroll
            for (int i = 0; i < 2; ++i) al[i] = *(const bf16x8*)(AsL + (wave * 32 + i * 16 + fr) * LDS_STRIDE + fq * 8);
#pragma unroll
            for (int j = 0; j < 8; ++j) {
                const bf16x8 bh = *(const bf16x8*)(Bs + (j * 16 + fr) * LDS_STRIDE + fq * 8);
                const bf16x8 bl = *(const bf16x8*)(BsL + (j * 16 + fr) * LDS_STRIDE + fq * 8);
#pragma unroll
                for (int i = 0; i < 2; ++i) {
                    acc[i][j] = __builtin_amdgcn_mfma_f32_16x16x32_bf16(a[i], bh, acc[i][j], 0, 0, 0);
                    acc[i][j] = __builtin_amdgcn_mfma_f32_16x16x32_bf16(a[i], bl, acc[i][j], 0, 0, 0);
                    acc[i][j] = __builtin_amdgcn_mfma_f32_16x16x32_bf16(al[i], bh, acc[i][j], 0, 0, 0);
                }
            }
        }
        __syncthreads();
        if (kt + 1 < nk) {
            store_l();
            __syncthreads();
        }
    }
}


constexpr int ASTR = 72;
constexpr int BSTR = 136;
template <bool GATHER, bool PAIR>
__device__ __forceinline__ void gemm2(const bf16_t* __restrict__ A, int lda, const int* __restrict__ rowidx, int m0, int mrows,
                                      const bf16_t* __restrict__ B, int ldb, int n0, int ncols, int K, unsigned char* smem,
                                      f32x4 (&acc)[4][4]) {
    bf16_t* As = (bf16_t*)smem;
    bf16_t* Bs = As + 128 * ASTR;
    const int tid = threadIdx.x, lane = tid & 63, wave = tid >> 6, wm = wave >> 1, wn = wave & 1;
#pragma unroll
    for (int i = 0; i < 4; ++i)
#pragma unroll
        for (int j = 0; j < 4; ++j) acc[i][j] = (f32x4){0.f, 0.f, 0.f, 0.f};
    const int arl = tid >> 1, ahalf = tid & 1;
    const int arc = arl < mrows ? arl : mrows - 1;
    const long asrc = GATHER ? (long)rowidx[m0 + arc] : (long)(m0 + arc);
    const bf16_t* ap = A + (size_t)asrc * lda + ahalf * 32;
    const int brow = tid >> 2, bq = tid & 3;
    const bf16_t* bp = B + (size_t)brow * ldb + n0 + (PAIR ? bq * 16 : bq * 32);
    const int boff1 = 8, boff2 = PAIR ? 1024 : 16, boff3 = PAIR ? 1032 : 24;
    bf16_t* asd = As + arl * ASTR + ahalf * 32;
    bf16_t* bsd = Bs + brow * BSTR + bq * 32;
    uint4 a0, a1, a2, a3, b0, b1, b2, b3;
#define G2_LOAD(k0)                                                                                       \
    do {                                                                                                  \
        const bf16_t* ap_ = ap + (k0);                                                                    \
        a0 = *(const uint4*)(ap_); a1 = *(const uint4*)(ap_ + 8);                                         \
        a2 = *(const uint4*)(ap_ + 16); a3 = *(const uint4*)(ap_ + 24);                                   \
        const bf16_t* bp_ = bp + (size_t)(k0) * ldb;                                                      \
        b0 = *(const uint4*)(bp_); b1 = *(const uint4*)(bp_ + boff1);                                     \
        b2 = *(const uint4*)(bp_ + boff2); b3 = *(const uint4*)(bp_ + boff3);                             \
    } while (0)
#define G2_STORE()                                                                                        \
    do {                                                                                                  \
        *(uint4*)(asd) = a0; *(uint4*)(asd + 8) = a1; *(uint4*)(asd + 16) = a2; *(uint4*)(asd + 24) = a3; \
        *(uint4*)(bsd) = b0; *(uint4*)(bsd + 8) = b1; *(uint4*)(bsd + 16) = b2; *(uint4*)(bsd + 24) = b3; \
    } while (0)
    const int nk = K / 64;
    __syncthreads();
    G2_LOAD(0);
    G2_STORE();
    __syncthreads();
    const int fr = lane & 15, fq = lane >> 4;
    const bf16_t* afp = As + (wm * 64 + fr) * ASTR + fq * 8;
    const bf16_t* bfp = Bs + (8 * fq + (fr >> 2)) * BSTR + wn * 64 + 4 * (fr & 3);
    for (int kt = 0; kt < nk; ++kt) {
        if (kt + 1 < nk) G2_LOAD((kt + 1) * 64);
#pragma unroll
        for (int kh = 0; kh < 2; ++kh) {
            bf16x8 a[4], b[4];
#pragma unroll
            for (int i = 0; i < 4; ++i) a[i] = *(const bf16x8*)(afp + i * 16 * ASTR + kh * 32);
#pragma unroll
            for (int j = 0; j < 4; ++j) {
                const bf16_t* q = bfp + kh * 32 * BSTR + j * 16;
                const s16x4 lo4 = lds_tr16(q), hi4 = lds_tr16(q + 4 * BSTR);
                b[j] = (bf16x8){lo4[0], lo4[1], lo4[2], lo4[3], hi4[0], hi4[1], hi4[2], hi4[3]};
            }
#pragma unroll
            for (int i = 0; i < 4; ++i)
#pragma unroll
                for (int j = 0; j < 4; ++j) acc[i][j] = __builtin_amdgcn_mfma_f32_16x16x32_bf16(a[i], b[j], acc[i][j], 0, 0, 0);
        }
        __syncthreads();
        if (kt + 1 < nk) {
            G2_STORE();
            __syncthreads();
        }
    }
#undef G2_LOAD
#undef G2_STORE
}
#define G2_ROW(i, r) ((threadIdx.x >> 7) * 64 + (i) * 16 + 4 * ((threadIdx.x & 63) >> 4) + (r))
#define G2_COL(j) (((((threadIdx.x >> 6) & 1) * 4 + (j)) * 16) + (threadIdx.x & 15))

__device__ __forceinline__ void cvt_weights(const float* __restrict__ src, bf16_t* __restrict__ dst, size_t n, int bid, int nb) {
    const size_t n8 = n >> 3;
    for (size_t i = (size_t)bid * NT + threadIdx.x; i < n8; i += (size_t)nb * NT) {
        const float4 u = ((const float4*)src)[2 * i], v = ((const float4*)src)[2 * i + 1];
        uint4 o; o.x = pk2(u.x, u.y); o.y = pk2(u.z, u.w); o.z = pk2(v.x, v.y); o.w = pk2(v.z, v.w);
        ((uint4*)dst)[i] = o;
    }
}
__device__ __forceinline__ void phase_prep(const Params& p, int bid, int nb) {
    const int lane = threadIdx.x & 63, wave = threadIdx.x >> 6;
    if (bid == 0 && threadIdx.x < 64) ((int*)(p.ws + WS_CTL))[threadIdx.x] = 0;
    cvt_weights(p.in[2], (bf16_t*)(p.ws + WB_IN), (size_t)D * DIN, bid, nb);
    cvt_weights(p.in[14], (bf16_t*)(p.ws + WB_A), (size_t)512 * D, bid, nb);
    cvt_weights(p.in[15], (bf16_t*)(p.ws + WB_B), (size_t)512 * D, bid, nb);
    cvt_weights(p.in[16], (bf16_t*)(p.ws + WB_OUT), (size_t)D * D, bid, nb);
    cvt_weights(p.in[21], (bf16_t*)(p.ws + WB_E1), (size_t)NEXP * D * 2 * DFF, bid, nb);
    cvt_weights(p.in[23], (bf16_t*)(p.ws + WB_E2), (size_t)NEXP * DFF * D, bid, nb);
    cvt_weights(p.in[26], (bf16_t*)(p.ws + WB_PLE), (size_t)256 * D, bid, nb);
    cvt_weights(p.in[27], (bf16_t*)(p.ws + WB_PLEG), (size_t)D * D, bid, nb);
    const float* x = p.in[0];
    const float* g = p.in[3];
    bf16_t* hb = (bf16_t*)(p.ws + WS_HB);
    for (int t = bid * 4 + wave; t < S; t += nb * 4) {
        const float4* xr = (const float4*)(x + (size_t)t * D);
        float4 v[4];
        float ss = 0.f;
#pragma unroll
        for (int j = 0; j < 4; ++j) { v[j] = xr[lane + 64 * j]; ss += v[j].x * v[j].x + v[j].y * v[j].y + v[j].z * v[j].z + v[j].w * v[j].w; }
        ss = wave_sum(ss);
        const float rstd = rsqrtf(ss * (1.f / D) + EPS);
#pragma unroll
        for (int j = 0; j < 4; ++j) {
            const float4 gg = ((const float4*)g)[lane + 64 * j];
            uint2 o;
            o.x = pk2(v[j].x * rstd * gg.x, v[j].y * rstd * gg.y);
            o.y = pk2(v[j].z * rstd * gg.z, v[j].w * rstd * gg.w);
            ((uint2*)(hb + (size_t)t * D))[lane + 64 * j] = o;
        }
    }
}

__device__ __forceinline__ void phase_inproj(const Params& p, int bid, int nb, unsigned char* smem) {
    const bf16_t* hb = (const bf16_t*)(p.ws + WS_HB);
    float* z = (float*)(p.ws + WS_Z);
    constexpr int NTN = (DIN + 127) / 128;
    for (int w = bid; w < 128 * NTN; w += nb) {
        const int mt = w % 128, nt = w / 128;
        const int m0 = mt * 128, n0 = nt * 128;
        const int ncols = (DIN - n0) < 128 ? (DIN - n0) : 128;
        f32x4 acc[4][4];
        gemm2<false, false>(hb, D, nullptr, m0, 128, (const bf16_t*)(p.ws + WB_IN), DIN, n0, ncols, D, smem, acc);
#pragma unroll
        for (int i = 0; i < 4; ++i)
#pragma unroll
            for (int r = 0; r < 4; ++r) {
                float* zr = z + (size_t)(m0 + G2_ROW(i, r)) * DIN + n0;
#pragma unroll
                for (int j = 0; j < 4; ++j) { const int c = G2_COL(j); if (c < ncols) zr[c] = acc[i][j][r]; }
            }
    }
}

__device__ __forceinline__ float rms64(float v) { return rsqrtf(wave_sum(v * v) * (1.f / 64.f) + EPS); }
__device__ __forceinline__ void phase_post(const Params& p, int bid, int nb) {
    const int lane = threadIdx.x & 63, wave = threadIdx.x >> 6;
    const float* z = (const float*)(p.ws + WS_Z);
    float* qn = (float*)(p.ws + WS_QN);
    float* ksl = (float*)(p.ws + WS_KSL);
    float* vsl = (float*)(p.ws + WS_VSL);
    float* kwn = (float*)(p.ws + WS_KWN);
    float* vwn = (float*)(p.ws + WS_VWN);
    float* gt = (float*)(p.ws + WS_GT);
    float* dqn = (float*)(p.ws + WS_DQN);
    float* dkn = (float*)(p.ws + WS_DKN);
    float* dvn = (float*)(p.ws + WS_DVN);
    float* iqs = (float*)(p.ws + WS_IQS);
    float* iks = (float*)(p.ws + WS_IKS);
    float* iws = (float*)(p.ws + WS_IWS);
    const float gqn = p.in[4][lane], gkn = p.in[5][lane], gqd = p.in[6][lane], gkd = p.in[7][lane];
    for (int t = bid * 4 + wave; t < S; t += nb * 4) {
        const float* zr = z + (size_t)t * DIN;
#pragma unroll
        for (int h = 0; h < 8; ++h) {
            const float v = zr[Z_NQ + h * 64 + lane];
            const float qv = v * rms64(v) * gqn * 0.125f;
            qn[(size_t)t * 512 + h * 64 + lane] = qv;
            ((bf16_t*)(p.ws + WS_QNB))[(size_t)t * 512 + h * 64 + lane] = (bf16_t)f2bf(qv * LOG2E);
        }
#pragma unroll
        for (int g = 0; g < 2; ++g) {
            const size_t o_ = ((size_t)g * S + t) * 64 + lane;
            float v = zr[Z_NKV + 2 * 128 + g * 64 + lane];
            v = v * rms64(v) * gkn;
            ksl[o_] = v; ((bf16_t*)(p.ws + WS_KSLB))[o_] = (bf16_t)f2bf(v);
            v = zr[Z_NKV + 3 * 128 + g * 64 + lane];
            vsl[o_] = v; ((bf16_t*)(p.ws + WS_VSLB))[o_] = (bf16_t)f2bf(v);
            v = zr[Z_NKV + 4 * 128 + g * 64 + lane];
            v = v * rms64(v) * gkn;
            kwn[o_] = v; ((bf16_t*)(p.ws + WS_KWNB))[o_] = (bf16_t)f2bf(v);
            v = zr[Z_NKV + 5 * 128 + g * 64 + lane];
            vwn[o_] = v; ((bf16_t*)(p.ws + WS_VWNB))[o_] = (bf16_t)f2bf(v);
        }
        if (lane < 24) gt[(size_t)t * 32 + lane] = sigmoidf_(zr[Z_NGATE + lane]);
#pragma unroll
        for (int h = 0; h < 8; ++h) {
            float v = zr[Z_DQ + h * 64 + lane];
            dqn[(size_t)t * 512 + h * 64 + lane] = v * rms64(v) * gqd * 0.125f;
            v = zr[Z_DK + h * 64 + lane];
            dkn[(size_t)t * 512 + h * 64 + lane] = v * rms64(v) * gkd;
            dvn[(size_t)t * 512 + h * 64 + lane] = zr[Z_DV + h * 64 + lane];
        }
#pragma unroll
        for (int j = 0; j < 4; ++j) iqs[(size_t)t * 256 + j * 64 + lane] = zr[Z_IQ + j * 64 + lane] * 0.17677669529663687f;
        if (lane < 32) iks[(size_t)t * 32 + lane] = zr[Z_IK + lane];
        if (lane < 8) iws[(size_t)t * 8 + lane] = zr[Z_IW + lane] * 0.35355339059327373f;
    }
}

__device__ __forceinline__ void phase_compress(const Params& p, int bid, int nb) {
    const int lane = threadIdx.x & 63, wave = threadIdx.x >> 6;
    const float* z = (const float*)(p.ws + WS_Z);
    float* kc = (float*)(p.ws + WS_KC);
    float* vc = (float*)(p.ws + WS_VC);
    const float gkn = p.in[5][lane];
    for (int it = bid * 4 + wave; it < NCMP * 4; it += nb * 4) {
        const int kind = it & 1, g = (it >> 1) & 1, c = it >> 2;
        const float* pe = p.in[kind ? 11 : 8];
        const float* w1 = p.in[kind ? 12 : 9];
        const float* w2 = p.in[kind ? 13 : 10];
        float acc = 0.f;
        for (int l = 0; l < 32; ++l) {
            const float* zr = z + (size_t)(16 * c + l) * DIN + Z_NKV + kind * 128 + g * 64;
            const float zin = zr[lane] + pe[l * 64 + lane];
            const float* w1l = w1 + (size_t)l * 64 * 64;
#pragma unroll 8
            for (int d = 0; d < 64; ++d) acc += __shfl(zin, d) * w1l[d * 64 + lane];
        }
        const float hid = acc * sigmoidf_(acc);
        float o = 0.f;
#pragma unroll 8
        for (int e = 0; e < 64; ++e) o += __shfl(hid, e) * w2[e * 64 + lane];
        if (kind == 0) {
            o = o * rms64(o) * gkn;
            kc[((size_t)c * 2 + g) * 64 + lane] = o;
            ((bf16_t*)(p.ws + WS_KCB))[((size_t)g * 1024 + c) * 64 + lane] = (bf16_t)f2bf(o);
        } else {
            vc[((size_t)c * 2 + g) * 64 + lane] = o;
            ((bf16_t*)(p.ws + WS_VCB))[((size_t)g * 1024 + c) * 64 + lane] = (bf16_t)f2bf(o);
        }
    }
    if (bid == 0) {
        const int tid = threadIdx.x;
        if (tid < 128) ((bf16_t*)(p.ws + WS_KCB))[((size_t)(tid >> 6) * 1024 + 1023) * 64 + (tid & 63)] = 0;
        else ((bf16_t*)(p.ws + WS_VCB))[((size_t)((tid - 128) >> 6) * 1024 + 1023) * 64 + (tid & 63)] = 0;
    }
}

__device__ __forceinline__ float dot64(const float (&q)[64], const float* kp_) {
    const float4* kp = (const float4*)kp_;
    float dsum = 0.f;
#pragma unroll
    for (int d = 0; d < 16; ++d) { const float4 kv = kp[d]; dsum += q[4 * d] * kv.x + q[4 * d + 1] * kv.y + q[4 * d + 2] * kv.z + q[4 * d + 3] * kv.w; }
    return dsum;
}
__device__ __forceinline__ void wave_softmax_lds(float* pr, int n, int npad, int lane, float mx) {
    mx = wave_max(mx);
    float sum = 0.f;
#pragma unroll 1
    for (int k = lane; k < n; k += 64) { const float v = pr[k]; const float e = (v > -1e29f) ? __expf(v - mx) : 0.f; pr[k] = e; sum += e; }
    sum = wave_sum(sum);
    const float inv = 1.f / fmaxf(sum, 1e-30f);
#pragma unroll 1
    for (int k = lane; k < npad; k += 64) pr[k] = (k < n) ? pr[k] * inv : 0.f;
}
__device__ __forceinline__ void nsa_item(const Params& p, int t, int g, unsigned char* smem) {
    const int tid = threadIdx.x, lane = tid & 63, r = tid >> 6;
    float* pl = (float*)smem;
    float* lut = pl + 4 * 1024;
    float* sc = lut + 4 * 128;
    int* sel = (int*)(sc + 256);
    const float* qn = (const float*)(p.ws + WS_QN);
    const float* kc = (const float*)(p.ws + WS_KC);
    const float* vc = (const float*)(p.ws + WS_VC);
    const float* ksl = (const float*)(p.ws + WS_KSL) + (size_t)g * S * 64;
    const float* vsl = (const float*)(p.ws + WS_VSL) + (size_t)g * S * 64;
    const float* kwn = (const float*)(p.ws + WS_KWN) + (size_t)g * S * 64;
    const float* vwn = (const float*)(p.ws + WS_VWN) + (size_t)g * S * 64;
    const float* gt = (const float*)(p.ws + WS_GT);
    const float* relb = p.in[17];
    const int h = g * 4 + r;
    __syncthreads();
    for (int i = tid; i < 512; i += NT) { const int hh = i >> 7, n = i & 127; lut[i] = relb[bucket_of(n) * 16 + g * 4 + hh]; }
    float q[64];
    {
        const float4* qp = (const float4*)(qn + (size_t)t * 512 + h * 64);
#pragma unroll
        for (int d = 0; d < 16; ++d) { const float4 v = qp[d]; q[4 * d] = v.x; q[4 * d + 1] = v.y; q[4 * d + 2] = v.z; q[4 * d + 3] = v.w; }
    }
    __syncthreads();
    const float* mylut = lut + r * 128;
    float* pr = pl + r * 1024;
    const int nv = (t >= 31) ? ((t - 31) >> 4) + 1 : 0;
    float mx = -1e30f;
#pragma unroll 1
    for (int c = lane; c < nv; c += 64) {
        int dist = t - (16 * c + 31); dist = dist > 127 ? 127 : dist;
        const float v = dot64(q, kc + ((size_t)c * 2 + g) * 64) + mylut[dist];
        pr[c] = v; mx = fmaxf(mx, v);
    }
    wave_softmax_lds(pr, nv, 1024, lane, mx);
    __syncthreads();
    float oc = 0.f;
#pragma unroll 4
    for (int c = 0; c < nv; ++c) oc += pr[c] * vc[((size_t)c * 2 + g) * 64 + lane];
    {
        const int n = tid;
        float imp = 0.f;
#pragma unroll
        for (int rr = 0; rr < 4; ++rr) {
            const float* prr = pl + rr * 1024;
            float v = prr[4 * n] + prr[4 * n + 1] + prr[4 * n + 2];
            if (4 * n + 3 < NCMP) v += 0.5f * prr[4 * n + 3];
            if (n > 0) v += 0.5f * prr[4 * n - 1];
            imp += v;
        }
        const int cur = t >> 6;
        const bool valid = n <= cur;
        const bool forced = valid && (n == 0 || n > cur - 2);
        sc[n] = forced ? __builtin_inff() : (valid ? imp : -__builtin_inff());
    }
    __syncthreads();
    {
        const int n = tid;
        const float my = sc[n];
        int rank = 0;
#pragma unroll 8
        for (int m = 0; m < 256; ++m) { const float o = sc[m]; rank += (o > my) || (o == my && m < n); }
        if (rank < 16) sel[rank] = n;
    }
    __syncthreads();
    mx = -1e30f;
#pragma unroll 1
    for (int j = 0; j < 16; ++j) {
        const int tok = sel[j] * 64 + lane;
        float v = -1e30f;
        if (tok <= t) {
            int dist = t - tok; dist = dist > 127 ? 127 : dist;
            v = dot64(q, ksl + (size_t)tok * 64) + mylut[dist];
        }
        pr[j * 64 + lane] = v; mx = fmaxf(mx, v);
    }
    wave_softmax_lds(pr, 1024, 1024, lane, mx);
    float os = 0.f;
#pragma unroll 1
    for (int j = 0; j < 16; ++j) {
        const int base = sel[j] * 64;
        if (base <= t) {
            const int lim = (t - base) < 63 ? (t - base) : 63;
#pragma unroll 4
            for (int k = 0; k <= lim; ++k) os += pr[j * 64 + k] * vsl[(size_t)(base + k) * 64 + lane];
        }
    }
    const int s0 = t - 511;
    mx = -1e30f;
#pragma unroll 1
    for (int k = lane; k < 512; k += 64) {
        const int s = s0 + k;
        float v = -1e30f;
        if (s >= 0) {
            int dist = t - s; dist = dist > 127 ? 127 : dist;
            v = dot64(q, kwn + (size_t)s * 64) + mylut[dist];
        }
        pr[k] = v; mx = fmaxf(mx, v);
    }
    wave_softmax_lds(pr, 512, 512, lane, mx);
    float ow = 0.f;
    {
        const int kb = s0 < 0 ? -s0 : 0;
#pragma unroll 4
        for (int k = kb; k < 512; ++k) ow += pr[k] * vwn[(size_t)(s0 + k) * 64 + lane];
    }
    const float g0 = gt[(size_t)t * 32 + h * 3 + 0], g1 = gt[(size_t)t * 32 + h * 3 + 1], g2 = gt[(size_t)t * 32 + h * 3 + 2];
    const float o = g0 * oc + g1 * os + g2 * ow;
    ((bf16_t*)(p.ws + WS_OA))[(size_t)t * 512 + h * 64 + lane] = (bf16_t)f2bf(o);
}


constexpr int KSTR = 72;
constexpr int NSA_KT = 0;
constexpr int NSA_VT = NSA_KT + 32 * KSTR * 2;
constexpr int NSA_WV = NSA_VT + 32 * KSTR * 2;
constexpr int NSA_IMP = NSA_WV + 4 * 32 * KSTR * 2;
constexpr int NSA_LUT = NSA_IMP + 16 * 260 * 4;
constexpr int NSA_SEL = NSA_LUT + 4 * 128 * 4;
constexpr int NSA_END = NSA_SEL + 16 * 16 * 4;
static_assert(NSA_END <= SMEM_BYTES, "nsa lds");

__device__ __forceinline__ f32x4 mfma16(bf16x8 a, bf16x8 b, f32x4 c) { return __builtin_amdgcn_mfma_f32_16x16x32_bf16(a, b, c, 0, 0, 0); }
__device__ __forceinline__ bf16x8 pack_p(const f32x4& p1, const f32x4& p2) {
    const unsigned a = pk2(p1[0], p1[1]), b = pk2(p1[2], p1[3]), c = pk2(p2[0], p2[1]), d = pk2(p2[2], p2[3]);
    return __builtin_bit_cast(bf16x8, make_uint4(a, b, c, d));
}
__device__ __forceinline__ void pv_step(f32x4 (&o)[4], const bf16_t* vt, bf16x8 pb, int fq, int fr) {
    const bf16_t* base = vt + (4 * fq + (fr >> 2)) * KSTR + 4 * (fr & 3);
#pragma unroll
    for (int dt = 0; dt < 4; ++dt) {
        const s16x4 lo4 = lds_tr16(base + dt * 16), hi4 = lds_tr16(base + 16 * KSTR + dt * 16);
        const bf16x8 va = (bf16x8){lo4[0], lo4[1], lo4[2], lo4[3], hi4[0], hi4[1], hi4[2], hi4[3]};
        o[dt] = mfma16(va, pb, o[dt]);
    }
}
__device__ __forceinline__ float quad_sum(float v) {
    v += __shfl_xor(v, 1);
    v += __shfl_xor(v, 2);
    return v;
}

__device__ __forceinline__ void nsa_tile(const Params& p, int tt, int g, unsigned char* smem) {
    const int tid = threadIdx.x, lane = tid & 63, wave = tid >> 6, fr = lane & 15, fq = lane >> 4;
    bf16_t* kt = (bf16_t*)(smem + NSA_KT);
    bf16_t* vt = (bf16_t*)(smem + NSA_VT);
    bf16_t* wv = (bf16_t*)(smem + NSA_WV) + wave * 32 * KSTR;
    float* imp = (float*)(smem + NSA_IMP);
    float* lut = (float*)(smem + NSA_LUT);
    int* sel = (int*)(smem + NSA_SEL);
    const bf16_t* qnb = (const bf16_t*)(p.ws + WS_QNB);
    const bf16_t* kslb = (const bf16_t*)(p.ws + WS_KSLB) + (size_t)g * S * 64;
    const bf16_t* vslb = (const bf16_t*)(p.ws + WS_VSLB) + (size_t)g * S * 64;
    const bf16_t* kwnb = (const bf16_t*)(p.ws + WS_KWNB) + (size_t)g * S * 64;
    const bf16_t* vwnb = (const bf16_t*)(p.ws + WS_VWNB) + (size_t)g * S * 64;
    const bf16_t* kcb = (const bf16_t*)(p.ws + WS_KCB) + (size_t)g * 1024 * 64;
    const bf16_t* vcb = (const bf16_t*)(p.ws + WS_VCB) + (size_t)g * 1024 * 64;
    const float* gt = (const float*)(p.ws + WS_GT);
    const float* relb = p.in[17];
    const int t0 = tt * 16;
    const int tl = 4 * wave + (fr >> 2);
    const int tok = t0 + tl;
    const int hl = fr & 3, head = g * 4 + hl;
    __syncthreads();
    for (int i = tid; i < 512; i += NT) { const int hh = i >> 7, n = i & 127; lut[i] = relb[bucket_of(n) * 16 + g * 4 + hh] * LOG2E; }
    for (int i = tid; i < 16 * 260; i += NT) imp[i] = 0.f;
    float U2;
    {
        const float mq = wave_max(fabsf(p.in[4][lane])), mk = wave_max(fabsf(p.in[5][lane]));
        float mb = 0.f;
#pragma unroll
        for (int k = 0; k < 4; ++k) { const int e = lane + 64 * k; mb = fmaxf(mb, fabsf(relb[(e >> 3) * 16 + (e & 7)])); }
        mb = wave_max(mb);
        U2 = (8.f * mq * mk + mb) * LOG2E;
    }
    bf16x8 qf[2];
#pragma unroll
    for (int kh = 0; kh < 2; ++kh) qf[kh] = *(const bf16x8*)(qnb + (size_t)tok * 512 + head * 64 + kh * 32 + fq * 8);
    __syncthreads();
    const float* lutp = lut + hl * 128;
    const float lutfar = lutp[127];
    const f32x4 zero4 = (f32x4){0.f, 0.f, 0.f, 0.f};
    f32x4 outacc[4];
#pragma unroll
    for (int dt = 0; dt < 4; ++dt) outacc[dt] = zero4;
    const float g0 = gt[(size_t)tok * 32 + head * 3 + 0], g1 = gt[(size_t)tok * 32 + head * 3 + 1], g2 = gt[(size_t)tok * 32 + head * 3 + 2];
    const int srow = tid >> 3, sch = tid & 7;

    {
        int ks0 = (t0 - 511) & ~31; ks0 = ks0 < 0 ? 0 : ks0;
        const int nsteps = (t0 + 16 - ks0 + 31) >> 5;
        f32x4 o[4];
#pragma unroll
        for (int dt = 0; dt < 4; ++dt) o[dt] = zero4;
        float lsum = 0.f;
        uint4 kreg = *(const uint4*)(kwnb + (size_t)(ks0 + srow) * 64 + sch * 8);
        uint4 vreg = *(const uint4*)(vwnb + (size_t)(ks0 + srow) * 64 + sch * 8);
#pragma unroll 1
        for (int st = 0; st < nsteps; ++st) {
            const int ks = ks0 + st * 32;
            *(uint4*)(kt + srow * KSTR + sch * 8) = kreg;
            *(uint4*)(vt + srow * KSTR + sch * 8) = vreg;
            __syncthreads();
            if (st + 1 < nsteps) {
                kreg = *(const uint4*)(kwnb + (size_t)(ks + 32 + srow) * 64 + sch * 8);
                vreg = *(const uint4*)(vwnb + (size_t)(ks + 32 + srow) * 64 + sch * 8);
            }
            f32x4 s1 = zero4, s2 = zero4;
#pragma unroll
            for (int kh = 0; kh < 2; ++kh) {
                const bf16x8 k1 = *(const bf16x8*)(kt + fr * KSTR + kh * 32 + fq * 8);
                const bf16x8 k2 = *(const bf16x8*)(kt + (16 + fr) * KSTR + kh * 32 + fq * 8);
                s1 = mfma16(k1, qf[kh], s1);
                s2 = mfma16(k2, qf[kh], s2);
            }
            const bool far = (t0 + 4 * wave) - (ks + 31) >= 113;
            f32x4 p1, p2;
#pragma unroll
            for (int r = 0; r < 4; ++r) {
                const int d1 = tok - (ks + 4 * fq + r), d2 = d1 - 16;
                const float b1 = far ? lutfar : lutp[d1 < 0 ? 0 : (d1 > 127 ? 127 : d1)];
                const float b2 = far ? lutfar : lutp[d2 < 0 ? 0 : (d2 > 127 ? 127 : d2)];
                p1[r] = (d1 >= 0 && d1 < 512) ? __builtin_amdgcn_exp2f(s1[r] + b1 - U2) : 0.f;
                p2[r] = (d2 >= 0 && d2 < 512) ? __builtin_amdgcn_exp2f(s2[r] + b2 - U2) : 0.f;
                lsum += p1[r] + p2[r];
            }
            pv_step(o, vt, pack_p(p1, p2), fq, fr);
            __syncthreads();
        }
        lsum += __shfl_xor(lsum, 16);
        lsum += __shfl_xor(lsum, 32);
        const float sc = lsum > 0.f ? g2 / lsum : 0.f;
#pragma unroll
        for (int dt = 0; dt < 4; ++dt)
#pragma unroll
            for (int r = 0; r < 4; ++r) outacc[dt][r] += sc * o[dt][r];
    }

    {
        const int tlast = t0 + 15;
        const int cmax = (tlast >= 31) ? ((tlast - 31) >> 4) + 1 : 0;
        const int nsteps = (cmax + 31) >> 5;
        float inv_l = 0.f;
#pragma unroll 1
        for (int pass = 0; pass < 2; ++pass) {
            f32x4 o[4];
#pragma unroll
            for (int dt = 0; dt < 4; ++dt) o[dt] = zero4;
            float lsum = 0.f;
            uint4 kreg = make_uint4(0, 0, 0, 0), vreg = kreg;
            if (nsteps > 0) {
                kreg = *(const uint4*)(kcb + (size_t)srow * 64 + sch * 8);
                vreg = *(const uint4*)(vcb + (size_t)srow * 64 + sch * 8);
            }
#pragma unroll 1
            for (int st = 0; st < nsteps; ++st) {
                const int cs = st * 32;
                *(uint4*)(kt + srow * KSTR + sch * 8) = kreg;
                *(uint4*)(vt + srow * KSTR + sch * 8) = vreg;
                __syncthreads();
                if (st + 1 < nsteps) {
                    kreg = *(const uint4*)(kcb + (size_t)(cs + 32 + srow) * 64 + sch * 8);
                    vreg = *(const uint4*)(vcb + (size_t)(cs + 32 + srow) * 64 + sch * 8);
                }
                f32x4 s1 = zero4, s2 = zero4;
#pragma unroll
                for (int kh = 0; kh < 2; ++kh) {
                    const bf16x8 k1 = *(const bf16x8*)(kt + fr * KSTR + kh * 32 + fq * 8);
                    const bf16x8 k2 = *(const bf16x8*)(kt + (16 + fr) * KSTR + kh * 32 + fq * 8);
                    s1 = mfma16(k1, qf[kh], s1);
                    s2 = mfma16(k2, qf[kh], s2);
                }
                const bool far = (t0 + 4 * wave) - (16 * (cs + 31) + 31) >= 113;
                f32x4 p1, p2;
#pragma unroll
                for (int r = 0; r < 4; ++r) {
                    const int d1 = tok - (16 * (cs + 4 * fq + r) + 31), d2 = d1 - 256;
                    const float b1 = far ? lutfar : lutp[d1 < 0 ? 0 : (d1 > 127 ? 127 : d1)];
                    const float b2 = far ? lutfar : lutp[d2 < 0 ? 0 : (d2 > 127 ? 127 : d2)];
                    p1[r] = (d1 >= 0) ? __builtin_amdgcn_exp2f(s1[r] + b1 - U2) : 0.f;
                    p2[r] = (d2 >= 0) ? __builtin_amdgcn_exp2f(s2[r] + b2 - U2) : 0.f;
                    lsum += p1[r] + p2[r];
                }
                if (pass == 1) {
#pragma unroll
                    for (int r = 0; r < 4; ++r) { p1[r] *= inv_l; p2[r] *= inv_l; }
                    f32x4 h1, h2;
#pragma unroll
                    for (int r = 0; r < 4; ++r) { h1[r] = quad_sum(p1[r]); h2[r] = quad_sum(p2[r]); }
                    if (hl == 0) {
                        float* ir = imp + tl * 260 + (cs >> 2) + fq;
                        atomicAdd(ir, h1[0] + h1[1] + h1[2] + 0.5f * h1[3]);
                        atomicAdd(ir + 1, 0.5f * h1[3]);
                        atomicAdd(ir + 4, h2[0] + h2[1] + h2[2] + 0.5f * h2[3]);
                        atomicAdd(ir + 5, 0.5f * h2[3]);
                    }
                    pv_step(o, vt, pack_p(p1, p2), fq, fr);
                }
                __syncthreads();
            }
            if (pass == 0) {
                lsum += __shfl_xor(lsum, 16);
                lsum += __shfl_xor(lsum, 32);
                inv_l = lsum > 0.f ? 1.f / lsum : 0.f;
            } else {
#pragma unroll
                for (int dt = 0; dt < 4; ++dt)
#pragma unroll
                    for (int r = 0; r < 4; ++r) outacc[dt][r] += g0 * o[dt][r];
            }
        }
    }
    __syncthreads();

#pragma unroll 1
    for (int tq = 0; tq < 4; ++tq) {
        const int tli = 4 * wave + tq, tk = t0 + tli, cur = tk >> 6;
        int* sl = sel + tli * 16;
        int nf = 0;
        if (lane == 0) {
            sl[0] = 0; int c_ = 1;
            if (cur - 1 >= 1) sl[c_++] = cur - 1;
            if (cur >= 1) sl[c_++] = cur;
            for (int k = c_; k < 16; ++k) sl[k] = -1;
        }
        nf = 1 + (cur - 1 >= 1 ? 1 : 0) + (cur >= 1 ? 1 : 0);
        const int ncand = cur - 2 > 0 ? cur - 2 : 0;
        int need = 16 - nf; need = need < ncand ? need : ncand;
        unsigned long long key[4];
#pragma unroll
        for (int k = 0; k < 4; ++k) {
            const int n = lane + 64 * k;
            const bool c = (n >= 1) && (n <= cur - 2);
            key[k] = c ? (((unsigned long long)__builtin_bit_cast(unsigned, imp[tli * 260 + n]) << 32) | (unsigned long long)(0xFFFFFFFFu - (unsigned)n)) + (1ull << 32) : 0ull;
        }
#pragma unroll 1
        for (int rd = 0; rd < need; ++rd) {
            unsigned long long m = key[0];
            m = key[1] > m ? key[1] : m; m = key[2] > m ? key[2] : m; m = key[3] > m ? key[3] : m;
#pragma unroll
            for (int o_ = 1; o_ < 64; o_ <<= 1) {
                const unsigned lo_ = __shfl_xor((unsigned)m, o_), hi_ = __shfl_xor((unsigned)(m >> 32), o_);
                const unsigned long long other = ((unsigned long long)hi_ << 32) | lo_;
                m = other > m ? other : m;
            }
            const int nstar = (int)(0xFFFFFFFFu - (unsigned)m);
#pragma unroll
            for (int k = 0; k < 4; ++k) if (key[k] == m) key[k] = 0ull;
            if (lane == 0) sl[nf + rd] = nstar;
        }
    }
    __syncthreads();

    {
        f32x4 o[4];
#pragma unroll
        for (int dt = 0; dt < 4; ++dt) o[dt] = zero4;
        float lsum = 0.f;
        const int vrow = lane >> 1, vhalf = lane & 1;
#pragma unroll 1
        for (int tq = 0; tq < 4; ++tq) {
            const int tli = 4 * wave + tq, tk = t0 + tli;
            const bool mine = (fr >> 2) == tq;
#pragma unroll 1
            for (int j = 0; j < 16; ++j) {
                const int b = __builtin_amdgcn_readfirstlane(sel[tli * 16 + j]);
                if (b < 0) continue;
                const int base = b * 64;
#pragma unroll 1
                for (int hf = 0; hf < 2; ++hf) {
                    const int ks = base + 32 * hf;
                    if (ks > tk) break;
                    bf16x8 k1[2], k2[2];
#pragma unroll
                    for (int kh = 0; kh < 2; ++kh) {
                        k1[kh] = *(const bf16x8*)(kslb + (size_t)(ks + fr) * 64 + kh * 32 + fq * 8);
                        k2[kh] = *(const bf16x8*)(kslb + (size_t)(ks + 16 + fr) * 64 + kh * 32 + fq * 8);
                    }
                    const uint4* vsrc = (const uint4*)(vslb + (size_t)(ks + vrow) * 64 + vhalf * 32);
                    const uint4 v0 = vsrc[0], v1 = vsrc[1], v2 = vsrc[2], v3 = vsrc[3];
                    uint4* vdst = (uint4*)(wv + vrow * KSTR + vhalf * 32);
                    vdst[0] = v0; vdst[1] = v1; vdst[2] = v2; vdst[3] = v3;
                    f32x4 s1 = zero4, s2 = zero4;
#pragma unroll
                    for (int kh = 0; kh < 2; ++kh) { s1 = mfma16(k1[kh], qf[kh], s1); s2 = mfma16(k2[kh], qf[kh], s2); }
                    const bool far = tk - (ks + 31) >= 113;
                    f32x4 p1, p2;
#pragma unroll
                    for (int r = 0; r < 4; ++r) {
                        const int d1 = tk - (ks + 4 * fq + r), d2 = d1 - 16;
                        const float b1 = far ? lutfar : lutp[d1 < 0 ? 0 : (d1 > 127 ? 127 : d1)];
                        const float b2 = far ? lutfar : lutp[d2 < 0 ? 0 : (d2 > 127 ? 127 : d2)];
                        p1[r] = (mine && d1 >= 0) ? __builtin_amdgcn_exp2f(s1[r] + b1 - U2) : 0.f;
                        p2[r] = (mine && d2 >= 0) ? __builtin_amdgcn_exp2f(s2[r] + b2 - U2) : 0.f;
                        lsum += p1[r] + p2[r];
                    }
                    asm volatile("" ::: "memory");
                    pv_step(o, wv, pack_p(p1, p2), fq, fr);
                    asm volatile("" ::: "memory");
                }
            }
        }
        lsum += __shfl_xor(lsum, 16);
        lsum += __shfl_xor(lsum, 32);
        const float sc = lsum > 0.f ? g1 / lsum : 0.f;
#pragma unroll
        for (int dt = 0; dt < 4; ++dt)
#pragma unroll
            for (int r = 0; r < 4; ++r) outacc[dt][r] += sc * o[dt][r];
    }
    bf16_t* orow = (bf16_t*)(p.ws + WS_OA) + (size_t)tok * 512 + head * 64 + 4 * fq;
#pragma unroll
    for (int dt = 0; dt < 4; ++dt) {
        uint2 v; v.x = pk2(outacc[dt][0], outacc[dt][1]); v.y = pk2(outacc[dt][2], outacc[dt][3]);
        *(uint2*)(orow + dt * 16) = v;
    }
}

__device__ __forceinline__ void dsa_item(const Params& p, int t, unsigned char* smem) {
    const int tid = threadIdx.x, lane = tid & 63, wave = tid >> 6;
    unsigned* keys = (unsigned*)smem;
    float* pbuf = (float*)smem;
    unsigned* hist = keys + 16384;
    int* sel = (int*)(hist + 256);
    float* qi = (float*)(sel + 256);
    float* lut = qi + 256;
    float* wi = lut + 1024;
    int* misc = (int*)(wi + 8);
    const float* iqs = (const float*)(p.ws + WS_IQS);
    const float* iks = (const float*)(p.ws + WS_IKS);
    const float* iws = (const float*)(p.ws + WS_IWS);
    const float* dqn = (const float*)(p.ws + WS_DQN);
    const float* dkn = (const float*)(p.ws + WS_DKN);
    const float* dvn = (const float*)(p.ws + WS_DVN);
    const float* relb = p.in[17];
    __syncthreads();
    qi[tid] = iqs[(size_t)t * 256 + tid];
    if (tid < 8) wi[tid] = iws[(size_t)t * 8 + tid];
    for (int i = tid; i < 1024; i += NT) { const int hh = i >> 7, n = i & 127; lut[i] = relb[bucket_of(n) * 16 + 8 + hh]; }
    if (tid == 0) misc[0] = 0;
    __syncthreads();
    const int n = t + 1;
    int nsel;
    if (n <= 256) {
        if (tid < n) sel[tid] = tid;
        nsel = n;
    } else {
#pragma unroll 1
        for (int s = tid; s < n; s += NT) {
            asm volatile("" ::: "memory");
            const float4* kp = (const float4*)(iks + (size_t)s * 32);
            float kk[32];
#pragma unroll
            for (int d = 0; d < 8; ++d) { const float4 v = kp[d]; kk[4 * d] = v.x; kk[4 * d + 1] = v.y; kk[4 * d + 2] = v.z; kk[4 * d + 3] = v.w; }
            float score = 0.f;
#pragma unroll
            for (int hh = 0; hh < 8; ++hh) {
                float dsum = 0.f;
#pragma unroll
                for (int d = 0; d < 32; ++d) dsum += qi[hh * 32 + d] * kk[d];
                score += wi[hh] * fmaxf(dsum, 0.f);
            }
            score += 0.0f;
            const unsigned u = __builtin_bit_cast(unsigned, score);
            keys[s] = (u & 0x80000000u) ? ~u : (u | 0x80000000u);
        }
        unsigned prefix = 0, mask = 0;
        int need = 256;
#pragma unroll 1
        for (int pass = 3; pass >= 0; --pass) {
            hist[tid] = 0;
            __syncthreads();
#pragma unroll 1
            for (int s = tid; s < n; s += NT) { const unsigned k = keys[s]; if ((k & mask) == prefix) atomicAdd(&hist[(k >> (8 * pass)) & 255u], 1u); }
            __syncthreads();
            {
                unsigned above = 0;
                for (int b = tid + 1; b < 256; ++b) above += hist[b];
                const unsigned mine = hist[tid];
                if ((int)above < need && (int)(above + mine) >= need) { misc[1] = tid; misc[2] = need - (int)above; misc[3] = (int)mine; }
            }
            __syncthreads();
            prefix |= (unsigned)misc[1] << (8 * pass);
            mask |= 0xFFu << (8 * pass);
            need = misc[2];
            __syncthreads();
        }
        const unsigned T = prefix;
        const int ties = misc[3];
        if (ties == need) {
#pragma unroll 1
            for (int s = tid; s < n; s += NT) { const unsigned k = keys[s]; if (k >= T) { const int pos = atomicAdd(&misc[0], 1); sel[pos] = s; } }
        } else {
#pragma unroll 1
            for (int s = tid; s < n; s += NT) { const unsigned k = keys[s]; if (k > T) { const int pos = atomicAdd(&misc[0], 1); sel[pos] = s; } }
            __syncthreads();
            if (tid == 0) {
                int pos = misc[0], got = 0;
                for (int s = 0; s < n && got < need; ++s) if (keys[s] == T) { sel[pos++] = s; ++got; }
            }
        }
        nsel = 256;
    }
    __syncthreads();
#pragma unroll 1
    for (int hh = wave * 2; hh < wave * 2 + 2; ++hh) {
        float q[64];
        {
            const float4* qp = (const float4*)(dqn + (size_t)t * 512 + hh * 64);
#pragma unroll
            for (int d = 0; d < 16; ++d) { const float4 v = qp[d]; q[4 * d] = v.x; q[4 * d + 1] = v.y; q[4 * d + 2] = v.z; q[4 * d + 3] = v.w; }
        }
        float* pr = pbuf + hh * 256;
        float mx = -1e30f;
#pragma unroll 1
        for (int k = lane; k < nsel; k += 64) {
            const int s = sel[k];
            int dist = t - s; dist = dist > 127 ? 127 : dist;
            const float v = dot64(q, dkn + (size_t)s * 512 + hh * 64) + lut[hh * 128 + dist];
            pr[k] = v; mx = fmaxf(mx, v);
        }
        wave_softmax_lds(pr, nsel, nsel, lane, mx);
        float o = 0.f;
#pragma unroll 4
        for (int k = 0; k < nsel; ++k) o += pr[k] * dvn[(size_t)sel[k] * 512 + hh * 64 + lane];
        ((bf16_t*)(p.ws + WS_OB))[(size_t)t * 512 + hh * 64 + lane] = (bf16_t)f2bf(o);
    }
}

__device__ __forceinline__ void phase_attn(const Params& p, int bid, int nb, unsigned char* smem) {
    for (int w = bid; w < S + 2048; w += nb) {
        if (w < S) dsa_item(p, S - 1 - w, smem);
        else { const int i = w - S; nsa_tile(p, 1023 - (i >> 1), i & 1, smem); }
    }
}

template <int PASS>
__device__ __forceinline__ void phase_merge(const Params& p, int bid, int nb, unsigned char* smem) {
    const float* z = (const float*)(p.ws + WS_Z);
    bf16_t* merged = (bf16_t*)(p.ws + WS_MERGED);
    float* tmp = (float*)(p.ws + WS_X1);
    const bf16_t* A = (const bf16_t*)(p.ws + (PASS ? WS_OB : WS_OA));
    const bf16_t* Bw = (const bf16_t*)(p.ws + (PASS ? WB_B : WB_A));
    constexpr int zoff = PASS ? Z_GB : Z_GA;
    for (int w = bid; w < 128 * 8; w += nb) {
        const int mt = w % 128, nt = w / 128;
        const int m0 = mt * 128, n0 = nt * 128;
        f32x4 acc[4][4];
        gemm2<false, false>(A, 512, nullptr, m0, 128, Bw, D, n0, 128, 512, smem, acc);
#pragma unroll
        for (int i = 0; i < 4; ++i)
#pragma unroll
            for (int r = 0; r < 4; ++r) {
                const int row = m0 + G2_ROW(i, r);
                const float* zr = z + (size_t)row * DIN + zoff + n0 + G2_COL(0);
                float* tr = tmp + (size_t)row * D + n0 + G2_COL(0);
                bf16_t* mr = merged + (size_t)row * D + n0 + G2_COL(0);
#pragma unroll
                for (int j = 0; j < 4; ++j) {
                    const float v = sigmoidf_(zr[j * 16]) * acc[i][j][r];
                    if (PASS == 0) tr[j * 16] = v;
                    else mr[j * 16] = (bf16_t)f2bf(tr[j * 16] + v);
                }
            }
    }
}

__device__ __forceinline__ void phase_outproj(const Params& p, int bid, int nb, unsigned char* smem) {
    const bf16_t* merged = (const bf16_t*)(p.ws + WS_MERGED);
    const float* x = p.in[0];
    float* x1 = (float*)(p.ws + WS_X1);
    for (int w = bid; w < 128 * 8; w += nb) {
        const int mt = w % 128, nt = w / 128;
        const int m0 = mt * 128, n0 = nt * 128;
        f32x4 acc[4][4];
        gemm2<false, false>(merged, D, nullptr, m0, 128, (const bf16_t*)(p.ws + WB_OUT), D, n0, 128, D, smem, acc);
#pragma unroll
        for (int i = 0; i < 4; ++i)
#pragma unroll
            for (int r = 0; r < 4; ++r) {
                const size_t ro = (size_t)(m0 + G2_ROW(i, r)) * D + n0;
#pragma unroll
                for (int j = 0; j < 4; ++j) { const int c = G2_COL(j); x1[ro + c] = x[ro + c] + acc[i][j][r]; }
            }
    }
}

__device__ __forceinline__ void phase_route(const Params& p, int bid, int nb) {
    const int lane = threadIdx.x & 63, wave = threadIdx.x >> 6;
    const float* x1 = (const float*)(p.ws + WS_X1);
    const float* g = p.in[18];
    const float* wr = p.in[19];
    const float* br = p.in[20];
    bf16_t* hb = (bf16_t*)(p.ws + WS_HB);
    int* topi = (int*)(p.ws + WS_TOPI);
    float* topw = (float*)(p.ws + WS_TOPW);
    int* cnt = (int*)(p.ws + WS_CTL);
    for (int t = bid * 4 + wave; t < S; t += nb * 4) {
        const float4* xr = (const float4*)(x1 + (size_t)t * D);
        float4 v[4];
        float ss = 0.f;
#pragma unroll
        for (int j = 0; j < 4; ++j) { v[j] = xr[lane + 64 * j]; ss += v[j].x * v[j].x + v[j].y * v[j].y + v[j].z * v[j].z + v[j].w * v[j].w; }
        ss = wave_sum(ss);
        const float rstd = rsqrtf(ss * (1.f / D) + EPS);
        float lg[32];
#pragma unroll
        for (int e = 0; e < 32; ++e) lg[e] = 0.f;
#pragma unroll
        for (int j = 0; j < 4; ++j) {
            const float4 gg = ((const float4*)g)[lane + 64 * j];
            const float h0 = v[j].x * rstd * gg.x, h1 = v[j].y * rstd * gg.y, h2 = v[j].z * rstd * gg.z, h3 = v[j].w * rstd * gg.w;
            uint2 o; o.x = pk2(h0, h1); o.y = pk2(h2, h3);
            ((uint2*)(hb + (size_t)t * D))[lane + 64 * j] = o;
            const int k = 4 * (lane + 64 * j);
            const float4* w0 = (const float4*)(wr + (size_t)k * 32);
#pragma unroll
            for (int e4 = 0; e4 < 8; ++e4) {
                const float4 a = w0[e4], b = w0[8 + e4], c = w0[16 + e4], d = w0[24 + e4];
                lg[4 * e4 + 0] += h0 * a.x + h1 * b.x + h2 * c.x + h3 * d.x;
                lg[4 * e4 + 1] += h0 * a.y + h1 * b.y + h2 * c.y + h3 * d.y;
                lg[4 * e4 + 2] += h0 * a.z + h1 * b.z + h2 * c.z + h3 * d.z;
                lg[4 * e4 + 3] += h0 * a.w + h1 * b.w + h2 * c.w + h3 * d.w;
            }
        }
#pragma unroll
        for (int e = 0; e < 32; ++e) lg[e] = wave_sum(lg[e]) + br[e];
        int idx[4]; float val[4];
        unsigned used = 0;
#pragma unroll
        for (int k = 0; k < 4; ++k) {
            float best = -__builtin_inff(); int bi = 0;
#pragma unroll
            for (int e = 0; e < 32; ++e) { const bool ok = !((used >> e) & 1u) && (lg[e] > best); best = ok ? lg[e] : best; bi = ok ? e : bi; }
            idx[k] = bi; val[k] = best; used |= 1u << bi;
        }
        const float e0 = 1.f, e1 = __expf(val[1] - val[0]), e2 = __expf(val[2] - val[0]), e3 = __expf(val[3] - val[0]);
        const float inv = 1.f / (e0 + e1 + e2 + e3);
        if (lane == 0) {
            topi[t * 4 + 0] = idx[0]; topi[t * 4 + 1] = idx[1]; topi[t * 4 + 2] = idx[2]; topi[t * 4 + 3] = idx[3];
            topw[t * 4 + 0] = e0 * inv; topw[t * 4 + 1] = e1 * inv; topw[t * 4 + 2] = e2 * inv; topw[t * 4 + 3] = e3 * inv;
            atomicAdd(&cnt[idx[0]], 1); atomicAdd(&cnt[idx[1]], 1); atomicAdd(&cnt[idx[2]], 1); atomicAdd(&cnt[idx[3]], 1);
        }
    }
}

__device__ __forceinline__ void phase_place(const Params& p, int bid, int nb, unsigned char* smem) {
    int* off = (int*)smem;
    const int* cnt = (const int*)(p.ws + WS_CTL);
    int* cur = (int*)(p.ws + WS_CTL) + 32;
    const int* topi = (const int*)(p.ws + WS_TOPI);
    int* ppos = (int*)(p.ws + WS_PPOS);
    int* rowtok = (int*)(p.ws + WS_ROWTOK);
    __syncthreads();
    if (threadIdx.x == 0) { int a = 0; for (int e = 0; e < NEXP; ++e) { off[e] = a; a += cnt[e]; } }
    __syncthreads();
    for (int i = bid * NT + threadIdx.x; i < S * 4; i += nb * NT) {
        const int e = topi[i];
        const int pos = off[e] + atomicAdd(&cur[e], 1);
        ppos[i] = pos;
        rowtok[pos] = i >> 2;
    }
}

__device__ __forceinline__ void moe_tile_map(const int* cnt, int* sm, int& total_mt) {
    __syncthreads();
    if (threadIdx.x == 0) {
        int a = 0, b = 0;
        for (int e = 0; e < NEXP; ++e) { sm[e] = a; sm[33 + e] = b; a += (cnt[e] + 127) >> 7; b += cnt[e]; }
        sm[32] = a; sm[65] = b;
    }
    __syncthreads();
    total_mt = sm[32];
}
__device__ __forceinline__ void phase_moe1(const Params& p, int bid, int nb, unsigned char* smem) {
    int* sm = (int*)(smem + 65536);
    const int* cnt = (const int*)(p.ws + WS_CTL);
    const int* rowtok = (const int*)(p.ws + WS_ROWTOK);
    const bf16_t* hb = (const bf16_t*)(p.ws + WS_HB);
    bf16_t* act = (bf16_t*)(p.ws + WS_ACT);
    const int lane = threadIdx.x & 63, wave = threadIdx.x >> 6;
    int total_mt;
    moe_tile_map(cnt, sm, total_mt);
    for (int w = bid; w < total_mt * 16; w += nb) {
        const int tm = w >> 4, nt = w & 15;
        int e = 0;
        while (e < NEXP - 1 && sm[e + 1] <= tm) ++e;
        const int mt = tm - sm[e];
        const int rbase = sm[33 + e] + mt * 128;
        const int mrows = min(128, cnt[e] - mt * 128);
        const int n0 = nt * 64;
        f32x4 acc[4][4];
        gemm2<true, true>(hb, D, rowtok, rbase, mrows, (const bf16_t*)(p.ws + WB_E1) + (size_t)e * D * 2 * DFF, 2 * DFF, n0, 128, D, smem, acc);
        const float* b1 = p.in[22] + (size_t)e * 2 * DFF;
        const int wn_ = (threadIdx.x >> 6) & 1;
#pragma unroll
        for (int i = 0; i < 4; ++i)
#pragma unroll
            for (int jp = 0; jp < 2; ++jp) {
                const int col = n0 + (wn_ * 2 + jp) * 16 + (threadIdx.x & 15);
                const float bg = b1[col], bl = b1[DFF + col];
#pragma unroll
                for (int r = 0; r < 4; ++r) {
                    const int rl = G2_ROW(i, r);
                    if (rl < mrows) {
                        const float gate = fminf(acc[i][2 * jp][r] + bg, 7.f);
                        const float lin = fminf(fmaxf(acc[i][2 * jp + 1][r] + bl, -7.f), 7.f);
                        const float a_ = (lin + 1.f) * gate * sigmoidf_(1.702f * gate);
                        act[(size_t)(rbase + rl) * DFF + col] = (bf16_t)f2bf(a_);
                    }
                }
            }
    }
}
__device__ __forceinline__ void phase_moe2(const Params& p, int bid, int nb, unsigned char* smem) {
    int* sm = (int*)(smem + 65536);
    const int* cnt = (const int*)(p.ws + WS_CTL);
    const bf16_t* act = (const bf16_t*)(p.ws + WS_ACT);
    float* yrows = (float*)(p.ws + WS_YROWS);
    const int lane = threadIdx.x & 63, wave = threadIdx.x >> 6;
    int total_mt;
    moe_tile_map(cnt, sm, total_mt);
    for (int w = bid; w < total_mt * 8; w += nb) {
        const int tm = w >> 3, nt = w & 7;
        int e = 0;
        while (e < NEXP - 1 && sm[e + 1] <= tm) ++e;
        const int mt = tm - sm[e];
        const int rbase = sm[33 + e] + mt * 128;
        const int mrows = min(128, cnt[e] - mt * 128);
        const int n0 = nt * 128;
        f32x4 acc[4][4];
        gemm2<false, false>(act, DFF, nullptr, rbase, mrows, (const bf16_t*)(p.ws + WB_E2) + (size_t)e * DFF * D, D, n0, 128, DFF, smem, acc);
        const float* b2 = p.in[24] + (size_t)e * D + n0;
#pragma unroll
        for (int i = 0; i < 4; ++i)
#pragma unroll
            for (int r = 0; r < 4; ++r) {
                const int rl = G2_ROW(i, r);
                if (rl < mrows) {
                    float* yr = yrows + (size_t)(rbase + rl) * D + n0;
#pragma unroll
                    for (int j = 0; j < 4; ++j) { const int c = G2_COL(j); yr[c] = acc[i][j][r] + b2[c]; }
                }
            }
    }
}

__device__ __forceinline__ void phase_combine(const Params& p, int bid, int nb) {
    const int lane = threadIdx.x & 63, wave = threadIdx.x >> 6;
    const float* x1 = (const float*)(p.ws + WS_X1);
    const float* yrows = (const float*)(p.ws + WS_YROWS);
    const int* ppos = (const int*)(p.ws + WS_PPOS);
    const float* topw = (const float*)(p.ws + WS_TOPW);
    const float* g = p.in[25];
    bf16_t* hb = (bf16_t*)(p.ws + WS_HB);
    bf16_t* pb = (bf16_t*)(p.ws + WS_PB);
    for (int t = bid * 4 + wave; t < S; t += nb * 4) {
        {
            const float4 pv = ((const float4*)(p.in[1] + (size_t)t * 256))[lane];
            uint2 o; o.x = pk2(pv.x, pv.y); o.y = pk2(pv.z, pv.w);
            ((uint2*)(pb + (size_t)t * 256))[lane] = o;
        }
        float4 v[4];
#pragma unroll
        for (int j = 0; j < 4; ++j) v[j] = ((const float4*)(x1 + (size_t)t * D))[lane + 64 * j];
#pragma unroll
        for (int k = 0; k < 4; ++k) {
            const float wk = topw[t * 4 + k];
            const float4* yr = (const float4*)(yrows + (size_t)ppos[t * 4 + k] * D);
#pragma unroll
            for (int j = 0; j < 4; ++j) { const float4 y = yr[lane + 64 * j]; v[j].x += wk * y.x; v[j].y += wk * y.y; v[j].z += wk * y.z; v[j].w += wk * y.w; }
        }
        float ss = 0.f;
#pragma unroll
        for (int j = 0; j < 4; ++j) ss += v[j].x * v[j].x + v[j].y * v[j].y + v[j].z * v[j].z + v[j].w * v[j].w;
        ss = wave_sum(ss);
        const float rstd = rsqrtf(ss * (1.f / D) + EPS);
#pragma unroll
        for (int j = 0; j < 4; ++j) {
            ((float4*)(p.out + (size_t)t * D))[lane + 64 * j] = v[j];
            const float4 gg = ((const float4*)g)[lane + 64 * j];
            uint2 o;
            o.x = pk2(v[j].x * rstd * gg.x, v[j].y * rstd * gg.y);
            o.y = pk2(v[j].z * rstd * gg.z, v[j].w * rstd * gg.w);
            ((uint2*)(hb + (size_t)t * D))[lane + 64 * j] = o;
        }
    }
}

template <int PASS>
__device__ __forceinline__ void phase_ple(const Params& p, int bid, int nb, unsigned char* smem) {
    float* tmp = (float*)(p.ws + WS_X1);
    const bf16_t* A = (const bf16_t*)(p.ws + (PASS ? WS_PB : WS_HB));
    const bf16_t* Bw = (const bf16_t*)(p.ws + (PASS ? WB_PLE : WB_PLEG));
    constexpr int K = PASS ? 256 : D;
    for (int w = bid; w < 128 * 8; w += nb) {
        const int mt = w % 128, nt = w / 128;
        const int m0 = mt * 128, n0 = nt * 128;
        f32x4 acc[4][4];
        gemm2<false, false>(A, K, nullptr, m0, 128, Bw, D, n0, 128, K, smem, acc);
#pragma unroll
        for (int i = 0; i < 4; ++i)
#pragma unroll
            for (int r = 0; r < 4; ++r) {
                const size_t ro = (size_t)(m0 + G2_ROW(i, r)) * D + n0 + G2_COL(0);
                float* tr = tmp + ro;
                float* orow = p.out + ro;
#pragma unroll
                for (int j = 0; j < 4; ++j) {
                    if (PASS == 0) tr[j * 16] = sigmoidf_(acc[i][j][r]);
                    else orow[j * 16] = orow[j * 16] + tr[j * 16] * acc[i][j][r];
                }
            }
    }
}

template <int PH>
__device__ __forceinline__ void run_phase(const Params& p, int bid, int nb, unsigned char* smem) {
    if (PH == 0) phase_prep(p, bid, nb);
    if (PH == 1) phase_inproj(p, bid, nb, smem);
    if (PH == 2) phase_post(p, bid, nb);
    if (PH == 3) phase_compress(p, bid, nb);
    if (PH == 4) phase_attn(p, bid, nb, smem);
    if (PH == 5) phase_merge<0>(p, bid, nb, smem);
    if (PH == 13) phase_merge<1>(p, bid, nb, smem);
    if (PH == 6) phase_outproj(p, bid, nb, smem);
    if (PH == 7) phase_route(p, bid, nb);
    if (PH == 8) phase_place(p, bid, nb, smem);
    if (PH == 9) phase_moe1(p, bid, nb, smem);
    if (PH == 10) phase_moe2(p, bid, nb, smem);
    if (PH == 11) phase_combine(p, bid, nb);
    if (PH == 12) phase_ple<0>(p, bid, nb, smem);
    if (PH == 14) phase_ple<1>(p, bid, nb, smem);
}

#if SINGLE_LAUNCH
__global__ void __launch_bounds__(NT, 2) fwd_mega(Params p) {
    __shared__ __attribute__((aligned(16))) unsigned char smem[SMEM_BYTES];
    cg::grid_group grid = cg::this_grid();
    const int bid = blockIdx.x, nb = gridDim.x;
    run_phase<0>(p, bid, nb, smem); grid.sync();
    run_phase<1>(p, bid, nb, smem); grid.sync();
    run_phase<2>(p, bid, nb, smem); grid.sync();
    run_phase<3>(p, bid, nb, smem); grid.sync();
    run_phase<4>(p, bid, nb, smem); grid.sync();
    run_phase<5>(p, bid, nb, smem); grid.sync();
    run_phase<13>(p, bid, nb, smem); grid.sync();
    run_phase<6>(p, bid, nb, smem); grid.sync();
    run_phase<7>(p, bid, nb, smem); grid.sync();
    run_phase<8>(p, bid, nb, smem); grid.sync();
    run_phase<9>(p, bid, nb, smem); grid.sync();
    run_phase<10>(p, bid, nb, smem); grid.sync();
    run_phase<11>(p, bid, nb, smem); grid.sync();
    run_phase<12>(p, bid, nb, smem); grid.sync();
    run_phase<14>(p, bid, nb, smem);
}
#else
template <int PH>
__global__ void __launch_bounds__(NT, 2) k_phase(Params p) {
    __shared__ __attribute__((aligned(16))) unsigned char smem[SMEM_BYTES];
    run_phase<PH>(p, blockIdx.x, gridDim.x, smem);
}
#endif

extern "C" void kernel_launch(void* const* d_in, const int* in_sizes, int n_in, void* d_out, int out_size, void* d_ws, size_t ws_size,
                              hipStream_t stream) {
    if (n_in != 28 || ws_size < WS_END) { fprintf(stderr, "kernel_launch: unexpected n_in %d or ws_size %zu (< %zu)\n", n_in, ws_size, (size_t)WS_END); return; }
    Params p{};
    for (int i = 0; i < 28; ++i) p.in[i] = (const float*)d_in[i];
    p.out = (float*)d_out;
    p.ws = (unsigned char*)d_ws;
#if SINGLE_LAUNCH
    static int grid_blocks = 0;
    if (!grid_blocks) {
        int dev = 0, cus = 0, per_cu = 0;
        hipGetDevice(&dev);
        hipDeviceGetAttribute(&cus, hipDeviceAttributeMultiprocessorCount, dev);
        hipOccupancyMaxActiveBlocksPerMultiprocessor(&per_cu, fwd_mega, NT, 0);
        if (per_cu > 2) per_cu = 2;
        if (per_cu < 1) per_cu = 1;
        grid_blocks = cus * per_cu;
    }
    void* args[] = {&p};
    hipError_t e = hipLaunchCooperativeKernel((void*)fwd_mega, dim3(grid_blocks), dim3(NT), args, 0, stream);
    if (e != hipSuccess) fprintf(stderr, "cooperative launch failed: %s (grid %d)\n", hipGetErrorString(e), grid_blocks);
#else
    const int G = 512;
    k_phase<0><<<G, NT, 0, stream>>>(p);
    k_phase<1><<<G, NT, 0, stream>>>(p);
    k_phase<2><<<G, NT, 0, stream>>>(p);
    k_phase<3><<<G, NT, 0, stream>>>(p);
    k_phase<4><<<G, NT, 0, stream>>>(p);
    k_phase<5><<<G, NT, 0, stream>>>(p);
    k_phase<13><<<G, NT, 0, stream>>>(p);
    k_phase<6><<<G, NT, 0, stream>>>(p);
    k_phase<7><<<G, NT, 0, stream>>>(p);
    k_phase<8><<<G, NT, 0, stream>>>(p);
    k_phase<9><<<G, NT, 0, stream>>>(p);
    k_phase<10><<<G, NT, 0, stream>>>(p);
    k_phase<11><<<G, NT, 0, stream>>>(p);
    k_phase<12><<<G, NT, 0, stream>>>(p);
    k_phase<14><<<G, NT, 0, stream>>>(p);
#endif
}
```

```cpp
#include <hip/hip_runtime.h>
#include <hip/hip_cooperative_groups.h>
#include <cstdio>
#include <cstdint>
namespace cg = cooperative_groups;

#ifndef SINGLE_LAUNCH
#define SINGLE_LAUNCH 1
#endif

constexpr int S = 16384;
constexpr int D = 1024;
constexpr int DIN = 5184;
constexpr int NCMP = 1023;
constexpr int NSLC = 256;
constexpr int NEXP = 32;
constexpr int DFF = 1024;
constexpr float EPS = 1e-6f;
constexpr float LOG2E = 1.4426950408889634f;
constexpr int Z_NQ = 0, Z_NKV = 512, Z_NGATE = 1280, Z_DQ = 1304, Z_DK = 1816, Z_DV = 2328, Z_IQ = 2840, Z_IK = 3096,
              Z_IW = 3128, Z_GA = 3136, Z_GB = 4160;

constexpr int NT = 256;
constexpr int SMEM_BYTES = 73728;

typedef unsigned short bf16_t;
typedef short bf16x8 __attribute__((ext_vector_type(8)));
typedef float f32x4 __attribute__((ext_vector_type(4)));
typedef short s16x4 __attribute__((ext_vector_type(4)));
typedef __attribute__((address_space(3))) s16x4* lds_s16x4_ptr;
__device__ __forceinline__ s16x4 lds_tr16(const void* p) {
    return __builtin_amdgcn_ds_read_tr16_b64_v4i16((lds_s16x4_ptr)(uintptr_t)p);
}

constexpr size_t MBy = 1ull << 20;
constexpr size_t WS_CTL = 0;
constexpr size_t WS_HB = 1 * MBy;
constexpr size_t WS_OA = WS_HB + (size_t)S * D * 2;
constexpr size_t WS_OB = WS_OA + (size_t)S * 512 * 2;
constexpr size_t WS_MERGED = WS_OB + (size_t)S * 512 * 2;
constexpr size_t WS_X1 = WS_MERGED + (size_t)S * D * 2;
constexpr size_t WS_TOPI = WS_X1 + (size_t)S * D * 4;
constexpr size_t WS_TOPW = WS_TOPI + (size_t)S * 4 * 4;
constexpr size_t WS_PPOS = WS_TOPW + (size_t)S * 4 * 4;
constexpr size_t WS_ROWTOK = WS_PPOS + (size_t)S * 4 * 4;
constexpr size_t WS_PB = WS_ROWTOK + (size_t)65536 * 4;
constexpr size_t WS_REG = WS_PB + (size_t)S * 256 * 2;
constexpr size_t WS_Z = WS_REG;
constexpr size_t WS_GT = WS_Z + (size_t)S * DIN * 4;
constexpr size_t WS_IWS = WS_GT + (size_t)S * 32 * 4;
constexpr size_t WS_QNB = WS_IWS + (size_t)S * 8 * 4;
constexpr size_t WS_KSLB = WS_QNB + (size_t)S * 512 * 2;
constexpr size_t WS_VSLB = WS_KSLB + (size_t)S * 128 * 2;
constexpr size_t WS_KWNB = WS_VSLB + (size_t)S * 128 * 2;
constexpr size_t WS_VWNB = WS_KWNB + (size_t)S * 128 * 2;
constexpr size_t WS_KCB = WS_VWNB + (size_t)S * 128 * 2;
constexpr size_t WS_VCB = WS_KCB + (size_t)2 * 1024 * 64 * 2;
constexpr size_t WS_DQB = WS_VCB + (size_t)2 * 1024 * 64 * 2;
constexpr size_t WS_DKB = WS_DQB + (size_t)S * 512 * 2;
constexpr size_t WS_DVB = WS_DKB + (size_t)S * 512 * 2;
constexpr size_t WS_IQB = WS_DVB + (size_t)S * 512 * 2;
constexpr size_t WS_IKB = WS_IQB + (size_t)S * 256 * 2;
constexpr size_t WS_ENDA = WS_IKB + (size_t)S * 32 * 2;
constexpr size_t WS_ACT = WS_REG;
constexpr size_t WS_YROWS = WS_ACT + (size_t)(65536 + 128) * DFF * 2;
constexpr size_t WS_ENDB = WS_YROWS + (size_t)(65536 + 128) * D * 4;
constexpr size_t WS_END0 = WS_ENDA > WS_ENDB ? WS_ENDA : WS_ENDB;
constexpr size_t WB_IN = WS_END0;
constexpr size_t WB_A = WB_IN + (size_t)D * DIN * 2;
constexpr size_t WB_B = WB_A + (size_t)512 * D * 2;
constexpr size_t WB_OUT = WB_B + (size_t)512 * D * 2;
constexpr size_t WB_E1 = WB_OUT + (size_t)D * D * 2;
constexpr size_t WB_E2 = WB_E1 + (size_t)NEXP * D * 2 * DFF * 2;
constexpr size_t WB_PLE = WB_E2 + (size_t)NEXP * DFF * D * 2;
constexpr size_t WB_PLEG = WB_PLE + (size_t)256 * D * 2;
constexpr size_t WS_END = WB_PLEG + (size_t)D * D * 2;

struct Params {
    const float* in[28];
    float* out;
    unsigned char* ws;
};

__device__ __forceinline__ unsigned f2bf(float f) {
    unsigned u = __builtin_bit_cast(unsigned, f);
    return (u + 0x7fffu + ((u >> 16) & 1u)) >> 16;
}
__device__ __forceinline__ unsigned pk2(float lo, float hi) { return f2bf(lo) | (f2bf(hi) << 16); }
__device__ __forceinline__ float bf2f(unsigned short b) { return __builtin_bit_cast(float, (unsigned)b << 16); }
__device__ __forceinline__ float wave_sum(float v) {
#pragma unroll
    for (int o = 1; o < 64; o <<= 1) v += __shfl_xor(v, o);
    return v;
}
__device__ __forceinline__ float wave_max(float v) {
#pragma unroll
    for (int o = 1; o < 64; o <<= 1) v = fmaxf(v, __shfl_xor(v, o));
    return v;
}
__device__ __forceinline__ float sigmoidf_(float x) { return 1.f / (1.f + __expf(-x)); }
__device__ __forceinline__ int bucket_of(int n) {
    if (n < 16) return n;
    int b = 16;
    b += (n >= 19) + (n >= 21) + (n >= 24) + (n >= 27) + (n >= 31) + (n >= 35) + (n >= 40) + (n >= 46) + (n >= 52) + (n >= 59) +
         (n >= 67) + (n >= 77) + (n >= 87) + (n >= 99) + (n >= 113);
    return b;
}

constexpr int LDS_STRIDE = 40;
constexpr int BTR_STRIDE = 136;
template <bool A_F32, bool GATHER, bool SPLIT = false, bool BTR = true>
__device__ __forceinline__ void gemm_tile(const void* __restrict__ Aptr, int lda, const int* __restrict__ rowidx, int m0, int mrows,
                                          const float* __restrict__ B, int ldb, int n0, int split_off, int ncols, int K,
                                          unsigned char* smem, f32x4 (&acc)[2][8]) {
    bf16_t* As = (bf16_t*)smem;
    bf16_t* Bs = As + 128 * LDS_STRIDE;
    bf16_t* AsL = Bs + 128 * LDS_STRIDE;
    bf16_t* BsL = AsL + 128 * LDS_STRIDE;
    const int tid = threadIdx.x, lane = tid & 63, wave = tid >> 6;
#pragma unroll
    for (int i = 0; i < 2; ++i)
#pragma unroll
        for (int j = 0; j < 8; ++j) acc[i][j] = (f32x4){0.f, 0.f, 0.f, 0.f};
    auto lo = [](float v) { return v - bf2f((unsigned short)f2bf(v)); };

    const int ar = tid >> 2, ach = tid & 3;
    const unsigned char* arow[2];
    bool aval[2];
#pragma unroll
    for (int i = 0; i < 2; ++i) {
        int r = ar + 64 * i;
        aval[i] = r < mrows;
        long src = 0;
        if (aval[i]) src = GATHER ? (long)rowidx[m0 + r] : (long)(m0 + r);
        arow[i] = (const unsigned char*)Aptr + (size_t)src * lda * (A_F32 ? 4 : 2) + (size_t)ach * 8 * (A_F32 ? 4 : 2);
    }
    const int nq = tid & 31, kq = tid >> 5;
    const int jn = 4 * nq;
    const bool bval = jn < ncols;
    const float* bptr = B + (size_t)(4 * kq) * ldb + n0 + jn + (jn >= 64 ? split_off : 0);

    uint4 areg[2];
    float4 af0a, af0b, af1a, af1b;
    float4 breg[4];
    auto load_g = [&](int k0) {
#pragma unroll
        for (int i = 0; i < 2; ++i) {
            if (A_F32) {
                float4 t0 = make_float4(0, 0, 0, 0), t1 = t0;
                if (aval[i]) {
                    const float4* s = (const float4*)(arow[i] + (size_t)k0 * 4);
                    t0 = s[0]; t1 = s[1];
                }
                if (i == 0) { af0a = t0; af0b = t1; } else { af1a = t0; af1b = t1; }
            } else {
                if (aval[i]) areg[i] = *(const uint4*)(arow[i] + (size_t)k0 * 2);
                else areg[i] = make_uint4(0, 0, 0, 0);
            }
        }
#pragma unroll
        for (int kk = 0; kk < 4; ++kk) {
            if (bval) breg[kk] = *(const float4*)(bptr + (size_t)(k0 + kk) * ldb);
            else breg[kk] = make_float4(0, 0, 0, 0);
        }
    };
    auto store_l = [&]() {
#pragma unroll
        for (int i = 0; i < 2; ++i) {
            uint4 v;
            const float4 t0 = (i == 0) ? af0a : af1a, t1 = (i == 0) ? af0b : af1b;
            if (A_F32) {
                v.x = pk2(t0.x, t0.y); v.y = pk2(t0.z, t0.w);
                v.z = pk2(t1.x, t1.y); v.w = pk2(t1.z, t1.w);
            } else v = areg[i];
            *(uint4*)(As + (ar + 64 * i) * LDS_STRIDE + ach * 8) = v;
            if (SPLIT && A_F32) {
                v.x = pk2(lo(t0.x), lo(t0.y)); v.y = pk2(lo(t0.z), lo(t0.w));
                v.z = pk2(lo(t1.x), lo(t1.y)); v.w = pk2(lo(t1.z), lo(t1.w));
                *(uint4*)(AsL + (ar + 64 * i) * LDS_STRIDE + ach * 8) = v;
            }
        }
        if (SPLIT) {
            uint2 v;
            v.x = pk2(lo(breg[0].x), lo(breg[1].x)); v.y = pk2(lo(breg[2].x), lo(breg[3].x));
            *(uint2*)(BsL + (jn + 0) * LDS_STRIDE + 4 * kq) = v;
            v.x = pk2(lo(breg[0].y), lo(breg[1].y)); v.y = pk2(lo(breg[2].y), lo(breg[3].y));
            *(uint2*)(BsL + (jn + 1) * LDS_STRIDE + 4 * kq) = v;
            v.x = pk2(lo(breg[0].z), lo(breg[1].z)); v.y = pk2(lo(breg[2].z), lo(breg[3].z));
            *(uint2*)(BsL + (jn + 2) * LDS_STRIDE + 4 * kq) = v;
            v.x = pk2(lo(breg[0].w), lo(breg[1].w)); v.y = pk2(lo(breg[2].w), lo(breg[3].w));
            *(uint2*)(BsL + (jn + 3) * LDS_STRIDE + 4 * kq) = v;
        }
        if (BTR && !SPLIT) {
#pragma unroll
            for (int kk = 0; kk < 4; ++kk) {
                uint2 v; v.x = pk2(breg[kk].x, breg[kk].y); v.y = pk2(breg[kk].z, breg[kk].w);
                *(uint2*)(Bs + (4 * kq + kk) * BTR_STRIDE + jn) = v;
            }
        } else {
            uint2 v;
            v.x = pk2(breg[0].x, breg[1].x); v.y = pk2(breg[2].x, breg[3].x);
            *(uint2*)(Bs + (jn + 0) * LDS_STRIDE + 4 * kq) = v;
            v.x = pk2(breg[0].y, breg[1].y); v.y = pk2(breg[2].y, breg[3].y);
            *(uint2*)(Bs + (jn + 1) * LDS_STRIDE + 4 * kq) = v;
            v.x = pk2(breg[0].z, breg[1].z); v.y = pk2(breg[2].z, breg[3].z);
            *(uint2*)(Bs + (jn + 2) * LDS_STRIDE + 4 * kq) = v;
            v.x = pk2(breg[0].w, breg[1].w); v.y = pk2(breg[2].w, breg[3].w);
            *(uint2*)(Bs + (jn + 3) * LDS_STRIDE + 4 * kq) = v;
        }
    };
    const int nk = K / 32;
    __syncthreads();
    load_g(0);
    store_l();
    __syncthreads();
    const int fr = lane & 15, fq = lane >> 4;
    for (int kt = 0; kt < nk; ++kt) {
        if (kt + 1 < nk) load_g((kt + 1) * 32);
        bf16x8 a[2];
#pragma unroll
        for (int i = 0; i < 2; ++i) a[i] = *(const bf16x8*)(As + (wave * 32 + i * 16 + fr) * LDS_STRIDE + fq * 8);
        if (!SPLIT) {
            bf16x8 b[8];
#pragma unroll
            for (int j = 0; j < 8; ++j) {
                if (BTR && !SPLIT) {
                    const bf16_t* bp = Bs + (8 * fq + (fr >> 2)) * BTR_STRIDE + 16 * j + 4 * (fr & 3);
                    const s16x4 lo4 = lds_tr16(bp), hi4 = lds_tr16(bp + 4 * BTR_STRIDE);
                    b[j] = (bf16x8){lo4[0], lo4[1], lo4[2], lo4[3], hi4[0], hi4[1], hi4[2], hi4[3]};
                } else b[j] = *(const bf16x8*)(Bs + (j * 16 + fr) * LDS_STRIDE + fq * 8);
            }
#pragma unroll
            for (int i = 0; i < 2; ++i)
#pragma unroll
                for (int j = 0; j < 8; ++j) acc[i][j] = __builtin_amdgcn_mfma_f32_16x16x32_bf16(a[i], b[j], acc[i][j], 0, 0, 0);
        } else {
            bf16x8 al[2];
#pragma unroll
            for (int i = 0; i < 2; ++i) al[i] = *(const bf16x8*)(AsL + (wave * 32 + i * 16 + fr) * LDS_STRIDE + fq * 8);
#pragma unroll
            for (int j = 0; j < 8; ++j) {
                const bf16x8 bh = *(const bf16x8*)(Bs + (j * 16 + fr) * LDS_STRIDE + fq * 8);
                const bf16x8 bl = *(const bf16x8*)(BsL + (j * 16 + fr) * LDS_STRIDE + fq * 8);
#pragma unroll
                for (int i = 0; i < 2; ++i) {
                    acc[i][j] = __builtin_amdgcn_mfma_f32_16x16x32_bf16(a[i], bh, acc[i][j], 0, 0, 0);
                    acc[i][j] = __builtin_amdgcn_mfma_f32_16x16x32_bf16(a[i], bl, acc[i][j], 0, 0, 0);
                    acc[i][j] = __builtin_amdgcn_mfma_f32_16x16x32_bf16(al[i], bh, acc[i][j], 0, 0, 0);
                }
            }
        }
        __syncthreads();
        if (kt + 1 < nk) {
            store_l();
            __syncthreads();
        }
    }
}


constexpr int ASTR = 72;
constexpr int BSTR = 136;
template <bool GATHER, bool PAIR>
__device__ __forceinline__ void gemm2(const bf16_t* __restrict__ A, int lda, const int* __restrict__ rowidx, int m0, int mrows,
                                      const bf16_t* __restrict__ B, int ldb, int n0, int ncols, int K, unsigned char* smem,
                                      f32x4 (&acc)[4][4]) {
    bf16_t* As = (bf16_t*)smem;
    bf16_t* Bs = As + 128 * ASTR;
    const int tid = threadIdx.x, lane = tid & 63, wave = tid >> 6, wm = wave >> 1, wn = wave & 1;
#pragma unroll
    for (int i = 0; i < 4; ++i)
#pragma unroll
        for (int j = 0; j < 4; ++j) acc[i][j] = (f32x4){0.f, 0.f, 0.f, 0.f};
    const int arl = tid >> 1, ahalf = tid & 1;
    const int arc = arl < mrows ? arl : mrows - 1;
    const long asrc = GATHER ? (long)rowidx[m0 + arc] : (long)(m0 + arc);
    const bf16_t* ap = A + (size_t)asrc * lda + ahalf * 32;
    const int brow = tid >> 2, bq = tid & 3;
    const bf16_t* bp = B + (size_t)brow * ldb + n0 + (PAIR ? bq * 16 : bq * 32);
    const int boff1 = 8, boff2 = PAIR ? 1024 : 16, boff3 = PAIR ? 1032 : 24;
    bf16_t* asd = As + arl * ASTR + ahalf * 32;
    bf16_t* bsd = Bs + brow * BSTR + bq * 32;
    uint4 a0, a1, a2, a3, b0, b1, b2, b3;
#define G2_LOAD(k0)                                                                                       \
    do {                                                                                                  \
        const bf16_t* ap_ = ap + (k0);                                                                    \
        a0 = *(const uint4*)(ap_); a1 = *(const uint4*)(ap_ + 8);                                         \
        a2 = *(const uint4*)(ap_ + 16); a3 = *(const uint4*)(ap_ + 24);                                   \
        const bf16_t* bp_ = bp + (size_t)(k0) * ldb;                                                      \
        b0 = *(const uint4*)(bp_); b1 = *(const uint4*)(bp_ + boff1);                                     \
        b2 = *(const uint4*)(bp_ + boff2); b3 = *(const uint4*)(bp_ + boff3);                             \
    } while (0)
#define G2_STORE()                                                                                        \
    do {                                                                                                  \
        *(uint4*)(asd) = a0; *(uint4*)(asd + 8) = a1; *(uint4*)(asd + 16) = a2; *(uint4*)(asd + 24) = a3; \
        *(uint4*)(bsd) = b0; *(uint4*)(bsd + 8) = b1; *(uint4*)(bsd + 16) = b2; *(uint4*)(bsd + 24) = b3; \
    } while (0)
    const int nk = K / 64;
    __syncthreads();
    G2_LOAD(0);
    G2_STORE();
    __syncthreads();
    const int fr = lane & 15, fq = lane >> 4;
    const bf16_t* afp = As + (wm * 64 + fr) * ASTR + fq * 8;
    const bf16_t* bfp = Bs + (8 * fq + (fr >> 2)) * BSTR + wn * 64 + 4 * (fr & 3);
    for (int kt = 0; kt < nk; ++kt) {
        if (kt + 1 < nk) G2_LOAD((kt + 1) * 64);
#pragma unroll
        for (int kh = 0; kh < 2; ++kh) {
            bf16x8 a[4], b[4];
#pragma unroll
            for (int i = 0; i < 4; ++i) a[i] = *(const bf16x8*)(afp + i * 16 * ASTR + kh * 32);
#pragma unroll
            for (int j = 0; j < 4; ++j) {
                const bf16_t* q = bfp + kh * 32 * BSTR + j * 16;
                const s16x4 lo4 = lds_tr16(q), hi4 = lds_tr16(q + 4 * BSTR);
                b[j] = (bf16x8){lo4[0], lo4[1], lo4[2], lo4[3], hi4[0], hi4[1], hi4[2], hi4[3]};
            }
#pragma unroll
            for (int i = 0; i < 4; ++i)
#pragma unroll
                for (int j = 0; j < 4; ++j) acc[i][j] = __builtin_amdgcn_mfma_f32_16x16x32_bf16(a[i], b[j], acc[i][j], 0, 0, 0);
        }
        __syncthreads();
        if (kt + 1 < nk) {
            G2_STORE();
            __syncthreads();
        }
    }
#undef G2_LOAD
#undef G2_STORE
}
#define G2_ROW(i, r) ((threadIdx.x >> 7) * 64 + (i) * 16 + 4 * ((threadIdx.x & 63) >> 4) + (r))
#define G2_COL(j) (((((threadIdx.x >> 6) & 1) * 4 + (j)) * 16) + (threadIdx.x & 15))

__device__ __forceinline__ void cvt_weights(const float* __restrict__ src, bf16_t* __restrict__ dst, size_t n, int bid, int nb) {
    const size_t n8 = n >> 3;
    for (size_t i = (size_t)bid * NT + threadIdx.x; i < n8; i += (size_t)nb * NT) {
        const float4 u = ((const float4*)src)[2 * i], v = ((const float4*)src)[2 * i + 1];
        uint4 o; o.x = pk2(u.x, u.y); o.y = pk2(u.z, u.w); o.z = pk2(v.x, v.y); o.w = pk2(v.z, v.w);
        ((uint4*)dst)[i] = o;
    }
}
__device__ __forceinline__ void phase_prep(const Params& p, int bid, int nb) {
    const int lane = threadIdx.x & 63, wave = threadIdx.x >> 6;
    if (bid == 0 && threadIdx.x < 64) ((int*)(p.ws + WS_CTL))[threadIdx.x] = 0;
    cvt_weights(p.in[2], (bf16_t*)(p.ws + WB_IN), (size_t)D * DIN, bid, nb);
    cvt_weights(p.in[14], (bf16_t*)(p.ws + WB_A), (size_t)512 * D, bid, nb);
    cvt_weights(p.in[15], (bf16_t*)(p.ws + WB_B), (size_t)512 * D, bid, nb);
    cvt_weights(p.in[16], (bf16_t*)(p.ws + WB_OUT), (size_t)D * D, bid, nb);
    cvt_weights(p.in[21], (bf16_t*)(p.ws + WB_E1), (size_t)NEXP * D * 2 * DFF, bid, nb);
    cvt_weights(p.in[23], (bf16_t*)(p.ws + WB_E2), (size_t)NEXP * DFF * D, bid, nb);
    cvt_weights(p.in[26], (bf16_t*)(p.ws + WB_PLE), (size_t)256 * D, bid, nb);
    cvt_weights(p.in[27], (bf16_t*)(p.ws + WB_PLEG), (size_t)D * D, bid, nb);
    const float* x = p.in[0];
    const float* g = p.in[3];
    bf16_t* hb = (bf16_t*)(p.ws + WS_HB);
    for (int t = bid * 4 + wave; t < S; t += nb * 4) {
        const float4* xr = (const float4*)(x + (size_t)t * D);
        float4 v[4];
        float ss = 0.f;
#pragma unroll
        for (int j = 0; j < 4; ++j) { v[j] = xr[lane + 64 * j]; ss += v[j].x * v[j].x + v[j].y * v[j].y + v[j].z * v[j].z + v[j].w * v[j].w; }
        ss = wave_sum(ss);
        const float rstd = rsqrtf(ss * (1.f / D) + EPS);
#pragma unroll
        for (int j = 0; j < 4; ++j) {
            const float4 gg = ((const float4*)g)[lane + 64 * j];
            uint2 o;
            o.x = pk2(v[j].x * rstd * gg.x, v[j].y * rstd * gg.y);
            o.y = pk2(v[j].z * rstd * gg.z, v[j].w * rstd * gg.w);
            ((uint2*)(hb + (size_t)t * D))[lane + 64 * j] = o;
        }
    }
}

__device__ __forceinline__ void phase_inproj(const Params& p, int bid, int nb, unsigned char* smem) {
    const bf16_t* hb = (const bf16_t*)(p.ws + WS_HB);
    float* z = (float*)(p.ws + WS_Z);
    constexpr int NTN = (DIN + 127) / 128;
    for (int w = bid; w < 128 * NTN; w += nb) {
        const int mt = w % 128, nt = w / 128;
        const int m0 = mt * 128, n0 = nt * 128;
        const int ncols = (DIN - n0) < 128 ? (DIN - n0) : 128;
        f32x4 acc[4][4];
        gemm2<false, false>(hb, D, nullptr, m0, 128, (const bf16_t*)(p.ws + WB_IN), DIN, n0, ncols, D, smem, acc);
#pragma unroll
        for (int i = 0; i < 4; ++i)
#pragma unroll
            for (int r = 0; r < 4; ++r) {
                float* zr = z + (size_t)(m0 + G2_ROW(i, r)) * DIN + n0;
#pragma unroll
                for (int j = 0; j < 4; ++j) { const int c = G2_COL(j); if (c < ncols) zr[c] = acc[i][j][r]; }
            }
    }
}

__device__ __forceinline__ float rms64(float v) { return rsqrtf(wave_sum(v * v) * (1.f / 64.f) + EPS); }
__device__ __forceinline__ void phase_post(const Params& p, int bid, int nb) {
    const int lane = threadIdx.x & 63, wave = threadIdx.x >> 6;
    const float* z = (const float*)(p.ws + WS_Z);
    float* gt = (float*)(p.ws + WS_GT);
    float* iws = (float*)(p.ws + WS_IWS);
    bf16_t* qnb = (bf16_t*)(p.ws + WS_QNB);
    bf16_t* kslb = (bf16_t*)(p.ws + WS_KSLB);
    bf16_t* vslb = (bf16_t*)(p.ws + WS_VSLB);
    bf16_t* kwnb = (bf16_t*)(p.ws + WS_KWNB);
    bf16_t* vwnb = (bf16_t*)(p.ws + WS_VWNB);
    bf16_t* dqb = (bf16_t*)(p.ws + WS_DQB);
    bf16_t* dkb = (bf16_t*)(p.ws + WS_DKB);
    bf16_t* dvb = (bf16_t*)(p.ws + WS_DVB);
    bf16_t* iqb = (bf16_t*)(p.ws + WS_IQB);
    bf16_t* ikb = (bf16_t*)(p.ws + WS_IKB);
    const float gqn = p.in[4][lane], gkn = p.in[5][lane], gqd = p.in[6][lane], gkd = p.in[7][lane];
    for (int t = bid * 4 + wave; t < S; t += nb * 4) {
        const float* zr = z + (size_t)t * DIN;
#pragma unroll
        for (int h = 0; h < 8; ++h) {
            const float v = zr[Z_NQ + h * 64 + lane];
            qnb[(size_t)t * 512 + h * 64 + lane] = (bf16_t)f2bf(v * rms64(v) * gqn * (0.125f * LOG2E));
        }
#pragma unroll
        for (int g = 0; g < 2; ++g) {
            const size_t o_ = ((size_t)g * S + t) * 64 + lane;
            float v = zr[Z_NKV + 2 * 128 + g * 64 + lane];
            kslb[o_] = (bf16_t)f2bf(v * rms64(v) * gkn);
            vslb[o_] = (bf16_t)f2bf(zr[Z_NKV + 3 * 128 + g * 64 + lane]);
            v = zr[Z_NKV + 4 * 128 + g * 64 + lane];
            kwnb[o_] = (bf16_t)f2bf(v * rms64(v) * gkn);
            vwnb[o_] = (bf16_t)f2bf(zr[Z_NKV + 5 * 128 + g * 64 + lane]);
        }
        if (lane < 24) gt[(size_t)t * 32 + lane] = sigmoidf_(zr[Z_NGATE + lane]);
#pragma unroll
        for (int h = 0; h < 8; ++h) {
            float v = zr[Z_DQ + h * 64 + lane];
            dqb[(size_t)t * 512 + h * 64 + lane] = (bf16_t)f2bf(v * rms64(v) * gqd * (0.125f * LOG2E));
            v = zr[Z_DK + h * 64 + lane];
            dkb[(size_t)t * 512 + h * 64 + lane] = (bf16_t)f2bf(v * rms64(v) * gkd);
            dvb[(size_t)t * 512 + h * 64 + lane] = (bf16_t)f2bf(zr[Z_DV + h * 64 + lane]);
        }
#pragma unroll
        for (int j = 0; j < 4; ++j) iqb[(size_t)t * 256 + j * 64 + lane] = (bf16_t)f2bf(zr[Z_IQ + j * 64 + lane] * 0.17677669529663687f);
        if (lane < 32) ikb[(size_t)t * 32 + lane] = (bf16_t)f2bf(zr[Z_IK + lane]);
        if (lane < 8) iws[(size_t)t * 8 + lane] = zr[Z_IW + lane] * 0.35355339059327373f;
    }
}

__device__ __forceinline__ void phase_compress(const Params& p, int bid, int nb) {
    const int lane = threadIdx.x & 63, wave = threadIdx.x >> 6;
    const float* z = (const float*)(p.ws + WS_Z);
    const float gkn = p.in[5][lane];
    for (int it = bid * 4 + wave; it < NCMP * 4; it += nb * 4) {
        const int kind = it & 1, g = (it >> 1) & 1, c = it >> 2;
        const float* pe = p.in[kind ? 11 : 8];
        const float* w1 = p.in[kind ? 12 : 9];
        const float* w2 = p.in[kind ? 13 : 10];
        float acc = 0.f;
        for (int l = 0; l < 32; ++l) {
            const float* zr = z + (size_t)(16 * c + l) * DIN + Z_NKV + kind * 128 + g * 64;
            const float zin = zr[lane] + pe[l * 64 + lane];
            const float* w1l = w1 + (size_t)l * 64 * 64;
#pragma unroll 8
            for (int d = 0; d < 64; ++d) acc += __shfl(zin, d) * w1l[d * 64 + lane];
        }
        const float hid = acc * sigmoidf_(acc);
        float o = 0.f;
#pragma unroll 8
        for (int e = 0; e < 64; ++e) o += __shfl(hid, e) * w2[e * 64 + lane];
        if (kind == 0) {
            o = o * rms64(o) * gkn;
            ((bf16_t*)(p.ws + WS_KCB))[((size_t)g * 1024 + c) * 64 + lane] = (bf16_t)f2bf(o);
        } else {
            ((bf16_t*)(p.ws + WS_VCB))[((size_t)g * 1024 + c) * 64 + lane] = (bf16_t)f2bf(o);
        }
    }
    if (bid == 0) {
        const int tid = threadIdx.x;
        if (tid < 128) ((bf16_t*)(p.ws + WS_KCB))[((size_t)(tid >> 6) * 1024 + 1023) * 64 + (tid & 63)] = 0;
        else ((bf16_t*)(p.ws + WS_VCB))[((size_t)((tid - 128) >> 6) * 1024 + 1023) * 64 + (tid & 63)] = 0;
    }
}

constexpr int KSTR = 72;
constexpr int NSA_KT = 0;
constexpr int NSA_VT = NSA_KT + 32 * KSTR * 2;
constexpr int NSA_WV = NSA_VT + 32 * KSTR * 2;
constexpr int NSA_IMP = NSA_WV + 4 * 32 * KSTR * 2;
constexpr int NSA_LUT = NSA_IMP + 16 * 260 * 4;
constexpr int NSA_SEL = NSA_LUT + 4 * 128 * 4;
constexpr int NSA_END = NSA_SEL + 16 * 16 * 4;
static_assert(NSA_END <= SMEM_BYTES, "nsa lds");

__device__ __forceinline__ f32x4 mfma16(bf16x8 a, bf16x8 b, f32x4 c) { return __builtin_amdgcn_mfma_f32_16x16x32_bf16(a, b, c, 0, 0, 0); }
__device__ __forceinline__ bf16x8 pack_p(const f32x4& p1, const f32x4& p2) {
    const unsigned a = pk2(p1[0], p1[1]), b = pk2(p1[2], p1[3]), c = pk2(p2[0], p2[1]), d = pk2(p2[2], p2[3]);
    return __builtin_bit_cast(bf16x8, make_uint4(a, b, c, d));
}
__device__ __forceinline__ void pv_step(f32x4 (&o)[4], const bf16_t* vt, bf16x8 pb, int fq, int fr) {
    const bf16_t* base = vt + (4 * fq + (fr >> 2)) * KSTR + 4 * (fr & 3);
#pragma unroll
    for (int dt = 0; dt < 4; ++dt) {
        const s16x4 lo4 = lds_tr16(base + dt * 16), hi4 = lds_tr16(base + 16 * KSTR + dt * 16);
        const bf16x8 va = (bf16x8){lo4[0], lo4[1], lo4[2], lo4[3], hi4[0], hi4[1], hi4[2], hi4[3]};
        o[dt] = mfma16(va, pb, o[dt]);
    }
}
__device__ __forceinline__ float quad_sum(float v) {
    v += __shfl_xor(v, 1);
    v += __shfl_xor(v, 2);
    return v;
}

__device__ __forceinline__ void nsa_tile(const Params& p, int tt, int g, unsigned char* smem) {
    const int tid = threadIdx.x, lane = tid & 63, wave = tid >> 6, fr = lane & 15, fq = lane >> 4;
    bf16_t* kt = (bf16_t*)(smem + NSA_KT);
    bf16_t* vt = (bf16_t*)(smem + NSA_VT);
    bf16_t* wv = (bf16_t*)(smem + NSA_WV) + wave * 32 * KSTR;
    float* imp = (float*)(smem + NSA_IMP);
    float* lut = (float*)(smem + NSA_LUT);
    int* sel = (int*)(smem + NSA_SEL);
    const bf16_t* qnb = (const bf16_t*)(p.ws + WS_QNB);
    const bf16_t* kslb = (const bf16_t*)(p.ws + WS_KSLB) + (size_t)g * S * 64;
    const bf16_t* vslb = (const bf16_t*)(p.ws + WS_VSLB) + (size_t)g * S * 64;
    const bf16_t* kwnb = (const bf16_t*)(p.ws + WS_KWNB) + (size_t)g * S * 64;
    const bf16_t* vwnb = (const bf16_t*)(p.ws + WS_VWNB) + (size_t)g * S * 64;
    const bf16_t* kcb = (const bf16_t*)(p.ws + WS_KCB) + (size_t)g * 1024 * 64;
    const bf16_t* vcb = (const bf16_t*)(p.ws + WS_VCB) + (size_t)g * 1024 * 64;
    const float* gt = (const float*)(p.ws + WS_GT);
    const float* relb = p.in[17];
    const int t0 = tt * 16;
    const int tl = 4 * wave + (fr >> 2);
    const int tok = t0 + tl;
    const int hl = fr & 3, head = g * 4 + hl;
    __syncthreads();
    for (int i = tid; i < 512; i += NT) { const int hh = i >> 7, n = i & 127; lut[i] = relb[bucket_of(n) * 16 + g * 4 + hh] * LOG2E; }
    for (int i = tid; i < 16 * 260; i += NT) imp[i] = 0.f;
    float U2;
    {
        const float mq = wave_max(fabsf(p.in[4][lane])), mk = wave_max(fabsf(p.in[5][lane]));
        float mb = 0.f;
#pragma unroll
        for (int k = 0; k < 4; ++k) { const int e = lane + 64 * k; mb = fmaxf(mb, fabsf(relb[(e >> 3) * 16 + (e & 7)])); }
        mb = wave_max(mb);
        U2 = (8.f * mq * mk + mb) * LOG2E;
    }
    bf16x8 qf[2];
#pragma unroll
    for (int kh = 0; kh < 2; ++kh) qf[kh] = *(const bf16x8*)(qnb + (size_t)tok * 512 + head * 64 + kh * 32 + fq * 8);
    __syncthreads();
    const float* lutp = lut + hl * 128;
    const float lutfar = lutp[127];
    const f32x4 zero4 = (f32x4){0.f, 0.f, 0.f, 0.f};
    f32x4 outacc[4];
#pragma unroll
    for (int dt = 0; dt < 4; ++dt) outacc[dt] = zero4;
    const float g0 = gt[(size_t)tok * 32 + head * 3 + 0], g1 = gt[(size_t)tok * 32 + head * 3 + 1], g2 = gt[(size_t)tok * 32 + head * 3 + 2];
    const int srow = tid >> 3, sch = tid & 7;

    {
        int ks0 = (t0 - 511) & ~31; ks0 = ks0 < 0 ? 0 : ks0;
        const int nsteps = (t0 + 16 - ks0 + 31) >> 5;
        f32x4 o[4];
#pragma unroll
        for (int dt = 0; dt < 4; ++dt) o[dt] = zero4;
        float lsum = 0.f;
        uint4 kreg = *(const uint4*)(kwnb + (size_t)(ks0 + srow) * 64 + sch * 8);
        uint4 vreg = *(const uint4*)(vwnb + (size_t)(ks0 + srow) * 64 + sch * 8);
#pragma unroll 1
        for (int st = 0; st < nsteps; ++st) {
            const int ks = ks0 + st * 32;
            *(uint4*)(kt + srow * KSTR + sch * 8) = kreg;
            *(uint4*)(vt + srow * KSTR + sch * 8) = vreg;
            __syncthreads();
            if (st + 1 < nsteps) {
                kreg = *(const uint4*)(kwnb + (size_t)(ks + 32 + srow) * 64 + sch * 8);
                vreg = *(const uint4*)(vwnb + (size_t)(ks + 32 + srow) * 64 + sch * 8);
            }
            f32x4 s1 = zero4, s2 = zero4;
#pragma unroll
            for (int kh = 0; kh < 2; ++kh) {
                const bf16x8 k1 = *(const bf16x8*)(kt + fr * KSTR + kh * 32 + fq * 8);
                const bf16x8 k2 = *(const bf16x8*)(kt + (16 + fr) * KSTR + kh * 32 + fq * 8);
                s1 = mfma16(k1, qf[kh], s1);
                s2 = mfma16(k2, qf[kh], s2);
            }
            const bool far = (t0 + 4 * wave) - (ks + 31) >= 113;
            f32x4 p1, p2;
#pragma unroll
            for (int r = 0; r < 4; ++r) {
                const int d1 = tok - (ks + 4 * fq + r), d2 = d1 - 16;
                const float b1 = far ? lutfar : lutp[d1 < 0 ? 0 : (d1 > 127 ? 127 : d1)];
                const float b2 = far ? lutfar : lutp[d2 < 0 ? 0 : (d2 > 127 ? 127 : d2)];
                p1[r] = (d1 >= 0 && d1 < 512) ? __builtin_amdgcn_exp2f(s1[r] + b1 - U2) : 0.f;
                p2[r] = (d2 >= 0 && d2 < 512) ? __builtin_amdgcn_exp2f(s2[r] + b2 - U2) : 0.f;
                lsum += p1[r] + p2[r];
            }
            pv_step(o, vt, pack_p(p1, p2), fq, fr);
            __syncthreads();
        }
        lsum += __shfl_xor(lsum, 16);
        lsum += __shfl_xor(lsum, 32);
        const float sc = lsum > 0.f ? g2 / lsum : 0.f;
#pragma unroll
        for (int dt = 0; dt < 4; ++dt)
#pragma unroll
            for (int r = 0; r < 4; ++r) outacc[dt][r] += sc * o[dt][r];
    }

    {
        const int tlast = t0 + 15;
        const int cmax = (tlast >= 31) ? ((tlast - 31) >> 4) + 1 : 0;
        const int nsteps = (cmax + 31) >> 5;
        float inv_l = 0.f;
#pragma unroll 1
        for (int pass = 0; pass < 2; ++pass) {
            f32x4 o[4];
#pragma unroll
            for (int dt = 0; dt < 4; ++dt) o[dt] = zero4;
            float lsum = 0.f;
            uint4 kreg = make_uint4(0, 0, 0, 0), vreg = kreg;
            if (nsteps > 0) {
                kreg = *(const uint4*)(kcb + (size_t)srow * 64 + sch * 8);
                vreg = *(const uint4*)(vcb + (size_t)srow * 64 + sch * 8);
            }
#pragma unroll 1
            for (int st = 0; st < nsteps; ++st) {
                const int cs = st * 32;
                *(uint4*)(kt + srow * KSTR + sch * 8) = kreg;
                *(uint4*)(vt + srow * KSTR + sch * 8) = vreg;
                __syncthreads();
                if (st + 1 < nsteps) {
                    kreg = *(const uint4*)(kcb + (size_t)(cs + 32 + srow) * 64 + sch * 8);
                    vreg = *(const uint4*)(vcb + (size_t)(cs + 32 + srow) * 64 + sch * 8);
                }
                f32x4 s1 = zero4, s2 = zero4;
#pragma unroll
                for (int kh = 0; kh < 2; ++kh) {
                    const bf16x8 k1 = *(const bf16x8*)(kt + fr * KSTR + kh * 32 + fq * 8);
                    const bf16x8 k2 = *(const bf16x8*)(kt + (16 + fr) * KSTR + kh * 32 + fq * 8);
                    s1 = mfma16(k1, qf[kh], s1);
                    s2 = mfma16(k2, qf[kh], s2);
                }
                const bool far = (t0 + 4 * wave) - (16 * (cs + 31) + 31) >= 113;
                f32x4 p1, p2;
#pragma unroll
                for (int r = 0; r < 4; ++r) {
                    const int d1 = tok - (16 * (cs + 4 * fq + r) + 31), d2 = d1 - 256;
                    const float b1 = far ? lutfar : lutp[d1 < 0 ? 0 : (d1 > 127 ? 127 : d1)];
                    const float b2 = far ? lutfar : lutp[d2 < 0 ? 0 : (d2 > 127 ? 127 : d2)];
                    p1[r] = (d1 >= 0) ? __builtin_amdgcn_exp2f(s1[r] + b1 - U2) : 0.f;
                    p2[r] = (d2 >= 0) ? __builtin_amdgcn_exp2f(s2[r] + b2 - U2) : 0.f;
                    lsum += p1[r] + p2[r];
                }
                if (pass == 1) {
#pragma unroll
                    for (int r = 0; r < 4; ++r) { p1[r] *= inv_l; p2[r] *= inv_l; }
                    f32x4 h1, h2;
#pragma unroll
                    for (int r = 0; r < 4; ++r) { h1[r] = quad_sum(p1[r]); h2[r] = quad_sum(p2[r]); }
                    if (hl == 0) {
                        float* ir = imp + tl * 260 + (cs >> 2) + fq;
                        atomicAdd(ir, h1[0] + h1[1] + h1[2] + 0.5f * h1[3]);
                        atomicAdd(ir + 1, 0.5f * h1[3]);
                        atomicAdd(ir + 4, h2[0] + h2[1] + h2[2] + 0.5f * h2[3]);
                        atomicAdd(ir + 5, 0.5f * h2[3]);
                    }
                    pv_step(o, vt, pack_p(p1, p2), fq, fr);
                }
                __syncthreads();
            }
            if (pass == 0) {
                lsum += __shfl_xor(lsum, 16);
                lsum += __shfl_xor(lsum, 32);
                inv_l = lsum > 0.f ? 1.f / lsum : 0.f;
            } else {
#pragma unroll
                for (int dt = 0; dt < 4; ++dt)
#pragma unroll
                    for (int r = 0; r < 4; ++r) outacc[dt][r] += g0 * o[dt][r];
            }
        }
    }
    __syncthreads();

#pragma unroll 1
    for (int tq = 0; tq < 4; ++tq) {
        const int tli = 4 * wave + tq, tk = t0 + tli, cur = tk >> 6;
        int* sl = sel + tli * 16;
        int nf = 0;
        if (lane == 0) {
            sl[0] = 0; int c_ = 1;
            if (cur - 1 >= 1) sl[c_++] = cur - 1;
            if (cur >= 1) sl[c_++] = cur;
            for (int k = c_; k < 16; ++k) sl[k] = -1;
        }
        nf = 1 + (cur - 1 >= 1 ? 1 : 0) + (cur >= 1 ? 1 : 0);
        const int ncand = cur - 2 > 0 ? cur - 2 : 0;
        int need = 16 - nf; need = need < ncand ? need : ncand;
        unsigned long long key[4];
#pragma unroll
        for (int k = 0; k < 4; ++k) {
            const int n = lane + 64 * k;
            const bool c = (n >= 1) && (n <= cur - 2);
            key[k] = c ? (((unsigned long long)__builtin_bit_cast(unsigned, imp[tli * 260 + n]) << 32) | (unsigned long long)(0xFFFFFFFFu - (unsigned)n)) + (1ull << 32) : 0ull;
        }
#pragma unroll 1
        for (int rd = 0; rd < need; ++rd) {
            unsigned long long m = key[0];
            m = key[1] > m ? key[1] : m; m = key[2] > m ? key[2] : m; m = key[3] > m ? key[3] : m;
#pragma unroll
            for (int o_ = 1; o_ < 64; o_ <<= 1) {
                const unsigned lo_ = __shfl_xor((unsigned)m, o_), hi_ = __shfl_xor((unsigned)(m >> 32), o_);
                const unsigned long long other = ((unsigned long long)hi_ << 32) | lo_;
                m = other > m ? other : m;
            }
            const int nstar = (int)(0xFFFFFFFFu - (unsigned)m);
#pragma unroll
            for (int k = 0; k < 4; ++k) if (key[k] == m) key[k] = 0ull;
            if (lane == 0) sl[nf + rd] = nstar;
        }
    }
    __syncthreads();

    {
        f32x4 o[4];
#pragma unroll
        for (int dt = 0; dt < 4; ++dt) o[dt] = zero4;
        float lsum = 0.f;
        const int vrow = lane >> 1, vhalf = lane & 1;
#pragma unroll 1
        for (int tq = 0; tq < 4; ++tq) {
            const int tli = 4 * wave + tq, tk = t0 + tli;
            const bool mine = (fr >> 2) == tq;
#pragma unroll 1
            for (int j = 0; j < 16; ++j) {
                const int b = __builtin_amdgcn_readfirstlane(sel[tli * 16 + j]);
                if (b < 0) continue;
                const int base = b * 64;
#pragma unroll 1
                for (int hf = 0; hf < 2; ++hf) {
                    const int ks = base + 32 * hf;
                    if (ks > tk) break;
                    bf16x8 k1[2], k2[2];
#pragma unroll
                    for (int kh = 0; kh < 2; ++kh) {
                        k1[kh] = *(const bf16x8*)(kslb + (size_t)(ks + fr) * 64 + kh * 32 + fq * 8);
                        k2[kh] = *(const bf16x8*)(kslb + (size_t)(ks + 16 + fr) * 64 + kh * 32 + fq * 8);
                    }
                    const uint4* vsrc = (const uint4*)(vslb + (size_t)(ks + vrow) * 64 + vhalf * 32);
                    const uint4 v0 = vsrc[0], v1 = vsrc[1], v2 = vsrc[2], v3 = vsrc[3];
                    uint4* vdst = (uint4*)(wv + vrow * KSTR + vhalf * 32);
                    vdst[0] = v0; vdst[1] = v1; vdst[2] = v2; vdst[3] = v3;
                    f32x4 s1 = zero4, s2 = zero4;
#pragma unroll
                    for (int kh = 0; kh < 2; ++kh) { s1 = mfma16(k1[kh], qf[kh], s1); s2 = mfma16(k2[kh], qf[kh], s2); }
                    const bool far = tk - (ks + 31) >= 113;
                    f32x4 p1, p2;
#pragma unroll
                    for (int r = 0; r < 4; ++r) {
                        const int d1 = tk - (ks + 4 * fq + r), d2 = d1 - 16;
                        const float b1 = far ? lutfar : lutp[d1 < 0 ? 0 : (d1 > 127 ? 127 : d1)];
                        const float b2 = far ? lutfar : lutp[d2 < 0 ? 0 : (d2 > 127 ? 127 : d2)];
                        p1[r] = (mine && d1 >= 0) ? __builtin_amdgcn_exp2f(s1[r] + b1 - U2) : 0.f;
                        p2[r] = (mine && d2 >= 0) ? __builtin_amdgcn_exp2f(s2[r] + b2 - U2) : 0.f;
                        lsum += p1[r] + p2[r];
                    }
                    asm volatile("" ::: "memory");
                    pv_step(o, wv, pack_p(p1, p2), fq, fr);
                    asm volatile("" ::: "memory");
                }
            }
        }
        lsum += __shfl_xor(lsum, 16);
        lsum += __shfl_xor(lsum, 32);
        const float sc = lsum > 0.f ? g1 / lsum : 0.f;
#pragma unroll
        for (int dt = 0; dt < 4; ++dt)
#pragma unroll
            for (int r = 0; r < 4; ++r) outacc[dt][r] += sc * o[dt][r];
    }
    bf16_t* orow = (bf16_t*)(p.ws + WS_OA) + (size_t)tok * 512 + head * 64 + 4 * fq;
#pragma unroll
    for (int dt = 0; dt < 4; ++dt) {
        uint2 v; v.x = pk2(outacc[dt][0], outacc[dt][1]); v.y = pk2(outacc[dt][2], outacc[dt][3]);
        *(uint2*)(orow + dt * 16) = v;
    }
}

typedef float f32x16 __attribute__((ext_vector_type(16)));
constexpr int DSA_CK = 0;
constexpr int DSA_CI = DSA_CK + 16 * 512 * 4;
constexpr int DSA_LUT = DSA_CI + 16 * 512 * 2;
constexpr int DSA_END = DSA_LUT + 8 * 128 * 4;
static_assert(DSA_END <= SMEM_BYTES, "dsa lds");

__device__ __forceinline__ unsigned mono_key(float s) {
    const unsigned u = __builtin_bit_cast(unsigned, s + 0.0f);
    return (u & 0x80000000u) ? ~u : (u | 0x80000000u);
}
__device__ __forceinline__ unsigned dsa_compact(unsigned* ck, unsigned short* ci, int n, int lane) {
    unsigned kk[8]; unsigned ii[8];
#pragma unroll
    for (int k = 0; k < 8; ++k) { const int e = lane + 64 * k; kk[k] = e < n ? ck[e] : 0u; ii[k] = e < n ? (unsigned)ci[e] : 0xFFFFu; }
    unsigned T = 0;
#pragma unroll 1
    for (int b = 31; b >= 0; --b) {
        const unsigned cand = T | (1u << b);
        int c = 0;
#pragma unroll
        for (int k = 0; k < 8; ++k) c += __builtin_popcountll(__ballot(kk[k] >= cand));
        if (c >= 256) T = cand;
    }
    int cgt = 0, ceq = 0;
#pragma unroll
    for (int k = 0; k < 8; ++k) { cgt += __builtin_popcountll(__ballot(kk[k] > T)); ceq += __builtin_popcountll(__ballot(kk[k] == T)); }
    const int need = 256 - cgt;
    unsigned X = 0xFFFFu;
    if (ceq > need) {
        X = 0;
#pragma unroll 1
        for (int b = 15; b >= 0; --b) {
            const unsigned cand = X | (1u << b);
            int c = 0;
#pragma unroll
            for (int k = 0; k < 8; ++k) c += __builtin_popcountll(__ballot(kk[k] == T && ii[k] < cand));
            if (c < need) X = cand;
        }
    }
    int base = 0;
    const unsigned long long lt = (1ull << lane) - 1ull;
#pragma unroll
    for (int k = 0; k < 8; ++k) {
        const bool keep = (kk[k] > T) || (kk[k] == T && ii[k] <= X);
        const unsigned long long m = __ballot(keep);
        if (keep) { const int pos = base + __builtin_popcountll(m & lt); ck[pos] = kk[k]; ci[pos] = (unsigned short)ii[k]; }
        base += __builtin_popcountll(m);
    }
    return T;
}

__device__ __forceinline__ void dsa_tile(const Params& p, int tt, unsigned char* smem) {
    const int tid = threadIdx.x, lane = tid & 63, wave = tid >> 6, col = lane & 31, hi = lane >> 5;
    unsigned* ckb = (unsigned*)(smem + DSA_CK);
    unsigned short* cib = (unsigned short*)(smem + DSA_CI);
    float* lut = (float*)(smem + DSA_LUT);
    const bf16_t* iqb = (const bf16_t*)(p.ws + WS_IQB);
    const bf16_t* ikb = (const bf16_t*)(p.ws + WS_IKB);
    const float* iws = (const float*)(p.ws + WS_IWS);
    const bf16_t* dqb = (const bf16_t*)(p.ws + WS_DQB);
    const bf16_t* dkb = (const bf16_t*)(p.ws + WS_DKB);
    const bf16_t* dvb = (const bf16_t*)(p.ws + WS_DVB);
    const float* relb = p.in[17];
    const int t0 = tt * 16;
    __syncthreads();
    for (int i = tid; i < 1024; i += NT) { const int hh = i >> 7, n = i & 127; lut[i] = relb[bucket_of(n) * 16 + 8 + hh] * LOG2E; }
    __syncthreads();
    const int tw = t0 + 4 * wave;
    bf16x8 af[2];
    {
        const int rho = col;
        const int tl_ = 2 * ((rho >> 2) & 1) + (rho >> 4), hd = 4 * ((rho >> 3) & 1) + (rho & 3);
#pragma unroll
        for (int ks = 0; ks < 2; ++ks) af[ks] = *(const bf16x8*)(iqb + (size_t)(tw + tl_) * 256 + hd * 32 + ks * 16 + hi * 8);
    }
    const int tokA = tw + 2 * hi, tokB = tokA + 1;
    float wA[8], wB[8];
#pragma unroll
    for (int h = 0; h < 8; ++h) { wA[h] = iws[(size_t)tokA * 8 + h]; wB[h] = iws[(size_t)tokB * 8 + h]; }
    unsigned* ckA = ckb + (4 * wave + 2 * hi) * 512;
    unsigned* ckB = ckA + 512;
    unsigned short* ciA = cib + (4 * wave + 2 * hi) * 512;
    unsigned short* ciB = ciA + 512;
    int cntA = 0, cntB = 0;
    unsigned LA = 0, LB = 0;
    const unsigned ltm = (1u << col) - 1u;
    const int nchunk = (tw + 4 + 31) >> 5;
    const f32x16 zero16 = {0.f, 0.f, 0.f, 0.f, 0.f, 0.f, 0.f, 0.f, 0.f, 0.f, 0.f, 0.f, 0.f, 0.f, 0.f, 0.f};
#pragma unroll 1
    for (int ch = 0; ch < nchunk; ++ch) {
        const int kidx = ch * 32 + col;
        const bf16x8 b0 = *(const bf16x8*)(ikb + (size_t)kidx * 32 + hi * 8);
        const bf16x8 b1 = *(const bf16x8*)(ikb + (size_t)kidx * 32 + 16 + hi * 8);
        f32x16 c = __builtin_amdgcn_mfma_f32_32x32x16_bf16(af[0], b0, zero16, 0, 0, 0);
        c = __builtin_amdgcn_mfma_f32_32x32x16_bf16(af[1], b1, c, 0, 0, 0);
        float sA = 0.f, sB = 0.f;
#pragma unroll
        for (int h = 0; h < 8; ++h) { sA += wA[h] * fmaxf(c[h], 0.f); sB += wB[h] * fmaxf(c[8 + h], 0.f); }
        const unsigned keyA = mono_key(sA), keyB = mono_key(sB);
        const bool pA = (kidx <= tokA) && (keyA > LA), pB = (kidx <= tokB) && (keyB > LB);
        const unsigned long long mA = __ballot(pA), mB = __ballot(pB);
        const unsigned hA = hi ? (unsigned)(mA >> 32) : (unsigned)mA, hB = hi ? (unsigned)(mB >> 32) : (unsigned)mB;
        if (pA) { const int pos = cntA + __builtin_popcount(hA & ltm); ckA[pos] = keyA; ciA[pos] = (unsigned short)kidx; }
        if (pB) { const int pos = cntB + __builtin_popcount(hB & ltm); ckB[pos] = keyB; ciB[pos] = (unsigned short)kidx; }
        cntA += __builtin_popcount(hA); cntB += __builtin_popcount(hB);
        if ((ch & 7) == 7 || ch == nchunk - 1) {
#pragma unroll
            for (int tq = 0; tq < 4; ++tq) {
                const int cn = __shfl((tq & 1) ? cntB : cntA, (tq >> 1) * 32);
                if (cn > 256) {
                    const unsigned T = dsa_compact(ckb + (4 * wave + tq) * 512, cib + (4 * wave + tq) * 512, cn, lane);
                    if (hi == (tq >> 1)) { if (tq & 1) { cntB = 256; LB = T; } else { cntA = 256; LA = T; } }
                }
            }
        }
    }
    float U2;
    {
        const float mq = wave_max(fabsf(p.in[6][lane])), mk = wave_max(fabsf(p.in[7][lane]));
        float mb = 0.f;
#pragma unroll
        for (int k = 0; k < 4; ++k) { const int e = lane + 64 * k; mb = fmaxf(mb, fabsf(relb[(e >> 3) * 16 + 8 + (e & 7)])); }
        mb = wave_max(mb);
        U2 = (8.f * mq * mk + mb) * LOG2E;
    }
    const int hh = lane >> 3;
    const float* lutp = lut + hh * 128;
#pragma unroll 1
    for (int tq = 0; tq < 4; ++tq) {
        const int tk = tw + tq;
        int nsel = __shfl((tq & 1) ? cntB : cntA, (tq >> 1) * 32);
        nsel = nsel > 256 ? 256 : nsel;
        const unsigned short* sl = cib + (4 * wave + tq) * 512;
        float q[8];
        {
            const uint4 qv = *(const uint4*)(dqb + (size_t)tk * 512 + lane * 8);
            q[0] = __builtin_bit_cast(float, qv.x << 16); q[1] = __builtin_bit_cast(float, qv.x & 0xffff0000u);
            q[2] = __builtin_bit_cast(float, qv.y << 16); q[3] = __builtin_bit_cast(float, qv.y & 0xffff0000u);
            q[4] = __builtin_bit_cast(float, qv.z << 16); q[5] = __builtin_bit_cast(float, qv.z & 0xffff0000u);
            q[6] = __builtin_bit_cast(float, qv.w << 16); q[7] = __builtin_bit_cast(float, qv.w & 0xffff0000u);
        }
        float o[8];
#pragma unroll
        for (int j = 0; j < 8; ++j) o[j] = 0.f;
        float lsum = 0.f;
#pragma unroll 4
        for (int k = 0; k < nsel; ++k) {
            const int s = (int)sl[k];
            const uint4 kv = *(const uint4*)(dkb + (size_t)s * 512 + lane * 8);
            const uint4 vv = *(const uint4*)(dvb + (size_t)s * 512 + lane * 8);
            float d = q[0] * __builtin_bit_cast(float, kv.x << 16) + q[1] * __builtin_bit_cast(float, kv.x & 0xffff0000u)
                    + q[2] * __builtin_bit_cast(float, kv.y << 16) + q[3] * __builtin_bit_cast(float, kv.y & 0xffff0000u)
                    + q[4] * __builtin_bit_cast(float, kv.z << 16) + q[5] * __builtin_bit_cast(float, kv.z & 0xffff0000u)
                    + q[6] * __builtin_bit_cast(float, kv.w << 16) + q[7] * __builtin_bit_cast(float, kv.w & 0xffff0000u);
            d += __shfl_xor(d, 1); d += __shfl_xor(d, 2); d += __shfl_xor(d, 4);
            int dist = tk - s; dist = dist > 127 ? 127 : dist;
            const float pr = __builtin_amdgcn_exp2f(d + lutp[dist] - U2);
            lsum += pr;
            o[0] += pr * __builtin_bit_cast(float, vv.x << 16); o[1] += pr * __builtin_bit_cast(float, vv.x & 0xffff0000u);
            o[2] += pr * __builtin_bit_cast(float, vv.y << 16); o[3] += pr * __builtin_bit_cast(float, vv.y & 0xffff0000u);
            o[4] += pr * __builtin_bit_cast(float, vv.z << 16); o[5] += pr * __builtin_bit_cast(float, vv.z & 0xffff0000u);
            o[6] += pr * __builtin_bit_cast(float, vv.w << 16); o[7] += pr * __builtin_bit_cast(float, vv.w & 0xffff0000u);
        }
        const float inv = lsum > 0.f ? 1.f / lsum : 0.f;
        uint4 ov;
        ov.x = pk2(o[0] * inv, o[1] * inv); ov.y = pk2(o[2] * inv, o[3] * inv); ov.z = pk2(o[4] * inv, o[5] * inv); ov.w = pk2(o[6] * inv, o[7] * inv);
        *(uint4*)((bf16_t*)(p.ws + WS_OB) + (size_t)tk * 512 + lane * 8) = ov;
    }
}

__device__ __forceinline__ void phase_attn(const Params& p, int bid, int nb, unsigned char* smem) {
    for (int w = bid; w < 1024 + 2048; w += nb) {
        if (w < 1024) dsa_tile(p, 1023 - w, smem);
        else { const int i = w - 1024; nsa_tile(p, 1023 - (i >> 1), i & 1, smem); }
    }
}

template <int PASS>
__device__ __forceinline__ void phase_merge(const Params& p, int bid, int nb, unsigned char* smem) {
    const float* z = (const float*)(p.ws + WS_Z);
    bf16_t* merged = (bf16_t*)(p.ws + WS_MERGED);
    float* tmp = (float*)(p.ws + WS_X1);
    const bf16_t* A = (const bf16_t*)(p.ws + (PASS ? WS_OB : WS_OA));
    const bf16_t* Bw = (const bf16_t*)(p.ws + (PASS ? WB_B : WB_A));
    constexpr int zoff = PASS ? Z_GB : Z_GA;
    for (int w = bid; w < 128 * 8; w += nb) {
        const int mt = w % 128, nt = w / 128;
        const int m0 = mt * 128, n0 = nt * 128;
        f32x4 acc[4][4];
        gemm2<false, false>(A, 512, nullptr, m0, 128, Bw, D, n0, 128, 512, smem, acc);
#pragma unroll
        for (int i = 0; i < 4; ++i)
#pragma unroll
            for (int r = 0; r < 4; ++r) {
                const int row = m0 + G2_ROW(i, r);
                const float* zr = z + (size_t)row * DIN + zoff + n0 + G2_COL(0);
                float* tr = tmp + (size_t)row * D + n0 + G2_COL(0);
                bf16_t* mr = merged + (size_t)row * D + n0 + G2_COL(0);
#pragma unroll
                for (int j = 0; j < 4; ++j) {
                    const float v = sigmoidf_(zr[j * 16]) * acc[i][j][r];
                    if (PASS == 0) tr[j * 16] = v;
                    else mr[j * 16] = (bf16_t)f2bf(tr[j * 16] + v);
                }
            }
    }
}

__device__ __forceinline__ void phase_outproj(const Params& p, int bid, int nb, unsigned char* smem) {
    const bf16_t* merged = (const bf16_t*)(p.ws + WS_MERGED);
    const float* x = p.in[0];
    float* x1 = (float*)(p.ws + WS_X1);
    for (int w = bid; w < 128 * 8; w += nb) {
        const int mt = w % 128, nt = w / 128;
        const int m0 = mt * 128, n0 = nt * 128;
        f32x4 acc[4][4];
        gemm2<false, false>(merged, D, nullptr, m0, 128, (const bf16_t*)(p.ws + WB_OUT), D, n0, 128, D, smem, acc);
#pragma unroll
        for (int i = 0; i < 4; ++i)
#pragma unroll
            for (int r = 0; r < 4; ++r) {
                const size_t ro = (size_t)(m0 + G2_ROW(i, r)) * D + n0;
#pragma unroll
                for (int j = 0; j < 4; ++j) { const int c = G2_COL(j); x1[ro + c] = x[ro + c] + acc[i][j][r]; }
            }
    }
}

__device__ __forceinline__ void phase_route(const Params& p, int bid, int nb) {
    const int lane = threadIdx.x & 63, wave = threadIdx.x >> 6;
    const float* x1 = (const float*)(p.ws + WS_X1);
    const float* g = p.in[18];
    const float* wr = p.in[19];
    const float* br = p.in[20];
    bf16_t* hb = (bf16_t*)(p.ws + WS_HB);
    int* topi = (int*)(p.ws + WS_TOPI);
    float* topw = (float*)(p.ws + WS_TOPW);
    int* cnt = (int*)(p.ws + WS_CTL);
    for (int t = bid * 4 + wave; t < S; t += nb * 4) {
        const float4* xr = (const float4*)(x1 + (size_t)t * D);
        float4 v[4];
        float ss = 0.f;
#pragma unroll
        for (int j = 0; j < 4; ++j) { v[j] = xr[lane + 64 * j]; ss += v[j].x * v[j].x + v[j].y * v[j].y + v[j].z * v[j].z + v[j].w * v[j].w; }
        ss = wave_sum(ss);
        const float rstd = rsqrtf(ss * (1.f / D) + EPS);
        float lg[32];
#pragma unroll
        for (int e = 0; e < 32; ++e) lg[e] = 0.f;
#pragma unroll
        for (int j = 0; j < 4; ++j) {
            const float4 gg = ((const float4*)g)[lane + 64 * j];
            const float h0 = v[j].x * rstd * gg.x, h1 = v[j].y * rstd * gg.y, h2 = v[j].z * rstd * gg.z, h3 = v[j].w * rstd * gg.w;
            uint2 o; o.x = pk2(h0, h1); o.y = pk2(h2, h3);
            ((uint2*)(hb + (size_t)t * D))[lane + 64 * j] = o;
            const int k = 4 * (lane + 64 * j);
            const float4* w0 = (const float4*)(wr + (size_t)k * 32);
#pragma unroll
            for (int e4 = 0; e4 < 8; ++e4) {
                const float4 a = w0[e4], b = w0[8 + e4], c = w0[16 + e4], d = w0[24 + e4];
                lg[4 * e4 + 0] += h0 * a.x + h1 * b.x + h2 * c.x + h3 * d.x;
                lg[4 * e4 + 1] += h0 * a.y + h1 * b.y + h2 * c.y + h3 * d.y;
                lg[4 * e4 + 2] += h0 * a.z + h1 * b.z + h2 * c.z + h3 * d.z;
                lg[4 * e4 + 3] += h0 * a.w + h1 * b.w + h2 * c.w + h3 * d.w;
            }
        }
#pragma unroll
        for (int e = 0; e < 32; ++e) lg[e] = wave_sum(lg[e]) + br[e];
        int idx[4]; float val[4];
        unsigned used = 0;
#pragma unroll
        for (int k = 0; k < 4; ++k) {
            float best = -__builtin_inff(); int bi = 0;
#pragma unroll
            for (int e = 0; e < 32; ++e) { const bool ok = !((used >> e) & 1u) && (lg[e] > best); best = ok ? lg[e] : best; bi = ok ? e : bi; }
            idx[k] = bi; val[k] = best; used |= 1u << bi;
        }
        const float e0 = 1.f, e1 = __expf(val[1] - val[0]), e2 = __expf(val[2] - val[0]), e3 = __expf(val[3] - val[0]);
        const float inv = 1.f / (e0 + e1 + e2 + e3);
        if (lane == 0) {
            topi[t * 4 + 0] = idx[0]; topi[t * 4 + 1] = idx[1]; topi[t * 4 + 2] = idx[2]; topi[t * 4 + 3] = idx[3];
            topw[t * 4 + 0] = e0 * inv; topw[t * 4 + 1] = e1 * inv; topw[t * 4 + 2] = e2 * inv; topw[t * 4 + 3] = e3 * inv;
            atomicAdd(&cnt[idx[0]], 1); atomicAdd(&cnt[idx[1]], 1); atomicAdd(&cnt[idx[2]], 1); atomicAdd(&cnt[idx[3]], 1);
        }
    }
}

__device__ __forceinline__ void phase_place(const Params& p, int bid, int nb, unsigned char* smem) {
    int* off = (int*)smem;
    const int* cnt = (const int*)(p.ws + WS_CTL);
    int* cur = (int*)(p.ws + WS_CTL) + 32;
    const int* topi = (const int*)(p.ws + WS_TOPI);
    int* ppos = (int*)(p.ws + WS_PPOS);
    int* rowtok = (int*)(p.ws + WS_ROWTOK);
    __syncthreads();
    if (threadIdx.x == 0) { int a = 0; for (int e = 0; e < NEXP; ++e) { off[e] = a; a += cnt[e]; } }
    __syncthreads();
    for (int i = bid * NT + threadIdx.x; i < S * 4; i += nb * NT) {
        const int e = topi[i];
        const int pos = off[e] + atomicAdd(&cur[e], 1);
        ppos[i] = pos;
        rowtok[pos] = i >> 2;
    }
}

__device__ __forceinline__ void moe_tile_map(const int* cnt, int* sm, int& total_mt) {
    __syncthreads();
    if (threadIdx.x == 0) {
        int a = 0, b = 0;
        for (int e = 0; e < NEXP; ++e) { sm[e] = a; sm[33 + e] = b; a += (cnt[e] + 127) >> 7; b += cnt[e]; }
        sm[32] = a; sm[65] = b;
    }
    __syncthreads();
    total_mt = sm[32];
}
__device__ __forceinline__ void phase_moe1(const Params& p, int bid, int nb, unsigned char* smem) {
    int* sm = (int*)(smem + 65536);
    const int* cnt = (const int*)(p.ws + WS_CTL);
    const int* rowtok = (const int*)(p.ws + WS_ROWTOK);
    const bf16_t* hb = (const bf16_t*)(p.ws + WS_HB);
    bf16_t* act = (bf16_t*)(p.ws + WS_ACT);
    const int lane = threadIdx.x & 63, wave = threadIdx.x >> 6;
    int total_mt;
    moe_tile_map(cnt, sm, total_mt);
    for (int w = bid; w < total_mt * 16; w += nb) {
        const int tm = w >> 4, nt = w & 15;
        int e = 0;
        while (e < NEXP - 1 && sm[e + 1] <= tm) ++e;
        const int mt = tm - sm[e];
        const int rbase = sm[33 + e] + mt * 128;
        const int mrows = min(128, cnt[e] - mt * 128);
        const int n0 = nt * 64;
        f32x4 acc[4][4];
        gemm2<true, true>(hb, D, rowtok, rbase, mrows, (const bf16_t*)(p.ws + WB_E1) + (size_t)e * D * 2 * DFF, 2 * DFF, n0, 128, D, smem, acc);
        const float* b1 = p.in[22] + (size_t)e * 2 * DFF;
        const int wn_ = (threadIdx.x >> 6) & 1;
#pragma unroll
        for (int i = 0; i < 4; ++i)
#pragma unroll
            for (int jp = 0; jp < 2; ++jp) {
                const int col = n0 + (wn_ * 2 + jp) * 16 + (threadIdx.x & 15);
                const float bg = b1[col], bl = b1[DFF + col];
#pragma unroll
                for (int r = 0; r < 4; ++r) {
                    const int rl = G2_ROW(i, r);
                    if (rl < mrows) {
                        const float gate = fminf(acc[i][2 * jp][r] + bg, 7.f);
                        const float lin = fminf(fmaxf(acc[i][2 * jp + 1][r] + bl, -7.f), 7.f);
                        const float a_ = (lin + 1.f) * gate * sigmoidf_(1.702f * gate);
                        act[(size_t)(rbase + rl) * DFF + col] = (bf16_t)f2bf(a_);
                    }
                }
            }
    }
}
__device__ __forceinline__ void phase_moe2(const Params& p, int bid, int nb, unsigned char* smem) {
    int* sm = (int*)(smem + 65536);
    const int* cnt = (const int*)(p.ws + WS_CTL);
    const bf16_t* act = (const bf16_t*)(p.ws + WS_ACT);
    float* yrows = (float*)(p.ws + WS_YROWS);
    const int lane = threadIdx.x & 63, wave = threadIdx.x >> 6;
    int total_mt;
    moe_tile_map(cnt, sm, total_mt);
    for (int w = bid; w < total_mt * 8; w += nb) {
        const int tm = w >> 3, nt = w & 7;
        int e = 0;
        while (e < NEXP - 1 && sm[e + 1] <= tm) ++e;
        const int mt = tm - sm[e];
        const int rbase = sm[33 + e] + mt * 128;
        const int mrows = min(128, cnt[e] - mt * 128);
        const int n0 = nt * 128;
        f32x4 acc[4][4];
        gemm2<false, false>(act, DFF, nullptr, rbase, mrows, (const bf16_t*)(p.ws + WB_E2) + (size_t)e * DFF * D, D, n0, 128, DFF, smem, acc);
        const float* b2 = p.in[24] + (size_t)e * D + n0;
#pragma unroll
        for (int i = 0; i < 4; ++i)
#pragma unroll
            for (int r = 0; r < 4; ++r) {
                const int rl = G2_ROW(i, r);
                if (rl < mrows) {
                    float* yr = yrows + (size_t)(rbase + rl) * D + n0;
#pragma unroll
                    for (int j = 0; j < 4; ++j) { const int c = G2_COL(j); yr[c] = acc[i][j][r] + b2[c]; }
                }
            }
    }
}

__device__ __forceinline__ void phase_combine(const Params& p, int bid, int nb) {
    const int lane = threadIdx.x & 63, wave = threadIdx.x >> 6;
    const float* x1 = (const float*)(p.ws + WS_X1);
    const float* yrows = (const float*)(p.ws + WS_YROWS);
    const int* ppos = (const int*)(p.ws + WS_PPOS);
    const float* topw = (const float*)(p.ws + WS_TOPW);
    const float* g = p.in[25];
    bf16_t* hb = (bf16_t*)(p.ws + WS_HB);
    bf16_t* pb = (bf16_t*)(p.ws + WS_PB);
    for (int t = bid * 4 + wave; t < S; t += nb * 4) {
        {
            const float4 pv = ((const float4*)(p.in[1] + (size_t)t * 256))[lane];
            uint2 o; o.x = pk2(pv.x, pv.y); o.y = pk2(pv.z, pv.w);
            ((uint2*)(pb + (size_t)t * 256))[lane] = o;
        }
        float4 v[4];
#pragma unroll
        for (int j = 0; j < 4; ++j) v[j] = ((const float4*)(x1 + (size_t)t * D))[lane + 64 * j];
#pragma unroll
        for (int k = 0; k < 4; ++k) {
            const float wk = topw[t * 4 + k];
            const float4* yr = (const float4*)(yrows + (size_t)ppos[t * 4 + k] * D);
#pragma unroll
            for (int j = 0; j < 4; ++j) { const float4 y = yr[lane + 64 * j]; v[j].x += wk * y.x; v[j].y += wk * y.y; v[j].z += wk * y.z; v[j].w += wk * y.w; }
        }
        float ss = 0.f;
#pragma unroll
        for (int j = 0; j < 4; ++j) ss += v[j].x * v[j].x + v[j].y * v[j].y + v[j].z * v[j].z + v[j].w * v[j].w;
        ss = wave_sum(ss);
        const float rstd = rsqrtf(ss * (1.f / D) + EPS);
#pragma unroll
        for (int j = 0; j < 4; ++j) {
            ((float4*)(p.out + (size_t)t * D))[lane + 64 * j] = v[j];
            const float4 gg = ((const float4*)g)[lane + 64 * j];
            uint2 o;
            o.x = pk2(v[j].x * rstd * gg.x, v[j].y * rstd * gg.y);
            o.y = pk2(v[j].z * rstd * gg.z, v[j].w * rstd * gg.w);
            ((uint2*)(hb + (size_t)t * D))[lane + 64 * j] = o;
        }
    }
}

template <int PASS>
__device__ __forceinline__ void phase_ple(const Params& p, int bid, int nb, unsigned char* smem) {
    float* tmp = (float*)(p.ws + WS_X1);
    const bf16_t* A = (const bf16_t*)(p.ws + (PASS ? WS_PB : WS_HB));
    const bf16_t* Bw = (const bf16_t*)(p.ws + (PASS ? WB_PLE : WB_PLEG));
    constexpr int K = PASS ? 256 : D;
    for (int w = bid; w < 128 * 8; w += nb) {
        const int mt = w % 128, nt = w / 128;
        const int m0 = mt * 128, n0 = nt * 128;
        f32x4 acc[4][4];
        gemm2<false, false>(A, K, nullptr, m0, 128, Bw, D, n0, 128, K, smem, acc);
#pragma unroll
        for (int i = 0; i < 4; ++i)
#pragma unroll
            for (int r = 0; r < 4; ++r) {
                const size_t ro = (size_t)(m0 + G2_ROW(i, r)) * D + n0 + G2_COL(0);
                float* tr = tmp + ro;
                float* orow = p.out + ro;
#pragma unroll
                for (int j = 0; j < 4; ++j) {
                    if (PASS == 0) tr[j * 16] = sigmoidf_(acc[i][j][r]);
                    else orow[j * 16] = orow[j * 16] + tr[j * 16] * acc[i][j][r];
                }
            }
    }
}

template <int PH>
__device__ __forceinline__ void run_phase(const Params& p, int bid, int nb, unsigned char* smem) {
    if (PH == 0) phase_prep(p, bid, nb);
    if (PH == 1) phase_inproj(p, bid, nb, smem);
    if (PH == 2) phase_post(p, bid, nb);
    if (PH == 3) phase_compress(p, bid, nb);
    if (PH == 4) phase_attn(p, bid, nb, smem);
    if (PH == 5) phase_merge<0>(p, bid, nb, smem);
    if (PH == 13) phase_merge<1>(p, bid, nb, smem);
    if (PH == 6) phase_outproj(p, bid, nb, smem);
    if (PH == 7) phase_route(p, bid, nb);
    if (PH == 8) phase_place(p, bid, nb, smem);
    if (PH == 9) phase_moe1(p, bid, nb, smem);
    if (PH == 10) phase_moe2(p, bid, nb, smem);
    if (PH == 11) phase_combine(p, bid, nb);
    if (PH == 12) phase_ple<0>(p, bid, nb, smem);
    if (PH == 14) phase_ple<1>(p, bid, nb, smem);
}

#if SINGLE_LAUNCH
__global__ void __launch_bounds__(NT, 2) fwd_mega(Params p) {
    __shared__ __attribute__((aligned(16))) unsigned char smem[SMEM_BYTES];
    cg::grid_group grid = cg::this_grid();
    const int bid = blockIdx.x, nb = gridDim.x;
    run_phase<0>(p, bid, nb, smem); grid.sync();
    run_phase<1>(p, bid, nb, smem); grid.sync();
    run_phase<2>(p, bid, nb, smem); grid.sync();
    run_phase<3>(p, bid, nb, smem); grid.sync();
    run_phase<4>(p, bid, nb, smem); grid.sync();
    run_phase<5>(p, bid, nb, smem); grid.sync();
    run_phase<13>(p, bid, nb, smem); grid.sync();
    run_phase<6>(p, bid, nb, smem); grid.sync();
    run_phase<7>(p, bid, nb, smem); grid.sync();
    run_phase<8>(p, bid, nb, smem); grid.sync();
    run_phase<9>(p, bid, nb, smem); grid.sync();
    run_phase<10>(p, bid, nb, smem); grid.sync();
    run_phase<11>(p, bid, nb, smem); grid.sync();
    run_phase<12>(p, bid, nb, smem); grid.sync();
    run_phase<14>(p, bid, nb, smem);
}
#else
template <int PH>
__global__ void __launch_bounds__(NT, 2) k_phase(Params p) {
    __shared__ __attribute__((aligned(16))) unsigned char smem[SMEM_BYTES];
    run_phase<PH>(p, blockIdx.x, gridDim.x, smem);
}
#endif

extern "C" void kernel_launch(void* const* d_in, const int* in_sizes, int n_in, void* d_out, int out_size, void* d_ws, size_t ws_size,
                              hipStream_t stream) {
    if (n_in != 28 || ws_size < WS_END) { fprintf(stderr, "kernel_launch: unexpected n_in %d or ws_size %zu (< %zu)\n", n_in, ws_size, (size_t)WS_END); return; }
    Params p{};
    for (int i = 0; i < 28; ++i) p.in[i] = (const float*)d_in[i];
    p.out = (float*)d_out;
    p.ws = (unsigned char*)d_ws;
#if SINGLE_LAUNCH
    static int grid_blocks = 0;
    if (!grid_blocks) {
        int dev = 0, cus = 0, per_cu = 0;
        hipGetDevice(&dev);
        hipDeviceGetAttribute(&cus, hipDeviceAttributeMultiprocessorCount, dev);
        hipOccupancyMaxActiveBlocksPerMultiprocessor(&per_cu, fwd_mega, NT, 0);
        if (per_cu > 2) per_cu = 2;
        if (per_cu < 1) per_cu = 1;
        grid_blocks = cus * per_cu;
    }
    void* args[] = {&p};
    hipError_t e = hipLaunchCooperativeKernel((void*)fwd_mega, dim3(grid_blocks), dim3(NT), args, 0, stream);
    if (e != hipSuccess) fprintf(stderr, "cooperative launch failed: %s (grid %d)\n", hipGetErrorString(e), grid_blocks);
#else
    const int G = 512;
    k_phase<0><<<G, NT, 0, stream>>>(p);
    k_phase<1><<<G, NT, 0, stream>>>(p);
    k_phase<2><<<G, NT, 0, stream>>>(p);
    k_phase<3><<<G, NT, 0, stream>>>(p);
    k_phase<4><<<G, NT, 0, stream>>>(p);
    k_phase<5><<<G, NT, 0, stream>>>(p);
    k_phase<13><<<G, NT, 0, stream>>>(p);
    k_phase<6><<<G, NT, 0, stream>>>(p);
    k_phase<7><<<G, NT, 0, stream>>>(p);
    k_phase<8><<<G, NT, 0, stream>>>(p);
    k_phase<9><<<G, NT, 0, stream>>>(p);
    k_phase<10><<<G, NT, 0, stream>>>(p);
    k_phase<11><<<G, NT, 0, stream>>>(p);
    k_phase<12><<<G, NT, 0, stream>>>(p);
    k_phase<14><<<G, NT, 0, stream>>>(p);
#endif
}
```

```cpp
#include <hip/hip_runtime.h>
#include <hip/hip_cooperative_groups.h>
#include <cstdio>
#include <cstdint>
namespace cg = cooperative_groups;

#ifndef SINGLE_LAUNCH
#define SINGLE_LAUNCH 1
#endif

constexpr int S = 16384;
constexpr int D = 1024;
constexpr int DIN = 5184;
constexpr int NCMP = 1023;
constexpr int NSLC = 256;
constexpr int NEXP = 32;
constexpr int DFF = 1024;
constexpr float EPS = 1e-6f;
constexpr float LOG2E = 1.4426950408889634f;
constexpr int Z_NQ = 0, Z_NKV = 512, Z_NGATE = 1280, Z_DQ = 1304, Z_DK = 1816, Z_DV = 2328, Z_IQ = 2840, Z_IK = 3096,
              Z_IW = 3128, Z_GA = 3136, Z_GB = 4160;

constexpr int NT = 256;
constexpr int SMEM_BYTES = 73728;

typedef unsigned short bf16_t;
typedef short bf16x8 __attribute__((ext_vector_type(8)));
typedef float f32x4 __attribute__((ext_vector_type(4)));
typedef short s16x4 __attribute__((ext_vector_type(4)));
typedef __attribute__((address_space(3))) s16x4* lds_s16x4_ptr;
__device__ __forceinline__ s16x4 lds_tr16(const void* p) {
    return __builtin_amdgcn_ds_read_tr16_b64_v4i16((lds_s16x4_ptr)(uintptr_t)p);
}

constexpr size_t MBy = 1ull << 20;
constexpr size_t WS_CTL = 0;
constexpr size_t WS_BAR = 65536;
constexpr size_t WS_HB = 1 * MBy;
constexpr size_t WS_OA = WS_HB + (size_t)S * D * 2;
constexpr size_t WS_OB = WS_OA + (size_t)S * 512 * 2;
constexpr size_t WS_MERGED = WS_OB + (size_t)S * 512 * 2;
constexpr size_t WS_X1 = WS_MERGED + (size_t)S * D * 2;
constexpr size_t WS_TOPI = WS_X1 + (size_t)S * D * 4;
constexpr size_t WS_TOPW = WS_TOPI + (size_t)S * 4 * 4;
constexpr size_t WS_PPOS = WS_TOPW + (size_t)S * 4 * 4;
constexpr size_t WS_ROWTOK = WS_PPOS + (size_t)S * 4 * 4;
constexpr size_t WS_PB = WS_ROWTOK + (size_t)65536 * 4;
constexpr size_t WS_REG = WS_PB + (size_t)S * 256 * 2;
constexpr size_t WS_Z = WS_REG;
constexpr size_t WS_GT = WS_Z + (size_t)S * DIN * 4;
constexpr size_t WS_IWS = WS_GT + (size_t)S * 32 * 4;
constexpr size_t WS_QNB = WS_IWS + (size_t)S * 8 * 4;
constexpr size_t WS_KSLB = WS_QNB + (size_t)S * 512 * 2;
constexpr size_t WS_VSLB = WS_KSLB + (size_t)S * 128 * 2;
constexpr size_t WS_KWNB = WS_VSLB + (size_t)S * 128 * 2;
constexpr size_t WS_VWNB = WS_KWNB + (size_t)S * 128 * 2;
constexpr size_t WS_KCB = WS_VWNB + (size_t)S * 128 * 2;
constexpr size_t WS_VCB = WS_KCB + (size_t)2 * 1024 * 64 * 2;
constexpr size_t WS_DQB = WS_VCB + (size_t)2 * 1024 * 64 * 2;
constexpr size_t WS_DKB = WS_DQB + (size_t)S * 512 * 2;
constexpr size_t WS_DVB = WS_DKB + (size_t)S * 512 * 2;
constexpr size_t WS_IQB = WS_DVB + (size_t)S * 512 * 2;
constexpr size_t WS_IKB = WS_IQB + (size_t)S * 256 * 2;
constexpr size_t WS_ENDA = WS_IKB + (size_t)S * 32 * 2;
constexpr size_t WS_ACT = WS_REG;
constexpr size_t WS_YROWS = WS_ACT + (size_t)(65536 + 128) * DFF * 2;
constexpr size_t WS_ENDB = WS_YROWS + (size_t)(65536 + 128) * D * 4;
constexpr size_t WS_END0 = WS_ENDA > WS_ENDB ? WS_ENDA : WS_ENDB;
constexpr size_t WB_IN = WS_END0;
constexpr size_t WB_A = WB_IN + (size_t)D * DIN * 2;
constexpr size_t WB_B = WB_A + (size_t)512 * D * 2;
constexpr size_t WB_OUT = WB_B + (size_t)512 * D * 2;
constexpr size_t WB_E1 = WB_OUT + (size_t)D * D * 2;
constexpr size_t WB_E2 = WB_E1 + (size_t)NEXP * D * 2 * DFF * 2;
constexpr size_t WB_PLE = WB_E2 + (size_t)NEXP * DFF * D * 2;
constexpr size_t WB_PLEG = WB_PLE + (size_t)256 * D * 2;
constexpr size_t WS_END = WB_PLEG + (size_t)D * D * 2;

struct Params {
    const float* in[28];
    float* out;
    unsigned char* ws;
};

__device__ __forceinline__ unsigned f2bf(float f) {
    unsigned u = __builtin_bit_cast(unsigned, f);
    return (u + 0x7fffu + ((u >> 16) & 1u)) >> 16;
}
__device__ __forceinline__ unsigned pk2(float lo, float hi) { return f2bf(lo) | (f2bf(hi) << 16); }
__device__ __forceinline__ float bf2f(unsigned short b) { return __builtin_bit_cast(float, (unsigned)b << 16); }
__device__ __forceinline__ float wave_sum(float v) {
#pragma unroll
    for (int o = 1; o < 64; o <<= 1) v += __shfl_xor(v, o);
    return v;
}
__device__ __forceinline__ float wave_max(float v) {
#pragma unroll
    for (int o = 1; o < 64; o <<= 1) v = fmaxf(v, __shfl_xor(v, o));
    return v;
}
__device__ __forceinline__ float sigmoidf_(float x) { return 1.f / (1.f + __expf(-x)); }
__device__ __forceinline__ int bucket_of(int n) {
    if (n < 16) return n;
    int b = 16;
    b += (n >= 19) + (n >= 21) + (n >= 24) + (n >= 27) + (n >= 31) + (n >= 35) + (n >= 40) + (n >= 46) + (n >= 52) + (n >= 59) +
         (n >= 67) + (n >= 77) + (n >= 87) + (n >= 99) + (n >= 113);
    return b;
}

constexpr int LDS_STRIDE = 40;
constexpr int BTR_STRIDE = 136;
template <bool A_F32, bool GATHER, bool SPLIT = false, bool BTR = true>
__device__ __forceinline__ void gemm_tile(const void* __restrict__ Aptr, int lda, const int* __restrict__ rowidx, int m0, int mrows,
                                          const float* __restrict__ B, int ldb, int n0, int split_off, int ncols, int K,
                                          unsigned char* smem, f32x4 (&acc)[2][8]) {
    bf16_t* As = (bf16_t*)smem;
    bf16_t* Bs = As + 128 * LDS_STRIDE;
    bf16_t* AsL = Bs + 128 * LDS_STRIDE;
    bf16_t* BsL = AsL + 128 * LDS_STRIDE;
    const int tid = threadIdx.x, lane = tid & 63, wave = tid >> 6;
#pragma unroll
    for (int i = 0; i < 2; ++i)
#pragma unroll
        for (int j = 0; j < 8; ++j) acc[i][j] = (f32x4){0.f, 0.f, 0.f, 0.f};
    auto lo = [](float v) { return v - bf2f((unsigned short)f2bf(v)); };

    const int ar = tid >> 2, ach = tid & 3;
    const unsigned char* arow[2];
    bool aval[2];
#pragma unroll
    for (int i = 0; i < 2; ++i) {
        int r = ar + 64 * i;
        aval[i] = r < mrows;
        long src = 0;
        if (aval[i]) src = GATHER ? (long)rowidx[m0 + r] : (long)(m0 + r);
        arow[i] = (const unsigned char*)Aptr + (size_t)src * lda * (A_F32 ? 4 : 2) + (size_t)ach * 8 * (A_F32 ? 4 : 2);
    }
    const int nq = tid & 31, kq = tid >> 5;
    const int jn = 4 * nq;
    const bool bval = jn < ncols;
    const float* bptr = B + (size_t)(4 * kq) * ldb + n0 + jn + (jn >= 64 ? split_off : 0);

    uint4 areg[2];
    float4 af0a, af0b, af1a, af1b;
    float4 breg[4];
    auto load_g = [&](int k0) {
#pragma unroll
        for (int i = 0; i < 2; ++i) {
            if (A_F32) {
                float4 t0 = make_float4(0, 0, 0, 0), t1 = t0;
                if (aval[i]) {
                    const float4* s = (const float4*)(arow[i] + (size_t)k0 * 4);
                    t0 = s[0]; t1 = s[1];
                }
                if (i == 0) { af0a = t0; af0b = t1; } else { af1a = t0; af1b = t1; }
            } else {
                if (aval[i]) areg[i] = *(const uint4*)(arow[i] + (size_t)k0 * 2);
                else areg[i] = make_uint4(0, 0, 0, 0);
            }
        }
#pragma unroll
        for (int kk = 0; kk < 4; ++kk) {
            if (bval) breg[kk] = *(const float4*)(bptr + (size_t)(k0 + kk) * ldb);
            else breg[kk] = make_float4(0, 0, 0, 0);
        }
    };
    auto store_l = [&]() {
#pragma unroll
        for (int i = 0; i < 2; ++i) {
            uint4 v;
            const float4 t0 = (i == 0) ? af0a : af1a, t1 = (i == 0) ? af0b : af1b;
            if (A_F32) {
                v.x = pk2(t0.x, t0.y); v.y = pk2(t0.z, t0.w);
                v.z = pk2(t1.x, t1.y); v.w = pk2(t1.z, t1.w);
            } else v = areg[i];
            *(uint4*)(As + (ar + 64 * i) * LDS_STRIDE + ach * 8) = v;
            if (SPLIT && A_F32) {
                v.x = pk2(lo(t0.x), lo(t0.y)); v.y = pk2(lo(t0.z), lo(t0.w));
                v.z = pk2(lo(t1.x), lo(t1.y)); v.w = pk2(lo(t1.z), lo(t1.w));
                *(uint4*)(AsL + (ar + 64 * i) * LDS_STRIDE + ach * 8) = v;
            }
        }
        if (SPLIT) {
            uint2 v;
            v.x = pk2(lo(breg[0].x), lo(breg[1].x)); v.y = pk2(lo(breg[2].x), lo(breg[3].x));
            *(uint2*)(BsL + (jn + 0) * LDS_STRIDE + 4 * kq) = v;
            v.x = pk2(lo(breg[0].y), lo(breg[1].y)); v.y = pk2(lo(breg[2].y), lo(breg[3].y));
            *(uint2*)(BsL + (jn + 1) * LDS_STRIDE + 4 * kq) = v;
            v.x = pk2(lo(breg[0].z), lo(breg[1].z)); v.y = pk2(lo(breg[2].z), lo(breg[3].z));
            *(uint2*)(BsL + (jn + 2) * LDS_STRIDE + 4 * kq) = v;
            v.x = pk2(lo(breg[0].w), lo(breg[1].w)); v.y = pk2(lo(breg[2].w), lo(breg[3].w));
            *(uint2*)(BsL + (jn + 3) * LDS_STRIDE + 4 * kq) = v;
        }
        if (BTR && !SPLIT) {
#pragma unroll
            for (int kk = 0; kk < 4; ++kk) {
                uint2 v; v.x = pk2(breg[kk].x, breg[kk].y); v.y = pk2(breg[kk].z, breg[kk].w);
                *(uint2*)(Bs + (4 * kq + kk) * BTR_STRIDE + jn) = v;
            }
        } else {
            uint2 v;
            v.x = pk2(breg[0].x, breg[1].x); v.y = pk2(breg[2].x, breg[3].x);
            *(uint2*)(Bs + (jn + 0) * LDS_STRIDE + 4 * kq) = v;
            v.x = pk2(breg[0].y, breg[1].y); v.y = pk2(breg[2].y, breg[3].y);
            *(uint2*)(Bs + (jn + 1) * LDS_STRIDE + 4 * kq) = v;
            v.x = pk2(breg[0].z, breg[1].z); v.y = pk2(breg[2].z, breg[3].z);
            *(uint2*)(Bs + (jn + 2) * LDS_STRIDE + 4 * kq) = v;
            v.x = pk2(breg[0].w, breg[1].w); v.y = pk2(breg[2].w, breg[3].w);
            *(uint2*)(Bs + (jn + 3) * LDS_STRIDE + 4 * kq) = v;
        }
    };
    const int nk = K / 32;
    __syncthreads();
    load_g(0);
    store_l();
    __syncthreads();
    const int fr = lane & 15, fq = lane >> 4;
    for (int kt = 0; kt < nk; ++kt) {
        if (kt + 1 < nk) load_g((kt + 1) * 32);
        bf16x8 a[2];
#pragma unroll
        for (int i = 0; i < 2; ++i) a[i] = *(const bf16x8*)(As + (wave * 32 + i * 16 + fr) * LDS_STRIDE + fq * 8);
        if (!SPLIT) {
            bf16x8 b[8];
#pragma unroll
            for (int j = 0; j < 8; ++j) {
                if (BTR && !SPLIT) {
                    const bf16_t* bp = Bs + (8 * fq + (fr >> 2)) * BTR_STRIDE + 16 * j + 4 * (fr & 3);
                    const s16x4 lo4 = lds_tr16(bp), hi4 = lds_tr16(bp + 4 * BTR_STRIDE);
                    b[j] = (bf16x8){lo4[0], lo4[1], lo4[2], lo4[3], hi4[0], hi4[1], hi4[2], hi4[3]};
                } else b[j] = *(const bf16x8*)(Bs + (j * 16 + fr) * LDS_STRIDE + fq * 8);
            }
#pragma unroll
            for (int i = 0; i < 2; ++i)
#pragma unroll
                for (int j = 0; j < 8; ++j) acc[i][j] = __builtin_amdgcn_mfma_f32_16x16x32_bf16(a[i], b[j], acc[i][j], 0, 0, 0);
        } else {
            bf16x8 al[2];
#pragma unroll
            for (int i = 0; i < 2; ++i) al[i] = *(const bf16x8*)(AsL + (wave * 32 + i * 16 + fr) * LDS_STRIDE + fq * 8);
#pragma unroll
            for (int j = 0; j < 8; ++j) {
                const bf16x8 bh = *(const bf16x8*)(Bs + (j * 16 + fr) * LDS_STRIDE + fq * 8);
                const bf16x8 bl = *(const bf16x8*)(BsL + (j * 16 + fr) * LDS_STRIDE + fq * 8);
#pragma unroll
                for (int i = 0; i < 2; ++i) {
                    acc[i][j] = __builtin_amdgcn_mfma_f32_16x16x32_bf16(a[i], bh, acc[i][j], 0, 0, 0);
                    acc[i][j] = __builtin_amdgcn_mfma_f32_16x16x32_bf16(a[i], bl, acc[i][j], 0, 0, 0);
                    acc[i][j] = __builtin_amdgcn_mfma_f32_16x16x32_bf16(al[i], bh, acc[i][j], 0, 0, 0);
                }
            }
        }
        __syncthreads();
        if (kt + 1 < nk) {
            store_l();
            __syncthreads();
        }
    }
}


constexpr int ASTR = 72;
constexpr int BSTR = 136;
template <bool GATHER, bool PAIR>
__device__ __forceinline__ void gemm2(const bf16_t* __restrict__ A, int lda, const int* __restrict__ rowidx, int m0, int mrows,
                                      const bf16_t* __restrict__ B, int ldb, int n0, int ncols, int K, unsigned char* smem,
                                      f32x4 (&acc)[4][4]) {
    bf16_t* As = (bf16_t*)smem;
    bf16_t* Bs = As + 128 * ASTR;
    const int tid = threadIdx.x, lane = tid & 63, wave = tid >> 6, wm = wave >> 1, wn = wave & 1;
#pragma unroll
    for (int i = 0; i < 4; ++i)
#pragma unroll
        for (int j = 0; j < 4; ++j) acc[i][j] = (f32x4){0.f, 0.f, 0.f, 0.f};
    const int arl = tid >> 1, ahalf = tid & 1;
    const int arc = arl < mrows ? arl : mrows - 1;
    const long asrc = GATHER ? (long)rowidx[m0 + arc] : (long)(m0 + arc);
    const bf16_t* ap = A + (size_t)asrc * lda + ahalf * 32;
    const int brow = tid >> 2, bq = tid & 3;
    const bf16_t* bp = B + (size_t)brow * ldb + n0 + (PAIR ? bq * 16 : bq * 32);
    const int boff1 = 8, boff2 = PAIR ? 1024 : 16, boff3 = PAIR ? 1032 : 24;
    bf16_t* asd = As + arl * ASTR + ahalf * 32;
    bf16_t* bsd = Bs + brow * BSTR + bq * 32;
    uint4 a0, a1, a2, a3, b0, b1, b2, b3;
#define G2_LOAD(k0)                                                                                       \
    do {                                                                                                  \
        const bf16_t* ap_ = ap + (k0);                                                                    \
        a0 = *(const uint4*)(ap_); a1 = *(const uint4*)(ap_ + 8);                                         \
        a2 = *(const uint4*)(ap_ + 16); a3 = *(const uint4*)(ap_ + 24);                                   \
        const bf16_t* bp_ = bp + (size_t)(k0) * ldb;                                                      \
        b0 = *(const uint4*)(bp_); b1 = *(const uint4*)(bp_ + boff1);                                     \
        b2 = *(const uint4*)(bp_ + boff2); b3 = *(const uint4*)(bp_ + boff3);                             \
    } while (0)
#define G2_STORE()                                                                                        \
    do {                                                                                                  \
        *(uint4*)(asd) = a0; *(uint4*)(asd + 8) = a1; *(uint4*)(asd + 16) = a2; *(uint4*)(asd + 24) = a3; \
        *(uint4*)(bsd) = b0; *(uint4*)(bsd + 8) = b1; *(uint4*)(bsd + 16) = b2; *(uint4*)(bsd + 24) = b3; \
    } while (0)
    const int nk = K / 64;
    __syncthreads();
    G2_LOAD(0);
    G2_STORE();
    __syncthreads();
    const int fr = lane & 15, fq = lane >> 4;
    const bf16_t* afp = As + (wm * 64 + fr) * ASTR + fq * 8;
    const bf16_t* bfp = Bs + (8 * fq + (fr >> 2)) * BSTR + wn * 64 + 4 * (fr & 3);
    for (int kt = 0; kt < nk; ++kt) {
        if (kt + 1 < nk) G2_LOAD((kt + 1) * 64);
#pragma unroll
        for (int kh = 0; kh < 2; ++kh) {
            bf16x8 a[4], b[4];
#pragma unroll
            for (int i = 0; i < 4; ++i) a[i] = *(const bf16x8*)(afp + i * 16 * ASTR + kh * 32);
#pragma unroll
            for (int j = 0; j < 4; ++j) {
                const bf16_t* q = bfp + kh * 32 * BSTR + j * 16;
                const s16x4 lo4 = lds_tr16(q), hi4 = lds_tr16(q + 4 * BSTR);
                b[j] = (bf16x8){lo4[0], lo4[1], lo4[2], lo4[3], hi4[0], hi4[1], hi4[2], hi4[3]};
            }
#pragma unroll
            for (int i = 0; i < 4; ++i)
#pragma unroll
                for (int j = 0; j < 4; ++j) acc[i][j] = __builtin_amdgcn_mfma_f32_16x16x32_bf16(a[i], b[j], acc[i][j], 0, 0, 0);
        }
        __syncthreads();
        if (kt + 1 < nk) {
            G2_STORE();
            __syncthreads();
        }
    }
#undef G2_LOAD
#undef G2_STORE
}
#define G2_ROW(i, r) ((threadIdx.x >> 7) * 64 + (i) * 16 + 4 * ((threadIdx.x & 63) >> 4) + (r))
#define G2_COL(j) (((((threadIdx.x >> 6) & 1) * 4 + (j)) * 16) + (threadIdx.x & 15))

__device__ __forceinline__ void cvt_weights(const float* __restrict__ src, bf16_t* __restrict__ dst, size_t n, int bid, int nb) {
    const size_t n8 = n >> 3;
    for (size_t i = (size_t)bid * NT + threadIdx.x; i < n8; i += (size_t)nb * NT) {
        const float4 u = ((const float4*)src)[2 * i], v = ((const float4*)src)[2 * i + 1];
        uint4 o; o.x = pk2(u.x, u.y); o.y = pk2(u.z, u.w); o.z = pk2(v.x, v.y); o.w = pk2(v.z, v.w);
        ((uint4*)dst)[i] = o;
    }
}
__device__ __forceinline__ void phase_prep(const Params& p, int bid, int nb) {
    const int lane = threadIdx.x & 63, wave = threadIdx.x >> 6;
    if (bid == 0 && threadIdx.x < 64) ((int*)(p.ws + WS_CTL))[threadIdx.x] = 0;
    cvt_weights(p.in[2], (bf16_t*)(p.ws + WB_IN), (size_t)D * DIN, bid, nb);
    cvt_weights(p.in[14], (bf16_t*)(p.ws + WB_A), (size_t)512 * D, bid, nb);
    cvt_weights(p.in[15], (bf16_t*)(p.ws + WB_B), (size_t)512 * D, bid, nb);
    cvt_weights(p.in[16], (bf16_t*)(p.ws + WB_OUT), (size_t)D * D, bid, nb);
    cvt_weights(p.in[21], (bf16_t*)(p.ws + WB_E1), (size_t)NEXP * D * 2 * DFF, bid, nb);
    cvt_weights(p.in[23], (bf16_t*)(p.ws + WB_E2), (size_t)NEXP * DFF * D, bid, nb);
    cvt_weights(p.in[26], (bf16_t*)(p.ws + WB_PLE), (size_t)256 * D, bid, nb);
    cvt_weights(p.in[27], (bf16_t*)(p.ws + WB_PLEG), (size_t)D * D, bid, nb);
    const float* x = p.in[0];
    const float* g = p.in[3];
    bf16_t* hb = (bf16_t*)(p.ws + WS_HB);
    for (int t = bid * 4 + wave; t < S; t += nb * 4) {
        const float4* xr = (const float4*)(x + (size_t)t * D);
        float4 v[4];
        float ss = 0.f;
#pragma unroll
        for (int j = 0; j < 4; ++j) { v[j] = xr[lane + 64 * j]; ss += v[j].x * v[j].x + v[j].y * v[j].y + v[j].z * v[j].z + v[j].w * v[j].w; }
        ss = wave_sum(ss);
        const float rstd = rsqrtf(ss * (1.f / D) + EPS);
#pragma unroll
        for (int j = 0; j < 4; ++j) {
            const float4 gg = ((const float4*)g)[lane + 64 * j];
            uint2 o;
            o.x = pk2(v[j].x * rstd * gg.x, v[j].y * rstd * gg.y);
            o.y = pk2(v[j].z * rstd * gg.z, v[j].w * rstd * gg.w);
            ((uint2*)(hb + (size_t)t * D))[lane + 64 * j] = o;
        }
    }
}

__device__ __forceinline__ void phase_inproj(const Params& p, int bid, int nb, unsigned char* smem) {
    const bf16_t* hb = (const bf16_t*)(p.ws + WS_HB);
    float* z = (float*)(p.ws + WS_Z);
    constexpr int NTN = (DIN + 127) / 128;
    for (int w = bid; w < 128 * NTN; w += nb) {
        const int mt = w % 128, nt = w / 128;
        const int m0 = mt * 128, n0 = nt * 128;
        const int ncols = (DIN - n0) < 128 ? (DIN - n0) : 128;
        f32x4 acc[4][4];
        gemm2<false, false>(hb, D, nullptr, m0, 128, (const bf16_t*)(p.ws + WB_IN), DIN, n0, ncols, D, smem, acc);
#pragma unroll
        for (int i = 0; i < 4; ++i)
#pragma unroll
            for (int r = 0; r < 4; ++r) {
                float* zr = z + (size_t)(m0 + G2_ROW(i, r)) * DIN + n0;
#pragma unroll
                for (int j = 0; j < 4; ++j) { const int c = G2_COL(j); if (c < ncols) zr[c] = acc[i][j][r]; }
            }
    }
}

__device__ __forceinline__ float rms64(float v) { return rsqrtf(wave_sum(v * v) * (1.f / 64.f) + EPS); }
__device__ __forceinline__ void phase_post(const Params& p, int bid, int nb) {
    const int lane = threadIdx.x & 63, wave = threadIdx.x >> 6;
    const float* z = (const float*)(p.ws + WS_Z);
    float* gt = (float*)(p.ws + WS_GT);
    float* iws = (float*)(p.ws + WS_IWS);
    bf16_t* qnb = (bf16_t*)(p.ws + WS_QNB);
    bf16_t* kslb = (bf16_t*)(p.ws + WS_KSLB);
    bf16_t* vslb = (bf16_t*)(p.ws + WS_VSLB);
    bf16_t* kwnb = (bf16_t*)(p.ws + WS_KWNB);
    bf16_t* vwnb = (bf16_t*)(p.ws + WS_VWNB);
    bf16_t* dqb = (bf16_t*)(p.ws + WS_DQB);
    bf16_t* dkb = (bf16_t*)(p.ws + WS_DKB);
    bf16_t* dvb = (bf16_t*)(p.ws + WS_DVB);
    bf16_t* iqb = (bf16_t*)(p.ws + WS_IQB);
    bf16_t* ikb = (bf16_t*)(p.ws + WS_IKB);
    const float gqn = p.in[4][lane], gkn = p.in[5][lane], gqd = p.in[6][lane], gkd = p.in[7][lane];
    for (int t = bid * 4 + wave; t < S; t += nb * 4) {
        const float* zr = z + (size_t)t * DIN;
#pragma unroll
        for (int h = 0; h < 8; ++h) {
            const float v = zr[Z_NQ + h * 64 + lane];
            qnb[(size_t)t * 512 + h * 64 + lane] = (bf16_t)f2bf(v * rms64(v) * gqn * (0.125f * LOG2E));
        }
#pragma unroll
        for (int g = 0; g < 2; ++g) {
            const size_t o_ = ((size_t)g * S + t) * 64 + lane;
            float v = zr[Z_NKV + 2 * 128 + g * 64 + lane];
            kslb[o_] = (bf16_t)f2bf(v * rms64(v) * gkn);
            vslb[o_] = (bf16_t)f2bf(zr[Z_NKV + 3 * 128 + g * 64 + lane]);
            v = zr[Z_NKV + 4 * 128 + g * 64 + lane];
            kwnb[o_] = (bf16_t)f2bf(v * rms64(v) * gkn);
            vwnb[o_] = (bf16_t)f2bf(zr[Z_NKV + 5 * 128 + g * 64 + lane]);
        }
        if (lane < 24) gt[(size_t)t * 32 + lane] = sigmoidf_(zr[Z_NGATE + lane]);
#pragma unroll
        for (int h = 0; h < 8; ++h) {
            float v = zr[Z_DQ + h * 64 + lane];
            dqb[(size_t)t * 512 + h * 64 + lane] = (bf16_t)f2bf(v * rms64(v) * gqd * (0.125f * LOG2E));
            v = zr[Z_DK + h * 64 + lane];
            dkb[(size_t)t * 512 + h * 64 + lane] = (bf16_t)f2bf(v * rms64(v) * gkd);
            dvb[(size_t)t * 512 + h * 64 + lane] = (bf16_t)f2bf(zr[Z_DV + h * 64 + lane]);
        }
#pragma unroll
        for (int j = 0; j < 4; ++j) iqb[(size_t)t * 256 + j * 64 + lane] = (bf16_t)f2bf(zr[Z_IQ + j * 64 + lane] * 0.17677669529663687f);
        if (lane < 32) ikb[(size_t)t * 32 + lane] = (bf16_t)f2bf(zr[Z_IK + lane]);
        if (lane < 8) iws[(size_t)t * 8 + lane] = zr[Z_IW + lane] * 0.35355339059327373f;
    }
}

__device__ __forceinline__ void phase_compress(const Params& p, int bid, int nb) {
    const int lane = threadIdx.x & 63, wave = threadIdx.x >> 6;
    const float* z = (const float*)(p.ws + WS_Z);
    const float gkn = p.in[5][lane];
    for (int it = bid * 4 + wave; it < NCMP * 4; it += nb * 4) {
        const int kind = it & 1, g = (it >> 1) & 1, c = it >> 2;
        const float* pe = p.in[kind ? 11 : 8];
        const float* w1 = p.in[kind ? 12 : 9];
        const float* w2 = p.in[kind ? 13 : 10];
        float acc = 0.f;
        for (int l = 0; l < 32; ++l) {
            const float* zr = z + (size_t)(16 * c + l) * DIN + Z_NKV + kind * 128 + g * 64;
            const float zin = zr[lane] + pe[l * 64 + lane];
            const float* w1l = w1 + (size_t)l * 64 * 64;
#pragma unroll 8
            for (int d = 0; d < 64; ++d) acc += __shfl(zin, d) * w1l[d * 64 + lane];
        }
        const float hid = acc * sigmoidf_(acc);
        float o = 0.f;
#pragma unroll 8
        for (int e = 0; e < 64; ++e) o += __shfl(hid, e) * w2[e * 64 + lane];
        if (kind == 0) {
            o = o * rms64(o) * gkn;
            ((bf16_t*)(p.ws + WS_KCB))[((size_t)g * 1024 + c) * 64 + lane] = (bf16_t)f2bf(o);
        } else {
            ((bf16_t*)(p.ws + WS_VCB))[((size_t)g * 1024 + c) * 64 + lane] = (bf16_t)f2bf(o);
        }
    }
    if (bid == 0) {
        const int tid = threadIdx.x;
        if (tid < 128) ((bf16_t*)(p.ws + WS_KCB))[((size_t)(tid >> 6) * 1024 + 1023) * 64 + (tid & 63)] = 0;
        else ((bf16_t*)(p.ws + WS_VCB))[((size_t)((tid - 128) >> 6) * 1024 + 1023) * 64 + (tid & 63)] = 0;
    }
}

constexpr int KSTR = 72;
constexpr int NSA_KT = 0;
constexpr int NSA_VT = NSA_KT + 32 * KSTR * 2;
constexpr int NSA_WV = NSA_VT + 32 * KSTR * 2;
constexpr int NSA_IMP = NSA_WV + 4 * 32 * KSTR * 2;
constexpr int NSA_LUT = NSA_IMP + 16 * 260 * 4;
constexpr int NSA_SEL = NSA_LUT + 4 * 128 * 4;
constexpr int NSA_END = NSA_SEL + 16 * 16 * 4;
static_assert(NSA_END <= SMEM_BYTES, "nsa lds");

__device__ __forceinline__ f32x4 mfma16(bf16x8 a, bf16x8 b, f32x4 c) { return __builtin_amdgcn_mfma_f32_16x16x32_bf16(a, b, c, 0, 0, 0); }
__device__ __forceinline__ bf16x8 pack_p(const f32x4& p1, const f32x4& p2) {
    const unsigned a = pk2(p1[0], p1[1]), b = pk2(p1[2], p1[3]), c = pk2(p2[0], p2[1]), d = pk2(p2[2], p2[3]);
    return __builtin_bit_cast(bf16x8, make_uint4(a, b, c, d));
}
__device__ __forceinline__ void pv_step(f32x4 (&o)[4], const bf16_t* vt, bf16x8 pb, int fq, int fr) {
    const bf16_t* base = vt + (4 * fq + (fr >> 2)) * KSTR + 4 * (fr & 3);
#pragma unroll
    for (int dt = 0; dt < 4; ++dt) {
        const s16x4 lo4 = lds_tr16(base + dt * 16), hi4 = lds_tr16(base + 16 * KSTR + dt * 16);
        const bf16x8 va = (bf16x8){lo4[0], lo4[1], lo4[2], lo4[3], hi4[0], hi4[1], hi4[2], hi4[3]};
        o[dt] = mfma16(va, pb, o[dt]);
    }
}
__device__ __forceinline__ float quad_sum(float v) {
    v += __shfl_xor(v, 1);
    v += __shfl_xor(v, 2);
    return v;
}

__device__ __forceinline__ void nsa_tile(const Params& p, int tt, int g, unsigned char* smem) {
    const int tid = threadIdx.x, lane = tid & 63, wave = tid >> 6, fr = lane & 15, fq = lane >> 4;
    bf16_t* kt = (bf16_t*)(smem + NSA_KT);
    bf16_t* vt = (bf16_t*)(smem + NSA_VT);
    bf16_t* wv = (bf16_t*)(smem + NSA_WV) + wave * 32 * KSTR;
    float* imp = (float*)(smem + NSA_IMP);
    float* lut = (float*)(smem + NSA_LUT);
    int* sel = (int*)(smem + NSA_SEL);
    const bf16_t* qnb = (const bf16_t*)(p.ws + WS_QNB);
    const bf16_t* kslb = (const bf16_t*)(p.ws + WS_KSLB) + (size_t)g * S * 64;
    const bf16_t* vslb = (const bf16_t*)(p.ws + WS_VSLB) + (size_t)g * S * 64;
    const bf16_t* kwnb = (const bf16_t*)(p.ws + WS_KWNB) + (size_t)g * S * 64;
    const bf16_t* vwnb = (const bf16_t*)(p.ws + WS_VWNB) + (size_t)g * S * 64;
    const bf16_t* kcb = (const bf16_t*)(p.ws + WS_KCB) + (size_t)g * 1024 * 64;
    const bf16_t* vcb = (const bf16_t*)(p.ws + WS_VCB) + (size_t)g * 1024 * 64;
    const float* gt = (const float*)(p.ws + WS_GT);
    const float* relb = p.in[17];
    const int t0 = tt * 16;
    const int tl = 4 * wave + (fr >> 2);
    const int tok = t0 + tl;
    const int hl = fr & 3, head = g * 4 + hl;
    __syncthreads();
    for (int i = tid; i < 512; i += NT) { const int hh = i >> 7, n = i & 127; lut[i] = relb[bucket_of(n) * 16 + g * 4 + hh] * LOG2E; }
    for (int i = tid; i < 16 * 260; i += NT) imp[i] = 0.f;
    float U2;
    {
        const float mq = wave_max(fabsf(p.in[4][lane])), mk = wave_max(fabsf(p.in[5][lane]));
        float mb = 0.f;
#pragma unroll
        for (int k = 0; k < 4; ++k) { const int e = lane + 64 * k; mb = fmaxf(mb, fabsf(relb[(e >> 3) * 16 + (e & 7)])); }
        mb = wave_max(mb);
        U2 = (8.f * mq * mk + mb) * LOG2E;
    }
    bf16x8 qf[2];
#pragma unroll
    for (int kh = 0; kh < 2; ++kh) qf[kh] = *(const bf16x8*)(qnb + (size_t)tok * 512 + head * 64 + kh * 32 + fq * 8);
    __syncthreads();
    const float* lutp = lut + hl * 128;
    const float lutfar = lutp[127];
    const f32x4 zero4 = (f32x4){0.f, 0.f, 0.f, 0.f};
    f32x4 outacc[4];
#pragma unroll
    for (int dt = 0; dt < 4; ++dt) outacc[dt] = zero4;
    const float g0 = gt[(size_t)tok * 32 + head * 3 + 0], g1 = gt[(size_t)tok * 32 + head * 3 + 1], g2 = gt[(size_t)tok * 32 + head * 3 + 2];
    const int srow = tid >> 3, sch = tid & 7;

    {
        int ks0 = (t0 - 511) & ~31; ks0 = ks0 < 0 ? 0 : ks0;
        const int nsteps = (t0 + 16 - ks0 + 31) >> 5;
        f32x4 o[4];
#pragma unroll
        for (int dt = 0; dt < 4; ++dt) o[dt] = zero4;
        float lsum = 0.f;
        uint4 kreg = *(const uint4*)(kwnb + (size_t)(ks0 + srow) * 64 + sch * 8);
        uint4 vreg = *(const uint4*)(vwnb + (size_t)(ks0 + srow) * 64 + sch * 8);
#pragma unroll 1
        for (int st = 0; st < nsteps; ++st) {
            const int ks = ks0 + st * 32;
            *(uint4*)(kt + srow * KSTR + sch * 8) = kreg;
            *(uint4*)(vt + srow * KSTR + sch * 8) = vreg;
            __syncthreads();
            if (st + 1 < nsteps) {
                kreg = *(const uint4*)(kwnb + (size_t)(ks + 32 + srow) * 64 + sch * 8);
                vreg = *(const uint4*)(vwnb + (size_t)(ks + 32 + srow) * 64 + sch * 8);
            }
            f32x4 s1 = zero4, s2 = zero4;
#pragma unroll
            for (int kh = 0; kh < 2; ++kh) {
                const bf16x8 k1 = *(const bf16x8*)(kt + fr * KSTR + kh * 32 + fq * 8);
                const bf16x8 k2 = *(const bf16x8*)(kt + (16 + fr) * KSTR + kh * 32 + fq * 8);
                s1 = mfma16(k1, qf[kh], s1);
                s2 = mfma16(k2, qf[kh], s2);
            }
            const bool far = (t0 + 4 * wave) - (ks + 31) >= 113;
            f32x4 p1, p2;
#pragma unroll
            for (int r = 0; r < 4; ++r) {
                const int d1 = tok - (ks + 4 * fq + r), d2 = d1 - 16;
                const float b1 = far ? lutfar : lutp[d1 < 0 ? 0 : (d1 > 127 ? 127 : d1)];
                const float b2 = far ? lutfar : lutp[d2 < 0 ? 0 : (d2 > 127 ? 127 : d2)];
                p1[r] = (d1 >= 0 && d1 < 512) ? __builtin_amdgcn_exp2f(s1[r] + b1 - U2) : 0.f;
                p2[r] = (d2 >= 0 && d2 < 512) ? __builtin_amdgcn_exp2f(s2[r] + b2 - U2) : 0.f;
                lsum += p1[r] + p2[r];
            }
            pv_step(o, vt, pack_p(p1, p2), fq, fr);
            __syncthreads();
        }
        lsum += __shfl_xor(lsum, 16);
        lsum += __shfl_xor(lsum, 32);
        const float sc = lsum > 0.f ? g2 / lsum : 0.f;
#pragma unroll
        for (int dt = 0; dt < 4; ++dt)
#pragma unroll
            for (int r = 0; r < 4; ++r) outacc[dt][r] += sc * o[dt][r];
    }

    {
        const int tlast = t0 + 15;
        const int cmax = (tlast >= 31) ? ((tlast - 31) >> 4) + 1 : 0;
        const int nsteps = (cmax + 31) >> 5;
        float inv_l = 0.f;
#pragma unroll 1
        for (int pass = 0; pass < 2; ++pass) {
            f32x4 o[4];
#pragma unroll
            for (int dt = 0; dt < 4; ++dt) o[dt] = zero4;
            float lsum = 0.f;
            uint4 kreg = make_uint4(0, 0, 0, 0), vreg = kreg;
            if (nsteps > 0) {
                kreg = *(const uint4*)(kcb + (size_t)srow * 64 + sch * 8);
                vreg = *(const uint4*)(vcb + (size_t)srow * 64 + sch * 8);
            }
#pragma unroll 1
            for (int st = 0; st < nsteps; ++st) {
                const int cs = st * 32;
                *(uint4*)(kt + srow * KSTR + sch * 8) = kreg;
                *(uint4*)(vt + srow * KSTR + sch * 8) = vreg;
                __syncthreads();
                if (st + 1 < nsteps) {
                    kreg = *(const uint4*)(kcb + (size_t)(cs + 32 + srow) * 64 + sch * 8);
                    vreg = *(const uint4*)(vcb + (size_t)(cs + 32 + srow) * 64 + sch * 8);
                }
                f32x4 s1 = zero4, s2 = zero4;
#pragma unroll
                for (int kh = 0; kh < 2; ++kh) {
                    const bf16x8 k1 = *(const bf16x8*)(kt + fr * KSTR + kh * 32 + fq * 8);
                    const bf16x8 k2 = *(const bf16x8*)(kt + (16 + fr) * KSTR + kh * 32 + fq * 8);
                    s1 = mfma16(k1, qf[kh], s1);
                    s2 = mfma16(k2, qf[kh], s2);
                }
                const bool far = (t0 + 4 * wave) - (16 * (cs + 31) + 31) >= 113;
                f32x4 p1, p2;
#pragma unroll
                for (int r = 0; r < 4; ++r) {
                    const int d1 = tok - (16 * (cs + 4 * fq + r) + 31), d2 = d1 - 256;
                    const float b1 = far ? lutfar : lutp[d1 < 0 ? 0 : (d1 > 127 ? 127 : d1)];
                    const float b2 = far ? lutfar : lutp[d2 < 0 ? 0 : (d2 > 127 ? 127 : d2)];
                    p1[r] = (d1 >= 0) ? __builtin_amdgcn_exp2f(s1[r] + b1 - U2) : 0.f;
                    p2[r] = (d2 >= 0) ? __builtin_amdgcn_exp2f(s2[r] + b2 - U2) : 0.f;
                    lsum += p1[r] + p2[r];
                }
                if (pass == 1) {
#pragma unroll
                    for (int r = 0; r < 4; ++r) { p1[r] *= inv_l; p2[r] *= inv_l; }
                    f32x4 h1, h2;
#pragma unroll
                    for (int r = 0; r < 4; ++r) { h1[r] = quad_sum(p1[r]); h2[r] = quad_sum(p2[r]); }
                    if (hl == 0) {
                        float* ir = imp + tl * 260 + (cs >> 2) + fq;
                        atomicAdd(ir, h1[0] + h1[1] + h1[2] + 0.5f * h1[3]);
                        atomicAdd(ir + 1, 0.5f * h1[3]);
                        atomicAdd(ir + 4, h2[0] + h2[1] + h2[2] + 0.5f * h2[3]);
                        atomicAdd(ir + 5, 0.5f * h2[3]);
                    }
                    pv_step(o, vt, pack_p(p1, p2), fq, fr);
                }
                __syncthreads();
            }
            if (pass == 0) {
                lsum += __shfl_xor(lsum, 16);
                lsum += __shfl_xor(lsum, 32);
                inv_l = lsum > 0.f ? 1.f / lsum : 0.f;
            } else {
#pragma unroll
                for (int dt = 0; dt < 4; ++dt)
#pragma unroll
                    for (int r = 0; r < 4; ++r) outacc[dt][r] += g0 * o[dt][r];
            }
        }
    }
    __syncthreads();

#pragma unroll 1
    for (int tq = 0; tq < 4; ++tq) {
        const int tli = 4 * wave + tq, tk = t0 + tli, cur = tk >> 6;
        int* sl = sel + tli * 16;
        int nf = 0;
        if (lane == 0) {
            sl[0] = 0; int c_ = 1;
            if (cur - 1 >= 1) sl[c_++] = cur - 1;
            if (cur >= 1) sl[c_++] = cur;
            for (int k = c_; k < 16; ++k) sl[k] = -1;
        }
        nf = 1 + (cur - 1 >= 1 ? 1 : 0) + (cur >= 1 ? 1 : 0);
        const int ncand = cur - 2 > 0 ? cur - 2 : 0;
        int need = 16 - nf; need = need < ncand ? need : ncand;
        unsigned long long key[4];
#pragma unroll
        for (int k = 0; k < 4; ++k) {
            const int n = lane + 64 * k;
            const bool c = (n >= 1) && (n <= cur - 2);
            key[k] = c ? (((unsigned long long)__builtin_bit_cast(unsigned, imp[tli * 260 + n]) << 32) | (unsigned long long)(0xFFFFFFFFu - (unsigned)n)) + (1ull << 32) : 0ull;
        }
#pragma unroll 1
        for (int rd = 0; rd < need; ++rd) {
            unsigned long long m = key[0];
            m = key[1] > m ? key[1] : m; m = key[2] > m ? key[2] : m; m = key[3] > m ? key[3] : m;
#pragma unroll
            for (int o_ = 1; o_ < 64; o_ <<= 1) {
                const unsigned lo_ = __shfl_xor((unsigned)m, o_), hi_ = __shfl_xor((unsigned)(m >> 32), o_);
                const unsigned long long other = ((unsigned long long)hi_ << 32) | lo_;
                m = other > m ? other : m;
            }
            const int nstar = (int)(0xFFFFFFFFu - (unsigned)m);
#pragma unroll
            for (int k = 0; k < 4; ++k) if (key[k] == m) key[k] = 0ull;
            if (lane == 0) sl[nf + rd] = nstar;
        }
    }
    __syncthreads();

    {
        f32x4 o[4];
#pragma unroll
        for (int dt = 0; dt < 4; ++dt) o[dt] = zero4;
        float lsum = 0.f;
        const int vrow = lane >> 1, vhalf = lane & 1;
#pragma unroll 1
        for (int tq = 0; tq < 4; ++tq) {
            const int tli = 4 * wave + tq, tk = t0 + tli;
            const bool mine = (fr >> 2) == tq;
#pragma unroll 1
            for (int j = 0; j < 16; ++j) {
                const int b = __builtin_amdgcn_readfirstlane(sel[tli * 16 + j]);
                if (b < 0) continue;
                const int base = b * 64;
#pragma unroll 1
                for (int hf = 0; hf < 2; ++hf) {
                    const int ks = base + 32 * hf;
                    if (ks > tk) break;
                    bf16x8 k1[2], k2[2];
#pragma unroll
                    for (int kh = 0; kh < 2; ++kh) {
                        k1[kh] = *(const bf16x8*)(kslb + (size_t)(ks + fr) * 64 + kh * 32 + fq * 8);
                        k2[kh] = *(const bf16x8*)(kslb + (size_t)(ks + 16 + fr) * 64 + kh * 32 + fq * 8);
                    }
                    const uint4* vsrc = (const uint4*)(vslb + (size_t)(ks + vrow) * 64 + vhalf * 32);
                    const uint4 v0 = vsrc[0], v1 = vsrc[1], v2 = vsrc[2], v3 = vsrc[3];
                    uint4* vdst = (uint4*)(wv + vrow * KSTR + vhalf * 32);
                    vdst[0] = v0; vdst[1] = v1; vdst[2] = v2; vdst[3] = v3;
                    f32x4 s1 = zero4, s2 = zero4;
#pragma unroll
                    for (int kh = 0; kh < 2; ++kh) { s1 = mfma16(k1[kh], qf[kh], s1); s2 = mfma16(k2[kh], qf[kh], s2); }
                    const bool far = tk - (ks + 31) >= 113;
                    f32x4 p1, p2;
#pragma unroll
                    for (int r = 0; r < 4; ++r) {
                        const int d1 = tk - (ks + 4 * fq + r), d2 = d1 - 16;
                        const float b1 = far ? lutfar : lutp[d1 < 0 ? 0 : (d1 > 127 ? 127 : d1)];
                        const float b2 = far ? lutfar : lutp[d2 < 0 ? 0 : (d2 > 127 ? 127 : d2)];
                        p1[r] = (mine && d1 >= 0) ? __builtin_amdgcn_exp2f(s1[r] + b1 - U2) : 0.f;
                        p2[r] = (mine && d2 >= 0) ? __builtin_amdgcn_exp2f(s2[r] + b2 - U2) : 0.f;
                        lsum += p1[r] + p2[r];
                    }
                    asm volatile("" ::: "memory");
                    pv_step(o, wv, pack_p(p1, p2), fq, fr);
                    asm volatile("" ::: "memory");
                }
            }
        }
        lsum += __shfl_xor(lsum, 16);
        lsum += __shfl_xor(lsum, 32);
        const float sc = lsum > 0.f ? g1 / lsum : 0.f;
#pragma unroll
        for (int dt = 0; dt < 4; ++dt)
#pragma unroll
            for (int r = 0; r < 4; ++r) outacc[dt][r] += sc * o[dt][r];
    }
    bf16_t* orow = (bf16_t*)(p.ws + WS_OA) + (size_t)tok * 512 + head * 64 + 4 * fq;
#pragma unroll
    for (int dt = 0; dt < 4; ++dt) {
        uint2 v; v.x = pk2(outacc[dt][0], outacc[dt][1]); v.y = pk2(outacc[dt][2], outacc[dt][3]);
        *(uint2*)(orow + dt * 16) = v;
    }
}

typedef float f32x16 __attribute__((ext_vector_type(16)));
constexpr int DSA_CK = 0;
constexpr int DSA_CI = DSA_CK + 16 * 512 * 4;
constexpr int DSA_LUT = DSA_CI + 16 * 512 * 2;
constexpr int DSA_END = DSA_LUT + 8 * 128 * 4;
static_assert(DSA_END <= SMEM_BYTES, "dsa lds");

__device__ __forceinline__ unsigned mono_key(float s) {
    const unsigned u = __builtin_bit_cast(unsigned, s + 0.0f);
    return (u & 0x80000000u) ? ~u : (u | 0x80000000u);
}
__device__ __forceinline__ unsigned dsa_compact(unsigned* ck, unsigned short* ci, int n, int lane) {
    unsigned kk[8]; unsigned ii[8];
#pragma unroll
    for (int k = 0; k < 8; ++k) { const int e = lane + 64 * k; kk[k] = e < n ? ck[e] : 0u; ii[k] = e < n ? (unsigned)ci[e] : 0xFFFFu; }
    unsigned T = 0;
#pragma unroll 1
    for (int b = 31; b >= 0; --b) {
        const unsigned cand = T | (1u << b);
        int c = 0;
#pragma unroll
        for (int k = 0; k < 8; ++k) c += __builtin_popcountll(__ballot(kk[k] >= cand));
        if (c >= 256) T = cand;
    }
    int cgt = 0, ceq = 0;
#pragma unroll
    for (int k = 0; k < 8; ++k) { cgt += __builtin_popcountll(__ballot(kk[k] > T)); ceq += __builtin_popcountll(__ballot(kk[k] == T)); }
    const int need = 256 - cgt;
    unsigned X = 0xFFFFu;
    if (ceq > need) {
        X = 0;
#pragma unroll 1
        for (int b = 15; b >= 0; --b) {
            const unsigned cand = X | (1u << b);
            int c = 0;
#pragma unroll
            for (int k = 0; k < 8; ++k) c += __builtin_popcountll(__ballot(kk[k] == T && ii[k] < cand));
            if (c < need) X = cand;
        }
    }
    int base = 0;
    const unsigned long long lt = (1ull << lane) - 1ull;
#pragma unroll
    for (int k = 0; k < 8; ++k) {
        const bool keep = (kk[k] > T) || (kk[k] == T && ii[k] <= X);
        const unsigned long long m = __ballot(keep);
        if (keep) { const int pos = base + __builtin_popcountll(m & lt); ck[pos] = kk[k]; ci[pos] = (unsigned short)ii[k]; }
        base += __builtin_popcountll(m);
    }
    return T;
}

__device__ __forceinline__ void dsa_tile(const Params& p, int tt, unsigned char* smem) {
    const int tid = threadIdx.x, lane = tid & 63, wave = tid >> 6, col = lane & 31, hi = lane >> 5;
    unsigned* ckb = (unsigned*)(smem + DSA_CK);
    unsigned short* cib = (unsigned short*)(smem + DSA_CI);
    float* lut = (float*)(smem + DSA_LUT);
    const bf16_t* iqb = (const bf16_t*)(p.ws + WS_IQB);
    const bf16_t* ikb = (const bf16_t*)(p.ws + WS_IKB);
    const float* iws = (const float*)(p.ws + WS_IWS);
    const bf16_t* dqb = (const bf16_t*)(p.ws + WS_DQB);
    const bf16_t* dkb = (const bf16_t*)(p.ws + WS_DKB);
    const bf16_t* dvb = (const bf16_t*)(p.ws + WS_DVB);
    const float* relb = p.in[17];
    const int t0 = tt * 16;
    __syncthreads();
    for (int i = tid; i < 1024; i += NT) { const int hh = i >> 7, n = i & 127; lut[i] = relb[bucket_of(n) * 16 + 8 + hh] * LOG2E; }
    __syncthreads();
    const int tw = t0 + 4 * wave;
    bf16x8 af[2];
    {
        const int rho = col;
        const int tl_ = 2 * ((rho >> 2) & 1) + (rho >> 4), hd = 4 * ((rho >> 3) & 1) + (rho & 3);
#pragma unroll
        for (int ks = 0; ks < 2; ++ks) af[ks] = *(const bf16x8*)(iqb + (size_t)(tw + tl_) * 256 + hd * 32 + ks * 16 + hi * 8);
    }
    const int tokA = tw + 2 * hi, tokB = tokA + 1;
    float wA[8], wB[8];
#pragma unroll
    for (int h = 0; h < 8; ++h) { wA[h] = iws[(size_t)tokA * 8 + h]; wB[h] = iws[(size_t)tokB * 8 + h]; }
    unsigned* ckA = ckb + (4 * wave + 2 * hi) * 512;
    unsigned* ckB = ckA + 512;
    unsigned short* ciA = cib + (4 * wave + 2 * hi) * 512;
    unsigned short* ciB = ciA + 512;
    int cntA = 0, cntB = 0;
    unsigned LA = 0, LB = 0;
    const unsigned ltm = (1u << col) - 1u;
    const int nchunk = (tw + 4 + 31) >> 5;
    const f32x16 zero16 = {0.f, 0.f, 0.f, 0.f, 0.f, 0.f, 0.f, 0.f, 0.f, 0.f, 0.f, 0.f, 0.f, 0.f, 0.f, 0.f};
    bf16x8 nb0 = *(const bf16x8*)(ikb + (size_t)col * 32 + hi * 8);
    bf16x8 nb1 = *(const bf16x8*)(ikb + (size_t)col * 32 + 16 + hi * 8);
#pragma unroll 1
    for (int ch = 0; ch < nchunk; ++ch) {
        const int kidx = ch * 32 + col;
        const bf16x8 b0 = nb0, b1 = nb1;
        if (ch + 1 < nchunk) {
            nb0 = *(const bf16x8*)(ikb + (size_t)(kidx + 32) * 32 + hi * 8);
            nb1 = *(const bf16x8*)(ikb + (size_t)(kidx + 32) * 32 + 16 + hi * 8);
        }
        f32x16 c = __builtin_amdgcn_mfma_f32_32x32x16_bf16(af[0], b0, zero16, 0, 0, 0);
        c = __builtin_amdgcn_mfma_f32_32x32x16_bf16(af[1], b1, c, 0, 0, 0);
        float sA = 0.f, sB = 0.f;
#pragma unroll
        for (int h = 0; h < 8; ++h) { sA += wA[h] * fmaxf(c[h], 0.f); sB += wB[h] * fmaxf(c[8 + h], 0.f); }
        const unsigned keyA = mono_key(sA), keyB = mono_key(sB);
        const bool pA = (kidx <= tokA) && (keyA > LA), pB = (kidx <= tokB) && (keyB > LB);
        const unsigned long long mA = __ballot(pA), mB = __ballot(pB);
        const unsigned hA = hi ? (unsigned)(mA >> 32) : (unsigned)mA, hB = hi ? (unsigned)(mB >> 32) : (unsigned)mB;
        if (pA) { const int pos = cntA + __builtin_popcount(hA & ltm); ckA[pos] = keyA; ciA[pos] = (unsigned short)kidx; }
        if (pB) { const int pos = cntB + __builtin_popcount(hB & ltm); ckB[pos] = keyB; ciB[pos] = (unsigned short)kidx; }
        cntA += __builtin_popcount(hA); cntB += __builtin_popcount(hB);
        if ((ch & 7) == 7 || ch == nchunk - 1) {
#pragma unroll
            for (int tq = 0; tq < 4; ++tq) {
                const int cn = __shfl((tq & 1) ? cntB : cntA, (tq >> 1) * 32);
                if (cn > 256) {
                    const unsigned T = dsa_compact(ckb + (4 * wave + tq) * 512, cib + (4 * wave + tq) * 512, cn, lane);
                    if (hi == (tq >> 1)) { if (tq & 1) { cntB = 256; LB = T; } else { cntA = 256; LA = T; } }
                }
            }
        }
    }
    float U2;
    {
        const float mq = wave_max(fabsf(p.in[6][lane])), mk = wave_max(fabsf(p.in[7][lane]));
        float mb = 0.f;
#pragma unroll
        for (int k = 0; k < 4; ++k) { const int e = lane + 64 * k; mb = fmaxf(mb, fabsf(relb[(e >> 3) * 16 + 8 + (e & 7)])); }
        mb = wave_max(mb);
        U2 = (8.f * mq * mk + mb) * LOG2E;
    }
    const int hh = lane >> 3;
    const float* lutp = lut + hh * 128;
#pragma unroll 1
    for (int tq = 0; tq < 4; ++tq) {
        const int tk = tw + tq;
        int nsel = __shfl((tq & 1) ? cntB : cntA, (tq >> 1) * 32);
        nsel = nsel > 256 ? 256 : nsel;
        const unsigned short* sl = cib + (4 * wave + tq) * 512;
        float q[8];
        {
            const uint4 qv = *(const uint4*)(dqb + (size_t)tk * 512 + lane * 8);
            q[0] = __builtin_bit_cast(float, qv.x << 16); q[1] = __builtin_bit_cast(float, qv.x & 0xffff0000u);
            q[2] = __builtin_bit_cast(float, qv.y << 16); q[3] = __builtin_bit_cast(float, qv.y & 0xffff0000u);
            q[4] = __builtin_bit_cast(float, qv.z << 16); q[5] = __builtin_bit_cast(float, qv.z & 0xffff0000u);
            q[6] = __builtin_bit_cast(float, qv.w << 16); q[7] = __builtin_bit_cast(float, qv.w & 0xffff0000u);
        }
        float o[8];
#pragma unroll
        for (int j = 0; j < 8; ++j) o[j] = 0.f;
        float lsum = 0.f;
        int sA_[4], sB_[4];
        uint4 kA_[4], vA_[4], kB_[4], vB_[4];
#define DSA_LOADG(S_, K_, V_, kb)                                                        \
        _Pragma("unroll") for (int j = 0; j < 4; ++j) {                                 \
            int kk_ = (kb) + j; kk_ = kk_ < nsel ? kk_ : nsel - 1;                      \
            S_[j] = (int)sl[kk_];                                                        \
            K_[j] = *(const uint4*)(dkb + (size_t)S_[j] * 512 + lane * 8);               \
            V_[j] = *(const uint4*)(dvb + (size_t)S_[j] * 512 + lane * 8);               \
        }
#define DSA_COMPG(S_, K_, V_, kb)                                                        \
        _Pragma("unroll") for (int j = 0; j < 4; ++j) {                                 \
            const uint4 kv = K_[j], vv = V_[j];                                          \
            float d = q[0] * __builtin_bit_cast(float, kv.x << 16) + q[1] * __builtin_bit_cast(float, kv.x & 0xffff0000u) \
                    + q[2] * __builtin_bit_cast(float, kv.y << 16) + q[3] * __builtin_bit_cast(float, kv.y & 0xffff0000u) \
                    + q[4] * __builtin_bit_cast(float, kv.z << 16) + q[5] * __builtin_bit_cast(float, kv.z & 0xffff0000u) \
                    + q[6] * __builtin_bit_cast(float, kv.w << 16) + q[7] * __builtin_bit_cast(float, kv.w & 0xffff0000u); \
            d += __shfl_xor(d, 1); d += __shfl_xor(d, 2); d += __shfl_xor(d, 4);       \
            int dist = tk - S_[j]; dist = dist > 127 ? 127 : dist;                       \
            float pr = __builtin_amdgcn_exp2f(d + lutp[dist] - U2);                      \
            pr = ((kb) + j < nsel) ? pr : 0.f;                                           \
            lsum += pr;                                                                  \
            o[0] += pr * __builtin_bit_cast(float, vv.x << 16); o[1] += pr * __builtin_bit_cast(float, vv.x & 0xffff0000u); \
            o[2] += pr * __builtin_bit_cast(float, vv.y << 16); o[3] += pr * __builtin_bit_cast(float, vv.y & 0xffff0000u); \
            o[4] += pr * __builtin_bit_cast(float, vv.z << 16); o[5] += pr * __builtin_bit_cast(float, vv.z & 0xffff0000u); \
            o[6] += pr * __builtin_bit_cast(float, vv.w << 16); o[7] += pr * __builtin_bit_cast(float, vv.w & 0xffff0000u); \
        }
        if (nsel > 0) {
            DSA_LOADG(sA_, kA_, vA_, 0)
#pragma unroll 1
            for (int kb = 0; kb < nsel; kb += 8) {
                DSA_LOADG(sB_, kB_, vB_, kb + 4)
                DSA_COMPG(sA_, kA_, vA_, kb)
                DSA_LOADG(sA_, kA_, vA_, kb + 8)
                DSA_COMPG(sB_, kB_, vB_, kb + 4)
            }
        }
#undef DSA_LOADG
#undef DSA_COMPG
        const float inv = lsum > 0.f ? 1.f / lsum : 0.f;
        uint4 ov;
        ov.x = pk2(o[0] * inv, o[1] * inv); ov.y = pk2(o[2] * inv, o[3] * inv); ov.z = pk2(o[4] * inv, o[5] * inv); ov.w = pk2(o[6] * inv, o[7] * inv);
        *(uint4*)((bf16_t*)(p.ws + WS_OB) + (size_t)tk * 512 + lane * 8) = ov;
    }
}

__device__ __forceinline__ void phase_attn(const Params& p, int bid, int nb, unsigned char* smem) {
#pragma unroll 1
    for (int w = bid; w < 1024; w += nb) dsa_tile(p, 1023 - w, smem);
#pragma unroll 1
    for (int i = bid; i < 2048; i += nb) nsa_tile(p, 1023 - (i >> 1), i & 1, smem);
}

template <int PASS>
__device__ __forceinline__ void phase_merge(const Params& p, int bid, int nb, unsigned char* smem) {
    const float* z = (const float*)(p.ws + WS_Z);
    bf16_t* merged = (bf16_t*)(p.ws + WS_MERGED);
    float* tmp = (float*)(p.ws + WS_X1);
    const bf16_t* A = (const bf16_t*)(p.ws + (PASS ? WS_OB : WS_OA));
    const bf16_t* Bw = (const bf16_t*)(p.ws + (PASS ? WB_B : WB_A));
    constexpr int zoff = PASS ? Z_GB : Z_GA;
    for (int w = bid; w < 128 * 8; w += nb) {
        const int mt = w % 128, nt = w / 128;
        const int m0 = mt * 128, n0 = nt * 128;
        f32x4 acc[4][4];
        gemm2<false, false>(A, 512, nullptr, m0, 128, Bw, D, n0, 128, 512, smem, acc);
#pragma unroll
        for (int i = 0; i < 4; ++i)
#pragma unroll
            for (int r = 0; r < 4; ++r) {
                const int row = m0 + G2_ROW(i, r);
                const float* zr = z + (size_t)row * DIN + zoff + n0 + G2_COL(0);
                float* tr = tmp + (size_t)row * D + n0 + G2_COL(0);
                bf16_t* mr = merged + (size_t)row * D + n0 + G2_COL(0);
#pragma unroll
                for (int j = 0; j < 4; ++j) {
                    const float v = sigmoidf_(zr[j * 16]) * acc[i][j][r];
                    if (PASS == 0) tr[j * 16] = v;
                    else mr[j * 16] = (bf16_t)f2bf(tr[j * 16] + v);
                }
            }
    }
}

__device__ __forceinline__ void phase_outproj(const Params& p, int bid, int nb, unsigned char* smem) {
    const bf16_t* merged = (const bf16_t*)(p.ws + WS_MERGED);
    const float* x = p.in[0];
    float* x1 = (float*)(p.ws + WS_X1);
    for (int w = bid; w < 128 * 8; w += nb) {
        const int mt = w % 128, nt = w / 128;
        const int m0 = mt * 128, n0 = nt * 128;
        f32x4 acc[4][4];
        gemm2<false, false>(merged, D, nullptr, m0, 128, (const bf16_t*)(p.ws + WB_OUT), D, n0, 128, D, smem, acc);
#pragma unroll
        for (int i = 0; i < 4; ++i)
#pragma unroll
            for (int r = 0; r < 4; ++r) {
                const size_t ro = (size_t)(m0 + G2_ROW(i, r)) * D + n0;
#pragma unroll
                for (int j = 0; j < 4; ++j) { const int c = G2_COL(j); x1[ro + c] = x[ro + c] + acc[i][j][r]; }
            }
    }
}

__device__ __forceinline__ void phase_route(const Params& p, int bid, int nb) {
    const int lane = threadIdx.x & 63, wave = threadIdx.x >> 6;
    const float* x1 = (const float*)(p.ws + WS_X1);
    const float* g = p.in[18];
    const float* wr = p.in[19];
    const float* br = p.in[20];
    bf16_t* hb = (bf16_t*)(p.ws + WS_HB);
    int* topi = (int*)(p.ws + WS_TOPI);
    float* topw = (float*)(p.ws + WS_TOPW);
    int* cnt = (int*)(p.ws + WS_CTL);
    for (int t = bid * 4 + wave; t < S; t += nb * 4) {
        const float4* xr = (const float4*)(x1 + (size_t)t * D);
        float4 v[4];
        float ss = 0.f;
#pragma unroll
        for (int j = 0; j < 4; ++j) { v[j] = xr[lane + 64 * j]; ss += v[j].x * v[j].x + v[j].y * v[j].y + v[j].z * v[j].z + v[j].w * v[j].w; }
        ss = wave_sum(ss);
        const float rstd = rsqrtf(ss * (1.f / D) + EPS);
        float lg[32];
#pragma unroll
        for (int e = 0; e < 32; ++e) lg[e] = 0.f;
#pragma unroll
        for (int j = 0; j < 4; ++j) {
            const float4 gg = ((const float4*)g)[lane + 64 * j];
            const float h0 = v[j].x * rstd * gg.x, h1 = v[j].y * rstd * gg.y, h2 = v[j].z * rstd * gg.z, h3 = v[j].w * rstd * gg.w;
            uint2 o; o.x = pk2(h0, h1); o.y = pk2(h2, h3);
            ((uint2*)(hb + (size_t)t * D))[lane + 64 * j] = o;
            const int k = 4 * (lane + 64 * j);
            const float4* w0 = (const float4*)(wr + (size_t)k * 32);
#pragma unroll
            for (int e4 = 0; e4 < 8; ++e4) {
                const float4 a = w0[e4], b = w0[8 + e4], c = w0[16 + e4], d = w0[24 + e4];
                lg[4 * e4 + 0] += h0 * a.x + h1 * b.x + h2 * c.x + h3 * d.x;
                lg[4 * e4 + 1] += h0 * a.y + h1 * b.y + h2 * c.y + h3 * d.y;
                lg[4 * e4 + 2] += h0 * a.z + h1 * b.z + h2 * c.z + h3 * d.z;
                lg[4 * e4 + 3] += h0 * a.w + h1 * b.w + h2 * c.w + h3 * d.w;
            }
        }
#pragma unroll
        for (int e = 0; e < 32; ++e) lg[e] = wave_sum(lg[e]) + br[e];
        int idx[4]; float val[4];
        unsigned used = 0;
#pragma unroll
        for (int k = 0; k < 4; ++k) {
            float best = -__builtin_inff(); int bi = 0;
#pragma unroll
            for (int e = 0; e < 32; ++e) { const bool ok = !((used >> e) & 1u) && (lg[e] > best); best = ok ? lg[e] : best; bi = ok ? e : bi; }
            idx[k] = bi; val[k] = best; used |= 1u << bi;
        }
        const float e0 = 1.f, e1 = __expf(val[1] - val[0]), e2 = __expf(val[2] - val[0]), e3 = __expf(val[3] - val[0]);
        const float inv = 1.f / (e0 + e1 + e2 + e3);
        if (lane == 0) {
            topi[t * 4 + 0] = idx[0]; topi[t * 4 + 1] = idx[1]; topi[t * 4 + 2] = idx[2]; topi[t * 4 + 3] = idx[3];
            topw[t * 4 + 0] = e0 * inv; topw[t * 4 + 1] = e1 * inv; topw[t * 4 + 2] = e2 * inv; topw[t * 4 + 3] = e3 * inv;
            atomicAdd(&cnt[idx[0]], 1); atomicAdd(&cnt[idx[1]], 1); atomicAdd(&cnt[idx[2]], 1); atomicAdd(&cnt[idx[3]], 1);
        }
    }
}

__device__ __forceinline__ void phase_place(const Params& p, int bid, int nb, unsigned char* smem) {
    int* off = (int*)smem;
    const int* cnt = (const int*)(p.ws + WS_CTL);
    int* cur = (int*)(p.ws + WS_CTL) + 32;
    const int* topi = (const int*)(p.ws + WS_TOPI);
    int* ppos = (int*)(p.ws + WS_PPOS);
    int* rowtok = (int*)(p.ws + WS_ROWTOK);
    __syncthreads();
    if (threadIdx.x == 0) { int a = 0; for (int e = 0; e < NEXP; ++e) { off[e] = a; a += cnt[e]; } }
    __syncthreads();
    for (int i = bid * NT + threadIdx.x; i < S * 4; i += nb * NT) {
        const int e = topi[i];
        const int pos = off[e] + atomicAdd(&cur[e], 1);
        ppos[i] = pos;
        rowtok[pos] = i >> 2;
    }
}

__device__ __forceinline__ void moe_tile_map(const int* cnt, int* sm, int& total_mt) {
    __syncthreads();
    if (threadIdx.x == 0) {
        int a = 0, b = 0;
        for (int e = 0; e < NEXP; ++e) { sm[e] = a; sm[33 + e] = b; a += (cnt[e] + 127) >> 7; b += cnt[e]; }
        sm[32] = a; sm[65] = b;
    }
    __syncthreads();
    total_mt = sm[32];
}
__device__ __forceinline__ void phase_moe1(const Params& p, int bid, int nb, unsigned char* smem) {
    int* sm = (int*)(smem + 65536);
    const int* cnt = (const int*)(p.ws + WS_CTL);
    const int* rowtok = (const int*)(p.ws + WS_ROWTOK);
    const bf16_t* hb = (const bf16_t*)(p.ws + WS_HB);
    bf16_t* act = (bf16_t*)(p.ws + WS_ACT);
    const int lane = threadIdx.x & 63, wave = threadIdx.x >> 6;
    int total_mt;
    moe_tile_map(cnt, sm, total_mt);
    for (int w = bid; w < total_mt * 16; w += nb) {
        const int tm = w >> 4, nt = w & 15;
        int e = 0;
        while (e < NEXP - 1 && sm[e + 1] <= tm) ++e;
        const int mt = tm - sm[e];
        const int rbase = sm[33 + e] + mt * 128;
        const int mrows = min(128, cnt[e] - mt * 128);
        const int n0 = nt * 64;
        f32x4 acc[4][4];
        gemm2<true, true>(hb, D, rowtok, rbase, mrows, (const bf16_t*)(p.ws + WB_E1) + (size_t)e * D * 2 * DFF, 2 * DFF, n0, 128, D, smem, acc);
        const float* b1 = p.in[22] + (size_t)e * 2 * DFF;
        const int wn_ = (threadIdx.x >> 6) & 1;
#pragma unroll
        for (int i = 0; i < 4; ++i)
#pragma unroll
            for (int jp = 0; jp < 2; ++jp) {
                const int col = n0 + (wn_ * 2 + jp) * 16 + (threadIdx.x & 15);
                const float bg = b1[col], bl = b1[DFF + col];
#pragma unroll
                for (int r = 0; r < 4; ++r) {
                    const int rl = G2_ROW(i, r);
                    if (rl < mrows) {
                        const float gate = fminf(acc[i][2 * jp][r] + bg, 7.f);
                        const float lin = fminf(fmaxf(acc[i][2 * jp + 1][r] + bl, -7.f), 7.f);
                        const float a_ = (lin + 1.f) * gate * sigmoidf_(1.702f * gate);
                        act[(size_t)(rbase + rl) * DFF + col] = (bf16_t)f2bf(a_);
                    }
                }
            }
    }
}
__device__ __forceinline__ void phase_moe2(const Params& p, int bid, int nb, unsigned char* smem) {
    int* sm = (int*)(smem + 65536);
    const int* cnt = (const int*)(p.ws + WS_CTL);
    const bf16_t* act = (const bf16_t*)(p.ws + WS_ACT);
    float* yrows = (float*)(p.ws + WS_YROWS);
    const int lane = threadIdx.x & 63, wave = threadIdx.x >> 6;
    int total_mt;
    moe_tile_map(cnt, sm, total_mt);
    for (int w = bid; w < total_mt * 8; w += nb) {
        const int tm = w >> 3, nt = w & 7;
        int e = 0;
        while (e < NEXP - 1 && sm[e + 1] <= tm) ++e;
        const int mt = tm - sm[e];
        const int rbase = sm[33 + e] + mt * 128;
        const int mrows = min(128, cnt[e] - mt * 128);
        const int n0 = nt * 128;
        f32x4 acc[4][4];
        gemm2<false, false>(act, DFF, nullptr, rbase, mrows, (const bf16_t*)(p.ws + WB_E2) + (size_t)e * DFF * D, D, n0, 128, DFF, smem, acc);
        const float* b2 = p.in[24] + (size_t)e * D + n0;
#pragma unroll
        for (int i = 0; i < 4; ++i)
#pragma unroll
            for (int r = 0; r < 4; ++r) {
                const int rl = G2_ROW(i, r);
                if (rl < mrows) {
                    float* yr = yrows + (size_t)(rbase + rl) * D + n0;
#pragma unroll
                    for (int j = 0; j < 4; ++j) { const int c = G2_COL(j); yr[c] = acc[i][j][r] + b2[c]; }
                }
            }
    }
}

__device__ __forceinline__ void phase_combine(const Params& p, int bid, int nb) {
    const int lane = threadIdx.x & 63, wave = threadIdx.x >> 6;
    const float* x1 = (const float*)(p.ws + WS_X1);
    const float* yrows = (const float*)(p.ws + WS_YROWS);
    const int* ppos = (const int*)(p.ws + WS_PPOS);
    const float* topw = (const float*)(p.ws + WS_TOPW);
    const float* g = p.in[25];
    bf16_t* hb = (bf16_t*)(p.ws + WS_HB);
    bf16_t* pb = (bf16_t*)(p.ws + WS_PB);
    for (int t = bid * 4 + wave; t < S; t += nb * 4) {
        {
            const float4 pv = ((const float4*)(p.in[1] + (size_t)t * 256))[lane];
            uint2 o; o.x = pk2(pv.x, pv.y); o.y = pk2(pv.z, pv.w);
            ((uint2*)(pb + (size_t)t * 256))[lane] = o;
        }
        float4 v[4];
#pragma unroll
        for (int j = 0; j < 4; ++j) v[j] = ((const float4*)(x1 + (size_t)t * D))[lane + 64 * j];
#pragma unroll
        for (int k = 0; k < 4; ++k) {
            const float wk = topw[t * 4 + k];
            const float4* yr = (const float4*)(yrows + (size_t)ppos[t * 4 + k] * D);
#pragma unroll
            for (int j = 0; j < 4; ++j) { const float4 y = yr[lane + 64 * j]; v[j].x += wk * y.x; v[j].y += wk * y.y; v[j].z += wk * y.z; v[j].w += wk * y.w; }
        }
        float ss = 0.f;
#pragma unroll
        for (int j = 0; j < 4; ++j) ss += v[j].x * v[j].x + v[j].y * v[j].y + v[j].z * v[j].z + v[j].w * v[j].w;
        ss = wave_sum(ss);
        const float rstd = rsqrtf(ss * (1.f / D) + EPS);
#pragma unroll
        for (int j = 0; j < 4; ++j) {
            ((float4*)(p.out + (size_t)t * D))[lane + 64 * j] = v[j];
            const float4 gg = ((const float4*)g)[lane + 64 * j];
            uint2 o;
            o.x = pk2(v[j].x * rstd * gg.x, v[j].y * rstd * gg.y);
            o.y = pk2(v[j].z * rstd * gg.z, v[j].w * rstd * gg.w);
            ((uint2*)(hb + (size_t)t * D))[lane + 64 * j] = o;
        }
    }
}

template <int PASS>
__device__ __forceinline__ void phase_ple(const Params& p, int bid, int nb, unsigned char* smem) {
    float* tmp = (float*)(p.ws + WS_X1);
    const bf16_t* A = (const bf16_t*)(p.ws + (PASS ? WS_PB : WS_HB));
    const bf16_t* Bw = (const bf16_t*)(p.ws + (PASS ? WB_PLE : WB_PLEG));
    constexpr int K = PASS ? 256 : D;
    for (int w = bid; w < 128 * 8; w += nb) {
        const int mt = w % 128, nt = w / 128;
        const int m0 = mt * 128, n0 = nt * 128;
        f32x4 acc[4][4];
        gemm2<false, false>(A, K, nullptr, m0, 128, Bw, D, n0, 128, K, smem, acc);
#pragma unroll
        for (int i = 0; i < 4; ++i)
#pragma unroll
            for (int r = 0; r < 4; ++r) {
                const size_t ro = (size_t)(m0 + G2_ROW(i, r)) * D + n0 + G2_COL(0);
                float* tr = tmp + ro;
                float* orow = p.out + ro;
#pragma unroll
                for (int j = 0; j < 4; ++j) {
                    if (PASS == 0) tr[j * 16] = sigmoidf_(acc[i][j][r]);
                    else orow[j * 16] = orow[j * 16] + tr[j * 16] * acc[i][j][r];
                }
            }
    }
}

#define LAS __attribute__((address_space(3)))
#define XB_TMO      128
#define XB_XCNT(j)  (256  + 64 * (j))
#define XB_XSUB(j)  (1280 + 64 * (j))
#define XB_XGEN(j)  (2304 + 64 * (j))
#define XB_TOP      3328
#define XB_TOPGEN   3392
#define XCD_BAR_WORDS 3456
#define XB_SPIN_CAP (1u << 18)

__device__ __forceinline__ unsigned xb_ld(unsigned* p)              { return __hip_atomic_load(p, __ATOMIC_RELAXED, __HIP_MEMORY_SCOPE_AGENT); }
__device__ __forceinline__ unsigned xb_add(unsigned* p, unsigned v) { return __hip_atomic_fetch_add(p, v, __ATOMIC_RELAXED, __HIP_MEMORY_SCOPE_AGENT); }
__device__ __forceinline__ unsigned xb_xcc_id() { return (unsigned)__builtin_amdgcn_s_getreg((3 << 11) | 20) & 0xFu; }
#define XB_SPIN(cond, bar) do { unsigned _sp = 0; while (cond) { __builtin_amdgcn_s_sleep(1); \
    if ((++_sp & 255u) == 0u) { if (xb_ld(&(bar)[XB_TMO])) break; if (_sp > XB_SPIN_CAP) { atomicAdd(&(bar)[XB_TMO], 1u); break; } } } } while (0)

struct XcdBarrier {
    unsigned* bar; unsigned x;
    volatile LAS unsigned* st;
};

__device__ __forceinline__ XcdBarrier xcd_barrier_post(unsigned* bar, volatile LAS unsigned* st) {
    XcdBarrier b; b.bar = bar; b.x = xb_xcc_id(); b.st = st;
    if (threadIdx.x == 0) (void)xb_add(&bar[XB_XCNT(b.x)], 1u);
    return b;
}
__device__ __forceinline__ void xcd_barrier_complete(unsigned* bar, unsigned x, unsigned& nloc, unsigned& nx) {
    const unsigned G = gridDim.x * gridDim.y * gridDim.z;
    unsigned sum, cnt, mine, sp = 0u;
    for (;;) {
        sum = 0u; cnt = 0u; mine = 0u;
#pragma unroll
        for (unsigned j = 0; j < 16; ++j) { const unsigned c = xb_ld(&bar[XB_XCNT(j)]); sum += c; cnt += (c > 0u) ? 1u : 0u; mine = (j == x) ? c : mine; }
        if (sum == G) break;
        __builtin_amdgcn_s_sleep(1);
        if ((++sp & 255u) == 0u) { if (xb_ld(&bar[XB_TMO])) break; if (sp > XB_SPIN_CAP) { atomicAdd(&bar[XB_TMO], 1u); break; } }
    }
    nloc = mine > 0u ? mine : 1u; nx = cnt > 0u ? cnt : 1u;
}

__device__ __forceinline__ void xcd_barrier(const XcdBarrier& b) {
    asm volatile("s_waitcnt vmcnt(0)" ::: "memory");
    __syncthreads();
    if (threadIdx.x == 0) {
        unsigned* bar = b.bar;
        __builtin_amdgcn_s_waitcnt(0);
        unsigned nloc = b.st[0], nx = b.st[1];
        if (nloc == 0u) { xcd_barrier_complete(bar, b.x, nloc, nx); b.st[0] = nloc; b.st[1] = nx; }
        const unsigned old = xb_add(&bar[XB_XSUB(b.x)], 1u);
        const unsigned gen = old / nloc;
        if (old + 1u == (gen + 1u) * nloc) {
            __builtin_amdgcn_fence(__ATOMIC_RELEASE, "agent");
            asm volatile("s_waitcnt vmcnt(0)" ::: "memory");
            const unsigned og = xb_add(&bar[XB_TOP], 1u);
            const unsigned tg = og / nx;
            if (og + 1u == (tg + 1u) * nx) xb_add(&bar[XB_TOPGEN], 1u);
            else XB_SPIN(xb_ld(&bar[XB_TOPGEN]) == tg, bar);
            __builtin_amdgcn_fence(__ATOMIC_ACQUIRE, "agent");
            xb_add(&bar[XB_XGEN(b.x)], 1u);
            asm volatile("s_waitcnt vmcnt(0)" ::: "memory");
        } else {
            XB_SPIN(xb_ld(&bar[XB_XGEN(b.x)]) == gen, bar);
            __builtin_amdgcn_fence(__ATOMIC_ACQUIRE, "agent");
            asm volatile("s_waitcnt vmcnt(0)" ::: "memory");
        }
    }
    __syncthreads();
}

template <int PH>
__device__ __forceinline__ void run_phase(const Params& p, int bid, int nb, unsigned char* smem) {
    if (PH == 0) phase_prep(p, bid, nb);
    if (PH == 1) phase_inproj(p, bid, nb, smem);
    if (PH == 2) phase_post(p, bid, nb);
    if (PH == 3) phase_compress(p, bid, nb);
    if (PH == 4) phase_attn(p, bid, nb, smem);
    if (PH == 5) phase_merge<0>(p, bid, nb, smem);
    if (PH == 13) phase_merge<1>(p, bid, nb, smem);
    if (PH == 6) phase_outproj(p, bid, nb, smem);
    if (PH == 7) phase_route(p, bid, nb);
    if (PH == 8) phase_place(p, bid, nb, smem);
    if (PH == 9) phase_moe1(p, bid, nb, smem);
    if (PH == 10) phase_moe2(p, bid, nb, smem);
    if (PH == 11) phase_combine(p, bid, nb);
    if (PH == 12) phase_ple<0>(p, bid, nb, smem);
    if (PH == 14) phase_ple<1>(p, bid, nb, smem);
}

#if SINGLE_LAUNCH
__global__ void __launch_bounds__(NT, 2) fwd_mega(Params p) {
    __shared__ __attribute__((aligned(16))) unsigned char smem[SMEM_BYTES];
    cg::grid_group grid = cg::this_grid();
    const int bid = blockIdx.x, nb = gridDim.x;
    volatile LAS unsigned* bst = (volatile LAS unsigned*)(LAS unsigned char*)(smem + SMEM_BYTES - 16);
    if (threadIdx.x < 2) bst[threadIdx.x] = 0u;
    __syncthreads();
    const XcdBarrier bar = xcd_barrier_post((unsigned*)(p.ws + WS_BAR), bst);
#define GSYNC() xcd_barrier(bar)
    run_phase<0>(p, bid, nb, smem); grid.sync();
    run_phase<1>(p, bid, nb, smem); GSYNC();
    run_phase<2>(p, bid, nb, smem); GSYNC();
    run_phase<3>(p, bid, nb, smem); GSYNC();
    run_phase<4>(p, bid, nb, smem); GSYNC();
    run_phase<5>(p, bid, nb, smem); GSYNC();
    run_phase<13>(p, bid, nb, smem); GSYNC();
    run_phase<6>(p, bid, nb, smem); GSYNC();
    run_phase<7>(p, bid, nb, smem); GSYNC();
    run_phase<8>(p, bid, nb, smem); GSYNC();
    run_phase<9>(p, bid, nb, smem); GSYNC();
    run_phase<10>(p, bid, nb, smem); GSYNC();
    run_phase<11>(p, bid, nb, smem); GSYNC();
    run_phase<12>(p, bid, nb, smem); GSYNC();
    run_phase<14>(p, bid, nb, smem);
#undef GSYNC
}
#else
template <int PH>
__global__ void __launch_bounds__(NT, 2) k_phase(Params p) {
    __shared__ __attribute__((aligned(16))) unsigned char smem[SMEM_BYTES];
    run_phase<PH>(p, blockIdx.x, gridDim.x, smem);
}
#endif

extern "C" void kernel_launch(void* const* d_in, const int* in_sizes, int n_in, void* d_out, int out_size, void* d_ws, size_t ws_size,
                              hipStream_t stream) {
    if (n_in != 28 || ws_size < WS_END) { fprintf(stderr, "kernel_launch: unexpected n_in %d or ws_size %zu (< %zu)\n", n_in, ws_size, (size_t)WS_END); return; }
    Params p{};
    for (int i = 0; i < 28; ++i) p.in[i] = (const float*)d_in[i];
    p.out = (float*)d_out;
    p.ws = (unsigned char*)d_ws;
#if SINGLE_LAUNCH
    static int grid_blocks = 0;
    if (!grid_blocks) {
        int dev = 0, cus = 0, per_cu = 0;
        hipGetDevice(&dev);
        hipDeviceGetAttribute(&cus, hipDeviceAttributeMultiprocessorCount, dev);
        hipOccupancyMaxActiveBlocksPerMultiprocessor(&per_cu, fwd_mega, NT, 0);
        if (per_cu > 2) per_cu = 2;
        if (per_cu < 1) per_cu = 1;
        grid_blocks = cus * per_cu;
    }
    (void)hipMemsetAsync((unsigned char*)d_ws + WS_BAR, 0, XCD_BAR_WORDS * 4, stream);
    void* args[] = {&p};
    hipError_t e = hipLaunchCooperativeKernel((void*)fwd_mega, dim3(grid_blocks), dim3(NT), args, 0, stream);
    if (e != hipSuccess) fprintf(stderr, "cooperative launch failed: %s (grid %d)\n", hipGetErrorString(e), grid_blocks);
#else
    const int G = 512;
    k_phase<0><<<G, NT, 0, stream>>>(p);
    k_phase<1><<<G, NT, 0, stream>>>(p);
    k_phase<2><<<G, NT, 0, stream>>>(p);
    k_phase<3><<<G, NT, 0, stream>>>(p);
    k_phase<4><<<G, NT, 0, stream>>>(p);
    k_phase<5><<<G, NT, 0, stream>>>(p);
    k_phase<13><<<G, NT, 0, stream>>>(p);
    k_phase<6><<<G, NT, 0, stream>>>(p);
    k_phase<7><<<G, NT, 0, stream>>>(p);
    k_phase<8><<<G, NT, 0, stream>>>(p);
    k_phase<9><<<G, NT, 0, stream>>>(p);
    k_phase<10><<<G, NT, 0, stream>>>(p);
    k_phase<11><<<G, NT, 0, stream>>>(p);
    k_phase<12><<<G, NT, 0, stream>>>(p);
    k_phase<14><<<G, NT, 0, stream>>>(p);
#endif
}
```

```cpp
#include <hip/hip_runtime.h>
#include <hip/hip_cooperative_groups.h>
#include <cstdio>
#include <cstdint>
namespace cg = cooperative_groups;

#ifndef SINGLE_LAUNCH
#define SINGLE_LAUNCH 1
#endif

constexpr int S = 16384;
constexpr int D = 1024;
constexpr int DIN = 5184;
constexpr int NCMP = 1023;
constexpr int NSLC = 256;
constexpr int NEXP = 32;
constexpr int DFF = 1024;
constexpr float EPS = 1e-6f;
constexpr float LOG2E = 1.4426950408889634f;
constexpr int Z_NQ = 0, Z_NKV = 512, Z_NGATE = 1280, Z_DQ = 1304, Z_DK = 1816, Z_DV = 2328, Z_IQ = 2840, Z_IK = 3096,
              Z_IW = 3128, Z_GA = 3136, Z_GB = 4160;

constexpr int NT = 256;
constexpr int SMEM_BYTES = 73728;

typedef unsigned short bf16_t;
typedef short bf16x8 __attribute__((ext_vector_type(8)));
typedef float f32x4 __attribute__((ext_vector_type(4)));
typedef short s16x4 __attribute__((ext_vector_type(4)));
typedef __attribute__((address_space(3))) s16x4* lds_s16x4_ptr;
__device__ __forceinline__ s16x4 lds_tr16(const void* p) {
    return __builtin_amdgcn_ds_read_tr16_b64_v4i16((lds_s16x4_ptr)(uintptr_t)p);
}

constexpr size_t MBy = 1ull << 20;
constexpr size_t WS_CTL = 0;
constexpr size_t WS_BAR = 65536;
constexpr size_t WS_HB = 1 * MBy;
constexpr size_t WS_OA = WS_HB + (size_t)S * D * 2;
constexpr size_t WS_OB = WS_OA + (size_t)S * 512 * 2;
constexpr size_t WS_MERGED = WS_OB + (size_t)S * 512 * 2;
constexpr size_t WS_X1 = WS_MERGED + (size_t)S * D * 2;
constexpr size_t WS_TOPI = WS_X1 + (size_t)S * D * 4;
constexpr size_t WS_TOPW = WS_TOPI + (size_t)S * 4 * 4;
constexpr size_t WS_PPOS = WS_TOPW + (size_t)S * 4 * 4;
constexpr size_t WS_ROWTOK = WS_PPOS + (size_t)S * 4 * 4;
constexpr size_t WS_PB = WS_ROWTOK + (size_t)65536 * 4;
constexpr size_t WS_SEL = WS_PB + (size_t)S * 256 * 2;
constexpr size_t WS_NSEL = WS_SEL + (size_t)S * 256 * 2;
constexpr size_t WS_REG = WS_NSEL + (size_t)S * 4;
constexpr size_t WS_Z = WS_REG;
constexpr size_t WS_GT = WS_Z + (size_t)S * DIN * 4;
constexpr size_t WS_IWS = WS_GT + (size_t)S * 32 * 4;
constexpr size_t WS_QNB = WS_IWS + (size_t)S * 8 * 4;
constexpr size_t WS_KSLB = WS_QNB + (size_t)S * 512 * 2;
constexpr size_t WS_VSLB = WS_KSLB + (size_t)S * 128 * 2;
constexpr size_t WS_KWNB = WS_VSLB + (size_t)S * 128 * 2;
constexpr size_t WS_VWNB = WS_KWNB + (size_t)S * 128 * 2;
constexpr size_t WS_KCB = WS_VWNB + (size_t)S * 128 * 2;
constexpr size_t WS_VCB = WS_KCB + (size_t)2 * 1024 * 64 * 2;
constexpr size_t WS_KCR = WS_VCB + (size_t)2 * 1024 * 64 * 2;
constexpr size_t WS_VCR = WS_KCR + (size_t)S * 128 * 2;
constexpr size_t WS_DQB = WS_VCR + (size_t)S * 128 * 2;
constexpr size_t WS_DKB = WS_DQB + (size_t)S * 512 * 2;
constexpr size_t WS_DVB = WS_DKB + (size_t)S * 512 * 2;
constexpr size_t WS_IQB = WS_DVB + (size_t)S * 512 * 2;
constexpr size_t WS_IKB = WS_IQB + (size_t)S * 256 * 2;
constexpr size_t WS_ENDA = WS_IKB + (size_t)S * 32 * 2;
constexpr size_t WS_ACT = WS_REG;
constexpr size_t WS_YROWS = WS_ACT + (size_t)(65536 + 128) * DFF * 2;
constexpr size_t WS_ENDB = WS_YROWS + (size_t)(65536 + 128) * D * 4;
constexpr size_t WS_END0 = WS_ENDA > WS_ENDB ? WS_ENDA : WS_ENDB;
constexpr size_t WB_IN = WS_END0;
constexpr size_t WB_A = WB_IN + (size_t)D * DIN * 2;
constexpr size_t WB_B = WB_A + (size_t)512 * D * 2;
constexpr size_t WB_OUT = WB_B + (size_t)512 * D * 2;
constexpr size_t WB_E1 = WB_OUT + (size_t)D * D * 2;
constexpr size_t WB_E2 = WB_E1 + (size_t)NEXP * D * 2 * DFF * 2;
constexpr size_t WB_PLE = WB_E2 + (size_t)NEXP * DFF * D * 2;
constexpr size_t WB_PLEG = WB_PLE + (size_t)256 * D * 2;
constexpr size_t WB_CK1 = WB_PLEG + (size_t)D * D * 2;
constexpr size_t WB_CV1 = WB_CK1 + (size_t)2048 * 64 * 2;
constexpr size_t WS_END = WB_CV1 + (size_t)2048 * 64 * 2 + 4096;

struct Params {
    const float* in[28];
    float* out;
    unsigned char* ws;
};

__device__ __forceinline__ unsigned f2bf(float f) {
    unsigned u = __builtin_bit_cast(unsigned, f);
    return (u + 0x7fffu + ((u >> 16) & 1u)) >> 16;
}
__device__ __forceinline__ unsigned pk2(float lo, float hi) { return f2bf(lo) | (f2bf(hi) << 16); }
__device__ __forceinline__ float bf2f(unsigned short b) { return __builtin_bit_cast(float, (unsigned)b << 16); }
__device__ __forceinline__ float wave_sum(float v) {
#pragma unroll
    for (int o = 1; o < 64; o <<= 1) v += __shfl_xor(v, o);
    return v;
}
__device__ __forceinline__ float wave_max(float v) {
#pragma unroll
    for (int o = 1; o < 64; o <<= 1) v = fmaxf(v, __shfl_xor(v, o));
    return v;
}
__device__ __forceinline__ float sigmoidf_(float x) { return 1.f / (1.f + __expf(-x)); }
__device__ __forceinline__ int bucket_of(int n) {
    if (n < 16) return n;
    int b = 16;
    b += (n >= 19) + (n >= 21) + (n >= 24) + (n >= 27) + (n >= 31) + (n >= 35) + (n >= 40) + (n >= 46) + (n >= 52) + (n >= 59) +
         (n >= 67) + (n >= 77) + (n >= 87) + (n >= 99) + (n >= 113);
    return b;
}

constexpr int LDS_STRIDE = 40;
constexpr int BTR_STRIDE = 136;
template <bool A_F32, bool GATHER, bool SPLIT = false, bool BTR = true>
__device__ __forceinline__ void gemm_tile(const void* __restrict__ Aptr, int lda, const int* __restrict__ rowidx, int m0, int mrows,
                                          const float* __restrict__ B, int ldb, int n0, int split_off, int ncols, int K,
                                          unsigned char* smem, f32x4 (&acc)[2][8]) {
    bf16_t* As = (bf16_t*)smem;
    bf16_t* Bs = As + 128 * LDS_STRIDE;
    bf16_t* AsL = Bs + 128 * LDS_STRIDE;
    bf16_t* BsL = AsL + 128 * LDS_STRIDE;
    const int tid = threadIdx.x, lane = tid & 63, wave = tid >> 6;
#pragma unroll
    for (int i = 0; i < 2; ++i)
#pragma unroll
        for (int j = 0; j < 8; ++j) acc[i][j] = (f32x4){0.f, 0.f, 0.f, 0.f};
    auto lo = [](float v) { return v - bf2f((unsigned short)f2bf(v)); };

    const int ar = tid >> 2, ach = tid & 3;
    const unsigned char* arow[2];
    bool aval[2];
#pragma unroll
    for (int i = 0; i < 2; ++i) {
        int r = ar + 64 * i;
        aval[i] = r < mrows;
        long src = 0;
        if (aval[i]) src = GATHER ? (long)rowidx[m0 + r] : (long)(m0 + r);
        arow[i] = (const unsigned char*)Aptr + (size_t)src * lda * (A_F32 ? 4 : 2) + (size_t)ach * 8 * (A_F32 ? 4 : 2);
    }
    const int nq = tid & 31, kq = tid >> 5;
    const int jn = 4 * nq;
    const bool bval = jn < ncols;
    const float* bptr = B + (size_t)(4 * kq) * ldb + n0 + jn + (jn >= 64 ? split_off : 0);

    uint4 areg[2];
    float4 af0a, af0b, af1a, af1b;
    float4 breg[4];
    auto load_g = [&](int k0) {
#pragma unroll
        for (int i = 0; i < 2; ++i) {
            if (A_F32) {
                float4 t0 = make_float4(0, 0, 0, 0), t1 = t0;
                if (aval[i]) {
                    const float4* s = (const float4*)(arow[i] + (size_t)k0 * 4);
                    t0 = s[0]; t1 = s[1];
                }
                if (i == 0) { af0a = t0; af0b = t1; } else { af1a = t0; af1b = t1; }
            } else {
                if (aval[i]) areg[i] = *(const uint4*)(arow[i] + (size_t)k0 * 2);
                else areg[i] = make_uint4(0, 0, 0, 0);
            }
        }
#pragma unroll
        for (int kk = 0; kk < 4; ++kk) {
            if (bval) breg[kk] = *(const float4*)(bptr + (size_t)(k0 + kk) * ldb);
            else breg[kk] = make_float4(0, 0, 0, 0);
        }
    };
    auto store_l = [&]() {
#pragma unroll
        for (int i = 0; i < 2; ++i) {
            uint4 v;
            const float4 t0 = (i == 0) ? af0a : af1a, t1 = (i == 0) ? af0b : af1b;
            if (A_F32) {
                v.x = pk2(t0.x, t0.y); v.y = pk2(t0.z, t0.w);
                v.z = pk2(t1.x, t1.y); v.w = pk2(t1.z, t1.w);
            } else v = areg[i];
            *(uint4*)(As + (ar + 64 * i) * LDS_STRIDE + ach * 8) = v;
            if (SPLIT && A_F32) {
                v.x = pk2(lo(t0.x), lo(t0.y)); v.y = pk2(lo(t0.z), lo(t0.w));
                v.z = pk2(lo(t1.x), lo(t1.y)); v.w = pk2(lo(t1.z), lo(t1.w));
                *(uint4*)(AsL + (ar + 64 * i) * LDS_STRIDE + ach * 8) = v;
            }
        }
        if (SPLIT) {
            uint2 v;
            v.x = pk2(lo(breg[0].x), lo(breg[1].x)); v.y = pk2(lo(breg[2].x), lo(breg[3].x));
            *(uint2*)(BsL + (jn + 0) * LDS_STRIDE + 4 * kq) = v;
            v.x = pk2(lo(breg[0].y), lo(breg[1].y)); v.y = pk2(lo(breg[2].y), lo(breg[3].y));
            *(uint2*)(BsL + (jn + 1) * LDS_STRIDE + 4 * kq) = v;
            v.x = pk2(lo(breg[0].z), lo(breg[1].z)); v.y = pk2(lo(breg[2].z), lo(breg[3].z));
            *(uint2*)(BsL + (jn + 2) * LDS_STRIDE + 4 * kq) = v;
            v.x = pk2(lo(breg[0].w), lo(breg[1].w)); v.y = pk2(lo(breg[2].w), lo(breg[3].w));
            *(uint2*)(BsL + (jn + 3) * LDS_STRIDE + 4 * kq) = v;
        }
        if (BTR && !SPLIT) {
#pragma unroll
            for (int kk = 0; kk < 4; ++kk) {
                uint2 v; v.x = pk2(breg[kk].x, breg[kk].y); v.y = pk2(breg[kk].z, breg[kk].w);
                *(uint2*)(Bs + (4 * kq + kk) * BTR_STRIDE + jn) = v;
            }
        } else {
            uint2 v;
            v.x = pk2(breg[0].x, breg[1].x); v.y = pk2(breg[2].x, breg[3].x);
            *(uint2*)(Bs + (jn + 0) * LDS_STRIDE + 4 * kq) = v;
            v.x = pk2(breg[0].y, breg[1].y); v.y = pk2(breg[2].y, breg[3].y);
            *(uint2*)(Bs + (jn + 1) * LDS_STRIDE + 4 * kq) = v;
            v.x = pk2(breg[0].z, breg[1].z); v.y = pk2(breg[2].z, breg[3].z);
            *(uint2*)(Bs + (jn + 2) * LDS_STRIDE + 4 * kq) = v;
            v.x = pk2(breg[0].w, breg[1].w); v.y = pk2(breg[2].w, breg[3].w);
            *(uint2*)(Bs + (jn + 3) * LDS_STRIDE + 4 * kq) = v;
        }
    };
    const int nk = K / 32;
    __syncthreads();
    load_g(0);
    store_l();
    __syncthreads();
    const int fr = lane & 15, fq = lane >> 4;
    for (int kt = 0; kt < nk; ++kt) {
        if (kt + 1 < nk) load_g((kt + 1) * 32);
        bf16x8 a[2];
#pragma unroll
        for (int i = 0; i < 2; ++i) a[i] = *(const bf16x8*)(As + (wave * 32 + i * 16 + fr) * LDS_STRIDE + fq * 8);
        if (!SPLIT) {
            bf16x8 b[8];
#pragma unroll
            for (int j = 0; j < 8; ++j) {
                if (BTR && !SPLIT) {
                    const bf16_t* bp = Bs + (8 * fq + (fr >> 2)) * BTR_STRIDE + 16 * j + 4 * (fr & 3);
                    const s16x4 lo4 = lds_tr16(bp), hi4 = lds_tr16(bp + 4 * BTR_STRIDE);
                    b[j] = (bf16x8){lo4[0], lo4[1], lo4[2], lo4[3], hi4[0], hi4[1], hi4[2], hi4[3]};
                } else b[j] = *(const bf16x8*)(Bs + (j * 16 + fr) * LDS_STRIDE + fq * 8);
            }
#pragma unroll
            for (int i = 0; i < 2; ++i)
#pragma unroll
                for (int j = 0; j < 8; ++j) acc[i][j] = __builtin_amdgcn_mfma_f32_16x16x32_bf16(a[i], b[j], acc[i][j], 0, 0, 0);
        } else {
            bf16x8 al[2];
#pragma unroll
            for (int i = 0; i < 2; ++i) al[i] = *(const bf16x8*)(AsL + (wave * 32 + i * 16 + fr) * LDS_STRIDE + fq * 8);
#pragma unroll
            for (int j = 0; j < 8; ++j) {
                const bf16x8 bh = *(const bf16x8*)(Bs + (j * 16 + fr) * LDS_STRIDE + fq * 8);
                const bf16x8 bl = *(const bf16x8*)(BsL + (j * 16 + fr) * LDS_STRIDE + fq * 8);
#pragma unroll
                for (int i = 0; i < 2; ++i) {
                    acc[i][j] = __builtin_amdgcn_mfma_f32_16x16x32_bf16(a[i], bh, acc[i][j], 0, 0, 0);
                    acc[i][j] = __builtin_amdgcn_mfma_f32_16x16x32_bf16(a[i], bl, acc[i][j], 0, 0, 0);
                    acc[i][j] = __builtin_amdgcn_mfma_f32_16x16x32_bf16(al[i], bh, acc[i][j], 0, 0, 0);
                }
            }
        }
        __syncthreads();
        if (kt + 1 < nk) {
            store_l();
            __syncthreads();
        }
    }
}


constexpr int ASTR = 72;
constexpr int BSTR = 136;
template <bool GATHER, bool PAIR>
__device__ __forceinline__ void gemm2(const bf16_t* __restrict__ A, int lda, const int* __restrict__ rowidx, int m0, int mrows,
                                      const bf16_t* __restrict__ B, int ldb, int n0, int ncols, int K, unsigned char* smem,
                                      f32x4 (&acc)[4][4]) {
    bf16_t* As = (bf16_t*)smem;
    bf16_t* Bs = As + 128 * ASTR;
    const int tid = threadIdx.x, lane = tid & 63, wave = tid >> 6, wm = wave >> 1, wn = wave & 1;
#pragma unroll
    for (int i = 0; i < 4; ++i)
#pragma unroll
        for (int j = 0; j < 4; ++j) acc[i][j] = (f32x4){0.f, 0.f, 0.f, 0.f};
    const int arl = tid >> 1, ahalf = tid & 1;
    const int arc = arl < mrows ? arl : mrows - 1;
    const long asrc = GATHER ? (long)rowidx[m0 + arc] : (long)(m0 + arc);
    const bf16_t* ap = A + (size_t)asrc * lda + ahalf * 32;
    const int brow = tid >> 2, bq = tid & 3;
    const bf16_t* bp = B + (size_t)brow * ldb + n0 + (PAIR ? bq * 16 : bq * 32);
    const int boff1 = 8, boff2 = PAIR ? 1024 : 16, boff3 = PAIR ? 1032 : 24;
    bf16_t* asd = As + arl * ASTR + ahalf * 32;
    bf16_t* bsd = Bs + brow * BSTR + bq * 32;
    uint4 a0, a1, a2, a3, b0, b1, b2, b3;
#define G2_LOAD(k0)                                                                                       \
    do {                                                                                                  \
        const bf16_t* ap_ = ap + (k0);                                                                    \
        a0 = *(const uint4*)(ap_); a1 = *(const uint4*)(ap_ + 8);                                         \
        a2 = *(const uint4*)(ap_ + 16); a3 = *(const uint4*)(ap_ + 24);                                   \
        const bf16_t* bp_ = bp + (size_t)(k0) * ldb;                                                      \
        b0 = *(const uint4*)(bp_); b1 = *(const uint4*)(bp_ + boff1);                                     \
        b2 = *(const uint4*)(bp_ + boff2); b3 = *(const uint4*)(bp_ + boff3);                             \
    } while (0)
#define G2_STORE()                                                                                        \
    do {                                                                                                  \
        *(uint4*)(asd) = a0; *(uint4*)(asd + 8) = a1; *(uint4*)(asd + 16) = a2; *(uint4*)(asd + 24) = a3; \
        *(uint4*)(bsd) = b0; *(uint4*)(bsd + 8) = b1; *(uint4*)(bsd + 16) = b2; *(uint4*)(bsd + 24) = b3; \
    } while (0)
    const int nk = K / 64;
    __syncthreads();
    G2_LOAD(0);
    G2_STORE();
    __syncthreads();
    const int fr = lane & 15, fq = lane >> 4;
    const bf16_t* afp = As + (wm * 64 + fr) * ASTR + fq * 8;
    const bf16_t* bfp = Bs + (8 * fq + (fr >> 2)) * BSTR + wn * 64 + 4 * (fr & 3);
    for (int kt = 0; kt < nk; ++kt) {
        if (kt + 1 < nk) G2_LOAD((kt + 1) * 64);
#pragma unroll
        for (int kh = 0; kh < 2; ++kh) {
            bf16x8 a[4], b[4];
#pragma unroll
            for (int i = 0; i < 4; ++i) a[i] = *(const bf16x8*)(afp + i * 16 * ASTR + kh * 32);
#pragma unroll
            for (int j = 0; j < 4; ++j) {
                const bf16_t* q = bfp + kh * 32 * BSTR + j * 16;
                const s16x4 lo4 = lds_tr16(q), hi4 = lds_tr16(q + 4 * BSTR);
                b[j] = (bf16x8){lo4[0], lo4[1], lo4[2], lo4[3], hi4[0], hi4[1], hi4[2], hi4[3]};
            }
#pragma unroll
            for (int i = 0; i < 4; ++i)
#pragma unroll
                for (int j = 0; j < 4; ++j) acc[i][j] = __builtin_amdgcn_mfma_f32_16x16x32_bf16(a[i], b[j], acc[i][j], 0, 0, 0);
        }
        __syncthreads();
        if (kt + 1 < nk) {
            G2_STORE();
            __syncthreads();
        }
    }
#undef G2_LOAD
#undef G2_STORE
}
#define G2_ROW(i, r) ((threadIdx.x >> 7) * 64 + (i) * 16 + 4 * ((threadIdx.x & 63) >> 4) + (r))
#define G2_COL(j) (((((threadIdx.x >> 6) & 1) * 4 + (j)) * 16) + (threadIdx.x & 15))

__device__ __forceinline__ void cvt_weights(const float* __restrict__ src, bf16_t* __restrict__ dst, size_t n, int bid, int nb) {
    const size_t n8 = n >> 3;
    for (size_t i = (size_t)bid * NT + threadIdx.x; i < n8; i += (size_t)nb * NT) {
        const float4 u = ((const float4*)src)[2 * i], v = ((const float4*)src)[2 * i + 1];
        uint4 o; o.x = pk2(u.x, u.y); o.y = pk2(u.z, u.w); o.z = pk2(v.x, v.y); o.w = pk2(v.z, v.w);
        ((uint4*)dst)[i] = o;
    }
}
__device__ __forceinline__ void phase_prep(const Params& p, int bid, int nb) {
    const int lane = threadIdx.x & 63, wave = threadIdx.x >> 6;
    if (bid == 0 && threadIdx.x < 64) ((int*)(p.ws + WS_CTL))[threadIdx.x] = 0;
    cvt_weights(p.in[2], (bf16_t*)(p.ws + WB_IN), (size_t)D * DIN, bid, nb);
    cvt_weights(p.in[14], (bf16_t*)(p.ws + WB_A), (size_t)512 * D, bid, nb);
    cvt_weights(p.in[15], (bf16_t*)(p.ws + WB_B), (size_t)512 * D, bid, nb);
    cvt_weights(p.in[16], (bf16_t*)(p.ws + WB_OUT), (size_t)D * D, bid, nb);
    cvt_weights(p.in[21], (bf16_t*)(p.ws + WB_E1), (size_t)NEXP * D * 2 * DFF, bid, nb);
    cvt_weights(p.in[23], (bf16_t*)(p.ws + WB_E2), (size_t)NEXP * DFF * D, bid, nb);
    cvt_weights(p.in[26], (bf16_t*)(p.ws + WB_PLE), (size_t)256 * D, bid, nb);
    cvt_weights(p.in[27], (bf16_t*)(p.ws + WB_PLEG), (size_t)D * D, bid, nb);
    cvt_weights(p.in[9], (bf16_t*)(p.ws + WB_CK1), (size_t)2048 * 64, bid, nb);
    cvt_weights(p.in[12], (bf16_t*)(p.ws + WB_CV1), (size_t)2048 * 64, bid, nb);
    const float* x = p.in[0];
    const float* g = p.in[3];
    bf16_t* hb = (bf16_t*)(p.ws + WS_HB);
    for (int t = bid * 4 + wave; t < S; t += nb * 4) {
        const float4* xr = (const float4*)(x + (size_t)t * D);
        float4 v[4];
        float ss = 0.f;
#pragma unroll
        for (int j = 0; j < 4; ++j) { v[j] = xr[lane + 64 * j]; ss += v[j].x * v[j].x + v[j].y * v[j].y + v[j].z * v[j].z + v[j].w * v[j].w; }
        ss = wave_sum(ss);
        const float rstd = rsqrtf(ss * (1.f / D) + EPS);
#pragma unroll
        for (int j = 0; j < 4; ++j) {
            const float4 gg = ((const float4*)g)[lane + 64 * j];
            uint2 o;
            o.x = pk2(v[j].x * rstd * gg.x, v[j].y * rstd * gg.y);
            o.y = pk2(v[j].z * rstd * gg.z, v[j].w * rstd * gg.w);
            ((uint2*)(hb + (size_t)t * D))[lane + 64 * j] = o;
        }
    }
}

__device__ __forceinline__ void phase_inproj(const Params& p, int bid, int nb, unsigned char* smem) {
    const bf16_t* hb = (const bf16_t*)(p.ws + WS_HB);
    float* z = (float*)(p.ws + WS_Z);
    constexpr int NTN = (DIN + 127) / 128;
    for (int w = bid; w < 128 * NTN; w += nb) {
        const int mt = w % 128, nt = w / 128;
        const int m0 = mt * 128, n0 = nt * 128;
        const int ncols = (DIN - n0) < 128 ? (DIN - n0) : 128;
        f32x4 acc[4][4];
        gemm2<false, false>(hb, D, nullptr, m0, 128, (const bf16_t*)(p.ws + WB_IN), DIN, n0, ncols, D, smem, acc);
#pragma unroll
        for (int i = 0; i < 4; ++i)
#pragma unroll
            for (int r = 0; r < 4; ++r) {
                float* zr = z + (size_t)(m0 + G2_ROW(i, r)) * DIN + n0;
#pragma unroll
                for (int j = 0; j < 4; ++j) { const int c = G2_COL(j); if (c < ncols) zr[c] = acc[i][j][r]; }
            }
    }
}

__device__ __forceinline__ float rms64(float v) { return rsqrtf(wave_sum(v * v) * (1.f / 64.f) + EPS); }
__device__ __forceinline__ void phase_post(const Params& p, int bid, int nb) {
    const int lane = threadIdx.x & 63, wave = threadIdx.x >> 6;
    const float* __restrict__ z = (const float*)(p.ws + WS_Z);
    float* __restrict__ gt = (float*)(p.ws + WS_GT);
    float* __restrict__ iws = (float*)(p.ws + WS_IWS);
    bf16_t* __restrict__ qnb = (bf16_t*)(p.ws + WS_QNB);
    bf16_t* __restrict__ kslb = (bf16_t*)(p.ws + WS_KSLB);
    bf16_t* __restrict__ vslb = (bf16_t*)(p.ws + WS_VSLB);
    bf16_t* __restrict__ kwnb = (bf16_t*)(p.ws + WS_KWNB);
    bf16_t* __restrict__ vwnb = (bf16_t*)(p.ws + WS_VWNB);
    bf16_t* __restrict__ kcr = (bf16_t*)(p.ws + WS_KCR);
    bf16_t* __restrict__ vcr = (bf16_t*)(p.ws + WS_VCR);
    bf16_t* __restrict__ dqb = (bf16_t*)(p.ws + WS_DQB);
    bf16_t* __restrict__ dkb = (bf16_t*)(p.ws + WS_DKB);
    bf16_t* __restrict__ dvb = (bf16_t*)(p.ws + WS_DVB);
    bf16_t* __restrict__ iqb = (bf16_t*)(p.ws + WS_IQB);
    bf16_t* __restrict__ ikb = (bf16_t*)(p.ws + WS_IKB);
    const float gqn = p.in[4][lane], gkn = p.in[5][lane], gqd = p.in[6][lane], gkd = p.in[7][lane];
    for (int t = bid * 4 + wave; t < S; t += nb * 4) {
        const float* zr = z + (size_t)t * DIN;
        float vq[8], vkv[12], vdq[8], vdk[8], vdv[8], viq[4];
#pragma unroll
        for (int h = 0; h < 8; ++h) vq[h] = zr[Z_NQ + h * 64 + lane];
#pragma unroll
        for (int j = 0; j < 12; ++j) vkv[j] = zr[Z_NKV + j * 64 + lane];
#pragma unroll
        for (int h = 0; h < 8; ++h) { vdq[h] = zr[Z_DQ + h * 64 + lane]; vdk[h] = zr[Z_DK + h * 64 + lane]; vdv[h] = zr[Z_DV + h * 64 + lane]; }
#pragma unroll
        for (int j = 0; j < 4; ++j) viq[j] = zr[Z_IQ + j * 64 + lane];
        const float vmisc = zr[Z_IK + lane];
        const float vgate = lane < 24 ? zr[Z_NGATE + lane] : 0.f;
#pragma unroll
        for (int h = 0; h < 8; ++h) qnb[(size_t)t * 512 + h * 64 + lane] = (bf16_t)f2bf(vq[h] * rms64(vq[h]) * gqn * (0.125f * LOG2E));
#pragma unroll
        for (int g = 0; g < 2; ++g) {
            const size_t o_ = ((size_t)g * S + t) * 64 + lane;
            kcr[o_] = (bf16_t)f2bf(vkv[0 + g]);
            vcr[o_] = (bf16_t)f2bf(vkv[2 + g]);
            kslb[o_] = (bf16_t)f2bf(vkv[4 + g] * rms64(vkv[4 + g]) * gkn);
            vslb[o_] = (bf16_t)f2bf(vkv[6 + g]);
            kwnb[o_] = (bf16_t)f2bf(vkv[8 + g] * rms64(vkv[8 + g]) * gkn);
            vwnb[o_] = (bf16_t)f2bf(vkv[10 + g]);
        }
        if (lane < 24) gt[(size_t)t * 32 + lane] = sigmoidf_(vgate);
#pragma unroll
        for (int h = 0; h < 8; ++h) {
            dqb[(size_t)t * 512 + h * 64 + lane] = (bf16_t)f2bf(vdq[h] * rms64(vdq[h]) * gqd * (0.125f * LOG2E));
            dkb[(size_t)t * 512 + h * 64 + lane] = (bf16_t)f2bf(vdk[h] * rms64(vdk[h]) * gkd);
            dvb[(size_t)t * 512 + h * 64 + lane] = (bf16_t)f2bf(vdv[h]);
        }
#pragma unroll
        for (int j = 0; j < 4; ++j) iqb[(size_t)t * 256 + j * 64 + lane] = (bf16_t)f2bf(viq[j] * 0.17677669529663687f);
        if (lane < 32) ikb[(size_t)t * 32 + lane] = (bf16_t)f2bf(vmisc);
        else if (lane < 40) iws[(size_t)t * 8 + lane - 32] = vmisc * 0.35355339059327373f;
    }
}

__device__ __forceinline__ void phase_compress(const Params& p, int bid, int nb, unsigned char* smem) {
    const int tid = threadIdx.x, lane = tid & 63, wave = tid >> 6;
    float* cvec = (float*)(smem + 36864);
    float* hid = (float*)(smem + 36864 + 256);
    for (int w = bid; w < 32; w += nb) {
        const int kind = w >> 4, g = (w >> 3) & 1, mt = w & 7;
        const bf16_t* raw = (const bf16_t*)(p.ws + (kind ? WS_VCR : WS_KCR)) + (size_t)g * S * 64;
        const bf16_t* w1b = (const bf16_t*)(p.ws + (kind ? WB_CV1 : WB_CK1));
        const float* pe = p.in[kind ? 11 : 8];
        const float* w1 = p.in[kind ? 12 : 9];
        const float* w2 = p.in[kind ? 13 : 10];
        const int m0 = mt * 128;
        const int mrows = (NCMP - m0) < 128 ? (NCMP - m0) : 128;
        f32x4 acc[4][4];
        gemm2<false, false>(raw, 16 * 64, nullptr, m0, mrows, w1b, 64, 0, 64, 2048, smem, acc);
        {
            const int e = tid & 63, part = tid >> 6;
            float s = 0.f;
            for (int k = part * 512; k < part * 512 + 512; ++k) s += pe[k] * w1[(size_t)k * 64 + e];
            hid[tid] = s;
            __syncthreads();
            if (tid < 64) cvec[tid] = hid[tid] + hid[64 + tid] + hid[128 + tid] + hid[192 + tid];
            __syncthreads();
        }
        if ((wave & 1) == 0) {
#pragma unroll
            for (int i = 0; i < 4; ++i)
#pragma unroll
                for (int j = 0; j < 4; ++j)
#pragma unroll
                    for (int r = 0; r < 4; ++r) {
                        const int row = G2_ROW(i, r), col = j * 16 + (lane & 15);
                        const float a = acc[i][j][r] + cvec[col];
                        hid[row * 65 + col] = a * sigmoidf_(a);
                    }
        }
        __syncthreads();
        const float gkn = p.in[5][lane];
        for (int row = wave; row < mrows; row += 4) {
            float o = 0.f;
#pragma unroll 8
            for (int e = 0; e < 64; ++e) o += hid[row * 65 + e] * w2[e * 64 + lane];
            if (kind == 0) o = o * rms64(o) * gkn;
            ((bf16_t*)(p.ws + (kind ? WS_VCB : WS_KCB)))[((size_t)g * 1024 + m0 + row) * 64 + lane] = (bf16_t)f2bf(o);
        }
        __syncthreads();
    }
    if (bid == nb - 1) {
        if (tid < 128) ((bf16_t*)(p.ws + WS_KCB))[((size_t)(tid >> 6) * 1024 + 1023) * 64 + (tid & 63)] = 0;
        else ((bf16_t*)(p.ws + WS_VCB))[((size_t)((tid - 128) >> 6) * 1024 + 1023) * 64 + (tid & 63)] = 0;
    }
}

constexpr int KSTR = 72;
constexpr int NSA_KT = 0;
constexpr int NSA_VT = NSA_KT + 32 * KSTR * 2;
constexpr int NSA_WV = NSA_VT + 32 * KSTR * 2;
constexpr int NSA_IMP = NSA_WV + 4 * 32 * KSTR * 2;
constexpr int NSA_LUT = NSA_IMP + 16 * 260 * 4;
constexpr int NSA_SEL = NSA_LUT + 4 * 128 * 4;
constexpr int NSA_END = NSA_SEL + 16 * 16 * 4;
static_assert(NSA_END <= SMEM_BYTES, "nsa lds");

__device__ __forceinline__ f32x4 mfma16(bf16x8 a, bf16x8 b, f32x4 c) { return __builtin_amdgcn_mfma_f32_16x16x32_bf16(a, b, c, 0, 0, 0); }
__device__ __forceinline__ bf16x8 pack_p(const f32x4& p1, const f32x4& p2) {
    const unsigned a = pk2(p1[0], p1[1]), b = pk2(p1[2], p1[3]), c = pk2(p2[0], p2[1]), d = pk2(p2[2], p2[3]);
    return __builtin_bit_cast(bf16x8, make_uint4(a, b, c, d));
}
__device__ __forceinline__ void pv_step(f32x4 (&o)[4], const bf16_t* vt, bf16x8 pb, int fq, int fr) {
    const bf16_t* base = vt + (4 * fq + (fr >> 2)) * KSTR + 4 * (fr & 3);
#pragma unroll
    for (int dt = 0; dt < 4; ++dt) {
        const s16x4 lo4 = lds_tr16(base + dt * 16), hi4 = lds_tr16(base + 16 * KSTR + dt * 16);
        const bf16x8 va = (bf16x8){lo4[0], lo4[1], lo4[2], lo4[3], hi4[0], hi4[1], hi4[2], hi4[3]};
        o[dt] = mfma16(va, pb, o[dt]);
    }
}
__device__ __forceinline__ float quad_sum(float v) {
    v += __shfl_xor(v, 1);
    v += __shfl_xor(v, 2);
    return v;
}

__device__ __forceinline__ void nsa_tile(const Params& p, int tt, int g, unsigned char* smem) {
    const int tid = threadIdx.x, lane = tid & 63, wave = tid >> 6, fr = lane & 15, fq = lane >> 4;
    bf16_t* kt = (bf16_t*)(smem + NSA_KT);
    bf16_t* vt = (bf16_t*)(smem + NSA_VT);
    bf16_t* wv = (bf16_t*)(smem + NSA_WV) + wave * 32 * KSTR;
    float* imp = (float*)(smem + NSA_IMP);
    float* lut = (float*)(smem + NSA_LUT);
    int* sel = (int*)(smem + NSA_SEL);
    const bf16_t* qnb = (const bf16_t*)(p.ws + WS_QNB);
    const bf16_t* kslb = (const bf16_t*)(p.ws + WS_KSLB) + (size_t)g * S * 64;
    const bf16_t* vslb = (const bf16_t*)(p.ws + WS_VSLB) + (size_t)g * S * 64;
    const bf16_t* kwnb = (const bf16_t*)(p.ws + WS_KWNB) + (size_t)g * S * 64;
    const bf16_t* vwnb = (const bf16_t*)(p.ws + WS_VWNB) + (size_t)g * S * 64;
    const bf16_t* kcb = (const bf16_t*)(p.ws + WS_KCB) + (size_t)g * 1024 * 64;
    const bf16_t* vcb = (const bf16_t*)(p.ws + WS_VCB) + (size_t)g * 1024 * 64;
    const float* gt = (const float*)(p.ws + WS_GT);
    const float* relb = p.in[17];
    const int t0 = tt * 16;
    const int tl = 4 * wave + (fr >> 2);
    const int tok = t0 + tl;
    const int hl = fr & 3, head = g * 4 + hl;
    __syncthreads();
    for (int i = tid; i < 512; i += NT) { const int hh = i >> 7, n = i & 127; lut[i] = relb[bucket_of(n) * 16 + g * 4 + hh] * LOG2E; }
    for (int i = tid; i < 16 * 260; i += NT) imp[i] = 0.f;
    float U2;
    {
        const float mq = wave_max(fabsf(p.in[4][lane])), mk = wave_max(fabsf(p.in[5][lane]));
        float mb = 0.f;
#pragma unroll
        for (int k = 0; k < 4; ++k) { const int e = lane + 64 * k; mb = fmaxf(mb, fabsf(relb[(e >> 3) * 16 + (e & 7)])); }
        mb = wave_max(mb);
        U2 = (8.f * mq * mk + mb) * LOG2E;
    }
    bf16x8 qf[2];
#pragma unroll
    for (int kh = 0; kh < 2; ++kh) qf[kh] = *(const bf16x8*)(qnb + (size_t)tok * 512 + head * 64 + kh * 32 + fq * 8);
    __syncthreads();
    const float* lutp = lut + hl * 128;
    const float lutfar = lutp[127];
    const f32x4 zero4 = (f32x4){0.f, 0.f, 0.f, 0.f};
    f32x4 outacc[4];
#pragma unroll
    for (int dt = 0; dt < 4; ++dt) outacc[dt] = zero4;
    const float g0 = gt[(size_t)tok * 32 + head * 3 + 0], g1 = gt[(size_t)tok * 32 + head * 3 + 1], g2 = gt[(size_t)tok * 32 + head * 3 + 2];
    const int srow = tid >> 3, sch = tid & 7;

    {
        int ks0 = (t0 - 511) & ~31; ks0 = ks0 < 0 ? 0 : ks0;
        const int nsteps = (t0 + 16 - ks0 + 31) >> 5;
        f32x4 o[4];
#pragma unroll
        for (int dt = 0; dt < 4; ++dt) o[dt] = zero4;
        float lsum = 0.f;
        uint4 kreg = *(const uint4*)(kwnb + (size_t)(ks0 + srow) * 64 + sch * 8);
        uint4 vreg = *(const uint4*)(vwnb + (size_t)(ks0 + srow) * 64 + sch * 8);
#pragma unroll 1
        for (int st = 0; st < nsteps; ++st) {
            const int ks = ks0 + st * 32;
            *(uint4*)(kt + srow * KSTR + sch * 8) = kreg;
            *(uint4*)(vt + srow * KSTR + sch * 8) = vreg;
            __syncthreads();
            if (st + 1 < nsteps) {
                kreg = *(const uint4*)(kwnb + (size_t)(ks + 32 + srow) * 64 + sch * 8);
                vreg = *(const uint4*)(vwnb + (size_t)(ks + 32 + srow) * 64 + sch * 8);
            }
            f32x4 s1 = zero4, s2 = zero4;
#pragma unroll
            for (int kh = 0; kh < 2; ++kh) {
                const bf16x8 k1 = *(const bf16x8*)(kt + fr * KSTR + kh * 32 + fq * 8);
                const bf16x8 k2 = *(const bf16x8*)(kt + (16 + fr) * KSTR + kh * 32 + fq * 8);
                s1 = mfma16(k1, qf[kh], s1);
                s2 = mfma16(k2, qf[kh], s2);
            }
            const bool far = (t0 + 4 * wave) - (ks + 31) >= 113;
            f32x4 p1, p2;
#pragma unroll
            for (int r = 0; r < 4; ++r) {
                const int d1 = tok - (ks + 4 * fq + r), d2 = d1 - 16;
                const float b1 = far ? lutfar : lutp[d1 < 0 ? 0 : (d1 > 127 ? 127 : d1)];
                const float b2 = far ? lutfar : lutp[d2 < 0 ? 0 : (d2 > 127 ? 127 : d2)];
                p1[r] = (d1 >= 0 && d1 < 512) ? __builtin_amdgcn_exp2f(s1[r] + b1 - U2) : 0.f;
                p2[r] = (d2 >= 0 && d2 < 512) ? __builtin_amdgcn_exp2f(s2[r] + b2 - U2) : 0.f;
                lsum += p1[r] + p2[r];
            }
            pv_step(o, vt, pack_p(p1, p2), fq, fr);
            __syncthreads();
        }
        lsum += __shfl_xor(lsum, 16);
        lsum += __shfl_xor(lsum, 32);
        const float sc = lsum > 0.f ? g2 / lsum : 0.f;
#pragma unroll
        for (int dt = 0; dt < 4; ++dt)
#pragma unroll
            for (int r = 0; r < 4; ++r) outacc[dt][r] += sc * o[dt][r];
    }

    {
        const int tlast = t0 + 15;
        const int cmax = (tlast >= 31) ? ((tlast - 31) >> 4) + 1 : 0;
        const int nsteps = (cmax + 31) >> 5;
        float inv_l = 0.f;
#pragma unroll 1
        for (int pass = 0; pass < 2; ++pass) {
            f32x4 o[4];
#pragma unroll
            for (int dt = 0; dt < 4; ++dt) o[dt] = zero4;
            float lsum = 0.f;
            uint4 kreg = make_uint4(0, 0, 0, 0), vreg = kreg;
            if (nsteps > 0) {
                kreg = *(const uint4*)(kcb + (size_t)srow * 64 + sch * 8);
                vreg = *(const uint4*)(vcb + (size_t)srow * 64 + sch * 8);
            }
#pragma unroll 1
            for (int st = 0; st < nsteps; ++st) {
                const int cs = st * 32;
                *(uint4*)(kt + srow * KSTR + sch * 8) = kreg;
                *(uint4*)(vt + srow * KSTR + sch * 8) = vreg;
                __syncthreads();
                if (st + 1 < nsteps) {
                    kreg = *(const uint4*)(kcb + (size_t)(cs + 32 + srow) * 64 + sch * 8);
                    vreg = *(const uint4*)(vcb + (size_t)(cs + 32 + srow) * 64 + sch * 8);
                }
                f32x4 s1 = zero4, s2 = zero4;
#pragma unroll
                for (int kh = 0; kh < 2; ++kh) {
                    const bf16x8 k1 = *(const bf16x8*)(kt + fr * KSTR + kh * 32 + fq * 8);
                    const bf16x8 k2 = *(const bf16x8*)(kt + (16 + fr) * KSTR + kh * 32 + fq * 8);
                    s1 = mfma16(k1, qf[kh], s1);
                    s2 = mfma16(k2, qf[kh], s2);
                }
                const bool far = (t0 + 4 * wave) - (16 * (cs + 31) + 31) >= 113;
                f32x4 p1, p2;
#pragma unroll
                for (int r = 0; r < 4; ++r) {
                    const int d1 = tok - (16 * (cs + 4 * fq + r) + 31), d2 = d1 - 256;
                    const float b1 = far ? lutfar : lutp[d1 < 0 ? 0 : (d1 > 127 ? 127 : d1)];
                    const float b2 = far ? lutfar : lutp[d2 < 0 ? 0 : (d2 > 127 ? 127 : d2)];
                    p1[r] = (d1 >= 0) ? __builtin_amdgcn_exp2f(s1[r] + b1 - U2) : 0.f;
                    p2[r] = (d2 >= 0) ? __builtin_amdgcn_exp2f(s2[r] + b2 - U2) : 0.f;
                    lsum += p1[r] + p2[r];
                }
                if (pass == 1) {
#pragma unroll
                    for (int r = 0; r < 4; ++r) { p1[r] *= inv_l; p2[r] *= inv_l; }
                    f32x4 h1, h2;
#pragma unroll
                    for (int r = 0; r < 4; ++r) { h1[r] = quad_sum(p1[r]); h2[r] = quad_sum(p2[r]); }
                    if (hl == 0) {
                        float* ir = imp + tl * 260 + (cs >> 2) + fq;
                        atomicAdd(ir, h1[0] + h1[1] + h1[2] + 0.5f * h1[3]);
                        atomicAdd(ir + 1, 0.5f * h1[3]);
                        atomicAdd(ir + 4, h2[0] + h2[1] + h2[2] + 0.5f * h2[3]);
                        atomicAdd(ir + 5, 0.5f * h2[3]);
                    }
                    pv_step(o, vt, pack_p(p1, p2), fq, fr);
                }
                __syncthreads();
            }
            if (pass == 0) {
                lsum += __shfl_xor(lsum, 16);
                lsum += __shfl_xor(lsum, 32);
                inv_l = lsum > 0.f ? 1.f / lsum : 0.f;
            } else {
#pragma unroll
                for (int dt = 0; dt < 4; ++dt)
#pragma unroll
                    for (int r = 0; r < 4; ++r) outacc[dt][r] += g0 * o[dt][r];
            }
        }
    }
    __syncthreads();

#pragma unroll 1
    for (int tq = 0; tq < 4; ++tq) {
        const int tli = 4 * wave + tq, tk = t0 + tli, cur = tk >> 6;
        int* sl = sel + tli * 16;
        int nf = 0;
        if (lane == 0) {
            sl[0] = 0; int c_ = 1;
            if (cur - 1 >= 1) sl[c_++] = cur - 1;
            if (cur >= 1) sl[c_++] = cur;
            for (int k = c_; k < 16; ++k) sl[k] = -1;
        }
        nf = 1 + (cur - 1 >= 1 ? 1 : 0) + (cur >= 1 ? 1 : 0);
        const int ncand = cur - 2 > 0 ? cur - 2 : 0;
        int need = 16 - nf; need = need < ncand ? need : ncand;
        unsigned long long key[4];
#pragma unroll
        for (int k = 0; k < 4; ++k) {
            const int n = lane + 64 * k;
            const bool c = (n >= 1) && (n <= cur - 2);
            key[k] = c ? (((unsigned long long)__builtin_bit_cast(unsigned, imp[tli * 260 + n]) << 32) | (unsigned long long)(0xFFFFFFFFu - (unsigned)n)) + (1ull << 32) : 0ull;
        }
#pragma unroll 1
        for (int rd = 0; rd < need; ++rd) {
            unsigned long long m = key[0];
            m = key[1] > m ? key[1] : m; m = key[2] > m ? key[2] : m; m = key[3] > m ? key[3] : m;
#pragma unroll
            for (int o_ = 1; o_ < 64; o_ <<= 1) {
                const unsigned lo_ = __shfl_xor((unsigned)m, o_), hi_ = __shfl_xor((unsigned)(m >> 32), o_);
                const unsigned long long other = ((unsigned long long)hi_ << 32) | lo_;
                m = other > m ? other : m;
            }
            const int nstar = (int)(0xFFFFFFFFu - (unsigned)m);
#pragma unroll
            for (int k = 0; k < 4; ++k) if (key[k] == m) key[k] = 0ull;
            if (lane == 0) sl[nf + rd] = nstar;
        }
    }
    __syncthreads();

    {
        f32x4 o[4];
#pragma unroll
        for (int dt = 0; dt < 4; ++dt) o[dt] = zero4;
        float lsum = 0.f;
        const int vrow = lane >> 1, vhalf = lane & 1;
#pragma unroll 1
        for (int tq = 0; tq < 4; ++tq) {
            const int tli = 4 * wave + tq, tk = t0 + tli;
            const bool mine = (fr >> 2) == tq;
#pragma unroll 1
            for (int j = 0; j < 16; ++j) {
                const int b = __builtin_amdgcn_readfirstlane(sel[tli * 16 + j]);
                if (b < 0) continue;
                const int base = b * 64;
#pragma unroll 1
                for (int hf = 0; hf < 2; ++hf) {
                    const int ks = base + 32 * hf;
                    if (ks > tk) break;
                    bf16x8 k1[2], k2[2];
#pragma unroll
                    for (int kh = 0; kh < 2; ++kh) {
                        k1[kh] = *(const bf16x8*)(kslb + (size_t)(ks + fr) * 64 + kh * 32 + fq * 8);
                        k2[kh] = *(const bf16x8*)(kslb + (size_t)(ks + 16 + fr) * 64 + kh * 32 + fq * 8);
                    }
                    const uint4* vsrc = (const uint4*)(vslb + (size_t)(ks + vrow) * 64 + vhalf * 32);
                    const uint4 v0 = vsrc[0], v1 = vsrc[1], v2 = vsrc[2], v3 = vsrc[3];
                    uint4* vdst = (uint4*)(wv + vrow * KSTR + vhalf * 32);
                    vdst[0] = v0; vdst[1] = v1; vdst[2] = v2; vdst[3] = v3;
                    f32x4 s1 = zero4, s2 = zero4;
#pragma unroll
                    for (int kh = 0; kh < 2; ++kh) { s1 = mfma16(k1[kh], qf[kh], s1); s2 = mfma16(k2[kh], qf[kh], s2); }
                    const bool far = tk - (ks + 31) >= 113;
                    f32x4 p1, p2;
#pragma unroll
                    for (int r = 0; r < 4; ++r) {
                        const int d1 = tk - (ks + 4 * fq + r), d2 = d1 - 16;
                        const float b1 = far ? lutfar : lutp[d1 < 0 ? 0 : (d1 > 127 ? 127 : d1)];
                        const float b2 = far ? lutfar : lutp[d2 < 0 ? 0 : (d2 > 127 ? 127 : d2)];
                        p1[r] = (mine && d1 >= 0) ? __builtin_amdgcn_exp2f(s1[r] + b1 - U2) : 0.f;
                        p2[r] = (mine && d2 >= 0) ? __builtin_amdgcn_exp2f(s2[r] + b2 - U2) : 0.f;
                        lsum += p1[r] + p2[r];
                    }
                    asm volatile("" ::: "memory");
                    pv_step(o, wv, pack_p(p1, p2), fq, fr);
                    asm volatile("" ::: "memory");
                }
            }
        }
        lsum += __shfl_xor(lsum, 16);
        lsum += __shfl_xor(lsum, 32);
        const float sc = lsum > 0.f ? g1 / lsum : 0.f;
#pragma unroll
        for (int dt = 0; dt < 4; ++dt)
#pragma unroll
            for (int r = 0; r < 4; ++r) outacc[dt][r] += sc * o[dt][r];
    }
    bf16_t* orow = (bf16_t*)(p.ws + WS_OA) + (size_t)tok * 512 + head * 64 + 4 * fq;
#pragma unroll
    for (int dt = 0; dt < 4; ++dt) {
        uint2 v; v.x = pk2(outacc[dt][0], outacc[dt][1]); v.y = pk2(outacc[dt][2], outacc[dt][3]);
        *(uint2*)(orow + dt * 16) = v;
    }
}

typedef float f32x16 __attribute__((ext_vector_type(16)));
constexpr int DSA_CK = 0;
constexpr int DSA_CI = DSA_CK + 16 * 512 * 4;
constexpr int DSA_LUT = DSA_CI + 16 * 512 * 2;
constexpr int DSA_END = DSA_LUT + 8 * 128 * 4;
static_assert(DSA_END <= SMEM_BYTES, "dsa lds");

__device__ __forceinline__ unsigned mono_key(float s) {
    const unsigned u = __builtin_bit_cast(unsigned, s + 0.0f);
    return (u & 0x80000000u) ? ~u : (u | 0x80000000u);
}
__device__ __forceinline__ unsigned dsa_compact(unsigned* ck, unsigned short* ci, int n, int lane) {
    unsigned kk[8]; unsigned ii[8];
#pragma unroll
    for (int k = 0; k < 8; ++k) { const int e = lane + 64 * k; kk[k] = e < n ? ck[e] : 0u; ii[k] = e < n ? (unsigned)ci[e] : 0xFFFFu; }
    unsigned T = 0;
#pragma unroll 1
    for (int b = 31; b >= 0; --b) {
        const unsigned cand = T | (1u << b);
        int c = 0;
#pragma unroll
        for (int k = 0; k < 8; ++k) c += __builtin_popcountll(__ballot(kk[k] >= cand));
        if (c >= 256) T = cand;
    }
    int cgt = 0, ceq = 0;
#pragma unroll
    for (int k = 0; k < 8; ++k) { cgt += __builtin_popcountll(__ballot(kk[k] > T)); ceq += __builtin_popcountll(__ballot(kk[k] == T)); }
    const int need = 256 - cgt;
    unsigned X = 0xFFFFu;
    if (ceq > need) {
        X = 0;
#pragma unroll 1
        for (int b = 15; b >= 0; --b) {
            const unsigned cand = X | (1u << b);
            int c = 0;
#pragma unroll
            for (int k = 0; k < 8; ++k) c += __builtin_popcountll(__ballot(kk[k] == T && ii[k] < cand));
            if (c < need) X = cand;
        }
    }
    int base = 0;
    const unsigned long long lt = (1ull << lane) - 1ull;
#pragma unroll
    for (int k = 0; k < 8; ++k) {
        const bool keep = (kk[k] > T) || (kk[k] == T && ii[k] <= X);
        const unsigned long long m = __ballot(keep);
        if (keep) { const int pos = base + __builtin_popcountll(m & lt); ck[pos] = kk[k]; ci[pos] = (unsigned short)ii[k]; }
        base += __builtin_popcountll(m);
    }
    return T;
}

__device__ __forceinline__ void dsa_tile(const Params& p, int tt, unsigned char* smem) {
    const int tid = threadIdx.x, lane = tid & 63, wave = tid >> 6, col = lane & 31, hi = lane >> 5;
    unsigned* ckb = (unsigned*)(smem + DSA_CK);
    unsigned short* cib = (unsigned short*)(smem + DSA_CI);
    const bf16_t* iqb = (const bf16_t*)(p.ws + WS_IQB);
    const bf16_t* ikb = (const bf16_t*)(p.ws + WS_IKB);
    const float* iws = (const float*)(p.ws + WS_IWS);
    const int t0 = tt * 16;
    __syncthreads();
    const int tw = t0 + 4 * wave;
    bf16x8 af[2];
    {
        const int rho = col;
        const int tl_ = 2 * ((rho >> 2) & 1) + (rho >> 4), hd = 4 * ((rho >> 3) & 1) + (rho & 3);
#pragma unroll
        for (int ks = 0; ks < 2; ++ks) af[ks] = *(const bf16x8*)(iqb + (size_t)(tw + tl_) * 256 + hd * 32 + ks * 16 + hi * 8);
    }
    const int tokA = tw + 2 * hi, tokB = tokA + 1;
    float wA[8], wB[8];
#pragma unroll
    for (int h = 0; h < 8; ++h) { wA[h] = iws[(size_t)tokA * 8 + h]; wB[h] = iws[(size_t)tokB * 8 + h]; }
    unsigned* ckA = ckb + (4 * wave + 2 * hi) * 512;
    unsigned* ckB = ckA + 512;
    unsigned short* ciA = cib + (4 * wave + 2 * hi) * 512;
    unsigned short* ciB = ciA + 512;
    int cntA = 0, cntB = 0;
    unsigned LA = 0, LB = 0;
    const unsigned ltm = (1u << col) - 1u;
    const int nchunk = (tw + 4 + 31) >> 5;
    const f32x16 zero16 = {0.f, 0.f, 0.f, 0.f, 0.f, 0.f, 0.f, 0.f, 0.f, 0.f, 0.f, 0.f, 0.f, 0.f, 0.f, 0.f};
    bf16x8 nx0[4], nx1[4];
    const bf16_t* ikl = ikb + (size_t)col * 32 + hi * 8;
#pragma unroll
    for (int j = 0; j < 4; ++j) {
        const int cj = j < nchunk ? j : nchunk - 1;
        nx0[j] = *(const bf16x8*)(ikl + (size_t)cj * 1024); nx1[j] = *(const bf16x8*)(ikl + (size_t)cj * 1024 + 16);
    }
#pragma unroll 1
    for (int ch4 = 0; ch4 < nchunk; ch4 += 4) {
        bf16x8 cu0[4], cu1[4];
#pragma unroll
        for (int j = 0; j < 4; ++j) { cu0[j] = nx0[j]; cu1[j] = nx1[j]; }
#pragma unroll
        for (int j = 0; j < 4; ++j) {
            int cj = ch4 + 4 + j; cj = cj < nchunk ? cj : nchunk - 1;
            nx0[j] = *(const bf16x8*)(ikl + (size_t)cj * 1024); nx1[j] = *(const bf16x8*)(ikl + (size_t)cj * 1024 + 16);
        }
#pragma unroll
        for (int j = 0; j < 4; ++j) {
            const int ch = ch4 + j;
            if (ch < nchunk) {
                const int kidx = ch * 32 + col;
                f32x16 c = __builtin_amdgcn_mfma_f32_32x32x16_bf16(af[0], cu0[j], zero16, 0, 0, 0);
                c = __builtin_amdgcn_mfma_f32_32x32x16_bf16(af[1], cu1[j], c, 0, 0, 0);
                float sA = 0.f, sB = 0.f;
#pragma unroll
                for (int h = 0; h < 8; ++h) { sA += wA[h] * fmaxf(c[h], 0.f); sB += wB[h] * fmaxf(c[8 + h], 0.f); }
                const unsigned keyA = mono_key(sA), keyB = mono_key(sB);
                const bool pA = (kidx <= tokA) && (keyA > LA), pB = (kidx <= tokB) && (keyB > LB);
                const unsigned long long mA = __ballot(pA), mB = __ballot(pB);
                const unsigned hA = hi ? (unsigned)(mA >> 32) : (unsigned)mA, hB = hi ? (unsigned)(mB >> 32) : (unsigned)mB;
                if (pA) { const int pos = cntA + __builtin_popcount(hA & ltm); ckA[pos] = keyA; ciA[pos] = (unsigned short)kidx; }
                if (pB) { const int pos = cntB + __builtin_popcount(hB & ltm); ckB[pos] = keyB; ciB[pos] = (unsigned short)kidx; }
                cntA += __builtin_popcount(hA); cntB += __builtin_popcount(hB);
            }
        }
        if (__any((cntA > 384) || (cntB > 384))) {
#pragma unroll
            for (int tq = 0; tq < 4; ++tq) {
                const int cn = __shfl((tq & 1) ? cntB : cntA, (tq >> 1) * 32);
                if (cn > 384) {
                    const unsigned T = dsa_compact(ckb + (4 * wave + tq) * 512, cib + (4 * wave + tq) * 512, cn, lane);
                    if (hi == (tq >> 1)) { if (tq & 1) { cntB = 256; LB = T; } else { cntA = 256; LA = T; } }
                }
            }
        }
    }
#pragma unroll
    for (int tq = 0; tq < 4; ++tq) {
        const int cn = __shfl((tq & 1) ? cntB : cntA, (tq >> 1) * 32);
        if (cn > 256) {
            (void)dsa_compact(ckb + (4 * wave + tq) * 512, cib + (4 * wave + tq) * 512, cn, lane);
            if (hi == (tq >> 1)) { if (tq & 1) cntB = 256; else cntA = 256; }
        }
    }
    unsigned short* selg = (unsigned short*)(p.ws + WS_SEL);
    int* nselg = (int*)(p.ws + WS_NSEL);
#pragma unroll
    for (int tq = 0; tq < 4; ++tq) {
        int nsel = __shfl((tq & 1) ? cntB : cntA, (tq >> 1) * 32);
        nsel = nsel > 256 ? 256 : nsel;
        const unsigned short* sl = cib + (4 * wave + tq) * 512;
#pragma unroll
        for (int k = 0; k < 4; ++k) { const int e = lane + 64 * k; selg[(size_t)(tw + tq) * 256 + e] = e < nsel ? sl[e] : (unsigned short)0; }
        if (lane == 0) nselg[tw + tq] = nsel;
    }
}

__device__ __forceinline__ void phase_dsa_attn(const Params& p, int bid, int nb, unsigned char* smem) {
    const int tid = threadIdx.x, lane = tid & 63, wave = tid >> 6, slot = lane >> 3, chunk = lane & 7;
    float* lut = (float*)smem;
    const bf16_t* dqb = (const bf16_t*)(p.ws + WS_DQB);
    const bf16_t* dkb = (const bf16_t*)(p.ws + WS_DKB);
    const bf16_t* dvb = (const bf16_t*)(p.ws + WS_DVB);
    const unsigned short* selg = (const unsigned short*)(p.ws + WS_SEL);
    const int* nselg = (const int*)(p.ws + WS_NSEL);
    const float* relb = p.in[17];
    const int h = bid & 7, bh = bid >> 3, nbh = nb >> 3;
    __syncthreads();
    if (tid < 128) lut[tid] = relb[bucket_of(tid) * 16 + 8 + h] * LOG2E;
    float U2;
    {
        const float mq = wave_max(fabsf(p.in[6][lane])), mk = wave_max(fabsf(p.in[7][lane]));
        float mb = 0.f;
#pragma unroll
        for (int k = 0; k < 4; ++k) { const int e = lane + 64 * k; mb = fmaxf(mb, fabsf(relb[(e >> 3) * 16 + 8 + (e & 7)])); }
        mb = wave_max(mb);
        U2 = (8.f * mq * mk + mb) * LOG2E;
    }
    __syncthreads();
    const bf16_t* kbase = dkb + h * 64 + chunk * 8;
    const bf16_t* vbase = dvb + h * 64 + chunk * 8;
#pragma unroll 1
    for (int t = bh * 4 + wave; t < S; t += nbh * 4) {
        const int nsel = nselg[t];
        const uint2* ip = (const uint2*)(selg + (size_t)t * 256 + slot * 32);
        float q[8];
        {
            const uint4 qv = *(const uint4*)(dqb + (size_t)t * 512 + h * 64 + chunk * 8);
            q[0] = __builtin_bit_cast(float, qv.x << 16); q[1] = __builtin_bit_cast(float, qv.x & 0xffff0000u);
            q[2] = __builtin_bit_cast(float, qv.y << 16); q[3] = __builtin_bit_cast(float, qv.y & 0xffff0000u);
            q[4] = __builtin_bit_cast(float, qv.z << 16); q[5] = __builtin_bit_cast(float, qv.z & 0xffff0000u);
            q[6] = __builtin_bit_cast(float, qv.w << 16); q[7] = __builtin_bit_cast(float, qv.w & 0xffff0000u);
        }
        float o[8];
#pragma unroll
        for (int j = 0; j < 8; ++j) o[j] = 0.f;
        float lsum = 0.f;
        int sA_[4], sB_[4];
        uint4 kA_[4], vA_[4], kB_[4], vB_[4];
        uint2 idn = ip[0];
#define DSA_LOADG(S_, K_, V_, I_)                                                        \
        S_[0] = (int)((I_).x & 0xffffu); S_[1] = (int)((I_).x >> 16); S_[2] = (int)((I_).y & 0xffffu); S_[3] = (int)((I_).y >> 16); \
        _Pragma("unroll") for (int j = 0; j < 4; ++j) {                                 \
            K_[j] = *(const uint4*)(kbase + (size_t)S_[j] * 512);                        \
            V_[j] = *(const uint4*)(vbase + (size_t)S_[j] * 512);                        \
        }
#define DSA_COMPG(S_, K_, V_, gi)                                                        \
        _Pragma("unroll") for (int j = 0; j < 4; ++j) {                                 \
            const uint4 kv = K_[j], vv = V_[j];                                          \
            float d = q[0] * __builtin_bit_cast(float, kv.x << 16) + q[1] * __builtin_bit_cast(float, kv.x & 0xffff0000u) \
                    + q[2] * __builtin_bit_cast(float, kv.y << 16) + q[3] * __builtin_bit_cast(float, kv.y & 0xffff0000u) \
                    + q[4] * __builtin_bit_cast(float, kv.z << 16) + q[5] * __builtin_bit_cast(float, kv.z & 0xffff0000u) \
                    + q[6] * __builtin_bit_cast(float, kv.w << 16) + q[7] * __builtin_bit_cast(float, kv.w & 0xffff0000u); \
            d += __shfl_xor(d, 1); d += __shfl_xor(d, 2); d += __shfl_xor(d, 4);       \
            int dist = t - S_[j]; dist = dist > 127 ? 127 : (dist < 0 ? 0 : dist);       \
            float pr = __builtin_amdgcn_exp2f(d + lut[dist] - U2);                       \
            pr = (slot * 32 + (gi) * 4 + j < nsel) ? pr : 0.f;                           \
            lsum += pr;                                                                  \
            o[0] += pr * __builtin_bit_cast(float, vv.x << 16); o[1] += pr * __builtin_bit_cast(float, vv.x & 0xffff0000u); \
            o[2] += pr * __builtin_bit_cast(float, vv.y << 16); o[3] += pr * __builtin_bit_cast(float, vv.y & 0xffff0000u); \
            o[4] += pr * __builtin_bit_cast(float, vv.z << 16); o[5] += pr * __builtin_bit_cast(float, vv.z & 0xffff0000u); \
            o[6] += pr * __builtin_bit_cast(float, vv.w << 16); o[7] += pr * __builtin_bit_cast(float, vv.w & 0xffff0000u); \
        }
        DSA_LOADG(sA_, kA_, vA_, idn)
        idn = ip[1];
#pragma unroll 1
        for (int gi = 0; gi < 8; gi += 2) {
            DSA_LOADG(sB_, kB_, vB_, idn)
            idn = ip[gi + 2 < 8 ? gi + 2 : 7];
            DSA_COMPG(sA_, kA_, vA_, gi)
            DSA_LOADG(sA_, kA_, vA_, idn)
            idn = ip[gi + 3 < 8 ? gi + 3 : 7];
            DSA_COMPG(sB_, kB_, vB_, gi + 1)
        }
#undef DSA_LOADG
#undef DSA_COMPG
#pragma unroll
        for (int j = 0; j < 8; ++j) { o[j] += __shfl_xor(o[j], 8); o[j] += __shfl_xor(o[j], 16); o[j] += __shfl_xor(o[j], 32); }
        lsum += __shfl_xor(lsum, 8); lsum += __shfl_xor(lsum, 16); lsum += __shfl_xor(lsum, 32);
        if (slot == 0) {
            const float inv = lsum > 0.f ? 1.f / lsum : 0.f;
            uint4 ov;
            ov.x = pk2(o[0] * inv, o[1] * inv); ov.y = pk2(o[2] * inv, o[3] * inv); ov.z = pk2(o[4] * inv, o[5] * inv); ov.w = pk2(o[6] * inv, o[7] * inv);
            *(uint4*)((bf16_t*)(p.ws + WS_OB) + (size_t)t * 512 + h * 64 + chunk * 8) = ov;
        }
    }
}

__device__ __forceinline__ void phase_attn(const Params& p, int bid, int nb, unsigned char* smem) {
#pragma unroll 1
    for (int w = bid; w < 1024; w += nb) dsa_tile(p, 1023 - w, smem);
#pragma unroll 1
    for (int i = bid; i < 2048; i += nb) nsa_tile(p, 1023 - (i >> 1), i & 1, smem);
}

template <int PASS>
__device__ __forceinline__ void phase_merge(const Params& p, int bid, int nb, unsigned char* smem) {
    const float* z = (const float*)(p.ws + WS_Z);
    bf16_t* merged = (bf16_t*)(p.ws + WS_MERGED);
    float* tmp = (float*)(p.ws + WS_X1);
    const bf16_t* A = (const bf16_t*)(p.ws + (PASS ? WS_OB : WS_OA));
    const bf16_t* Bw = (const bf16_t*)(p.ws + (PASS ? WB_B : WB_A));
    constexpr int zoff = PASS ? Z_GB : Z_GA;
    for (int w = bid; w < 128 * 8; w += nb) {
        const int mt = w % 128, nt = w / 128;
        const int m0 = mt * 128, n0 = nt * 128;
        f32x4 acc[4][4];
        gemm2<false, false>(A, 512, nullptr, m0, 128, Bw, D, n0, 128, 512, smem, acc);
#pragma unroll
        for (int i = 0; i < 4; ++i)
#pragma unroll
            for (int r = 0; r < 4; ++r) {
                const int row = m0 + G2_ROW(i, r);
                const float* zr = z + (size_t)row * DIN + zoff + n0 + G2_COL(0);
                float* tr = tmp + (size_t)row * D + n0 + G2_COL(0);
                bf16_t* mr = merged + (size_t)row * D + n0 + G2_COL(0);
#pragma unroll
                for (int j = 0; j < 4; ++j) {
                    const float v = sigmoidf_(zr[j * 16]) * acc[i][j][r];
                    if (PASS == 0) tr[j * 16] = v;
                    else mr[j * 16] = (bf16_t)f2bf(tr[j * 16] + v);
                }
            }
    }
}

__device__ __forceinline__ void phase_outproj(const Params& p, int bid, int nb, unsigned char* smem) {
    const bf16_t* merged = (const bf16_t*)(p.ws + WS_MERGED);
    const float* x = p.in[0];
    float* x1 = (float*)(p.ws + WS_X1);
    for (int w = bid; w < 128 * 8; w += nb) {
        const int mt = w % 128, nt = w / 128;
        const int m0 = mt * 128, n0 = nt * 128;
        f32x4 acc[4][4];
        gemm2<false, false>(merged, D, nullptr, m0, 128, (const bf16_t*)(p.ws + WB_OUT), D, n0, 128, D, smem, acc);
#pragma unroll
        for (int i = 0; i < 4; ++i)
#pragma unroll
            for (int r = 0; r < 4; ++r) {
                const size_t ro = (size_t)(m0 + G2_ROW(i, r)) * D + n0;
#pragma unroll
                for (int j = 0; j < 4; ++j) { const int c = G2_COL(j); x1[ro + c] = x[ro + c] + acc[i][j][r]; }
            }
    }
}

__device__ __forceinline__ void phase_route(const Params& p, int bid, int nb) {
    const int lane = threadIdx.x & 63, wave = threadIdx.x >> 6;
    const float* x1 = (const float*)(p.ws + WS_X1);
    const float* g = p.in[18];
    const float* wr = p.in[19];
    const float* br = p.in[20];
    bf16_t* hb = (bf16_t*)(p.ws + WS_HB);
    int* topi = (int*)(p.ws + WS_TOPI);
    float* topw = (float*)(p.ws + WS_TOPW);
    int* cnt = (int*)(p.ws + WS_CTL);
    for (int t = bid * 4 + wave; t < S; t += nb * 4) {
        const float4* xr = (const float4*)(x1 + (size_t)t * D);
        float4 v[4];
        float ss = 0.f;
#pragma unroll
        for (int j = 0; j < 4; ++j) { v[j] = xr[lane + 64 * j]; ss += v[j].x * v[j].x + v[j].y * v[j].y + v[j].z * v[j].z + v[j].w * v[j].w; }
        ss = wave_sum(ss);
        const float rstd = rsqrtf(ss * (1.f / D) + EPS);
        float lg[32];
#pragma unroll
        for (int e = 0; e < 32; ++e) lg[e] = 0.f;
#pragma unroll
        for (int j = 0; j < 4; ++j) {
            const float4 gg = ((const float4*)g)[lane + 64 * j];
            const float h0 = v[j].x * rstd * gg.x, h1 = v[j].y * rstd * gg.y, h2 = v[j].z * rstd * gg.z, h3 = v[j].w * rstd * gg.w;
            uint2 o; o.x = pk2(h0, h1); o.y = pk2(h2, h3);
            ((uint2*)(hb + (size_t)t * D))[lane + 64 * j] = o;
            const int k = 4 * (lane + 64 * j);
            const float4* w0 = (const float4*)(wr + (size_t)k * 32);
#pragma unroll
            for (int e4 = 0; e4 < 8; ++e4) {
                const float4 a = w0[e4], b = w0[8 + e4], c = w0[16 + e4], d = w0[24 + e4];
                lg[4 * e4 + 0] += h0 * a.x + h1 * b.x + h2 * c.x + h3 * d.x;
                lg[4 * e4 + 1] += h0 * a.y + h1 * b.y + h2 * c.y + h3 * d.y;
                lg[4 * e4 + 2] += h0 * a.z + h1 * b.z + h2 * c.z + h3 * d.z;
                lg[4 * e4 + 3] += h0 * a.w + h1 * b.w + h2 * c.w + h3 * d.w;
            }
        }
#pragma unroll
        for (int e = 0; e < 32; ++e) lg[e] = wave_sum(lg[e]) + br[e];
        int idx[4]; float val[4];
        unsigned used = 0;
#pragma unroll
        for (int k = 0; k < 4; ++k) {
            float best = -__builtin_inff(); int bi = 0;
#pragma unroll
            for (int e = 0; e < 32; ++e) { const bool ok = !((used >> e) & 1u) && (lg[e] > best); best = ok ? lg[e] : best; bi = ok ? e : bi; }
            idx[k] = bi; val[k] = best; used |= 1u << bi;
        }
        const float e0 = 1.f, e1 = __expf(val[1] - val[0]), e2 = __expf(val[2] - val[0]), e3 = __expf(val[3] - val[0]);
        const float inv = 1.f / (e0 + e1 + e2 + e3);
        if (lane == 0) {
            topi[t * 4 + 0] = idx[0]; topi[t * 4 + 1] = idx[1]; topi[t * 4 + 2] = idx[2]; topi[t * 4 + 3] = idx[3];
            topw[t * 4 + 0] = e0 * inv; topw[t * 4 + 1] = e1 * inv; topw[t * 4 + 2] = e2 * inv; topw[t * 4 + 3] = e3 * inv;
            atomicAdd(&cnt[idx[0]], 1); atomicAdd(&cnt[idx[1]], 1); atomicAdd(&cnt[idx[2]], 1); atomicAdd(&cnt[idx[3]], 1);
        }
    }
}

__device__ __forceinline__ void phase_place(const Params& p, int bid, int nb, unsigned char* smem) {
    int* off = (int*)smem;
    const int* cnt = (const int*)(p.ws + WS_CTL);
    int* cur = (int*)(p.ws + WS_CTL) + 32;
    const int* topi = (const int*)(p.ws + WS_TOPI);
    int* ppos = (int*)(p.ws + WS_PPOS);
    int* rowtok = (int*)(p.ws + WS_ROWTOK);
    __syncthreads();
    if (threadIdx.x == 0) { int a = 0; for (int e = 0; e < NEXP; ++e) { off[e] = a; a += cnt[e]; } }
    __syncthreads();
    for (int i = bid * NT + threadIdx.x; i < S * 4; i += nb * NT) {
        const int e = topi[i];
        const int pos = off[e] + atomicAdd(&cur[e], 1);
        ppos[i] = pos;
        rowtok[pos] = i >> 2;
    }
}

__device__ __forceinline__ void moe_tile_map(const int* cnt, int* sm, int& total_mt) {
    __syncthreads();
    if (threadIdx.x == 0) {
        int a = 0, b = 0;
        for (int e = 0; e < NEXP; ++e) { sm[e] = a; sm[33 + e] = b; a += (cnt[e] + 127) >> 7; b += cnt[e]; }
        sm[32] = a; sm[65] = b;
    }
    __syncthreads();
    total_mt = sm[32];
}
__device__ __forceinline__ void phase_moe1(const Params& p, int bid, int nb, unsigned char* smem) {
    int* sm = (int*)(smem + 65536);
    const int* cnt = (const int*)(p.ws + WS_CTL);
    const int* rowtok = (const int*)(p.ws + WS_ROWTOK);
    const bf16_t* hb = (const bf16_t*)(p.ws + WS_HB);
    bf16_t* act = (bf16_t*)(p.ws + WS_ACT);
    const int lane = threadIdx.x & 63, wave = threadIdx.x >> 6;
    int total_mt;
    moe_tile_map(cnt, sm, total_mt);
    for (int w = bid; w < total_mt * 16; w += nb) {
        const int tm = w >> 4, nt = w & 15;
        int e = 0;
        while (e < NEXP - 1 && sm[e + 1] <= tm) ++e;
        const int mt = tm - sm[e];
        const int rbase = sm[33 + e] + mt * 128;
        const int mrows = min(128, cnt[e] - mt * 128);
        const int n0 = nt * 64;
        f32x4 acc[4][4];
        gemm2<true, true>(hb, D, rowtok, rbase, mrows, (const bf16_t*)(p.ws + WB_E1) + (size_t)e * D * 2 * DFF, 2 * DFF, n0, 128, D, smem, acc);
        const float* b1 = p.in[22] + (size_t)e * 2 * DFF;
        const int wn_ = (threadIdx.x >> 6) & 1;
#pragma unroll
        for (int i = 0; i < 4; ++i)
#pragma unroll
            for (int jp = 0; jp < 2; ++jp) {
                const int col = n0 + (wn_ * 2 + jp) * 16 + (threadIdx.x & 15);
                const float bg = b1[col], bl = b1[DFF + col];
#pragma unroll
                for (int r = 0; r < 4; ++r) {
                    const int rl = G2_ROW(i, r);
                    if (rl < mrows) {
                        const float gate = fminf(acc[i][2 * jp][r] + bg, 7.f);
                        const float lin = fminf(fmaxf(acc[i][2 * jp + 1][r] + bl, -7.f), 7.f);
                        const float a_ = (lin + 1.f) * gate * sigmoidf_(1.702f * gate);
                        act[(size_t)(rbase + rl) * DFF + col] = (bf16_t)f2bf(a_);
                    }
                }
            }
    }
}
__device__ __forceinline__ void phase_moe2(const Params& p, int bid, int nb, unsigned char* smem) {
    int* sm = (int*)(smem + 65536);
    const int* cnt = (const int*)(p.ws + WS_CTL);
    const bf16_t* act = (const bf16_t*)(p.ws + WS_ACT);
    float* yrows = (float*)(p.ws + WS_YROWS);
    const int lane = threadIdx.x & 63, wave = threadIdx.x >> 6;
    int total_mt;
    moe_tile_map(cnt, sm, total_mt);
    for (int w = bid; w < total_mt * 8; w += nb) {
        const int tm = w >> 3, nt = w & 7;
        int e = 0;
        while (e < NEXP - 1 && sm[e + 1] <= tm) ++e;
        const int mt = tm - sm[e];
        const int rbase = sm[33 + e] + mt * 128;
        const int mrows = min(128, cnt[e] - mt * 128);
        const int n0 = nt * 128;
        f32x4 acc[4][4];
        gemm2<false, false>(act, DFF, nullptr, rbase, mrows, (const bf16_t*)(p.ws + WB_E2) + (size_t)e * DFF * D, D, n0, 128, DFF, smem, acc);
        const float* b2 = p.in[24] + (size_t)e * D + n0;
#pragma unroll
        for (int i = 0; i < 4; ++i)
#pragma unroll
            for (int r = 0; r < 4; ++r) {
                const int rl = G2_ROW(i, r);
                if (rl < mrows) {
                    float* yr = yrows + (size_t)(rbase + rl) * D + n0;
#pragma unroll
                    for (int j = 0; j < 4; ++j) { const int c = G2_COL(j); yr[c] = acc[i][j][r] + b2[c]; }
                }
            }
    }
}

__device__ __forceinline__ void phase_combine(const Params& p, int bid, int nb) {
    const int lane = threadIdx.x & 63, wave = threadIdx.x >> 6;
    const float* x1 = (const float*)(p.ws + WS_X1);
    const float* yrows = (const float*)(p.ws + WS_YROWS);
    const int* ppos = (const int*)(p.ws + WS_PPOS);
    const float* topw = (const float*)(p.ws + WS_TOPW);
    const float* g = p.in[25];
    bf16_t* hb = (bf16_t*)(p.ws + WS_HB);
    bf16_t* pb = (bf16_t*)(p.ws + WS_PB);
    for (int t = bid * 4 + wave; t < S; t += nb * 4) {
        {
            const float4 pv = ((const float4*)(p.in[1] + (size_t)t * 256))[lane];
            uint2 o; o.x = pk2(pv.x, pv.y); o.y = pk2(pv.z, pv.w);
            ((uint2*)(pb + (size_t)t * 256))[lane] = o;
        }
        float4 v[4];
#pragma unroll
        for (int j = 0; j < 4; ++j) v[j] = ((const float4*)(x1 + (size_t)t * D))[lane + 64 * j];
#pragma unroll
        for (int k = 0; k < 4; ++k) {
            const float wk = topw[t * 4 + k];
            const float4* yr = (const float4*)(yrows + (size_t)ppos[t * 4 + k] * D);
#pragma unroll
            for (int j = 0; j < 4; ++j) { const float4 y = yr[lane + 64 * j]; v[j].x += wk * y.x; v[j].y += wk * y.y; v[j].z += wk * y.z; v[j].w += wk * y.w; }
        }
        float ss = 0.f;
#pragma unroll
        for (int j = 0; j < 4; ++j) ss += v[j].x * v[j].x + v[j].y * v[j].y + v[j].z * v[j].z + v[j].w * v[j].w;
        ss = wave_sum(ss);
        const float rstd = rsqrtf(ss * (1.f / D) + EPS);
#pragma unroll
        for (int j = 0; j < 4; ++j) {
            ((float4*)(p.out + (size_t)t * D))[lane + 64 * j] = v[j];
            const float4 gg = ((const float4*)g)[lane + 64 * j];
            uint2 o;
            o.x = pk2(v[j].x * rstd * gg.x, v[j].y * rstd * gg.y);
            o.y = pk2(v[j].z * rstd * gg.z, v[j].w * rstd * gg.w);
            ((uint2*)(hb + (size_t)t * D))[lane + 64 * j] = o;
        }
    }
}

template <int PASS>
__device__ __forceinline__ void phase_ple(const Params& p, int bid, int nb, unsigned char* smem) {
    float* tmp = (float*)(p.ws + WS_X1);
    const bf16_t* A = (const bf16_t*)(p.ws + (PASS ? WS_PB : WS_HB));
    const bf16_t* Bw = (const bf16_t*)(p.ws + (PASS ? WB_PLE : WB_PLEG));
    constexpr int K = PASS ? 256 : D;
    for (int w = bid; w < 128 * 8; w += nb) {
        const int mt = w % 128, nt = w / 128;
        const int m0 = mt * 128, n0 = nt * 128;
        f32x4 acc[4][4];
        gemm2<false, false>(A, K, nullptr, m0, 128, Bw, D, n0, 128, K, smem, acc);
#pragma unroll
        for (int i = 0; i < 4; ++i)
#pragma unroll
            for (int r = 0; r < 4; ++r) {
                const size_t ro = (size_t)(m0 + G2_ROW(i, r)) * D + n0 + G2_COL(0);
                float* tr = tmp + ro;
                float* orow = p.out + ro;
#pragma unroll
                for (int j = 0; j < 4; ++j) {
                    if (PASS == 0) tr[j * 16] = sigmoidf_(acc[i][j][r]);
                    else orow[j * 16] = orow[j * 16] + tr[j * 16] * acc[i][j][r];
                }
            }
    }
}

#define LAS __attribute__((address_space(3)))
#define XB_TMO      128
#define XB_XCNT(j)  (256  + 64 * (j))
#define XB_XSUB(j)  (1280 + 64 * (j))
#define XB_XGEN(j)  (2304 + 64 * (j))
#define XB_TOP      3328
#define XB_TOPGEN   3392
#define XCD_BAR_WORDS 3456
#define XB_SPIN_CAP (1u << 18)

__device__ __forceinline__ unsigned xb_ld(unsigned* p)              { return __hip_atomic_load(p, __ATOMIC_RELAXED, __HIP_MEMORY_SCOPE_AGENT); }
__device__ __forceinline__ unsigned xb_add(unsigned* p, unsigned v) { return __hip_atomic_fetch_add(p, v, __ATOMIC_RELAXED, __HIP_MEMORY_SCOPE_AGENT); }
__device__ __forceinline__ unsigned xb_xcc_id() { return (unsigned)__builtin_amdgcn_s_getreg((3 << 11) | 20) & 0xFu; }
#define XB_SPIN(cond, bar) do { unsigned _sp = 0; while (cond) { __builtin_amdgcn_s_sleep(1); \
    if ((++_sp & 255u) == 0u) { if (xb_ld(&(bar)[XB_TMO])) break; if (_sp > XB_SPIN_CAP) { atomicAdd(&(bar)[XB_TMO], 1u); break; } } } } while (0)

struct XcdBarrier {
    unsigned* bar; unsigned x;
    volatile LAS unsigned* st;
};

__device__ __forceinline__ XcdBarrier xcd_barrier_post(unsigned* bar, volatile LAS unsigned* st) {
    XcdBarrier b; b.bar = bar; b.x = xb_xcc_id(); b.st = st;
    if (threadIdx.x == 0) (void)xb_add(&bar[XB_XCNT(b.x)], 1u);
    return b;
}
__device__ __forceinline__ void xcd_barrier_complete(unsigned* bar, unsigned x, unsigned& nloc, unsigned& nx) {
    const unsigned G = gridDim.x * gridDim.y * gridDim.z;
    unsigned sum, cnt, mine, sp = 0u;
    for (;;) {
        sum = 0u; cnt = 0u; mine = 0u;
#pragma unroll
        for (unsigned j = 0; j < 16; ++j) { const unsigned c = xb_ld(&bar[XB_XCNT(j)]); sum += c; cnt += (c > 0u) ? 1u : 0u; mine = (j == x) ? c : mine; }
        if (sum == G) break;
        __builtin_amdgcn_s_sleep(1);
        if ((++sp & 255u) == 0u) { if (xb_ld(&bar[XB_TMO])) break; if (sp > XB_SPIN_CAP) { atomicAdd(&bar[XB_TMO], 1u); break; } }
    }
    nloc = mine > 0u ? mine : 1u; nx = cnt > 0u ? cnt : 1u;
}

__device__ __forceinline__ void xcd_barrier(const XcdBarrier& b) {
    asm volatile("s_waitcnt vmcnt(0)" ::: "memory");
    __syncthreads();
    if (threadIdx.x == 0) {
        unsigned* bar = b.bar;
        __builtin_amdgcn_s_waitcnt(0);
        unsigned nloc = b.st[0], nx = b.st[1];
        if (nloc == 0u) { xcd_barrier_complete(bar, b.x, nloc, nx); b.st[0] = nloc; b.st[1] = nx; }
        const unsigned old = xb_add(&bar[XB_XSUB(b.x)], 1u);
        const unsigned gen = old / nloc;
        if (old + 1u == (gen + 1u) * nloc) {
            __builtin_amdgcn_fence(__ATOMIC_RELEASE, "agent");
            asm volatile("s_waitcnt vmcnt(0)" ::: "memory");
            const unsigned og = xb_add(&bar[XB_TOP], 1u);
            const unsigned tg = og / nx;
            if (og + 1u == (tg + 1u) * nx) xb_add(&bar[XB_TOPGEN], 1u);
            else XB_SPIN(xb_ld(&bar[XB_TOPGEN]) == tg, bar);
            __builtin_amdgcn_fence(__ATOMIC_ACQUIRE, "agent");
            xb_add(&bar[XB_XGEN(b.x)], 1u);
            asm volatile("s_waitcnt vmcnt(0)" ::: "memory");
        } else {
            XB_SPIN(xb_ld(&bar[XB_XGEN(b.x)]) == gen, bar);
            __builtin_amdgcn_fence(__ATOMIC_ACQUIRE, "agent");
            asm volatile("s_waitcnt vmcnt(0)" ::: "memory");
        }
    }
    __syncthreads();
}

template <int PH>
__device__ __forceinline__ void run_phase(const Params& p, int bid, int nb, unsigned char* smem) {
    if (PH == 0) phase_prep(p, bid, nb);
    if (PH == 1) phase_inproj(p, bid, nb, smem);
    if (PH == 2) phase_post(p, bid, nb);
    if (PH == 3) phase_compress(p, bid, nb, smem);
    if (PH == 4) phase_attn(p, bid, nb, smem);
    if (PH == 15) phase_dsa_attn(p, bid, nb, smem);
    if (PH == 5) phase_merge<0>(p, bid, nb, smem);
    if (PH == 13) phase_merge<1>(p, bid, nb, smem);
    if (PH == 6) phase_outproj(p, bid, nb, smem);
    if (PH == 7) phase_route(p, bid, nb);
    if (PH == 8) phase_place(p, bid, nb, smem);
    if (PH == 9) phase_moe1(p, bid, nb, smem);
    if (PH == 10) phase_moe2(p, bid, nb, smem);
    if (PH == 11) phase_combine(p, bid, nb);
    if (PH == 12) phase_ple<0>(p, bid, nb, smem);
    if (PH == 14) phase_ple<1>(p, bid, nb, smem);
}

#if SINGLE_LAUNCH
__global__ void __launch_bounds__(NT, 2) fwd_mega(Params p) {
    __shared__ __attribute__((aligned(16))) unsigned char smem[SMEM_BYTES];
    cg::grid_group grid = cg::this_grid();
    const int bid = blockIdx.x, nb = gridDim.x;
    volatile LAS unsigned* bst = (volatile LAS unsigned*)(LAS unsigned char*)(smem + SMEM_BYTES - 16);
    if (threadIdx.x < 2) bst[threadIdx.x] = 0u;
    __syncthreads();
    const XcdBarrier bar = xcd_barrier_post((unsigned*)(p.ws + WS_BAR), bst);
#define GSYNC() xcd_barrier(bar)
    run_phase<0>(p, bid, nb, smem); grid.sync();
    run_phase<1>(p, bid, nb, smem); GSYNC();
    run_phase<2>(p, bid, nb, smem); GSYNC();
    run_phase<3>(p, bid, nb, smem); GSYNC();
    run_phase<4>(p, bid, nb, smem); GSYNC();
    run_phase<15>(p, bid, nb, smem); GSYNC();
    run_phase<5>(p, bid, nb, smem); GSYNC();
    run_phase<13>(p, bid, nb, smem); GSYNC();
    run_phase<6>(p, bid, nb, smem); GSYNC();
    run_phase<7>(p, bid, nb, smem); GSYNC();
    run_phase<8>(p, bid, nb, smem); GSYNC();
    run_phase<9>(p, bid, nb, smem); GSYNC();
    run_phase<10>(p, bid, nb, smem); GSYNC();
    run_phase<11>(p, bid, nb, smem); GSYNC();
    run_phase<12>(p, bid, nb, smem); GSYNC();
    run_phase<14>(p, bid, nb, smem);
#undef GSYNC
}
#else
template <int PH>
__global__ void __launch_bounds__(NT, 2) k_phase(Params p) {
    __shared__ __attribute__((aligned(16))) unsigned char smem[SMEM_BYTES];
    run_phase<PH>(p, blockIdx.x, gridDim.x, smem);
}
#endif

extern "C" void kernel_launch(void* const* d_in, const int* in_sizes, int n_in, void* d_out, int out_size, void* d_ws, size_t ws_size,
                              hipStream_t stream) {
    if (n_in != 28 || ws_size < WS_END) { fprintf(stderr, "kernel_launch: unexpected n_in %d or ws_size %zu (< %zu)\n", n_in, ws_size, (size_t)WS_END); return; }
    Params p{};
    for (int i = 0; i < 28; ++i) p.in[i] = (const float*)d_in[i];
    p.out = (float*)d_out;
    p.ws = (unsigned char*)d_ws;
#if SINGLE_LAUNCH
    static int grid_blocks = 0;
    if (!grid_blocks) {
        int dev = 0, cus = 0, per_cu = 0;
        hipGetDevice(&dev);
        hipDeviceGetAttribute(&cus, hipDeviceAttributeMultiprocessorCount, dev);
        hipOccupancyMaxActiveBlocksPerMultiprocessor(&per_cu, fwd_mega, NT, 0);
        if (per_cu > 2) per_cu = 2;
        if (per_cu < 1) per_cu = 1;
        grid_blocks = cus * per_cu;
    }
    (void)hipMemsetAsync((unsigned char*)d_ws + WS_BAR, 0, XCD_BAR_WORDS * 4, stream);
    void* args[] = {&p};
    hipError_t e = hipLaunchCooperativeKernel((void*)fwd_mega, dim3(grid_blocks), dim3(NT), args, 0, stream);
    if (e != hipSuccess) fprintf(stderr, "cooperative launch failed: %s (grid %d)\n", hipGetErrorString(e), grid_blocks);
#else
    const int G = 512;
    k_phase<0><<<G, NT, 0, stream>>>(p);
    k_phase<1><<<G, NT, 0, stream>>>(p);
    k_phase<2><<<G, NT, 0, stream>>>(p);
    k_phase<3><<<G, NT, 0, stream>>>(p);
    k_phase<4><<<G, NT, 0, stream>>>(p);
    k_phase<15><<<G, NT, 0, stream>>>(p);
    k_phase<5><<<G, NT, 0, stream>>>(p);
    k_phase<13><<<G, NT, 0, stream>>>(p);
    k_phase<6><<<G, NT, 0, stream>>>(p);
    k_phase<7><<<G, NT, 0, stream>>>(p);
    k_phase<8><<<G, NT, 0, stream>>>(p);
    k_phase<9><<<G, NT, 0, stream>>>(p);
    k_phase<10><<<G, NT, 0, stream>>>(p);
    k_phase<11><<<G, NT, 0, stream>>>(p);
    k_phase<12><<<G, NT, 0, stream>>>(p);
    k_phase<14><<<G, NT, 0, stream>>>(p);
#endif
}
```

```cpp
#include <hip/hip_runtime.h>
#include <hip/hip_cooperative_groups.h>
#include <cstdio>
#include <cstdint>
namespace cg = cooperative_groups;

#ifndef SINGLE_LAUNCH
#define SINGLE_LAUNCH 1
#endif

constexpr int S = 16384;
constexpr int D = 1024;
constexpr int DIN = 5184;
constexpr int NCMP = 1023;
constexpr int NSLC = 256;
constexpr int NEXP = 32;
constexpr int DFF = 1024;
constexpr float EPS = 1e-6f;
constexpr float LOG2E = 1.4426950408889634f;
constexpr int Z_NQ = 0, Z_NKV = 512, Z_NGATE = 1280, Z_DQ = 1304, Z_DK = 1816, Z_DV = 2328, Z_IQ = 2840, Z_IK = 3096,
              Z_IW = 3128, Z_GA = 3136, Z_GB = 4160;

constexpr int NT = 256;
constexpr int SMEM_BYTES = 73728;

typedef unsigned short bf16_t;
typedef short bf16x8 __attribute__((ext_vector_type(8)));
typedef float f32x4 __attribute__((ext_vector_type(4)));
typedef short s16x4 __attribute__((ext_vector_type(4)));
typedef __attribute__((address_space(3))) s16x4* lds_s16x4_ptr;
__device__ __forceinline__ s16x4 lds_tr16(const void* p) {
    return __builtin_amdgcn_ds_read_tr16_b64_v4i16((lds_s16x4_ptr)(uintptr_t)p);
}

constexpr size_t MBy = 1ull << 20;
constexpr size_t WS_CTL = 0;
constexpr size_t WS_BAR = 65536;
constexpr size_t WS_HB = 1 * MBy;
constexpr size_t WS_OA = WS_HB + (size_t)S * D * 2;
constexpr size_t WS_OB = WS_OA + (size_t)S * 512 * 2;
constexpr size_t WS_MERGED = WS_OB + (size_t)S * 512 * 2;
constexpr size_t WS_X1 = WS_MERGED + (size_t)S * D * 2;
constexpr size_t WS_TOPI = WS_X1 + (size_t)S * D * 4;
constexpr size_t WS_TOPW = WS_TOPI + (size_t)S * 4 * 4;
constexpr size_t WS_PPOS = WS_TOPW + (size_t)S * 4 * 4;
constexpr size_t WS_ROWTOK = WS_PPOS + (size_t)S * 4 * 4;
constexpr size_t WS_PB = WS_ROWTOK + (size_t)65536 * 4;
constexpr size_t WS_SEL = WS_PB + (size_t)S * 256 * 2;
constexpr size_t WS_NSEL = WS_SEL + (size_t)S * 256 * 2;
constexpr size_t WS_REG = WS_NSEL + (size_t)S * 4;
constexpr size_t WS_SGA = WS_REG;
constexpr size_t WS_SGB = WS_SGA + (size_t)S * D * 2;
constexpr size_t WS_GT = WS_SGB + (size_t)S * D * 2;
constexpr size_t WS_IWS = WS_GT + (size_t)S * 32 * 4;
constexpr size_t WS_QNB = WS_IWS + (size_t)S * 8 * 4;
constexpr size_t WS_KSLB = WS_QNB + (size_t)S * 512 * 2;
constexpr size_t WS_VSLB = WS_KSLB + (size_t)S * 128 * 2;
constexpr size_t WS_KWNB = WS_VSLB + (size_t)S * 128 * 2;
constexpr size_t WS_VWNB = WS_KWNB + (size_t)S * 128 * 2;
constexpr size_t WS_KCB = WS_VWNB + (size_t)S * 128 * 2;
constexpr size_t WS_VCB = WS_KCB + (size_t)2 * 1024 * 64 * 2;
constexpr size_t WS_KCR = WS_VCB + (size_t)2 * 1024 * 64 * 2;
constexpr size_t WS_VCR = WS_KCR + (size_t)S * 128 * 2;
constexpr size_t WS_DQB = WS_VCR + (size_t)S * 128 * 2;
constexpr size_t WS_DKB = WS_DQB + (size_t)S * 512 * 2;
constexpr size_t WS_DVB = WS_DKB + (size_t)S * 512 * 2;
constexpr size_t WS_IQB = WS_DVB + (size_t)S * 512 * 2;
constexpr size_t WS_IKB = WS_IQB + (size_t)S * 256 * 2;
constexpr size_t WS_ENDA = WS_IKB + (size_t)S * 32 * 2;
constexpr size_t WS_ACT = WS_REG;
constexpr size_t WS_YROWS = WS_ACT + (size_t)(65536 + 128) * DFF * 2;
constexpr size_t WS_ENDB = WS_YROWS + (size_t)(65536 + 128) * D * 4;
constexpr size_t WS_END0 = WS_ENDA > WS_ENDB ? WS_ENDA : WS_ENDB;
constexpr size_t WB_IN = WS_END0;
constexpr size_t WB_A = WB_IN + (size_t)D * DIN * 2;
constexpr size_t WB_B = WB_A + (size_t)512 * D * 2;
constexpr size_t WB_OUT = WB_B + (size_t)512 * D * 2;
constexpr size_t WB_E1 = WB_OUT + (size_t)D * D * 2;
constexpr size_t WB_E2 = WB_E1 + (size_t)NEXP * D * 2 * DFF * 2;
constexpr size_t WB_PLE = WB_E2 + (size_t)NEXP * DFF * D * 2;
constexpr size_t WB_PLEG = WB_PLE + (size_t)256 * D * 2;
constexpr size_t WB_CK1 = WB_PLEG + (size_t)D * D * 2;
constexpr size_t WB_CV1 = WB_CK1 + (size_t)2048 * 64 * 2;
constexpr size_t WS_END = WB_CV1 + (size_t)2048 * 64 * 2 + 4096;

struct Params {
    const float* in[28];
    float* out;
    unsigned char* ws;
};

__device__ __forceinline__ unsigned f2bf(float f) {
    unsigned u = __builtin_bit_cast(unsigned, f);
    return (u + 0x7fffu + ((u >> 16) & 1u)) >> 16;
}
__device__ __forceinline__ unsigned pk2(float lo, float hi) { return f2bf(lo) | (f2bf(hi) << 16); }
__device__ __forceinline__ float bf2f(unsigned short b) { return __builtin_bit_cast(float, (unsigned)b << 16); }
__device__ __forceinline__ float wave_sum(float v) {
#pragma unroll
    for (int o = 1; o < 64; o <<= 1) v += __shfl_xor(v, o);
    return v;
}
__device__ __forceinline__ float wave_max(float v) {
#pragma unroll
    for (int o = 1; o < 64; o <<= 1) v = fmaxf(v, __shfl_xor(v, o));
    return v;
}
__device__ __forceinline__ float sigmoidf_(float x) { return 1.f / (1.f + __expf(-x)); }
__device__ __forceinline__ int bucket_of(int n) {
    if (n < 16) return n;
    int b = 16;
    b += (n >= 19) + (n >= 21) + (n >= 24) + (n >= 27) + (n >= 31) + (n >= 35) + (n >= 40) + (n >= 46) + (n >= 52) + (n >= 59) +
         (n >= 67) + (n >= 77) + (n >= 87) + (n >= 99) + (n >= 113);
    return b;
}

constexpr int LDS_STRIDE = 40;
constexpr int BTR_STRIDE = 136;
template <bool A_F32, bool GATHER, bool SPLIT = false, bool BTR = true>
__device__ __forceinline__ void gemm_tile(const void* __restrict__ Aptr, int lda, const int* __restrict__ rowidx, int m0, int mrows,
                                          const float* __restrict__ B, int ldb, int n0, int split_off, int ncols, int K,
                                          unsigned char* smem, f32x4 (&acc)[2][8]) {
    bf16_t* As = (bf16_t*)smem;
    bf16_t* Bs = As + 128 * LDS_STRIDE;
    bf16_t* AsL = Bs + 128 * LDS_STRIDE;
    bf16_t* BsL = AsL + 128 * LDS_STRIDE;
    const int tid = threadIdx.x, lane = tid & 63, wave = tid >> 6;
#pragma unroll
    for (int i = 0; i < 2; ++i)
#pragma unroll
        for (int j = 0; j < 8; ++j) acc[i][j] = (f32x4){0.f, 0.f, 0.f, 0.f};
    auto lo = [](float v) { return v - bf2f((unsigned short)f2bf(v)); };

    const int ar = tid >> 2, ach = tid & 3;
    const unsigned char* arow[2];
    bool aval[2];
#pragma unroll
    for (int i = 0; i < 2; ++i) {
        int r = ar + 64 * i;
        aval[i] = r < mrows;
        long src = 0;
        if (aval[i]) src = GATHER ? (long)rowidx[m0 + r] : (long)(m0 + r);
        arow[i] = (const unsigned char*)Aptr + (size_t)src * lda * (A_F32 ? 4 : 2) + (size_t)ach * 8 * (A_F32 ? 4 : 2);
    }
    const int nq = tid & 31, kq = tid >> 5;
    const int jn = 4 * nq;
    const bool bval = jn < ncols;
    const float* bptr = B + (size_t)(4 * kq) * ldb + n0 + jn + (jn >= 64 ? split_off : 0);

    uint4 areg[2];
    float4 af0a, af0b, af1a, af1b;
    float4 breg[4];
    auto load_g = [&](int k0) {
#pragma unroll
        for (int i = 0; i < 2; ++i) {
            if (A_F32) {
                float4 t0 = make_float4(0, 0, 0, 0), t1 = t0;
                if (aval[i]) {
                    const float4* s = (const float4*)(arow[i] + (size_t)k0 * 4);
                    t0 = s[0]; t1 = s[1];
                }
                if (i == 0) { af0a = t0; af0b = t1; } else { af1a = t0; af1b = t1; }
            } else {
                if (aval[i]) areg[i] = *(const uint4*)(arow[i] + (size_t)k0 * 2);
                else areg[i] = make_uint4(0, 0, 0, 0);
            }
        }
#pragma unroll
        for (int kk = 0; kk < 4; ++kk) {
            if (bval) breg[kk] = *(const float4*)(bptr + (size_t)(k0 + kk) * ldb);
            else breg[kk] = make_float4(0, 0, 0, 0);
        }
    };
    auto store_l = [&]() {
#pragma unroll
        for (int i = 0; i < 2; ++i) {
            uint4 v;
            const float4 t0 = (i == 0) ? af0a : af1a, t1 = (i == 0) ? af0b : af1b;
            if (A_F32) {
                v.x = pk2(t0.x, t0.y); v.y = pk2(t0.z, t0.w);
                v.z = pk2(t1.x, t1.y); v.w = pk2(t1.z, t1.w);
            } else v = areg[i];
            *(uint4*)(As + (ar + 64 * i) * LDS_STRIDE + ach * 8) = v;
            if (SPLIT && A_F32) {
                v.x = pk2(lo(t0.x), lo(t0.y)); v.y = pk2(lo(t0.z), lo(t0.w));
                v.z = pk2(lo(t1.x), lo(t1.y)); v.w = pk2(lo(t1.z), lo(t1.w));
                *(uint4*)(AsL + (ar + 64 * i) * LDS_STRIDE + ach * 8) = v;
            }
        }
        if (SPLIT) {
            uint2 v;
            v.x = pk2(lo(breg[0].x), lo(breg[1].x)); v.y = pk2(lo(breg[2].x), lo(breg[3].x));
            *(uint2*)(BsL + (jn + 0) * LDS_STRIDE + 4 * kq) = v;
            v.x = pk2(lo(breg[0].y), lo(breg[1].y)); v.y = pk2(lo(breg[2].y), lo(breg[3].y));
            *(uint2*)(BsL + (jn + 1) * LDS_STRIDE + 4 * kq) = v;
            v.x = pk2(lo(breg[0].z), lo(breg[1].z)); v.y = pk2(lo(breg[2].z), lo(breg[3].z));
            *(uint2*)(BsL + (jn + 2) * LDS_STRIDE + 4 * kq) = v;
            v.x = pk2(lo(breg[0].w), lo(breg[1].w)); v.y = pk2(lo(breg[2].w), lo(breg[3].w));
            *(uint2*)(BsL + (jn + 3) * LDS_STRIDE + 4 * kq) = v;
        }
        if (BTR && !SPLIT) {
#pragma unroll
            for (int kk = 0; kk < 4; ++kk) {
                uint2 v; v.x = pk2(breg[kk].x, breg[kk].y); v.y = pk2(breg[kk].z, breg[kk].w);
                *(uint2*)(Bs + (4 * kq + kk) * BTR_STRIDE + jn) = v;
            }
        } else {
            uint2 v;
            v.x = pk2(breg[0].x, breg[1].x); v.y = pk2(breg[2].x, breg[3].x);
            *(uint2*)(Bs + (jn + 0) * LDS_STRIDE + 4 * kq) = v;
            v.x = pk2(breg[0].y, breg[1].y); v.y = pk2(breg[2].y, breg[3].y);
            *(uint2*)(Bs + (jn + 1) * LDS_STRIDE + 4 * kq) = v;
            v.x = pk2(breg[0].z, breg[1].z); v.y = pk2(breg[2].z, breg[3].z);
            *(uint2*)(Bs + (jn + 2) * LDS_STRIDE + 4 * kq) = v;
            v.x = pk2(breg[0].w, breg[1].w); v.y = pk2(breg[2].w, breg[3].w);
            *(uint2*)(Bs + (jn + 3) * LDS_STRIDE + 4 * kq) = v;
        }
    };
    const int nk = K / 32;
    __syncthreads();
    load_g(0);
    store_l();
    __syncthreads();
    const int fr = lane & 15, fq = lane >> 4;
    for (int kt = 0; kt < nk; ++kt) {
        if (kt + 1 < nk) load_g((kt + 1) * 32);
        bf16x8 a[2];
#pragma unroll
        for (int i = 0; i < 2; ++i) a[i] = *(const bf16x8*)(As + (wave * 32 + i * 16 + fr) * LDS_STRIDE + fq * 8);
        if (!SPLIT) {
            bf16x8 b[8];
#pragma unroll
            for (int j = 0; j < 8; ++j) {
                if (BTR && !SPLIT) {
                    const bf16_t* bp = Bs + (8 * fq + (fr >> 2)) * BTR_STRIDE + 16 * j + 4 * (fr & 3);
                    const s16x4 lo4 = lds_tr16(bp), hi4 = lds_tr16(bp + 4 * BTR_STRIDE);
                    b[j] = (bf16x8){lo4[0], lo4[1], lo4[2], lo4[3], hi4[0], hi4[1], hi4[2], hi4[3]};
                } else b[j] = *(const bf16x8*)(Bs + (j * 16 + fr) * LDS_STRIDE + fq * 8);
            }
#pragma unroll
            for (int i = 0; i < 2; ++i)
#pragma unroll
                for (int j = 0; j < 8; ++j) acc[i][j] = __builtin_amdgcn_mfma_f32_16x16x32_bf16(a[i], b[j], acc[i][j], 0, 0, 0);
        } else {
            bf16x8 al[2];
#pragma unroll
            for (int i = 0; i < 2; ++i) al[i] = *(const bf16x8*)(AsL + (wave * 32 + i * 16 + fr) * LDS_STRIDE + fq * 8);
#pragma unroll
            for (int j = 0; j < 8; ++j) {
                const bf16x8 bh = *(const bf16x8*)(Bs + (j * 16 + fr) * LDS_STRIDE + fq * 8);
                const bf16x8 bl = *(const bf16x8*)(BsL + (j * 16 + fr) * LDS_STRIDE + fq * 8);
#pragma unroll
                for (int i = 0; i < 2; ++i) {
                    acc[i][j] = __builtin_amdgcn_mfma_f32_16x16x32_bf16(a[i], bh, acc[i][j], 0, 0, 0);
                    acc[i][j] = __builtin_amdgcn_mfma_f32_16x16x32_bf16(a[i], bl, acc[i][j], 0, 0, 0);
                    acc[i][j] = __builtin_amdgcn_mfma_f32_16x16x32_bf16(al[i], bh, acc[i][j], 0, 0, 0);
                }
            }
        }
        __syncthreads();
        if (kt + 1 < nk) {
            store_l();
            __syncthreads();
        }
    }
}


constexpr int ASTR = 72;
constexpr int BSTR = 136;
template <bool GATHER, bool PAIR>
__device__ __forceinline__ void gemm2(const bf16_t* __restrict__ A, int lda, const int* __restrict__ rowidx, int m0, int mrows,
                                      const bf16_t* __restrict__ B, int ldb, int n0, int ncols, int K, unsigned char* smem,
                                      f32x4 (&acc)[4][4]) {
    bf16_t* As = (bf16_t*)smem;
    bf16_t* Bs = As + 128 * ASTR;
    const int tid = threadIdx.x, lane = tid & 63, wave = tid >> 6, wm = wave >> 1, wn = wave & 1;
#pragma unroll
    for (int i = 0; i < 4; ++i)
#pragma unroll
        for (int j = 0; j < 4; ++j) acc[i][j] = (f32x4){0.f, 0.f, 0.f, 0.f};
    const int arl = tid >> 1, ahalf = tid & 1;
    const int arc = arl < mrows ? arl : mrows - 1;
    const long asrc = GATHER ? (long)rowidx[m0 + arc] : (long)(m0 + arc);
    const bf16_t* ap = A + (size_t)asrc * lda + ahalf * 32;
    const int brow = tid >> 2, bq = tid & 3;
    const bf16_t* bp = B + (size_t)brow * ldb + n0 + (PAIR ? bq * 16 : bq * 32);
    const int boff1 = 8, boff2 = PAIR ? 1024 : 16, boff3 = PAIR ? 1032 : 24;
    bf16_t* asd = As + arl * ASTR + ahalf * 32;
    bf16_t* bsd = Bs + brow * BSTR + bq * 32;
    uint4 a0, a1, a2, a3, b0, b1, b2, b3;
#define G2_LOAD(k0)                                                                                       \
    do {                                                                                                  \
        const bf16_t* ap_ = ap + (k0);                                                                    \
        a0 = *(const uint4*)(ap_); a1 = *(const uint4*)(ap_ + 8);                                         \
        a2 = *(const uint4*)(ap_ + 16); a3 = *(const uint4*)(ap_ + 24);                                   \
        const bf16_t* bp_ = bp + (size_t)(k0) * ldb;                                                      \
        b0 = *(const uint4*)(bp_); b1 = *(const uint4*)(bp_ + boff1);                                     \
        b2 = *(const uint4*)(bp_ + boff2); b3 = *(const uint4*)(bp_ + boff3);                             \
    } while (0)
#define G2_STORE()                                                                                        \
    do {                                                                                                  \
        *(uint4*)(asd) = a0; *(uint4*)(asd + 8) = a1; *(uint4*)(asd + 16) = a2; *(uint4*)(asd + 24) = a3; \
        *(uint4*)(bsd) = b0; *(uint4*)(bsd + 8) = b1; *(uint4*)(bsd + 16) = b2; *(uint4*)(bsd + 24) = b3; \
    } while (0)
    const int nk = K / 64;
    __syncthreads();
    G2_LOAD(0);
    G2_STORE();
    __syncthreads();
    const int fr = lane & 15, fq = lane >> 4;
    const bf16_t* afp = As + (wm * 64 + fr) * ASTR + fq * 8;
    const bf16_t* bfp = Bs + (8 * fq + (fr >> 2)) * BSTR + wn * 64 + 4 * (fr & 3);
    for (int kt = 0; kt < nk; ++kt) {
        if (kt + 1 < nk) G2_LOAD((kt + 1) * 64);
#pragma unroll
        for (int kh = 0; kh < 2; ++kh) {
            bf16x8 a[4], b[4];
#pragma unroll
            for (int i = 0; i < 4; ++i) a[i] = *(const bf16x8*)(afp + i * 16 * ASTR + kh * 32);
#pragma unroll
            for (int j = 0; j < 4; ++j) {
                const bf16_t* q = bfp + kh * 32 * BSTR + j * 16;
                const s16x4 lo4 = lds_tr16(q), hi4 = lds_tr16(q + 4 * BSTR);
                b[j] = (bf16x8){lo4[0], lo4[1], lo4[2], lo4[3], hi4[0], hi4[1], hi4[2], hi4[3]};
            }
#pragma unroll
            for (int i = 0; i < 4; ++i)
#pragma unroll
                for (int j = 0; j < 4; ++j) acc[i][j] = __builtin_amdgcn_mfma_f32_16x16x32_bf16(a[i], b[j], acc[i][j], 0, 0, 0);
        }
        __syncthreads();
        if (kt + 1 < nk) {
            G2_STORE();
            __syncthreads();
        }
    }
#undef G2_LOAD
#undef G2_STORE
}
#define G2_ROW(i, r) ((threadIdx.x >> 7) * 64 + (i) * 16 + 4 * ((threadIdx.x & 63) >> 4) + (r))
#define G2_COL(j) (((((threadIdx.x >> 6) & 1) * 4 + (j)) * 16) + (threadIdx.x & 15))

__device__ __forceinline__ void cvt_weights(const float* __restrict__ src, bf16_t* __restrict__ dst, size_t n, int bid, int nb) {
    const size_t n8 = n >> 3;
    for (size_t i = (size_t)bid * NT + threadIdx.x; i < n8; i += (size_t)nb * NT) {
        const float4 u = ((const float4*)src)[2 * i], v = ((const float4*)src)[2 * i + 1];
        uint4 o; o.x = pk2(u.x, u.y); o.y = pk2(u.z, u.w); o.z = pk2(v.x, v.y); o.w = pk2(v.z, v.w);
        ((uint4*)dst)[i] = o;
    }
}
__device__ __forceinline__ void phase_prep(const Params& p, int bid, int nb) {
    const int lane = threadIdx.x & 63, wave = threadIdx.x >> 6;
    if (bid == 0 && threadIdx.x < 64) ((int*)(p.ws + WS_CTL))[threadIdx.x] = 0;
    {
        const float* src_ = p.in[2];
        bf16_t* dst_ = (bf16_t*)(p.ws + WB_IN);
        constexpr int G8 = DIN / 8;
        for (size_t i = (size_t)bid * NT + threadIdx.x; i < (size_t)D * G8; i += (size_t)nb * NT) {
            const int k = (int)(i / G8), nc = (int)(i % G8) * 8;
            int oc;
            if (nc < 1280) oc = nc; else if (nc < 2816) oc = nc + 24; else if (nc < 3072) oc = nc + 24; else if (nc < 5120) oc = nc + 64;
            else if (nc < 5152) oc = nc - 5120 + 3096; else if (nc < 5176) oc = nc - 5152 + 1280; else oc = nc - 5176 + 3128;
            const float4 u = *(const float4*)(src_ + (size_t)k * DIN + oc), v = *(const float4*)(src_ + (size_t)k * DIN + oc + 4);
            uint4 o; o.x = pk2(u.x, u.y); o.y = pk2(u.z, u.w); o.z = pk2(v.x, v.y); o.w = pk2(v.z, v.w);
            *(uint4*)(dst_ + (size_t)k * DIN + nc) = o;
        }
    }
    cvt_weights(p.in[14], (bf16_t*)(p.ws + WB_A), (size_t)512 * D, bid, nb);
    cvt_weights(p.in[15], (bf16_t*)(p.ws + WB_B), (size_t)512 * D, bid, nb);
    cvt_weights(p.in[16], (bf16_t*)(p.ws + WB_OUT), (size_t)D * D, bid, nb);
    cvt_weights(p.in[21], (bf16_t*)(p.ws + WB_E1), (size_t)NEXP * D * 2 * DFF, bid, nb);
    cvt_weights(p.in[23], (bf16_t*)(p.ws + WB_E2), (size_t)NEXP * DFF * D, bid, nb);
    cvt_weights(p.in[26], (bf16_t*)(p.ws + WB_PLE), (size_t)256 * D, bid, nb);
    cvt_weights(p.in[27], (bf16_t*)(p.ws + WB_PLEG), (size_t)D * D, bid, nb);
    cvt_weights(p.in[9], (bf16_t*)(p.ws + WB_CK1), (size_t)2048 * 64, bid, nb);
    cvt_weights(p.in[12], (bf16_t*)(p.ws + WB_CV1), (size_t)2048 * 64, bid, nb);
    const float* x = p.in[0];
    const float* g = p.in[3];
    bf16_t* hb = (bf16_t*)(p.ws + WS_HB);
    for (int t = bid * 4 + wave; t < S; t += nb * 4) {
        const float4* xr = (const float4*)(x + (size_t)t * D);
        float4 v[4];
        float ss = 0.f;
#pragma unroll
        for (int j = 0; j < 4; ++j) { v[j] = xr[lane + 64 * j]; ss += v[j].x * v[j].x + v[j].y * v[j].y + v[j].z * v[j].z + v[j].w * v[j].w; }
        ss = wave_sum(ss);
        const float rstd = rsqrtf(ss * (1.f / D) + EPS);
#pragma unroll
        for (int j = 0; j < 4; ++j) {
            const float4 gg = ((const float4*)g)[lane + 64 * j];
            uint2 o;
            o.x = pk2(v[j].x * rstd * gg.x, v[j].y * rstd * gg.y);
            o.y = pk2(v[j].z * rstd * gg.z, v[j].w * rstd * gg.w);
            ((uint2*)(hb + (size_t)t * D))[lane + 64 * j] = o;
        }
    }
}

__device__ __forceinline__ void phase_inproj(const Params& p, int bid, int nb, unsigned char* smem) {
    const bf16_t* hb = (const bf16_t*)(p.ws + WS_HB);
    const int lane = threadIdx.x & 63, fr = lane & 15;
    constexpr int NTN = (DIN + 127) / 128;
    for (int w = bid; w < 128 * NTN; w += nb) {
        const int mt = w % 128, nt = w / 128;
        const int m0 = mt * 128, n0 = nt * 128;
        const int ncols = (DIN - n0) < 128 ? (DIN - n0) : 128;
        f32x4 acc[4][4];
        gemm2<false, false>(hb, D, nullptr, m0, 128, (const bf16_t*)(p.ws + WB_IN), DIN, n0, ncols, D, smem, acc);
        const int cid = __builtin_amdgcn_readfirstlane((n0 >> 6) + ((threadIdx.x >> 6) & 1));
        if (cid > 80) continue;
        int kind; bf16_t* dst; int ld; const float* gain = nullptr; float scale = 1.f;
        if (cid < 8) { kind = 0; dst = (bf16_t*)(p.ws + WS_QNB) + cid * 64; ld = 512; gain = p.in[4]; scale = 0.125f * LOG2E; }
        else if (cid < 20) {
            const int j = cid - 8, kd = j >> 1, g = j & 1;
            ld = 64; kind = (kd == 2 || kd == 4) ? 0 : 1; gain = p.in[5];
            const size_t base = kd == 0 ? WS_KCR : kd == 1 ? WS_VCR : kd == 2 ? WS_KSLB : kd == 3 ? WS_VSLB : kd == 4 ? WS_KWNB : WS_VWNB;
            dst = (bf16_t*)(p.ws + base) + (size_t)g * S * 64;
        }
        else if (cid < 28) { kind = 0; dst = (bf16_t*)(p.ws + WS_DQB) + (cid - 20) * 64; ld = 512; gain = p.in[6]; scale = 0.125f * LOG2E; }
        else if (cid < 36) { kind = 0; dst = (bf16_t*)(p.ws + WS_DKB) + (cid - 28) * 64; ld = 512; gain = p.in[7]; }
        else if (cid < 44) { kind = 1; dst = (bf16_t*)(p.ws + WS_DVB) + (cid - 36) * 64; ld = 512; }
        else if (cid < 48) { kind = 1; dst = (bf16_t*)(p.ws + WS_IQB) + (cid - 44) * 64; ld = 256; scale = 0.17677669529663687f; }
        else if (cid < 64) { kind = 2; dst = (bf16_t*)(p.ws + WS_SGA) + (cid - 48) * 64; ld = D; }
        else if (cid < 80) { kind = 2; dst = (bf16_t*)(p.ws + WS_SGB) + (cid - 64) * 64; ld = D; }
        else { kind = 3; dst = nullptr; ld = 0; }
        if (kind == 0) {
            float gv[4];
#pragma unroll
            for (int j = 0; j < 4; ++j) gv[j] = gain[j * 16 + fr] * scale;
#pragma unroll
            for (int i = 0; i < 4; ++i)
#pragma unroll
                for (int r = 0; r < 4; ++r) {
                    float ss = acc[i][0][r] * acc[i][0][r] + acc[i][1][r] * acc[i][1][r] + acc[i][2][r] * acc[i][2][r] + acc[i][3][r] * acc[i][3][r];
                    ss += __shfl_xor(ss, 1); ss += __shfl_xor(ss, 2); ss += __shfl_xor(ss, 4); ss += __shfl_xor(ss, 8);
                    const float rstd = rsqrtf(ss * (1.f / 64.f) + EPS);
                    bf16_t* dr = dst + (size_t)(m0 + G2_ROW(i, r)) * ld + fr;
#pragma unroll
                    for (int j = 0; j < 4; ++j) dr[j * 16] = (bf16_t)f2bf(acc[i][j][r] * rstd * gv[j]);
                }
        } else if (kind == 1 || kind == 2) {
#pragma unroll
            for (int i = 0; i < 4; ++i)
#pragma unroll
                for (int r = 0; r < 4; ++r) {
                    bf16_t* dr = dst + (size_t)(m0 + G2_ROW(i, r)) * ld + fr;
#pragma unroll
                    for (int j = 0; j < 4; ++j) {
                        const float v = acc[i][j][r];
                        dr[j * 16] = (bf16_t)f2bf(kind == 2 ? sigmoidf_(v) : v * scale);
                    }
                }
        } else {
            bf16_t* ikb = (bf16_t*)(p.ws + WS_IKB);
            float* gt = (float*)(p.ws + WS_GT);
            float* iws = (float*)(p.ws + WS_IWS);
#pragma unroll
            for (int i = 0; i < 4; ++i)
#pragma unroll
                for (int r = 0; r < 4; ++r) {
                    const size_t t = (size_t)(m0 + G2_ROW(i, r));
                    ikb[t * 32 + fr] = (bf16_t)f2bf(acc[i][0][r]);
                    ikb[t * 32 + 16 + fr] = (bf16_t)f2bf(acc[i][1][r]);
                    gt[t * 32 + fr] = sigmoidf_(acc[i][2][r]);
                    if (fr < 8) gt[t * 32 + 16 + fr] = sigmoidf_(acc[i][3][r]);
                    else iws[t * 8 + fr - 8] = acc[i][3][r] * 0.35355339059327373f;
                }
        }
    }
}

__device__ __forceinline__ float rms64(float v) { return rsqrtf(wave_sum(v * v) * (1.f / 64.f) + EPS); }

__device__ __forceinline__ void phase_compress(const Params& p, int bid, int nb, unsigned char* smem) {
    const int tid = threadIdx.x, lane = tid & 63, wave = tid >> 6;
    float* cvec = (float*)(smem + 36864);
    float* hid = (float*)(smem + 36864 + 256);
    for (int w = bid; w < 32; w += nb) {
        const int kind = w >> 4, g = (w >> 3) & 1, mt = w & 7;
        const bf16_t* raw = (const bf16_t*)(p.ws + (kind ? WS_VCR : WS_KCR)) + (size_t)g * S * 64;
        const bf16_t* w1b = (const bf16_t*)(p.ws + (kind ? WB_CV1 : WB_CK1));
        const float* pe = p.in[kind ? 11 : 8];
        const float* w1 = p.in[kind ? 12 : 9];
        const float* w2 = p.in[kind ? 13 : 10];
        const int m0 = mt * 128;
        const int mrows = (NCMP - m0) < 128 ? (NCMP - m0) : 128;
        f32x4 acc[4][4];
        gemm2<false, false>(raw, 16 * 64, nullptr, m0, mrows, w1b, 64, 0, 64, 2048, smem, acc);
        {
            const int e = tid & 63, part = tid >> 6;
            float s = 0.f;
            for (int k = part * 512; k < part * 512 + 512; ++k) s += pe[k] * w1[(size_t)k * 64 + e];
            hid[tid] = s;
            __syncthreads();
            if (tid < 64) cvec[tid] = hid[tid] + hid[64 + tid] + hid[128 + tid] + hid[192 + tid];
            __syncthreads();
        }
        if ((wave & 1) == 0) {
#pragma unroll
            for (int i = 0; i < 4; ++i)
#pragma unroll
                for (int j = 0; j < 4; ++j)
#pragma unroll
                    for (int r = 0; r < 4; ++r) {
                        const int row = G2_ROW(i, r), col = j * 16 + (lane & 15);
                        const float a = acc[i][j][r] + cvec[col];
                        hid[row * 65 + col] = a * sigmoidf_(a);
                    }
        }
        __syncthreads();
        const float gkn = p.in[5][lane];
        for (int row = wave; row < mrows; row += 4) {
            float o = 0.f;
#pragma unroll 8
            for (int e = 0; e < 64; ++e) o += hid[row * 65 + e] * w2[e * 64 + lane];
            if (kind == 0) o = o * rms64(o) * gkn;
            ((bf16_t*)(p.ws + (kind ? WS_VCB : WS_KCB)))[((size_t)g * 1024 + m0 + row) * 64 + lane] = (bf16_t)f2bf(o);
        }
        __syncthreads();
    }
    if (bid == nb - 1) {
        if (tid < 128) ((bf16_t*)(p.ws + WS_KCB))[((size_t)(tid >> 6) * 1024 + 1023) * 64 + (tid & 63)] = 0;
        else ((bf16_t*)(p.ws + WS_VCB))[((size_t)((tid - 128) >> 6) * 1024 + 1023) * 64 + (tid & 63)] = 0;
    }
}

constexpr int KSTR = 72;
constexpr int NSA_KT = 0;
constexpr int NSA_VT = NSA_KT + 32 * KSTR * 2;
constexpr int NSA_WV = NSA_VT + 32 * KSTR * 2;
constexpr int NSA_IMP = NSA_WV + 4 * 2 * 32 * KSTR * 2;
constexpr int NSA_LUT = NSA_IMP + 16 * 260 * 4;
constexpr int NSA_SEL = NSA_LUT + 4 * 128 * 4;
constexpr int NSA_STP = NSA_SEL + 16 * 16 * 4;
constexpr int NSA_END = NSA_STP + 4 * 128 * 4;
static_assert(NSA_END <= SMEM_BYTES, "nsa lds");

__device__ __forceinline__ f32x4 mfma16(bf16x8 a, bf16x8 b, f32x4 c) { return __builtin_amdgcn_mfma_f32_16x16x32_bf16(a, b, c, 0, 0, 0); }
__device__ __forceinline__ bf16x8 pack_p(const f32x4& p1, const f32x4& p2) {
    const unsigned a = pk2(p1[0], p1[1]), b = pk2(p1[2], p1[3]), c = pk2(p2[0], p2[1]), d = pk2(p2[2], p2[3]);
    return __builtin_bit_cast(bf16x8, make_uint4(a, b, c, d));
}
__device__ __forceinline__ void pv_step(f32x4 (&o)[4], const bf16_t* vt, bf16x8 pb, int fq, int fr) {
    const bf16_t* base = vt + (4 * fq + (fr >> 2)) * KSTR + 4 * (fr & 3);
#pragma unroll
    for (int dt = 0; dt < 4; ++dt) {
        const s16x4 lo4 = lds_tr16(base + dt * 16), hi4 = lds_tr16(base + 16 * KSTR + dt * 16);
        const bf16x8 va = (bf16x8){lo4[0], lo4[1], lo4[2], lo4[3], hi4[0], hi4[1], hi4[2], hi4[3]};
        o[dt] = mfma16(va, pb, o[dt]);
    }
}
__device__ __forceinline__ float quad_sum(float v) {
    v += __shfl_xor(v, 1);
    v += __shfl_xor(v, 2);
    return v;
}

__device__ __forceinline__ void nsa_tile(const Params& p, int tt, int g, unsigned char* smem) {
    const int tid = threadIdx.x, lane = tid & 63, wave = tid >> 6, fr = lane & 15, fq = lane >> 4;
    bf16_t* kt = (bf16_t*)(smem + NSA_KT);
    bf16_t* vt = (bf16_t*)(smem + NSA_VT);
    bf16_t* wv = (bf16_t*)(smem + NSA_WV) + wave * 2 * 32 * KSTR;
    float* imp = (float*)(smem + NSA_IMP);
    float* lut = (float*)(smem + NSA_LUT);
    int* sel = (int*)(smem + NSA_SEL);
    const bf16_t* qnb = (const bf16_t*)(p.ws + WS_QNB);
    const bf16_t* kslb = (const bf16_t*)(p.ws + WS_KSLB) + (size_t)g * S * 64;
    const bf16_t* vslb = (const bf16_t*)(p.ws + WS_VSLB) + (size_t)g * S * 64;
    const bf16_t* kwnb = (const bf16_t*)(p.ws + WS_KWNB) + (size_t)g * S * 64;
    const bf16_t* vwnb = (const bf16_t*)(p.ws + WS_VWNB) + (size_t)g * S * 64;
    const bf16_t* kcb = (const bf16_t*)(p.ws + WS_KCB) + (size_t)g * 1024 * 64;
    const bf16_t* vcb = (const bf16_t*)(p.ws + WS_VCB) + (size_t)g * 1024 * 64;
    const float* gt = (const float*)(p.ws + WS_GT);
    const float* relb = p.in[17];
    const int t0 = tt * 16;
    const int tl = 4 * wave + (fr >> 2);
    const int tok = t0 + tl;
    const int hl = fr & 3, head = g * 4 + hl;
    __syncthreads();
    for (int i = tid; i < 512; i += NT) { const int hh = i >> 7, n = i & 127; lut[i] = relb[bucket_of(n) * 16 + g * 4 + hh] * LOG2E; }
    for (int i = tid; i < 16 * 260; i += NT) imp[i] = 0.f;
    float U2;
    {
        const float mq = wave_max(fabsf(p.in[4][lane])), mk = wave_max(fabsf(p.in[5][lane]));
        float mb = 0.f;
#pragma unroll
        for (int k = 0; k < 4; ++k) { const int e = lane + 64 * k; mb = fmaxf(mb, fabsf(relb[(e >> 3) * 16 + (e & 7)])); }
        mb = wave_max(mb);
        U2 = (8.f * mq * mk + mb) * LOG2E;
    }
    bf16x8 qf[2];
#pragma unroll
    for (int kh = 0; kh < 2; ++kh) qf[kh] = *(const bf16x8*)(qnb + (size_t)tok * 512 + head * 64 + kh * 32 + fq * 8);
    __syncthreads();
    const float* lutp = lut + hl * 128;
    const float lutfar = lutp[127];
    const f32x4 zero4 = (f32x4){0.f, 0.f, 0.f, 0.f};
    f32x4 outacc[4];
#pragma unroll
    for (int dt = 0; dt < 4; ++dt) outacc[dt] = zero4;
    const float g0 = gt[(size_t)tok * 32 + head * 3 + 0], g1 = gt[(size_t)tok * 32 + head * 3 + 1], g2 = gt[(size_t)tok * 32 + head * 3 + 2];
    const int srow = tid >> 3, sch = tid & 7;

    {
        int ks0 = (t0 - 511) & ~31; ks0 = ks0 < 0 ? 0 : ks0;
        const int nsteps = (t0 + 16 - ks0 + 31) >> 5;
        f32x4 o[4];
#pragma unroll
        for (int dt = 0; dt < 4; ++dt) o[dt] = zero4;
        float lsum = 0.f;
        uint4 kreg = *(const uint4*)(kwnb + (size_t)(ks0 + srow) * 64 + sch * 8);
        uint4 vreg = *(const uint4*)(vwnb + (size_t)(ks0 + srow) * 64 + sch * 8);
#pragma unroll 1
        for (int st = 0; st < nsteps; ++st) {
            const int ks = ks0 + st * 32;
            *(uint4*)(kt + srow * KSTR + sch * 8) = kreg;
            *(uint4*)(vt + srow * KSTR + sch * 8) = vreg;
            __syncthreads();
            if (st + 1 < nsteps) {
                kreg = *(const uint4*)(kwnb + (size_t)(ks + 32 + srow) * 64 + sch * 8);
                vreg = *(const uint4*)(vwnb + (size_t)(ks + 32 + srow) * 64 + sch * 8);
            }
            f32x4 s1 = zero4, s2 = zero4;
#pragma unroll
            for (int kh = 0; kh < 2; ++kh) {
                const bf16x8 k1 = *(const bf16x8*)(kt + fr * KSTR + kh * 32 + fq * 8);
                const bf16x8 k2 = *(const bf16x8*)(kt + (16 + fr) * KSTR + kh * 32 + fq * 8);
                s1 = mfma16(k1, qf[kh], s1);
                s2 = mfma16(k2, qf[kh], s2);
            }
            const bool far = (t0 + 4 * wave) - (ks + 31) >= 113;
            f32x4 p1, p2;
#pragma unroll
            for (int r = 0; r < 4; ++r) {
                const int d1 = tok - (ks + 4 * fq + r), d2 = d1 - 16;
                const float b1 = far ? lutfar : lutp[d1 < 0 ? 0 : (d1 > 127 ? 127 : d1)];
                const float b2 = far ? lutfar : lutp[d2 < 0 ? 0 : (d2 > 127 ? 127 : d2)];
                p1[r] = (d1 >= 0 && d1 < 512) ? __builtin_amdgcn_exp2f(s1[r] + b1 - U2) : 0.f;
                p2[r] = (d2 >= 0 && d2 < 512) ? __builtin_amdgcn_exp2f(s2[r] + b2 - U2) : 0.f;
                lsum += p1[r] + p2[r];
            }
            pv_step(o, vt, pack_p(p1, p2), fq, fr);
            __syncthreads();
        }
        lsum += __shfl_xor(lsum, 16);
        lsum += __shfl_xor(lsum, 32);
        const float sc = lsum > 0.f ? g2 / lsum : 0.f;
#pragma unroll
        for (int dt = 0; dt < 4; ++dt)
#pragma unroll
            for (int r = 0; r < 4; ++r) outacc[dt][r] += sc * o[dt][r];
    }

    {
        const int tlast = t0 + 15;
        const int cmax = (tlast >= 31) ? ((tlast - 31) >> 4) + 1 : 0;
        const int nsteps = (cmax + 31) >> 5;
        float inv_l = 0.f;
#pragma unroll 1
        for (int pass = 0; pass < 2; ++pass) {
            f32x4 o[4];
#pragma unroll
            for (int dt = 0; dt < 4; ++dt) o[dt] = zero4;
            float lsum = 0.f;
            uint4 kreg = make_uint4(0, 0, 0, 0), vreg = kreg;
            if (nsteps > 0) {
                kreg = *(const uint4*)(kcb + (size_t)srow * 64 + sch * 8);
                vreg = *(const uint4*)(vcb + (size_t)srow * 64 + sch * 8);
            }
#pragma unroll 1
            for (int st = 0; st < nsteps; ++st) {
                const int cs = st * 32;
                *(uint4*)(kt + srow * KSTR + sch * 8) = kreg;
                *(uint4*)(vt + srow * KSTR + sch * 8) = vreg;
                __syncthreads();
                if (st + 1 < nsteps) {
                    kreg = *(const uint4*)(kcb + (size_t)(cs + 32 + srow) * 64 + sch * 8);
                    vreg = *(const uint4*)(vcb + (size_t)(cs + 32 + srow) * 64 + sch * 8);
                }
                f32x4 s1 = zero4, s2 = zero4;
#pragma unroll
                for (int kh = 0; kh < 2; ++kh) {
                    const bf16x8 k1 = *(const bf16x8*)(kt + fr * KSTR + kh * 32 + fq * 8);
                    const bf16x8 k2 = *(const bf16x8*)(kt + (16 + fr) * KSTR + kh * 32 + fq * 8);
                    s1 = mfma16(k1, qf[kh], s1);
                    s2 = mfma16(k2, qf[kh], s2);
                }
                const bool far = (t0 + 4 * wave) - (16 * (cs + 31) + 31) >= 113;
                f32x4 p1, p2;
#pragma unroll
                for (int r = 0; r < 4; ++r) {
                    const int d1 = tok - (16 * (cs + 4 * fq + r) + 31), d2 = d1 - 256;
                    const float b1 = far ? lutfar : lutp[d1 < 0 ? 0 : (d1 > 127 ? 127 : d1)];
                    const float b2 = far ? lutfar : lutp[d2 < 0 ? 0 : (d2 > 127 ? 127 : d2)];
                    p1[r] = (d1 >= 0) ? __builtin_amdgcn_exp2f(s1[r] + b1 - U2) : 0.f;
                    p2[r] = (d2 >= 0) ? __builtin_amdgcn_exp2f(s2[r] + b2 - U2) : 0.f;
                    lsum += p1[r] + p2[r];
                }
                if (pass == 1) {
#pragma unroll
                    for (int r = 0; r < 4; ++r) { p1[r] *= inv_l; p2[r] *= inv_l; }
                    f32x4 h1, h2;
#pragma unroll
                    for (int r = 0; r < 4; ++r) { h1[r] = quad_sum(p1[r]); h2[r] = quad_sum(p2[r]); }
                    if (hl == 0) {
                        float* ir = imp + tl * 260 + (cs >> 2) + fq;
                        atomicAdd(ir, h1[0] + h1[1] + h1[2] + 0.5f * h1[3]);
                        atomicAdd(ir + 1, 0.5f * h1[3]);
                        atomicAdd(ir + 4, h2[0] + h2[1] + h2[2] + 0.5f * h2[3]);
                        atomicAdd(ir + 5, 0.5f * h2[3]);
                    }
                    pv_step(o, vt, pack_p(p1, p2), fq, fr);
                }
                __syncthreads();
            }
            if (pass == 0) {
                lsum += __shfl_xor(lsum, 16);
                lsum += __shfl_xor(lsum, 32);
                inv_l = lsum > 0.f ? 1.f / lsum : 0.f;
            } else {
#pragma unroll
                for (int dt = 0; dt < 4; ++dt)
#pragma unroll
                    for (int r = 0; r < 4; ++r) outacc[dt][r] += g0 * o[dt][r];
            }
        }
    }
    __syncthreads();

#pragma unroll 1
    for (int tq = 0; tq < 4; ++tq) {
        const int tli = 4 * wave + tq, tk = t0 + tli, cur = tk >> 6;
        int* sl = sel + tli * 16;
        int nf = 0;
        if (lane == 0) {
            sl[0] = 0; int c_ = 1;
            if (cur - 1 >= 1) sl[c_++] = cur - 1;
            if (cur >= 1) sl[c_++] = cur;
            for (int k = c_; k < 16; ++k) sl[k] = -1;
        }
        nf = 1 + (cur - 1 >= 1 ? 1 : 0) + (cur >= 1 ? 1 : 0);
        const int ncand = cur - 2 > 0 ? cur - 2 : 0;
        int need = 16 - nf; need = need < ncand ? need : ncand;
        unsigned long long key[4];
#pragma unroll
        for (int k = 0; k < 4; ++k) {
            const int n = lane + 64 * k;
            const bool c = (n >= 1) && (n <= cur - 2);
            key[k] = c ? (((unsigned long long)__builtin_bit_cast(unsigned, imp[tli * 260 + n]) << 32) | (unsigned long long)(0xFFFFFFFFu - (unsigned)n)) + (1ull << 32) : 0ull;
        }
#pragma unroll 1
        for (int rd = 0; rd < need; ++rd) {
            unsigned long long m = key[0];
            m = key[1] > m ? key[1] : m; m = key[2] > m ? key[2] : m; m = key[3] > m ? key[3] : m;
#pragma unroll
            for (int o_ = 1; o_ < 64; o_ <<= 1) {
                const unsigned lo_ = __shfl_xor((unsigned)m, o_), hi_ = __shfl_xor((unsigned)(m >> 32), o_);
                const unsigned long long other = ((unsigned long long)hi_ << 32) | lo_;
                m = other > m ? other : m;
            }
            const int nstar = (int)(0xFFFFFFFFu - (unsigned)m);
#pragma unroll
            for (int k = 0; k < 4; ++k) if (key[k] == m) key[k] = 0ull;
            if (lane == 0) sl[nf + rd] = nstar;
        }
    }
    __syncthreads();

    {
        int* stp = (int*)(smem + NSA_STP) + wave * 128;
        int nst;
        {
            const int tq = lane >> 4, j = lane & 15;
            const int tk_ = t0 + 4 * wave + tq;
            const int b = sel[(4 * wave + tq) * 16 + j];
            const bool c1 = (b >= 0) && (b * 64 <= tk_), c2 = (b >= 0) && (b * 64 + 32 <= tk_);
            const unsigned long long m1 = __ballot(c1), m2 = __ballot(c2);
            const unsigned long long lt = (1ull << lane) - 1ull;
            const int pos = __builtin_popcountll(m1 & lt) + __builtin_popcountll(m2 & lt);
            if (c1) stp[pos] = (b * 64) | (tq << 20);
            if (c2) stp[pos + 1] = (b * 64 + 32) | (tq << 20);
            nst = __builtin_popcountll(m1) + __builtin_popcountll(m2);
        }
        asm volatile("" ::: "memory");
        uint2 oacc_pk[4];
#pragma unroll
        for (int dt = 0; dt < 4; ++dt) { oacc_pk[dt].x = pk2(outacc[dt][0], outacc[dt][1]); oacc_pk[dt].y = pk2(outacc[dt][2], outacc[dt][3]); }
        f32x4 o[4];
#pragma unroll
        for (int dt = 0; dt < 4; ++dt) o[dt] = zero4;
        float lsum = 0.f;
        const int vrow = lane >> 1, vhalf = lane & 1;
        bf16_t* slot0 = wv;
        bf16_t* slot1 = wv + 32 * KSTR;
        bf16x8 ka1[2], ka2[2], kb1[2], kb2[2];
        uint4 va0, va1, va2, va3, vb0, vb1, vb2, vb3;
#define SLC_STEP(i_) __builtin_amdgcn_readfirstlane(stp[(i_) < nst ? (i_) : nst - 1])
#define SLC_KLOAD(K1_, K2_, w_)                                                                                     \
        { const bf16_t* kp_ = kslb + (size_t)(((w_) & 0xFFFFF) + fr) * 64 + fq * 8;                                    \
          K1_[0] = *(const bf16x8*)(kp_); K1_[1] = *(const bf16x8*)(kp_ + 32);                                       \
          K2_[0] = *(const bf16x8*)(kp_ + 16 * 64); K2_[1] = *(const bf16x8*)(kp_ + 16 * 64 + 32); }
#define SLC_VLOAD(V_, w_)                                                                                           \
        { const uint4* vs_ = (const uint4*)(vslb + (size_t)(((w_) & 0xFFFFF) + vrow) * 64 + vhalf * 32);               \
          V_##0 = vs_[0]; V_##1 = vs_[1]; V_##2 = vs_[2]; V_##3 = vs_[3]; }
#define SLC_VSTORE(V_, slot_)                                                                                       \
        { uint4* vd_ = (uint4*)((slot_) + vrow * KSTR + vhalf * 32); vd_[0] = V_##0; vd_[1] = V_##1; vd_[2] = V_##2; vd_[3] = V_##3; }
#define SLC_STAGE(s_, K1_, K2_, VW_, slotr_, slotw_)                                                                \
        {                                                                                                           \
            const int wcur = SLC_STEP(s_), wk = SLC_STEP((s_) + 2), wvn = SLC_STEP((s_) + 3);                       \
            SLC_VSTORE(VW_, slotw_)                                                      \
            SLC_VLOAD(VW_, wvn)                                                                    \
            f32x4 s1 = zero4, s2 = zero4;                                                                           \
            s1 = mfma16(K1_[0], qf[0], s1); s2 = mfma16(K2_[0], qf[0], s2);                                         \
            s1 = mfma16(K1_[1], qf[1], s1); s2 = mfma16(K2_[1], qf[1], s2);                                         \
            asm volatile("" : "+v"(s1), "+v"(s2));                                                                  \
            SLC_KLOAD(K1_, K2_, wk)                                                                \
            const int ks = wcur & 0xFFFFF, tq = wcur >> 20, tk = t0 + 4 * wave + tq;                                \
            const bool mine = (fr >> 2) == tq;                                                                      \
            const bool far = tk - (ks + 31) >= 113;                                                                 \
            f32x4 p1, p2;                                                                                           \
            _Pragma("unroll") for (int r = 0; r < 4; ++r) {                                                         \
                const int d1 = tk - (ks + 4 * fq + r), d2 = d1 - 16;                                                \
                const float b1 = far ? lutfar : lutp[d1 < 0 ? 0 : (d1 > 127 ? 127 : d1)];                           \
                const float b2 = far ? lutfar : lutp[d2 < 0 ? 0 : (d2 > 127 ? 127 : d2)];                           \
                p1[r] = (mine && d1 >= 0) ? __builtin_amdgcn_exp2f(s1[r] + b1 - U2) : 0.f;                          \
                p2[r] = (mine && d2 >= 0) ? __builtin_amdgcn_exp2f(s2[r] + b2 - U2) : 0.f;                          \
                lsum += p1[r] + p2[r];                                                                              \
            }                                                                                                       \
            asm volatile("" ::: "memory");                                                                          \
            pv_step(o, slotr_, pack_p(p1, p2), fq, fr);                                                             \
            asm volatile("" ::: "memory");                                                                          \
        }
        {
            const int w0 = SLC_STEP(0), w1 = SLC_STEP(1), w2 = SLC_STEP(2);
            SLC_VLOAD(va, w0)
            SLC_KLOAD(ka1, ka2, w0)
            SLC_KLOAD(kb1, kb2, w1)
            SLC_VSTORE(va, slot0)
            SLC_VLOAD(vb, w1)
            SLC_VLOAD(va, w2)
        }
#pragma unroll 1
        for (int s = 0; s < nst; s += 2) {
            SLC_STAGE(s, ka1, ka2, vb, slot0, slot1)
            if (s + 1 < nst) SLC_STAGE(s + 1, kb1, kb2, va, slot1, slot0)
        }
#undef SLC_STEP
#undef SLC_KLOAD
#undef SLC_VLOAD
#undef SLC_VSTORE
#undef SLC_STAGE
        lsum += __shfl_xor(lsum, 16);
        lsum += __shfl_xor(lsum, 32);
        const float sc = lsum > 0.f ? g1 / lsum : 0.f;
#pragma unroll
        for (int dt = 0; dt < 4; ++dt) {
            outacc[dt][0] = __builtin_bit_cast(float, oacc_pk[dt].x << 16) + sc * o[dt][0];
            outacc[dt][1] = __builtin_bit_cast(float, oacc_pk[dt].x & 0xffff0000u) + sc * o[dt][1];
            outacc[dt][2] = __builtin_bit_cast(float, oacc_pk[dt].y << 16) + sc * o[dt][2];
            outacc[dt][3] = __builtin_bit_cast(float, oacc_pk[dt].y & 0xffff0000u) + sc * o[dt][3];
        }
    }
    bf16_t* orow = (bf16_t*)(p.ws + WS_OA) + (size_t)tok * 512 + head * 64 + 4 * fq;
#pragma unroll
    for (int dt = 0; dt < 4; ++dt) {
        uint2 v; v.x = pk2(outacc[dt][0], outacc[dt][1]); v.y = pk2(outacc[dt][2], outacc[dt][3]);
        *(uint2*)(orow + dt * 16) = v;
    }
}

typedef float f32x16 __attribute__((ext_vector_type(16)));
constexpr int DSA_CK = 0;
constexpr int DSA_CI = DSA_CK + 16 * 512 * 4;
constexpr int DSA_LUT = DSA_CI + 16 * 512 * 2;
constexpr int DSA_END = DSA_LUT + 8 * 128 * 4;
static_assert(DSA_END <= SMEM_BYTES, "dsa lds");

__device__ __forceinline__ unsigned mono_key(float s) {
    const unsigned u = __builtin_bit_cast(unsigned, s + 0.0f);
    return (u & 0x80000000u) ? ~u : (u | 0x80000000u);
}
__device__ __forceinline__ unsigned dsa_compact(unsigned* ck, unsigned short* ci, int n, int lane) {
    unsigned kk[8]; unsigned ii[8];
#pragma unroll
    for (int k = 0; k < 8; ++k) { const int e = lane + 64 * k; kk[k] = e < n ? ck[e] : 0u; ii[k] = e < n ? (unsigned)ci[e] : 0xFFFFu; }
    unsigned T = 0;
#pragma unroll 1
    for (int b = 31; b >= 0; --b) {
        const unsigned cand = T | (1u << b);
        int c = 0;
#pragma unroll
        for (int k = 0; k < 8; ++k) c += __builtin_popcountll(__ballot(kk[k] >= cand));
        if (c >= 256) T = cand;
    }
    int cgt = 0, ceq = 0;
#pragma unroll
    for (int k = 0; k < 8; ++k) { cgt += __builtin_popcountll(__ballot(kk[k] > T)); ceq += __builtin_popcountll(__ballot(kk[k] == T)); }
    const int need = 256 - cgt;
    unsigned X = 0xFFFFu;
    if (ceq > need) {
        X = 0;
#pragma unroll 1
        for (int b = 15; b >= 0; --b) {
            const unsigned cand = X | (1u << b);
            int c = 0;
#pragma unroll
            for (int k = 0; k < 8; ++k) c += __builtin_popcountll(__ballot(kk[k] == T && ii[k] < cand));
            if (c < need) X = cand;
        }
    }
    int base = 0;
    const unsigned long long lt = (1ull << lane) - 1ull;
#pragma unroll
    for (int k = 0; k < 8; ++k) {
        const bool keep = (kk[k] > T) || (kk[k] == T && ii[k] <= X);
        const unsigned long long m = __ballot(keep);
        if (keep) { const int pos = base + __builtin_popcountll(m & lt); ck[pos] = kk[k]; ci[pos] = (unsigned short)ii[k]; }
        base += __builtin_popcountll(m);
    }
    return T;
}

__device__ __forceinline__ void dsa_tile(const Params& p, int tt, unsigned char* smem) {
    const int tid = threadIdx.x, lane = tid & 63, wave = tid >> 6, col = lane & 31, hi = lane >> 5;
    unsigned* ckb = (unsigned*)(smem + DSA_CK);
    unsigned short* cib = (unsigned short*)(smem + DSA_CI);
    const bf16_t* iqb = (const bf16_t*)(p.ws + WS_IQB);
    const bf16_t* ikb = (const bf16_t*)(p.ws + WS_IKB);
    const float* iws = (const float*)(p.ws + WS_IWS);
    const int t0 = tt * 16;
    __syncthreads();
    const int tw = t0 + 4 * wave;
    bf16x8 af[2];
    {
        const int rho = col;
        const int tl_ = 2 * ((rho >> 2) & 1) + (rho >> 4), hd = 4 * ((rho >> 3) & 1) + (rho & 3);
#pragma unroll
        for (int ks = 0; ks < 2; ++ks) af[ks] = *(const bf16x8*)(iqb + (size_t)(tw + tl_) * 256 + hd * 32 + ks * 16 + hi * 8);
    }
    const int tokA = tw + 2 * hi, tokB = tokA + 1;
    float wA[8], wB[8];
#pragma unroll
    for (int h = 0; h < 8; ++h) { wA[h] = iws[(size_t)tokA * 8 + h]; wB[h] = iws[(size_t)tokB * 8 + h]; }
    unsigned* ckA = ckb + (4 * wave + 2 * hi) * 512;
    unsigned* ckB = ckA + 512;
    unsigned short* ciA = cib + (4 * wave + 2 * hi) * 512;
    unsigned short* ciB = ciA + 512;
    int cntA = 0, cntB = 0;
    unsigned LA = 0, LB = 0;
    const unsigned ltm = (1u << col) - 1u;
    const int nchunk = (tw + 4 + 31) >> 5;
    const f32x16 zero16 = {0.f, 0.f, 0.f, 0.f, 0.f, 0.f, 0.f, 0.f, 0.f, 0.f, 0.f, 0.f, 0.f, 0.f, 0.f, 0.f};
    bf16x8 nx0[4], nx1[4];
    const bf16_t* ikl = ikb + (size_t)col * 32 + hi * 8;
#pragma unroll
    for (int j = 0; j < 4; ++j) {
        const int cj = j < nchunk ? j : nchunk - 1;
        nx0[j] = *(const bf16x8*)(ikl + (size_t)cj * 1024); nx1[j] = *(const bf16x8*)(ikl + (size_t)cj * 1024 + 16);
    }
#pragma unroll 1
    for (int ch4 = 0; ch4 < nchunk; ch4 += 4) {
        bf16x8 cu0[4], cu1[4];
#pragma unroll
        for (int j = 0; j < 4; ++j) { cu0[j] = nx0[j]; cu1[j] = nx1[j]; }
#pragma unroll
        for (int j = 0; j < 4; ++j) {
            int cj = ch4 + 4 + j; cj = cj < nchunk ? cj : nchunk - 1;
            nx0[j] = *(const bf16x8*)(ikl + (size_t)cj * 1024); nx1[j] = *(const bf16x8*)(ikl + (size_t)cj * 1024 + 16);
        }
#pragma unroll
        for (int j = 0; j < 4; ++j) {
            const int ch = ch4 + j;
            if (ch < nchunk) {
                const int kidx = ch * 32 + col;
                f32x16 c = __builtin_amdgcn_mfma_f32_32x32x16_bf16(af[0], cu0[j], zero16, 0, 0, 0);
                c = __builtin_amdgcn_mfma_f32_32x32x16_bf16(af[1], cu1[j], c, 0, 0, 0);
                float sA = 0.f, sB = 0.f;
#pragma unroll
                for (int h = 0; h < 8; ++h) { sA += wA[h] * fmaxf(c[h], 0.f); sB += wB[h] * fmaxf(c[8 + h], 0.f); }
                const unsigned keyA = mono_key(sA), keyB = mono_key(sB);
                const bool pA = (kidx <= tokA) && (keyA > LA), pB = (kidx <= tokB) && (keyB > LB);
                const unsigned long long mA = __ballot(pA), mB = __ballot(pB);
                const unsigned hA = hi ? (unsigned)(mA >> 32) : (unsigned)mA, hB = hi ? (unsigned)(mB >> 32) : (unsigned)mB;
                if (pA) { const int pos = cntA + __builtin_popcount(hA & ltm); ckA[pos] = keyA; ciA[pos] = (unsigned short)kidx; }
                if (pB) { const int pos = cntB + __builtin_popcount(hB & ltm); ckB[pos] = keyB; ciB[pos] = (unsigned short)kidx; }
                cntA += __builtin_popcount(hA); cntB += __builtin_popcount(hB);
            }
        }
        if (__any((cntA > 384) || (cntB > 384))) {
#pragma unroll
            for (int tq = 0; tq < 4; ++tq) {
                const int cn = __shfl((tq & 1) ? cntB : cntA, (tq >> 1) * 32);
                if (cn > 384) {
                    const unsigned T = dsa_compact(ckb + (4 * wave + tq) * 512, cib + (4 * wave + tq) * 512, cn, lane);
                    if (hi == (tq >> 1)) { if (tq & 1) { cntB = 256; LB = T; } else { cntA = 256; LA = T; } }
                }
            }
        }
    }
#pragma unroll
    for (int tq = 0; tq < 4; ++tq) {
        const int cn = __shfl((tq & 1) ? cntB : cntA, (tq >> 1) * 32);
        if (cn > 256) {
            (void)dsa_compact(ckb + (4 * wave + tq) * 512, cib + (4 * wave + tq) * 512, cn, lane);
            if (hi == (tq >> 1)) { if (tq & 1) cntB = 256; else cntA = 256; }
        }
    }
    unsigned short* selg = (unsigned short*)(p.ws + WS_SEL);
    int* nselg = (int*)(p.ws + WS_NSEL);
#pragma unroll
    for (int tq = 0; tq < 4; ++tq) {
        int nsel = __shfl((tq & 1) ? cntB : cntA, (tq >> 1) * 32);
        nsel = nsel > 256 ? 256 : nsel;
        const unsigned short* sl = cib + (4 * wave + tq) * 512;
#pragma unroll
        for (int k = 0; k < 4; ++k) { const int e = lane + 64 * k; selg[(size_t)(tw + tq) * 256 + e] = e < nsel ? sl[e] : (unsigned short)0; }
        if (lane == 0) nselg[tw + tq] = nsel;
    }
}

__device__ __forceinline__ void phase_dsa_attn(const Params& p, int bid, int nb, unsigned char* smem) {
    const int tid = threadIdx.x, lane = tid & 63, wave = tid >> 6, slot = lane >> 3, chunk = lane & 7;
    float* lut = (float*)smem;
    const bf16_t* dqb = (const bf16_t*)(p.ws + WS_DQB);
    const bf16_t* dkb = (const bf16_t*)(p.ws + WS_DKB);
    const bf16_t* dvb = (const bf16_t*)(p.ws + WS_DVB);
    const unsigned short* selg = (const unsigned short*)(p.ws + WS_SEL);
    const int* nselg = (const int*)(p.ws + WS_NSEL);
    const float* relb = p.in[17];
    const int h = bid & 7, bh = bid >> 3, nbh = nb >> 3;
    __syncthreads();
    if (tid < 128) lut[tid] = relb[bucket_of(tid) * 16 + 8 + h] * LOG2E;
    float U2;
    {
        const float mq = wave_max(fabsf(p.in[6][lane])), mk = wave_max(fabsf(p.in[7][lane]));
        float mb = 0.f;
#pragma unroll
        for (int k = 0; k < 4; ++k) { const int e = lane + 64 * k; mb = fmaxf(mb, fabsf(relb[(e >> 3) * 16 + 8 + (e & 7)])); }
        mb = wave_max(mb);
        U2 = (8.f * mq * mk + mb) * LOG2E;
    }
    __syncthreads();
    const bf16_t* kbase = dkb + h * 64 + chunk * 8;
    const bf16_t* vbase = dvb + h * 64 + chunk * 8;
#pragma unroll 1
    for (int t = bh * 4 + wave; t < S; t += nbh * 4) {
        const int nsel = nselg[t];
        const uint2* ip = (const uint2*)(selg + (size_t)t * 256 + slot * 32);
        float q[8];
        {
            const uint4 qv = *(const uint4*)(dqb + (size_t)t * 512 + h * 64 + chunk * 8);
            q[0] = __builtin_bit_cast(float, qv.x << 16); q[1] = __builtin_bit_cast(float, qv.x & 0xffff0000u);
            q[2] = __builtin_bit_cast(float, qv.y << 16); q[3] = __builtin_bit_cast(float, qv.y & 0xffff0000u);
            q[4] = __builtin_bit_cast(float, qv.z << 16); q[5] = __builtin_bit_cast(float, qv.z & 0xffff0000u);
            q[6] = __builtin_bit_cast(float, qv.w << 16); q[7] = __builtin_bit_cast(float, qv.w & 0xffff0000u);
        }
        float o[8];
#pragma unroll
        for (int j = 0; j < 8; ++j) o[j] = 0.f;
        float lsum = 0.f;
        int sA_[4], sB_[4];
        uint4 kA_[4], vA_[4], kB_[4], vB_[4];
        uint2 idn = ip[0];
#define DSA_LOADG(S_, K_, V_, I_)                                                        \
        S_[0] = (int)((I_).x & 0xffffu); S_[1] = (int)((I_).x >> 16); S_[2] = (int)((I_).y & 0xffffu); S_[3] = (int)((I_).y >> 16); \
        _Pragma("unroll") for (int j = 0; j < 4; ++j) {                                 \
            K_[j] = *(const uint4*)(kbase + (size_t)S_[j] * 512);                        \
            V_[j] = *(const uint4*)(vbase + (size_t)S_[j] * 512);                        \
        }
#define DSA_COMPG(S_, K_, V_, gi)                                                        \
        _Pragma("unroll") for (int j = 0; j < 4; ++j) {                                 \
            const uint4 kv = K_[j], vv = V_[j];                                          \
            float d = q[0] * __builtin_bit_cast(float, kv.x << 16) + q[1] * __builtin_bit_cast(float, kv.x & 0xffff0000u) \
                    + q[2] * __builtin_bit_cast(float, kv.y << 16) + q[3] * __builtin_bit_cast(float, kv.y & 0xffff0000u) \
                    + q[4] * __builtin_bit_cast(float, kv.z << 16) + q[5] * __builtin_bit_cast(float, kv.z & 0xffff0000u) \
                    + q[6] * __builtin_bit_cast(float, kv.w << 16) + q[7] * __builtin_bit_cast(float, kv.w & 0xffff0000u); \
            d += __shfl_xor(d, 1); d += __shfl_xor(d, 2); d += __shfl_xor(d, 4);       \
            int dist = t - S_[j]; dist = dist > 127 ? 127 : (dist < 0 ? 0 : dist);       \
            float pr = __builtin_amdgcn_exp2f(d + lut[dist] - U2);                       \
            pr = (slot * 32 + (gi) * 4 + j < nsel) ? pr : 0.f;                           \
            lsum += pr;                                                                  \
            o[0] += pr * __builtin_bit_cast(float, vv.x << 16); o[1] += pr * __builtin_bit_cast(float, vv.x & 0xffff0000u); \
            o[2] += pr * __builtin_bit_cast(float, vv.y << 16); o[3] += pr * __builtin_bit_cast(float, vv.y & 0xffff0000u); \
            o[4] += pr * __builtin_bit_cast(float, vv.z << 16); o[5] += pr * __builtin_bit_cast(float, vv.z & 0xffff0000u); \
            o[6] += pr * __builtin_bit_cast(float, vv.w << 16); o[7] += pr * __builtin_bit_cast(float, vv.w & 0xffff0000u); \
        }
        DSA_LOADG(sA_, kA_, vA_, idn)
        idn = ip[1];
#pragma unroll 1
        for (int gi = 0; gi < 8; gi += 2) {
            DSA_LOADG(sB_, kB_, vB_, idn)
            idn = ip[gi + 2 < 8 ? gi + 2 : 7];
            DSA_COMPG(sA_, kA_, vA_, gi)
            DSA_LOADG(sA_, kA_, vA_, idn)
            idn = ip[gi + 3 < 8 ? gi + 3 : 7];
            DSA_COMPG(sB_, kB_, vB_, gi + 1)
        }
#undef DSA_LOADG
#undef DSA_COMPG
#pragma unroll
        for (int j = 0; j < 8; ++j) { o[j] += __shfl_xor(o[j], 8); o[j] += __shfl_xor(o[j], 16); o[j] += __shfl_xor(o[j], 32); }
        lsum += __shfl_xor(lsum, 8); lsum += __shfl_xor(lsum, 16); lsum += __shfl_xor(lsum, 32);
        if (slot == 0) {
            const float inv = lsum > 0.f ? 1.f / lsum : 0.f;
            uint4 ov;
            ov.x = pk2(o[0] * inv, o[1] * inv); ov.y = pk2(o[2] * inv, o[3] * inv); ov.z = pk2(o[4] * inv, o[5] * inv); ov.w = pk2(o[6] * inv, o[7] * inv);
            *(uint4*)((bf16_t*)(p.ws + WS_OB) + (size_t)t * 512 + h * 64 + chunk * 8) = ov;
        }
    }
}

__device__ __forceinline__ void phase_attn(const Params& p, int bid, int nb, unsigned char* smem) {
#pragma unroll 1
    for (int w = bid, rd = 0; w < 1024; w += nb, ++rd) {
        const int r0 = w - bid;
        const int cnt = (1024 - r0) < nb ? (1024 - r0) : nb;
        const int k = (rd & 1) ? (cnt - 1 - bid) : bid;
        dsa_tile(p, 1023 - (r0 + k), smem);
    }
#pragma unroll 1
    for (int i = bid, rd = 0; i < 2048; i += nb, ++rd) {
        const int r0 = i - bid;
        const int cnt = (2048 - r0) < nb ? (2048 - r0) : nb;
        const int k = ((rd & 1) && !(cnt & 1)) ? 2 * ((cnt >> 1) - 1 - (bid >> 1)) + (bid & 1) : bid;
        const int j = r0 + k;
        nsa_tile(p, 1023 - (j >> 1), j & 1, smem);
    }
}

template <int PASS>
__device__ __forceinline__ void phase_merge(const Params& p, int bid, int nb, unsigned char* smem) {
    const bf16_t* sg = (const bf16_t*)(p.ws + (PASS ? WS_SGB : WS_SGA));
    bf16_t* merged = (bf16_t*)(p.ws + WS_MERGED);
    float* tmp = (float*)(p.ws + WS_X1);
    const bf16_t* A = (const bf16_t*)(p.ws + (PASS ? WS_OB : WS_OA));
    const bf16_t* Bw = (const bf16_t*)(p.ws + (PASS ? WB_B : WB_A));
    for (int w = bid; w < 128 * 8; w += nb) {
        const int mt = w % 128, nt = w / 128;
        const int m0 = mt * 128, n0 = nt * 128;
        f32x4 acc[4][4];
        gemm2<false, false>(A, 512, nullptr, m0, 128, Bw, D, n0, 128, 512, smem, acc);
#pragma unroll
        for (int i = 0; i < 4; ++i)
#pragma unroll
            for (int r = 0; r < 4; ++r) {
                const int row = m0 + G2_ROW(i, r);
                const bf16_t* zr = sg + (size_t)row * D + n0 + G2_COL(0);
                float* tr = tmp + (size_t)row * D + n0 + G2_COL(0);
                bf16_t* mr = merged + (size_t)row * D + n0 + G2_COL(0);
#pragma unroll
                for (int j = 0; j < 4; ++j) {
                    const float v = bf2f(zr[j * 16]) * acc[i][j][r];
                    if (PASS == 0) tr[j * 16] = v;
                    else mr[j * 16] = (bf16_t)f2bf(tr[j * 16] + v);
                }
            }
    }
}

__device__ __forceinline__ void phase_outproj(const Params& p, int bid, int nb, unsigned char* smem) {
    const bf16_t* merged = (const bf16_t*)(p.ws + WS_MERGED);
    const float* x = p.in[0];
    float* x1 = (float*)(p.ws + WS_X1);
    for (int w = bid; w < 128 * 8; w += nb) {
        const int mt = w % 128, nt = w / 128;
        const int m0 = mt * 128, n0 = nt * 128;
        f32x4 acc[4][4];
        gemm2<false, false>(merged, D, nullptr, m0, 128, (const bf16_t*)(p.ws + WB_OUT), D, n0, 128, D, smem, acc);
#pragma unroll
        for (int i = 0; i < 4; ++i)
#pragma unroll
            for (int r = 0; r < 4; ++r) {
                const size_t ro = (size_t)(m0 + G2_ROW(i, r)) * D + n0;
#pragma unroll
                for (int j = 0; j < 4; ++j) { const int c = G2_COL(j); x1[ro + c] = x[ro + c] + acc[i][j][r]; }
            }
    }
}

__device__ __forceinline__ void phase_route(const Params& p, int bid, int nb) {
    const int lane = threadIdx.x & 63, wave = threadIdx.x >> 6;
    const float* x1 = (const float*)(p.ws + WS_X1);
    const float* g = p.in[18];
    const float* wr = p.in[19];
    const float* br = p.in[20];
    bf16_t* hb = (bf16_t*)(p.ws + WS_HB);
    int* topi = (int*)(p.ws + WS_TOPI);
    float* topw = (float*)(p.ws + WS_TOPW);
    int* cnt = (int*)(p.ws + WS_CTL);
    for (int t = bid * 4 + wave; t < S; t += nb * 4) {
        const float4* xr = (const float4*)(x1 + (size_t)t * D);
        float4 v[4];
        float ss = 0.f;
#pragma unroll
        for (int j = 0; j < 4; ++j) { v[j] = xr[lane + 64 * j]; ss += v[j].x * v[j].x + v[j].y * v[j].y + v[j].z * v[j].z + v[j].w * v[j].w; }
        ss = wave_sum(ss);
        const float rstd = rsqrtf(ss * (1.f / D) + EPS);
        float lg[32];
#pragma unroll
        for (int e = 0; e < 32; ++e) lg[e] = 0.f;
#pragma unroll
        for (int j = 0; j < 4; ++j) {
            const float4 gg = ((const float4*)g)[lane + 64 * j];
            const float h0 = v[j].x * rstd * gg.x, h1 = v[j].y * rstd * gg.y, h2 = v[j].z * rstd * gg.z, h3 = v[j].w * rstd * gg.w;
            uint2 o; o.x = pk2(h0, h1); o.y = pk2(h2, h3);
            ((uint2*)(hb + (size_t)t * D))[lane + 64 * j] = o;
            const int k = 4 * (lane + 64 * j);
            const float4* w0 = (const float4*)(wr + (size_t)k * 32);
#pragma unroll
            for (int e4 = 0; e4 < 8; ++e4) {
                const float4 a = w0[e4], b = w0[8 + e4], c = w0[16 + e4], d = w0[24 + e4];
                lg[4 * e4 + 0] += h0 * a.x + h1 * b.x + h2 * c.x + h3 * d.x;
                lg[4 * e4 + 1] += h0 * a.y + h1 * b.y + h2 * c.y + h3 * d.y;
                lg[4 * e4 + 2] += h0 * a.z + h1 * b.z + h2 * c.z + h3 * d.z;
                lg[4 * e4 + 3] += h0 * a.w + h1 * b.w + h2 * c.w + h3 * d.w;
            }
        }
#pragma unroll
        for (int e = 0; e < 32; ++e) lg[e] = wave_sum(lg[e]) + br[e];
        int idx[4]; float val[4];
        unsigned used = 0;
#pragma unroll
        for (int k = 0; k < 4; ++k) {
            float best = -__builtin_inff(); int bi = 0;
#pragma unroll
            for (int e = 0; e < 32; ++e) { const bool ok = !((used >> e) & 1u) && (lg[e] > best); best = ok ? lg[e] : best; bi = ok ? e : bi; }
            idx[k] = bi; val[k] = best; used |= 1u << bi;
        }
        const float e0 = 1.f, e1 = __expf(val[1] - val[0]), e2 = __expf(val[2] - val[0]), e3 = __expf(val[3] - val[0]);
        const float inv = 1.f / (e0 + e1 + e2 + e3);
        if (lane == 0) {
            topi[t * 4 + 0] = idx[0]; topi[t * 4 + 1] = idx[1]; topi[t * 4 + 2] = idx[2]; topi[t * 4 + 3] = idx[3];
            topw[t * 4 + 0] = e0 * inv; topw[t * 4 + 1] = e1 * inv; topw[t * 4 + 2] = e2 * inv; topw[t * 4 + 3] = e3 * inv;
            atomicAdd(&cnt[idx[0]], 1); atomicAdd(&cnt[idx[1]], 1); atomicAdd(&cnt[idx[2]], 1); atomicAdd(&cnt[idx[3]], 1);
        }
    }
}

__device__ __forceinline__ void phase_place(const Params& p, int bid, int nb, unsigned char* smem) {
    int* off = (int*)smem;
    const int* cnt = (const int*)(p.ws + WS_CTL);
    int* cur = (int*)(p.ws + WS_CTL) + 32;
    const int* topi = (const int*)(p.ws + WS_TOPI);
    int* ppos = (int*)(p.ws + WS_PPOS);
    int* rowtok = (int*)(p.ws + WS_ROWTOK);
    __syncthreads();
    if (threadIdx.x == 0) { int a = 0; for (int e = 0; e < NEXP; ++e) { off[e] = a; a += cnt[e]; } }
    __syncthreads();
    for (int i = bid * NT + threadIdx.x; i < S * 4; i += nb * NT) {
        const int e = topi[i];
        const int pos = off[e] + atomicAdd(&cur[e], 1);
        ppos[i] = pos;
        rowtok[pos] = i >> 2;
    }
}

__device__ __forceinline__ void moe_tile_map(const int* cnt, int* sm, int& total_mt) {
    __syncthreads();
    if (threadIdx.x == 0) {
        int a = 0, b = 0;
        for (int e = 0; e < NEXP; ++e) { sm[e] = a; sm[33 + e] = b; a += (cnt[e] + 127) >> 7; b += cnt[e]; }
        sm[32] = a; sm[65] = b;
    }
    __syncthreads();
    total_mt = sm[32];
}
__device__ __forceinline__ void phase_moe1(const Params& p, int bid, int nb, unsigned char* smem) {
    int* sm = (int*)(smem + 65536);
    const int* cnt = (const int*)(p.ws + WS_CTL);
    const int* rowtok = (const int*)(p.ws + WS_ROWTOK);
    const bf16_t* hb = (const bf16_t*)(p.ws + WS_HB);
    bf16_t* act = (bf16_t*)(p.ws + WS_ACT);
    const int lane = threadIdx.x & 63, wave = threadIdx.x >> 6;
    int total_mt;
    moe_tile_map(cnt, sm, total_mt);
    for (int w = bid; w < total_mt * 16; w += nb) {
        const int tm = w >> 4, nt = w & 15;
        int e = 0;
        while (e < NEXP - 1 && sm[e + 1] <= tm) ++e;
        const int mt = tm - sm[e];
        const int rbase = sm[33 + e] + mt * 128;
        const int mrows = min(128, cnt[e] - mt * 128);
        const int n0 = nt * 64;
        f32x4 acc[4][4];
        gemm2<true, true>(hb, D, rowtok, rbase, mrows, (const bf16_t*)(p.ws + WB_E1) + (size_t)e * D * 2 * DFF, 2 * DFF, n0, 128, D, smem, acc);
        const float* b1 = p.in[22] + (size_t)e * 2 * DFF;
        const int wn_ = (threadIdx.x >> 6) & 1;
#pragma unroll
        for (int i = 0; i < 4; ++i)
#pragma unroll
            for (int jp = 0; jp < 2; ++jp) {
                const int col = n0 + (wn_ * 2 + jp) * 16 + (threadIdx.x & 15);
                const float bg = b1[col], bl = b1[DFF + col];
#pragma unroll
                for (int r = 0; r < 4; ++r) {
                    const int rl = G2_ROW(i, r);
                    if (rl < mrows) {
                        const float gate = fminf(acc[i][2 * jp][r] + bg, 7.f);
                        const float lin = fminf(fmaxf(acc[i][2 * jp + 1][r] + bl, -7.f), 7.f);
                        const float a_ = (lin + 1.f) * gate * sigmoidf_(1.702f * gate);
                        act[(size_t)(rbase + rl) * DFF + col] = (bf16_t)f2bf(a_);
                    }
                }
            }
    }
}
__device__ __forceinline__ void phase_moe2(const Params& p, int bid, int nb, unsigned char* smem) {
    int* sm = (int*)(smem + 65536);
    const int* cnt = (const int*)(p.ws + WS_CTL);
    const bf16_t* act = (const bf16_t*)(p.ws + WS_ACT);
    float* yrows = (float*)(p.ws + WS_YROWS);
    const int lane = threadIdx.x & 63, wave = threadIdx.x >> 6;
    int total_mt;
    moe_tile_map(cnt, sm, total_mt);
    for (int w = bid; w < total_mt * 8; w += nb) {
        const int tm = w >> 3, nt = w & 7;
        int e = 0;
        while (e < NEXP - 1 && sm[e + 1] <= tm) ++e;
        const int mt = tm - sm[e];
        const int rbase = sm[33 + e] + mt * 128;
        const int mrows = min(128, cnt[e] - mt * 128);
        const int n0 = nt * 128;
        f32x4 acc[4][4];
        gemm2<false, false>(act, DFF, nullptr, rbase, mrows, (const bf16_t*)(p.ws + WB_E2) + (size_t)e * DFF * D, D, n0, 128, DFF, smem, acc);
        const float* b2 = p.in[24] + (size_t)e * D + n0;
#pragma unroll
        for (int i = 0; i < 4; ++i)
#pragma unroll
            for (int r = 0; r < 4; ++r) {
                const int rl = G2_ROW(i, r);
                if (rl < mrows) {
                    float* yr = yrows + (size_t)(rbase + rl) * D + n0;
#pragma unroll
                    for (int j = 0; j < 4; ++j) { const int c = G2_COL(j); yr[c] = acc[i][j][r] + b2[c]; }
                }
            }
    }
}

__device__ __forceinline__ void phase_combine(const Params& p, int bid, int nb) {
    const int lane = threadIdx.x & 63, wave = threadIdx.x >> 6;
    const float* x1 = (const float*)(p.ws + WS_X1);
    const float* yrows = (const float*)(p.ws + WS_YROWS);
    const int* ppos = (const int*)(p.ws + WS_PPOS);
    const float* topw = (const float*)(p.ws + WS_TOPW);
    const float* g = p.in[25];
    bf16_t* hb = (bf16_t*)(p.ws + WS_HB);
    bf16_t* pb = (bf16_t*)(p.ws + WS_PB);
    for (int t = bid * 4 + wave; t < S; t += nb * 4) {
        {
            const float4 pv = ((const float4*)(p.in[1] + (size_t)t * 256))[lane];
            uint2 o; o.x = pk2(pv.x, pv.y); o.y = pk2(pv.z, pv.w);
            ((uint2*)(pb + (size_t)t * 256))[lane] = o;
        }
        float4 v[4];
#pragma unroll
        for (int j = 0; j < 4; ++j) v[j] = ((const float4*)(x1 + (size_t)t * D))[lane + 64 * j];
#pragma unroll
        for (int k = 0; k < 4; ++k) {
            const float wk = topw[t * 4 + k];
            const float4* yr = (const float4*)(yrows + (size_t)ppos[t * 4 + k] * D);
#pragma unroll
            for (int j = 0; j < 4; ++j) { const float4 y = yr[lane + 64 * j]; v[j].x += wk * y.x; v[j].y += wk * y.y; v[j].z += wk * y.z; v[j].w += wk * y.w; }
        }
        float ss = 0.f;
#pragma unroll
        for (int j = 0; j < 4; ++j) ss += v[j].x * v[j].x + v[j].y * v[j].y + v[j].z * v[j].z + v[j].w * v[j].w;
        ss = wave_sum(ss);
        const float rstd = rsqrtf(ss * (1.f / D) + EPS);
#pragma unroll
        for (int j = 0; j < 4; ++j) {
            ((float4*)(p.out + (size_t)t * D))[lane + 64 * j] = v[j];
            const float4 gg = ((const float4*)g)[lane + 64 * j];
            uint2 o;
            o.x = pk2(v[j].x * rstd * gg.x, v[j].y * rstd * gg.y);
            o.y = pk2(v[j].z * rstd * gg.z, v[j].w * rstd * gg.w);
            ((uint2*)(hb + (size_t)t * D))[lane + 64 * j] = o;
        }
    }
}

template <int PASS>
__device__ __forceinline__ void phase_ple(const Params& p, int bid, int nb, unsigned char* smem) {
    float* tmp = (float*)(p.ws + WS_X1);
    const bf16_t* A = (const bf16_t*)(p.ws + (PASS ? WS_PB : WS_HB));
    const bf16_t* Bw = (const bf16_t*)(p.ws + (PASS ? WB_PLE : WB_PLEG));
    constexpr int K = PASS ? 256 : D;
    for (int w = bid; w < 128 * 8; w += nb) {
        const int mt = w % 128, nt = w / 128;
        const int m0 = mt * 128, n0 = nt * 128;
        f32x4 acc[4][4];
        gemm2<false, false>(A, K, nullptr, m0, 128, Bw, D, n0, 128, K, smem, acc);
#pragma unroll
        for (int i = 0; i < 4; ++i)
#pragma unroll
            for (int r = 0; r < 4; ++r) {
                const size_t ro = (size_t)(m0 + G2_ROW(i, r)) * D + n0 + G2_COL(0);
                float* tr = tmp + ro;
                float* orow = p.out + ro;
#pragma unroll
                for (int j = 0; j < 4; ++j) {
                    if (PASS == 0) tr[j * 16] = sigmoidf_(acc[i][j][r]);
                    else orow[j * 16] = orow[j * 16] + tr[j * 16] * acc[i][j][r];
                }
            }
    }
}

#define LAS __attribute__((address_space(3)))
#define XB_TMO      128
#define XB_XCNT(j)  (256  + 64 * (j))
#define XB_XSUB(j)  (1280 + 64 * (j))
#define XB_XGEN(j)  (2304 + 64 * (j))
#define XB_TOP      3328
#define XB_TOPGEN   3392
#define XCD_BAR_WORDS 3456
#define XB_SPIN_CAP (1u << 18)

__device__ __forceinline__ unsigned xb_ld(unsigned* p)              { return __hip_atomic_load(p, __ATOMIC_RELAXED, __HIP_MEMORY_SCOPE_AGENT); }
__device__ __forceinline__ unsigned xb_add(unsigned* p, unsigned v) { return __hip_atomic_fetch_add(p, v, __ATOMIC_RELAXED, __HIP_MEMORY_SCOPE_AGENT); }
__device__ __forceinline__ unsigned xb_xcc_id() { return (unsigned)__builtin_amdgcn_s_getreg((3 << 11) | 20) & 0xFu; }
#define XB_SPIN(cond, bar) do { unsigned _sp = 0; while (cond) { __builtin_amdgcn_s_sleep(1); \
    if ((++_sp & 255u) == 0u) { if (xb_ld(&(bar)[XB_TMO])) break; if (_sp > XB_SPIN_CAP) { atomicAdd(&(bar)[XB_TMO], 1u); break; } } } } while (0)

struct XcdBarrier {
    unsigned* bar; unsigned x;
    volatile LAS unsigned* st;
};

__device__ __forceinline__ XcdBarrier xcd_barrier_post(unsigned* bar, volatile LAS unsigned* st) {
    XcdBarrier b; b.bar = bar; b.x = xb_xcc_id(); b.st = st;
    if (threadIdx.x == 0) (void)xb_add(&bar[XB_XCNT(b.x)], 1u);
    return b;
}
__device__ __forceinline__ void xcd_barrier_complete(unsigned* bar, unsigned x, unsigned& nloc, unsigned& nx) {
    const unsigned G = gridDim.x * gridDim.y * gridDim.z;
    unsigned sum, cnt, mine, sp = 0u;
    for (;;) {
        sum = 0u; cnt = 0u; mine = 0u;
#pragma unroll
        for (unsigned j = 0; j < 16; ++j) { const unsigned c = xb_ld(&bar[XB_XCNT(j)]); sum += c; cnt += (c > 0u) ? 1u : 0u; mine = (j == x) ? c : mine; }
        if (sum == G) break;
        __builtin_amdgcn_s_sleep(1);
        if ((++sp & 255u) == 0u) { if (xb_ld(&bar[XB_TMO])) break; if (sp > XB_SPIN_CAP) { atomicAdd(&bar[XB_TMO], 1u); break; } }
    }
    nloc = mine > 0u ? mine : 1u; nx = cnt > 0u ? cnt : 1u;
}

__device__ __forceinline__ void xcd_barrier(const XcdBarrier& b) {
    asm volatile("s_waitcnt vmcnt(0)" ::: "memory");
    __syncthreads();
    if (threadIdx.x == 0) {
        unsigned* bar = b.bar;
        __builtin_amdgcn_s_waitcnt(0);
        unsigned nloc = b.st[0], nx = b.st[1];
        if (nloc == 0u) { xcd_barrier_complete(bar, b.x, nloc, nx); b.st[0] = nloc; b.st[1] = nx; }
        const unsigned old = xb_add(&bar[XB_XSUB(b.x)], 1u);
        const unsigned gen = old / nloc;
        if (old + 1u == (gen + 1u) * nloc) {
            __builtin_amdgcn_fence(__ATOMIC_RELEASE, "agent");
            asm volatile("s_waitcnt vmcnt(0)" ::: "memory");
            const unsigned og = xb_add(&bar[XB_TOP], 1u);
            const unsigned tg = og / nx;
            if (og + 1u == (tg + 1u) * nx) xb_add(&bar[XB_TOPGEN], 1u);
            else XB_SPIN(xb_ld(&bar[XB_TOPGEN]) == tg, bar);
            __builtin_amdgcn_fence(__ATOMIC_ACQUIRE, "agent");
            xb_add(&bar[XB_XGEN(b.x)], 1u);
            asm volatile("s_waitcnt vmcnt(0)" ::: "memory");
        } else {
            XB_SPIN(xb_ld(&bar[XB_XGEN(b.x)]) == gen, bar);
            __builtin_amdgcn_fence(__ATOMIC_ACQUIRE, "agent");
            asm volatile("s_waitcnt vmcnt(0)" ::: "memory");
        }
    }
    __syncthreads();
}

template <int PH>
__device__ __forceinline__ void run_phase(const Params& p, int bid, int nb, unsigned char* smem) {
    if (PH == 0) phase_prep(p, bid, nb);
    if (PH == 1) phase_inproj(p, bid, nb, smem);
    if (PH == 3) phase_compress(p, bid, nb, smem);
    if (PH == 4) phase_attn(p, bid, nb, smem);
    if (PH == 15) phase_dsa_attn(p, bid, nb, smem);
    if (PH == 5) phase_merge<0>(p, bid, nb, smem);
    if (PH == 13) phase_merge<1>(p, bid, nb, smem);
    if (PH == 6) phase_outproj(p, bid, nb, smem);
    if (PH == 7) phase_route(p, bid, nb);
    if (PH == 8) phase_place(p, bid, nb, smem);
    if (PH == 9) phase_moe1(p, bid, nb, smem);
    if (PH == 10) phase_moe2(p, bid, nb, smem);
    if (PH == 11) phase_combine(p, bid, nb);
    if (PH == 12) phase_ple<0>(p, bid, nb, smem);
    if (PH == 14) phase_ple<1>(p, bid, nb, smem);
}

#if SINGLE_LAUNCH
__global__ void __launch_bounds__(NT, 2) fwd_mega(Params p) {
    __shared__ __attribute__((aligned(16))) unsigned char smem[SMEM_BYTES];
    cg::grid_group grid = cg::this_grid();
    const int bid = blockIdx.x, nb = gridDim.x;
    volatile LAS unsigned* bst = (volatile LAS unsigned*)(LAS unsigned char*)(smem + SMEM_BYTES - 16);
    if (threadIdx.x < 2) bst[threadIdx.x] = 0u;
    __syncthreads();
    const XcdBarrier bar = xcd_barrier_post((unsigned*)(p.ws + WS_BAR), bst);
#define GSYNC() xcd_barrier(bar)
    run_phase<0>(p, bid, nb, smem); grid.sync();
    run_phase<1>(p, bid, nb, smem); GSYNC();
    run_phase<3>(p, bid, nb, smem); GSYNC();
    run_phase<4>(p, bid, nb, smem); GSYNC();
    run_phase<15>(p, bid, nb, smem); GSYNC();
    run_phase<5>(p, bid, nb, smem); GSYNC();
    run_phase<13>(p, bid, nb, smem); GSYNC();
    run_phase<6>(p, bid, nb, smem); GSYNC();
    run_phase<7>(p, bid, nb, smem); GSYNC();
    run_phase<8>(p, bid, nb, smem); GSYNC();
    run_phase<9>(p, bid, nb, smem); GSYNC();
    run_phase<10>(p, bid, nb, smem); GSYNC();
    run_phase<11>(p, bid, nb, smem); GSYNC();
    run_phase<12>(p, bid, nb, smem); GSYNC();
    run_phase<14>(p, bid, nb, smem);
#undef GSYNC
}
#else
template <int PH>
__global__ void __launch_bounds__(NT, 2) k_phase(Params p) {
    __shared__ __attribute__((aligned(16))) unsigned char smem[SMEM_BYTES];
    run_phase<PH>(p, blockIdx.x, gridDim.x, smem);
}
#endif

extern "C" void kernel_launch(void* const* d_in, const int* in_sizes, int n_in, void* d_out, int out_size, void* d_ws, size_t ws_size,
                              hipStream_t stream) {
    if (n_in != 28 || ws_size < WS_END) { fprintf(stderr, "kernel_launch: unexpected n_in %d or ws_size %zu (< %zu)\n", n_in, ws_size, (size_t)WS_END); return; }
    Params p{};
    for (int i = 0; i < 28; ++i) p.in[i] = (const float*)d_in[i];
    p.out = (float*)d_out;
    p.ws = (unsigned char*)d_ws;
#if SINGLE_LAUNCH
    static int grid_blocks = 0;
    if (!grid_blocks) {
        int dev = 0, cus = 0, per_cu = 0;
        hipGetDevice(&dev);
        hipDeviceGetAttribute(&cus, hipDeviceAttributeMultiprocessorCount, dev);
        hipOccupancyMaxActiveBlocksPerMultiprocessor(&per_cu, fwd_mega, NT, 0);
        if (per_cu > 2) per_cu = 2;
        if (per_cu < 1) per_cu = 1;
        grid_blocks = cus * per_cu;
    }
    (void)hipMemsetAsync((unsigned char*)d_ws + WS_BAR, 0, XCD_BAR_WORDS * 4, stream);
    void* args[] = {&p};
    hipError_t e = hipLaunchCooperativeKernel((void*)fwd_mega, dim3(grid_blocks), dim3(NT), args, 0, stream);
    if (e != hipSuccess) fprintf(stderr, "cooperative launch failed: %s (grid %d)\n", hipGetErrorString(e), grid_blocks);
#else
    const int G = 512;
    k_phase<0><<<G, NT, 0, stream>>>(p);
    k_phase<1><<<G, NT, 0, stream>>>(p);
    k_phase<3><<<G, NT, 0, stream>>>(p);
    k_phase<4><<<G, NT, 0, stream>>>(p);
    k_phase<15><<<G, NT, 0, stream>>>(p);
    k_phase<5><<<G, NT, 0, stream>>>(p);
    k_phase<13><<<G, NT, 0, stream>>>(p);
    k_phase<6><<<G, NT, 0, stream>>>(p);
    k_phase<7><<<G, NT, 0, stream>>>(p);
    k_phase<8><<<G, NT, 0, stream>>>(p);
    k_phase<9><<<G, NT, 0, stream>>>(p);
    k_phase<10><<<G, NT, 0, stream>>>(p);
    k_phase<11><<<G, NT, 0, stream>>>(p);
    k_phase<12><<<G, NT, 0, stream>>>(p);
    k_phase<14><<<G, NT, 0, stream>>>(p);
#endif
}
```

```cpp
#include <hip/hip_runtime.h>
#include <hip/hip_cooperative_groups.h>
#include <cstdio>
#include <cstdint>
namespace cg = cooperative_groups;

#ifndef SINGLE_LAUNCH
#define SINGLE_LAUNCH 1
#endif

constexpr int S = 16384;
constexpr int D = 1024;
constexpr int DIN = 5184;
constexpr int NCMP = 1023;
constexpr int NSLC = 256;
constexpr int NEXP = 32;
constexpr int DFF = 1024;
constexpr float EPS = 1e-6f;
constexpr float LOG2E = 1.4426950408889634f;
constexpr int Z_NQ = 0, Z_NKV = 512, Z_NGATE = 1280, Z_DQ = 1304, Z_DK = 1816, Z_DV = 2328, Z_IQ = 2840, Z_IK = 3096,
              Z_IW = 3128, Z_GA = 3136, Z_GB = 4160;

constexpr int NT = 256;
constexpr int SMEM_BYTES = 73728;

typedef unsigned short bf16_t;
typedef short bf16x8 __attribute__((ext_vector_type(8)));
typedef float f32x4 __attribute__((ext_vector_type(4)));
typedef short s16x4 __attribute__((ext_vector_type(4)));
typedef __attribute__((address_space(3))) s16x4* lds_s16x4_ptr;
__device__ __forceinline__ s16x4 lds_tr16(const void* p) {
    return __builtin_amdgcn_ds_read_tr16_b64_v4i16((lds_s16x4_ptr)(uintptr_t)p);
}

constexpr size_t MBy = 1ull << 20;
constexpr size_t WS_CTL = 0;
constexpr size_t WS_BAR = 65536;
constexpr size_t WS_HB = 1 * MBy;
constexpr size_t WS_OA = WS_HB + (size_t)S * D * 2;
constexpr size_t WS_OB = WS_OA + (size_t)S * 512 * 2;
constexpr size_t WS_MERGED = WS_OB + (size_t)S * 512 * 2;
constexpr size_t WS_X1 = WS_MERGED + (size_t)S * D * 2;
constexpr size_t WS_TOPI = WS_X1 + (size_t)S * D * 4;
constexpr size_t WS_TOPW = WS_TOPI + (size_t)S * 4 * 4;
constexpr size_t WS_PPOS = WS_TOPW + (size_t)S * 4 * 4;
constexpr size_t WS_ROWTOK = WS_PPOS + (size_t)S * 4 * 4;
constexpr size_t WS_PB = WS_ROWTOK + (size_t)65536 * 4;
constexpr size_t WS_PW = WS_PB + (size_t)S * 256 * 2;
constexpr size_t WS_SEL = WS_PW + (size_t)S * D * 2;
constexpr size_t WS_NSEL = WS_SEL + (size_t)S * 256 * 2;
constexpr size_t WS_REG = WS_NSEL + (size_t)S * 4;
constexpr size_t WS_SGA = WS_REG;
constexpr size_t WS_SGB = WS_SGA + (size_t)S * D * 2;
constexpr size_t WS_GT = WS_SGB + (size_t)S * D * 2;
constexpr size_t WS_IWS = WS_GT + (size_t)S * 32 * 4;
constexpr size_t WS_QNB = WS_IWS + (size_t)S * 8 * 4;
constexpr size_t WS_KSLB = WS_QNB + (size_t)S * 512 * 2;
constexpr size_t WS_VSLB = WS_KSLB + (size_t)S * 128 * 2;
constexpr size_t WS_KWNB = WS_VSLB + (size_t)S * 128 * 2;
constexpr size_t WS_VWNB = WS_KWNB + (size_t)S * 128 * 2;
constexpr size_t WS_KCB = WS_VWNB + (size_t)S * 128 * 2;
constexpr size_t WS_VCB = WS_KCB + (size_t)2 * 1024 * 64 * 2;
constexpr size_t WS_KCR = WS_VCB + (size_t)2 * 1024 * 64 * 2;
constexpr size_t WS_VCR = WS_KCR + (size_t)S * 128 * 2;
constexpr size_t WS_DQB = WS_VCR + (size_t)S * 128 * 2;
constexpr size_t WS_DKB = WS_DQB + (size_t)S * 512 * 2;
constexpr size_t WS_DVB = WS_DKB + (size_t)S * 512 * 2;
constexpr size_t WS_IQB = WS_DVB + (size_t)S * 512 * 2;
constexpr size_t WS_IKB = WS_IQB + (size_t)S * 256 * 2;
constexpr size_t WS_ENDA = WS_IKB + (size_t)S * 32 * 2;
constexpr size_t WS_ACT = WS_REG;
constexpr size_t WS_YROWS = WS_ACT + (size_t)(65536 + 128) * DFF * 2;
constexpr size_t WS_ENDB = WS_YROWS + (size_t)(65536 + 128) * D * 4;
constexpr size_t WS_END0 = WS_ENDA > WS_ENDB ? WS_ENDA : WS_ENDB;
constexpr size_t WB_IN = WS_END0;
constexpr size_t WB_A = WB_IN + (size_t)D * DIN * 2;
constexpr size_t WB_B = WB_A + (size_t)512 * D * 2;
constexpr size_t WB_OUT = WB_B + (size_t)512 * D * 2;
constexpr size_t WB_E1 = WB_OUT + (size_t)D * D * 2;
constexpr size_t WB_E2 = WB_E1 + (size_t)NEXP * D * 2 * DFF * 2;
constexpr size_t WB_PLE = WB_E2 + (size_t)NEXP * DFF * D * 2;
constexpr size_t WB_PLEG = WB_PLE + (size_t)256 * D * 2;
constexpr size_t WB_CK1 = WB_PLEG + (size_t)D * D * 2;
constexpr size_t WB_CV1 = WB_CK1 + (size_t)2048 * 64 * 2;
constexpr size_t WS_END = WB_CV1 + (size_t)2048 * 64 * 2 + 4096;

struct Params {
    const float* in[28];
    float* out;
    unsigned char* ws;
};

__device__ __forceinline__ unsigned f2bf(float f) {
    unsigned u = __builtin_bit_cast(unsigned, f);
    return (u + 0x7fffu + ((u >> 16) & 1u)) >> 16;
}
__device__ __forceinline__ unsigned pk2(float lo, float hi) { return f2bf(lo) | (f2bf(hi) << 16); }
__device__ __forceinline__ float bf2f(unsigned short b) { return __builtin_bit_cast(float, (unsigned)b << 16); }
__device__ __forceinline__ float wave_sum(float v) {
#pragma unroll
    for (int o = 1; o < 64; o <<= 1) v += __shfl_xor(v, o);
    return v;
}
__device__ __forceinline__ float wave_max(float v) {
#pragma unroll
    for (int o = 1; o < 64; o <<= 1) v = fmaxf(v, __shfl_xor(v, o));
    return v;
}
__device__ __forceinline__ float sigmoidf_(float x) { return 1.f / (1.f + __expf(-x)); }
__device__ __forceinline__ int bucket_of(int n) {
    if (n < 16) return n;
    int b = 16;
    b += (n >= 19) + (n >= 21) + (n >= 24) + (n >= 27) + (n >= 31) + (n >= 35) + (n >= 40) + (n >= 46) + (n >= 52) + (n >= 59) +
         (n >= 67) + (n >= 77) + (n >= 87) + (n >= 99) + (n >= 113);
    return b;
}

constexpr int LDS_STRIDE = 40;
constexpr int BTR_STRIDE = 136;
template <bool A_F32, bool GATHER, bool SPLIT = false, bool BTR = true>
__device__ __forceinline__ void gemm_tile(const void* __restrict__ Aptr, int lda, const int* __restrict__ rowidx, int m0, int mrows,
                                          const float* __restrict__ B, int ldb, int n0, int split_off, int ncols, int K,
                                          unsigned char* smem, f32x4 (&acc)[2][8]) {
    bf16_t* As = (bf16_t*)smem;
    bf16_t* Bs = As + 128 * LDS_STRIDE;
    bf16_t* AsL = Bs + 128 * LDS_STRIDE;
    bf16_t* BsL = AsL + 128 * LDS_STRIDE;
    const int tid = threadIdx.x, lane = tid & 63, wave = tid >> 6;
#pragma unroll
    for (int i = 0; i < 2; ++i)
#pragma unroll
        for (int j = 0; j < 8; ++j) acc[i][j] = (f32x4){0.f, 0.f, 0.f, 0.f};
    auto lo = [](float v) { return v - bf2f((unsigned short)f2bf(v)); };

    const int ar = tid >> 2, ach = tid & 3;
    const unsigned char* arow[2];
    bool aval[2];
#pragma unroll
    for (int i = 0; i < 2; ++i) {
        int r = ar + 64 * i;
        aval[i] = r < mrows;
        long src = 0;
        if (aval[i]) src = GATHER ? (long)rowidx[m0 + r] : (long)(m0 + r);
        arow[i] = (const unsigned char*)Aptr + (size_t)src * lda * (A_F32 ? 4 : 2) + (size_t)ach * 8 * (A_F32 ? 4 : 2);
    }
    const int nq = tid & 31, kq = tid >> 5;
    const int jn = 4 * nq;
    const bool bval = jn < ncols;
    const float* bptr = B + (size_t)(4 * kq) * ldb + n0 + jn + (jn >= 64 ? split_off : 0);

    uint4 areg[2];
    float4 af0a, af0b, af1a, af1b;
    float4 breg[4];
    auto load_g = [&](int k0) {
#pragma unroll
        for (int i = 0; i < 2; ++i) {
            if (A_F32) {
                float4 t0 = make_float4(0, 0, 0, 0), t1 = t0;
                if (aval[i]) {
                    const float4* s = (const float4*)(arow[i] + (size_t)k0 * 4);
                    t0 = s[0]; t1 = s[1];
                }
                if (i == 0) { af0a = t0; af0b = t1; } else { af1a = t0; af1b = t1; }
            } else {
                if (aval[i]) areg[i] = *(const uint4*)(arow[i] + (size_t)k0 * 2);
                else areg[i] = make_uint4(0, 0, 0, 0);
            }
        }
#pragma unroll
        for (int kk = 0; kk < 4; ++kk) {
            if (bval) breg[kk] = *(const float4*)(bptr + (size_t)(k0 + kk) * ldb);
            else breg[kk] = make_float4(0, 0, 0, 0);
        }
    };
    auto store_l = [&]() {
#pragma unroll
        for (int i = 0; i < 2; ++i) {
            uint4 v;
            const float4 t0 = (i == 0) ? af0a : af1a, t1 = (i == 0) ? af0b : af1b;
            if (A_F32) {
                v.x = pk2(t0.x, t0.y); v.y = pk2(t0.z, t0.w);
                v.z = pk2(t1.x, t1.y); v.w = pk2(t1.z, t1.w);
            } else v = areg[i];
            *(uint4*)(As + (ar + 64 * i) * LDS_STRIDE + ach * 8) = v;
            if (SPLIT && A_F32) {
                v.x = pk2(lo(t0.x), lo(t0.y)); v.y = pk2(lo(t0.z), lo(t0.w));
                v.z = pk2(lo(t1.x), lo(t1.y)); v.w = pk2(lo(t1.z), lo(t1.w));
                *(uint4*)(AsL + (ar + 64 * i) * LDS_STRIDE + ach * 8) = v;
            }
        }
        if (SPLIT) {
            uint2 v;
            v.x = pk2(lo(breg[0].x), lo(breg[1].x)); v.y = pk2(lo(breg[2].x), lo(breg[3].x));
            *(uint2*)(BsL + (jn + 0) * LDS_STRIDE + 4 * kq) = v;
            v.x = pk2(lo(breg[0].y), lo(breg[1].y)); v.y = pk2(lo(breg[2].y), lo(breg[3].y));
            *(uint2*)(BsL + (jn + 1) * LDS_STRIDE + 4 * kq) = v;
            v.x = pk2(lo(breg[0].z), lo(breg[1].z)); v.y = pk2(lo(breg[2].z), lo(breg[3].z));
            *(uint2*)(BsL + (jn + 2) * LDS_STRIDE + 4 * kq) = v;
            v.x = pk2(lo(breg[0].w), lo(breg[1].w)); v.y = pk2(lo(breg[2].w), lo(breg[3].w));
            *(uint2*)(BsL + (jn + 3) * LDS_STRIDE + 4 * kq) = v;
        }
        if (BTR && !SPLIT) {
#pragma unroll
            for (int kk = 0; kk < 4; ++kk) {
                uint2 v; v.x = pk2(breg[kk].x, breg[kk].y); v.y = pk2(breg[kk].z, breg[kk].w);
                *(uint2*)(Bs + (4 * kq + kk) * BTR_STRIDE + jn) = v;
            }
        } else {
            uint2 v;
            v.x = pk2(breg[0].x, breg[1].x); v.y = pk2(breg[2].x, breg[3].x);
            *(uint2*)(Bs + (jn + 0) * LDS_STRIDE + 4 * kq) = v;
            v.x = pk2(breg[0].y, breg[1].y); v.y = pk2(breg[2].y, breg[3].y);
            *(uint2*)(Bs + (jn + 1) * LDS_STRIDE + 4 * kq) = v;
            v.x = pk2(breg[0].z, breg[1].z); v.y = pk2(breg[2].z, breg[3].z);
            *(uint2*)(Bs + (jn + 2) * LDS_STRIDE + 4 * kq) = v;
            v.x = pk2(breg[0].w, breg[1].w); v.y = pk2(breg[2].w, breg[3].w);
            *(uint2*)(Bs + (jn + 3) * LDS_STRIDE + 4 * kq) = v;
        }
    };
    const int nk = K / 32;
    __syncthreads();
    load_g(0);
    store_l();
    __syncthreads();
    const int fr = lane & 15, fq = lane >> 4;
    for (int kt = 0; kt < nk; ++kt) {
        if (kt + 1 < nk) load_g((kt + 1) * 32);
        bf16x8 a[2];
#pragma unroll
        for (int i = 0; i < 2; ++i) a[i] = *(const bf16x8*)(As + (wave * 32 + i * 16 + fr) * LDS_STRIDE + fq * 8);
        if (!SPLIT) {
            bf16x8 b[8];
#pragma unroll
            for (int j = 0; j < 8; ++j) {
                if (BTR && !SPLIT) {
                    const bf16_t* bp = Bs + (8 * fq + (fr >> 2)) * BTR_STRIDE + 16 * j + 4 * (fr & 3);
                    const s16x4 lo4 = lds_tr16(bp), hi4 = lds_tr16(bp + 4 * BTR_STRIDE);
                    b[j] = (bf16x8){lo4[0], lo4[1], lo4[2], lo4[3], hi4[0], hi4[1], hi4[2], hi4[3]};
                } else b[j] = *(const bf16x8*)(Bs + (j * 16 + fr) * LDS_STRIDE + fq * 8);
            }
#pragma unroll
            for (int i = 0; i < 2; ++i)
#pragma unroll
                for (int j = 0; j < 8; ++j) acc[i][j] = __builtin_amdgcn_mfma_f32_16x16x32_bf16(a[i], b[j], acc[i][j], 0, 0, 0);
        } else {
            bf16x8 al[2];
#pragma unroll
            for (int i = 0; i < 2; ++i) al[i] = *(const bf16x8*)(AsL + (wave * 32 + i * 16 + fr) * LDS_STRIDE + fq * 8);
#pragma unroll
            for (int j = 0; j < 8; ++j) {
                const bf16x8 bh = *(const bf16x8*)(Bs + (j * 16 + fr) * LDS_STRIDE + fq * 8);
                const bf16x8 bl = *(const bf16x8*)(BsL + (j * 16 + fr) * LDS_STRIDE + fq * 8);
#pragma unroll
                for (int i = 0; i < 2; ++i) {
                    acc[i][j] = __builtin_amdgcn_mfma_f32_16x16x32_bf16(a[i], bh, acc[i][j], 0, 0, 0);
                    acc[i][j] = __builtin_amdgcn_mfma_f32_16x16x32_bf16(a[i], bl, acc[i][j], 0, 0, 0);
                    acc[i][j] = __builtin_amdgcn_mfma_f32_16x16x32_bf16(al[i], bh, acc[i][j], 0, 0, 0);
                }
            }
        }
        __syncthreads();
        if (kt + 1 < nk) {
            store_l();
            __syncthreads();
        }
    }
}


constexpr int ASTR = 72;
constexpr int BSTR = 136;
template <bool GATHER, bool PAIR>
__device__ __forceinline__ void gemm2(const bf16_t* __restrict__ A, int lda, const int* __restrict__ rowidx, int m0, int mrows,
                                      const bf16_t* __restrict__ B, int ldb, int n0, int ncols, int K, unsigned char* smem,
                                      f32x4 (&acc)[4][4]) {
    bf16_t* As = (bf16_t*)smem;
    bf16_t* Bs = As + 128 * ASTR;
    const int tid = threadIdx.x, lane = tid & 63, wave = tid >> 6, wm = wave >> 1, wn = wave & 1;
#pragma unroll
    for (int i = 0; i < 4; ++i)
#pragma unroll
        for (int j = 0; j < 4; ++j) acc[i][j] = (f32x4){0.f, 0.f, 0.f, 0.f};
    const int arl = tid >> 1, ahalf = tid & 1;
    const int arc = arl < mrows ? arl : mrows - 1;
    const long asrc = GATHER ? (long)rowidx[m0 + arc] : (long)(m0 + arc);
    const bf16_t* ap = A + (size_t)asrc * lda + ahalf * 32;
    const int brow = tid >> 2, bq = tid & 3;
    const bf16_t* bp = B + (size_t)brow * ldb + n0 + (PAIR ? bq * 16 : bq * 32);
    const int boff1 = 8, boff2 = PAIR ? 1024 : 16, boff3 = PAIR ? 1032 : 24;
    bf16_t* asd = As + arl * ASTR + ahalf * 32;
    bf16_t* bsd = Bs + brow * BSTR + bq * 32;
    uint4 a0, a1, a2, a3, b0, b1, b2, b3;
#define G2_LOAD(k0)                                                                                       \
    do {                                                                                                  \
        const bf16_t* ap_ = ap + (k0);                                                                    \
        a0 = *(const uint4*)(ap_); a1 = *(const uint4*)(ap_ + 8);                                         \
        a2 = *(const uint4*)(ap_ + 16); a3 = *(const uint4*)(ap_ + 24);                                   \
        const bf16_t* bp_ = bp + (size_t)(k0) * ldb;                                                      \
        b0 = *(const uint4*)(bp_); b1 = *(const uint4*)(bp_ + boff1);                                     \
        b2 = *(const uint4*)(bp_ + boff2); b3 = *(const uint4*)(bp_ + boff3);                             \
    } while (0)
#define G2_STORE()                                                                                        \
    do {                                                                                                  \
        *(uint4*)(asd) = a0; *(uint4*)(asd + 8) = a1; *(uint4*)(asd + 16) = a2; *(uint4*)(asd + 24) = a3; \
        *(uint4*)(bsd) = b0; *(uint4*)(bsd + 8) = b1; *(uint4*)(bsd + 16) = b2; *(uint4*)(bsd + 24) = b3; \
    } while (0)
    const int nk = K / 64;
    __syncthreads();
    G2_LOAD(0);
    G2_STORE();
    __syncthreads();
    const int fr = lane & 15, fq = lane >> 4;
    const bf16_t* afp = As + (wm * 64 + fr) * ASTR + fq * 8;
    const bf16_t* bfp = Bs + (8 * fq + (fr >> 2)) * BSTR + wn * 64 + 4 * (fr & 3);
    for (int kt = 0; kt < nk; ++kt) {
        if (kt + 1 < nk) G2_LOAD((kt + 1) * 64);
#pragma unroll
        for (int kh = 0; kh < 2; ++kh) {
            bf16x8 a[4], b[4];
#pragma unroll
            for (int i = 0; i < 4; ++i) a[i] = *(const bf16x8*)(afp + i * 16 * ASTR + kh * 32);
#pragma unroll
            for (int j = 0; j < 4; ++j) {
                const bf16_t* q = bfp + kh * 32 * BSTR + j * 16;
                const s16x4 lo4 = lds_tr16(q), hi4 = lds_tr16(q + 4 * BSTR);
                b[j] = (bf16x8){lo4[0], lo4[1], lo4[2], lo4[3], hi4[0], hi4[1], hi4[2], hi4[3]};
            }
#pragma unroll
            for (int i = 0; i < 4; ++i)
#pragma unroll
                for (int j = 0; j < 4; ++j) acc[i][j] = __builtin_amdgcn_mfma_f32_16x16x32_bf16(a[i], b[j], acc[i][j], 0, 0, 0);
        }
        __syncthreads();
        if (kt + 1 < nk) {
            G2_STORE();
            __syncthreads();
        }
    }
#undef G2_LOAD
#undef G2_STORE
}
#define G2_ROW(i, r) ((threadIdx.x >> 7) * 64 + (i) * 16 + 4 * ((threadIdx.x & 63) >> 4) + (r))
#define G2_COL(j) (((((threadIdx.x >> 6) & 1) * 4 + (j)) * 16) + (threadIdx.x & 15))

__device__ __forceinline__ void cvt_weights(const float* __restrict__ src, bf16_t* __restrict__ dst, size_t n, int bid, int nb) {
    const size_t n8 = n >> 3;
    for (size_t i = (size_t)bid * NT + threadIdx.x; i < n8; i += (size_t)nb * NT) {
        const float4 u = ((const float4*)src)[2 * i], v = ((const float4*)src)[2 * i + 1];
        uint4 o; o.x = pk2(u.x, u.y); o.y = pk2(u.z, u.w); o.z = pk2(v.x, v.y); o.w = pk2(v.z, v.w);
        ((uint4*)dst)[i] = o;
    }
}
__device__ __forceinline__ void phase_prep(const Params& p, int bid, int nb) {
    const int lane = threadIdx.x & 63, wave = threadIdx.x >> 6;
    if (bid == 0 && threadIdx.x < 64) ((int*)(p.ws + WS_CTL))[threadIdx.x] = 0;
    {
        const float* src_ = p.in[2];
        bf16_t* dst_ = (bf16_t*)(p.ws + WB_IN);
        constexpr int G8 = DIN / 8;
        for (size_t i = (size_t)bid * NT + threadIdx.x; i < (size_t)D * G8; i += (size_t)nb * NT) {
            const int k = (int)(i / G8), nc = (int)(i % G8) * 8;
            int oc;
            if (nc < 1280) oc = nc; else if (nc < 2816) oc = nc + 24; else if (nc < 3072) oc = nc + 24; else if (nc < 5120) oc = nc + 64;
            else if (nc < 5152) oc = nc - 5120 + 3096; else if (nc < 5176) oc = nc - 5152 + 1280; else oc = nc - 5176 + 3128;
            const float4 u = *(const float4*)(src_ + (size_t)k * DIN + oc), v = *(const float4*)(src_ + (size_t)k * DIN + oc + 4);
            uint4 o; o.x = pk2(u.x, u.y); o.y = pk2(u.z, u.w); o.z = pk2(v.x, v.y); o.w = pk2(v.z, v.w);
            *(uint4*)(dst_ + (size_t)k * DIN + nc) = o;
        }
    }
    cvt_weights(p.in[14], (bf16_t*)(p.ws + WB_A), (size_t)512 * D, bid, nb);
    cvt_weights(p.in[15], (bf16_t*)(p.ws + WB_B), (size_t)512 * D, bid, nb);
    cvt_weights(p.in[16], (bf16_t*)(p.ws + WB_OUT), (size_t)D * D, bid, nb);
    cvt_weights(p.in[26], (bf16_t*)(p.ws + WB_PLE), (size_t)256 * D, bid, nb);
    cvt_weights(p.in[1], (bf16_t*)(p.ws + WS_PB), (size_t)S * 256, bid, nb);
    cvt_weights(p.in[9], (bf16_t*)(p.ws + WB_CK1), (size_t)2048 * 64, bid, nb);
    cvt_weights(p.in[12], (bf16_t*)(p.ws + WB_CV1), (size_t)2048 * 64, bid, nb);
    const float* x = p.in[0];
    const float* g = p.in[3];
    bf16_t* hb = (bf16_t*)(p.ws + WS_HB);
    for (int t = bid * 4 + wave; t < S; t += nb * 4) {
        const float4* xr = (const float4*)(x + (size_t)t * D);
        float4 v[4];
        float ss = 0.f;
#pragma unroll
        for (int j = 0; j < 4; ++j) { v[j] = xr[lane + 64 * j]; ss += v[j].x * v[j].x + v[j].y * v[j].y + v[j].z * v[j].z + v[j].w * v[j].w; }
        ss = wave_sum(ss);
        const float rstd = rsqrtf(ss * (1.f / D) + EPS);
#pragma unroll
        for (int j = 0; j < 4; ++j) {
            const float4 gg = ((const float4*)g)[lane + 64 * j];
            uint2 o;
            o.x = pk2(v[j].x * rstd * gg.x, v[j].y * rstd * gg.y);
            o.y = pk2(v[j].z * rstd * gg.z, v[j].w * rstd * gg.w);
            ((uint2*)(hb + (size_t)t * D))[lane + 64 * j] = o;
        }
    }
}

__device__ __forceinline__ void phase_inproj(const Params& p, int bid, int nb, unsigned char* smem) {
    const bf16_t* hb = (const bf16_t*)(p.ws + WS_HB);
    const int lane = threadIdx.x & 63, fr = lane & 15;
    constexpr int NTN = (DIN + 127) / 128;
    for (int w = bid; w < 128 * NTN; w += nb) {
        const int mt = w % 128, nt = w / 128;
        const int m0 = mt * 128, n0 = nt * 128;
        const int ncols = (DIN - n0) < 128 ? (DIN - n0) : 128;
        f32x4 acc[4][4];
        gemm2<false, false>(hb, D, nullptr, m0, 128, (const bf16_t*)(p.ws + WB_IN), DIN, n0, ncols, D, smem, acc);
        const int cid = __builtin_amdgcn_readfirstlane((n0 >> 6) + ((threadIdx.x >> 6) & 1));
        if (cid > 80) continue;
        int kind; bf16_t* dst; int ld; const float* gain = nullptr; float scale = 1.f;
        if (cid < 8) { kind = 0; dst = (bf16_t*)(p.ws + WS_QNB) + cid * 64; ld = 512; gain = p.in[4]; scale = 0.125f * LOG2E; }
        else if (cid < 20) {
            const int j = cid - 8, kd = j >> 1, g = j & 1;
            ld = 64; kind = (kd == 2 || kd == 4) ? 0 : 1; gain = p.in[5];
            const size_t base = kd == 0 ? WS_KCR : kd == 1 ? WS_VCR : kd == 2 ? WS_KSLB : kd == 3 ? WS_VSLB : kd == 4 ? WS_KWNB : WS_VWNB;
            dst = (bf16_t*)(p.ws + base) + (size_t)g * S * 64;
        }
        else if (cid < 28) { kind = 0; dst = (bf16_t*)(p.ws + WS_DQB) + (cid - 20) * 64; ld = 512; gain = p.in[6]; scale = 0.125f * LOG2E; }
        else if (cid < 36) { kind = 0; dst = (bf16_t*)(p.ws + WS_DKB) + (cid - 28) * 64; ld = 512; gain = p.in[7]; }
        else if (cid < 44) { kind = 1; dst = (bf16_t*)(p.ws + WS_DVB) + (cid - 36) * 64; ld = 512; }
        else if (cid < 48) { kind = 1; dst = (bf16_t*)(p.ws + WS_IQB) + (cid - 44) * 64; ld = 256; scale = 0.17677669529663687f; }
        else if (cid < 64) { kind = 2; dst = (bf16_t*)(p.ws + WS_SGA) + (cid - 48) * 64; ld = D; }
        else if (cid < 80) { kind = 2; dst = (bf16_t*)(p.ws + WS_SGB) + (cid - 64) * 64; ld = D; }
        else { kind = 3; dst = nullptr; ld = 0; }
        if (kind == 0) {
            float gv[4];
#pragma unroll
            for (int j = 0; j < 4; ++j) gv[j] = gain[j * 16 + fr] * scale;
#pragma unroll
            for (int i = 0; i < 4; ++i)
#pragma unroll
                for (int r = 0; r < 4; ++r) {
                    float ss = acc[i][0][r] * acc[i][0][r] + acc[i][1][r] * acc[i][1][r] + acc[i][2][r] * acc[i][2][r] + acc[i][3][r] * acc[i][3][r];
                    ss += __shfl_xor(ss, 1); ss += __shfl_xor(ss, 2); ss += __shfl_xor(ss, 4); ss += __shfl_xor(ss, 8);
                    const float rstd = rsqrtf(ss * (1.f / 64.f) + EPS);
                    bf16_t* dr = dst + (size_t)(m0 + G2_ROW(i, r)) * ld + fr;
#pragma unroll
                    for (int j = 0; j < 4; ++j) dr[j * 16] = (bf16_t)f2bf(acc[i][j][r] * rstd * gv[j]);
                }
        } else if (kind == 1 || kind == 2) {
#pragma unroll
            for (int i = 0; i < 4; ++i)
#pragma unroll
                for (int r = 0; r < 4; ++r) {
                    bf16_t* dr = dst + (size_t)(m0 + G2_ROW(i, r)) * ld + fr;
#pragma unroll
                    for (int j = 0; j < 4; ++j) {
                        const float v = acc[i][j][r];
                        dr[j * 16] = (bf16_t)f2bf(kind == 2 ? sigmoidf_(v) : v * scale);
                    }
                }
        } else {
            bf16_t* ikb = (bf16_t*)(p.ws + WS_IKB);
            float* gt = (float*)(p.ws + WS_GT);
            float* iws = (float*)(p.ws + WS_IWS);
#pragma unroll
            for (int i = 0; i < 4; ++i)
#pragma unroll
                for (int r = 0; r < 4; ++r) {
                    const size_t t = (size_t)(m0 + G2_ROW(i, r));
                    ikb[t * 32 + fr] = (bf16_t)f2bf(acc[i][0][r]);
                    ikb[t * 32 + 16 + fr] = (bf16_t)f2bf(acc[i][1][r]);
                    gt[t * 32 + fr] = sigmoidf_(acc[i][2][r]);
                    if (fr < 8) gt[t * 32 + 16 + fr] = sigmoidf_(acc[i][3][r]);
                    else iws[t * 8 + fr - 8] = acc[i][3][r] * 0.35355339059327373f;
                }
        }
    }
}

__device__ __forceinline__ float rms64(float v) { return rsqrtf(wave_sum(v * v) * (1.f / 64.f) + EPS); }

__device__ __forceinline__ void phase_compress(const Params& p, int bid, int nb, unsigned char* smem) {
    const int tid = threadIdx.x, lane = tid & 63, wave = tid >> 6;
    float* cvec = (float*)(smem + 36864);
    float* hid = (float*)(smem + 36864 + 256);
    if (bid >= 32 && nb > 32) {
        bf16_t* pw = (bf16_t*)(p.ws + WS_PW);
        for (int w = bid - 32; w < 128 * 8; w += nb - 32) {
            const int mt = w % 128, nt = w / 128;
            const int m0 = mt * 128, n0 = nt * 128;
            f32x4 acc[4][4];
            gemm2<false, false>((const bf16_t*)(p.ws + WS_PB), 256, nullptr, m0, 128, (const bf16_t*)(p.ws + WB_PLE), D, n0, 128, 256, smem, acc);
#pragma unroll
            for (int i = 0; i < 4; ++i)
#pragma unroll
                for (int r = 0; r < 4; ++r) {
                    bf16_t* pr = pw + (size_t)(m0 + G2_ROW(i, r)) * D + n0 + G2_COL(0);
#pragma unroll
                    for (int j = 0; j < 4; ++j) pr[j * 16] = (bf16_t)f2bf(acc[i][j][r]);
                }
        }
    }
    for (int w = bid; w < 32; w += nb) {
        const int kind = w >> 4, g = (w >> 3) & 1, mt = w & 7;
        const bf16_t* raw = (const bf16_t*)(p.ws + (kind ? WS_VCR : WS_KCR)) + (size_t)g * S * 64;
        const bf16_t* w1b = (const bf16_t*)(p.ws + (kind ? WB_CV1 : WB_CK1));
        const float* pe = p.in[kind ? 11 : 8];
        const float* w1 = p.in[kind ? 12 : 9];
        const float* w2 = p.in[kind ? 13 : 10];
        const int m0 = mt * 128;
        const int mrows = (NCMP - m0) < 128 ? (NCMP - m0) : 128;
        f32x4 acc[4][4];
        gemm2<false, false>(raw, 16 * 64, nullptr, m0, mrows, w1b, 64, 0, 64, 2048, smem, acc);
        {
            const int e = tid & 63, part = tid >> 6;
            float s = 0.f;
            for (int k = part * 512; k < part * 512 + 512; ++k) s += pe[k] * w1[(size_t)k * 64 + e];
            hid[tid] = s;
            __syncthreads();
            if (tid < 64) cvec[tid] = hid[tid] + hid[64 + tid] + hid[128 + tid] + hid[192 + tid];
            __syncthreads();
        }
        if ((wave & 1) == 0) {
#pragma unroll
            for (int i = 0; i < 4; ++i)
#pragma unroll
                for (int j = 0; j < 4; ++j)
#pragma unroll
                    for (int r = 0; r < 4; ++r) {
                        const int row = G2_ROW(i, r), col = j * 16 + (lane & 15);
                        const float a = acc[i][j][r] + cvec[col];
                        hid[row * 65 + col] = a * sigmoidf_(a);
                    }
        }
        __syncthreads();
        const float gkn = p.in[5][lane];
        for (int row = wave; row < mrows; row += 4) {
            float o = 0.f;
#pragma unroll 8
            for (int e = 0; e < 64; ++e) o += hid[row * 65 + e] * w2[e * 64 + lane];
            if (kind == 0) o = o * rms64(o) * gkn;
            ((bf16_t*)(p.ws + (kind ? WS_VCB : WS_KCB)))[((size_t)g * 1024 + m0 + row) * 64 + lane] = (bf16_t)f2bf(o);
        }
        __syncthreads();
    }
    if (bid == nb - 1) {
        if (tid < 128) ((bf16_t*)(p.ws + WS_KCB))[((size_t)(tid >> 6) * 1024 + 1023) * 64 + (tid & 63)] = 0;
        else ((bf16_t*)(p.ws + WS_VCB))[((size_t)((tid - 128) >> 6) * 1024 + 1023) * 64 + (tid & 63)] = 0;
    }
}

constexpr int KSTR = 72;
constexpr int NSA_KT = 0;
constexpr int NSA_VT = NSA_KT + 32 * KSTR * 2;
constexpr int NSA_WV = NSA_VT + 32 * KSTR * 2;
constexpr int NSA_IMP = NSA_WV + 4 * 2 * 32 * KSTR * 2;
constexpr int NSA_LUT = NSA_IMP + 16 * 260 * 4;
constexpr int NSA_SEL = NSA_LUT + 4 * 128 * 4;
constexpr int NSA_STP = NSA_SEL + 16 * 16 * 4;
constexpr int NSA_END = NSA_STP + 4 * 128 * 4;
static_assert(NSA_END <= SMEM_BYTES, "nsa lds");

__device__ __forceinline__ f32x4 mfma16(bf16x8 a, bf16x8 b, f32x4 c) { return __builtin_amdgcn_mfma_f32_16x16x32_bf16(a, b, c, 0, 0, 0); }
__device__ __forceinline__ bf16x8 pack_p(const f32x4& p1, const f32x4& p2) {
    const unsigned a = pk2(p1[0], p1[1]), b = pk2(p1[2], p1[3]), c = pk2(p2[0], p2[1]), d = pk2(p2[2], p2[3]);
    return __builtin_bit_cast(bf16x8, make_uint4(a, b, c, d));
}
__device__ __forceinline__ void pv_step(f32x4 (&o)[4], const bf16_t* vt, bf16x8 pb, int fq, int fr) {
    const bf16_t* base = vt + (4 * fq + (fr >> 2)) * KSTR + 4 * (fr & 3);
#pragma unroll
    for (int dt = 0; dt < 4; ++dt) {
        const s16x4 lo4 = lds_tr16(base + dt * 16), hi4 = lds_tr16(base + 16 * KSTR + dt * 16);
        const bf16x8 va = (bf16x8){lo4[0], lo4[1], lo4[2], lo4[3], hi4[0], hi4[1], hi4[2], hi4[3]};
        o[dt] = mfma16(va, pb, o[dt]);
    }
}
__device__ __forceinline__ float quad_sum(float v) {
    v += __shfl_xor(v, 1);
    v += __shfl_xor(v, 2);
    return v;
}

__device__ __forceinline__ void nsa_tile(const Params& p, int tt, int g, unsigned char* smem) {
    const int tid = threadIdx.x, lane = tid & 63, wave = tid >> 6, fr = lane & 15, fq = lane >> 4;
    bf16_t* kt = (bf16_t*)(smem + NSA_KT);
    bf16_t* vt = (bf16_t*)(smem + NSA_VT);
    bf16_t* wv = (bf16_t*)(smem + NSA_WV) + wave * 2 * 32 * KSTR;
    float* imp = (float*)(smem + NSA_IMP);
    float* lut = (float*)(smem + NSA_LUT);
    int* sel = (int*)(smem + NSA_SEL);
    const bf16_t* qnb = (const bf16_t*)(p.ws + WS_QNB);
    const bf16_t* kslb = (const bf16_t*)(p.ws + WS_KSLB) + (size_t)g * S * 64;
    const bf16_t* vslb = (const bf16_t*)(p.ws + WS_VSLB) + (size_t)g * S * 64;
    const bf16_t* kwnb = (const bf16_t*)(p.ws + WS_KWNB) + (size_t)g * S * 64;
    const bf16_t* vwnb = (const bf16_t*)(p.ws + WS_VWNB) + (size_t)g * S * 64;
    const bf16_t* kcb = (const bf16_t*)(p.ws + WS_KCB) + (size_t)g * 1024 * 64;
    const bf16_t* vcb = (const bf16_t*)(p.ws + WS_VCB) + (size_t)g * 1024 * 64;
    const float* gt = (const float*)(p.ws + WS_GT);
    const float* relb = p.in[17];
    const int t0 = tt * 16;
    const int tl = 4 * wave + (fr >> 2);
    const int tok = t0 + tl;
    const int hl = fr & 3, head = g * 4 + hl;
    __syncthreads();
    for (int i = tid; i < 512; i += NT) { const int hh = i >> 7, n = i & 127; lut[i] = relb[bucket_of(n) * 16 + g * 4 + hh] * LOG2E; }
    for (int i = tid; i < 16 * 260; i += NT) imp[i] = 0.f;
    float U2;
    {
        const float mq = wave_max(fabsf(p.in[4][lane])), mk = wave_max(fabsf(p.in[5][lane]));
        float mb = 0.f;
#pragma unroll
        for (int k = 0; k < 4; ++k) { const int e = lane + 64 * k; mb = fmaxf(mb, fabsf(relb[(e >> 3) * 16 + (e & 7)])); }
        mb = wave_max(mb);
        U2 = (8.f * mq * mk + mb) * LOG2E;
    }
    bf16x8 qf[2];
#pragma unroll
    for (int kh = 0; kh < 2; ++kh) qf[kh] = *(const bf16x8*)(qnb + (size_t)tok * 512 + head * 64 + kh * 32 + fq * 8);
    __syncthreads();
    const float* lutp = lut + hl * 128;
    const float lutfar = lutp[127];
    const f32x4 zero4 = (f32x4){0.f, 0.f, 0.f, 0.f};
    f32x4 outacc[4];
#pragma unroll
    for (int dt = 0; dt < 4; ++dt) outacc[dt] = zero4;
    const float g0 = gt[(size_t)tok * 32 + head * 3 + 0], g1 = gt[(size_t)tok * 32 + head * 3 + 1], g2 = gt[(size_t)tok * 32 + head * 3 + 2];
    const int srow = tid >> 3, sch = tid & 7;

    {
        int ks0 = (t0 - 511) & ~31; ks0 = ks0 < 0 ? 0 : ks0;
        const int nsteps = (t0 + 16 - ks0 + 31) >> 5;
        f32x4 o[4];
#pragma unroll
        for (int dt = 0; dt < 4; ++dt) o[dt] = zero4;
        float lsum = 0.f;
        uint4 kreg = *(const uint4*)(kwnb + (size_t)(ks0 + srow) * 64 + sch * 8);
        uint4 vreg = *(const uint4*)(vwnb + (size_t)(ks0 + srow) * 64 + sch * 8);
#pragma unroll 1
        for (int st = 0; st < nsteps; ++st) {
            const int ks = ks0 + st * 32;
            *(uint4*)(kt + srow * KSTR + sch * 8) = kreg;
            *(uint4*)(vt + srow * KSTR + sch * 8) = vreg;
            __syncthreads();
            if (st + 1 < nsteps) {
                kreg = *(const uint4*)(kwnb + (size_t)(ks + 32 + srow) * 64 + sch * 8);
                vreg = *(const uint4*)(vwnb + (size_t)(ks + 32 + srow) * 64 + sch * 8);
            }
            f32x4 s1 = zero4, s2 = zero4;
#pragma unroll
            for (int kh = 0; kh < 2; ++kh) {
                const bf16x8 k1 = *(const bf16x8*)(kt + fr * KSTR + kh * 32 + fq * 8);
                const bf16x8 k2 = *(const bf16x8*)(kt + (16 + fr) * KSTR + kh * 32 + fq * 8);
                s1 = mfma16(k1, qf[kh], s1);
                s2 = mfma16(k2, qf[kh], s2);
            }
            const bool far = (t0 + 4 * wave) - (ks + 31) >= 113;
            f32x4 p1, p2;
#pragma unroll
            for (int r = 0; r < 4; ++r) {
                const int d1 = tok - (ks + 4 * fq + r), d2 = d1 - 16;
                const float b1 = far ? lutfar : lutp[d1 < 0 ? 0 : (d1 > 127 ? 127 : d1)];
                const float b2 = far ? lutfar : lutp[d2 < 0 ? 0 : (d2 > 127 ? 127 : d2)];
                p1[r] = (d1 >= 0 && d1 < 512) ? __builtin_amdgcn_exp2f(s1[r] + b1 - U2) : 0.f;
                p2[r] = (d2 >= 0 && d2 < 512) ? __builtin_amdgcn_exp2f(s2[r] + b2 - U2) : 0.f;
                lsum += p1[r] + p2[r];
            }
            pv_step(o, vt, pack_p(p1, p2), fq, fr);
            __syncthreads();
        }
        lsum += __shfl_xor(lsum, 16);
        lsum += __shfl_xor(lsum, 32);
        const float sc = lsum > 0.f ? g2 / lsum : 0.f;
#pragma unroll
        for (int dt = 0; dt < 4; ++dt)
#pragma unroll
            for (int r = 0; r < 4; ++r) outacc[dt][r] += sc * o[dt][r];
    }

    {
        const int tlast = t0 + 15;
        const int cmax = (tlast >= 31) ? ((tlast - 31) >> 4) + 1 : 0;
        const int nsteps = (cmax + 31) >> 5;
        float inv_l = 0.f;
#pragma unroll 1
        for (int pass = 0; pass < 2; ++pass) {
            f32x4 o[4];
#pragma unroll
            for (int dt = 0; dt < 4; ++dt) o[dt] = zero4;
            float lsum = 0.f;
            uint4 kreg = make_uint4(0, 0, 0, 0), vreg = kreg;
            if (nsteps > 0) {
                kreg = *(const uint4*)(kcb + (size_t)srow * 64 + sch * 8);
                vreg = *(const uint4*)(vcb + (size_t)srow * 64 + sch * 8);
            }
#pragma unroll 1
            for (int st = 0; st < nsteps; ++st) {
                const int cs = st * 32;
                *(uint4*)(kt + srow * KSTR + sch * 8) = kreg;
                *(uint4*)(vt + srow * KSTR + sch * 8) = vreg;
                __syncthreads();
                if (st + 1 < nsteps) {
                    kreg = *(const uint4*)(kcb + (size_t)(cs + 32 + srow) * 64 + sch * 8);
                    vreg = *(const uint4*)(vcb + (size_t)(cs + 32 + srow) * 64 + sch * 8);
                }
                f32x4 s1 = zero4, s2 = zero4;
#pragma unroll
                for (int kh = 0; kh < 2; ++kh) {
                    const bf16x8 k1 = *(const bf16x8*)(kt + fr * KSTR + kh * 32 + fq * 8);
                    const bf16x8 k2 = *(const bf16x8*)(kt + (16 + fr) * KSTR + kh * 32 + fq * 8);
                    s1 = mfma16(k1, qf[kh], s1);
                    s2 = mfma16(k2, qf[kh], s2);
                }
                const bool far = (t0 + 4 * wave) - (16 * (cs + 31) + 31) >= 113;
                f32x4 p1, p2;
#pragma unroll
                for (int r = 0; r < 4; ++r) {
                    const int d1 = tok - (16 * (cs + 4 * fq + r) + 31), d2 = d1 - 256;
                    const float b1 = far ? lutfar : lutp[d1 < 0 ? 0 : (d1 > 127 ? 127 : d1)];
                    const float b2 = far ? lutfar : lutp[d2 < 0 ? 0 : (d2 > 127 ? 127 : d2)];
                    p1[r] = (d1 >= 0) ? __builtin_amdgcn_exp2f(s1[r] + b1 - U2) : 0.f;
                    p2[r] = (d2 >= 0) ? __builtin_amdgcn_exp2f(s2[r] + b2 - U2) : 0.f;
                    lsum += p1[r] + p2[r];
                }
                if (pass == 1) {
#pragma unroll
                    for (int r = 0; r < 4; ++r) { p1[r] *= inv_l; p2[r] *= inv_l; }
                    f32x4 h1, h2;
#pragma unroll
                    for (int r = 0; r < 4; ++r) { h1[r] = quad_sum(p1[r]); h2[r] = quad_sum(p2[r]); }
                    if (hl == 0) {
                        float* ir = imp + tl * 260 + (cs >> 2) + fq;
                        atomicAdd(ir, h1[0] + h1[1] + h1[2] + 0.5f * h1[3]);
                        atomicAdd(ir + 1, 0.5f * h1[3]);
                        atomicAdd(ir + 4, h2[0] + h2[1] + h2[2] + 0.5f * h2[3]);
                        atomicAdd(ir + 5, 0.5f * h2[3]);
                    }
                    pv_step(o, vt, pack_p(p1, p2), fq, fr);
                }
                __syncthreads();
            }
            if (pass == 0) {
                lsum += __shfl_xor(lsum, 16);
                lsum += __shfl_xor(lsum, 32);
                inv_l = lsum > 0.f ? 1.f / lsum : 0.f;
            } else {
#pragma unroll
                for (int dt = 0; dt < 4; ++dt)
#pragma unroll
                    for (int r = 0; r < 4; ++r) outacc[dt][r] += g0 * o[dt][r];
            }
        }
    }
    __syncthreads();

#pragma unroll 1
    for (int tq = 0; tq < 4; ++tq) {
        const int tli = 4 * wave + tq, tk = t0 + tli, cur = tk >> 6;
        int* sl = sel + tli * 16;
        int nf = 0;
        if (lane == 0) {
            sl[0] = 0; int c_ = 1;
            if (cur - 1 >= 1) sl[c_++] = cur - 1;
            if (cur >= 1) sl[c_++] = cur;
            for (int k = c_; k < 16; ++k) sl[k] = -1;
        }
        nf = 1 + (cur - 1 >= 1 ? 1 : 0) + (cur >= 1 ? 1 : 0);
        const int ncand = cur - 2 > 0 ? cur - 2 : 0;
        int need = 16 - nf; need = need < ncand ? need : ncand;
        unsigned long long key[4];
#pragma unroll
        for (int k = 0; k < 4; ++k) {
            const int n = lane + 64 * k;
            const bool c = (n >= 1) && (n <= cur - 2);
            key[k] = c ? (((unsigned long long)__builtin_bit_cast(unsigned, imp[tli * 260 + n]) << 32) | (unsigned long long)(0xFFFFFFFFu - (unsigned)n)) + (1ull << 32) : 0ull;
        }
#pragma unroll 1
        for (int rd = 0; rd < need; ++rd) {
            unsigned long long m = key[0];
            m = key[1] > m ? key[1] : m; m = key[2] > m ? key[2] : m; m = key[3] > m ? key[3] : m;
#pragma unroll
            for (int o_ = 1; o_ < 64; o_ <<= 1) {
                const unsigned lo_ = __shfl_xor((unsigned)m, o_), hi_ = __shfl_xor((unsigned)(m >> 32), o_);
                const unsigned long long other = ((unsigned long long)hi_ << 32) | lo_;
                m = other > m ? other : m;
            }
            const int nstar = (int)(0xFFFFFFFFu - (unsigned)m);
#pragma unroll
            for (int k = 0; k < 4; ++k) if (key[k] == m) key[k] = 0ull;
            if (lane == 0) sl[nf + rd] = nstar;
        }
    }
    __syncthreads();

    {
        int* stp = (int*)(smem + NSA_STP) + wave * 128;
        int nst;
        {
            const int tq = lane >> 4, j = lane & 15;
            const int tk_ = t0 + 4 * wave + tq;
            const int b = sel[(4 * wave + tq) * 16 + j];
            const bool c1 = (b >= 0) && (b * 64 <= tk_), c2 = (b >= 0) && (b * 64 + 32 <= tk_);
            const unsigned long long m1 = __ballot(c1), m2 = __ballot(c2);
            const unsigned long long lt = (1ull << lane) - 1ull;
            const int pos = __builtin_popcountll(m1 & lt) + __builtin_popcountll(m2 & lt);
            if (c1) stp[pos] = (b * 64) | (tq << 20);
            if (c2) stp[pos + 1] = (b * 64 + 32) | (tq << 20);
            nst = __builtin_popcountll(m1) + __builtin_popcountll(m2);
        }
        asm volatile("" ::: "memory");
        uint2 oacc_pk[4];
#pragma unroll
        for (int dt = 0; dt < 4; ++dt) { oacc_pk[dt].x = pk2(outacc[dt][0], outacc[dt][1]); oacc_pk[dt].y = pk2(outacc[dt][2], outacc[dt][3]); }
        f32x4 o[4];
#pragma unroll
        for (int dt = 0; dt < 4; ++dt) o[dt] = zero4;
        float lsum = 0.f;
        const int vrow = lane >> 1, vhalf = lane & 1;
        bf16_t* slot0 = wv;
        bf16_t* slot1 = wv + 32 * KSTR;
        bf16x8 ka1[2], ka2[2], kb1[2], kb2[2];
        uint4 va0, va1, va2, va3;
#define SLC_STEP(i_) __builtin_amdgcn_readfirstlane(stp[(i_) < nst ? (i_) : nst - 1])
#define SLC_KLOAD(K1_, K2_, w_)                                                                                     \
        { const bf16_t* kp_ = kslb + (size_t)(((w_) & 0xFFFFF) + fr) * 64 + fq * 8;                                    \
          K1_[0] = *(const bf16x8*)(kp_); K1_[1] = *(const bf16x8*)(kp_ + 32);                                       \
          K2_[0] = *(const bf16x8*)(kp_ + 16 * 64); K2_[1] = *(const bf16x8*)(kp_ + 16 * 64 + 32); }
#define SLC_VLOAD(V_, w_)                                                                                           \
        { const uint4* vs_ = (const uint4*)(vslb + (size_t)(((w_) & 0xFFFFF) + vrow) * 64 + vhalf * 32);               \
          V_##0 = vs_[0]; V_##1 = vs_[1]; V_##2 = vs_[2]; V_##3 = vs_[3]; }
#define SLC_VSTORE(V_, slot_)                                                                                       \
        { uint4* vd_ = (uint4*)((slot_) + vrow * KSTR + vhalf * 32); vd_[0] = V_##0; vd_[1] = V_##1; vd_[2] = V_##2; vd_[3] = V_##3; }
#define SLC_STAGE(s_, K1_, K2_, VW_, slotr_, slotw_)                                                                \
        {                                                                                                           \
            const int wcur = SLC_STEP(s_), wk = SLC_STEP((s_) + 2), wvn = wk;                                       \
            SLC_VSTORE(VW_, slotw_)                                                      \
            SLC_VLOAD(VW_, wvn)                                                                    \
            f32x4 s1 = zero4, s2 = zero4;                                                                           \
            s1 = mfma16(K1_[0], qf[0], s1); s2 = mfma16(K2_[0], qf[0], s2);                                         \
            s1 = mfma16(K1_[1], qf[1], s1); s2 = mfma16(K2_[1], qf[1], s2);                                         \
            asm volatile("" : "+v"(s1), "+v"(s2));                                                                  \
            SLC_KLOAD(K1_, K2_, wk)                                                                \
            const int ks = wcur & 0xFFFFF, tq = wcur >> 20, tk = t0 + 4 * wave + tq;                                \
            const bool mine = (fr >> 2) == tq;                                                                      \
            const bool far = tk - (ks + 31) >= 113;                                                                 \
            f32x4 p1, p2;                                                                                           \
            _Pragma("unroll") for (int r = 0; r < 4; ++r) {                                                         \
                const int d1 = tk - (ks + 4 * fq + r), d2 = d1 - 16;                                                \
                const float b1 = far ? lutfar : lutp[d1 < 0 ? 0 : (d1 > 127 ? 127 : d1)];                           \
                const float b2 = far ? lutfar : lutp[d2 < 0 ? 0 : (d2 > 127 ? 127 : d2)];                           \
                p1[r] = (mine && d1 >= 0) ? __builtin_amdgcn_exp2f(s1[r] + b1 - U2) : 0.f;                          \
                p2[r] = (mine && d2 >= 0) ? __builtin_amdgcn_exp2f(s2[r] + b2 - U2) : 0.f;                          \
                lsum += p1[r] + p2[r];                                                                              \
            }                                                                                                       \
            asm volatile("" ::: "memory");                                                                          \
            pv_step(o, slotr_, pack_p(p1, p2), fq, fr);                                                             \
            asm volatile("" ::: "memory");                                                                          \
        }
        {
            const int w0 = SLC_STEP(0), w1 = SLC_STEP(1);
            SLC_VLOAD(va, w0)
            SLC_KLOAD(ka1, ka2, w0)
            SLC_KLOAD(kb1, kb2, w1)
            SLC_VSTORE(va, slot0)
            SLC_VLOAD(va, w1)
        }
#pragma unroll 1
        for (int s = 0; s < nst; s += 2) {
            SLC_STAGE(s, ka1, ka2, va, slot0, slot1)
            if (s + 1 < nst) SLC_STAGE(s + 1, kb1, kb2, va, slot1, slot0)
        }
#undef SLC_STEP
#undef SLC_KLOAD
#undef SLC_VLOAD
#undef SLC_VSTORE
#undef SLC_STAGE
        lsum += __shfl_xor(lsum, 16);
        lsum += __shfl_xor(lsum, 32);
        const float sc = lsum > 0.f ? g1 / lsum : 0.f;
#pragma unroll
        for (int dt = 0; dt < 4; ++dt) {
            outacc[dt][0] = __builtin_bit_cast(float, oacc_pk[dt].x << 16) + sc * o[dt][0];
            outacc[dt][1] = __builtin_bit_cast(float, oacc_pk[dt].x & 0xffff0000u) + sc * o[dt][1];
            outacc[dt][2] = __builtin_bit_cast(float, oacc_pk[dt].y << 16) + sc * o[dt][2];
            outacc[dt][3] = __builtin_bit_cast(float, oacc_pk[dt].y & 0xffff0000u) + sc * o[dt][3];
        }
    }
    bf16_t* orow = (bf16_t*)(p.ws + WS_OA) + (size_t)tok * 512 + head * 64 + 4 * fq;
#pragma unroll
    for (int dt = 0; dt < 4; ++dt) {
        uint2 v; v.x = pk2(outacc[dt][0], outacc[dt][1]); v.y = pk2(outacc[dt][2], outacc[dt][3]);
        *(uint2*)(orow + dt * 16) = v;
    }
}

typedef float f32x16 __attribute__((ext_vector_type(16)));
constexpr int DSA_CK = 0;
constexpr int DSA_CI = DSA_CK + 16 * 512 * 4;
constexpr int DSA_LUT = DSA_CI + 16 * 512 * 2;
constexpr int DSA_END = DSA_LUT + 8 * 128 * 4;
static_assert(DSA_END <= SMEM_BYTES, "dsa lds");

__device__ __forceinline__ unsigned mono_key(float s) {
    const unsigned u = __builtin_bit_cast(unsigned, s + 0.0f);
    return (u & 0x80000000u) ? ~u : (u | 0x80000000u);
}
__device__ __forceinline__ unsigned dsa_compact(unsigned* ck, unsigned short* ci, int n, int lane) {
    unsigned kk[8]; unsigned ii[8];
#pragma unroll
    for (int k = 0; k < 8; ++k) { const int e = lane + 64 * k; kk[k] = e < n ? ck[e] : 0u; ii[k] = e < n ? (unsigned)ci[e] : 0xFFFFu; }
    unsigned T = 0;
#pragma unroll 1
    for (int b = 31; b >= 0; --b) {
        const unsigned cand = T | (1u << b);
        int c = 0;
#pragma unroll
        for (int k = 0; k < 8; ++k) c += __builtin_popcountll(__ballot(kk[k] >= cand));
        if (c >= 256) T = cand;
    }
    int cgt = 0, ceq = 0;
#pragma unroll
    for (int k = 0; k < 8; ++k) { cgt += __builtin_popcountll(__ballot(kk[k] > T)); ceq += __builtin_popcountll(__ballot(kk[k] == T)); }
    const int need = 256 - cgt;
    unsigned X = 0xFFFFu;
    if (ceq > need) {
        X = 0;
#pragma unroll 1
        for (int b = 15; b >= 0; --b) {
            const unsigned cand = X | (1u << b);
            int c = 0;
#pragma unroll
            for (int k = 0; k < 8; ++k) c += __builtin_popcountll(__ballot(kk[k] == T && ii[k] < cand));
            if (c < need) X = cand;
        }
    }
    int base = 0;
    const unsigned long long lt = (1ull << lane) - 1ull;
#pragma unroll
    for (int k = 0; k < 8; ++k) {
        const bool keep = (kk[k] > T) || (kk[k] == T && ii[k] <= X);
        const unsigned long long m = __ballot(keep);
        if (keep) { const int pos = base + __builtin_popcountll(m & lt); ck[pos] = kk[k]; ci[pos] = (unsigned short)ii[k]; }
        base += __builtin_popcountll(m);
    }
    return T;
}

__device__ __forceinline__ void dsa_tile(const Params& p, int tt, unsigned char* smem) {
    const int tid = threadIdx.x, lane = tid & 63, wave = tid >> 6, col = lane & 31, hi = lane >> 5;
    unsigned* ckb = (unsigned*)(smem + DSA_CK);
    unsigned short* cib = (unsigned short*)(smem + DSA_CI);
    const bf16_t* iqb = (const bf16_t*)(p.ws + WS_IQB);
    const bf16_t* ikb = (const bf16_t*)(p.ws + WS_IKB);
    const float* iws = (const float*)(p.ws + WS_IWS);
    const int t0 = tt * 16;
    __syncthreads();
    const int tw = t0 + 4 * wave;
    bf16x8 af[2];
    {
        const int rho = col;
        const int tl_ = 2 * ((rho >> 2) & 1) + (rho >> 4), hd = 4 * ((rho >> 3) & 1) + (rho & 3);
#pragma unroll
        for (int ks = 0; ks < 2; ++ks) af[ks] = *(const bf16x8*)(iqb + (size_t)(tw + tl_) * 256 + hd * 32 + ks * 16 + hi * 8);
    }
    const int tokA = tw + 2 * hi, tokB = tokA + 1;
    float wA[8], wB[8];
#pragma unroll
    for (int h = 0; h < 8; ++h) { wA[h] = iws[(size_t)tokA * 8 + h]; wB[h] = iws[(size_t)tokB * 8 + h]; }
    unsigned* ckA = ckb + (4 * wave + 2 * hi) * 512;
    unsigned* ckB = ckA + 512;
    unsigned short* ciA = cib + (4 * wave + 2 * hi) * 512;
    unsigned short* ciB = ciA + 512;
    int cntA = 0, cntB = 0;
    unsigned LA = 0, LB = 0;
    const unsigned ltm = (1u << col) - 1u;
    const int nchunk = (tw + 4 + 31) >> 5;
    const f32x16 zero16 = {0.f, 0.f, 0.f, 0.f, 0.f, 0.f, 0.f, 0.f, 0.f, 0.f, 0.f, 0.f, 0.f, 0.f, 0.f, 0.f};
    bf16x8 nx0[4], nx1[4];
    const bf16_t* ikl = ikb + (size_t)col * 32 + hi * 8;
#pragma unroll
    for (int j = 0; j < 4; ++j) {
        const int cj = j < nchunk ? j : nchunk - 1;
        nx0[j] = *(const bf16x8*)(ikl + (size_t)cj * 1024); nx1[j] = *(const bf16x8*)(ikl + (size_t)cj * 1024 + 16);
    }
#pragma unroll 1
    for (int ch4 = 0; ch4 < nchunk; ch4 += 4) {
        bf16x8 cu0[4], cu1[4];
#pragma unroll
        for (int j = 0; j < 4; ++j) { cu0[j] = nx0[j]; cu1[j] = nx1[j]; }
#pragma unroll
        for (int j = 0; j < 4; ++j) {
            int cj = ch4 + 4 + j; cj = cj < nchunk ? cj : nchunk - 1;
            nx0[j] = *(const bf16x8*)(ikl + (size_t)cj * 1024); nx1[j] = *(const bf16x8*)(ikl + (size_t)cj * 1024 + 16);
        }
#pragma unroll
        for (int j = 0; j < 4; ++j) {
            const int ch = ch4 + j;
            if (ch < nchunk) {
                const int kidx = ch * 32 + col;
                f32x16 c = __builtin_amdgcn_mfma_f32_32x32x16_bf16(af[0], cu0[j], zero16, 0, 0, 0);
                c = __builtin_amdgcn_mfma_f32_32x32x16_bf16(af[1], cu1[j], c, 0, 0, 0);
                float sA = 0.f, sB = 0.f;
#pragma unroll
                for (int h = 0; h < 8; ++h) { sA += wA[h] * fmaxf(c[h], 0.f); sB += wB[h] * fmaxf(c[8 + h], 0.f); }
                const unsigned keyA = mono_key(sA), keyB = mono_key(sB);
                const bool pA = (kidx <= tokA) && (keyA > LA), pB = (kidx <= tokB) && (keyB > LB);
                const unsigned long long mA = __ballot(pA), mB = __ballot(pB);
                const unsigned hA = hi ? (unsigned)(mA >> 32) : (unsigned)mA, hB = hi ? (unsigned)(mB >> 32) : (unsigned)mB;
                if (pA) { const int pos = cntA + __builtin_popcount(hA & ltm); ckA[pos] = keyA; ciA[pos] = (unsigned short)kidx; }
                if (pB) { const int pos = cntB + __builtin_popcount(hB & ltm); ckB[pos] = keyB; ciB[pos] = (unsigned short)kidx; }
                cntA += __builtin_popcount(hA); cntB += __builtin_popcount(hB);
            }
        }
        if (__any((cntA > 384) || (cntB > 384))) {
#pragma unroll
            for (int tq = 0; tq < 4; ++tq) {
                const int cn = __shfl((tq & 1) ? cntB : cntA, (tq >> 1) * 32);
                if (cn > 384) {
                    const unsigned T = dsa_compact(ckb + (4 * wave + tq) * 512, cib + (4 * wave + tq) * 512, cn, lane);
                    if (hi == (tq >> 1)) { if (tq & 1) { cntB = 256; LB = T; } else { cntA = 256; LA = T; } }
                }
            }
        }
    }
#pragma unroll
    for (int tq = 0; tq < 4; ++tq) {
        const int cn = __shfl((tq & 1) ? cntB : cntA, (tq >> 1) * 32);
        if (cn > 256) {
            (void)dsa_compact(ckb + (4 * wave + tq) * 512, cib + (4 * wave + tq) * 512, cn, lane);
            if (hi == (tq >> 1)) { if (tq & 1) cntB = 256; else cntA = 256; }
        }
    }
    unsigned short* selg = (unsigned short*)(p.ws + WS_SEL);
    int* nselg = (int*)(p.ws + WS_NSEL);
#pragma unroll
    for (int tq = 0; tq < 4; ++tq) {
        int nsel = __shfl((tq & 1) ? cntB : cntA, (tq >> 1) * 32);
        nsel = nsel > 256 ? 256 : nsel;
        const unsigned short* sl = cib + (4 * wave + tq) * 512;
#pragma unroll
        for (int k = 0; k < 4; ++k) { const int e = lane + 64 * k; selg[(size_t)(tw + tq) * 256 + e] = e < nsel ? sl[e] : (unsigned short)0; }
        if (lane == 0) nselg[tw + tq] = nsel;
    }
}

__device__ __forceinline__ void phase_dsa_attn(const Params& p, int bid, int nb, unsigned char* smem) {
    const int tid = threadIdx.x, lane = tid & 63, wave = tid >> 6, slot = lane >> 3, chunk = lane & 7;
    float* lut = (float*)smem;
    const bf16_t* dqb = (const bf16_t*)(p.ws + WS_DQB);
    const bf16_t* dkb = (const bf16_t*)(p.ws + WS_DKB);
    const bf16_t* dvb = (const bf16_t*)(p.ws + WS_DVB);
    const unsigned short* selg = (const unsigned short*)(p.ws + WS_SEL);
    const int* nselg = (const int*)(p.ws + WS_NSEL);
    const float* relb = p.in[17];
    const int h = bid & 7, bh = bid >> 3, nbh = nb >> 3;
    __syncthreads();
    if (tid < 128) lut[tid] = relb[bucket_of(tid) * 16 + 8 + h] * LOG2E;
    float U2;
    {
        const float mq = wave_max(fabsf(p.in[6][lane])), mk = wave_max(fabsf(p.in[7][lane]));
        float mb = 0.f;
#pragma unroll
        for (int k = 0; k < 4; ++k) { const int e = lane + 64 * k; mb = fmaxf(mb, fabsf(relb[(e >> 3) * 16 + 8 + (e & 7)])); }
        mb = wave_max(mb);
        U2 = (8.f * mq * mk + mb) * LOG2E;
    }
    __syncthreads();
    const bf16_t* kbase = dkb + h * 64 + chunk * 8;
    const bf16_t* vbase = dvb + h * 64 + chunk * 8;
#pragma unroll 1
    for (int t = bh * 4 + wave; t < S; t += nbh * 4) {
        const int nsel = nselg[t];
        const uint2* ip = (const uint2*)(selg + (size_t)t * 256 + slot * 32);
        float q[8];
        {
            const uint4 qv = *(const uint4*)(dqb + (size_t)t * 512 + h * 64 + chunk * 8);
            q[0] = __builtin_bit_cast(float, qv.x << 16); q[1] = __builtin_bit_cast(float, qv.x & 0xffff0000u);
            q[2] = __builtin_bit_cast(float, qv.y << 16); q[3] = __builtin_bit_cast(float, qv.y & 0xffff0000u);
            q[4] = __builtin_bit_cast(float, qv.z << 16); q[5] = __builtin_bit_cast(float, qv.z & 0xffff0000u);
            q[6] = __builtin_bit_cast(float, qv.w << 16); q[7] = __builtin_bit_cast(float, qv.w & 0xffff0000u);
        }
        float o[8];
#pragma unroll
        for (int j = 0; j < 8; ++j) o[j] = 0.f;
        float lsum = 0.f;
        int sA_[4], sB_[4];
        uint4 kA_[4], vA_[4], kB_[4], vB_[4];
        uint2 idn = ip[0];
#define DSA_LOADG(S_, K_, V_, I_)                                                        \
        S_[0] = (int)((I_).x & 0xffffu); S_[1] = (int)((I_).x >> 16); S_[2] = (int)((I_).y & 0xffffu); S_[3] = (int)((I_).y >> 16); \
        _Pragma("unroll") for (int j = 0; j < 4; ++j) {                                 \
            K_[j] = *(const uint4*)(kbase + (size_t)S_[j] * 512);                        \
            V_[j] = *(const uint4*)(vbase + (size_t)S_[j] * 512);                        \
        }
#define DSA_COMPG(S_, K_, V_, gi)                                                        \
        _Pragma("unroll") for (int j = 0; j < 4; ++j) {                                 \
            const uint4 kv = K_[j], vv = V_[j];                                          \
            float d = q[0] * __builtin_bit_cast(float, kv.x << 16) + q[1] * __builtin_bit_cast(float, kv.x & 0xffff0000u) \
                    + q[2] * __builtin_bit_cast(float, kv.y << 16) + q[3] * __builtin_bit_cast(float, kv.y & 0xffff0000u) \
                    + q[4] * __builtin_bit_cast(float, kv.z << 16) + q[5] * __builtin_bit_cast(float, kv.z & 0xffff0000u) \
                    + q[6] * __builtin_bit_cast(float, kv.w << 16) + q[7] * __builtin_bit_cast(float, kv.w & 0xffff0000u); \
            d += __shfl_xor(d, 1); d += __shfl_xor(d, 2); d += __shfl_xor(d, 4);       \
            int dist = t - S_[j]; dist = dist > 127 ? 127 : (dist < 0 ? 0 : dist);       \
            float pr = __builtin_amdgcn_exp2f(d + lut[dist] - U2);                       \
            pr = (slot * 32 + (gi) * 4 + j < nsel) ? pr : 0.f;                           \
            lsum += pr;                                                                  \
            o[0] += pr * __builtin_bit_cast(float, vv.x << 16); o[1] += pr * __builtin_bit_cast(float, vv.x & 0xffff0000u); \
            o[2] += pr * __builtin_bit_cast(float, vv.y << 16); o[3] += pr * __builtin_bit_cast(float, vv.y & 0xffff0000u); \
            o[4] += pr * __builtin_bit_cast(float, vv.z << 16); o[5] += pr * __builtin_bit_cast(float, vv.z & 0xffff0000u); \
            o[6] += pr * __builtin_bit_cast(float, vv.w << 16); o[7] += pr * __builtin_bit_cast(float, vv.w & 0xffff0000u); \
        }
        DSA_LOADG(sA_, kA_, vA_, idn)
        idn = ip[1];
#pragma unroll 1
        for (int gi = 0; gi < 8; gi += 2) {
            DSA_LOADG(sB_, kB_, vB_, idn)
            idn = ip[gi + 2 < 8 ? gi + 2 : 7];
            DSA_COMPG(sA_, kA_, vA_, gi)
            DSA_LOADG(sA_, kA_, vA_, idn)
            idn = ip[gi + 3 < 8 ? gi + 3 : 7];
            DSA_COMPG(sB_, kB_, vB_, gi + 1)
        }
#undef DSA_LOADG
#undef DSA_COMPG
#pragma unroll
        for (int j = 0; j < 8; ++j) { o[j] += __shfl_xor(o[j], 8); o[j] += __shfl_xor(o[j], 16); o[j] += __shfl_xor(o[j], 32); }
        lsum += __shfl_xor(lsum, 8); lsum += __shfl_xor(lsum, 16); lsum += __shfl_xor(lsum, 32);
        if (slot == 0) {
            const float inv = lsum > 0.f ? 1.f / lsum : 0.f;
            uint4 ov;
            ov.x = pk2(o[0] * inv, o[1] * inv); ov.y = pk2(o[2] * inv, o[3] * inv); ov.z = pk2(o[4] * inv, o[5] * inv); ov.w = pk2(o[6] * inv, o[7] * inv);
            *(uint4*)((bf16_t*)(p.ws + WS_OB) + (size_t)t * 512 + h * 64 + chunk * 8) = ov;
        }
    }
}

__device__ __forceinline__ void convert_late_weights(const Params& p, int bid, int nb) {
    cvt_weights(p.in[21], (bf16_t*)(p.ws + WB_E1), (size_t)NEXP * D * 2 * DFF, bid, nb);
    cvt_weights(p.in[23], (bf16_t*)(p.ws + WB_E2), (size_t)NEXP * DFF * D, bid, nb);
    cvt_weights(p.in[27], (bf16_t*)(p.ws + WB_PLEG), (size_t)D * D, bid, nb);
}
__device__ __forceinline__ void phase_attn(const Params& p, int bid, int nb, unsigned char* smem) {
    const bool conv_first = bid < (nb >> 1);
    if (conv_first) convert_late_weights(p, bid, nb);
#pragma unroll 1
    for (int part = 0; part < 2; ++part) {
        if ((part == 0) == conv_first) {
#pragma unroll 1
        for (int w = bid, rd = 0; w < 1024; w += nb, ++rd) {
            const int r0 = w - bid;
            const int cnt = (1024 - r0) < nb ? (1024 - r0) : nb;
            const int k = (rd & 1) ? (cnt - 1 - bid) : bid;
            dsa_tile(p, 1023 - (r0 + k), smem);
        }
    }
        else {
#pragma unroll 1
        for (int i = bid, rd = 0; i < 2048; i += nb, ++rd) {
            const int r0 = i - bid;
            const int cnt = (2048 - r0) < nb ? (2048 - r0) : nb;
            const int k = ((rd & 1) && !(cnt & 1)) ? 2 * ((cnt >> 1) - 1 - (bid >> 1)) + (bid & 1) : bid;
            const int j = r0 + k;
            nsa_tile(p, 1023 - (j >> 1), j & 1, smem);
        }
    }
    }
    if (!conv_first) convert_late_weights(p, bid, nb);
}

template <int PASS>
__device__ __forceinline__ void phase_merge(const Params& p, int bid, int nb, unsigned char* smem) {
    const bf16_t* sg = (const bf16_t*)(p.ws + (PASS ? WS_SGB : WS_SGA));
    bf16_t* merged = (bf16_t*)(p.ws + WS_MERGED);
    float* tmp = (float*)(p.ws + WS_X1);
    const bf16_t* A = (const bf16_t*)(p.ws + (PASS ? WS_OB : WS_OA));
    const bf16_t* Bw = (const bf16_t*)(p.ws + (PASS ? WB_B : WB_A));
    for (int w = bid; w < 128 * 8; w += nb) {
        const int mt = w % 128, nt = w / 128;
        const int m0 = mt * 128, n0 = nt * 128;
        f32x4 acc[4][4];
        gemm2<false, false>(A, 512, nullptr, m0, 128, Bw, D, n0, 128, 512, smem, acc);
#pragma unroll
        for (int i = 0; i < 4; ++i)
#pragma unroll
            for (int r = 0; r < 4; ++r) {
                const int row = m0 + G2_ROW(i, r);
                const bf16_t* zr = sg + (size_t)row * D + n0 + G2_COL(0);
                float* tr = tmp + (size_t)row * D + n0 + G2_COL(0);
                bf16_t* mr = merged + (size_t)row * D + n0 + G2_COL(0);
#pragma unroll
                for (int j = 0; j < 4; ++j) {
                    const float v = bf2f(zr[j * 16]) * acc[i][j][r];
                    if (PASS == 0) tr[j * 16] = v;
                    else mr[j * 16] = (bf16_t)f2bf(tr[j * 16] + v);
                }
            }
    }
}

__device__ __forceinline__ void phase_outproj(const Params& p, int bid, int nb, unsigned char* smem) {
    const bf16_t* merged = (const bf16_t*)(p.ws + WS_MERGED);
    const float* x = p.in[0];
    float* x1 = (float*)(p.ws + WS_X1);
    for (int w = bid; w < 128 * 8; w += nb) {
        const int mt = w % 128, nt = w / 128;
        const int m0 = mt * 128, n0 = nt * 128;
        f32x4 acc[4][4];
        gemm2<false, false>(merged, D, nullptr, m0, 128, (const bf16_t*)(p.ws + WB_OUT), D, n0, 128, D, smem, acc);
#pragma unroll
        for (int i = 0; i < 4; ++i)
#pragma unroll
            for (int r = 0; r < 4; ++r) {
                const size_t ro = (size_t)(m0 + G2_ROW(i, r)) * D + n0;
#pragma unroll
                for (int j = 0; j < 4; ++j) { const int c = G2_COL(j); x1[ro + c] = x[ro + c] + acc[i][j][r]; }
            }
    }
}

__device__ __forceinline__ void phase_route(const Params& p, int bid, int nb) {
    const int lane = threadIdx.x & 63, wave = threadIdx.x >> 6;
    const float* x1 = (const float*)(p.ws + WS_X1);
    const float* g = p.in[18];
    const float* wr = p.in[19];
    const float* br = p.in[20];
    bf16_t* hb = (bf16_t*)(p.ws + WS_HB);
    int* topi = (int*)(p.ws + WS_TOPI);
    float* topw = (float*)(p.ws + WS_TOPW);
    int* cnt = (int*)(p.ws + WS_CTL);
    for (int t = bid * 4 + wave; t < S; t += nb * 4) {
        const float4* xr = (const float4*)(x1 + (size_t)t * D);
        float4 v[4];
        float ss = 0.f;
#pragma unroll
        for (int j = 0; j < 4; ++j) { v[j] = xr[lane + 64 * j]; ss += v[j].x * v[j].x + v[j].y * v[j].y + v[j].z * v[j].z + v[j].w * v[j].w; }
        ss = wave_sum(ss);
        const float rstd = rsqrtf(ss * (1.f / D) + EPS);
        float lg[32];
#pragma unroll
        for (int e = 0; e < 32; ++e) lg[e] = 0.f;
#pragma unroll
        for (int j = 0; j < 4; ++j) {
            const float4 gg = ((const float4*)g)[lane + 64 * j];
            const float h0 = v[j].x * rstd * gg.x, h1 = v[j].y * rstd * gg.y, h2 = v[j].z * rstd * gg.z, h3 = v[j].w * rstd * gg.w;
            uint2 o; o.x = pk2(h0, h1); o.y = pk2(h2, h3);
            ((uint2*)(hb + (size_t)t * D))[lane + 64 * j] = o;
            const int k = 4 * (lane + 64 * j);
            const float4* w0 = (const float4*)(wr + (size_t)k * 32);
#pragma unroll
            for (int e4 = 0; e4 < 8; ++e4) {
                const float4 a = w0[e4], b = w0[8 + e4], c = w0[16 + e4], d = w0[24 + e4];
                lg[4 * e4 + 0] += h0 * a.x + h1 * b.x + h2 * c.x + h3 * d.x;
                lg[4 * e4 + 1] += h0 * a.y + h1 * b.y + h2 * c.y + h3 * d.y;
                lg[4 * e4 + 2] += h0 * a.z + h1 * b.z + h2 * c.z + h3 * d.z;
                lg[4 * e4 + 3] += h0 * a.w + h1 * b.w + h2 * c.w + h3 * d.w;
            }
        }
#pragma unroll
        for (int e = 0; e < 32; ++e) lg[e] = wave_sum(lg[e]) + br[e];
        int idx[4]; float val[4];
        unsigned used = 0;
#pragma unroll
        for (int k = 0; k < 4; ++k) {
            float best = -__builtin_inff(); int bi = 0;
#pragma unroll
            for (int e = 0; e < 32; ++e) { const bool ok = !((used >> e) & 1u) && (lg[e] > best); best = ok ? lg[e] : best; bi = ok ? e : bi; }
            idx[k] = bi; val[k] = best; used |= 1u << bi;
        }
        const float e0 = 1.f, e1 = __expf(val[1] - val[0]), e2 = __expf(val[2] - val[0]), e3 = __expf(val[3] - val[0]);
        const float inv = 1.f / (e0 + e1 + e2 + e3);
        if (lane == 0) {
            topi[t * 4 + 0] = idx[0]; topi[t * 4 + 1] = idx[1]; topi[t * 4 + 2] = idx[2]; topi[t * 4 + 3] = idx[3];
            topw[t * 4 + 0] = e0 * inv; topw[t * 4 + 1] = e1 * inv; topw[t * 4 + 2] = e2 * inv; topw[t * 4 + 3] = e3 * inv;
            atomicAdd(&cnt[idx[0]], 1); atomicAdd(&cnt[idx[1]], 1); atomicAdd(&cnt[idx[2]], 1); atomicAdd(&cnt[idx[3]], 1);
        }
    }
}

__device__ __forceinline__ void phase_place(const Params& p, int bid, int nb, unsigned char* smem) {
    int* off = (int*)smem;
    const int* cnt = (const int*)(p.ws + WS_CTL);
    int* cur = (int*)(p.ws + WS_CTL) + 32;
    const int* topi = (const int*)(p.ws + WS_TOPI);
    int* ppos = (int*)(p.ws + WS_PPOS);
    int* rowtok = (int*)(p.ws + WS_ROWTOK);
    __syncthreads();
    if (threadIdx.x == 0) { int a = 0; for (int e = 0; e < NEXP; ++e) { off[e] = a; a += cnt[e]; } }
    __syncthreads();
    for (int i = bid * NT + threadIdx.x; i < S * 4; i += nb * NT) {
        const int e = topi[i];
        const int pos = off[e] + atomicAdd(&cur[e], 1);
        ppos[i] = pos;
        rowtok[pos] = i >> 2;
    }
}

__device__ __forceinline__ void moe_tile_map(const int* cnt, int* sm, int& total_mt) {
    __syncthreads();
    if (threadIdx.x == 0) {
        int a = 0, b = 0;
        for (int e = 0; e < NEXP; ++e) { sm[e] = a; sm[33 + e] = b; a += (cnt[e] + 127) >> 7; b += cnt[e]; }
        sm[32] = a; sm[65] = b;
    }
    __syncthreads();
    total_mt = sm[32];
}
__device__ __forceinline__ void phase_moe1(const Params& p, int bid, int nb, unsigned char* smem) {
    int* sm = (int*)(smem + 65536);
    const int* cnt = (const int*)(p.ws + WS_CTL);
    const int* rowtok = (const int*)(p.ws + WS_ROWTOK);
    const bf16_t* hb = (const bf16_t*)(p.ws + WS_HB);
    bf16_t* act = (bf16_t*)(p.ws + WS_ACT);
    const int lane = threadIdx.x & 63, wave = threadIdx.x >> 6;
    int total_mt;
    moe_tile_map(cnt, sm, total_mt);
    for (int w = bid; w < total_mt * 16; w += nb) {
        const int tm = w >> 4, nt = w & 15;
        int e = 0;
        while (e < NEXP - 1 && sm[e + 1] <= tm) ++e;
        const int mt = tm - sm[e];
        const int rbase = sm[33 + e] + mt * 128;
        const int mrows = min(128, cnt[e] - mt * 128);
        const int n0 = nt * 64;
        f32x4 acc[4][4];
        gemm2<true, true>(hb, D, rowtok, rbase, mrows, (const bf16_t*)(p.ws + WB_E1) + (size_t)e * D * 2 * DFF, 2 * DFF, n0, 128, D, smem, acc);
        const float* b1 = p.in[22] + (size_t)e * 2 * DFF;
        const int wn_ = (threadIdx.x >> 6) & 1;
#pragma unroll
        for (int i = 0; i < 4; ++i)
#pragma unroll
            for (int jp = 0; jp < 2; ++jp) {
                const int col = n0 + (wn_ * 2 + jp) * 16 + (threadIdx.x & 15);
                const float bg = b1[col], bl = b1[DFF + col];
#pragma unroll
                for (int r = 0; r < 4; ++r) {
                    const int rl = G2_ROW(i, r);
                    if (rl < mrows) {
                        const float gate = fminf(acc[i][2 * jp][r] + bg, 7.f);
                        const float lin = fminf(fmaxf(acc[i][2 * jp + 1][r] + bl, -7.f), 7.f);
                        const float a_ = (lin + 1.f) * gate * sigmoidf_(1.702f * gate);
                        act[(size_t)(rbase + rl) * DFF + col] = (bf16_t)f2bf(a_);
                    }
                }
            }
    }
}
__device__ __forceinline__ void phase_moe2(const Params& p, int bid, int nb, unsigned char* smem) {
    int* sm = (int*)(smem + 65536);
    const int* cnt = (const int*)(p.ws + WS_CTL);
    const bf16_t* act = (const bf16_t*)(p.ws + WS_ACT);
    float* yrows = (float*)(p.ws + WS_YROWS);
    const int lane = threadIdx.x & 63, wave = threadIdx.x >> 6;
    int total_mt;
    moe_tile_map(cnt, sm, total_mt);
    for (int w = bid; w < total_mt * 8; w += nb) {
        const int tm = w >> 3, nt = w & 7;
        int e = 0;
        while (e < NEXP - 1 && sm[e + 1] <= tm) ++e;
        const int mt = tm - sm[e];
        const int rbase = sm[33 + e] + mt * 128;
        const int mrows = min(128, cnt[e] - mt * 128);
        const int n0 = nt * 128;
        f32x4 acc[4][4];
        gemm2<false, false>(act, DFF, nullptr, rbase, mrows, (const bf16_t*)(p.ws + WB_E2) + (size_t)e * DFF * D, D, n0, 128, DFF, smem, acc);
        const float* b2 = p.in[24] + (size_t)e * D + n0;
#pragma unroll
        for (int i = 0; i < 4; ++i)
#pragma unroll
            for (int r = 0; r < 4; ++r) {
                const int rl = G2_ROW(i, r);
                if (rl < mrows) {
                    float* yr = yrows + (size_t)(rbase + rl) * D + n0;
#pragma unroll
                    for (int j = 0; j < 4; ++j) { const int c = G2_COL(j); yr[c] = acc[i][j][r] + b2[c]; }
                }
            }
    }
}

__device__ __forceinline__ void phase_combine(const Params& p, int bid, int nb) {
    const int lane = threadIdx.x & 63, wave = threadIdx.x >> 6;
    const float* x1 = (const float*)(p.ws + WS_X1);
    const float* yrows = (const float*)(p.ws + WS_YROWS);
    const int* ppos = (const int*)(p.ws + WS_PPOS);
    const float* topw = (const float*)(p.ws + WS_TOPW);
    const float* g = p.in[25];
    bf16_t* hb = (bf16_t*)(p.ws + WS_HB);
    bf16_t* pb = (bf16_t*)(p.ws + WS_PB);
    for (int t = bid * 4 + wave; t < S; t += nb * 4) {
        float4 v[4];
#pragma unroll
        for (int j = 0; j < 4; ++j) v[j] = ((const float4*)(x1 + (size_t)t * D))[lane + 64 * j];
#pragma unroll
        for (int k = 0; k < 4; ++k) {
            const float wk = topw[t * 4 + k];
            const float4* yr = (const float4*)(yrows + (size_t)ppos[t * 4 + k] * D);
#pragma unroll
            for (int j = 0; j < 4; ++j) { const float4 y = yr[lane + 64 * j]; v[j].x += wk * y.x; v[j].y += wk * y.y; v[j].z += wk * y.z; v[j].w += wk * y.w; }
        }
        float ss = 0.f;
#pragma unroll
        for (int j = 0; j < 4; ++j) ss += v[j].x * v[j].x + v[j].y * v[j].y + v[j].z * v[j].z + v[j].w * v[j].w;
        ss = wave_sum(ss);
        const float rstd = rsqrtf(ss * (1.f / D) + EPS);
#pragma unroll
        for (int j = 0; j < 4; ++j) {
            ((float4*)(p.out + (size_t)t * D))[lane + 64 * j] = v[j];
            const float4 gg = ((const float4*)g)[lane + 64 * j];
            uint2 o;
            o.x = pk2(v[j].x * rstd * gg.x, v[j].y * rstd * gg.y);
            o.y = pk2(v[j].z * rstd * gg.z, v[j].w * rstd * gg.w);
            ((uint2*)(hb + (size_t)t * D))[lane + 64 * j] = o;
        }
    }
}

__device__ __forceinline__ void phase_ple(const Params& p, int bid, int nb, unsigned char* smem) {
    const bf16_t* pw = (const bf16_t*)(p.ws + WS_PW);
    for (int w = bid; w < 128 * 8; w += nb) {
        const int mt = w % 128, nt = w / 128;
        const int m0 = mt * 128, n0 = nt * 128;
        f32x4 acc[4][4];
        gemm2<false, false>((const bf16_t*)(p.ws + WS_HB), D, nullptr, m0, 128, (const bf16_t*)(p.ws + WB_PLEG), D, n0, 128, D, smem, acc);
#pragma unroll
        for (int i = 0; i < 4; ++i)
#pragma unroll
            for (int r = 0; r < 4; ++r) {
                const size_t ro = (size_t)(m0 + G2_ROW(i, r)) * D + n0 + G2_COL(0);
                float* orow = p.out + ro;
#pragma unroll
                for (int j = 0; j < 4; ++j) orow[j * 16] = orow[j * 16] + sigmoidf_(acc[i][j][r]) * bf2f(pw[ro + j * 16]);
            }
    }
}

#define LAS __attribute__((address_space(3)))
#define XB_TMO      128
#define XB_XCNT(j)  (256  + 64 * (j))
#define XB_XSUB(j)  (1280 + 64 * (j))
#define XB_XGEN(j)  (2304 + 64 * (j))
#define XB_TOP      3328
#define XB_TOPGEN   3392
#define XCD_BAR_WORDS 3456
#define XB_SPIN_CAP (1u << 18)

__device__ __forceinline__ unsigned xb_ld(unsigned* p)              { return __hip_atomic_load(p, __ATOMIC_RELAXED, __HIP_MEMORY_SCOPE_AGENT); }
__device__ __forceinline__ unsigned xb_add(unsigned* p, unsigned v) { return __hip_atomic_fetch_add(p, v, __ATOMIC_RELAXED, __HIP_MEMORY_SCOPE_AGENT); }
__device__ __forceinline__ unsigned xb_xcc_id() { return (unsigned)__builtin_amdgcn_s_getreg((3 << 11) | 20) & 0xFu; }
#define XB_SPIN(cond, bar) do { unsigned _sp = 0; while (cond) { __builtin_amdgcn_s_sleep(1); \
    if ((++_sp & 255u) == 0u) { if (xb_ld(&(bar)[XB_TMO])) break; if (_sp > XB_SPIN_CAP) { atomicAdd(&(bar)[XB_TMO], 1u); break; } } } } while (0)

struct XcdBarrier {
    unsigned* bar; unsigned x;
    volatile LAS unsigned* st;
};

__device__ __forceinline__ XcdBarrier xcd_barrier_post(unsigned* bar, volatile LAS unsigned* st) {
    XcdBarrier b; b.bar = bar; b.x = xb_xcc_id(); b.st = st;
    if (threadIdx.x == 0) (void)xb_add(&bar[XB_XCNT(b.x)], 1u);
    return b;
}
__device__ __forceinline__ void xcd_barrier_complete(unsigned* bar, unsigned x, unsigned& nloc, unsigned& nx) {
    const unsigned G = gridDim.x * gridDim.y * gridDim.z;
    unsigned sum, cnt, mine, sp = 0u;
    for (;;) {
        sum = 0u; cnt = 0u; mine = 0u;
#pragma unroll
        for (unsigned j = 0; j < 16; ++j) { const unsigned c = xb_ld(&bar[XB_XCNT(j)]); sum += c; cnt += (c > 0u) ? 1u : 0u; mine = (j == x) ? c : mine; }
        if (sum == G) break;
        __builtin_amdgcn_s_sleep(1);
        if ((++sp & 255u) == 0u) { if (xb_ld(&bar[XB_TMO])) break; if (sp > XB_SPIN_CAP) { atomicAdd(&bar[XB_TMO], 1u); break; } }
    }
    nloc = mine > 0u ? mine : 1u; nx = cnt > 0u ? cnt : 1u;
}

__device__ __forceinline__ void xcd_barrier(const XcdBarrier& b) {
    asm volatile("s_waitcnt vmcnt(0)" ::: "memory");
    __syncthreads();
    if (threadIdx.x == 0) {
        unsigned* bar = b.bar;
        __builtin_amdgcn_s_waitcnt(0);
        unsigned nloc = b.st[0], nx = b.st[1];
        if (nloc == 0u) { xcd_barrier_complete(bar, b.x, nloc, nx); b.st[0] = nloc; b.st[1] = nx; }
        const unsigned old = xb_add(&bar[XB_XSUB(b.x)], 1u);
        const unsigned gen = old / nloc;
        if (old + 1u == (gen + 1u) * nloc) {
            __builtin_amdgcn_fence(__ATOMIC_RELEASE, "agent");
            asm volatile("s_waitcnt vmcnt(0)" ::: "memory");
            const unsigned og = xb_add(&bar[XB_TOP], 1u);
            const unsigned tg = og / nx;
            if (og + 1u == (tg + 1u) * nx) xb_add(&bar[XB_TOPGEN], 1u);
            else XB_SPIN(xb_ld(&bar[XB_TOPGEN]) == tg, bar);
            __builtin_amdgcn_fence(__ATOMIC_ACQUIRE, "agent");
            xb_add(&bar[XB_XGEN(b.x)], 1u);
            asm volatile("s_waitcnt vmcnt(0)" ::: "memory");
        } else {
            XB_SPIN(xb_ld(&bar[XB_XGEN(b.x)]) == gen, bar);
            __builtin_amdgcn_fence(__ATOMIC_ACQUIRE, "agent");
            asm volatile("s_waitcnt vmcnt(0)" ::: "memory");
        }
    }
    __syncthreads();
}

template <int PH>
__device__ __forceinline__ void run_phase(const Params& p, int bid, int nb, unsigned char* smem) {
    if (PH == 0) phase_prep(p, bid, nb);
    if (PH == 1) phase_inproj(p, bid, nb, smem);
    if (PH == 3) phase_compress(p, bid, nb, smem);
    if (PH == 4) phase_attn(p, bid, nb, smem);
    if (PH == 15) phase_dsa_attn(p, bid, nb, smem);
    if (PH == 5) phase_merge<0>(p, bid, nb, smem);
    if (PH == 13) phase_merge<1>(p, bid, nb, smem);
    if (PH == 6) phase_outproj(p, bid, nb, smem);
    if (PH == 7) phase_route(p, bid, nb);
    if (PH == 8) phase_place(p, bid, nb, smem);
    if (PH == 9) phase_moe1(p, bid, nb, smem);
    if (PH == 10) phase_moe2(p, bid, nb, smem);
    if (PH == 11) phase_combine(p, bid, nb);
    if (PH == 12) phase_ple(p, bid, nb, smem);
}

#if SINGLE_LAUNCH
__global__ void __launch_bounds__(NT, 2) fwd_mega(Params p) {
    __shared__ __attribute__((aligned(16))) unsigned char smem[SMEM_BYTES];
    cg::grid_group grid = cg::this_grid();
    const int bid = blockIdx.x, nb = gridDim.x;
    volatile LAS unsigned* bst = (volatile LAS unsigned*)(LAS unsigned char*)(smem + SMEM_BYTES - 16);
    if (threadIdx.x < 2) bst[threadIdx.x] = 0u;
    __syncthreads();
    const XcdBarrier bar = xcd_barrier_post((unsigned*)(p.ws + WS_BAR), bst);
#define GSYNC() xcd_barrier(bar)
    run_phase<0>(p, bid, nb, smem); grid.sync();
    run_phase<1>(p, bid, nb, smem); GSYNC();
    run_phase<3>(p, bid, nb, smem); GSYNC();
    run_phase<4>(p, bid, nb, smem); GSYNC();
    run_phase<15>(p, bid, nb, smem); GSYNC();
    run_phase<5>(p, bid, nb, smem); GSYNC();
    run_phase<13>(p, bid, nb, smem); GSYNC();
    run_phase<6>(p, bid, nb, smem); GSYNC();
    run_phase<7>(p, bid, nb, smem); GSYNC();
    run_phase<8>(p, bid, nb, smem); GSYNC();
    run_phase<9>(p, bid, nb, smem); GSYNC();
    run_phase<10>(p, bid, nb, smem); GSYNC();
    run_phase<11>(p, bid, nb, smem); GSYNC();
    run_phase<12>(p, bid, nb, smem);
#undef GSYNC
}
#else
template <int PH>
__global__ void __launch_bounds__(NT, 2) k_phase(Params p) {
    __shared__ __attribute__((aligned(16))) unsigned char smem[SMEM_BYTES];
    run_phase<PH>(p, blockIdx.x, gridDim.x, smem);
}
#endif

extern "C" void kernel_launch(void* const* d_in, const int* in_sizes, int n_in, void* d_out, int out_size, void* d_ws, size_t ws_size,
                              hipStream_t stream) {
    if (n_in != 28 || ws_size < WS_END) { fprintf(stderr, "kernel_launch: unexpected n_in %d or ws_size %zu (< %zu)\n", n_in, ws_size, (size_t)WS_END); return; }
    Params p{};
    for (int i = 0; i < 28; ++i) p.in[i] = (const float*)d_in[i];
    p.out = (float*)d_out;
    p.ws = (unsigned char*)d_ws;
#if SINGLE_LAUNCH
    static int grid_blocks = 0;
    if (!grid_blocks) {
        int dev = 0, cus = 0, per_cu = 0;
        hipGetDevice(&dev);
        hipDeviceGetAttribute(&cus, hipDeviceAttributeMultiprocessorCount, dev);
        hipOccupancyMaxActiveBlocksPerMultiprocessor(&per_cu, fwd_mega, NT, 0);
        if (per_cu > 2) per_cu = 2;
        if (per_cu < 1) per_cu = 1;
        grid_blocks = cus * per_cu;
    }
    (void)hipMemsetAsync((unsigned char*)d_ws + WS_BAR, 0, XCD_BAR_WORDS * 4, stream);
    void* args[] = {&p};
    hipError_t e = hipLaunchCooperativeKernel((void*)fwd_mega, dim3(grid_blocks), dim3(NT), args, 0, stream);
    if (e != hipSuccess) fprintf(stderr, "cooperative launch failed: %s (grid %d)\n", hipGetErrorString(e), grid_blocks);
#else
    const int G = 512;
    k_phase<0><<<G, NT, 0, stream>>>(p);
    k_phase<1><<<G, NT, 0, stream>>>(p);
    k_phase<3><<<G, NT, 0, stream>>>(p);
    k_phase<4><<<G, NT, 0, stream>>>(p);
    k_phase<15><<<G, NT, 0, stream>>>(p);
    k_phase<5><<<G, NT, 0, stream>>>(p);
    k_phase<13><<<G, NT, 0, stream>>>(p);
    k_phase<6><<<G, NT, 0, stream>>>(p);
    k_phase<7><<<G, NT, 0, stream>>>(p);
    k_phase<8><<<G, NT, 0, stream>>>(p);
    k_phase<9><<<G, NT, 0, stream>>>(p);
    k_phase<10><<<G, NT, 0, stream>>>(p);
    k_phase<11><<<G, NT, 0, stream>>>(p);
    k_phase<12><<<G, NT, 0, stream>>>(p);
#endif
}
```

```cpp
#include <hip/hip_runtime.h>
#include <hip/hip_cooperative_groups.h>
#include <cstdio>
#include <cstdint>
namespace cg = cooperative_groups;

#ifndef SINGLE_LAUNCH
#define SINGLE_LAUNCH 1
#endif

constexpr int S = 16384;
constexpr int D = 1024;
constexpr int DIN = 5184;
constexpr int NCMP = 1023;
constexpr int NSLC = 256;
constexpr int NEXP = 32;
constexpr int DFF = 1024;
constexpr float EPS = 1e-6f;
constexpr float LOG2E = 1.4426950408889634f;
constexpr int Z_NQ = 0, Z_NKV = 512, Z_NGATE = 1280, Z_DQ = 1304, Z_DK = 1816, Z_DV = 2328, Z_IQ = 2840, Z_IK = 3096,
              Z_IW = 3128, Z_GA = 3136, Z_GB = 4160;

constexpr int NT = 256;
constexpr int SMEM_BYTES = 73728;

typedef unsigned short bf16_t;
typedef short bf16x8 __attribute__((ext_vector_type(8)));
typedef float f32x4 __attribute__((ext_vector_type(4)));
typedef short s16x4 __attribute__((ext_vector_type(4)));
typedef __attribute__((address_space(3))) s16x4* lds_s16x4_ptr;
__device__ __forceinline__ s16x4 lds_tr16(const void* p) {
    return __builtin_amdgcn_ds_read_tr16_b64_v4i16((lds_s16x4_ptr)(uintptr_t)p);
}

constexpr size_t MBy = 1ull << 20;
constexpr size_t WS_CTL = 0;
constexpr size_t WS_BAR = 65536;
constexpr size_t WS_HB = 1 * MBy;
constexpr size_t WS_OA = WS_HB + (size_t)S * D * 2;
constexpr size_t WS_OB = WS_OA + (size_t)S * 512 * 2;
constexpr size_t WS_MERGED = WS_OB + (size_t)S * 512 * 2;
constexpr size_t WS_X1 = WS_MERGED + (size_t)S * D * 2;
constexpr size_t WS_TOPI = WS_X1 + (size_t)S * D * 4;
constexpr size_t WS_TOPW = WS_TOPI + (size_t)S * 4 * 4;
constexpr size_t WS_PPOS = WS_TOPW + (size_t)S * 4 * 4;
constexpr size_t WS_ROWTOK = WS_PPOS + (size_t)S * 4 * 4;
constexpr size_t WS_PB = WS_ROWTOK + (size_t)65536 * 4;
constexpr size_t WS_PW = WS_PB + (size_t)S * 256 * 2;
constexpr size_t WS_SEL = WS_PW + (size_t)S * D * 2;
constexpr size_t WS_NSEL = WS_SEL + (size_t)S * 256 * 2;
constexpr size_t WS_REG = WS_NSEL + (size_t)S * 4;
constexpr size_t WS_SGA = WS_REG;
constexpr size_t WS_SGB = WS_SGA + (size_t)S * D * 2;
constexpr size_t WS_GT = WS_SGB + (size_t)S * D * 2;
constexpr size_t WS_IWS = WS_GT + (size_t)S * 32 * 4;
constexpr size_t WS_QNB = WS_IWS + (size_t)S * 8 * 4;
constexpr size_t WS_KSLB = WS_QNB + (size_t)S * 512 * 2;
constexpr size_t WS_VSLB = WS_KSLB + (size_t)S * 128 * 2;
constexpr size_t WS_KWNB = WS_VSLB + (size_t)S * 128 * 2;
constexpr size_t WS_VWNB = WS_KWNB + (size_t)S * 128 * 2;
constexpr size_t WS_KCB = WS_VWNB + (size_t)S * 128 * 2;
constexpr size_t WS_VCB = WS_KCB + (size_t)2 * 1024 * 64 * 2;
constexpr size_t WS_KCR = WS_VCB + (size_t)2 * 1024 * 64 * 2;
constexpr size_t WS_VCR = WS_KCR + (size_t)S * 128 * 2;
constexpr size_t WS_DQB = WS_VCR + (size_t)S * 128 * 2;
constexpr size_t WS_DKB = WS_DQB + (size_t)S * 512 * 2;
constexpr size_t WS_DVB = WS_DKB + (size_t)S * 512 * 2;
constexpr size_t WS_IQB = WS_DVB + (size_t)S * 512 * 2;
constexpr size_t WS_IKB = WS_IQB + (size_t)S * 256 * 2;
constexpr size_t WS_ENDA = WS_IKB + (size_t)S * 32 * 2;
constexpr size_t WS_ACT = WS_REG;
constexpr size_t WS_YROWS = WS_ACT + (size_t)(65536 + 128) * DFF * 2;
constexpr size_t WS_ENDB = WS_YROWS + (size_t)(65536 + 128) * D * 4;
constexpr size_t WS_END0 = WS_ENDA > WS_ENDB ? WS_ENDA : WS_ENDB;
constexpr size_t WB_IN = WS_END0;
constexpr size_t WB_A = WB_IN + (size_t)D * DIN * 2;
constexpr size_t WB_B = WB_A + (size_t)512 * D * 2;
constexpr size_t WB_OUT = WB_B + (size_t)512 * D * 2;
constexpr size_t WB_E1 = WB_OUT + (size_t)D * D * 2;
constexpr size_t WB_E2 = WB_E1 + (size_t)NEXP * D * 2 * DFF * 2;
constexpr size_t WB_PLE = WB_E2 + (size_t)NEXP * DFF * D * 2;
constexpr size_t WB_PLEG = WB_PLE + (size_t)256 * D * 2;
constexpr size_t WB_CK1 = WB_PLEG + (size_t)D * D * 2;
constexpr size_t WB_CV1 = WB_CK1 + (size_t)2048 * 64 * 2;
constexpr size_t WS_END = WB_CV1 + (size_t)2048 * 64 * 2 + 4096;

struct Params {
    const float* in[28];
    float* out;
    unsigned char* ws;
};

__device__ __forceinline__ unsigned f2bf(float f) {
    unsigned u = __builtin_bit_cast(unsigned, f);
    return (u + 0x7fffu + ((u >> 16) & 1u)) >> 16;
}
__device__ __forceinline__ unsigned pk2(float lo, float hi) { return f2bf(lo) | (f2bf(hi) << 16); }
__device__ __forceinline__ float bf2f(unsigned short b) { return __builtin_bit_cast(float, (unsigned)b << 16); }
__device__ __forceinline__ int tid_opaque() { int t = threadIdx.x; asm volatile("" : "+v"(t)); return t; }
__device__ __forceinline__ float wave_sum(float v) {
#pragma unroll
    for (int o = 1; o < 64; o <<= 1) v += __shfl_xor(v, o);
    return v;
}
__device__ __forceinline__ float wave_max(float v) {
#pragma unroll
    for (int o = 1; o < 64; o <<= 1) v = fmaxf(v, __shfl_xor(v, o));
    return v;
}
__device__ __forceinline__ float sigmoidf_(float x) { return 1.f / (1.f + __expf(-x)); }
__device__ __forceinline__ int bucket_of(int n) {
    if (n < 16) return n;
    int b = 16;
    b += (n >= 19) + (n >= 21) + (n >= 24) + (n >= 27) + (n >= 31) + (n >= 35) + (n >= 40) + (n >= 46) + (n >= 52) + (n >= 59) +
         (n >= 67) + (n >= 77) + (n >= 87) + (n >= 99) + (n >= 113);
    return b;
}

constexpr int LDS_STRIDE = 40;
constexpr int BTR_STRIDE = 136;
template <bool A_F32, bool GATHER, bool SPLIT = false, bool BTR = true>
__device__ __forceinline__ void gemm_tile(const void* __restrict__ Aptr, int lda, const int* __restrict__ rowidx, int m0, int mrows,
                                          const float* __restrict__ B, int ldb, int n0, int split_off, int ncols, int K,
                                          unsigned char* smem, f32x4 (&acc)[2][8]) {
    bf16_t* As = (bf16_t*)smem;
    bf16_t* Bs = As + 128 * LDS_STRIDE;
    bf16_t* AsL = Bs + 128 * LDS_STRIDE;
    bf16_t* BsL = AsL + 128 * LDS_STRIDE;
    const int tid = tid_opaque(), lane = tid & 63, wave = tid >> 6;
#pragma unroll
    for (int i = 0; i < 2; ++i)
#pragma unroll
        for (int j = 0; j < 8; ++j) acc[i][j] = (f32x4){0.f, 0.f, 0.f, 0.f};
    auto lo = [](float v) { return v - bf2f((unsigned short)f2bf(v)); };

    const int ar = tid >> 2, ach = tid & 3;
    const unsigned char* arow[2];
    bool aval[2];
#pragma unroll
    for (int i = 0; i < 2; ++i) {
        int r = ar + 64 * i;
        aval[i] = r < mrows;
        long src = 0;
        if (aval[i]) src = GATHER ? (long)rowidx[m0 + r] : (long)(m0 + r);
        arow[i] = (const unsigned char*)Aptr + (size_t)src * lda * (A_F32 ? 4 : 2) + (size_t)ach * 8 * (A_F32 ? 4 : 2);
    }
    const int nq = tid & 31, kq = tid >> 5;
    const int jn = 4 * nq;
    const bool bval = jn < ncols;
    const float* bptr = B + (size_t)(4 * kq) * ldb + n0 + jn + (jn >= 64 ? split_off : 0);

    uint4 areg[2];
    float4 af0a, af0b, af1a, af1b;
    float4 breg[4];
    auto load_g = [&](int k0) {
#pragma unroll
        for (int i = 0; i < 2; ++i) {
            if (A_F32) {
                float4 t0 = make_float4(0, 0, 0, 0), t1 = t0;
                if (aval[i]) {
                    const float4* s = (const float4*)(arow[i] + (size_t)k0 * 4);
                    t0 = s[0]; t1 = s[1];
                }
                if (i == 0) { af0a = t0; af0b = t1; } else { af1a = t0; af1b = t1; }
            } else {
                if (aval[i]) areg[i] = *(const uint4*)(arow[i] + (size_t)k0 * 2);
                else areg[i] = make_uint4(0, 0, 0, 0);
            }
        }
#pragma unroll
        for (int kk = 0; kk < 4; ++kk) {
            if (bval) breg[kk] = *(const float4*)(bptr + (size_t)(k0 + kk) * ldb);
            else breg[kk] = make_float4(0, 0, 0, 0);
        }
    };
    auto store_l = [&]() {
#pragma unroll
        for (int i = 0; i < 2; ++i) {
            uint4 v;
            const float4 t0 = (i == 0) ? af0a : af1a, t1 = (i == 0) ? af0b : af1b;
            if (A_F32) {
                v.x = pk2(t0.x, t0.y); v.y = pk2(t0.z, t0.w);
                v.z = pk2(t1.x, t1.y); v.w = pk2(t1.z, t1.w);
            } else v = areg[i];
            *(uint4*)(As + (ar + 64 * i) * LDS_STRIDE + ach * 8) = v;
            if (SPLIT && A_F32) {
                v.x = pk2(lo(t0.x), lo(t0.y)); v.y = pk2(lo(t0.z), lo(t0.w));
                v.z = pk2(lo(t1.x), lo(t1.y)); v.w = pk2(lo(t1.z), lo(t1.w));
                *(uint4*)(AsL + (ar + 64 * i) * LDS_STRIDE + ach * 8) = v;
            }
        }
        if (SPLIT) {
            uint2 v;
            v.x = pk2(lo(breg[0].x), lo(breg[1].x)); v.y = pk2(lo(breg[2].x), lo(breg[3].x));
            *(uint2*)(BsL + (jn + 0) * LDS_STRIDE + 4 * kq) = v;
            v.x = pk2(lo(breg[0].y), lo(breg[1].y)); v.y = pk2(lo(breg[2].y), lo(breg[3].y));
            *(uint2*)(BsL + (jn + 1) * LDS_STRIDE + 4 * kq) = v;
            v.x = pk2(lo(breg[0].z), lo(breg[1].z)); v.y = pk2(lo(breg[2].z), lo(breg[3].z));
            *(uint2*)(BsL + (jn + 2) * LDS_STRIDE + 4 * kq) = v;
            v.x = pk2(lo(breg[0].w), lo(breg[1].w)); v.y = pk2(lo(breg[2].w), lo(breg[3].w));
            *(uint2*)(BsL + (jn + 3) * LDS_STRIDE + 4 * kq) = v;
        }
        if (BTR && !SPLIT) {
#pragma unroll
            for (int kk = 0; kk < 4; ++kk) {
                uint2 v; v.x = pk2(breg[kk].x, breg[kk].y); v.y = pk2(breg[kk].z, breg[kk].w);
                *(uint2*)(Bs + (4 * kq + kk) * BTR_STRIDE + jn) = v;
            }
        } else {
            uint2 v;
            v.x = pk2(breg[0].x, breg[1].x); v.y = pk2(breg[2].x, breg[3].x);
            *(uint2*)(Bs + (jn + 0) * LDS_STRIDE + 4 * kq) = v;
            v.x = pk2(breg[0].y, breg[1].y); v.y = pk2(breg[2].y, breg[3].y);
            *(uint2*)(Bs + (jn + 1) * LDS_STRIDE + 4 * kq) = v;
            v.x = pk2(breg[0].z, breg[1].z); v.y = pk2(breg[2].z, breg[3].z);
            *(uint2*)(Bs + (jn + 2) * LDS_STRIDE + 4 * kq) = v;
            v.x = pk2(breg[0].w, breg[1].w); v.y = pk2(breg[2].w, breg[3].w);
            *(uint2*)(Bs + (jn + 3) * LDS_STRIDE + 4 * kq) = v;
        }
    };
    const int nk = K / 32;
    __syncthreads();
    load_g(0);
    store_l();
    __syncthreads();
    const int fr = lane & 15, fq = lane >> 4;
    for (int kt = 0; kt < nk; ++kt) {
        if (kt + 1 < nk) load_g((kt + 1) * 32);
        bf16x8 a[2];
#pragma unroll
        for (int i = 0; i < 2; ++i) a[i] = *(const bf16x8*)(As + (wave * 32 + i * 16 + fr) * LDS_STRIDE + fq * 8);
        if (!SPLIT) {
            bf16x8 b[8];
#pragma unroll
            for (int j = 0; j < 8; ++j) {
                if (BTR && !SPLIT) {
                    const bf16_t* bp = Bs + (8 * fq + (fr >> 2)) * BTR_STRIDE + 16 * j + 4 * (fr & 3);
                    const s16x4 lo4 = lds_tr16(bp), hi4 = lds_tr16(bp + 4 * BTR_STRIDE);
                    b[j] = (bf16x8){lo4[0], lo4[1], lo4[2], lo4[3], hi4[0], hi4[1], hi4[2], hi4[3]};
                } else b[j] = *(const bf16x8*)(Bs + (j * 16 + fr) * LDS_STRIDE + fq * 8);
            }
#pragma unroll
            for (int i = 0; i < 2; ++i)
#pragma unroll
                for (int j = 0; j < 8; ++j) acc[i][j] = __builtin_amdgcn_mfma_f32_16x16x32_bf16(a[i], b[j], acc[i][j], 0, 0, 0);
        } else {
            bf16x8 al[2];
#pragma unroll
            for (int i = 0; i < 2; ++i) al[i] = *(const bf16x8*)(AsL + (wave * 32 + i * 16 + fr) * LDS_STRIDE + fq * 8);
#pragma unroll
            for (int j = 0; j < 8; ++j) {
                const bf16x8 bh = *(const bf16x8*)(Bs + (j * 16 + fr) * LDS_STRIDE + fq * 8);
                const bf16x8 bl = *(const bf16x8*)(BsL + (j * 16 + fr) * LDS_STRIDE + fq * 8);
#pragma unroll
                for (int i = 0; i < 2; ++i) {
                    acc[i][j] = __builtin_amdgcn_mfma_f32_16x16x32_bf16(a[i], bh, acc[i][j], 0, 0, 0);
                    acc[i][j] = __builtin_amdgcn_mfma_f32_16x16x32_bf16(a[i], bl, acc[i][j], 0, 0, 0);
                    acc[i][j] = __builtin_amdgcn_mfma_f32_16x16x32_bf16(al[i], bh, acc[i][j], 0, 0, 0);
                }
            }
        }
        __syncthreads();
        if (kt + 1 < nk) {
            store_l();
            __syncthreads();
        }
    }
}


constexpr int ASTR = 72;
constexpr int BSTR = 136;
template <bool GATHER, bool PAIR>
__device__ __forceinline__ void gemm2(const bf16_t* __restrict__ A, int lda, const int* __restrict__ rowidx, int m0, int mrows,
                                      const bf16_t* __restrict__ B, int ldb, int n0, int ncols, int K, unsigned char* smem,
                                      f32x4 (&acc)[4][4]) {
    bf16_t* As = (bf16_t*)smem;
    bf16_t* Bs = As + 128 * ASTR;
    const int tid = tid_opaque(), lane = tid & 63, wave = tid >> 6, wm = wave >> 1, wn = wave & 1;
#pragma unroll
    for (int i = 0; i < 4; ++i)
#pragma unroll
        for (int j = 0; j < 4; ++j) acc[i][j] = (f32x4){0.f, 0.f, 0.f, 0.f};
    const int ar0 = tid >> 3, ach = tid & 7;
    const bf16_t* ap0; const bf16_t* ap1; const bf16_t* ap2; const bf16_t* ap3;
    {
        int r_[4];
#pragma unroll
        for (int i = 0; i < 4; ++i) { const int rl = 32 * i + ar0; r_[i] = rl < mrows ? rl : mrows - 1; }
        ap0 = A + (size_t)(GATHER ? (long)rowidx[m0 + r_[0]] : (long)(m0 + r_[0])) * lda + ach * 8;
        ap1 = A + (size_t)(GATHER ? (long)rowidx[m0 + r_[1]] : (long)(m0 + r_[1])) * lda + ach * 8;
        ap2 = A + (size_t)(GATHER ? (long)rowidx[m0 + r_[2]] : (long)(m0 + r_[2])) * lda + ach * 8;
        ap3 = A + (size_t)(GATHER ? (long)rowidx[m0 + r_[3]] : (long)(m0 + r_[3])) * lda + ach * 8;
    }
    const int br0 = tid >> 4, bch = tid & 15;
    const int bcol = PAIR ? ((bch >> 2) * 16 + (bch & 1) * 8 + ((bch >> 1) & 1) * 1024) : bch * 8;
    const bf16_t* bp = B + (size_t)br0 * ldb + n0 + bcol;
    bf16_t* asd = As + ar0 * ASTR + ach * 8;
    bf16_t* bsd = Bs + br0 * BSTR + bch * 8;
    uint4 a0, a1, a2, a3, b0, b1, b2, b3;
#define G2_LOAD(k0)                                                                                       \
    do {                                                                                                  \
        a0 = *(const uint4*)(ap0 + (k0)); a1 = *(const uint4*)(ap1 + (k0));                               \
        a2 = *(const uint4*)(ap2 + (k0)); a3 = *(const uint4*)(ap3 + (k0));                               \
        const bf16_t* bp_ = bp + (size_t)(k0) * ldb;                                                      \
        b0 = *(const uint4*)(bp_); b1 = *(const uint4*)(bp_ + (size_t)16 * ldb);                          \
        b2 = *(const uint4*)(bp_ + (size_t)32 * ldb); b3 = *(const uint4*)(bp_ + (size_t)48 * ldb);       \
    } while (0)
#define G2_STORE()                                                                                        \
    do {                                                                                                  \
        *(uint4*)(asd) = a0; *(uint4*)(asd + 32 * ASTR) = a1; *(uint4*)(asd + 64 * ASTR) = a2; *(uint4*)(asd + 96 * ASTR) = a3; \
        *(uint4*)(bsd) = b0; *(uint4*)(bsd + 16 * BSTR) = b1; *(uint4*)(bsd + 32 * BSTR) = b2; *(uint4*)(bsd + 48 * BSTR) = b3; \
    } while (0)
    const int nk = K / 64;
    __syncthreads();
    G2_LOAD(0);
    G2_STORE();
    __syncthreads();
    const int fr = lane & 15, fq = lane >> 4;
    const bf16_t* afp = As + (wm * 64 + fr) * ASTR + fq * 8;
    const bf16_t* bfp = Bs + (8 * fq + (fr >> 2)) * BSTR + wn * 64 + 4 * (fr & 3);
    for (int kt = 0; kt < nk; ++kt) {
        if (kt + 1 < nk) G2_LOAD((kt + 1) * 64);
#pragma unroll
        for (int kh = 0; kh < 2; ++kh) {
            bf16x8 a[4], b[4];
#pragma unroll
            for (int i = 0; i < 4; ++i) a[i] = *(const bf16x8*)(afp + i * 16 * ASTR + kh * 32);
#pragma unroll
            for (int j = 0; j < 4; ++j) {
                const bf16_t* q = bfp + kh * 32 * BSTR + j * 16;
                const s16x4 lo4 = lds_tr16(q), hi4 = lds_tr16(q + 4 * BSTR);
                b[j] = (bf16x8){lo4[0], lo4[1], lo4[2], lo4[3], hi4[0], hi4[1], hi4[2], hi4[3]};
            }
#pragma unroll
            for (int i = 0; i < 4; ++i)
#pragma unroll
                for (int j = 0; j < 4; ++j) acc[i][j] = __builtin_amdgcn_mfma_f32_16x16x32_bf16(a[i], b[j], acc[i][j], 0, 0, 0);
        }
        __syncthreads();
        if (kt + 1 < nk) {
            G2_STORE();
            __syncthreads();
        }
    }
#undef G2_LOAD
#undef G2_STORE
}
#define G2_ROW(i, r) ((g2tid >> 7) * 64 + (i) * 16 + 4 * ((g2tid & 63) >> 4) + (r))
#define G2_COL(j) (((((g2tid >> 6) & 1) * 4 + (j)) * 16) + (g2tid & 15))

__device__ __forceinline__ void cvt_weights(const float* __restrict__ src, bf16_t* __restrict__ dst, size_t n, int bid, int nb) {
    const size_t n8 = n >> 3;
    for (size_t i = (size_t)bid * NT + tid_opaque(); i < n8; i += (size_t)nb * NT) {
        const float4 u = ((const float4*)src)[2 * i], v = ((const float4*)src)[2 * i + 1];
        uint4 o; o.x = pk2(u.x, u.y); o.y = pk2(u.z, u.w); o.z = pk2(v.x, v.y); o.w = pk2(v.z, v.w);
        ((uint4*)dst)[i] = o;
    }
}
__device__ __forceinline__ void phase_prep(const Params& p, int bid, int nb) {
    const int lane = tid_opaque() & 63, wave = tid_opaque() >> 6;
    if (bid == 0 && tid_opaque() < 64) ((int*)(p.ws + WS_CTL))[tid_opaque()] = 0;
    {
        const float* src_ = p.in[2];
        bf16_t* dst_ = (bf16_t*)(p.ws + WB_IN);
        constexpr int G8 = DIN / 8;
        for (size_t i = (size_t)bid * NT + tid_opaque(); i < (size_t)D * G8; i += (size_t)nb * NT) {
            const int k = (int)(i / G8), nc = (int)(i % G8) * 8;
            int oc;
            if (nc < 1280) oc = nc; else if (nc < 2816) oc = nc + 24; else if (nc < 3072) oc = nc + 24; else if (nc < 5120) oc = nc + 64;
            else if (nc < 5152) oc = nc - 5120 + 3096; else if (nc < 5176) oc = nc - 5152 + 1280; else oc = nc - 5176 + 3128;
            const float4 u = *(const float4*)(src_ + (size_t)k * DIN + oc), v = *(const float4*)(src_ + (size_t)k * DIN + oc + 4);
            uint4 o; o.x = pk2(u.x, u.y); o.y = pk2(u.z, u.w); o.z = pk2(v.x, v.y); o.w = pk2(v.z, v.w);
            *(uint4*)(dst_ + (size_t)k * DIN + nc) = o;
        }
    }
    cvt_weights(p.in[14], (bf16_t*)(p.ws + WB_A), (size_t)512 * D, bid, nb);
    cvt_weights(p.in[15], (bf16_t*)(p.ws + WB_B), (size_t)512 * D, bid, nb);
    cvt_weights(p.in[16], (bf16_t*)(p.ws + WB_OUT), (size_t)D * D, bid, nb);
    cvt_weights(p.in[26], (bf16_t*)(p.ws + WB_PLE), (size_t)256 * D, bid, nb);
    cvt_weights(p.in[1], (bf16_t*)(p.ws + WS_PB), (size_t)S * 256, bid, nb);
    cvt_weights(p.in[9], (bf16_t*)(p.ws + WB_CK1), (size_t)2048 * 64, bid, nb);
    cvt_weights(p.in[12], (bf16_t*)(p.ws + WB_CV1), (size_t)2048 * 64, bid, nb);
    const float* x = p.in[0];
    const float* g = p.in[3];
    bf16_t* hb = (bf16_t*)(p.ws + WS_HB);
    for (int t = bid * 4 + wave; t < S; t += nb * 4) {
        const float4* xr = (const float4*)(x + (size_t)t * D);
        float4 v[4];
        float ss = 0.f;
#pragma unroll
        for (int j = 0; j < 4; ++j) { v[j] = xr[lane + 64 * j]; ss += v[j].x * v[j].x + v[j].y * v[j].y + v[j].z * v[j].z + v[j].w * v[j].w; }
        ss = wave_sum(ss);
        const float rstd = rsqrtf(ss * (1.f / D) + EPS);
#pragma unroll
        for (int j = 0; j < 4; ++j) {
            const float4 gg = ((const float4*)g)[lane + 64 * j];
            uint2 o;
            o.x = pk2(v[j].x * rstd * gg.x, v[j].y * rstd * gg.y);
            o.y = pk2(v[j].z * rstd * gg.z, v[j].w * rstd * gg.w);
            ((uint2*)(hb + (size_t)t * D))[lane + 64 * j] = o;
        }
    }
}

__device__ __forceinline__ void phase_inproj(const Params& p, int bid, int nb, unsigned char* smem) {
    const int g2tid = tid_opaque();
    const bf16_t* hb = (const bf16_t*)(p.ws + WS_HB);
    const int lane = tid_opaque() & 63, fr = lane & 15;
    constexpr int NTN = (DIN + 127) / 128;
    for (int w = bid; w < 128 * NTN; w += nb) {
        const int mt = w % 128, nt = w / 128;
        const int m0 = mt * 128, n0 = nt * 128;
        const int ncols = (DIN - n0) < 128 ? (DIN - n0) : 128;
        f32x4 acc[4][4];
        gemm2<false, false>(hb, D, nullptr, m0, 128, (const bf16_t*)(p.ws + WB_IN), DIN, n0, ncols, D, smem, acc);
        const int cid = __builtin_amdgcn_readfirstlane((n0 >> 6) + ((tid_opaque() >> 6) & 1));
        if (cid > 80) continue;
        int kind; bf16_t* dst; int ld; const float* gain = nullptr; float scale = 1.f;
        if (cid < 8) { kind = 0; dst = (bf16_t*)(p.ws + WS_QNB) + cid * 64; ld = 512; gain = p.in[4]; scale = 0.125f * LOG2E; }
        else if (cid < 20) {
            const int j = cid - 8, kd = j >> 1, g = j & 1;
            ld = 64; kind = (kd == 2 || kd == 4) ? 0 : 1; gain = p.in[5];
            const size_t base = kd == 0 ? WS_KCR : kd == 1 ? WS_VCR : kd == 2 ? WS_KSLB : kd == 3 ? WS_VSLB : kd == 4 ? WS_KWNB : WS_VWNB;
            dst = (bf16_t*)(p.ws + base) + (size_t)g * S * 64;
        }
        else if (cid < 28) { kind = 0; dst = (bf16_t*)(p.ws + WS_DQB) + (cid - 20) * 64; ld = 512; gain = p.in[6]; scale = 0.125f * LOG2E; }
        else if (cid < 36) { kind = 0; dst = (bf16_t*)(p.ws + WS_DKB) + (cid - 28) * 64; ld = 512; gain = p.in[7]; }
        else if (cid < 44) { kind = 1; dst = (bf16_t*)(p.ws + WS_DVB) + (cid - 36) * 64; ld = 512; }
        else if (cid < 48) { kind = 1; dst = (bf16_t*)(p.ws + WS_IQB) + (cid - 44) * 64; ld = 256; scale = 0.17677669529663687f; }
        else if (cid < 64) { kind = 2; dst = (bf16_t*)(p.ws + WS_SGA) + (cid - 48) * 64; ld = D; }
        else if (cid < 80) { kind = 2; dst = (bf16_t*)(p.ws + WS_SGB) + (cid - 64) * 64; ld = D; }
        else { kind = 3; dst = nullptr; ld = 0; }
        if (kind == 0) {
            float gv[4];
#pragma unroll
            for (int j = 0; j < 4; ++j) gv[j] = gain[j * 16 + fr] * scale;
#pragma unroll
            for (int i = 0; i < 4; ++i)
#pragma unroll
                for (int r = 0; r < 4; ++r) {
                    float ss = acc[i][0][r] * acc[i][0][r] + acc[i][1][r] * acc[i][1][r] + acc[i][2][r] * acc[i][2][r] + acc[i][3][r] * acc[i][3][r];
                    ss += __shfl_xor(ss, 1); ss += __shfl_xor(ss, 2); ss += __shfl_xor(ss, 4); ss += __shfl_xor(ss, 8);
                    const float rstd = rsqrtf(ss * (1.f / 64.f) + EPS);
                    bf16_t* dr = dst + (size_t)(m0 + G2_ROW(i, r)) * ld + fr;
#pragma unroll
                    for (int j = 0; j < 4; ++j) dr[j * 16] = (bf16_t)f2bf(acc[i][j][r] * rstd * gv[j]);
                }
        } else if (kind == 1 || kind == 2) {
#pragma unroll
            for (int i = 0; i < 4; ++i)
#pragma unroll
                for (int r = 0; r < 4; ++r) {
                    bf16_t* dr = dst + (size_t)(m0 + G2_ROW(i, r)) * ld + fr;
#pragma unroll
                    for (int j = 0; j < 4; ++j) {
                        const float v = acc[i][j][r];
                        dr[j * 16] = (bf16_t)f2bf(kind == 2 ? sigmoidf_(v) : v * scale);
                    }
                }
        } else {
            bf16_t* ikb = (bf16_t*)(p.ws + WS_IKB);
            float* gt = (float*)(p.ws + WS_GT);
            float* iws = (float*)(p.ws + WS_IWS);
#pragma unroll
            for (int i = 0; i < 4; ++i)
#pragma unroll
                for (int r = 0; r < 4; ++r) {
                    const size_t t = (size_t)(m0 + G2_ROW(i, r));
                    ikb[t * 32 + fr] = (bf16_t)f2bf(acc[i][0][r]);
                    ikb[t * 32 + 16 + fr] = (bf16_t)f2bf(acc[i][1][r]);
                    gt[t * 32 + fr] = sigmoidf_(acc[i][2][r]);
                    if (fr < 8) gt[t * 32 + 16 + fr] = sigmoidf_(acc[i][3][r]);
                    else iws[t * 8 + fr - 8] = acc[i][3][r] * 0.35355339059327373f;
                }
        }
    }
}

__device__ __forceinline__ float rms64(float v) { return rsqrtf(wave_sum(v * v) * (1.f / 64.f) + EPS); }

__device__ __forceinline__ void phase_compress(const Params& p, int bid, int nb, unsigned char* smem) {
    const int g2tid = tid_opaque();
    const int tid = tid_opaque(), lane = tid & 63, wave = tid >> 6;
    float* cvec = (float*)(smem + 36864);
    float* hid = (float*)(smem + 36864 + 256);
    bf16_t* pw = (bf16_t*)(p.ws + WS_PW);
    for (int w = bid; w < 32 + 128 * 8; w += nb) {
        const bool is_c = w < 32;
        const int kind = w >> 4, g = (w >> 3) & 1;
        const int w2_ = w - 32;
        const int m0 = is_c ? (w & 7) * 128 : (w2_ % 128) * 128;
        const int n0 = is_c ? 0 : (w2_ / 128) * 128;
        const int mrows = is_c ? ((NCMP - m0) < 128 ? (NCMP - m0) : 128) : 128;
        const bf16_t* Ap = is_c ? (const bf16_t*)(p.ws + (kind ? WS_VCR : WS_KCR)) + (size_t)g * S * 64 : (const bf16_t*)(p.ws + WS_PB);
        const bf16_t* Bp = is_c ? (const bf16_t*)(p.ws + (kind ? WB_CV1 : WB_CK1)) : (const bf16_t*)(p.ws + WB_PLE);
        f32x4 acc[4][4];
        gemm2<false, false>(Ap, is_c ? 16 * 64 : 256, nullptr, m0, mrows, Bp, is_c ? 64 : D, n0, is_c ? 64 : 128, is_c ? 2048 : 256, smem, acc);
        if (!is_c) {
#pragma unroll
            for (int i = 0; i < 4; ++i)
#pragma unroll
                for (int r = 0; r < 4; ++r) {
                    bf16_t* pr = pw + (size_t)(m0 + G2_ROW(i, r)) * D + n0 + G2_COL(0);
#pragma unroll
                    for (int j = 0; j < 4; ++j) pr[j * 16] = (bf16_t)f2bf(acc[i][j][r]);
                }
            continue;
        }
        const float* pe = p.in[kind ? 11 : 8];
        const float* w1 = p.in[kind ? 12 : 9];
        const float* w2 = p.in[kind ? 13 : 10];
        {
            const int e = tid & 63, part = tid >> 6;
            float s = 0.f;
            for (int k = part * 512; k < part * 512 + 512; ++k) s += pe[k] * w1[(size_t)k * 64 + e];
            __syncthreads();
            hid[tid] = s;
            __syncthreads();
            if (tid < 64) cvec[tid] = hid[tid] + hid[64 + tid] + hid[128 + tid] + hid[192 + tid];
            __syncthreads();
        }
        if ((wave & 1) == 0) {
#pragma unroll
            for (int i = 0; i < 4; ++i)
#pragma unroll
                for (int j = 0; j < 4; ++j)
#pragma unroll
                    for (int r = 0; r < 4; ++r) {
                        const int row = G2_ROW(i, r), col = j * 16 + (lane & 15);
                        const float a = acc[i][j][r] + cvec[col];
                        hid[row * 65 + col] = a * sigmoidf_(a);
                    }
        }
        __syncthreads();
        const float gkn = p.in[5][lane];
        for (int row = wave; row < mrows; row += 4) {
            float o = 0.f;
#pragma unroll 8
            for (int e = 0; e < 64; ++e) o += hid[row * 65 + e] * w2[e * 64 + lane];
            if (kind == 0) o = o * rms64(o) * gkn;
            ((bf16_t*)(p.ws + (kind ? WS_VCB : WS_KCB)))[((size_t)g * 1024 + m0 + row) * 64 + lane] = (bf16_t)f2bf(o);
        }
        __syncthreads();
    }
    if (bid == nb - 1) {
        if (tid < 128) ((bf16_t*)(p.ws + WS_KCB))[((size_t)(tid >> 6) * 1024 + 1023) * 64 + (tid & 63)] = 0;
        else ((bf16_t*)(p.ws + WS_VCB))[((size_t)((tid - 128) >> 6) * 1024 + 1023) * 64 + (tid & 63)] = 0;
    }
}

constexpr int KSTR = 72;
constexpr int NSA_KT = 0;
constexpr int NSA_VT = NSA_KT + 32 * KSTR * 2;
constexpr int NSA_WV = NSA_VT + 32 * KSTR * 2;
constexpr int NSA_IMP = NSA_WV + 4 * 2 * 32 * KSTR * 2;
constexpr int NSA_LUT = NSA_IMP + 16 * 260 * 4;
constexpr int NSA_SEL = NSA_LUT + 4 * 128 * 4;
constexpr int NSA_STP = NSA_SEL + 16 * 16 * 4;
constexpr int NSA_END = NSA_STP + 4 * 128 * 4;
static_assert(NSA_END <= SMEM_BYTES, "nsa lds");

__device__ __forceinline__ f32x4 mfma16(bf16x8 a, bf16x8 b, f32x4 c) { return __builtin_amdgcn_mfma_f32_16x16x32_bf16(a, b, c, 0, 0, 0); }
__device__ __forceinline__ bf16x8 pack_p(const f32x4& p1, const f32x4& p2) {
    const unsigned a = pk2(p1[0], p1[1]), b = pk2(p1[2], p1[3]), c = pk2(p2[0], p2[1]), d = pk2(p2[2], p2[3]);
    return __builtin_bit_cast(bf16x8, make_uint4(a, b, c, d));
}
__device__ __forceinline__ void pv_step(f32x4 (&o)[4], const bf16_t* vt, bf16x8 pb, int fq, int fr) {
    const bf16_t* base = vt + (4 * fq + (fr >> 2)) * KSTR + 4 * (fr & 3);
#pragma unroll
    for (int dt = 0; dt < 4; ++dt) {
        const s16x4 lo4 = lds_tr16(base + dt * 16), hi4 = lds_tr16(base + 16 * KSTR + dt * 16);
        const bf16x8 va = (bf16x8){lo4[0], lo4[1], lo4[2], lo4[3], hi4[0], hi4[1], hi4[2], hi4[3]};
        o[dt] = mfma16(va, pb, o[dt]);
    }
}
__device__ __forceinline__ float quad_sum(float v) {
    v += __shfl_xor(v, 1);
    v += __shfl_xor(v, 2);
    return v;
}

__device__ __forceinline__ void nsa_tile(const Params& p, int tt, int g, unsigned char* smem) {
    const int tid = tid_opaque(), lane = tid & 63, wave = tid >> 6, fr = lane & 15, fq = lane >> 4;
    bf16_t* kt = (bf16_t*)(smem + NSA_KT);
    bf16_t* vt = (bf16_t*)(smem + NSA_VT);
    bf16_t* wv = (bf16_t*)(smem + NSA_WV) + wave * 2 * 32 * KSTR;
    float* imp = (float*)(smem + NSA_IMP);
    float* lut = (float*)(smem + NSA_LUT);
    int* sel = (int*)(smem + NSA_SEL);
    const bf16_t* qnb = (const bf16_t*)(p.ws + WS_QNB);
    const bf16_t* kslb = (const bf16_t*)(p.ws + WS_KSLB) + (size_t)g * S * 64;
    const bf16_t* vslb = (const bf16_t*)(p.ws + WS_VSLB) + (size_t)g * S * 64;
    const bf16_t* kwnb = (const bf16_t*)(p.ws + WS_KWNB) + (size_t)g * S * 64;
    const bf16_t* vwnb = (const bf16_t*)(p.ws + WS_VWNB) + (size_t)g * S * 64;
    const bf16_t* kcb = (const bf16_t*)(p.ws + WS_KCB) + (size_t)g * 1024 * 64;
    const bf16_t* vcb = (const bf16_t*)(p.ws + WS_VCB) + (size_t)g * 1024 * 64;
    const float* gt = (const float*)(p.ws + WS_GT);
    const float* relb = p.in[17];
    const int t0 = tt * 16;
    const int tl = 4 * wave + (fr >> 2);
    const int tok = t0 + tl;
    const int hl = fr & 3, head = g * 4 + hl;
    __syncthreads();
    for (int i = tid; i < 512; i += NT) { const int hh = i >> 7, n = i & 127; lut[i] = relb[bucket_of(n) * 16 + g * 4 + hh] * LOG2E; }
    for (int i = tid; i < 16 * 260; i += NT) imp[i] = 0.f;
    float U2;
    {
        const float mq = wave_max(fabsf(p.in[4][lane])), mk = wave_max(fabsf(p.in[5][lane]));
        float mb = 0.f;
#pragma unroll
        for (int k = 0; k < 4; ++k) { const int e = lane + 64 * k; mb = fmaxf(mb, fabsf(relb[(e >> 3) * 16 + (e & 7)])); }
        mb = wave_max(mb);
        U2 = (8.f * mq * mk + mb) * LOG2E;
    }
    bf16x8 qf[2];
#pragma unroll
    for (int kh = 0; kh < 2; ++kh) qf[kh] = *(const bf16x8*)(qnb + (size_t)tok * 512 + head * 64 + kh * 32 + fq * 8);
    __syncthreads();
    const float* lutp = lut + hl * 128;
    const float lutfar = lutp[127];
    const f32x4 zero4 = (f32x4){0.f, 0.f, 0.f, 0.f};
    f32x4 outacc[4];
#pragma unroll
    for (int dt = 0; dt < 4; ++dt) outacc[dt] = zero4;
    const float g0 = gt[(size_t)tok * 32 + head * 3 + 0], g1 = gt[(size_t)tok * 32 + head * 3 + 1], g2 = gt[(size_t)tok * 32 + head * 3 + 2];
    const int srow = tid >> 3, sch = tid & 7;

    bf16_t* ktb = (bf16_t*)(smem + NSA_WV);
    bf16_t* vtb = ktb + 2 * 64 * KSTR;
#define NSA_QK(KT_)                                                                                         \
        f32x4 s1 = zero4, s2 = zero4;                                                                       \
        _Pragma("unroll") for (int kh = 0; kh < 2; ++kh) {                                                  \
            const bf16x8 k1 = *(const bf16x8*)((KT_) + fr * KSTR + kh * 32 + fq * 8);                       \
            const bf16x8 k2 = *(const bf16x8*)((KT_) + (16 + fr) * KSTR + kh * 32 + fq * 8);                \
            s1 = mfma16(k1, qf[kh], s1);                                                                    \
            s2 = mfma16(k2, qf[kh], s2);                                                                    \
        }
    {
        int ks0 = (t0 - 511) & ~63; ks0 = ks0 < 0 ? 0 : ks0;
        const int nsteps = (t0 + 16 - ks0 + 63) >> 6;
        f32x4 o[4];
#pragma unroll
        for (int dt = 0; dt < 4; ++dt) o[dt] = zero4;
        float lsum = 0.f;
#define WIN_ROW(r_) ((r_) < S ? (r_) : S - 1)
        uint4 kr0 = *(const uint4*)(kwnb + (size_t)WIN_ROW(ks0 + srow) * 64 + sch * 8);
        uint4 kr1 = *(const uint4*)(kwnb + (size_t)WIN_ROW(ks0 + 32 + srow) * 64 + sch * 8);
        uint4 vr0 = *(const uint4*)(vwnb + (size_t)WIN_ROW(ks0 + srow) * 64 + sch * 8);
        uint4 vr1 = *(const uint4*)(vwnb + (size_t)WIN_ROW(ks0 + 32 + srow) * 64 + sch * 8);
#pragma unroll 1
        for (int st = 0; st < nsteps; ++st) {
            const int ksb = ks0 + st * 64;
            bf16_t* kt_ = ktb + (st & 1) * 64 * KSTR;
            bf16_t* vt_ = vtb + (st & 1) * 64 * KSTR;
            *(uint4*)(kt_ + srow * KSTR + sch * 8) = kr0; *(uint4*)(kt_ + (32 + srow) * KSTR + sch * 8) = kr1;
            *(uint4*)(vt_ + srow * KSTR + sch * 8) = vr0; *(uint4*)(vt_ + (32 + srow) * KSTR + sch * 8) = vr1;
            __syncthreads();
            if (st + 1 < nsteps) {
                kr0 = *(const uint4*)(kwnb + (size_t)WIN_ROW(ksb + 64 + srow) * 64 + sch * 8);
                kr1 = *(const uint4*)(kwnb + (size_t)WIN_ROW(ksb + 96 + srow) * 64 + sch * 8);
                vr0 = *(const uint4*)(vwnb + (size_t)WIN_ROW(ksb + 64 + srow) * 64 + sch * 8);
                vr1 = *(const uint4*)(vwnb + (size_t)WIN_ROW(ksb + 96 + srow) * 64 + sch * 8);
            }
#pragma unroll
            for (int hf = 0; hf < 2; ++hf) {
                const int ks = ksb + 32 * hf;
                if (ks > t0 + 15) continue;
                NSA_QK(kt_ + hf * 32 * KSTR)
                const bool far = (t0 + 4 * wave) - (ks + 31) >= 113;
                f32x4 p1, p2;
#pragma unroll
                for (int r = 0; r < 4; ++r) {
                    const int d1 = tok - (ks + 4 * fq + r), d2 = d1 - 16;
                    const float b1 = far ? lutfar : lutp[d1 < 0 ? 0 : (d1 > 127 ? 127 : d1)];
                    const float b2 = far ? lutfar : lutp[d2 < 0 ? 0 : (d2 > 127 ? 127 : d2)];
                    p1[r] = (d1 >= 0 && d1 < 512) ? __builtin_amdgcn_exp2f(s1[r] + b1 - U2) : 0.f;
                    p2[r] = (d2 >= 0 && d2 < 512) ? __builtin_amdgcn_exp2f(s2[r] + b2 - U2) : 0.f;
                    lsum += p1[r] + p2[r];
                }
                pv_step(o, vt_ + hf * 32 * KSTR, pack_p(p1, p2), fq, fr);
            }
        }
#undef WIN_ROW
        lsum += __shfl_xor(lsum, 16);
        lsum += __shfl_xor(lsum, 32);
        const float sc = lsum > 0.f ? g2 / lsum : 0.f;
#pragma unroll
        for (int dt = 0; dt < 4; ++dt)
#pragma unroll
            for (int r = 0; r < 4; ++r) outacc[dt][r] += sc * o[dt][r];
    }
    __syncthreads();

    {
        const int tlast = t0 + 15;
        const int cmax = (tlast >= 31) ? ((tlast - 31) >> 4) + 1 : 0;
        const int nsteps = (cmax + 63) >> 6;
        float inv_l = 0.f;
#pragma unroll 1
        for (int pass = 0; pass < 2; ++pass) {
            f32x4 o[4];
#pragma unroll
            for (int dt = 0; dt < 4; ++dt) o[dt] = zero4;
            float lsum = 0.f;
            uint4 kr0 = make_uint4(0, 0, 0, 0), kr1 = kr0, vr0 = kr0, vr1 = kr0;
            if (nsteps > 0) {
                kr0 = *(const uint4*)(kcb + (size_t)srow * 64 + sch * 8); kr1 = *(const uint4*)(kcb + (size_t)(32 + srow) * 64 + sch * 8);
                vr0 = *(const uint4*)(vcb + (size_t)srow * 64 + sch * 8); vr1 = *(const uint4*)(vcb + (size_t)(32 + srow) * 64 + sch * 8);
            }
#pragma unroll 1
            for (int st = 0; st < nsteps; ++st) {
                const int csb = st * 64;
                bf16_t* kt_ = ktb + (st & 1) * 64 * KSTR;
                bf16_t* vt_ = vtb + (st & 1) * 64 * KSTR;
                *(uint4*)(kt_ + srow * KSTR + sch * 8) = kr0; *(uint4*)(kt_ + (32 + srow) * KSTR + sch * 8) = kr1;
                *(uint4*)(vt_ + srow * KSTR + sch * 8) = vr0; *(uint4*)(vt_ + (32 + srow) * KSTR + sch * 8) = vr1;
                __syncthreads();
                if (st + 1 < nsteps) {
                    kr0 = *(const uint4*)(kcb + (size_t)(csb + 64 + srow) * 64 + sch * 8); kr1 = *(const uint4*)(kcb + (size_t)(csb + 96 + srow) * 64 + sch * 8);
                    vr0 = *(const uint4*)(vcb + (size_t)(csb + 64 + srow) * 64 + sch * 8); vr1 = *(const uint4*)(vcb + (size_t)(csb + 96 + srow) * 64 + sch * 8);
                }
#pragma unroll
                for (int hf = 0; hf < 2; ++hf) {
                    const int cs = csb + 32 * hf;
                    if (cs >= cmax) continue;
                    NSA_QK(kt_ + hf * 32 * KSTR)
                    const bool far = (t0 + 4 * wave) - (16 * (cs + 31) + 31) >= 113;
                    f32x4 p1, p2;
#pragma unroll
                    for (int r = 0; r < 4; ++r) {
                        const int d1 = tok - (16 * (cs + 4 * fq + r) + 31), d2 = d1 - 256;
                        const float b1 = far ? lutfar : lutp[d1 < 0 ? 0 : (d1 > 127 ? 127 : d1)];
                        const float b2 = far ? lutfar : lutp[d2 < 0 ? 0 : (d2 > 127 ? 127 : d2)];
                        p1[r] = (d1 >= 0) ? __builtin_amdgcn_exp2f(s1[r] + b1 - U2) : 0.f;
                        p2[r] = (d2 >= 0) ? __builtin_amdgcn_exp2f(s2[r] + b2 - U2) : 0.f;
                        lsum += p1[r] + p2[r];
                    }
                    if (pass == 1) {
#pragma unroll
                        for (int r = 0; r < 4; ++r) { p1[r] *= inv_l; p2[r] *= inv_l; }
                        f32x4 h1, h2;
#pragma unroll
                        for (int r = 0; r < 4; ++r) { h1[r] = quad_sum(p1[r]); h2[r] = quad_sum(p2[r]); }
                        if (hl == 0) {
                            float* ir = imp + tl * 260 + (cs >> 2) + fq;
                            atomicAdd(ir, h1[0] + h1[1] + h1[2] + 0.5f * h1[3]);
                            atomicAdd(ir + 1, 0.5f * h1[3]);
                            atomicAdd(ir + 4, h2[0] + h2[1] + h2[2] + 0.5f * h2[3]);
                            atomicAdd(ir + 5, 0.5f * h2[3]);
                        }
                        pv_step(o, vt_ + hf * 32 * KSTR, pack_p(p1, p2), fq, fr);
                    }
                }
            }
            __syncthreads();
            if (pass == 0) {
                lsum += __shfl_xor(lsum, 16);
                lsum += __shfl_xor(lsum, 32);
                inv_l = lsum > 0.f ? 1.f / lsum : 0.f;
            } else {
#pragma unroll
                for (int dt = 0; dt < 4; ++dt)
#pragma unroll
                    for (int r = 0; r < 4; ++r) outacc[dt][r] += g0 * o[dt][r];
            }
        }
    }
#undef NSA_QK
    __syncthreads();

#pragma unroll 1
    for (int tq = 0; tq < 4; ++tq) {
        const int tli = 4 * wave + tq, tk = t0 + tli, cur = tk >> 6;
        int* sl = sel + tli * 16;
        int nf = 0;
        if (lane == 0) {
            sl[0] = 0; int c_ = 1;
            if (cur - 1 >= 1) sl[c_++] = cur - 1;
            if (cur >= 1) sl[c_++] = cur;
            for (int k = c_; k < 16; ++k) sl[k] = -1;
        }
        nf = 1 + (cur - 1 >= 1 ? 1 : 0) + (cur >= 1 ? 1 : 0);
        const int ncand = cur - 2 > 0 ? cur - 2 : 0;
        int need = 16 - nf; need = need < ncand ? need : ncand;
        unsigned long long key[4];
#pragma unroll
        for (int k = 0; k < 4; ++k) {
            const int n = lane + 64 * k;
            const bool c = (n >= 1) && (n <= cur - 2);
            key[k] = c ? (((unsigned long long)__builtin_bit_cast(unsigned, imp[tli * 260 + n]) << 32) | (unsigned long long)(0xFFFFFFFFu - (unsigned)n)) + (1ull << 32) : 0ull;
        }
#pragma unroll 1
        for (int rd = 0; rd < need; ++rd) {
            unsigned long long m = key[0];
            m = key[1] > m ? key[1] : m; m = key[2] > m ? key[2] : m; m = key[3] > m ? key[3] : m;
#pragma unroll
            for (int o_ = 1; o_ < 64; o_ <<= 1) {
                const unsigned lo_ = __shfl_xor((unsigned)m, o_), hi_ = __shfl_xor((unsigned)(m >> 32), o_);
                const unsigned long long other = ((unsigned long long)hi_ << 32) | lo_;
                m = other > m ? other : m;
            }
            const int nstar = (int)(0xFFFFFFFFu - (unsigned)m);
#pragma unroll
            for (int k = 0; k < 4; ++k) if (key[k] == m) key[k] = 0ull;
            if (lane == 0) sl[nf + rd] = nstar;
        }
    }
    __syncthreads();

    {
        int* stp = (int*)(smem + NSA_STP) + wave * 128;
        int nst;
        {
            const int tq = lane >> 4, j = lane & 15;
            const int tk_ = t0 + 4 * wave + tq;
            const int b = sel[(4 * wave + tq) * 16 + j];
            const bool c1 = (b >= 0) && (b * 64 <= tk_), c2 = (b >= 0) && (b * 64 + 32 <= tk_);
            const unsigned long long m1 = __ballot(c1), m2 = __ballot(c2);
            const unsigned long long lt = (1ull << lane) - 1ull;
            const int pos = __builtin_popcountll(m1 & lt) + __builtin_popcountll(m2 & lt);
            if (c1) stp[pos] = (b * 64) | (tq << 20);
            if (c2) stp[pos + 1] = (b * 64 + 32) | (tq << 20);
            nst = __builtin_popcountll(m1) + __builtin_popcountll(m2);
        }
        asm volatile("" ::: "memory");
        uint2 oacc_pk[4];
#pragma unroll
        for (int dt = 0; dt < 4; ++dt) { oacc_pk[dt].x = pk2(outacc[dt][0], outacc[dt][1]); oacc_pk[dt].y = pk2(outacc[dt][2], outacc[dt][3]); }
        f32x4 o[4];
#pragma unroll
        for (int dt = 0; dt < 4; ++dt) o[dt] = zero4;
        float lsum = 0.f;
        const int r8 = lane >> 3, c8 = lane & 7;
        bf16_t* slot0 = wv;
        bf16_t* slot1 = wv + 32 * KSTR;
        bf16_t* kslot = (bf16_t*)(smem + NSA_IMP) + wave * 32 * 64;
        uint4 ka0, ka1, ka2, ka3, kb0, kb1, kb2, kb3;
        uint4 va0, va1, va2, va3;
#define SLC_STEP(i_) __builtin_amdgcn_readfirstlane(stp[(i_) < nst ? (i_) : nst - 1])
#define SLC_KLOAD(K_, w_)                                                                                           \
        { const uint4* kp_ = (const uint4*)(kslb + (size_t)(((w_) & 0xFFFFF) + r8) * 64 + c8 * 8);                      \
          K_##0 = kp_[0]; K_##1 = kp_[64]; K_##2 = kp_[128]; K_##3 = kp_[192]; }
#define SLC_VLOAD(V_, w_)                                                                                           \
        { const uint4* vs_ = (const uint4*)(vslb + (size_t)(((w_) & 0xFFFFF) + r8) * 64 + c8 * 8);                      \
          V_##0 = vs_[0]; V_##1 = vs_[64]; V_##2 = vs_[128]; V_##3 = vs_[192]; }
#define SLC_VSTORE(V_, slot_)                                                                                       \
        { bf16_t* vd_ = (slot_) + r8 * KSTR + c8 * 8;                                                               \
          *(uint4*)(vd_) = V_##0; *(uint4*)(vd_ + 8 * KSTR) = V_##1; *(uint4*)(vd_ + 16 * KSTR) = V_##2; *(uint4*)(vd_ + 24 * KSTR) = V_##3; }
#define SLC_KSTORE(K_)                                                                                              \
        { bf16_t* kd_ = kslot + r8 * 64 + ((c8 ^ r8) * 8);                                                          \
          *(uint4*)(kd_) = K_##0; *(uint4*)(kd_ + 8 * 64) = K_##1; *(uint4*)(kd_ + 16 * 64) = K_##2; *(uint4*)(kd_ + 24 * 64) = K_##3; }
#define SLC_STAGE(s_, K_, VW_, slotr_, slotw_)                                                                      \
        {                                                                                                           \
            const int wcur = SLC_STEP(s_), wk = SLC_STEP((s_) + 2);                                                 \
            SLC_KSTORE(K_)                                                            \
            SLC_VSTORE(VW_, slotw_)                                                      \
            asm volatile("" ::: "memory");                                                                          \
            SLC_VLOAD(VW_, wk)                                                                     \
            SLC_KLOAD(K_, wk)                                                                      \
            f32x4 s1 = zero4, s2 = zero4;                                                                           \
            _Pragma("unroll") for (int kh = 0; kh < 2; ++kh) {                                                      \
                const bf16x8 k1 = *(const bf16x8*)(kslot + fr * 64 + (((kh * 4 + fq) ^ (fr & 7)) * 8));             \
                const bf16x8 k2 = *(const bf16x8*)(kslot + (16 + fr) * 64 + (((kh * 4 + fq) ^ (fr & 7)) * 8));      \
                s1 = mfma16(k1, qf[kh], s1); s2 = mfma16(k2, qf[kh], s2);                                           \
            }                                                                                                       \
            const int ks = wcur & 0xFFFFF, tq = wcur >> 20, tk = t0 + 4 * wave + tq;                                \
            const bool mine = (fr >> 2) == tq;                                                                      \
            const bool far = tk - (ks + 31) >= 113;                                                                 \
            f32x4 p1, p2;                                                                                           \
            _Pragma("unroll") for (int r = 0; r < 4; ++r) {                                                         \
                const int d1 = tk - (ks + 4 * fq + r), d2 = d1 - 16;                                                \
                const float b1 = far ? lutfar : lutp[d1 < 0 ? 0 : (d1 > 127 ? 127 : d1)];                           \
                const float b2 = far ? lutfar : lutp[d2 < 0 ? 0 : (d2 > 127 ? 127 : d2)];                           \
                p1[r] = (mine && d1 >= 0) ? __builtin_amdgcn_exp2f(s1[r] + b1 - U2) : 0.f;                          \
                p2[r] = (mine && d2 >= 0) ? __builtin_amdgcn_exp2f(s2[r] + b2 - U2) : 0.f;                          \
                lsum += p1[r] + p2[r];                                                                              \
            }                                                                                                       \
            asm volatile("" ::: "memory");                                                                          \
            pv_step(o, slotr_, pack_p(p1, p2), fq, fr);                                                             \
            asm volatile("" ::: "memory");                                                                          \
        }
        {
            const int w0 = SLC_STEP(0), w1 = SLC_STEP(1);
            SLC_VLOAD(va, w0)
            SLC_KLOAD(ka, w0)
            SLC_KLOAD(kb, w1)
            SLC_VSTORE(va, slot0)
            SLC_VLOAD(va, w1)
        }
#pragma unroll 1
        for (int s = 0; s < nst; s += 2) {
            SLC_STAGE(s, ka, va, slot0, slot1)
            if (s + 1 < nst) SLC_STAGE(s + 1, kb, va, slot1, slot0)
        }
#undef SLC_STEP
#undef SLC_KLOAD
#undef SLC_VLOAD
#undef SLC_VSTORE
#undef SLC_KSTORE
#undef SLC_STAGE
        lsum += __shfl_xor(lsum, 16);
        lsum += __shfl_xor(lsum, 32);
        const float sc = lsum > 0.f ? g1 / lsum : 0.f;
#pragma unroll
        for (int dt = 0; dt < 4; ++dt) {
            outacc[dt][0] = __builtin_bit_cast(float, oacc_pk[dt].x << 16) + sc * o[dt][0];
            outacc[dt][1] = __builtin_bit_cast(float, oacc_pk[dt].x & 0xffff0000u) + sc * o[dt][1];
            outacc[dt][2] = __builtin_bit_cast(float, oacc_pk[dt].y << 16) + sc * o[dt][2];
            outacc[dt][3] = __builtin_bit_cast(float, oacc_pk[dt].y & 0xffff0000u) + sc * o[dt][3];
        }
    }
    bf16_t* orow = (bf16_t*)(p.ws + WS_OA) + (size_t)tok * 512 + head * 64 + 4 * fq;
#pragma unroll
    for (int dt = 0; dt < 4; ++dt) {
        uint2 v; v.x = pk2(outacc[dt][0], outacc[dt][1]); v.y = pk2(outacc[dt][2], outacc[dt][3]);
        *(uint2*)(orow + dt * 16) = v;
    }
}

typedef float f32x16 __attribute__((ext_vector_type(16)));
constexpr int DSA_CK = 0;
constexpr int DSA_CI = DSA_CK + 16 * 512 * 4;
constexpr int DSA_LUT = DSA_CI + 16 * 512 * 2;
constexpr int DSA_END = DSA_LUT + 8 * 128 * 4;
static_assert(DSA_END <= SMEM_BYTES, "dsa lds");

__device__ __forceinline__ unsigned mono_key(float s) {
    const unsigned u = __builtin_bit_cast(unsigned, s + 0.0f);
    return (u & 0x80000000u) ? ~u : (u | 0x80000000u);
}
__device__ __forceinline__ unsigned dsa_compact(unsigned* ck, unsigned short* ci, int n, int lane) {
    unsigned kk[8]; unsigned ii[8];
#pragma unroll
    for (int k = 0; k < 8; ++k) { const int e = lane + 64 * k; kk[k] = e < n ? ck[e] : 0u; ii[k] = e < n ? (unsigned)ci[e] : 0xFFFFu; }
    unsigned T = 0;
#pragma unroll 1
    for (int b = 31; b >= 0; --b) {
        const unsigned cand = T | (1u << b);
        int c = 0;
#pragma unroll
        for (int k = 0; k < 8; ++k) c += __builtin_popcountll(__ballot(kk[k] >= cand));
        if (c >= 256) T = cand;
    }
    int cgt = 0, ceq = 0;
#pragma unroll
    for (int k = 0; k < 8; ++k) { cgt += __builtin_popcountll(__ballot(kk[k] > T)); ceq += __builtin_popcountll(__ballot(kk[k] == T)); }
    const int need = 256 - cgt;
    unsigned X = 0xFFFFu;
    if (ceq > need) {
        X = 0;
#pragma unroll 1
        for (int b = 15; b >= 0; --b) {
            const unsigned cand = X | (1u << b);
            int c = 0;
#pragma unroll
            for (int k = 0; k < 8; ++k) c += __builtin_popcountll(__ballot(kk[k] == T && ii[k] < cand));
            if (c < need) X = cand;
        }
    }
    int base = 0;
    const unsigned long long lt = (1ull << lane) - 1ull;
#pragma unroll
    for (int k = 0; k < 8; ++k) {
        const bool keep = (kk[k] > T) || (kk[k] == T && ii[k] <= X);
        const unsigned long long m = __ballot(keep);
        if (keep) { const int pos = base + __builtin_popcountll(m & lt); ck[pos] = kk[k]; ci[pos] = (unsigned short)ii[k]; }
        base += __builtin_popcountll(m);
    }
    return T;
}

__device__ __forceinline__ void dsa_tile(const Params& p, int tt, unsigned char* smem) {
    const int tid = tid_opaque(), lane = tid & 63, wave = tid >> 6, col = lane & 31, hi = lane >> 5;
    unsigned* ckb = (unsigned*)(smem + DSA_CK);
    unsigned short* cib = (unsigned short*)(smem + DSA_CI);
    const bf16_t* iqb = (const bf16_t*)(p.ws + WS_IQB);
    const bf16_t* ikb = (const bf16_t*)(p.ws + WS_IKB);
    const float* iws = (const float*)(p.ws + WS_IWS);
    const int t0 = tt * 16;
    __syncthreads();
    const int tw = t0 + 4 * wave;
    bf16x8 af[2];
    {
        const int rho = col;
        const int tl_ = 2 * ((rho >> 2) & 1) + (rho >> 4), hd = 4 * ((rho >> 3) & 1) + (rho & 3);
#pragma unroll
        for (int ks = 0; ks < 2; ++ks) af[ks] = *(const bf16x8*)(iqb + (size_t)(tw + tl_) * 256 + hd * 32 + ks * 16 + hi * 8);
    }
    const int tokA = tw + 2 * hi, tokB = tokA + 1;
    float wA[8], wB[8];
#pragma unroll
    for (int h = 0; h < 8; ++h) { wA[h] = iws[(size_t)tokA * 8 + h]; wB[h] = iws[(size_t)tokB * 8 + h]; }
    unsigned* ckA = ckb + (4 * wave + 2 * hi) * 512;
    unsigned* ckB = ckA + 512;
    unsigned short* ciA = cib + (4 * wave + 2 * hi) * 512;
    unsigned short* ciB = ciA + 512;
    int cntA = 0, cntB = 0;
    unsigned LA = 0, LB = 0;
    const unsigned ltm = (1u << col) - 1u;
    const int nchunk = (tw + 4 + 31) >> 5;
    const f32x16 zero16 = {0.f, 0.f, 0.f, 0.f, 0.f, 0.f, 0.f, 0.f, 0.f, 0.f, 0.f, 0.f, 0.f, 0.f, 0.f, 0.f};
    bf16x8 nx0[4], nx1[4];
    const bf16_t* ikl = ikb + (size_t)col * 32 + hi * 8;
#pragma unroll
    for (int j = 0; j < 4; ++j) {
        const int cj = j < nchunk ? j : nchunk - 1;
        nx0[j] = *(const bf16x8*)(ikl + (size_t)cj * 1024); nx1[j] = *(const bf16x8*)(ikl + (size_t)cj * 1024 + 16);
    }
#pragma unroll 1
    for (int ch4 = 0; ch4 < nchunk; ch4 += 4) {
#pragma unroll
        for (int j = 0; j < 4; ++j) {
            const int ch = ch4 + j;
            const bf16x8 cu0 = nx0[j], cu1 = nx1[j];
            {
                int cj = ch + 4; cj = cj < nchunk ? cj : nchunk - 1;
                nx0[j] = *(const bf16x8*)(ikl + (size_t)cj * 1024); nx1[j] = *(const bf16x8*)(ikl + (size_t)cj * 1024 + 16);
            }
            if (ch < nchunk) {
                const int kidx = ch * 32 + col;
                f32x16 c = __builtin_amdgcn_mfma_f32_32x32x16_bf16(af[0], cu0, zero16, 0, 0, 0);
                c = __builtin_amdgcn_mfma_f32_32x32x16_bf16(af[1], cu1, c, 0, 0, 0);
                float sA = 0.f, sB = 0.f;
#pragma unroll
                for (int h = 0; h < 8; ++h) { sA += wA[h] * fmaxf(c[h], 0.f); sB += wB[h] * fmaxf(c[8 + h], 0.f); }
                const unsigned keyA = mono_key(sA), keyB = mono_key(sB);
                const bool pA = (kidx <= tokA) && (keyA > LA), pB = (kidx <= tokB) && (keyB > LB);
                const unsigned long long mA = __ballot(pA), mB = __ballot(pB);
                const unsigned hA = hi ? (unsigned)(mA >> 32) : (unsigned)mA, hB = hi ? (unsigned)(mB >> 32) : (unsigned)mB;
                if (pA) { const int pos = cntA + __builtin_popcount(hA & ltm); ckA[pos] = keyA; ciA[pos] = (unsigned short)kidx; }
                if (pB) { const int pos = cntB + __builtin_popcount(hB & ltm); ckB[pos] = keyB; ciB[pos] = (unsigned short)kidx; }
                cntA += __builtin_popcount(hA); cntB += __builtin_popcount(hB);
            }
        }
        if (__any((cntA > 384) || (cntB > 384))) {
#pragma unroll
            for (int tq = 0; tq < 4; ++tq) {
                const int cn = __shfl((tq & 1) ? cntB : cntA, (tq >> 1) * 32);
                if (cn > 384) {
                    const unsigned T = dsa_compact(ckb + (4 * wave + tq) * 512, cib + (4 * wave + tq) * 512, cn, lane);
                    if (hi == (tq >> 1)) { if (tq & 1) { cntB = 256; LB = T; } else { cntA = 256; LA = T; } }
                }
            }
        }
    }
#pragma unroll
    for (int tq = 0; tq < 4; ++tq) {
        const int cn = __shfl((tq & 1) ? cntB : cntA, (tq >> 1) * 32);
        if (cn > 256) {
            (void)dsa_compact(ckb + (4 * wave + tq) * 512, cib + (4 * wave + tq) * 512, cn, lane);
            if (hi == (tq >> 1)) { if (tq & 1) cntB = 256; else cntA = 256; }
        }
    }
    unsigned short* selg = (unsigned short*)(p.ws + WS_SEL);
    int* nselg = (int*)(p.ws + WS_NSEL);
#pragma unroll
    for (int tq = 0; tq < 4; ++tq) {
        int nsel = __shfl((tq & 1) ? cntB : cntA, (tq >> 1) * 32);
        nsel = nsel > 256 ? 256 : nsel;
        const unsigned short* sl = cib + (4 * wave + tq) * 512;
#pragma unroll
        for (int k = 0; k < 4; ++k) { const int e = lane + 64 * k; selg[(size_t)(tw + tq) * 256 + e] = e < nsel ? sl[e] : (unsigned short)0; }
        if (lane == 0) nselg[tw + tq] = nsel;
    }
}

__device__ __forceinline__ void phase_dsa_attn(const Params& p, int bid, int nb, unsigned char* smem) {
    const int tid = tid_opaque(), lane = tid & 63, wave = tid >> 6, slot = lane >> 3, chunk = lane & 7;
    float* lut = (float*)smem;
    const bf16_t* dqb = (const bf16_t*)(p.ws + WS_DQB);
    const bf16_t* dkb = (const bf16_t*)(p.ws + WS_DKB);
    const bf16_t* dvb = (const bf16_t*)(p.ws + WS_DVB);
    const unsigned short* selg = (const unsigned short*)(p.ws + WS_SEL);
    const int* nselg = (const int*)(p.ws + WS_NSEL);
    const float* relb = p.in[17];
    const int h = bid & 7, bh = bid >> 3, nbh = nb >> 3;
    __syncthreads();
    if (tid < 128) lut[tid] = relb[bucket_of(tid) * 16 + 8 + h] * LOG2E;
    float U2;
    {
        const float mq = wave_max(fabsf(p.in[6][lane])), mk = wave_max(fabsf(p.in[7][lane]));
        float mb = 0.f;
#pragma unroll
        for (int k = 0; k < 4; ++k) { const int e = lane + 64 * k; mb = fmaxf(mb, fabsf(relb[(e >> 3) * 16 + 8 + (e & 7)])); }
        mb = wave_max(mb);
        U2 = (8.f * mq * mk + mb) * LOG2E;
    }
    __syncthreads();
    const bf16_t* kbase = dkb + h * 64 + chunk * 8;
    const bf16_t* vbase = dvb + h * 64 + chunk * 8;
#pragma unroll 1
    for (int t = bh * 4 + wave; t < S; t += nbh * 4) {
        const int nsel = nselg[t];
        const uint2* ip = (const uint2*)(selg + (size_t)t * 256 + slot * 32);
        float q[8];
        {
            const uint4 qv = *(const uint4*)(dqb + (size_t)t * 512 + h * 64 + chunk * 8);
            q[0] = __builtin_bit_cast(float, qv.x << 16); q[1] = __builtin_bit_cast(float, qv.x & 0xffff0000u);
            q[2] = __builtin_bit_cast(float, qv.y << 16); q[3] = __builtin_bit_cast(float, qv.y & 0xffff0000u);
            q[4] = __builtin_bit_cast(float, qv.z << 16); q[5] = __builtin_bit_cast(float, qv.z & 0xffff0000u);
            q[6] = __builtin_bit_cast(float, qv.w << 16); q[7] = __builtin_bit_cast(float, qv.w & 0xffff0000u);
        }
        float o[8];
#pragma unroll
        for (int j = 0; j < 8; ++j) o[j] = 0.f;
        float lsum = 0.f;
        int sA_[4], sB_[4];
        uint4 kA_[4], vA_[4], kB_[4], vB_[4];
        uint2 idn = ip[0];
#define DSA_LOADG(S_, K_, V_, I_)                                                        \
        S_[0] = (int)((I_).x & 0xffffu); S_[1] = (int)((I_).x >> 16); S_[2] = (int)((I_).y & 0xffffu); S_[3] = (int)((I_).y >> 16); \
        _Pragma("unroll") for (int j = 0; j < 4; ++j) {                                 \
            K_[j] = *(const uint4*)(kbase + (size_t)S_[j] * 512);                        \
            V_[j] = *(const uint4*)(vbase + (size_t)S_[j] * 512);                        \
        }
#define DSA_COMPG(S_, K_, V_, gi)                                                        \
        _Pragma("unroll") for (int j = 0; j < 4; ++j) {                                 \
            const uint4 kv = K_[j], vv = V_[j];                                          \
            float d = q[0] * __builtin_bit_cast(float, kv.x << 16) + q[1] * __builtin_bit_cast(float, kv.x & 0xffff0000u) \
                    + q[2] * __builtin_bit_cast(float, kv.y << 16) + q[3] * __builtin_bit_cast(float, kv.y & 0xffff0000u) \
                    + q[4] * __builtin_bit_cast(float, kv.z << 16) + q[5] * __builtin_bit_cast(float, kv.z & 0xffff0000u) \
                    + q[6] * __builtin_bit_cast(float, kv.w << 16) + q[7] * __builtin_bit_cast(float, kv.w & 0xffff0000u); \
            d += __shfl_xor(d, 1); d += __shfl_xor(d, 2); d += __shfl_xor(d, 4);       \
            int dist = t - S_[j]; dist = dist > 127 ? 127 : (dist < 0 ? 0 : dist);       \
            float pr = __builtin_amdgcn_exp2f(d + lut[dist] - U2);                       \
            pr = (slot * 32 + (gi) * 4 + j < nsel) ? pr : 0.f;                           \
            lsum += pr;                                                                  \
            o[0] += pr * __builtin_bit_cast(float, vv.x << 16); o[1] += pr * __builtin_bit_cast(float, vv.x & 0xffff0000u); \
            o[2] += pr * __builtin_bit_cast(float, vv.y << 16); o[3] += pr * __builtin_bit_cast(float, vv.y & 0xffff0000u); \
            o[4] += pr * __builtin_bit_cast(float, vv.z << 16); o[5] += pr * __builtin_bit_cast(float, vv.z & 0xffff0000u); \
            o[6] += pr * __builtin_bit_cast(float, vv.w << 16); o[7] += pr * __builtin_bit_cast(float, vv.w & 0xffff0000u); \
        }
        DSA_LOADG(sA_, kA_, vA_, idn)
        idn = ip[1];
#pragma unroll 1
        for (int gi = 0; gi < 8; gi += 2) {
            DSA_LOADG(sB_, kB_, vB_, idn)
            idn = ip[gi + 2 < 8 ? gi + 2 : 7];
            DSA_COMPG(sA_, kA_, vA_, gi)
            DSA_LOADG(sA_, kA_, vA_, idn)
            idn = ip[gi + 3 < 8 ? gi + 3 : 7];
            DSA_COMPG(sB_, kB_, vB_, gi + 1)
        }
#undef DSA_LOADG
#undef DSA_COMPG
#pragma unroll
        for (int j = 0; j < 8; ++j) { o[j] += __shfl_xor(o[j], 8); o[j] += __shfl_xor(o[j], 16); o[j] += __shfl_xor(o[j], 32); }
        lsum += __shfl_xor(lsum, 8); lsum += __shfl_xor(lsum, 16); lsum += __shfl_xor(lsum, 32);
        if (slot == 0) {
            const float inv = lsum > 0.f ? 1.f / lsum : 0.f;
            uint4 ov;
            ov.x = pk2(o[0] * inv, o[1] * inv); ov.y = pk2(o[2] * inv, o[3] * inv); ov.z = pk2(o[4] * inv, o[5] * inv); ov.w = pk2(o[6] * inv, o[7] * inv);
            *(uint4*)((bf16_t*)(p.ws + WS_OB) + (size_t)t * 512 + h * 64 + chunk * 8) = ov;
        }
    }
}

__device__ __forceinline__ void convert_late_weights(const Params& p, int bid, int nb) {
    cvt_weights(p.in[21], (bf16_t*)(p.ws + WB_E1), (size_t)NEXP * D * 2 * DFF, bid, nb);
    cvt_weights(p.in[23], (bf16_t*)(p.ws + WB_E2), (size_t)NEXP * DFF * D, bid, nb);
    cvt_weights(p.in[27], (bf16_t*)(p.ws + WB_PLEG), (size_t)D * D, bid, nb);
}
__device__ __forceinline__ void phase_attn(const Params& p, int bid, int nb, unsigned char* smem) {
    const bool conv_first = bid < (nb >> 1);
    if (conv_first) convert_late_weights(p, bid, nb);
#pragma unroll 1
    for (int part = 0; part < 2; ++part) {
        if ((part == 0) == conv_first) {
#pragma unroll 1
        for (int w = bid, rd = 0; w < 1024; w += nb, ++rd) {
            const int r0 = w - bid;
            const int cnt = (1024 - r0) < nb ? (1024 - r0) : nb;
            const int k = (rd & 1) ? (cnt - 1 - bid) : bid;
            dsa_tile(p, 1023 - (r0 + k), smem);
        }
    }
        else {
#pragma unroll 1
        for (int i = bid, rd = 0; i < 2048; i += nb, ++rd) {
            const int r0 = i - bid;
            const int cnt = (2048 - r0) < nb ? (2048 - r0) : nb;
            const int k = ((rd & 1) && !(cnt & 1)) ? 2 * ((cnt >> 1) - 1 - (bid >> 1)) + (bid & 1) : bid;
            const int j = r0 + k;
            nsa_tile(p, 1023 - (j >> 1), j & 1, smem);
        }
    }
    }
    if (!conv_first) convert_late_weights(p, bid, nb);
}

template <int PASS>
__device__ __forceinline__ void phase_merge(const Params& p, int bid, int nb, unsigned char* smem) {
    const int g2tid = tid_opaque();
    const bf16_t* sg = (const bf16_t*)(p.ws + (PASS ? WS_SGB : WS_SGA));
    bf16_t* merged = (bf16_t*)(p.ws + WS_MERGED);
    float* tmp = (float*)(p.ws + WS_X1);
    const bf16_t* A = (const bf16_t*)(p.ws + (PASS ? WS_OB : WS_OA));
    const bf16_t* Bw = (const bf16_t*)(p.ws + (PASS ? WB_B : WB_A));
    for (int w = bid; w < 128 * 8; w += nb) {
        const int mt = w % 128, nt = w / 128;
        const int m0 = mt * 128, n0 = nt * 128;
        f32x4 acc[4][4];
        gemm2<false, false>(A, 512, nullptr, m0, 128, Bw, D, n0, 128, 512, smem, acc);
#pragma unroll
        for (int i = 0; i < 4; ++i)
#pragma unroll
            for (int r = 0; r < 4; ++r) {
                const int row = m0 + G2_ROW(i, r);
                const bf16_t* zr = sg + (size_t)row * D + n0 + G2_COL(0);
                float* tr = tmp + (size_t)row * D + n0 + G2_COL(0);
                bf16_t* mr = merged + (size_t)row * D + n0 + G2_COL(0);
#pragma unroll
                for (int j = 0; j < 4; ++j) {
                    const float v = bf2f(zr[j * 16]) * acc[i][j][r];
                    if (PASS == 0) tr[j * 16] = v;
                    else mr[j * 16] = (bf16_t)f2bf(tr[j * 16] + v);
                }
            }
    }
}

__device__ __forceinline__ void phase_outproj(const Params& p, int bid, int nb, unsigned char* smem) {
    const int g2tid = tid_opaque();
    const bf16_t* merged = (const bf16_t*)(p.ws + WS_MERGED);
    const float* x = p.in[0];
    float* x1 = (float*)(p.ws + WS_X1);
    for (int w = bid; w < 128 * 8; w += nb) {
        const int mt = w % 128, nt = w / 128;
        const int m0 = mt * 128, n0 = nt * 128;
        f32x4 acc[4][4];
        gemm2<false, false>(merged, D, nullptr, m0, 128, (const bf16_t*)(p.ws + WB_OUT), D, n0, 128, D, smem, acc);
#pragma unroll
        for (int i = 0; i < 4; ++i)
#pragma unroll
            for (int r = 0; r < 4; ++r) {
                const size_t ro = (size_t)(m0 + G2_ROW(i, r)) * D + n0;
#pragma unroll
                for (int j = 0; j < 4; ++j) { const int c = G2_COL(j); x1[ro + c] = x[ro + c] + acc[i][j][r]; }
            }
    }
}

__device__ __forceinline__ void phase_route(const Params& p, int bid, int nb) {
    const int lane = tid_opaque() & 63, wave = tid_opaque() >> 6;
    const float* x1 = (const float*)(p.ws + WS_X1);
    const float* g = p.in[18];
    const float* wr = p.in[19];
    const float* br = p.in[20];
    bf16_t* hb = (bf16_t*)(p.ws + WS_HB);
    int* topi = (int*)(p.ws + WS_TOPI);
    float* topw = (float*)(p.ws + WS_TOPW);
    int* cnt = (int*)(p.ws + WS_CTL);
    for (int t = bid * 4 + wave; t < S; t += nb * 4) {
        const float4* xr = (const float4*)(x1 + (size_t)t * D);
        float4 v[4];
        float ss = 0.f;
#pragma unroll
        for (int j = 0; j < 4; ++j) { v[j] = xr[lane + 64 * j]; ss += v[j].x * v[j].x + v[j].y * v[j].y + v[j].z * v[j].z + v[j].w * v[j].w; }
        ss = wave_sum(ss);
        const float rstd = rsqrtf(ss * (1.f / D) + EPS);
        float lg[32];
#pragma unroll
        for (int e = 0; e < 32; ++e) lg[e] = 0.f;
#pragma unroll
        for (int j = 0; j < 4; ++j) {
            const float4 gg = ((const float4*)g)[lane + 64 * j];
            const float h0 = v[j].x * rstd * gg.x, h1 = v[j].y * rstd * gg.y, h2 = v[j].z * rstd * gg.z, h3 = v[j].w * rstd * gg.w;
            uint2 o; o.x = pk2(h0, h1); o.y = pk2(h2, h3);
            ((uint2*)(hb + (size_t)t * D))[lane + 64 * j] = o;
            const int k = 4 * (lane + 64 * j);
            const float4* w0 = (const float4*)(wr + (size_t)k * 32);
#pragma unroll
            for (int e4 = 0; e4 < 8; ++e4) {
                const float4 a = w0[e4], b = w0[8 + e4], c = w0[16 + e4], d = w0[24 + e4];
                lg[4 * e4 + 0] += h0 * a.x + h1 * b.x + h2 * c.x + h3 * d.x;
                lg[4 * e4 + 1] += h0 * a.y + h1 * b.y + h2 * c.y + h3 * d.y;
                lg[4 * e4 + 2] += h0 * a.z + h1 * b.z + h2 * c.z + h3 * d.z;
                lg[4 * e4 + 3] += h0 * a.w + h1 * b.w + h2 * c.w + h3 * d.w;
            }
        }
#pragma unroll
        for (int e = 0; e < 32; ++e) lg[e] = wave_sum(lg[e]) + br[e];
        int idx[4]; float val[4];
        unsigned used = 0;
#pragma unroll
        for (int k = 0; k < 4; ++k) {
            float best = -__builtin_inff(); int bi = 0;
#pragma unroll
            for (int e = 0; e < 32; ++e) { const bool ok = !((used >> e) & 1u) && (lg[e] > best); best = ok ? lg[e] : best; bi = ok ? e : bi; }
            idx[k] = bi; val[k] = best; used |= 1u << bi;
        }
        const float e0 = 1.f, e1 = __expf(val[1] - val[0]), e2 = __expf(val[2] - val[0]), e3 = __expf(val[3] - val[0]);
        const float inv = 1.f / (e0 + e1 + e2 + e3);
        if (lane == 0) {
            topi[t * 4 + 0] = idx[0]; topi[t * 4 + 1] = idx[1]; topi[t * 4 + 2] = idx[2]; topi[t * 4 + 3] = idx[3];
            topw[t * 4 + 0] = e0 * inv; topw[t * 4 + 1] = e1 * inv; topw[t * 4 + 2] = e2 * inv; topw[t * 4 + 3] = e3 * inv;
            atomicAdd(&cnt[idx[0]], 1); atomicAdd(&cnt[idx[1]], 1); atomicAdd(&cnt[idx[2]], 1); atomicAdd(&cnt[idx[3]], 1);
        }
    }
}

__device__ __forceinline__ void phase_place(const Params& p, int bid, int nb, unsigned char* smem) {
    int* off = (int*)smem;
    const int* cnt = (const int*)(p.ws + WS_CTL);
    int* cur = (int*)(p.ws + WS_CTL) + 32;
    const int* topi = (const int*)(p.ws + WS_TOPI);
    int* ppos = (int*)(p.ws + WS_PPOS);
    int* rowtok = (int*)(p.ws + WS_ROWTOK);
    __syncthreads();
    if (tid_opaque() == 0) { int a = 0; for (int e = 0; e < NEXP; ++e) { off[e] = a; a += cnt[e]; } }
    __syncthreads();
    for (int i = bid * NT + tid_opaque(); i < S * 4; i += nb * NT) {
        const int e = topi[i];
        const int pos = off[e] + atomicAdd(&cur[e], 1);
        ppos[i] = pos;
        rowtok[pos] = i >> 2;
    }
}

__device__ __forceinline__ void moe_tile_map(const int* cnt, int* sm, int& total_mt) {
    __syncthreads();
    if (tid_opaque() == 0) {
        int a = 0, b = 0;
        for (int e = 0; e < NEXP; ++e) { sm[e] = a; sm[33 + e] = b; a += (cnt[e] + 127) >> 7; b += cnt[e]; }
        sm[32] = a; sm[65] = b;
    }
    __syncthreads();
    total_mt = sm[32];
}
__device__ __forceinline__ void phase_moe1(const Params& p, int bid, int nb, unsigned char* smem) {
    const int g2tid = tid_opaque();
    int* sm = (int*)(smem + 65536);
    const int* cnt = (const int*)(p.ws + WS_CTL);
    const int* rowtok = (const int*)(p.ws + WS_ROWTOK);
    const bf16_t* hb = (const bf16_t*)(p.ws + WS_HB);
    bf16_t* act = (bf16_t*)(p.ws + WS_ACT);
    const int lane = tid_opaque() & 63, wave = tid_opaque() >> 6;
    int total_mt;
    moe_tile_map(cnt, sm, total_mt);
    for (int w = bid; w < total_mt * 16; w += nb) {
        const int tm = w >> 4, nt = w & 15;
        int e = 0;
        while (e < NEXP - 1 && sm[e + 1] <= tm) ++e;
        const int mt = tm - sm[e];
        const int rbase = sm[33 + e] + mt * 128;
        const int mrows = min(128, cnt[e] - mt * 128);
        const int n0 = nt * 64;
        f32x4 acc[4][4];
        gemm2<true, true>(hb, D, rowtok, rbase, mrows, (const bf16_t*)(p.ws + WB_E1) + (size_t)e * D * 2 * DFF, 2 * DFF, n0, 128, D, smem, acc);
        const float* b1 = p.in[22] + (size_t)e * 2 * DFF;
        const int wn_ = (tid_opaque() >> 6) & 1;
#pragma unroll
        for (int i = 0; i < 4; ++i)
#pragma unroll
            for (int jp = 0; jp < 2; ++jp) {
                const int col = n0 + (wn_ * 2 + jp) * 16 + (tid_opaque() & 15);
                const float bg = b1[col], bl = b1[DFF + col];
#pragma unroll
                for (int r = 0; r < 4; ++r) {
                    const int rl = G2_ROW(i, r);
                    if (rl < mrows) {
                        const float gate = fminf(acc[i][2 * jp][r] + bg, 7.f);
                        const float lin = fminf(fmaxf(acc[i][2 * jp + 1][r] + bl, -7.f), 7.f);
                        const float a_ = (lin + 1.f) * gate * sigmoidf_(1.702f * gate);
                        act[(size_t)(rbase + rl) * DFF + col] = (bf16_t)f2bf(a_);
                    }
                }
            }
    }
}
__device__ __forceinline__ void phase_moe2(const Params& p, int bid, int nb, unsigned char* smem) {
    const int g2tid = tid_opaque();
    int* sm = (int*)(smem + 65536);
    const int* cnt = (const int*)(p.ws + WS_CTL);
    const bf16_t* act = (const bf16_t*)(p.ws + WS_ACT);
    float* yrows = (float*)(p.ws + WS_YROWS);
    const int lane = tid_opaque() & 63, wave = tid_opaque() >> 6;
    int total_mt;
    moe_tile_map(cnt, sm, total_mt);
    for (int w = bid; w < total_mt * 8; w += nb) {
        const int tm = w >> 3, nt = w & 7;
        int e = 0;
        while (e < NEXP - 1 && sm[e + 1] <= tm) ++e;
        const int mt = tm - sm[e];
        const int rbase = sm[33 + e] + mt * 128;
        const int mrows = min(128, cnt[e] - mt * 128);
        const int n0 = nt * 128;
        f32x4 acc[4][4];
        gemm2<false, false>(act, DFF, nullptr, rbase, mrows, (const bf16_t*)(p.ws + WB_E2) + (size_t)e * DFF * D, D, n0, 128, DFF, smem, acc);
        const float* b2 = p.in[24] + (size_t)e * D + n0;
#pragma unroll
        for (int i = 0; i < 4; ++i)
#pragma unroll
            for (int r = 0; r < 4; ++r) {
                const int rl = G2_ROW(i, r);
                if (rl < mrows) {
                    float* yr = yrows + (size_t)(rbase + rl) * D + n0;
#pragma unroll
                    for (int j = 0; j < 4; ++j) { const int c = G2_COL(j); yr[c] = acc[i][j][r] + b2[c]; }
                }
            }
    }
}

__device__ __forceinline__ void phase_combine(const Params& p, int bid, int nb) {
    const int lane = tid_opaque() & 63, wave = tid_opaque() >> 6;
    const float* x1 = (const float*)(p.ws + WS_X1);
    const float* yrows = (const float*)(p.ws + WS_YROWS);
    const int* ppos = (const int*)(p.ws + WS_PPOS);
    const float* topw = (const float*)(p.ws + WS_TOPW);
    const float* g = p.in[25];
    bf16_t* hb = (bf16_t*)(p.ws + WS_HB);
    bf16_t* pb = (bf16_t*)(p.ws + WS_PB);
    for (int t = bid * 4 + wave; t < S; t += nb * 4) {
        float4 v[4];
#pragma unroll
        for (int j = 0; j < 4; ++j) v[j] = ((const float4*)(x1 + (size_t)t * D))[lane + 64 * j];
#pragma unroll
        for (int k = 0; k < 4; ++k) {
            const float wk = topw[t * 4 + k];
            const float4* yr = (const float4*)(yrows + (size_t)ppos[t * 4 + k] * D);
#pragma unroll
            for (int j = 0; j < 4; ++j) { const float4 y = yr[lane + 64 * j]; v[j].x += wk * y.x; v[j].y += wk * y.y; v[j].z += wk * y.z; v[j].w += wk * y.w; }
        }
        float ss = 0.f;
#pragma unroll
        for (int j = 0; j < 4; ++j) ss += v[j].x * v[j].x + v[j].y * v[j].y + v[j].z * v[j].z + v[j].w * v[j].w;
        ss = wave_sum(ss);
        const float rstd = rsqrtf(ss * (1.f / D) + EPS);
#pragma unroll
        for (int j = 0; j < 4; ++j) {
            ((float4*)(p.out + (size_t)t * D))[lane + 64 * j] = v[j];
            const float4 gg = ((const float4*)g)[lane + 64 * j];
            uint2 o;
            o.x = pk2(v[j].x * rstd * gg.x, v[j].y * rstd * gg.y);
            o.y = pk2(v[j].z * rstd * gg.z, v[j].w * rstd * gg.w);
            ((uint2*)(hb + (size_t)t * D))[lane + 64 * j] = o;
        }
    }
}

__device__ __forceinline__ void phase_ple(const Params& p, int bid, int nb, unsigned char* smem) {
    const int g2tid = tid_opaque();
    const bf16_t* pw = (const bf16_t*)(p.ws + WS_PW);
    for (int w = bid; w < 128 * 8; w += nb) {
        const int mt = w % 128, nt = w / 128;
        const int m0 = mt * 128, n0 = nt * 128;
        f32x4 acc[4][4];
        gemm2<false, false>((const bf16_t*)(p.ws + WS_HB), D, nullptr, m0, 128, (const bf16_t*)(p.ws + WB_PLEG), D, n0, 128, D, smem, acc);
#pragma unroll
        for (int i = 0; i < 4; ++i)
#pragma unroll
            for (int r = 0; r < 4; ++r) {
                const size_t ro = (size_t)(m0 + G2_ROW(i, r)) * D + n0 + G2_COL(0);
                float* orow = p.out + ro;
#pragma unroll
                for (int j = 0; j < 4; ++j) orow[j * 16] = orow[j * 16] + sigmoidf_(acc[i][j][r]) * bf2f(pw[ro + j * 16]);
            }
    }
}

#define LAS __attribute__((address_space(3)))
#define XB_TMO      128
#define XB_XCNT(j)  (256  + 64 * (j))
#define XB_XSUB(j)  (1280 + 64 * (j))
#define XB_XGEN(j)  (2304 + 64 * (j))
#define XB_TOP      3328
#define XB_TOPGEN   3392
#define XCD_BAR_WORDS 3456
#define XB_SPIN_CAP (1u << 18)

__device__ __forceinline__ unsigned xb_ld(unsigned* p)              { return __hip_atomic_load(p, __ATOMIC_RELAXED, __HIP_MEMORY_SCOPE_AGENT); }
__device__ __forceinline__ unsigned xb_add(unsigned* p, unsigned v) { return __hip_atomic_fetch_add(p, v, __ATOMIC_RELAXED, __HIP_MEMORY_SCOPE_AGENT); }
__device__ __forceinline__ unsigned xb_xcc_id() { return (unsigned)__builtin_amdgcn_s_getreg((3 << 11) | 20) & 0xFu; }
#define XB_SPIN(cond, bar) do { unsigned _sp = 0; while (cond) { __builtin_amdgcn_s_sleep(1); \
    if ((++_sp & 255u) == 0u) { if (xb_ld(&(bar)[XB_TMO])) break; if (_sp > XB_SPIN_CAP) { atomicAdd(&(bar)[XB_TMO], 1u); break; } } } } while (0)

struct XcdBarrier {
    unsigned* bar; unsigned x;
    volatile LAS unsigned* st;
};

__device__ __forceinline__ XcdBarrier xcd_barrier_post(unsigned* bar, volatile LAS unsigned* st) {
    XcdBarrier b; b.bar = bar; b.x = xb_xcc_id(); b.st = st;
    if (tid_opaque() == 0) (void)xb_add(&bar[XB_XCNT(b.x)], 1u);
    return b;
}
__device__ __forceinline__ void xcd_barrier_complete(unsigned* bar, unsigned x, unsigned& nloc, unsigned& nx) {
    const unsigned G = gridDim.x * gridDim.y * gridDim.z;
    unsigned sum, cnt, mine, sp = 0u;
    for (;;) {
        sum = 0u; cnt = 0u; mine = 0u;
#pragma unroll
        for (unsigned j = 0; j < 16; ++j) { const unsigned c = xb_ld(&bar[XB_XCNT(j)]); sum += c; cnt += (c > 0u) ? 1u : 0u; mine = (j == x) ? c : mine; }
        if (sum == G) break;
        __builtin_amdgcn_s_sleep(1);
        if ((++sp & 255u) == 0u) { if (xb_ld(&bar[XB_TMO])) break; if (sp > XB_SPIN_CAP) { atomicAdd(&bar[XB_TMO], 1u); break; } }
    }
    nloc = mine > 0u ? mine : 1u; nx = cnt > 0u ? cnt : 1u;
}

__device__ __forceinline__ void xcd_barrier(const XcdBarrier& b) {
    asm volatile("s_waitcnt vmcnt(0)" ::: "memory");
    __syncthreads();
    if (tid_opaque() == 0) {
        unsigned* bar = b.bar;
        __builtin_amdgcn_s_waitcnt(0);
        unsigned nloc = b.st[0], nx = b.st[1];
        if (nloc == 0u) { xcd_barrier_complete(bar, b.x, nloc, nx); b.st[0] = nloc; b.st[1] = nx; }
        const unsigned old = xb_add(&bar[XB_XSUB(b.x)], 1u);
        const unsigned gen = old / nloc;
        if (old + 1u == (gen + 1u) * nloc) {
            __builtin_amdgcn_fence(__ATOMIC_RELEASE, "agent");
            asm volatile("s_waitcnt vmcnt(0)" ::: "memory");
            const unsigned og = xb_add(&bar[XB_TOP], 1u);
            const unsigned tg = og / nx;
            if (og + 1u == (tg + 1u) * nx) xb_add(&bar[XB_TOPGEN], 1u);
            else XB_SPIN(xb_ld(&bar[XB_TOPGEN]) == tg, bar);
            __builtin_amdgcn_fence(__ATOMIC_ACQUIRE, "agent");
            xb_add(&bar[XB_XGEN(b.x)], 1u);
            asm volatile("s_waitcnt vmcnt(0)" ::: "memory");
        } else {
            XB_SPIN(xb_ld(&bar[XB_XGEN(b.x)]) == gen, bar);
            __builtin_amdgcn_fence(__ATOMIC_ACQUIRE, "agent");
            asm volatile("s_waitcnt vmcnt(0)" ::: "memory");
        }
    }
    __syncthreads();
}

template <int PH>
__device__ __forceinline__ void run_phase(const Params& p, int bid, int nb, unsigned char* smem) {
    if (PH == 0) phase_prep(p, bid, nb);
    if (PH == 1) phase_inproj(p, bid, nb, smem);
    if (PH == 3) phase_compress(p, bid, nb, smem);
    if (PH == 4) phase_attn(p, bid, nb, smem);
    if (PH == 15) {
        if (bid < (nb >> 1)) { phase_dsa_attn(p, bid, nb, smem); phase_merge<0>(p, bid, nb, smem); }
        else { phase_merge<0>(p, bid, nb, smem); phase_dsa_attn(p, bid, nb, smem); }
    }
    if (PH == 13) phase_merge<1>(p, bid, nb, smem);
    if (PH == 6) phase_outproj(p, bid, nb, smem);
    if (PH == 7) phase_route(p, bid, nb);
    if (PH == 8) phase_place(p, bid, nb, smem);
    if (PH == 9) phase_moe1(p, bid, nb, smem);
    if (PH == 10) phase_moe2(p, bid, nb, smem);
    if (PH == 11) phase_combine(p, bid, nb);
    if (PH == 12) phase_ple(p, bid, nb, smem);
}

#if SINGLE_LAUNCH
__global__ void __launch_bounds__(NT, 2) fwd_mega(Params p) {
    __shared__ __attribute__((aligned(16))) unsigned char smem[SMEM_BYTES];
    cg::grid_group grid = cg::this_grid();
    const int bid = blockIdx.x, nb = gridDim.x;
    volatile LAS unsigned* bst = (volatile LAS unsigned*)(LAS unsigned char*)(smem + SMEM_BYTES - 16);
    if (tid_opaque() < 2) bst[tid_opaque()] = 0u;
    __syncthreads();
    const XcdBarrier bar = xcd_barrier_post((unsigned*)(p.ws + WS_BAR), bst);
#define GSYNC() xcd_barrier(bar)
    run_phase<0>(p, bid, nb, smem); grid.sync();
    run_phase<1>(p, bid, nb, smem); GSYNC();
    run_phase<3>(p, bid, nb, smem); GSYNC();
    run_phase<4>(p, bid, nb, smem); GSYNC();
    run_phase<15>(p, bid, nb, smem); GSYNC();
    run_phase<13>(p, bid, nb, smem); GSYNC();
    run_phase<6>(p, bid, nb, smem); GSYNC();
    run_phase<7>(p, bid, nb, smem); GSYNC();
    run_phase<8>(p, bid, nb, smem); GSYNC();
    run_phase<9>(p, bid, nb, smem); GSYNC();
    run_phase<10>(p, bid, nb, smem); GSYNC();
    run_phase<11>(p, bid, nb, smem); GSYNC();
    run_phase<12>(p, bid, nb, smem);
#undef GSYNC
}
#else
template <int PH>
__global__ void __launch_bounds__(NT, 2) k_phase(Params p) {
    __shared__ __attribute__((aligned(16))) unsigned char smem[SMEM_BYTES];
    run_phase<PH>(p, blockIdx.x, gridDim.x, smem);
}
#endif

extern "C" void kernel_launch(void* const* d_in, const int* in_sizes, int n_in, void* d_out, int out_size, void* d_ws, size_t ws_size,
                              hipStream_t stream) {
    if (n_in != 28 || ws_size < WS_END) { fprintf(stderr, "kernel_launch: unexpected n_in %d or ws_size %zu (< %zu)\n", n_in, ws_size, (size_t)WS_END); return; }
    Params p{};
    for (int i = 0; i < 28; ++i) p.in[i] = (const float*)d_in[i];
    p.out = (float*)d_out;
    p.ws = (unsigned char*)d_ws;
#if SINGLE_LAUNCH
    static int grid_blocks = 0;
    if (!grid_blocks) {
        int dev = 0, cus = 0, per_cu = 0;
        hipGetDevice(&dev);
        hipDeviceGetAttribute(&cus, hipDeviceAttributeMultiprocessorCount, dev);
        hipOccupancyMaxActiveBlocksPerMultiprocessor(&per_cu, fwd_mega, NT, 0);
        if (per_cu > 2) per_cu = 2;
        if (per_cu < 1) per_cu = 1;
        grid_blocks = cus * per_cu;
    }
    (void)hipMemsetAsync((unsigned char*)d_ws + WS_BAR, 0, XCD_BAR_WORDS * 4, stream);
    void* args[] = {&p};
    hipError_t e = hipLaunchCooperativeKernel((void*)fwd_mega, dim3(grid_blocks), dim3(NT), args, 0, stream);
    if (e != hipSuccess) fprintf(stderr, "cooperative launch failed: %s (grid %d)\n", hipGetErrorString(e), grid_blocks);
#else
    const int G = 512;
    k_phase<0><<<G, NT, 0, stream>>>(p);
    k_phase<1><<<G, NT, 0, stream>>>(p);
    k_phase<3><<<G, NT, 0, stream>>>(p);
    k_phase<4><<<G, NT, 0, stream>>>(p);
    k_phase<15><<<G, NT, 0, stream>>>(p);
    k_phase<13><<<G, NT, 0, stream>>>(p);
    k_phase<6><<<G, NT, 0, stream>>>(p);
    k_phase<7><<<G, NT, 0, stream>>>(p);
    k_phase<8><<<G, NT, 0, stream>>>(p);
    k_phase<9><<<G, NT, 0, stream>>>(p);
    k_phase<10><<<G, NT, 0, stream>>>(p);
    k_phase<11><<<G, NT, 0, stream>>>(p);
    k_phase<12><<<G, NT, 0, stream>>>(p);
#endif
}
```

```cpp
#include <hip/hip_runtime.h>
#include <hip/hip_cooperative_groups.h>
#include <cstdio>
#include <cstdint>
namespace cg = cooperative_groups;

#ifndef SINGLE_LAUNCH
#define SINGLE_LAUNCH 1
#endif

constexpr int S = 16384;
constexpr int D = 1024;
constexpr int DIN = 5184;
constexpr int NCMP = 1023;
constexpr int NSLC = 256;
constexpr int NEXP = 32;
constexpr int DFF = 1024;
constexpr float EPS = 1e-6f;
constexpr float LOG2E = 1.4426950408889634f;
constexpr int Z_NQ = 0, Z_NKV = 512, Z_NGATE = 1280, Z_DQ = 1304, Z_DK = 1816, Z_DV = 2328, Z_IQ = 2840, Z_IK = 3096,
              Z_IW = 3128, Z_GA = 3136, Z_GB = 4160;

constexpr int NT = 256;
constexpr int SMEM_BYTES = 73728;

typedef unsigned short bf16_t;
typedef short bf16x8 __attribute__((ext_vector_type(8)));
typedef float f32x4 __attribute__((ext_vector_type(4)));
typedef short s16x4 __attribute__((ext_vector_type(4)));
typedef __attribute__((address_space(3))) s16x4* lds_s16x4_ptr;
__device__ __forceinline__ s16x4 lds_tr16(const void* p) {
    return __builtin_amdgcn_ds_read_tr16_b64_v4i16((lds_s16x4_ptr)(uintptr_t)p);
}

constexpr size_t MBy = 1ull << 20;
constexpr size_t WS_CTL = 0;
constexpr size_t WS_BAR = 65536;
constexpr size_t WS_HB = 1 * MBy;
constexpr size_t WS_OA = WS_HB + (size_t)S * D * 2;
constexpr size_t WS_OB = WS_OA + (size_t)S * 512 * 2;
constexpr size_t WS_MERGED = WS_OB + (size_t)S * 512 * 2;
constexpr size_t WS_X1 = WS_MERGED + (size_t)S * D * 2;
constexpr size_t WS_TOPI = WS_X1 + (size_t)S * D * 4;
constexpr size_t WS_TOPW = WS_TOPI + (size_t)S * 4 * 4;
constexpr size_t WS_PPOS = WS_TOPW + (size_t)S * 4 * 4;
constexpr size_t WS_ROWTOK = WS_PPOS + (size_t)S * 4 * 4;
constexpr size_t WS_PB = WS_ROWTOK + (size_t)65536 * 4;
constexpr size_t WS_PW = WS_PB + (size_t)S * 256 * 2;
constexpr size_t WS_SEL = WS_PW + (size_t)S * D * 2;
constexpr size_t WS_NSEL = WS_SEL + (size_t)S * 256 * 2;
constexpr size_t WS_REG = WS_NSEL + (size_t)S * 4;
constexpr size_t WS_SGA = WS_REG;
constexpr size_t WS_SGB = WS_SGA + (size_t)S * D * 2;
constexpr size_t WS_GT = WS_SGB + (size_t)S * D * 2;
constexpr size_t WS_IWS = WS_GT + (size_t)S * 32 * 4;
constexpr size_t WS_QNB = WS_IWS + (size_t)S * 8 * 4;
constexpr size_t WS_KSLB = WS_QNB + (size_t)S * 512 * 2;
constexpr size_t WS_VSLB = WS_KSLB + (size_t)S * 128 * 2;
constexpr size_t WS_KWNB = WS_VSLB + (size_t)S * 128 * 2;
constexpr size_t WS_VWNB = WS_KWNB + (size_t)S * 128 * 2;
constexpr size_t WS_KCB = WS_VWNB + (size_t)S * 128 * 2;
constexpr size_t WS_VCB = WS_KCB + (size_t)2 * 1024 * 64 * 2;
constexpr size_t WS_KCR = WS_VCB + (size_t)2 * 1024 * 64 * 2;
constexpr size_t WS_VCR = WS_KCR + (size_t)S * 128 * 2;
constexpr size_t WS_DQB = WS_VCR + (size_t)S * 128 * 2;
constexpr size_t WS_DKB = WS_DQB + (size_t)S * 512 * 2;
constexpr size_t WS_DVB = WS_DKB + (size_t)S * 512 * 2;
constexpr size_t WS_IQB = WS_DVB + (size_t)S * 512 * 2;
constexpr size_t WS_IKB = WS_IQB + (size_t)S * 256 * 2;
constexpr size_t WS_ENDA = WS_IKB + (size_t)S * 32 * 2;
constexpr size_t WS_ACT = WS_REG;
constexpr size_t WS_YROWS = WS_ACT + (size_t)(65536 + 128) * DFF * 2;
constexpr size_t WS_ENDB = WS_YROWS + (size_t)(65536 + 128) * D * 4;
constexpr size_t WS_END0 = WS_ENDA > WS_ENDB ? WS_ENDA : WS_ENDB;
constexpr size_t WB_IN = WS_END0;
constexpr size_t WB_A = WB_IN + (size_t)D * DIN * 2;
constexpr size_t WB_B = WB_A + (size_t)512 * D * 2;
constexpr size_t WB_OUT = WB_B + (size_t)512 * D * 2;
constexpr size_t WB_E1 = WB_OUT + (size_t)D * D * 2;
constexpr size_t WB_E2 = WB_E1 + (size_t)NEXP * D * 2 * DFF * 2;
constexpr size_t WB_PLE = WB_E2 + (size_t)NEXP * DFF * D * 2;
constexpr size_t WB_PLEG = WB_PLE + (size_t)256 * D * 2;
constexpr size_t WB_CK1 = WB_PLEG + (size_t)D * D * 2;
constexpr size_t WB_CV1 = WB_CK1 + (size_t)2048 * 64 * 2;
constexpr size_t WS_END = WB_CV1 + (size_t)2048 * 64 * 2 + 4096;

struct Params {
    const float* in[28];
    float* out;
    unsigned char* ws;
};

__device__ __forceinline__ unsigned f2bf(float f) {
    unsigned u = __builtin_bit_cast(unsigned, f);
    return (u + 0x7fffu + ((u >> 16) & 1u)) >> 16;
}
__device__ __forceinline__ unsigned pk2(float lo, float hi) { return f2bf(lo) | (f2bf(hi) << 16); }
__device__ __forceinline__ float bf2f(unsigned short b) { return __builtin_bit_cast(float, (unsigned)b << 16); }
__device__ __forceinline__ int tid_opaque() { int t = threadIdx.x; asm volatile("" : "+v"(t)); return t; }
__device__ __forceinline__ float wave_sum(float v) {
#pragma unroll
    for (int o = 1; o < 64; o <<= 1) v += __shfl_xor(v, o);
    return v;
}
__device__ __forceinline__ float wave_max(float v) {
#pragma unroll
    for (int o = 1; o < 64; o <<= 1) v = fmaxf(v, __shfl_xor(v, o));
    return v;
}
__device__ __forceinline__ float sigmoidf_(float x) { return 1.f / (1.f + __expf(-x)); }
__device__ __forceinline__ int bucket_of(int n) {
    if (n < 16) return n;
    int b = 16;
    b += (n >= 19) + (n >= 21) + (n >= 24) + (n >= 27) + (n >= 31) + (n >= 35) + (n >= 40) + (n >= 46) + (n >= 52) + (n >= 59) +
         (n >= 67) + (n >= 77) + (n >= 87) + (n >= 99) + (n >= 113);
    return b;
}

constexpr int LDS_STRIDE = 40;
constexpr int BTR_STRIDE = 136;
template <bool A_F32, bool GATHER, bool SPLIT = false, bool BTR = true>
__device__ __forceinline__ void gemm_tile(const void* __restrict__ Aptr, int lda, const int* __restrict__ rowidx, int m0, int mrows,
                                          const float* __restrict__ B, int ldb, int n0, int split_off, int ncols, int K,
                                          unsigned char* smem, f32x4 (&acc)[2][8]) {
    bf16_t* As = (bf16_t*)smem;
    bf16_t* Bs = As + 128 * LDS_STRIDE;
    bf16_t* AsL = Bs + 128 * LDS_STRIDE;
    bf16_t* BsL = AsL + 128 * LDS_STRIDE;
    const int tid = tid_opaque(), lane = tid & 63, wave = tid >> 6;
#pragma unroll
    for (int i = 0; i < 2; ++i)
#pragma unroll
        for (int j = 0; j < 8; ++j) acc[i][j] = (f32x4){0.f, 0.f, 0.f, 0.f};
    auto lo = [](float v) { return v - bf2f((unsigned short)f2bf(v)); };

    const int ar = tid >> 2, ach = tid & 3;
    const unsigned char* arow[2];
    bool aval[2];
#pragma unroll
    for (int i = 0; i < 2; ++i) {
        int r = ar + 64 * i;
        aval[i] = r < mrows;
        long src = 0;
        if (aval[i]) src = GATHER ? (long)rowidx[m0 + r] : (long)(m0 + r);
        arow[i] = (const unsigned char*)Aptr + (size_t)src * lda * (A_F32 ? 4 : 2) + (size_t)ach * 8 * (A_F32 ? 4 : 2);
    }
    const int nq = tid & 31, kq = tid >> 5;
    const int jn = 4 * nq;
    const bool bval = jn < ncols;
    const float* bptr = B + (size_t)(4 * kq) * ldb + n0 + jn + (jn >= 64 ? split_off : 0);

    uint4 areg[2];
    float4 af0a, af0b, af1a, af1b;
    float4 breg[4];
    auto load_g = [&](int k0) {
#pragma unroll
        for (int i = 0; i < 2; ++i) {
            if (A_F32) {
                float4 t0 = make_float4(0, 0, 0, 0), t1 = t0;
                if (aval[i]) {
                    const float4* s = (const float4*)(arow[i] + (size_t)k0 * 4);
                    t0 = s[0]; t1 = s[1];
                }
                if (i == 0) { af0a = t0; af0b = t1; } else { af1a = t0; af1b = t1; }
            } else {
                if (aval[i]) areg[i] = *(const uint4*)(arow[i] + (size_t)k0 * 2);
                else areg[i] = make_uint4(0, 0, 0, 0);
            }
        }
#pragma unroll
        for (int kk = 0; kk < 4; ++kk) {
            if (bval) breg[kk] = *(const float4*)(bptr + (size_t)(k0 + kk) * ldb);
            else breg[kk] = make_float4(0, 0, 0, 0);
        }
    };
    auto store_l = [&]() {
#pragma unroll
        for (int i = 0; i < 2; ++i) {
            uint4 v;
            const float4 t0 = (i == 0) ? af0a : af1a, t1 = (i == 0) ? af0b : af1b;
            if (A_F32) {
                v.x = pk2(t0.x, t0.y); v.y = pk2(t0.z, t0.w);
                v.z = pk2(t1.x, t1.y); v.w = pk2(t1.z, t1.w);
            } else v = areg[i];
            *(uint4*)(As + (ar + 64 * i) * LDS_STRIDE + ach * 8) = v;
            if (SPLIT && A_F32) {
                v.x = pk2(lo(t0.x), lo(t0.y)); v.y = pk2(lo(t0.z), lo(t0.w));
                v.z = pk2(lo(t1.x), lo(t1.y)); v.w = pk2(lo(t1.z), lo(t1.w));
                *(uint4*)(AsL + (ar + 64 * i) * LDS_STRIDE + ach * 8) = v;
            }
        }
        if (SPLIT) {
            uint2 v;
            v.x = pk2(lo(breg[0].x), lo(breg[1].x)); v.y = pk2(lo(breg[2].x), lo(breg[3].x));
            *(uint2*)(BsL + (jn + 0) * LDS_STRIDE + 4 * kq) = v;
            v.x = pk2(lo(breg[0].y), lo(breg[1].y)); v.y = pk2(lo(breg[2].y), lo(breg[3].y));
            *(uint2*)(BsL + (jn + 1) * LDS_STRIDE + 4 * kq) = v;
            v.x = pk2(lo(breg[0].z), lo(breg[1].z)); v.y = pk2(lo(breg[2].z), lo(breg[3].z));
            *(uint2*)(BsL + (jn + 2) * LDS_STRIDE + 4 * kq) = v;
            v.x = pk2(lo(breg[0].w), lo(breg[1].w)); v.y = pk2(lo(breg[2].w), lo(breg[3].w));
            *(uint2*)(BsL + (jn + 3) * LDS_STRIDE + 4 * kq) = v;
        }
        if (BTR && !SPLIT) {
#pragma unroll
            for (int kk = 0; kk < 4; ++kk) {
                uint2 v; v.x = pk2(breg[kk].x, breg[kk].y); v.y = pk2(breg[kk].z, breg[kk].w);
                *(uint2*)(Bs + (4 * kq + kk) * BTR_STRIDE + jn) = v;
            }
        } else {
            uint2 v;
            v.x = pk2(breg[0].x, breg[1].x); v.y = pk2(breg[2].x, breg[3].x);
            *(uint2*)(Bs + (jn + 0) * LDS_STRIDE + 4 * kq) = v;
            v.x = pk2(breg[0].y, breg[1].y); v.y = pk2(breg[2].y, breg[3].y);
            *(uint2*)(Bs + (jn + 1) * LDS_STRIDE + 4 * kq) = v;
            v.x = pk2(breg[0].z, breg[1].z); v.y = pk2(breg[2].z, breg[3].z);
            *(uint2*)(Bs + (jn + 2) * LDS_STRIDE + 4 * kq) = v;
            v.x = pk2(breg[0].w, breg[1].w); v.y = pk2(breg[2].w, breg[3].w);
            *(uint2*)(Bs + (jn + 3) * LDS_STRIDE + 4 * kq) = v;
        }
    };
    const int nk = K / 32;
    __syncthreads();
    load_g(0);
    store_l();
    __syncthreads();
    const int fr = lane & 15, fq = lane >> 4;
    for (int kt = 0; kt < nk; ++kt) {
        if (kt + 1 < nk) load_g((kt + 1) * 32);
        bf16x8 a[2];
#pragma unroll
        for (int i = 0; i < 2; ++i) a[i] = *(const bf16x8*)(As + (wave * 32 + i * 16 + fr) * LDS_STRIDE + fq * 8);
        if (!SPLIT) {
            bf16x8 b[8];
#pragma unroll
            for (int j = 0; j < 8; ++j) {
                if (BTR && !SPLIT) {
                    const bf16_t* bp = Bs + (8 * fq + (fr >> 2)) * BTR_STRIDE + 16 * j + 4 * (fr & 3);
                    const s16x4 lo4 = lds_tr16(bp), hi4 = lds_tr16(bp + 4 * BTR_STRIDE);
                    b[j] = (bf16x8){lo4[0], lo4[1], lo4[2], lo4[3], hi4[0], hi4[1], hi4[2], hi4[3]};
                } else b[j] = *(const bf16x8*)(Bs + (j * 16 + fr) * LDS_STRIDE + fq * 8);
            }
#pragma unroll
            for (int i = 0; i < 2; ++i)
#pragma unroll
                for (int j = 0; j < 8; ++j) acc[i][j] = __builtin_amdgcn_mfma_f32_16x16x32_bf16(a[i], b[j], acc[i][j], 0, 0, 0);
        } else {
            bf16x8 al[2];
#pragma unroll
            for (int i = 0; i < 2; ++i) al[i] = *(const bf16x8*)(AsL + (wave * 32 + i * 16 + fr) * LDS_STRIDE + fq * 8);
#pragma unroll
            for (int j = 0; j < 8; ++j) {
                const bf16x8 bh = *(const bf16x8*)(Bs + (j * 16 + fr) * LDS_STRIDE + fq * 8);
                const bf16x8 bl = *(const bf16x8*)(BsL + (j * 16 + fr) * LDS_STRIDE + fq * 8);
#pragma unroll
                for (int i = 0; i < 2; ++i) {
                    acc[i][j] = __builtin_amdgcn_mfma_f32_16x16x32_bf16(a[i], bh, acc[i][j], 0, 0, 0);
                    acc[i][j] = __builtin_amdgcn_mfma_f32_16x16x32_bf16(a[i], bl, acc[i][j], 0, 0, 0);
                    acc[i][j] = __builtin_amdgcn_mfma_f32_16x16x32_bf16(al[i], bh, acc[i][j], 0, 0, 0);
                }
            }
        }
        __syncthreads();
        if (kt + 1 < nk) {
            store_l();
            __syncthreads();
        }
    }
}


constexpr int ASTR = 72;
constexpr int BSTR = 136;
template <bool GATHER, bool PAIR>
__device__ __forceinline__ void gemm2(const bf16_t* __restrict__ A, int lda, const int* __restrict__ rowidx, int m0, int mrows,
                                      const bf16_t* __restrict__ B, int ldb, int n0, int ncols, int K, unsigned char* smem,
                                      f32x4 (&acc)[4][4]) {
    bf16_t* As = (bf16_t*)smem;
    bf16_t* Bs = As + 128 * ASTR;
    const int tid = tid_opaque(), lane = tid & 63, wave = tid >> 6, wm = wave >> 1, wn = wave & 1;
#pragma unroll
    for (int i = 0; i < 4; ++i)
#pragma unroll
        for (int j = 0; j < 4; ++j) acc[i][j] = (f32x4){0.f, 0.f, 0.f, 0.f};
    const int ar0 = tid >> 3, ach = tid & 7;
    const bf16_t* ap0; const bf16_t* ap1; const bf16_t* ap2; const bf16_t* ap3;
    {
        int r_[4];
#pragma unroll
        for (int i = 0; i < 4; ++i) { const int rl = 32 * i + ar0; r_[i] = rl < mrows ? rl : mrows - 1; }
        ap0 = A + (size_t)(GATHER ? (long)rowidx[m0 + r_[0]] : (long)(m0 + r_[0])) * lda + ach * 8;
        ap1 = A + (size_t)(GATHER ? (long)rowidx[m0 + r_[1]] : (long)(m0 + r_[1])) * lda + ach * 8;
        ap2 = A + (size_t)(GATHER ? (long)rowidx[m0 + r_[2]] : (long)(m0 + r_[2])) * lda + ach * 8;
        ap3 = A + (size_t)(GATHER ? (long)rowidx[m0 + r_[3]] : (long)(m0 + r_[3])) * lda + ach * 8;
    }
    const int br0 = tid >> 4, bch = tid & 15;
    const int bcol = PAIR ? ((bch >> 2) * 16 + (bch & 1) * 8 + ((bch >> 1) & 1) * 1024) : bch * 8;
    const bf16_t* bp = B + (size_t)br0 * ldb + n0 + bcol;
    bf16_t* asd = As + ar0 * ASTR + ach * 8;
    bf16_t* bsd = Bs + br0 * BSTR + bch * 8;
    uint4 a0, a1, a2, a3, b0, b1, b2, b3;
#define G2_LOAD(k0)                                                                                       \
    do {                                                                                                  \
        a0 = *(const uint4*)(ap0 + (k0)); a1 = *(const uint4*)(ap1 + (k0));                               \
        a2 = *(const uint4*)(ap2 + (k0)); a3 = *(const uint4*)(ap3 + (k0));                               \
        const bf16_t* bp_ = bp + (size_t)(k0) * ldb;                                                      \
        b0 = *(const uint4*)(bp_); b1 = *(const uint4*)(bp_ + (size_t)16 * ldb);                          \
        b2 = *(const uint4*)(bp_ + (size_t)32 * ldb); b3 = *(const uint4*)(bp_ + (size_t)48 * ldb);       \
    } while (0)
#define G2_STORE()                                                                                        \
    do {                                                                                                  \
        *(uint4*)(asd) = a0; *(uint4*)(asd + 32 * ASTR) = a1; *(uint4*)(asd + 64 * ASTR) = a2; *(uint4*)(asd + 96 * ASTR) = a3; \
        *(uint4*)(bsd) = b0; *(uint4*)(bsd + 16 * BSTR) = b1; *(uint4*)(bsd + 32 * BSTR) = b2; *(uint4*)(bsd + 48 * BSTR) = b3; \
    } while (0)
    const int nk = K / 64;
    __syncthreads();
    G2_LOAD(0);
    G2_STORE();
    __syncthreads();
    const int fr = lane & 15, fq = lane >> 4;
    const bf16_t* afp = As + (wm * 64 + fr) * ASTR + fq * 8;
    const bf16_t* bfp = Bs + (8 * fq + (fr >> 2)) * BSTR + wn * 64 + 4 * (fr & 3);
    for (int kt = 0; kt < nk; ++kt) {
        if (kt + 1 < nk) G2_LOAD((kt + 1) * 64);
#pragma unroll
        for (int kh = 0; kh < 2; ++kh) {
            bf16x8 a[4], b[4];
#pragma unroll
            for (int i = 0; i < 4; ++i) a[i] = *(const bf16x8*)(afp + i * 16 * ASTR + kh * 32);
#pragma unroll
            for (int j = 0; j < 4; ++j) {
                const bf16_t* q = bfp + kh * 32 * BSTR + j * 16;
                const s16x4 lo4 = lds_tr16(q), hi4 = lds_tr16(q + 4 * BSTR);
                b[j] = (bf16x8){lo4[0], lo4[1], lo4[2], lo4[3], hi4[0], hi4[1], hi4[2], hi4[3]};
            }
#pragma unroll
            for (int i = 0; i < 4; ++i)
#pragma unroll
                for (int j = 0; j < 4; ++j) acc[i][j] = __builtin_amdgcn_mfma_f32_16x16x32_bf16(a[i], b[j], acc[i][j], 0, 0, 0);
        }
        __syncthreads();
        if (kt + 1 < nk) {
            G2_STORE();
            __syncthreads();
        }
    }
#undef G2_LOAD
#undef G2_STORE
}
#define G2_ROW(i, r) ((g2tid >> 7) * 64 + (i) * 16 + 4 * ((g2tid & 63) >> 4) + (r))
#define G2_COL(j) (((((g2tid >> 6) & 1) * 4 + (j)) * 16) + (g2tid & 15))
__device__ __forceinline__ void store_bf16_frag(bf16_t* base, int ld, float v0, float v1, float v2, float v3, int lane, unsigned rowmask = 0xFu) {
    const bool odd = lane & 1;
    const float s0 = odd ? v0 : v2, s1 = odd ? v1 : v3;
    const float r0 = __shfl_xor(s0, 1), r1 = __shfl_xor(s1, 1);
    bf16_t* p0 = odd ? base + 2 * ld - 1 : base;
    const unsigned w0 = odd ? pk2(r0, v2) : pk2(v0, r0);
    const unsigned w1 = odd ? pk2(r1, v3) : pk2(v1, r1);
    const unsigned m = odd ? (rowmask >> 2) : rowmask;
    if (m & 1u) *(unsigned*)p0 = w0;
    if (m & 2u) *(unsigned*)(p0 + ld) = w1;
}

__device__ __forceinline__ void cvt_weights(const float* __restrict__ src, bf16_t* __restrict__ dst, size_t n, int bid, int nb) {
    const size_t n8 = n >> 3;
    for (size_t i = (size_t)bid * NT + tid_opaque(); i < n8; i += (size_t)nb * NT) {
        const float4 u = ((const float4*)src)[2 * i], v = ((const float4*)src)[2 * i + 1];
        uint4 o; o.x = pk2(u.x, u.y); o.y = pk2(u.z, u.w); o.z = pk2(v.x, v.y); o.w = pk2(v.z, v.w);
        ((uint4*)dst)[i] = o;
    }
}
__device__ __forceinline__ void phase_prep(const Params& p, int bid, int nb) {
    const int lane = tid_opaque() & 63, wave = tid_opaque() >> 6;
    if (bid == 0 && tid_opaque() < 64) ((int*)(p.ws + WS_CTL))[tid_opaque()] = 0;
    {
        const float* src_ = p.in[2];
        bf16_t* dst_ = (bf16_t*)(p.ws + WB_IN);
        constexpr int G8 = DIN / 8;
        for (size_t i = (size_t)bid * NT + tid_opaque(); i < (size_t)D * G8; i += (size_t)nb * NT) {
            const int k = (int)(i / G8), nc = (int)(i % G8) * 8;
            int oc;
            if (nc < 1280) oc = nc; else if (nc < 2816) oc = nc + 24; else if (nc < 3072) oc = nc + 24; else if (nc < 5120) oc = nc + 64;
            else if (nc < 5152) oc = nc - 5120 + 3096; else if (nc < 5176) oc = nc - 5152 + 1280; else oc = nc - 5176 + 3128;
            const float4 u = *(const float4*)(src_ + (size_t)k * DIN + oc), v = *(const float4*)(src_ + (size_t)k * DIN + oc + 4);
            uint4 o; o.x = pk2(u.x, u.y); o.y = pk2(u.z, u.w); o.z = pk2(v.x, v.y); o.w = pk2(v.z, v.w);
            *(uint4*)(dst_ + (size_t)k * DIN + nc) = o;
        }
    }
    cvt_weights(p.in[14], (bf16_t*)(p.ws + WB_A), (size_t)512 * D, bid, nb);
    cvt_weights(p.in[15], (bf16_t*)(p.ws + WB_B), (size_t)512 * D, bid, nb);
    cvt_weights(p.in[16], (bf16_t*)(p.ws + WB_OUT), (size_t)D * D, bid, nb);
    cvt_weights(p.in[26], (bf16_t*)(p.ws + WB_PLE), (size_t)256 * D, bid, nb);
    cvt_weights(p.in[1], (bf16_t*)(p.ws + WS_PB), (size_t)S * 256, bid, nb);
    cvt_weights(p.in[9], (bf16_t*)(p.ws + WB_CK1), (size_t)2048 * 64, bid, nb);
    cvt_weights(p.in[12], (bf16_t*)(p.ws + WB_CV1), (size_t)2048 * 64, bid, nb);
    const float* x = p.in[0];
    const float* g = p.in[3];
    bf16_t* hb = (bf16_t*)(p.ws + WS_HB);
    for (int t = bid * 4 + wave; t < S; t += nb * 4) {
        const float4* xr = (const float4*)(x + (size_t)t * D);
        float4 v[4];
        float ss = 0.f;
#pragma unroll
        for (int j = 0; j < 4; ++j) { v[j] = xr[lane + 64 * j]; ss += v[j].x * v[j].x + v[j].y * v[j].y + v[j].z * v[j].z + v[j].w * v[j].w; }
        ss = wave_sum(ss);
        const float rstd = rsqrtf(ss * (1.f / D) + EPS);
#pragma unroll
        for (int j = 0; j < 4; ++j) {
            const float4 gg = ((const float4*)g)[lane + 64 * j];
            uint2 o;
            o.x = pk2(v[j].x * rstd * gg.x, v[j].y * rstd * gg.y);
            o.y = pk2(v[j].z * rstd * gg.z, v[j].w * rstd * gg.w);
            ((uint2*)(hb + (size_t)t * D))[lane + 64 * j] = o;
        }
    }
}

__device__ __forceinline__ void phase_inproj(const Params& p, int bid, int nb, unsigned char* smem) {
    const int g2tid = tid_opaque();
    const bf16_t* hb = (const bf16_t*)(p.ws + WS_HB);
    const int lane = tid_opaque() & 63, fr = lane & 15;
    constexpr int NTN = (DIN + 127) / 128;
    for (int w = bid; w < 128 * NTN; w += nb) {
        const int mt = w % 128, nt = w / 128;
        const int m0 = mt * 128, n0 = nt * 128;
        const int ncols = (DIN - n0) < 128 ? (DIN - n0) : 128;
        f32x4 acc[4][4];
        gemm2<false, false>(hb, D, nullptr, m0, 128, (const bf16_t*)(p.ws + WB_IN), DIN, n0, ncols, D, smem, acc);
        const int cid = __builtin_amdgcn_readfirstlane((n0 >> 6) + ((tid_opaque() >> 6) & 1));
        if (cid > 80) continue;
        int kind; bf16_t* dst; int ld; const float* gain = nullptr; float scale = 1.f;
        if (cid < 8) { kind = 0; dst = (bf16_t*)(p.ws + WS_QNB) + cid * 64; ld = 512; gain = p.in[4]; scale = 0.125f * LOG2E; }
        else if (cid < 20) {
            const int j = cid - 8, kd = j >> 1, g = j & 1;
            ld = 64; kind = (kd == 2 || kd == 4) ? 0 : 1; gain = p.in[5];
            const size_t base = kd == 0 ? WS_KCR : kd == 1 ? WS_VCR : kd == 2 ? WS_KSLB : kd == 3 ? WS_VSLB : kd == 4 ? WS_KWNB : WS_VWNB;
            dst = (bf16_t*)(p.ws + base) + (size_t)g * S * 64;
        }
        else if (cid < 28) { kind = 0; dst = (bf16_t*)(p.ws + WS_DQB) + (cid - 20) * 64; ld = 512; gain = p.in[6]; scale = 0.125f * LOG2E; }
        else if (cid < 36) { kind = 0; dst = (bf16_t*)(p.ws + WS_DKB) + (cid - 28) * 64; ld = 512; gain = p.in[7]; }
        else if (cid < 44) { kind = 1; dst = (bf16_t*)(p.ws + WS_DVB) + (cid - 36) * 64; ld = 512; }
        else if (cid < 48) { kind = 1; dst = (bf16_t*)(p.ws + WS_IQB) + (cid - 44) * 64; ld = 256; scale = 0.17677669529663687f; }
        else if (cid < 64) { kind = 2; dst = (bf16_t*)(p.ws + WS_SGA) + (cid - 48) * 64; ld = D; }
        else if (cid < 80) { kind = 2; dst = (bf16_t*)(p.ws + WS_SGB) + (cid - 64) * 64; ld = D; }
        else { kind = 3; dst = nullptr; ld = 0; }
        if (kind == 0) {
            float gv[4];
#pragma unroll
            for (int j = 0; j < 4; ++j) gv[j] = gain[j * 16 + fr] * scale;
#pragma unroll
            for (int i = 0; i < 4; ++i) {
                float rstd[4];
#pragma unroll
                for (int r = 0; r < 4; ++r) {
                    float ss = acc[i][0][r] * acc[i][0][r] + acc[i][1][r] * acc[i][1][r] + acc[i][2][r] * acc[i][2][r] + acc[i][3][r] * acc[i][3][r];
                    ss += __shfl_xor(ss, 1); ss += __shfl_xor(ss, 2); ss += __shfl_xor(ss, 4); ss += __shfl_xor(ss, 8);
                    rstd[r] = rsqrtf(ss * (1.f / 64.f) + EPS);
                }
                bf16_t* dr = dst + (size_t)(m0 + G2_ROW(i, 0)) * ld + fr;
#pragma unroll
                for (int j = 0; j < 4; ++j)
                    store_bf16_frag(dr + j * 16, ld, acc[i][j][0] * rstd[0] * gv[j], acc[i][j][1] * rstd[1] * gv[j], acc[i][j][2] * rstd[2] * gv[j],
                                    acc[i][j][3] * rstd[3] * gv[j], lane);
            }
        } else if (kind == 1 || kind == 2) {
#pragma unroll
            for (int i = 0; i < 4; ++i) {
                bf16_t* dr = dst + (size_t)(m0 + G2_ROW(i, 0)) * ld + fr;
#pragma unroll
                for (int j = 0; j < 4; ++j) {
                    float v[4];
#pragma unroll
                    for (int r = 0; r < 4; ++r) v[r] = kind == 2 ? sigmoidf_(acc[i][j][r]) : acc[i][j][r] * scale;
                    store_bf16_frag(dr + j * 16, ld, v[0], v[1], v[2], v[3], lane);
                }
            }
        } else {
            bf16_t* ikb = (bf16_t*)(p.ws + WS_IKB);
            float* gt = (float*)(p.ws + WS_GT);
            float* iws = (float*)(p.ws + WS_IWS);
#pragma unroll
            for (int i = 0; i < 4; ++i) {
                bf16_t* ir = ikb + (size_t)(m0 + G2_ROW(i, 0)) * 32 + fr;
                store_bf16_frag(ir, 32, acc[i][0][0], acc[i][0][1], acc[i][0][2], acc[i][0][3], lane);
                store_bf16_frag(ir + 16, 32, acc[i][1][0], acc[i][1][1], acc[i][1][2], acc[i][1][3], lane);
#pragma unroll
                for (int r = 0; r < 4; ++r) {
                    const size_t t = (size_t)(m0 + G2_ROW(i, r));
                    gt[t * 32 + fr] = sigmoidf_(acc[i][2][r]);
                    if (fr < 8) gt[t * 32 + 16 + fr] = sigmoidf_(acc[i][3][r]);
                    else iws[t * 8 + fr - 8] = acc[i][3][r] * 0.35355339059327373f;
                }
            }
        }
    }
}

__device__ __forceinline__ float rms64(float v) { return rsqrtf(wave_sum(v * v) * (1.f / 64.f) + EPS); }

__device__ __forceinline__ void phase_compress(const Params& p, int bid, int nb, unsigned char* smem) {
    const int g2tid = tid_opaque();
    const int tid = tid_opaque(), lane = tid & 63, wave = tid >> 6;
    float* cvec = (float*)(smem + 36864);
    float* hid = (float*)(smem + 36864 + 256);
    bf16_t* pw = (bf16_t*)(p.ws + WS_PW);
    for (int w = bid; w < 32 + 128 * 8; w += nb) {
        const bool is_c = w < 32;
        const int kind = w >> 4, g = (w >> 3) & 1;
        const int w2_ = w - 32;
        const int m0 = is_c ? (w & 7) * 128 : (w2_ % 128) * 128;
        const int n0 = is_c ? 0 : (w2_ / 128) * 128;
        const int mrows = is_c ? ((NCMP - m0) < 128 ? (NCMP - m0) : 128) : 128;
        const bf16_t* Ap = is_c ? (const bf16_t*)(p.ws + (kind ? WS_VCR : WS_KCR)) + (size_t)g * S * 64 : (const bf16_t*)(p.ws + WS_PB);
        const bf16_t* Bp = is_c ? (const bf16_t*)(p.ws + (kind ? WB_CV1 : WB_CK1)) : (const bf16_t*)(p.ws + WB_PLE);
        f32x4 acc[4][4];
        gemm2<false, false>(Ap, is_c ? 16 * 64 : 256, nullptr, m0, mrows, Bp, is_c ? 64 : D, n0, is_c ? 64 : 128, is_c ? 2048 : 256, smem, acc);
        if (!is_c) {
#pragma unroll
            for (int i = 0; i < 4; ++i) {
                bf16_t* pr = pw + (size_t)(m0 + G2_ROW(i, 0)) * D + n0 + G2_COL(0);
#pragma unroll
                for (int j = 0; j < 4; ++j) store_bf16_frag(pr + j * 16, D, acc[i][j][0], acc[i][j][1], acc[i][j][2], acc[i][j][3], lane);
            }
            continue;
        }
        const float* pe = p.in[kind ? 11 : 8];
        const float* w1 = p.in[kind ? 12 : 9];
        const float* w2 = p.in[kind ? 13 : 10];
        {
            const int e = tid & 63, part = tid >> 6;
            float s = 0.f;
            for (int k = part * 512; k < part * 512 + 512; ++k) s += pe[k] * w1[(size_t)k * 64 + e];
            __syncthreads();
            hid[tid] = s;
            __syncthreads();
            if (tid < 64) cvec[tid] = hid[tid] + hid[64 + tid] + hid[128 + tid] + hid[192 + tid];
            __syncthreads();
        }
        if ((wave & 1) == 0) {
#pragma unroll
            for (int i = 0; i < 4; ++i)
#pragma unroll
                for (int j = 0; j < 4; ++j)
#pragma unroll
                    for (int r = 0; r < 4; ++r) {
                        const int row = G2_ROW(i, r), col = j * 16 + (lane & 15);
                        const float a = acc[i][j][r] + cvec[col];
                        hid[row * 65 + col] = a * sigmoidf_(a);
                    }
        }
        __syncthreads();
        const float gkn = p.in[5][lane];
        for (int row = wave; row < mrows; row += 4) {
            float o = 0.f;
#pragma unroll 8
            for (int e = 0; e < 64; ++e) o += hid[row * 65 + e] * w2[e * 64 + lane];
            if (kind == 0) o = o * rms64(o) * gkn;
            ((bf16_t*)(p.ws + (kind ? WS_VCB : WS_KCB)))[((size_t)g * 1024 + m0 + row) * 64 + lane] = (bf16_t)f2bf(o);
        }
        __syncthreads();
    }
    if (bid == nb - 1) {
        if (tid < 128) ((bf16_t*)(p.ws + WS_KCB))[((size_t)(tid >> 6) * 1024 + 1023) * 64 + (tid & 63)] = 0;
        else ((bf16_t*)(p.ws + WS_VCB))[((size_t)((tid - 128) >> 6) * 1024 + 1023) * 64 + (tid & 63)] = 0;
    }
}

constexpr int KSTR = 72;
constexpr int NSA_KT = 0;
constexpr int NSA_VT = NSA_KT + 32 * KSTR * 2;
constexpr int NSA_WV = NSA_VT + 32 * KSTR * 2;
constexpr int NSA_IMP = NSA_WV + 4 * 2 * 32 * KSTR * 2;
constexpr int NSA_LUT = NSA_IMP + 16 * 260 * 4;
constexpr int NSA_SEL = NSA_LUT + 4 * 128 * 4;
constexpr int NSA_STP = NSA_SEL + 16 * 16 * 4;
constexpr int NSA_END = NSA_STP + 4 * 128 * 4;
static_assert(NSA_END <= SMEM_BYTES, "nsa lds");

__device__ __forceinline__ f32x4 mfma16(bf16x8 a, bf16x8 b, f32x4 c) { return __builtin_amdgcn_mfma_f32_16x16x32_bf16(a, b, c, 0, 0, 0); }
__device__ __forceinline__ bf16x8 pack_p(const f32x4& p1, const f32x4& p2) {
    const unsigned a = pk2(p1[0], p1[1]), b = pk2(p1[2], p1[3]), c = pk2(p2[0], p2[1]), d = pk2(p2[2], p2[3]);
    return __builtin_bit_cast(bf16x8, make_uint4(a, b, c, d));
}
__device__ __forceinline__ void pv_step(f32x4 (&o)[4], const bf16_t* vt, bf16x8 pb, int fq, int fr) {
    const bf16_t* base = vt + (4 * fq + (fr >> 2)) * KSTR + 4 * (fr & 3);
#pragma unroll
    for (int dt = 0; dt < 4; ++dt) {
        const s16x4 lo4 = lds_tr16(base + dt * 16), hi4 = lds_tr16(base + 16 * KSTR + dt * 16);
        const bf16x8 va = (bf16x8){lo4[0], lo4[1], lo4[2], lo4[3], hi4[0], hi4[1], hi4[2], hi4[3]};
        o[dt] = mfma16(va, pb, o[dt]);
    }
}
__device__ __forceinline__ float quad_sum(float v) {
    v += __shfl_xor(v, 1);
    v += __shfl_xor(v, 2);
    return v;
}

__device__ __forceinline__ void nsa_tile(const Params& p, int tt, int g, unsigned char* smem) {
    const int tid = tid_opaque(), lane = tid & 63, wave = tid >> 6, fr = lane & 15, fq = lane >> 4;
    bf16_t* kt = (bf16_t*)(smem + NSA_KT);
    bf16_t* vt = (bf16_t*)(smem + NSA_VT);
    bf16_t* wv = (bf16_t*)(smem + NSA_WV) + wave * 2 * 32 * KSTR;
    float* imp = (float*)(smem + NSA_IMP);
    float* lut = (float*)(smem + NSA_LUT);
    int* sel = (int*)(smem + NSA_SEL);
    const bf16_t* qnb = (const bf16_t*)(p.ws + WS_QNB);
    const bf16_t* kslb = (const bf16_t*)(p.ws + WS_KSLB) + (size_t)g * S * 64;
    const bf16_t* vslb = (const bf16_t*)(p.ws + WS_VSLB) + (size_t)g * S * 64;
    const bf16_t* kwnb = (const bf16_t*)(p.ws + WS_KWNB) + (size_t)g * S * 64;
    const bf16_t* vwnb = (const bf16_t*)(p.ws + WS_VWNB) + (size_t)g * S * 64;
    const bf16_t* kcb = (const bf16_t*)(p.ws + WS_KCB) + (size_t)g * 1024 * 64;
    const bf16_t* vcb = (const bf16_t*)(p.ws + WS_VCB) + (size_t)g * 1024 * 64;
    const float* gt = (const float*)(p.ws + WS_GT);
    const float* relb = p.in[17];
    const int t0 = tt * 16;
    const int tl = 4 * wave + (fr >> 2);
    const int tok = t0 + tl;
    const int hl = fr & 3, head = g * 4 + hl;
    __syncthreads();
    for (int i = tid; i < 512; i += NT) { const int hh = i >> 7, n = i & 127; lut[i] = relb[bucket_of(n) * 16 + g * 4 + hh] * LOG2E; }
    for (int i = tid; i < 16 * 260; i += NT) imp[i] = 0.f;
    float U2;
    {
        const float mq = wave_max(fabsf(p.in[4][lane])), mk = wave_max(fabsf(p.in[5][lane]));
        float mb = 0.f;
#pragma unroll
        for (int k = 0; k < 4; ++k) { const int e = lane + 64 * k; mb = fmaxf(mb, fabsf(relb[(e >> 3) * 16 + (e & 7)])); }
        mb = wave_max(mb);
        U2 = (8.f * mq * mk + mb) * LOG2E;
    }
    bf16x8 qf[2];
#pragma unroll
    for (int kh = 0; kh < 2; ++kh) qf[kh] = *(const bf16x8*)(qnb + (size_t)tok * 512 + head * 64 + kh * 32 + fq * 8);
    __syncthreads();
    const float* lutp = lut + hl * 128;
    const float lutfar = lutp[127];
    const f32x4 zero4 = (f32x4){0.f, 0.f, 0.f, 0.f};
    f32x4 outacc[4];
#pragma unroll
    for (int dt = 0; dt < 4; ++dt) outacc[dt] = zero4;
    const float g0 = gt[(size_t)tok * 32 + head * 3 + 0], g1 = gt[(size_t)tok * 32 + head * 3 + 1], g2 = gt[(size_t)tok * 32 + head * 3 + 2];
    const int srow = tid >> 3, sch = tid & 7;

    bf16_t* ktb = (bf16_t*)(smem + NSA_WV);
    bf16_t* vtb = ktb + 2 * 64 * KSTR;
#define NSA_QK(KT_)                                                                                         \
        f32x4 s1 = zero4, s2 = zero4;                                                                       \
        _Pragma("unroll") for (int kh = 0; kh < 2; ++kh) {                                                  \
            const bf16x8 k1 = *(const bf16x8*)((KT_) + fr * KSTR + kh * 32 + fq * 8);                       \
            const bf16x8 k2 = *(const bf16x8*)((KT_) + (16 + fr) * KSTR + kh * 32 + fq * 8);                \
            s1 = mfma16(k1, qf[kh], s1);                                                                    \
            s2 = mfma16(k2, qf[kh], s2);                                                                    \
        }
    {
        int ks0 = (t0 - 511) & ~63; ks0 = ks0 < 0 ? 0 : ks0;
        const int nsteps = (t0 + 16 - ks0 + 63) >> 6;
        f32x4 o[4];
#pragma unroll
        for (int dt = 0; dt < 4; ++dt) o[dt] = zero4;
        float lsum = 0.f;
#define WIN_ROW(r_) ((r_) < S ? (r_) : S - 1)
        uint4 kr0 = *(const uint4*)(kwnb + (size_t)WIN_ROW(ks0 + srow) * 64 + sch * 8);
        uint4 kr1 = *(const uint4*)(kwnb + (size_t)WIN_ROW(ks0 + 32 + srow) * 64 + sch * 8);
        uint4 vr0 = *(const uint4*)(vwnb + (size_t)WIN_ROW(ks0 + srow) * 64 + sch * 8);
        uint4 vr1 = *(const uint4*)(vwnb + (size_t)WIN_ROW(ks0 + 32 + srow) * 64 + sch * 8);
#pragma unroll 1
        for (int st = 0; st < nsteps; ++st) {
            const int ksb = ks0 + st * 64;
            bf16_t* kt_ = ktb + (st & 1) * 64 * KSTR;
            bf16_t* vt_ = vtb + (st & 1) * 64 * KSTR;
            *(uint4*)(kt_ + srow * KSTR + sch * 8) = kr0; *(uint4*)(kt_ + (32 + srow) * KSTR + sch * 8) = kr1;
            *(uint4*)(vt_ + srow * KSTR + sch * 8) = vr0; *(uint4*)(vt_ + (32 + srow) * KSTR + sch * 8) = vr1;
            __syncthreads();
            if (st + 1 < nsteps) {
                kr0 = *(const uint4*)(kwnb + (size_t)WIN_ROW(ksb + 64 + srow) * 64 + sch * 8);
                kr1 = *(const uint4*)(kwnb + (size_t)WIN_ROW(ksb + 96 + srow) * 64 + sch * 8);
                vr0 = *(const uint4*)(vwnb + (size_t)WIN_ROW(ksb + 64 + srow) * 64 + sch * 8);
                vr1 = *(const uint4*)(vwnb + (size_t)WIN_ROW(ksb + 96 + srow) * 64 + sch * 8);
            }
#pragma unroll
            for (int hf = 0; hf < 2; ++hf) {
                const int ks = ksb + 32 * hf;
                if (ks > t0 + 15) continue;
                NSA_QK(kt_ + hf * 32 * KSTR)
                const bool far = (t0 + 4 * wave) - (ks + 31) >= 113;
                f32x4 p1, p2;
#pragma unroll
                for (int r = 0; r < 4; ++r) {
                    const int d1 = tok - (ks + 4 * fq + r), d2 = d1 - 16;
                    const float b1 = far ? lutfar : lutp[d1 < 0 ? 0 : (d1 > 127 ? 127 : d1)];
                    const float b2 = far ? lutfar : lutp[d2 < 0 ? 0 : (d2 > 127 ? 127 : d2)];
                    p1[r] = (d1 >= 0 && d1 < 512) ? __builtin_amdgcn_exp2f(s1[r] + b1 - U2) : 0.f;
                    p2[r] = (d2 >= 0 && d2 < 512) ? __builtin_amdgcn_exp2f(s2[r] + b2 - U2) : 0.f;
                    lsum += p1[r] + p2[r];
                }
                pv_step(o, vt_ + hf * 32 * KSTR, pack_p(p1, p2), fq, fr);
            }
        }
#undef WIN_ROW
        lsum += __shfl_xor(lsum, 16);
        lsum += __shfl_xor(lsum, 32);
        const float sc = lsum > 0.f ? g2 / lsum : 0.f;
#pragma unroll
        for (int dt = 0; dt < 4; ++dt)
#pragma unroll
            for (int r = 0; r < 4; ++r) outacc[dt][r] += sc * o[dt][r];
    }
    __syncthreads();

    {
        const int tlast = t0 + 15;
        const int cmax = (tlast >= 31) ? ((tlast - 31) >> 4) + 1 : 0;
        const int nsteps = (cmax + 63) >> 6;
        float inv_l = 0.f;
#pragma unroll 1
        for (int pass = 0; pass < 2; ++pass) {
            f32x4 o[4];
#pragma unroll
            for (int dt = 0; dt < 4; ++dt) o[dt] = zero4;
            float lsum = 0.f;
            uint4 kr0 = make_uint4(0, 0, 0, 0), kr1 = kr0, vr0 = kr0, vr1 = kr0;
            if (nsteps > 0) {
                kr0 = *(const uint4*)(kcb + (size_t)srow * 64 + sch * 8); kr1 = *(const uint4*)(kcb + (size_t)(32 + srow) * 64 + sch * 8);
                vr0 = *(const uint4*)(vcb + (size_t)srow * 64 + sch * 8); vr1 = *(const uint4*)(vcb + (size_t)(32 + srow) * 64 + sch * 8);
            }
#pragma unroll 1
            for (int st = 0; st < nsteps; ++st) {
                const int csb = st * 64;
                bf16_t* kt_ = ktb + (st & 1) * 64 * KSTR;
                bf16_t* vt_ = vtb + (st & 1) * 64 * KSTR;
                *(uint4*)(kt_ + srow * KSTR + sch * 8) = kr0; *(uint4*)(kt_ + (32 + srow) * KSTR + sch * 8) = kr1;
                *(uint4*)(vt_ + srow * KSTR + sch * 8) = vr0; *(uint4*)(vt_ + (32 + srow) * KSTR + sch * 8) = vr1;
                __syncthreads();
                if (st + 1 < nsteps) {
                    kr0 = *(const uint4*)(kcb + (size_t)(csb + 64 + srow) * 64 + sch * 8); kr1 = *(const uint4*)(kcb + (size_t)(csb + 96 + srow) * 64 + sch * 8);
                    vr0 = *(const uint4*)(vcb + (size_t)(csb + 64 + srow) * 64 + sch * 8); vr1 = *(const uint4*)(vcb + (size_t)(csb + 96 + srow) * 64 + sch * 8);
                }
#pragma unroll
                for (int hf = 0; hf < 2; ++hf) {
                    const int cs = csb + 32 * hf;
                    if (cs >= cmax) continue;
                    NSA_QK(kt_ + hf * 32 * KSTR)
                    const bool far = (t0 + 4 * wave) - (16 * (cs + 31) + 31) >= 113;
                    f32x4 p1, p2;
#pragma unroll
                    for (int r = 0; r < 4; ++r) {
                        const int d1 = tok - (16 * (cs + 4 * fq + r) + 31), d2 = d1 - 256;
                        const float b1 = far ? lutfar : lutp[d1 < 0 ? 0 : (d1 > 127 ? 127 : d1)];
                        const float b2 = far ? lutfar : lutp[d2 < 0 ? 0 : (d2 > 127 ? 127 : d2)];
                        p1[r] = (d1 >= 0) ? __builtin_amdgcn_exp2f(s1[r] + b1 - U2) : 0.f;
                        p2[r] = (d2 >= 0) ? __builtin_amdgcn_exp2f(s2[r] + b2 - U2) : 0.f;
                        lsum += p1[r] + p2[r];
                    }
                    if (pass == 1) {
#pragma unroll
                        for (int r = 0; r < 4; ++r) { p1[r] *= inv_l; p2[r] *= inv_l; }
                        f32x4 h1, h2;
#pragma unroll
                        for (int r = 0; r < 4; ++r) { h1[r] = quad_sum(p1[r]); h2[r] = quad_sum(p2[r]); }
                        if (hl == 0) {
                            float* ir = imp + tl * 260 + (cs >> 2) + fq;
                            atomicAdd(ir, h1[0] + h1[1] + h1[2] + 0.5f * h1[3]);
                            atomicAdd(ir + 1, 0.5f * h1[3]);
                            atomicAdd(ir + 4, h2[0] + h2[1] + h2[2] + 0.5f * h2[3]);
                            atomicAdd(ir + 5, 0.5f * h2[3]);
                        }
                        pv_step(o, vt_ + hf * 32 * KSTR, pack_p(p1, p2), fq, fr);
                    }
                }
            }
            __syncthreads();
            if (pass == 0) {
                lsum += __shfl_xor(lsum, 16);
                lsum += __shfl_xor(lsum, 32);
                inv_l = lsum > 0.f ? 1.f / lsum : 0.f;
            } else {
#pragma unroll
                for (int dt = 0; dt < 4; ++dt)
#pragma unroll
                    for (int r = 0; r < 4; ++r) outacc[dt][r] += g0 * o[dt][r];
            }
        }
    }
#undef NSA_QK
    __syncthreads();

#pragma unroll 1
    for (int tq = 0; tq < 4; ++tq) {
        const int tli = 4 * wave + tq, tk = t0 + tli, cur = tk >> 6;
        int* sl = sel + tli * 16;
        int nf = 0;
        if (lane == 0) {
            sl[0] = 0; int c_ = 1;
            if (cur - 1 >= 1) sl[c_++] = cur - 1;
            if (cur >= 1) sl[c_++] = cur;
            for (int k = c_; k < 16; ++k) sl[k] = -1;
        }
        nf = 1 + (cur - 1 >= 1 ? 1 : 0) + (cur >= 1 ? 1 : 0);
        const int ncand = cur - 2 > 0 ? cur - 2 : 0;
        int need = 16 - nf; need = need < ncand ? need : ncand;
        unsigned long long key[4];
#pragma unroll
        for (int k = 0; k < 4; ++k) {
            const int n = lane + 64 * k;
            const bool c = (n >= 1) && (n <= cur - 2);
            key[k] = c ? (((unsigned long long)__builtin_bit_cast(unsigned, imp[tli * 260 + n]) << 32) | (unsigned long long)(0xFFFFFFFFu - (unsigned)n)) + (1ull << 32) : 0ull;
        }
#pragma unroll 1
        for (int rd = 0; rd < need; ++rd) {
            unsigned long long m = key[0];
            m = key[1] > m ? key[1] : m; m = key[2] > m ? key[2] : m; m = key[3] > m ? key[3] : m;
#pragma unroll
            for (int o_ = 1; o_ < 64; o_ <<= 1) {
                const unsigned lo_ = __shfl_xor((unsigned)m, o_), hi_ = __shfl_xor((unsigned)(m >> 32), o_);
                const unsigned long long other = ((unsigned long long)hi_ << 32) | lo_;
                m = other > m ? other : m;
            }
            const int nstar = (int)(0xFFFFFFFFu - (unsigned)m);
#pragma unroll
            for (int k = 0; k < 4; ++k) if (key[k] == m) key[k] = 0ull;
            if (lane == 0) sl[nf + rd] = nstar;
        }
    }
    __syncthreads();

    {
        int* stp = (int*)(smem + NSA_STP) + wave * 128;
        int nst;
        {
            const int tq = lane >> 4, j = lane & 15;
            const int tk_ = t0 + 4 * wave + tq;
            const int b = sel[(4 * wave + tq) * 16 + j];
            const bool c1 = (b >= 0) && (b * 64 <= tk_), c2 = (b >= 0) && (b * 64 + 32 <= tk_);
            const unsigned long long m1 = __ballot(c1), m2 = __ballot(c2);
            const unsigned long long lt = (1ull << lane) - 1ull;
            const int pos = __builtin_popcountll(m1 & lt) + __builtin_popcountll(m2 & lt);
            if (c1) stp[pos] = (b * 64) | (tq << 20);
            if (c2) stp[pos + 1] = (b * 64 + 32) | (tq << 20);
            nst = __builtin_popcountll(m1) + __builtin_popcountll(m2);
        }
        asm volatile("" ::: "memory");
        uint2 oacc_pk[4];
#pragma unroll
        for (int dt = 0; dt < 4; ++dt) { oacc_pk[dt].x = pk2(outacc[dt][0], outacc[dt][1]); oacc_pk[dt].y = pk2(outacc[dt][2], outacc[dt][3]); }
        f32x4 o[4];
#pragma unroll
        for (int dt = 0; dt < 4; ++dt) o[dt] = zero4;
        float lsum = 0.f;
        const int r8 = lane >> 3, c8 = lane & 7;
        bf16_t* slot0 = wv;
        bf16_t* slot1 = wv + 32 * KSTR;
        bf16_t* kslot = (bf16_t*)(smem + NSA_IMP) + wave * 32 * 64;
        uint4 ka0, ka1, ka2, ka3, kb0, kb1, kb2, kb3;
        uint4 va0, va1, va2, va3;
#define SLC_STEP(i_) __builtin_amdgcn_readfirstlane(stp[(i_) < nst ? (i_) : nst - 1])
#define SLC_KLOAD(K_, w_)                                                                                           \
        { const uint4* kp_ = (const uint4*)(kslb + (size_t)(((w_) & 0xFFFFF) + r8) * 64 + c8 * 8);                      \
          K_##0 = kp_[0]; K_##1 = kp_[64]; K_##2 = kp_[128]; K_##3 = kp_[192]; }
#define SLC_VLOAD(V_, w_)                                                                                           \
        { const uint4* vs_ = (const uint4*)(vslb + (size_t)(((w_) & 0xFFFFF) + r8) * 64 + c8 * 8);                      \
          V_##0 = vs_[0]; V_##1 = vs_[64]; V_##2 = vs_[128]; V_##3 = vs_[192]; }
#define SLC_VSTORE(V_, slot_)                                                                                       \
        { bf16_t* vd_ = (slot_) + r8 * KSTR + c8 * 8;                                                               \
          *(uint4*)(vd_) = V_##0; *(uint4*)(vd_ + 8 * KSTR) = V_##1; *(uint4*)(vd_ + 16 * KSTR) = V_##2; *(uint4*)(vd_ + 24 * KSTR) = V_##3; }
#define SLC_KSTORE(K_)                                                                                              \
        { bf16_t* kd_ = kslot + r8 * 64 + ((c8 ^ r8) * 8);                                                          \
          *(uint4*)(kd_) = K_##0; *(uint4*)(kd_ + 8 * 64) = K_##1; *(uint4*)(kd_ + 16 * 64) = K_##2; *(uint4*)(kd_ + 24 * 64) = K_##3; }
#define SLC_STAGE(s_, K_, VW_, slotr_, slotw_)                                                                      \
        {                                                                                                           \
            const int wcur = SLC_STEP(s_), wk = SLC_STEP((s_) + 2);                                                 \
            SLC_KSTORE(K_)                                                            \
            SLC_VSTORE(VW_, slotw_)                                                      \
            asm volatile("" ::: "memory");                                                                          \
            SLC_VLOAD(VW_, wk)                                                                     \
            SLC_KLOAD(K_, wk)                                                                      \
            f32x4 s1 = zero4, s2 = zero4;                                                                           \
            _Pragma("unroll") for (int kh = 0; kh < 2; ++kh) {                                                      \
                const bf16x8 k1 = *(const bf16x8*)(kslot + fr * 64 + (((kh * 4 + fq) ^ (fr & 7)) * 8));             \
                const bf16x8 k2 = *(const bf16x8*)(kslot + (16 + fr) * 64 + (((kh * 4 + fq) ^ (fr & 7)) * 8));      \
                s1 = mfma16(k1, qf[kh], s1); s2 = mfma16(k2, qf[kh], s2);                                           \
            }                                                                                                       \
            const int ks = wcur & 0xFFFFF, tq = wcur >> 20, tk = t0 + 4 * wave + tq;                                \
            const bool mine = (fr >> 2) == tq;                                                                      \
            const bool far = tk - (ks + 31) >= 113;                                                                 \
            f32x4 p1, p2;                                                                                           \
            _Pragma("unroll") for (int r = 0; r < 4; ++r) {                                                         \
                const int d1 = tk - (ks + 4 * fq + r), d2 = d1 - 16;                                                \
                const float b1 = far ? lutfar : lutp[d1 < 0 ? 0 : (d1 > 127 ? 127 : d1)];                           \
                const float b2 = far ? lutfar : lutp[d2 < 0 ? 0 : (d2 > 127 ? 127 : d2)];                           \
                p1[r] = (mine && d1 >= 0) ? __builtin_amdgcn_exp2f(s1[r] + b1 - U2) : 0.f;                          \
                p2[r] = (mine && d2 >= 0) ? __builtin_amdgcn_exp2f(s2[r] + b2 - U2) : 0.f;                          \
                lsum += p1[r] + p2[r];                                                                              \
            }                                                                                                       \
            asm volatile("" ::: "memory");                                                                          \
            pv_step(o, slotr_, pack_p(p1, p2), fq, fr);                                                             \
            asm volatile("" ::: "memory");                                                                          \
        }
        {
            const int w0 = SLC_STEP(0), w1 = SLC_STEP(1);
            SLC_VLOAD(va, w0)
            SLC_KLOAD(ka, w0)
            SLC_KLOAD(kb, w1)
            SLC_VSTORE(va, slot0)
            SLC_VLOAD(va, w1)
        }
#pragma unroll 1
        for (int s = 0; s < nst; s += 2) {
            SLC_STAGE(s, ka, va, slot0, slot1)
            if (s + 1 < nst) SLC_STAGE(s + 1, kb, va, slot1, slot0)
        }
#undef SLC_STEP
#undef SLC_KLOAD
#undef SLC_VLOAD
#undef SLC_VSTORE
#undef SLC_KSTORE
#undef SLC_STAGE
        lsum += __shfl_xor(lsum, 16);
        lsum += __shfl_xor(lsum, 32);
        const float sc = lsum > 0.f ? g1 / lsum : 0.f;
#pragma unroll
        for (int dt = 0; dt < 4; ++dt) {
            outacc[dt][0] = __builtin_bit_cast(float, oacc_pk[dt].x << 16) + sc * o[dt][0];
            outacc[dt][1] = __builtin_bit_cast(float, oacc_pk[dt].x & 0xffff0000u) + sc * o[dt][1];
            outacc[dt][2] = __builtin_bit_cast(float, oacc_pk[dt].y << 16) + sc * o[dt][2];
            outacc[dt][3] = __builtin_bit_cast(float, oacc_pk[dt].y & 0xffff0000u) + sc * o[dt][3];
        }
    }
    bf16_t* orow = (bf16_t*)(p.ws + WS_OA) + (size_t)tok * 512 + head * 64 + 4 * fq;
#pragma unroll
    for (int dt = 0; dt < 4; ++dt) {
        uint2 v; v.x = pk2(outacc[dt][0], outacc[dt][1]); v.y = pk2(outacc[dt][2], outacc[dt][3]);
        *(uint2*)(orow + dt * 16) = v;
    }
}

typedef float f32x16 __attribute__((ext_vector_type(16)));
constexpr int DSA_CK = 0;
constexpr int DSA_CI = DSA_CK + 16 * 512 * 4;
constexpr int DSA_LUT = DSA_CI + 16 * 512 * 2;
constexpr int DSA_END = DSA_LUT + 8 * 128 * 4;
static_assert(DSA_END <= SMEM_BYTES, "dsa lds");

__device__ __forceinline__ unsigned mono_key(float s) {
    const unsigned u = __builtin_bit_cast(unsigned, s + 0.0f);
    return (u & 0x80000000u) ? ~u : (u | 0x80000000u);
}
__device__ __forceinline__ unsigned dsa_compact(unsigned* ck, unsigned short* ci, int n, int lane) {
    unsigned kk[8]; unsigned ii[8];
#pragma unroll
    for (int k = 0; k < 8; ++k) { const int e = lane + 64 * k; kk[k] = e < n ? ck[e] : 0u; ii[k] = e < n ? (unsigned)ci[e] : 0xFFFFu; }
    unsigned T = 0;
#pragma unroll 1
    for (int b = 31; b >= 0; --b) {
        const unsigned cand = T | (1u << b);
        int c = 0;
#pragma unroll
        for (int k = 0; k < 8; ++k) c += __builtin_popcountll(__ballot(kk[k] >= cand));
        if (c >= 256) T = cand;
    }
    int cgt = 0, ceq = 0;
#pragma unroll
    for (int k = 0; k < 8; ++k) { cgt += __builtin_popcountll(__ballot(kk[k] > T)); ceq += __builtin_popcountll(__ballot(kk[k] == T)); }
    const int need = 256 - cgt;
    unsigned X = 0xFFFFu;
    if (ceq > need) {
        X = 0;
#pragma unroll 1
        for (int b = 15; b >= 0; --b) {
            const unsigned cand = X | (1u << b);
            int c = 0;
#pragma unroll
            for (int k = 0; k < 8; ++k) c += __builtin_popcountll(__ballot(kk[k] == T && ii[k] < cand));
            if (c < need) X = cand;
        }
    }
    int base = 0;
    const unsigned long long lt = (1ull << lane) - 1ull;
#pragma unroll
    for (int k = 0; k < 8; ++k) {
        const bool keep = (kk[k] > T) || (kk[k] == T && ii[k] <= X);
        const unsigned long long m = __ballot(keep);
        if (keep) { const int pos = base + __builtin_popcountll(m & lt); ck[pos] = kk[k]; ci[pos] = (unsigned short)ii[k]; }
        base += __builtin_popcountll(m);
    }
    return T;
}

__device__ __forceinline__ void dsa_tile(const Params& p, int tt, unsigned char* smem) {
    const int tid = tid_opaque(), lane = tid & 63, wave = tid >> 6, col = lane & 31, hi = lane >> 5;
    unsigned* ckb = (unsigned*)(smem + DSA_CK);
    unsigned short* cib = (unsigned short*)(smem + DSA_CI);
    const bf16_t* iqb = (const bf16_t*)(p.ws + WS_IQB);
    const bf16_t* ikb = (const bf16_t*)(p.ws + WS_IKB);
    const float* iws = (const float*)(p.ws + WS_IWS);
    const int t0 = tt * 16;
    __syncthreads();
    const int tw = t0 + 4 * wave;
    bf16x8 af[2];
    {
        const int rho = col;
        const int tl_ = 2 * ((rho >> 2) & 1) + (rho >> 4), hd = 4 * ((rho >> 3) & 1) + (rho & 3);
#pragma unroll
        for (int ks = 0; ks < 2; ++ks) af[ks] = *(const bf16x8*)(iqb + (size_t)(tw + tl_) * 256 + hd * 32 + ks * 16 + hi * 8);
    }
    const int tokA = tw + 2 * hi, tokB = tokA + 1;
    float wA[8], wB[8];
#pragma unroll
    for (int h = 0; h < 8; ++h) { wA[h] = iws[(size_t)tokA * 8 + h]; wB[h] = iws[(size_t)tokB * 8 + h]; }
    unsigned* ckA = ckb + (4 * wave + 2 * hi) * 512;
    unsigned* ckB = ckA + 512;
    unsigned short* ciA = cib + (4 * wave + 2 * hi) * 512;
    unsigned short* ciB = ciA + 512;
    int cntA = 0, cntB = 0;
    unsigned LA = 0, LB = 0;
    const unsigned ltm = (1u << col) - 1u;
    const int nchunk = (tw + 4 + 31) >> 5;
    const f32x16 zero16 = {0.f, 0.f, 0.f, 0.f, 0.f, 0.f, 0.f, 0.f, 0.f, 0.f, 0.f, 0.f, 0.f, 0.f, 0.f, 0.f};
    bf16x8 nx0[4], nx1[4];
    const bf16_t* ikl = ikb + (size_t)col * 32 + hi * 8;
#pragma unroll
    for (int j = 0; j < 4; ++j) {
        const int cj = j < nchunk ? j : nchunk - 1;
        nx0[j] = *(const bf16x8*)(ikl + (size_t)cj * 1024); nx1[j] = *(const bf16x8*)(ikl + (size_t)cj * 1024 + 16);
    }
#pragma unroll 1
    for (int ch4 = 0; ch4 < nchunk; ch4 += 4) {
#pragma unroll
        for (int j = 0; j < 4; ++j) {
            const int ch = ch4 + j;
            const bf16x8 cu0 = nx0[j], cu1 = nx1[j];
            {
                int cj = ch + 4; cj = cj < nchunk ? cj : nchunk - 1;
                nx0[j] = *(const bf16x8*)(ikl + (size_t)cj * 1024); nx1[j] = *(const bf16x8*)(ikl + (size_t)cj * 1024 + 16);
            }
            if (ch < nchunk) {
                const int kidx = ch * 32 + col;
                f32x16 c = __builtin_amdgcn_mfma_f32_32x32x16_bf16(af[0], cu0, zero16, 0, 0, 0);
                c = __builtin_amdgcn_mfma_f32_32x32x16_bf16(af[1], cu1, c, 0, 0, 0);
                float sA = 0.f, sB = 0.f;
#pragma unroll
                for (int h = 0; h < 8; ++h) { sA += wA[h] * fmaxf(c[h], 0.f); sB += wB[h] * fmaxf(c[8 + h], 0.f); }
                const unsigned keyA = mono_key(sA), keyB = mono_key(sB);
                const bool pA = (kidx <= tokA) && (keyA > LA), pB = (kidx <= tokB) && (keyB > LB);
                const unsigned long long mA = __ballot(pA), mB = __ballot(pB);
                const unsigned hA = hi ? (unsigned)(mA >> 32) : (unsigned)mA, hB = hi ? (unsigned)(mB >> 32) : (unsigned)mB;
                if (pA) { const int pos = cntA + __builtin_popcount(hA & ltm); ckA[pos] = keyA; ciA[pos] = (unsigned short)kidx; }
                if (pB) { const int pos = cntB + __builtin_popcount(hB & ltm); ckB[pos] = keyB; ciB[pos] = (unsigned short)kidx; }
                cntA += __builtin_popcount(hA); cntB += __builtin_popcount(hB);
            }
        }
        if (__any((cntA > 384) || (cntB > 384))) {
#pragma unroll
            for (int tq = 0; tq < 4; ++tq) {
                const int cn = __shfl((tq & 1) ? cntB : cntA, (tq >> 1) * 32);
                if (cn > 384) {
                    const unsigned T = dsa_compact(ckb + (4 * wave + tq) * 512, cib + (4 * wave + tq) * 512, cn, lane);
                    if (hi == (tq >> 1)) { if (tq & 1) { cntB = 256; LB = T; } else { cntA = 256; LA = T; } }
                }
            }
        }
    }
#pragma unroll
    for (int tq = 0; tq < 4; ++tq) {
        const int cn = __shfl((tq & 1) ? cntB : cntA, (tq >> 1) * 32);
        if (cn > 256) {
            (void)dsa_compact(ckb + (4 * wave + tq) * 512, cib + (4 * wave + tq) * 512, cn, lane);
            if (hi == (tq >> 1)) { if (tq & 1) cntB = 256; else cntA = 256; }
        }
    }
    unsigned short* selg = (unsigned short*)(p.ws + WS_SEL);
    int* nselg = (int*)(p.ws + WS_NSEL);
#pragma unroll
    for (int tq = 0; tq < 4; ++tq) {
        int nsel = __shfl((tq & 1) ? cntB : cntA, (tq >> 1) * 32);
        nsel = nsel > 256 ? 256 : nsel;
        const unsigned short* sl = cib + (4 * wave + tq) * 512;
#pragma unroll
        for (int k = 0; k < 4; ++k) { const int e = lane + 64 * k; selg[(size_t)(tw + tq) * 256 + e] = e < nsel ? sl[e] : (unsigned short)0; }
        if (lane == 0) nselg[tw + tq] = nsel;
    }
}

__device__ __forceinline__ void phase_dsa_attn(const Params& p, int bid, int nb, unsigned char* smem) {
    const int tid = tid_opaque(), lane = tid & 63, wave = tid >> 6, slot = lane >> 3, chunk = lane & 7;
    float* lut = (float*)smem;
    const bf16_t* dqb = (const bf16_t*)(p.ws + WS_DQB);
    const bf16_t* dkb = (const bf16_t*)(p.ws + WS_DKB);
    const bf16_t* dvb = (const bf16_t*)(p.ws + WS_DVB);
    const unsigned short* selg = (const unsigned short*)(p.ws + WS_SEL);
    const int* nselg = (const int*)(p.ws + WS_NSEL);
    const float* relb = p.in[17];
    const int h = bid & 7, bh = bid >> 3, nbh = nb >> 3;
    __syncthreads();
    if (tid < 128) lut[tid] = relb[bucket_of(tid) * 16 + 8 + h] * LOG2E;
    float U2;
    {
        const float mq = wave_max(fabsf(p.in[6][lane])), mk = wave_max(fabsf(p.in[7][lane]));
        float mb = 0.f;
#pragma unroll
        for (int k = 0; k < 4; ++k) { const int e = lane + 64 * k; mb = fmaxf(mb, fabsf(relb[(e >> 3) * 16 + 8 + (e & 7)])); }
        mb = wave_max(mb);
        U2 = (8.f * mq * mk + mb) * LOG2E;
    }
    __syncthreads();
    const bf16_t* kbase = dkb + h * 64 + chunk * 8;
    const bf16_t* vbase = dvb + h * 64 + chunk * 8;
#pragma unroll 1
    for (int t = bh * 4 + wave; t < S; t += nbh * 4) {
        const int nsel = nselg[t];
        const uint2* ip = (const uint2*)(selg + (size_t)t * 256 + slot * 32);
        float q[8];
        {
            const uint4 qv = *(const uint4*)(dqb + (size_t)t * 512 + h * 64 + chunk * 8);
            q[0] = __builtin_bit_cast(float, qv.x << 16); q[1] = __builtin_bit_cast(float, qv.x & 0xffff0000u);
            q[2] = __builtin_bit_cast(float, qv.y << 16); q[3] = __builtin_bit_cast(float, qv.y & 0xffff0000u);
            q[4] = __builtin_bit_cast(float, qv.z << 16); q[5] = __builtin_bit_cast(float, qv.z & 0xffff0000u);
            q[6] = __builtin_bit_cast(float, qv.w << 16); q[7] = __builtin_bit_cast(float, qv.w & 0xffff0000u);
        }
        float o[8];
#pragma unroll
        for (int j = 0; j < 8; ++j) o[j] = 0.f;
        float lsum = 0.f;
        int sA_[4], sB_[4];
        uint4 kA_[4], vA_[4], kB_[4], vB_[4];
        uint2 idn = ip[0];
#define DSA_LOADG(S_, K_, V_, I_)                                                        \
        S_[0] = (int)((I_).x & 0xffffu); S_[1] = (int)((I_).x >> 16); S_[2] = (int)((I_).y & 0xffffu); S_[3] = (int)((I_).y >> 16); \
        _Pragma("unroll") for (int j = 0; j < 4; ++j) {                                 \
            K_[j] = *(const uint4*)(kbase + (size_t)S_[j] * 512);                        \
            V_[j] = *(const uint4*)(vbase + (size_t)S_[j] * 512);                        \
        }
#define DSA_COMPG(S_, K_, V_, gi)                                                        \
        _Pragma("unroll") for (int j = 0; j < 4; ++j) {                                 \
            const uint4 kv = K_[j], vv = V_[j];                                          \
            float d = q[0] * __builtin_bit_cast(float, kv.x << 16) + q[1] * __builtin_bit_cast(float, kv.x & 0xffff0000u) \
                    + q[2] * __builtin_bit_cast(float, kv.y << 16) + q[3] * __builtin_bit_cast(float, kv.y & 0xffff0000u) \
                    + q[4] * __builtin_bit_cast(float, kv.z << 16) + q[5] * __builtin_bit_cast(float, kv.z & 0xffff0000u) \
                    + q[6] * __builtin_bit_cast(float, kv.w << 16) + q[7] * __builtin_bit_cast(float, kv.w & 0xffff0000u); \
            d += __shfl_xor(d, 1); d += __shfl_xor(d, 2); d += __shfl_xor(d, 4);       \
            int dist = t - S_[j]; dist = dist > 127 ? 127 : (dist < 0 ? 0 : dist);       \
            float pr = __builtin_amdgcn_exp2f(d + lut[dist] - U2);                       \
            pr = (slot * 32 + (gi) * 4 + j < nsel) ? pr : 0.f;                           \
            lsum += pr;                                                                  \
            o[0] += pr * __builtin_bit_cast(float, vv.x << 16); o[1] += pr * __builtin_bit_cast(float, vv.x & 0xffff0000u); \
            o[2] += pr * __builtin_bit_cast(float, vv.y << 16); o[3] += pr * __builtin_bit_cast(float, vv.y & 0xffff0000u); \
            o[4] += pr * __builtin_bit_cast(float, vv.z << 16); o[5] += pr * __builtin_bit_cast(float, vv.z & 0xffff0000u); \
            o[6] += pr * __builtin_bit_cast(float, vv.w << 16); o[7] += pr * __builtin_bit_cast(float, vv.w & 0xffff0000u); \
        }
        DSA_LOADG(sA_, kA_, vA_, idn)
        idn = ip[1];
#pragma unroll 1
        for (int gi = 0; gi < 8; gi += 2) {
            DSA_LOADG(sB_, kB_, vB_, idn)
            idn = ip[gi + 2 < 8 ? gi + 2 : 7];
            DSA_COMPG(sA_, kA_, vA_, gi)
            DSA_LOADG(sA_, kA_, vA_, idn)
            idn = ip[gi + 3 < 8 ? gi + 3 : 7];
            DSA_COMPG(sB_, kB_, vB_, gi + 1)
        }
#undef DSA_LOADG
#undef DSA_COMPG
#pragma unroll
        for (int j = 0; j < 8; ++j) { o[j] += __shfl_xor(o[j], 8); o[j] += __shfl_xor(o[j], 16); o[j] += __shfl_xor(o[j], 32); }
        lsum += __shfl_xor(lsum, 8); lsum += __shfl_xor(lsum, 16); lsum += __shfl_xor(lsum, 32);
        if (slot == 0) {
            const float inv = lsum > 0.f ? 1.f / lsum : 0.f;
            uint4 ov;
            ov.x = pk2(o[0] * inv, o[1] * inv); ov.y = pk2(o[2] * inv, o[3] * inv); ov.z = pk2(o[4] * inv, o[5] * inv); ov.w = pk2(o[6] * inv, o[7] * inv);
            *(uint4*)((bf16_t*)(p.ws + WS_OB) + (size_t)t * 512 + h * 64 + chunk * 8) = ov;
        }
    }
}

__device__ __forceinline__ void convert_late_weights(const Params& p, int bid, int nb) {
    cvt_weights(p.in[21], (bf16_t*)(p.ws + WB_E1), (size_t)NEXP * D * 2 * DFF, bid, nb);
    cvt_weights(p.in[23], (bf16_t*)(p.ws + WB_E2), (size_t)NEXP * DFF * D, bid, nb);
    cvt_weights(p.in[27], (bf16_t*)(p.ws + WB_PLEG), (size_t)D * D, bid, nb);
}
__device__ __forceinline__ void phase_attn(const Params& p, int bid, int nb, unsigned char* smem) {
    const bool conv_first = bid < (nb >> 1);
    if (conv_first) convert_late_weights(p, bid, nb);
#pragma unroll 1
    for (int part = 0; part < 2; ++part) {
        if ((part == 0) == conv_first) {
#pragma unroll 1
        for (int w = bid, rd = 0; w < 1024; w += nb, ++rd) {
            const int r0 = w - bid;
            const int cnt = (1024 - r0) < nb ? (1024 - r0) : nb;
            const int k = (rd & 1) ? (cnt - 1 - bid) : bid;
            dsa_tile(p, 1023 - (r0 + k), smem);
        }
    }
        else {
#pragma unroll 1
        for (int i = bid, rd = 0; i < 2048; i += nb, ++rd) {
            const int r0 = i - bid;
            const int cnt = (2048 - r0) < nb ? (2048 - r0) : nb;
            const int k = ((rd & 1) && !(cnt & 1)) ? 2 * ((cnt >> 1) - 1 - (bid >> 1)) + (bid & 1) : bid;
            const int j = r0 + k;
            nsa_tile(p, 1023 - (j >> 1), j & 1, smem);
        }
    }
    }
    if (!conv_first) convert_late_weights(p, bid, nb);
}

template <int PASS>
__device__ __forceinline__ void phase_merge(const Params& p, int bid, int nb, unsigned char* smem) {
    const int g2tid = tid_opaque();
    const bf16_t* sg = (const bf16_t*)(p.ws + (PASS ? WS_SGB : WS_SGA));
    bf16_t* merged = (bf16_t*)(p.ws + WS_MERGED);
    float* tmp = (float*)(p.ws + WS_X1);
    const bf16_t* A = (const bf16_t*)(p.ws + (PASS ? WS_OB : WS_OA));
    const bf16_t* Bw = (const bf16_t*)(p.ws + (PASS ? WB_B : WB_A));
    for (int w = bid; w < 128 * 8; w += nb) {
        const int mt = w % 128, nt = w / 128;
        const int m0 = mt * 128, n0 = nt * 128;
        f32x4 acc[4][4];
        gemm2<false, false>(A, 512, nullptr, m0, 128, Bw, D, n0, 128, 512, smem, acc);
#pragma unroll
        for (int i = 0; i < 4; ++i) {
            float vv[4][4];
#pragma unroll
            for (int r = 0; r < 4; ++r) {
                const int row = m0 + G2_ROW(i, r);
                const bf16_t* zr = sg + (size_t)row * D + n0 + G2_COL(0);
                float* tr = tmp + (size_t)row * D + n0 + G2_COL(0);
#pragma unroll
                for (int j = 0; j < 4; ++j) {
                    const float v = bf2f(zr[j * 16]) * acc[i][j][r];
                    if (PASS == 0) tr[j * 16] = v;
                    else vv[j][r] = tr[j * 16] + v;
                }
            }
            if (PASS == 1) {
                bf16_t* mr = merged + (size_t)(m0 + G2_ROW(i, 0)) * D + n0 + G2_COL(0);
#pragma unroll
                for (int j = 0; j < 4; ++j) store_bf16_frag(mr + j * 16, D, vv[j][0], vv[j][1], vv[j][2], vv[j][3], g2tid & 63);
            }
        }
    }
}

__device__ __forceinline__ void phase_outproj(const Params& p, int bid, int nb, unsigned char* smem) {
    const int g2tid = tid_opaque();
    const bf16_t* merged = (const bf16_t*)(p.ws + WS_MERGED);
    const float* x = p.in[0];
    float* x1 = (float*)(p.ws + WS_X1);
    for (int w = bid; w < 128 * 8; w += nb) {
        const int mt = w % 128, nt = w / 128;
        const int m0 = mt * 128, n0 = nt * 128;
        f32x4 acc[4][4];
        gemm2<false, false>(merged, D, nullptr, m0, 128, (const bf16_t*)(p.ws + WB_OUT), D, n0, 128, D, smem, acc);
#pragma unroll
        for (int i = 0; i < 4; ++i)
#pragma unroll
            for (int r = 0; r < 4; ++r) {
                const size_t ro = (size_t)(m0 + G2_ROW(i, r)) * D + n0;
#pragma unroll
                for (int j = 0; j < 4; ++j) { const int c = G2_COL(j); x1[ro + c] = x[ro + c] + acc[i][j][r]; }
            }
    }
}

__device__ __forceinline__ void phase_route(const Params& p, int bid, int nb, unsigned char* smem) {
    const int lane = tid_opaque() & 63, wave = tid_opaque() >> 6;
    const float* x1 = (const float*)(p.ws + WS_X1);
    const float* g = p.in[18];
    const float* wr = p.in[19];
    const float* br = p.in[20];
    bf16_t* hb = (bf16_t*)(p.ws + WS_HB);
    int* topi = (int*)(p.ws + WS_TOPI);
    float* topw = (float*)(p.ws + WS_TOPW);
    int* cnt = (int*)(p.ws + WS_CTL);
    float* hl = (float*)smem + wave * 1056;
    const int ksub = lane >> 3, e4 = lane & 7;
    __syncthreads();
    for (int t = bid * 4 + wave; t < S; t += nb * 4) {
        const float4* xr = (const float4*)(x1 + (size_t)t * D);
        float4 v[4];
        float ss = 0.f;
#pragma unroll
        for (int j = 0; j < 4; ++j) { v[j] = xr[lane + 64 * j]; ss += v[j].x * v[j].x + v[j].y * v[j].y + v[j].z * v[j].z + v[j].w * v[j].w; }
        ss = wave_sum(ss);
        const float rstd = rsqrtf(ss * (1.f / D) + EPS);
#pragma unroll
        for (int j = 0; j < 4; ++j) {
            const float4 gg = ((const float4*)g)[lane + 64 * j];
            const float4 h4 = make_float4(v[j].x * rstd * gg.x, v[j].y * rstd * gg.y, v[j].z * rstd * gg.z, v[j].w * rstd * gg.w);
            uint2 o; o.x = pk2(h4.x, h4.y); o.y = pk2(h4.z, h4.w);
            ((uint2*)(hb + (size_t)t * D))[lane + 64 * j] = o;
            ((float4*)hl)[lane + 64 * j] = h4;
        }
        asm volatile("" ::: "memory");
        float4 acc = make_float4(0.f, 0.f, 0.f, 0.f);
        const float4* wp = (const float4*)(wr + (size_t)ksub * 32) + e4;
#pragma unroll 8
        for (int i = 0; i < 128; ++i) {
            const float hk = hl[8 * i + ksub];
            const float4 w4 = wp[(size_t)i * 64];
            acc.x += hk * w4.x; acc.y += hk * w4.y; acc.z += hk * w4.z; acc.w += hk * w4.w;
        }
#pragma unroll
        for (int o_ = 8; o_ < 64; o_ <<= 1) { acc.x += __shfl_xor(acc.x, o_); acc.y += __shfl_xor(acc.y, o_); acc.z += __shfl_xor(acc.z, o_); acc.w += __shfl_xor(acc.w, o_); }
        if (ksub == 0) {
            const float4 b4 = ((const float4*)br)[e4];
            ((float4*)(hl + 1024))[e4] = make_float4(acc.x + b4.x, acc.y + b4.y, acc.z + b4.z, acc.w + b4.w);
        }
        asm volatile("" ::: "memory");
        float lg[32];
#pragma unroll
        for (int e = 0; e < 8; ++e) { const float4 l4 = ((const float4*)(hl + 1024))[e]; lg[4 * e] = l4.x; lg[4 * e + 1] = l4.y; lg[4 * e + 2] = l4.z; lg[4 * e + 3] = l4.w; }
        asm volatile("" ::: "memory");
        int idx[4]; float val[4];
        unsigned used = 0;
#pragma unroll
        for (int k = 0; k < 4; ++k) {
            float best = -__builtin_inff(); int bi = 0;
#pragma unroll
            for (int e = 0; e < 32; ++e) { const bool ok = !((used >> e) & 1u) && (lg[e] > best); best = ok ? lg[e] : best; bi = ok ? e : bi; }
            idx[k] = bi; val[k] = best; used |= 1u << bi;
        }
        const float e0 = 1.f, e1 = __expf(val[1] - val[0]), e2 = __expf(val[2] - val[0]), e3 = __expf(val[3] - val[0]);
        const float inv = 1.f / (e0 + e1 + e2 + e3);
        if (lane == 0) {
            topi[t * 4 + 0] = idx[0]; topi[t * 4 + 1] = idx[1]; topi[t * 4 + 2] = idx[2]; topi[t * 4 + 3] = idx[3];
            topw[t * 4 + 0] = e0 * inv; topw[t * 4 + 1] = e1 * inv; topw[t * 4 + 2] = e2 * inv; topw[t * 4 + 3] = e3 * inv;
            atomicAdd(&cnt[idx[0]], 1); atomicAdd(&cnt[idx[1]], 1); atomicAdd(&cnt[idx[2]], 1); atomicAdd(&cnt[idx[3]], 1);
        }
    }
}

__device__ __forceinline__ void phase_place(const Params& p, int bid, int nb, unsigned char* smem) {
    int* off = (int*)smem;
    const int* cnt = (const int*)(p.ws + WS_CTL);
    int* cur = (int*)(p.ws + WS_CTL) + 32;
    const int* topi = (const int*)(p.ws + WS_TOPI);
    int* ppos = (int*)(p.ws + WS_PPOS);
    int* rowtok = (int*)(p.ws + WS_ROWTOK);
    __syncthreads();
    if (tid_opaque() == 0) { int a = 0; for (int e = 0; e < NEXP; ++e) { off[e] = a; a += cnt[e]; } }
    __syncthreads();
    for (int i = bid * NT + tid_opaque(); i < S * 4; i += nb * NT) {
        const int e = topi[i];
        const int pos = off[e] + atomicAdd(&cur[e], 1);
        ppos[i] = pos;
        rowtok[pos] = i >> 2;
    }
}

__device__ __forceinline__ void moe_tile_map(const int* cnt, int* sm, int& total_mt) {
    __syncthreads();
    if (tid_opaque() == 0) {
        int a = 0, b = 0;
        for (int e = 0; e < NEXP; ++e) { sm[e] = a; sm[33 + e] = b; a += (cnt[e] + 127) >> 7; b += cnt[e]; }
        sm[32] = a; sm[65] = b;
    }
    __syncthreads();
    total_mt = sm[32];
}
__device__ __forceinline__ void phase_moe1(const Params& p, int bid, int nb, unsigned char* smem) {
    const int g2tid = tid_opaque();
    int* sm = (int*)(smem + 65536);
    const int* cnt = (const int*)(p.ws + WS_CTL);
    const int* rowtok = (const int*)(p.ws + WS_ROWTOK);
    const bf16_t* hb = (const bf16_t*)(p.ws + WS_HB);
    bf16_t* act = (bf16_t*)(p.ws + WS_ACT);
    const int lane = tid_opaque() & 63, wave = tid_opaque() >> 6;
    int total_mt;
    moe_tile_map(cnt, sm, total_mt);
    for (int w = bid; w < total_mt * 16; w += nb) {
        const int tm = w >> 4, nt = w & 15;
        int e = 0;
        while (e < NEXP - 1 && sm[e + 1] <= tm) ++e;
        const int mt = tm - sm[e];
        const int rbase = sm[33 + e] + mt * 128;
        const int mrows = min(128, cnt[e] - mt * 128);
        const int n0 = nt * 64;
        f32x4 acc[4][4];
        gemm2<true, true>(hb, D, rowtok, rbase, mrows, (const bf16_t*)(p.ws + WB_E1) + (size_t)e * D * 2 * DFF, 2 * DFF, n0, 128, D, smem, acc);
        const float* b1 = p.in[22] + (size_t)e * 2 * DFF;
        const int wn_ = (tid_opaque() >> 6) & 1;
#pragma unroll
        for (int i = 0; i < 4; ++i)
#pragma unroll
            for (int jp = 0; jp < 2; ++jp) {
                const int col = n0 + (wn_ * 2 + jp) * 16 + (tid_opaque() & 15);
                const float bg = b1[col], bl = b1[DFF + col];
                float av[4];
                unsigned rmask = 0;
#pragma unroll
                for (int r = 0; r < 4; ++r) {
                    const int rl = G2_ROW(i, r);
                    const float gate = fminf(acc[i][2 * jp][r] + bg, 7.f);
                    const float lin = fminf(fmaxf(acc[i][2 * jp + 1][r] + bl, -7.f), 7.f);
                    av[r] = (lin + 1.f) * gate * sigmoidf_(1.702f * gate);
                    rmask |= (rl < mrows) ? (1u << r) : 0u;
                }
                store_bf16_frag(act + (size_t)(rbase + G2_ROW(i, 0)) * DFF + col, DFF, av[0], av[1], av[2], av[3], g2tid & 63, rmask);
            }
    }
}
__device__ __forceinline__ void phase_moe2(const Params& p, int bid, int nb, unsigned char* smem) {
    const int g2tid = tid_opaque();
    int* sm = (int*)(smem + 65536);
    const int* cnt = (const int*)(p.ws + WS_CTL);
    const bf16_t* act = (const bf16_t*)(p.ws + WS_ACT);
    float* yrows = (float*)(p.ws + WS_YROWS);
    const int lane = tid_opaque() & 63, wave = tid_opaque() >> 6;
    int total_mt;
    moe_tile_map(cnt, sm, total_mt);
    for (int w = bid; w < total_mt * 8; w += nb) {
        const int tm = w >> 3, nt = w & 7;
        int e = 0;
        while (e < NEXP - 1 && sm[e + 1] <= tm) ++e;
        const int mt = tm - sm[e];
        const int rbase = sm[33 + e] + mt * 128;
        const int mrows = min(128, cnt[e] - mt * 128);
        const int n0 = nt * 128;
        f32x4 acc[4][4];
        gemm2<false, false>(act, DFF, nullptr, rbase, mrows, (const bf16_t*)(p.ws + WB_E2) + (size_t)e * DFF * D, D, n0, 128, DFF, smem, acc);
        const float* b2 = p.in[24] + (size_t)e * D + n0;
#pragma unroll
        for (int i = 0; i < 4; ++i)
#pragma unroll
            for (int r = 0; r < 4; ++r) {
                const int rl = G2_ROW(i, r);
                if (rl < mrows) {
                    float* yr = yrows + (size_t)(rbase + rl) * D + n0;
#pragma unroll
                    for (int j = 0; j < 4; ++j) { const int c = G2_COL(j); yr[c] = acc[i][j][r] + b2[c]; }
                }
            }
    }
}

__device__ __forceinline__ void phase_combine(const Params& p, int bid, int nb) {
    const int lane = tid_opaque() & 63, wave = tid_opaque() >> 6;
    const float* x1 = (const float*)(p.ws + WS_X1);
    const float* yrows = (const float*)(p.ws + WS_YROWS);
    const int* ppos = (const int*)(p.ws + WS_PPOS);
    const float* topw = (const float*)(p.ws + WS_TOPW);
    const float* g = p.in[25];
    bf16_t* hb = (bf16_t*)(p.ws + WS_HB);
    bf16_t* pb = (bf16_t*)(p.ws + WS_PB);
    for (int t = bid * 4 + wave; t < S; t += nb * 4) {
        float4 v[4];
#pragma unroll
        for (int j = 0; j < 4; ++j) v[j] = ((const float4*)(x1 + (size_t)t * D))[lane + 64 * j];
#pragma unroll
        for (int k = 0; k < 4; ++k) {
            const float wk = topw[t * 4 + k];
            const float4* yr = (const float4*)(yrows + (size_t)ppos[t * 4 + k] * D);
#pragma unroll
            for (int j = 0; j < 4; ++j) { const float4 y = yr[lane + 64 * j]; v[j].x += wk * y.x; v[j].y += wk * y.y; v[j].z += wk * y.z; v[j].w += wk * y.w; }
        }
        float ss = 0.f;
#pragma unroll
        for (int j = 0; j < 4; ++j) ss += v[j].x * v[j].x + v[j].y * v[j].y + v[j].z * v[j].z + v[j].w * v[j].w;
        ss = wave_sum(ss);
        const float rstd = rsqrtf(ss * (1.f / D) + EPS);
#pragma unroll
        for (int j = 0; j < 4; ++j) {
            ((float4*)(p.out + (size_t)t * D))[lane + 64 * j] = v[j];
            const float4 gg = ((const float4*)g)[lane + 64 * j];
            uint2 o;
            o.x = pk2(v[j].x * rstd * gg.x, v[j].y * rstd * gg.y);
            o.y = pk2(v[j].z * rstd * gg.z, v[j].w * rstd * gg.w);
            ((uint2*)(hb + (size_t)t * D))[lane + 64 * j] = o;
        }
    }
}

__device__ __forceinline__ void phase_ple(const Params& p, int bid, int nb, unsigned char* smem) {
    const int g2tid = tid_opaque();
    const bf16_t* pw = (const bf16_t*)(p.ws + WS_PW);
    for (int w = bid; w < 128 * 8; w += nb) {
        const int mt = w % 128, nt = w / 128;
        const int m0 = mt * 128, n0 = nt * 128;
        f32x4 acc[4][4];
        gemm2<false, false>((const bf16_t*)(p.ws + WS_HB), D, nullptr, m0, 128, (const bf16_t*)(p.ws + WB_PLEG), D, n0, 128, D, smem, acc);
#pragma unroll
        for (int i = 0; i < 4; ++i)
#pragma unroll
            for (int r = 0; r < 4; ++r) {
                const size_t ro = (size_t)(m0 + G2_ROW(i, r)) * D + n0 + G2_COL(0);
                float* orow = p.out + ro;
#pragma unroll
                for (int j = 0; j < 4; ++j) orow[j * 16] = orow[j * 16] + sigmoidf_(acc[i][j][r]) * bf2f(pw[ro + j * 16]);
            }
    }
}

#define LAS __attribute__((address_space(3)))
#define XB_TMO      128
#define XB_XCNT(j)  (256  + 64 * (j))
#define XB_XSUB(j)  (1280 + 64 * (j))
#define XB_XGEN(j)  (2304 + 64 * (j))
#define XB_TOP      3328
#define XB_TOPGEN   3392
#define XCD_BAR_WORDS 3456
#define XB_SPIN_CAP (1u << 22)

__device__ __forceinline__ unsigned xb_ld(unsigned* p)              { return __hip_atomic_load(p, __ATOMIC_RELAXED, __HIP_MEMORY_SCOPE_AGENT); }
__device__ __forceinline__ unsigned xb_add(unsigned* p, unsigned v) { return __hip_atomic_fetch_add(p, v, __ATOMIC_RELAXED, __HIP_MEMORY_SCOPE_AGENT); }
__device__ __forceinline__ unsigned xb_xcc_id() { return (unsigned)__builtin_amdgcn_s_getreg((3 << 11) | 20) & 0xFu; }
#define XB_SPIN(cond, bar) do { unsigned _sp = 0; while (cond) { __builtin_amdgcn_s_sleep(1); \
    if ((++_sp & 255u) == 0u) { if (xb_ld(&(bar)[XB_TMO])) break; if (_sp > XB_SPIN_CAP) { atomicAdd(&(bar)[XB_TMO], 1u); break; } } } } while (0)

struct XcdBarrier {
    unsigned* bar; unsigned x;
    volatile LAS unsigned* st;
};

__device__ __forceinline__ XcdBarrier xcd_barrier_post(unsigned* bar, volatile LAS unsigned* st) {
    XcdBarrier b; b.bar = bar; b.x = xb_xcc_id(); b.st = st;
    if (tid_opaque() == 0) (void)xb_add(&bar[XB_XCNT(b.x)], 1u);
    return b;
}
__device__ __forceinline__ void xcd_barrier_complete(unsigned* bar, unsigned x, unsigned& nloc, unsigned& nx) {
    const unsigned G = gridDim.x * gridDim.y * gridDim.z;
    unsigned sum, cnt, mine, sp = 0u;
    for (;;) {
        sum = 0u; cnt = 0u; mine = 0u;
#pragma unroll
        for (unsigned j = 0; j < 16; ++j) { const unsigned c = xb_ld(&bar[XB_XCNT(j)]); sum += c; cnt += (c > 0u) ? 1u : 0u; mine = (j == x) ? c : mine; }
        if (sum == G) break;
        __builtin_amdgcn_s_sleep(1);
        if ((++sp & 255u) == 0u) { if (xb_ld(&bar[XB_TMO])) break; if (sp > XB_SPIN_CAP) { atomicAdd(&bar[XB_TMO], 1u); break; } }
    }
    nloc = mine > 0u ? mine : 1u; nx = cnt > 0u ? cnt : 1u;
}

__device__ __forceinline__ void xcd_barrier(const XcdBarrier& b) {
    asm volatile("s_waitcnt vmcnt(0)" ::: "memory");
    __syncthreads();
    if (tid_opaque() == 0) {
        unsigned* bar = b.bar;
        __builtin_amdgcn_s_waitcnt(0);
        unsigned nloc = b.st[0], nx = b.st[1];
        if (nloc == 0u) { xcd_barrier_complete(bar, b.x, nloc, nx); b.st[0] = nloc; b.st[1] = nx; }
        const unsigned old = xb_add(&bar[XB_XSUB(b.x)], 1u);
        const unsigned gen = old / nloc;
        if (old + 1u == (gen + 1u) * nloc) {
            __builtin_amdgcn_fence(__ATOMIC_RELEASE, "agent");
            asm volatile("s_waitcnt vmcnt(0)" ::: "memory");
            const unsigned og = xb_add(&bar[XB_TOP], 1u);
            const unsigned tg = og / nx;
            if (og + 1u == (tg + 1u) * nx) xb_add(&bar[XB_TOPGEN], 1u);
            else XB_SPIN(xb_ld(&bar[XB_TOPGEN]) == tg, bar);
            __builtin_amdgcn_fence(__ATOMIC_ACQUIRE, "agent");
            xb_add(&bar[XB_XGEN(b.x)], 1u);
            asm volatile("s_waitcnt vmcnt(0)" ::: "memory");
        } else {
            XB_SPIN(xb_ld(&bar[XB_XGEN(b.x)]) == gen, bar);
            __builtin_amdgcn_fence(__ATOMIC_ACQUIRE, "agent");
            asm volatile("s_waitcnt vmcnt(0)" ::: "memory");
        }
    }
    __syncthreads();
}

template <int PH>
__device__ __forceinline__ void run_phase(const Params& p, int bid, int nb, unsigned char* smem) {
    if (PH == 0) phase_prep(p, bid, nb);
    if (PH == 1) phase_inproj(p, bid, nb, smem);
    if (PH == 3) phase_compress(p, bid, nb, smem);
    if (PH == 4) phase_attn(p, bid, nb, smem);
    if (PH == 15) {
        if (bid < (nb >> 1)) { phase_dsa_attn(p, bid, nb, smem); phase_merge<0>(p, bid, nb, smem); }
        else { phase_merge<0>(p, bid, nb, smem); phase_dsa_attn(p, bid, nb, smem); }
    }
    if (PH == 13) phase_merge<1>(p, bid, nb, smem);
    if (PH == 6) phase_outproj(p, bid, nb, smem);
    if (PH == 7) phase_route(p, bid, nb, smem);
    if (PH == 8) phase_place(p, bid, nb, smem);
    if (PH == 9) phase_moe1(p, bid, nb, smem);
    if (PH == 10) phase_moe2(p, bid, nb, smem);
    if (PH == 11) phase_combine(p, bid, nb);
    if (PH == 12) phase_ple(p, bid, nb, smem);
}

#if SINGLE_LAUNCH
__global__ void __launch_bounds__(NT, 2) fwd_mega(Params p) {
    __shared__ __attribute__((aligned(16))) unsigned char smem[SMEM_BYTES];
    cg::grid_group grid = cg::this_grid();
    const int bid = blockIdx.x, nb = gridDim.x;
    volatile LAS unsigned* bst = (volatile LAS unsigned*)(LAS unsigned char*)(smem + SMEM_BYTES - 16);
    if (tid_opaque() < 2) bst[tid_opaque()] = 0u;
    __syncthreads();
    const XcdBarrier bar = xcd_barrier_post((unsigned*)(p.ws + WS_BAR), bst);
#define GSYNC() xcd_barrier(bar)
    run_phase<0>(p, bid, nb, smem); grid.sync();
    run_phase<1>(p, bid, nb, smem); GSYNC();
    run_phase<3>(p, bid, nb, smem); GSYNC();
    run_phase<4>(p, bid, nb, smem); GSYNC();
    run_phase<15>(p, bid, nb, smem); GSYNC();
    run_phase<13>(p, bid, nb, smem); GSYNC();
    run_phase<6>(p, bid, nb, smem); GSYNC();
    run_phase<7>(p, bid, nb, smem); GSYNC();
    run_phase<8>(p, bid, nb, smem); GSYNC();
    run_phase<9>(p, bid, nb, smem); GSYNC();
    run_phase<10>(p, bid, nb, smem); GSYNC();
    run_phase<11>(p, bid, nb, smem); GSYNC();
    run_phase<12>(p, bid, nb, smem);
#undef GSYNC
}
#else
template <int PH>
__global__ void __launch_bounds__(NT, 2) k_phase(Params p) {
    __shared__ __attribute__((aligned(16))) unsigned char smem[SMEM_BYTES];
    run_phase<PH>(p, blockIdx.x, gridDim.x, smem);
}
#endif

extern "C" void kernel_launch(void* const* d_in, const int* in_sizes, int n_in, void* d_out, int out_size, void* d_ws, size_t ws_size,
                              hipStream_t stream) {
    if (n_in != 28 || ws_size < WS_END) { fprintf(stderr, "kernel_launch: unexpected n_in %d or ws_size %zu (< %zu)\n", n_in, ws_size, (size_t)WS_END); return; }
    Params p{};
    for (int i = 0; i < 28; ++i) p.in[i] = (const float*)d_in[i];
    p.out = (float*)d_out;
    p.ws = (unsigned char*)d_ws;
#if SINGLE_LAUNCH
    static int grid_blocks = 0;
    if (!grid_blocks) {
        int dev = 0, cus = 0, per_cu = 0;
        hipGetDevice(&dev);
        hipDeviceGetAttribute(&cus, hipDeviceAttributeMultiprocessorCount, dev);
        hipOccupancyMaxActiveBlocksPerMultiprocessor(&per_cu, fwd_mega, NT, 0);
        if (per_cu > 2) per_cu = 2;
        if (per_cu < 1) per_cu = 1;
        grid_blocks = cus * per_cu;
    }
    (void)hipMemsetAsync((unsigned char*)d_ws + WS_BAR, 0, XCD_BAR_WORDS * 4, stream);
    void* args[] = {&p};
    hipError_t e = hipLaunchCooperativeKernel((void*)fwd_mega, dim3(grid_blocks), dim3(NT), args, 0, stream);
    if (e != hipSuccess) fprintf(stderr, "cooperative launch failed: %s (grid %d)\n", hipGetErrorString(e), grid_blocks);
#else
    const int G = 512;
    k_phase<0><<<G, NT, 0, stream>>>(p);
    k_phase<1><<<G, NT, 0, stream>>>(p);
    k_phase<3><<<G, NT, 0, stream>>>(p);
    k_phase<4><<<G, NT, 0, stream>>>(p);
    k_phase<15><<<G, NT, 0, stream>>>(p);
    k_phase<13><<<G, NT, 0, stream>>>(p);
    k_phase<6><<<G, NT, 0, stream>>>(p);
    k_phase<7><<<G, NT, 0, stream>>>(p);
    k_phase<8><<<G, NT, 0, stream>>>(p);
    k_phase<9><<<G, NT, 0, stream>>>(p);
    k_phase<10><<<G, NT, 0, stream>>>(p);
    k_phase<11><<<G, NT, 0, stream>>>(p);
    k_phase<12><<<G, NT, 0, stream>>>(p);
#endif
}
```

```cpp
#include <hip/hip_runtime.h>
#include <hip/hip_cooperative_groups.h>
#include <cstdio>
#include <cstdint>
namespace cg = cooperative_groups;

#ifndef SINGLE_LAUNCH
#define SINGLE_LAUNCH 1
#endif

constexpr int S = 16384;
constexpr int D = 1024;
constexpr int DIN = 5184;
constexpr int NCMP = 1023;
constexpr int NSLC = 256;
constexpr int NEXP = 32;
constexpr int DFF = 1024;
constexpr float EPS = 1e-6f;
constexpr float LOG2E = 1.4426950408889634f;
constexpr int Z_NQ = 0, Z_NKV = 512, Z_NGATE = 1280, Z_DQ = 1304, Z_DK = 1816, Z_DV = 2328, Z_IQ = 2840, Z_IK = 3096,
              Z_IW = 3128, Z_GA = 3136, Z_GB = 4160;

constexpr int NT = 256;
constexpr int SMEM_BYTES = 73728;

typedef unsigned short bf16_t;
typedef short bf16x8 __attribute__((ext_vector_type(8)));
typedef float f32x4 __attribute__((ext_vector_type(4)));
typedef short s16x4 __attribute__((ext_vector_type(4)));
typedef __attribute__((address_space(3))) s16x4* lds_s16x4_ptr;
__device__ __forceinline__ s16x4 lds_tr16(const void* p) {
    return __builtin_amdgcn_ds_read_tr16_b64_v4i16((lds_s16x4_ptr)(uintptr_t)p);
}

constexpr size_t MBy = 1ull << 20;
constexpr size_t WS_CTL = 0;
constexpr size_t WS_BAR = 65536;
constexpr size_t WS_HB = 1 * MBy;
constexpr size_t WS_OA = WS_HB + (size_t)S * D * 2;
constexpr size_t WS_OB = WS_OA + (size_t)S * 512 * 2;
constexpr size_t WS_MERGED = WS_OB + (size_t)S * 512 * 2;
constexpr size_t WS_X1 = WS_MERGED + (size_t)S * D * 2;
constexpr size_t WS_TOPI = WS_X1 + (size_t)S * D * 4;
constexpr size_t WS_TOPW = WS_TOPI + (size_t)S * 4 * 4;
constexpr size_t WS_PPOS = WS_TOPW + (size_t)S * 4 * 4;
constexpr size_t WS_ROWTOK = WS_PPOS + (size_t)S * 4 * 4;
constexpr size_t WS_PB = WS_ROWTOK + (size_t)65536 * 4;
constexpr size_t WS_PW = WS_PB + (size_t)S * 256 * 2;
constexpr size_t WS_SEL = WS_PW + (size_t)S * D * 2;
constexpr size_t WS_NSEL = WS_SEL + (size_t)S * 256 * 2;
constexpr size_t WS_REG = WS_NSEL + (size_t)S * 4;
constexpr size_t WS_SGA = WS_REG;
constexpr size_t WS_SGB = WS_SGA + (size_t)S * D * 2;
constexpr size_t WS_GT = WS_SGB + (size_t)S * D * 2;
constexpr size_t WS_IWS = WS_GT + (size_t)S * 32 * 4;
constexpr size_t WS_QNB = WS_IWS + (size_t)S * 8 * 4;
constexpr size_t WS_KSLB = WS_QNB + (size_t)S * 512 * 2;
constexpr size_t WS_VSLB = WS_KSLB + (size_t)S * 128 * 2;
constexpr size_t WS_KWNB = WS_VSLB + (size_t)S * 128 * 2;
constexpr size_t WS_VWNB = WS_KWNB + (size_t)S * 128 * 2;
constexpr size_t WS_KCB = WS_VWNB + (size_t)S * 128 * 2;
constexpr size_t WS_VCB = WS_KCB + (size_t)2 * 1024 * 64 * 2;
constexpr size_t WS_KCR = WS_VCB + (size_t)2 * 1024 * 64 * 2;
constexpr size_t WS_VCR = WS_KCR + (size_t)S * 128 * 2;
constexpr size_t WS_DQB = WS_VCR + (size_t)S * 128 * 2;
constexpr size_t WS_DKB = WS_DQB + (size_t)S * 512 * 2;
constexpr size_t WS_DVB = WS_DKB + (size_t)S * 512 * 2;
constexpr size_t WS_IQB = WS_DVB + (size_t)S * 512 * 2;
constexpr size_t WS_IKB = WS_IQB + (size_t)S * 256 * 2;
constexpr size_t WS_ENDA = WS_IKB + (size_t)S * 32 * 2;
constexpr size_t WS_ACT = WS_REG;
constexpr size_t WS_YROWS = WS_ACT + (size_t)(65536 + 128) * DFF * 2;
constexpr size_t WS_ENDB = WS_YROWS + (size_t)(65536 + 128) * D * 4;
constexpr size_t WS_END0 = WS_ENDA > WS_ENDB ? WS_ENDA : WS_ENDB;
constexpr size_t WB_IN = WS_END0;
constexpr size_t WB_A = WB_IN + (size_t)D * DIN * 2;
constexpr size_t WB_B = WB_A + (size_t)512 * D * 2;
constexpr size_t WB_OUT = WB_B + (size_t)512 * D * 2;
constexpr size_t WB_E1 = WB_OUT + (size_t)D * D * 2;
constexpr size_t WB_E2 = WB_E1 + (size_t)NEXP * D * 2 * DFF * 2;
constexpr size_t WB_PLE = WB_E2 + (size_t)NEXP * DFF * D * 2;
constexpr size_t WB_PLEG = WB_PLE + (size_t)256 * D * 2;
constexpr size_t WB_CK1 = WB_PLEG + (size_t)D * D * 2;
constexpr size_t WB_CV1 = WB_CK1 + (size_t)2048 * 64 * 2;
constexpr size_t WS_END = WB_CV1 + (size_t)2048 * 64 * 2 + 4096;

struct Params {
    const float* in[28];
    float* out;
    unsigned char* ws;
};

__device__ __forceinline__ unsigned f2bf(float f) {
    unsigned u = __builtin_bit_cast(unsigned, f);
    return (u + 0x7fffu + ((u >> 16) & 1u)) >> 16;
}
__device__ __forceinline__ unsigned pk2(float lo, float hi) { return f2bf(lo) | (f2bf(hi) << 16); }
__device__ __forceinline__ float bf2f(unsigned short b) { return __builtin_bit_cast(float, (unsigned)b << 16); }
__device__ __forceinline__ int tid_opaque() { int t = threadIdx.x; asm volatile("" : "+v"(t)); return t; }
__device__ __forceinline__ float wave_sum(float v) {
#pragma unroll
    for (int o = 1; o < 64; o <<= 1) v += __shfl_xor(v, o);
    return v;
}
__device__ __forceinline__ float wave_max(float v) {
#pragma unroll
    for (int o = 1; o < 64; o <<= 1) v = fmaxf(v, __shfl_xor(v, o));
    return v;
}
__device__ __forceinline__ float sigmoidf_(float x) { return 1.f / (1.f + __expf(-x)); }
__device__ __forceinline__ int bucket_of(int n) {
    if (n < 16) return n;
    int b = 16;
    b += (n >= 19) + (n >= 21) + (n >= 24) + (n >= 27) + (n >= 31) + (n >= 35) + (n >= 40) + (n >= 46) + (n >= 52) + (n >= 59) +
         (n >= 67) + (n >= 77) + (n >= 87) + (n >= 99) + (n >= 113);
    return b;
}

constexpr int LDS_STRIDE = 40;
constexpr int BTR_STRIDE = 136;
template <bool A_F32, bool GATHER, bool SPLIT = false, bool BTR = true>
__device__ __forceinline__ void gemm_tile(const void* __restrict__ Aptr, int lda, const int* __restrict__ rowidx, int m0, int mrows,
                                          const float* __restrict__ B, int ldb, int n0, int split_off, int ncols, int K,
                                          unsigned char* smem, f32x4 (&acc)[2][8]) {
    bf16_t* As = (bf16_t*)smem;
    bf16_t* Bs = As + 128 * LDS_STRIDE;
    bf16_t* AsL = Bs + 128 * LDS_STRIDE;
    bf16_t* BsL = AsL + 128 * LDS_STRIDE;
    const int tid = tid_opaque(), lane = tid & 63, wave = tid >> 6;
#pragma unroll
    for (int i = 0; i < 2; ++i)
#pragma unroll
        for (int j = 0; j < 8; ++j) acc[i][j] = (f32x4){0.f, 0.f, 0.f, 0.f};
    auto lo = [](float v) { return v - bf2f((unsigned short)f2bf(v)); };

    const int ar = tid >> 2, ach = tid & 3;
    const unsigned char* arow[2];
    bool aval[2];
#pragma unroll
    for (int i = 0; i < 2; ++i) {
        int r = ar + 64 * i;
        aval[i] = r < mrows;
        long src = 0;
        if (aval[i]) src = GATHER ? (long)rowidx[m0 + r] : (long)(m0 + r);
        arow[i] = (const unsigned char*)Aptr + (size_t)src * lda * (A_F32 ? 4 : 2) + (size_t)ach * 8 * (A_F32 ? 4 : 2);
    }
    const int nq = tid & 31, kq = tid >> 5;
    const int jn = 4 * nq;
    const bool bval = jn < ncols;
    const float* bptr = B + (size_t)(4 * kq) * ldb + n0 + jn + (jn >= 64 ? split_off : 0);

    uint4 areg[2];
    float4 af0a, af0b, af1a, af1b;
    float4 breg[4];
    auto load_g = [&](int k0) {
#pragma unroll
        for (int i = 0; i < 2; ++i) {
            if (A_F32) {
                float4 t0 = make_float4(0, 0, 0, 0), t1 = t0;
                if (aval[i]) {
                    const float4* s = (const float4*)(arow[i] + (size_t)k0 * 4);
                    t0 = s[0]; t1 = s[1];
                }
                if (i == 0) { af0a = t0; af0b = t1; } else { af1a = t0; af1b = t1; }
            } else {
                if (aval[i]) areg[i] = *(const uint4*)(arow[i] + (size_t)k0 * 2);
                else areg[i] = make_uint4(0, 0, 0, 0);
            }
        }
#pragma unroll
        for (int kk = 0; kk < 4; ++kk) {
            if (bval) breg[kk] = *(const float4*)(bptr + (size_t)(k0 + kk) * ldb);
            else breg[kk] = make_float4(0, 0, 0, 0);
        }
    };
    auto store_l = [&]() {
#pragma unroll
        for (int i = 0; i < 2; ++i) {
            uint4 v;
            const float4 t0 = (i == 0) ? af0a : af1a, t1 = (i == 0) ? af0b : af1b;
            if (A_F32) {
                v.x = pk2(t0.x, t0.y); v.y = pk2(t0.z, t0.w);
                v.z = pk2(t1.x, t1.y); v.w = pk2(t1.z, t1.w);
            } else v = areg[i];
            *(uint4*)(As + (ar + 64 * i) * LDS_STRIDE + ach * 8) = v;
            if (SPLIT && A_F32) {
                v.x = pk2(lo(t0.x), lo(t0.y)); v.y = pk2(lo(t0.z), lo(t0.w));
                v.z = pk2(lo(t1.x), lo(t1.y)); v.w = pk2(lo(t1.z), lo(t1.w));
                *(uint4*)(AsL + (ar + 64 * i) * LDS_STRIDE + ach * 8) = v;
            }
        }
        if (SPLIT) {
            uint2 v;
            v.x = pk2(lo(breg[0].x), lo(breg[1].x)); v.y = pk2(lo(breg[2].x), lo(breg[3].x));
            *(uint2*)(BsL + (jn + 0) * LDS_STRIDE + 4 * kq) = v;
            v.x = pk2(lo(breg[0].y), lo(breg[1].y)); v.y = pk2(lo(breg[2].y), lo(breg[3].y));
            *(uint2*)(BsL + (jn + 1) * LDS_STRIDE + 4 * kq) = v;
            v.x = pk2(lo(breg[0].z), lo(breg[1].z)); v.y = pk2(lo(breg[2].z), lo(breg[3].z));
            *(uint2*)(BsL + (jn + 2) * LDS_STRIDE + 4 * kq) = v;
            v.x = pk2(lo(breg[0].w), lo(breg[1].w)); v.y = pk2(lo(breg[2].w), lo(breg[3].w));
            *(uint2*)(BsL + (jn + 3) * LDS_STRIDE + 4 * kq) = v;
        }
        if (BTR && !SPLIT) {
#pragma unroll
            for (int kk = 0; kk < 4; ++kk) {
                uint2 v; v.x = pk2(breg[kk].x, breg[kk].y); v.y = pk2(breg[kk].z, breg[kk].w);
                *(uint2*)(Bs + (4 * kq + kk) * BTR_STRIDE + jn) = v;
            }
        } else {
            uint2 v;
            v.x = pk2(breg[0].x, breg[1].x); v.y = pk2(breg[2].x, breg[3].x);
            *(uint2*)(Bs + (jn + 0) * LDS_STRIDE + 4 * kq) = v;
            v.x = pk2(breg[0].y, breg[1].y); v.y = pk2(breg[2].y, breg[3].y);
            *(uint2*)(Bs + (jn + 1) * LDS_STRIDE + 4 * kq) = v;
            v.x = pk2(breg[0].z, breg[1].z); v.y = pk2(breg[2].z, breg[3].z);
            *(uint2*)(Bs + (jn + 2) * LDS_STRIDE + 4 * kq) = v;
            v.x = pk2(breg[0].w, breg[1].w); v.y = pk2(breg[2].w, breg[3].w);
            *(uint2*)(Bs + (jn + 3) * LDS_STRIDE + 4 * kq) = v;
        }
    };
    const int nk = K / 32;
    __syncthreads();
    load_g(0);
    store_l();
    __syncthreads();
    const int fr = lane & 15, fq = lane >> 4;
    for (int kt = 0; kt < nk; ++kt) {
        if (kt + 1 < nk) load_g((kt + 1) * 32);
        bf16x8 a[2];
#pragma unroll
        for (int i = 0; i < 2; ++i) a[i] = *(const bf16x8*)(As + (wave * 32 + i * 16 + fr) * LDS_STRIDE + fq * 8);
        if (!SPLIT) {
            bf16x8 b[8];
#pragma unroll
            for (int j = 0; j < 8; ++j) {
                if (BTR && !SPLIT) {
                    const bf16_t* bp = Bs + (8 * fq + (fr >> 2)) * BTR_STRIDE + 16 * j + 4 * (fr & 3);
                    const s16x4 lo4 = lds_tr16(bp), hi4 = lds_tr16(bp + 4 * BTR_STRIDE);
                    b[j] = (bf16x8){lo4[0], lo4[1], lo4[2], lo4[3], hi4[0], hi4[1], hi4[2], hi4[3]};
                } else b[j] = *(const bf16x8*)(Bs + (j * 16 + fr) * LDS_STRIDE + fq * 8);
            }
#pragma unroll
            for (int i = 0; i < 2; ++i)
#pragma unroll
                for (int j = 0; j < 8; ++j) acc[i][j] = __builtin_amdgcn_mfma_f32_16x16x32_bf16(a[i], b[j], acc[i][j], 0, 0, 0);
        } else {
            bf16x8 al[2];
#pragma unroll
            for (int i = 0; i < 2; ++i) al[i] = *(const bf16x8*)(AsL + (wave * 32 + i * 16 + fr) * LDS_STRIDE + fq * 8);
#pragma unroll
            for (int j = 0; j < 8; ++j) {
                const bf16x8 bh = *(const bf16x8*)(Bs + (j * 16 + fr) * LDS_STRIDE + fq * 8);
                const bf16x8 bl = *(const bf16x8*)(BsL + (j * 16 + fr) * LDS_STRIDE + fq * 8);
#pragma unroll
                for (int i = 0; i < 2; ++i) {
                    acc[i][j] = __builtin_amdgcn_mfma_f32_16x16x32_bf16(a[i], bh, acc[i][j], 0, 0, 0);
                    acc[i][j] = __builtin_amdgcn_mfma_f32_16x16x32_bf16(a[i], bl, acc[i][j], 0, 0, 0);
                    acc[i][j] = __builtin_amdgcn_mfma_f32_16x16x32_bf16(al[i], bh, acc[i][j], 0, 0, 0);
                }
            }
        }
        __syncthreads();
        if (kt + 1 < nk) {
            store_l();
            __syncthreads();
        }
    }
}


constexpr int ASTR = 72;
constexpr int BSTR = 136;
template <bool GATHER, bool PAIR>
__device__ __forceinline__ void gemm2(const bf16_t* __restrict__ A, int lda, const int* __restrict__ rowidx, int m0, int mrows,
                                      const bf16_t* __restrict__ B, int ldb, int n0, int ncols, int K, unsigned char* smem,
                                      f32x4 (&acc)[4][4]) {
    bf16_t* As = (bf16_t*)smem;
    bf16_t* Bs = As + 128 * ASTR;
    const int tid = tid_opaque(), lane = tid & 63, wave = tid >> 6, wm = wave >> 1, wn = wave & 1;
#pragma unroll
    for (int i = 0; i < 4; ++i)
#pragma unroll
        for (int j = 0; j < 4; ++j) acc[i][j] = (f32x4){0.f, 0.f, 0.f, 0.f};
    const int ar0 = tid >> 3, ach = tid & 7;
    const bf16_t* ap0; const bf16_t* ap1; const bf16_t* ap2; const bf16_t* ap3;
    {
        int r_[4];
#pragma unroll
        for (int i = 0; i < 4; ++i) { const int rl = 32 * i + ar0; r_[i] = rl < mrows ? rl : mrows - 1; }
        ap0 = A + (size_t)(GATHER ? (long)rowidx[m0 + r_[0]] : (long)(m0 + r_[0])) * lda + ach * 8;
        ap1 = A + (size_t)(GATHER ? (long)rowidx[m0 + r_[1]] : (long)(m0 + r_[1])) * lda + ach * 8;
        ap2 = A + (size_t)(GATHER ? (long)rowidx[m0 + r_[2]] : (long)(m0 + r_[2])) * lda + ach * 8;
        ap3 = A + (size_t)(GATHER ? (long)rowidx[m0 + r_[3]] : (long)(m0 + r_[3])) * lda + ach * 8;
    }
    const int br0 = tid >> 4, bch = tid & 15;
    const int bcol = PAIR ? ((bch >> 2) * 16 + (bch & 1) * 8 + ((bch >> 1) & 1) * 1024) : bch * 8;
    const bf16_t* bp = B + (size_t)br0 * ldb + n0 + bcol;
    bf16_t* asd = As + ar0 * ASTR + ach * 8;
    bf16_t* bsd = Bs + br0 * BSTR + bch * 8;
    uint4 a0, a1, a2, a3, b0, b1, b2, b3;
#define G2_LOAD(k0)                                                                                       \
    do {                                                                                                  \
        a0 = *(const uint4*)(ap0 + (k0)); a1 = *(const uint4*)(ap1 + (k0));                               \
        a2 = *(const uint4*)(ap2 + (k0)); a3 = *(const uint4*)(ap3 + (k0));                               \
        const bf16_t* bp_ = bp + (size_t)(k0) * ldb;                                                      \
        b0 = *(const uint4*)(bp_); b1 = *(const uint4*)(bp_ + (size_t)16 * ldb);                          \
        b2 = *(const uint4*)(bp_ + (size_t)32 * ldb); b3 = *(const uint4*)(bp_ + (size_t)48 * ldb);       \
    } while (0)
#define G2_STORE()                                                                                        \
    do {                                                                                                  \
        *(uint4*)(asd) = a0; *(uint4*)(asd + 32 * ASTR) = a1; *(uint4*)(asd + 64 * ASTR) = a2; *(uint4*)(asd + 96 * ASTR) = a3; \
        *(uint4*)(bsd) = b0; *(uint4*)(bsd + 16 * BSTR) = b1; *(uint4*)(bsd + 32 * BSTR) = b2; *(uint4*)(bsd + 48 * BSTR) = b3; \
    } while (0)
    const int nk = K / 64;
    __syncthreads();
    G2_LOAD(0);
    G2_STORE();
    __syncthreads();
    const int fr = lane & 15, fq = lane >> 4;
    const bf16_t* afp = As + (wm * 64 + fr) * ASTR + fq * 8;
    const bf16_t* bfp = Bs + (8 * fq + (fr >> 2)) * BSTR + wn * 64 + 4 * (fr & 3);
    for (int kt = 0; kt < nk; ++kt) {
        if (kt + 1 < nk) G2_LOAD((kt + 1) * 64);
#pragma unroll
        for (int kh = 0; kh < 2; ++kh) {
            bf16x8 a[4], b[4];
#pragma unroll
            for (int i = 0; i < 4; ++i) a[i] = *(const bf16x8*)(afp + i * 16 * ASTR + kh * 32);
#pragma unroll
            for (int j = 0; j < 4; ++j) {
                const bf16_t* q = bfp + kh * 32 * BSTR + j * 16;
                const s16x4 lo4 = lds_tr16(q), hi4 = lds_tr16(q + 4 * BSTR);
                b[j] = (bf16x8){lo4[0], lo4[1], lo4[2], lo4[3], hi4[0], hi4[1], hi4[2], hi4[3]};
            }
#pragma unroll
            for (int i = 0; i < 4; ++i)
#pragma unroll
                for (int j = 0; j < 4; ++j) acc[i][j] = __builtin_amdgcn_mfma_f32_16x16x32_bf16(a[i], b[j], acc[i][j], 0, 0, 0);
        }
        __syncthreads();
        if (kt + 1 < nk) {
            G2_STORE();
            __syncthreads();
        }
    }
#undef G2_LOAD
#undef G2_STORE
}
#define G2_ROW(i, r) ((g2tid >> 7) * 64 + (i) * 16 + 4 * ((g2tid & 63) >> 4) + (r))
#define G2_COL(j) (((((g2tid >> 6) & 1) * 4 + (j)) * 16) + (g2tid & 15))
__device__ __forceinline__ void store_bf16_frag(bf16_t* base, int ld, float v0, float v1, float v2, float v3, int lane, unsigned rowmask = 0xFu) {
    const bool odd = lane & 1;
    const float s0 = odd ? v0 : v2, s1 = odd ? v1 : v3;
    const float r0 = __shfl_xor(s0, 1), r1 = __shfl_xor(s1, 1);
    bf16_t* p0 = odd ? base + 2 * ld - 1 : base;
    const unsigned w0 = odd ? pk2(r0, v2) : pk2(v0, r0);
    const unsigned w1 = odd ? pk2(r1, v3) : pk2(v1, r1);
    const unsigned m = odd ? (rowmask >> 2) : rowmask;
    if (m & 1u) *(unsigned*)p0 = w0;
    if (m & 2u) *(unsigned*)(p0 + ld) = w1;
}

__device__ __forceinline__ void cvt_weights(const float* __restrict__ src, bf16_t* __restrict__ dst, size_t n, int bid, int nb) {
    const size_t n8 = n >> 3;
    for (size_t i = (size_t)bid * NT + tid_opaque(); i < n8; i += (size_t)nb * NT) {
        const float4 u = ((const float4*)src)[2 * i], v = ((const float4*)src)[2 * i + 1];
        uint4 o; o.x = pk2(u.x, u.y); o.y = pk2(u.z, u.w); o.z = pk2(v.x, v.y); o.w = pk2(v.z, v.w);
        ((uint4*)dst)[i] = o;
    }
}
__device__ __forceinline__ void phase_prep(const Params& p, int bid, int nb) {
    const int lane = tid_opaque() & 63, wave = tid_opaque() >> 6;
    if (bid == 0 && tid_opaque() < 64) ((int*)(p.ws + WS_CTL))[tid_opaque()] = 0;
    {
        const float* src_ = p.in[2];
        bf16_t* dst_ = (bf16_t*)(p.ws + WB_IN);
        constexpr int G8 = DIN / 8;
        for (size_t i = (size_t)bid * NT + tid_opaque(); i < (size_t)D * G8; i += (size_t)nb * NT) {
            const int k = (int)(i / G8), nc = (int)(i % G8) * 8;
            int oc;
            if (nc < 1280) oc = nc; else if (nc < 2816) oc = nc + 24; else if (nc < 3072) oc = nc + 24; else if (nc < 5120) oc = nc + 64;
            else if (nc < 5152) oc = nc - 5120 + 3096; else if (nc < 5176) oc = nc - 5152 + 1280; else oc = nc - 5176 + 3128;
            const float4 u = *(const float4*)(src_ + (size_t)k * DIN + oc), v = *(const float4*)(src_ + (size_t)k * DIN + oc + 4);
            uint4 o; o.x = pk2(u.x, u.y); o.y = pk2(u.z, u.w); o.z = pk2(v.x, v.y); o.w = pk2(v.z, v.w);
            *(uint4*)(dst_ + (size_t)k * DIN + nc) = o;
        }
    }
    cvt_weights(p.in[14], (bf16_t*)(p.ws + WB_A), (size_t)512 * D, bid, nb);
    cvt_weights(p.in[15], (bf16_t*)(p.ws + WB_B), (size_t)512 * D, bid, nb);
    cvt_weights(p.in[16], (bf16_t*)(p.ws + WB_OUT), (size_t)D * D, bid, nb);
    cvt_weights(p.in[26], (bf16_t*)(p.ws + WB_PLE), (size_t)256 * D, bid, nb);
    cvt_weights(p.in[1], (bf16_t*)(p.ws + WS_PB), (size_t)S * 256, bid, nb);
    cvt_weights(p.in[9], (bf16_t*)(p.ws + WB_CK1), (size_t)2048 * 64, bid, nb);
    cvt_weights(p.in[12], (bf16_t*)(p.ws + WB_CV1), (size_t)2048 * 64, bid, nb);
    const float* x = p.in[0];
    const float* g = p.in[3];
    bf16_t* hb = (bf16_t*)(p.ws + WS_HB);
    for (int t = bid * 4 + wave; t < S; t += nb * 4) {
        const float4* xr = (const float4*)(x + (size_t)t * D);
        float4 v[4];
        float ss = 0.f;
#pragma unroll
        for (int j = 0; j < 4; ++j) { v[j] = xr[lane + 64 * j]; ss += v[j].x * v[j].x + v[j].y * v[j].y + v[j].z * v[j].z + v[j].w * v[j].w; }
        ss = wave_sum(ss);
        const float rstd = rsqrtf(ss * (1.f / D) + EPS);
#pragma unroll
        for (int j = 0; j < 4; ++j) {
            const float4 gg = ((const float4*)g)[lane + 64 * j];
            uint2 o;
            o.x = pk2(v[j].x * rstd * gg.x, v[j].y * rstd * gg.y);
            o.y = pk2(v[j].z * rstd * gg.z, v[j].w * rstd * gg.w);
            ((uint2*)(hb + (size_t)t * D))[lane + 64 * j] = o;
        }
    }
}

__device__ __forceinline__ void phase_inproj(const Params& p, int bid, int nb, unsigned char* smem) {
    const int g2tid = tid_opaque();
    const bf16_t* hb = (const bf16_t*)(p.ws + WS_HB);
    const int lane = tid_opaque() & 63, fr = lane & 15;
    constexpr int NTN = (DIN + 127) / 128;
    for (int w = bid; w < 128 * NTN; w += nb) {
        const int mt = w % 128, nt = w / 128;
        const int m0 = mt * 128, n0 = nt * 128;
        const int ncols = (DIN - n0) < 128 ? (DIN - n0) : 128;
        f32x4 acc[4][4];
        gemm2<false, false>(hb, D, nullptr, m0, 128, (const bf16_t*)(p.ws + WB_IN), DIN, n0, ncols, D, smem, acc);
        const int cid = __builtin_amdgcn_readfirstlane((n0 >> 6) + ((tid_opaque() >> 6) & 1));
        if (cid > 80) continue;
        int kind; bf16_t* dst; int ld; const float* gain = nullptr; float scale = 1.f;
        if (cid < 8) { kind = 0; dst = (bf16_t*)(p.ws + WS_QNB) + cid * 64; ld = 512; gain = p.in[4]; scale = 0.125f * LOG2E; }
        else if (cid < 20) {
            const int j = cid - 8, kd = j >> 1, g = j & 1;
            ld = 64; kind = (kd == 2 || kd == 4) ? 0 : 1; gain = p.in[5];
            const size_t base = kd == 0 ? WS_KCR : kd == 1 ? WS_VCR : kd == 2 ? WS_KSLB : kd == 3 ? WS_VSLB : kd == 4 ? WS_KWNB : WS_VWNB;
            dst = (bf16_t*)(p.ws + base) + (size_t)g * S * 64;
        }
        else if (cid < 28) { kind = 0; dst = (bf16_t*)(p.ws + WS_DQB) + (cid - 20) * 64; ld = 512; gain = p.in[6]; scale = 0.125f * LOG2E; }
        else if (cid < 36) { kind = 0; dst = (bf16_t*)(p.ws + WS_DKB) + (cid - 28) * 64; ld = 512; gain = p.in[7]; }
        else if (cid < 44) { kind = 1; dst = (bf16_t*)(p.ws + WS_DVB) + (cid - 36) * 64; ld = 512; }
        else if (cid < 48) { kind = 1; dst = (bf16_t*)(p.ws + WS_IQB) + (cid - 44) * 64; ld = 256; scale = 0.17677669529663687f; }
        else if (cid < 64) { kind = 2; dst = (bf16_t*)(p.ws + WS_SGA) + (cid - 48) * 64; ld = D; }
        else if (cid < 80) { kind = 2; dst = (bf16_t*)(p.ws + WS_SGB) + (cid - 64) * 64; ld = D; }
        else { kind = 3; dst = nullptr; ld = 0; }
        if (kind == 0) {
            float gv[4];
#pragma unroll
            for (int j = 0; j < 4; ++j) gv[j] = gain[j * 16 + fr] * scale;
#pragma unroll
            for (int i = 0; i < 4; ++i) {
                float rstd[4];
#pragma unroll
                for (int r = 0; r < 4; ++r) {
                    float ss = acc[i][0][r] * acc[i][0][r] + acc[i][1][r] * acc[i][1][r] + acc[i][2][r] * acc[i][2][r] + acc[i][3][r] * acc[i][3][r];
                    ss += __shfl_xor(ss, 1); ss += __shfl_xor(ss, 2); ss += __shfl_xor(ss, 4); ss += __shfl_xor(ss, 8);
                    rstd[r] = rsqrtf(ss * (1.f / 64.f) + EPS);
                }
                bf16_t* dr = dst + (size_t)(m0 + G2_ROW(i, 0)) * ld + fr;
#pragma unroll
                for (int j = 0; j < 4; ++j)
                    store_bf16_frag(dr + j * 16, ld, acc[i][j][0] * rstd[0] * gv[j], acc[i][j][1] * rstd[1] * gv[j], acc[i][j][2] * rstd[2] * gv[j],
                                    acc[i][j][3] * rstd[3] * gv[j], lane);
            }
        } else if (kind == 1 || kind == 2) {
#pragma unroll
            for (int i = 0; i < 4; ++i) {
                bf16_t* dr = dst + (size_t)(m0 + G2_ROW(i, 0)) * ld + fr;
#pragma unroll
                for (int j = 0; j < 4; ++j) {
                    float v[4];
#pragma unroll
                    for (int r = 0; r < 4; ++r) v[r] = kind == 2 ? sigmoidf_(acc[i][j][r]) : acc[i][j][r] * scale;
                    store_bf16_frag(dr + j * 16, ld, v[0], v[1], v[2], v[3], lane);
                }
            }
        } else {
            bf16_t* ikb = (bf16_t*)(p.ws + WS_IKB);
            float* gt = (float*)(p.ws + WS_GT);
            float* iws = (float*)(p.ws + WS_IWS);
#pragma unroll
            for (int i = 0; i < 4; ++i) {
                bf16_t* ir = ikb + (size_t)(m0 + G2_ROW(i, 0)) * 32 + fr;
                store_bf16_frag(ir, 32, acc[i][0][0], acc[i][0][1], acc[i][0][2], acc[i][0][3], lane);
                store_bf16_frag(ir + 16, 32, acc[i][1][0], acc[i][1][1], acc[i][1][2], acc[i][1][3], lane);
#pragma unroll
                for (int r = 0; r < 4; ++r) {
                    const size_t t = (size_t)(m0 + G2_ROW(i, r));
                    gt[t * 32 + fr] = sigmoidf_(acc[i][2][r]);
                    if (fr < 8) gt[t * 32 + 16 + fr] = sigmoidf_(acc[i][3][r]);
                    else iws[t * 8 + fr - 8] = acc[i][3][r] * 0.35355339059327373f;
                }
            }
        }
    }
}

__device__ __forceinline__ float rms64(float v) { return rsqrtf(wave_sum(v * v) * (1.f / 64.f) + EPS); }

__device__ __forceinline__ void phase_compress(const Params& p, int bid, int nb, unsigned char* smem) {
    const int g2tid = tid_opaque();
    const int tid = tid_opaque(), lane = tid & 63, wave = tid >> 6;
    float* cvec = (float*)(smem + 36864);
    float* hid = (float*)(smem + 36864 + 256);
    bf16_t* pw = (bf16_t*)(p.ws + WS_PW);
    for (int w = bid; w < 32 + 128 * 8; w += nb) {
        const bool is_c = w < 32;
        const int kind = w >> 4, g = (w >> 3) & 1;
        const int w2_ = w - 32;
        const int m0 = is_c ? (w & 7) * 128 : (w2_ % 128) * 128;
        const int n0 = is_c ? 0 : (w2_ / 128) * 128;
        const int mrows = is_c ? ((NCMP - m0) < 128 ? (NCMP - m0) : 128) : 128;
        const bf16_t* Ap = is_c ? (const bf16_t*)(p.ws + (kind ? WS_VCR : WS_KCR)) + (size_t)g * S * 64 : (const bf16_t*)(p.ws + WS_PB);
        const bf16_t* Bp = is_c ? (const bf16_t*)(p.ws + (kind ? WB_CV1 : WB_CK1)) : (const bf16_t*)(p.ws + WB_PLE);
        f32x4 acc[4][4];
        gemm2<false, false>(Ap, is_c ? 16 * 64 : 256, nullptr, m0, mrows, Bp, is_c ? 64 : D, n0, is_c ? 64 : 128, is_c ? 2048 : 256, smem, acc);
        if (!is_c) {
#pragma unroll
            for (int i = 0; i < 4; ++i) {
                bf16_t* pr = pw + (size_t)(m0 + G2_ROW(i, 0)) * D + n0 + G2_COL(0);
#pragma unroll
                for (int j = 0; j < 4; ++j) store_bf16_frag(pr + j * 16, D, acc[i][j][0], acc[i][j][1], acc[i][j][2], acc[i][j][3], lane);
            }
            continue;
        }
        const float* pe = p.in[kind ? 11 : 8];
        const float* w1 = p.in[kind ? 12 : 9];
        const float* w2 = p.in[kind ? 13 : 10];
        {
            const int e = tid & 63, part = tid >> 6;
            float s = 0.f;
            for (int k = part * 512; k < part * 512 + 512; ++k) s += pe[k] * w1[(size_t)k * 64 + e];
            __syncthreads();
            hid[tid] = s;
            __syncthreads();
            if (tid < 64) cvec[tid] = hid[tid] + hid[64 + tid] + hid[128 + tid] + hid[192 + tid];
            __syncthreads();
        }
        if ((wave & 1) == 0) {
#pragma unroll
            for (int i = 0; i < 4; ++i)
#pragma unroll
                for (int j = 0; j < 4; ++j)
#pragma unroll
                    for (int r = 0; r < 4; ++r) {
                        const int row = G2_ROW(i, r), col = j * 16 + (lane & 15);
                        const float a = acc[i][j][r] + cvec[col];
                        hid[row * 65 + col] = a * sigmoidf_(a);
                    }
        }
        __syncthreads();
        const float gkn = p.in[5][lane];
        for (int row = wave; row < mrows; row += 4) {
            float o = 0.f;
#pragma unroll 8
            for (int e = 0; e < 64; ++e) o += hid[row * 65 + e] * w2[e * 64 + lane];
            if (kind == 0) o = o * rms64(o) * gkn;
            ((bf16_t*)(p.ws + (kind ? WS_VCB : WS_KCB)))[((size_t)g * 1024 + m0 + row) * 64 + lane] = (bf16_t)f2bf(o);
        }
        __syncthreads();
    }
    if (bid == nb - 1) {
        if (tid < 128) ((bf16_t*)(p.ws + WS_KCB))[((size_t)(tid >> 6) * 1024 + 1023) * 64 + (tid & 63)] = 0;
        else ((bf16_t*)(p.ws + WS_VCB))[((size_t)((tid - 128) >> 6) * 1024 + 1023) * 64 + (tid & 63)] = 0;
    }
}

constexpr int KSTR = 72;
constexpr int NSA_KT = 0;
constexpr int NSA_VT = NSA_KT + 32 * KSTR * 2;
constexpr int NSA_WV = NSA_VT + 32 * KSTR * 2;
constexpr int NSA_IMP = NSA_WV + 4 * 2 * 32 * KSTR * 2;
constexpr int NSA_LUT = NSA_IMP + 16 * 260 * 4;
constexpr int NSA_SEL = NSA_LUT + 4 * 128 * 4;
constexpr int NSA_STP = NSA_SEL + 16 * 16 * 4;
constexpr int NSA_END = NSA_STP + 4 * 128 * 4;
static_assert(NSA_END <= SMEM_BYTES, "nsa lds");

__device__ __forceinline__ f32x4 mfma16(bf16x8 a, bf16x8 b, f32x4 c) { return __builtin_amdgcn_mfma_f32_16x16x32_bf16(a, b, c, 0, 0, 0); }
__device__ __forceinline__ bf16x8 pack_p(const f32x4& p1, const f32x4& p2) {
    const unsigned a = pk2(p1[0], p1[1]), b = pk2(p1[2], p1[3]), c = pk2(p2[0], p2[1]), d = pk2(p2[2], p2[3]);
    return __builtin_bit_cast(bf16x8, make_uint4(a, b, c, d));
}
__device__ __forceinline__ void pv_step(f32x4 (&o)[4], const bf16_t* vt, bf16x8 pb, int fq, int fr) {
    const bf16_t* base = vt + (4 * fq + (fr >> 2)) * KSTR + 4 * (fr & 3);
#pragma unroll
    for (int dt = 0; dt < 4; ++dt) {
        const s16x4 lo4 = lds_tr16(base + dt * 16), hi4 = lds_tr16(base + 16 * KSTR + dt * 16);
        const bf16x8 va = (bf16x8){lo4[0], lo4[1], lo4[2], lo4[3], hi4[0], hi4[1], hi4[2], hi4[3]};
        o[dt] = mfma16(va, pb, o[dt]);
    }
}
__device__ __forceinline__ float quad_sum(float v) {
    v += __shfl_xor(v, 1);
    v += __shfl_xor(v, 2);
    return v;
}

__device__ __forceinline__ void nsa_tile(const Params& p, int tt, int g, unsigned char* smem) {
    const int tid = tid_opaque(), lane = tid & 63, wave = tid >> 6, fr = lane & 15, fq = lane >> 4;
    bf16_t* kt = (bf16_t*)(smem + NSA_KT);
    bf16_t* vt = (bf16_t*)(smem + NSA_VT);
    bf16_t* wv = (bf16_t*)(smem + NSA_WV) + wave * 2 * 32 * KSTR;
    float* imp = (float*)(smem + NSA_IMP);
    float* lut = (float*)(smem + NSA_LUT);
    int* sel = (int*)(smem + NSA_SEL);
    const bf16_t* qnb = (const bf16_t*)(p.ws + WS_QNB);
    const bf16_t* kslb = (const bf16_t*)(p.ws + WS_KSLB) + (size_t)g * S * 64;
    const bf16_t* vslb = (const bf16_t*)(p.ws + WS_VSLB) + (size_t)g * S * 64;
    const bf16_t* kwnb = (const bf16_t*)(p.ws + WS_KWNB) + (size_t)g * S * 64;
    const bf16_t* vwnb = (const bf16_t*)(p.ws + WS_VWNB) + (size_t)g * S * 64;
    const bf16_t* kcb = (const bf16_t*)(p.ws + WS_KCB) + (size_t)g * 1024 * 64;
    const bf16_t* vcb = (const bf16_t*)(p.ws + WS_VCB) + (size_t)g * 1024 * 64;
    const float* gt = (const float*)(p.ws + WS_GT);
    const float* relb = p.in[17];
    const int t0 = tt * 16;
    const int tl = 4 * wave + (fr >> 2);
    const int tok = t0 + tl;
    const int hl = fr & 3, head = g * 4 + hl;
    __syncthreads();
    for (int i = tid; i < 512; i += NT) { const int hh = i >> 7, n = i & 127; lut[i] = relb[bucket_of(n) * 16 + g * 4 + hh] * LOG2E; }
    for (int i = tid; i < 16 * 260; i += NT) imp[i] = 0.f;
    float U2;
    {
        const float mq = wave_max(fabsf(p.in[4][lane])), mk = wave_max(fabsf(p.in[5][lane]));
        float mb = 0.f;
#pragma unroll
        for (int k = 0; k < 4; ++k) { const int e = lane + 64 * k; mb = fmaxf(mb, fabsf(relb[(e >> 3) * 16 + (e & 7)])); }
        mb = wave_max(mb);
        U2 = (8.f * mq * mk + mb) * LOG2E;
    }
    bf16x8 qf[2];
#pragma unroll
    for (int kh = 0; kh < 2; ++kh) qf[kh] = *(const bf16x8*)(qnb + (size_t)tok * 512 + head * 64 + kh * 32 + fq * 8);
    __syncthreads();
    const float* lutp = lut + hl * 128;
    const float lutfar = lutp[127];
    const f32x4 zero4 = (f32x4){0.f, 0.f, 0.f, 0.f};
    f32x4 outacc[4];
#pragma unroll
    for (int dt = 0; dt < 4; ++dt) outacc[dt] = zero4;
    const float g0 = gt[(size_t)tok * 32 + head * 3 + 0], g1 = gt[(size_t)tok * 32 + head * 3 + 1], g2 = gt[(size_t)tok * 32 + head * 3 + 2];
    const int srow = tid >> 3, sch = tid & 7;

    bf16_t* ktb = (bf16_t*)(smem + NSA_WV);
    bf16_t* vtb = ktb + 2 * 64 * KSTR;
#define NSA_QK(KT_)                                                                                         \
        f32x4 s1 = zero4, s2 = zero4;                                                                       \
        _Pragma("unroll") for (int kh = 0; kh < 2; ++kh) {                                                  \
            const bf16x8 k1 = *(const bf16x8*)((KT_) + fr * KSTR + kh * 32 + fq * 8);                       \
            const bf16x8 k2 = *(const bf16x8*)((KT_) + (16 + fr) * KSTR + kh * 32 + fq * 8);                \
            s1 = mfma16(k1, qf[kh], s1);                                                                    \
            s2 = mfma16(k2, qf[kh], s2);                                                                    \
        }
    {
        int ks0 = (t0 - 511) & ~63; ks0 = ks0 < 0 ? 0 : ks0;
        const int nsteps = (t0 + 16 - ks0 + 63) >> 6;
        f32x4 o[4];
#pragma unroll
        for (int dt = 0; dt < 4; ++dt) o[dt] = zero4;
        float lsum = 0.f;
#define WIN_ROW(r_) ((r_) < S ? (r_) : S - 1)
        uint4 kr0 = *(const uint4*)(kwnb + (size_t)WIN_ROW(ks0 + srow) * 64 + sch * 8);
        uint4 kr1 = *(const uint4*)(kwnb + (size_t)WIN_ROW(ks0 + 32 + srow) * 64 + sch * 8);
        uint4 vr0 = *(const uint4*)(vwnb + (size_t)WIN_ROW(ks0 + srow) * 64 + sch * 8);
        uint4 vr1 = *(const uint4*)(vwnb + (size_t)WIN_ROW(ks0 + 32 + srow) * 64 + sch * 8);
#pragma unroll 1
        for (int st = 0; st < nsteps; ++st) {
            const int ksb = ks0 + st * 64;
            bf16_t* kt_ = ktb + (st & 1) * 64 * KSTR;
            bf16_t* vt_ = vtb + (st & 1) * 64 * KSTR;
            *(uint4*)(kt_ + srow * KSTR + sch * 8) = kr0; *(uint4*)(kt_ + (32 + srow) * KSTR + sch * 8) = kr1;
            *(uint4*)(vt_ + srow * KSTR + sch * 8) = vr0; *(uint4*)(vt_ + (32 + srow) * KSTR + sch * 8) = vr1;
            __syncthreads();
            if (st + 1 < nsteps) {
                kr0 = *(const uint4*)(kwnb + (size_t)WIN_ROW(ksb + 64 + srow) * 64 + sch * 8);
                kr1 = *(const uint4*)(kwnb + (size_t)WIN_ROW(ksb + 96 + srow) * 64 + sch * 8);
                vr0 = *(const uint4*)(vwnb + (size_t)WIN_ROW(ksb + 64 + srow) * 64 + sch * 8);
                vr1 = *(const uint4*)(vwnb + (size_t)WIN_ROW(ksb + 96 + srow) * 64 + sch * 8);
            }
#pragma unroll
            for (int hf = 0; hf < 2; ++hf) {
                const int ks = ksb + 32 * hf;
                if (ks > t0 + 15) continue;
                NSA_QK(kt_ + hf * 32 * KSTR)
                const bool far = (t0 + 4 * wave) - (ks + 31) >= 113;
                f32x4 p1, p2;
#pragma unroll
                for (int r = 0; r < 4; ++r) {
                    const int d1 = tok - (ks + 4 * fq + r), d2 = d1 - 16;
                    const float b1 = far ? lutfar : lutp[d1 < 0 ? 0 : (d1 > 127 ? 127 : d1)];
                    const float b2 = far ? lutfar : lutp[d2 < 0 ? 0 : (d2 > 127 ? 127 : d2)];
                    p1[r] = (d1 >= 0 && d1 < 512) ? __builtin_amdgcn_exp2f(s1[r] + b1 - U2) : 0.f;
                    p2[r] = (d2 >= 0 && d2 < 512) ? __builtin_amdgcn_exp2f(s2[r] + b2 - U2) : 0.f;
                    lsum += p1[r] + p2[r];
                }
                pv_step(o, vt_ + hf * 32 * KSTR, pack_p(p1, p2), fq, fr);
            }
        }
#undef WIN_ROW
        lsum += __shfl_xor(lsum, 16);
        lsum += __shfl_xor(lsum, 32);
        const float sc = lsum > 0.f ? g2 / lsum : 0.f;
#pragma unroll
        for (int dt = 0; dt < 4; ++dt)
#pragma unroll
            for (int r = 0; r < 4; ++r) outacc[dt][r] += sc * o[dt][r];
    }
    __syncthreads();

    {
        const int tlast = t0 + 15;
        const int cmax = (tlast >= 31) ? ((tlast - 31) >> 4) + 1 : 0;
        const int nsteps = (cmax + 63) >> 6;
        float inv_l = 0.f;
#pragma unroll 1
        for (int pass = 0; pass < 2; ++pass) {
            f32x4 o[4];
#pragma unroll
            for (int dt = 0; dt < 4; ++dt) o[dt] = zero4;
            float lsum = 0.f;
            uint4 kr0 = make_uint4(0, 0, 0, 0), kr1 = kr0, vr0 = kr0, vr1 = kr0;
            if (nsteps > 0) {
                kr0 = *(const uint4*)(kcb + (size_t)srow * 64 + sch * 8); kr1 = *(const uint4*)(kcb + (size_t)(32 + srow) * 64 + sch * 8);
                vr0 = *(const uint4*)(vcb + (size_t)srow * 64 + sch * 8); vr1 = *(const uint4*)(vcb + (size_t)(32 + srow) * 64 + sch * 8);
            }
#pragma unroll 1
            for (int st = 0; st < nsteps; ++st) {
                const int csb = st * 64;
                bf16_t* kt_ = ktb + (st & 1) * 64 * KSTR;
                bf16_t* vt_ = vtb + (st & 1) * 64 * KSTR;
                *(uint4*)(kt_ + srow * KSTR + sch * 8) = kr0; *(uint4*)(kt_ + (32 + srow) * KSTR + sch * 8) = kr1;
                *(uint4*)(vt_ + srow * KSTR + sch * 8) = vr0; *(uint4*)(vt_ + (32 + srow) * KSTR + sch * 8) = vr1;
                __syncthreads();
                if (st + 1 < nsteps) {
                    kr0 = *(const uint4*)(kcb + (size_t)(csb + 64 + srow) * 64 + sch * 8); kr1 = *(const uint4*)(kcb + (size_t)(csb + 96 + srow) * 64 + sch * 8);
                    vr0 = *(const uint4*)(vcb + (size_t)(csb + 64 + srow) * 64 + sch * 8); vr1 = *(const uint4*)(vcb + (size_t)(csb + 96 + srow) * 64 + sch * 8);
                }
#pragma unroll
                for (int hf = 0; hf < 2; ++hf) {
                    const int cs = csb + 32 * hf;
                    if (cs >= cmax) continue;
                    NSA_QK(kt_ + hf * 32 * KSTR)
                    const bool far = (t0 + 4 * wave) - (16 * (cs + 31) + 31) >= 113;
                    f32x4 p1, p2;
#pragma unroll
                    for (int r = 0; r < 4; ++r) {
                        const int d1 = tok - (16 * (cs + 4 * fq + r) + 31), d2 = d1 - 256;
                        const float b1 = far ? lutfar : lutp[d1 < 0 ? 0 : (d1 > 127 ? 127 : d1)];
                        const float b2 = far ? lutfar : lutp[d2 < 0 ? 0 : (d2 > 127 ? 127 : d2)];
                        p1[r] = (d1 >= 0) ? __builtin_amdgcn_exp2f(s1[r] + b1 - U2) : 0.f;
                        p2[r] = (d2 >= 0) ? __builtin_amdgcn_exp2f(s2[r] + b2 - U2) : 0.f;
                        lsum += p1[r] + p2[r];
                    }
                    if (pass == 1) {
#pragma unroll
                        for (int r = 0; r < 4; ++r) { p1[r] *= inv_l; p2[r] *= inv_l; }
                        f32x4 h1, h2;
#pragma unroll
                        for (int r = 0; r < 4; ++r) { h1[r] = quad_sum(p1[r]); h2[r] = quad_sum(p2[r]); }
                        if (hl == 0) {
                            float* ir = imp + tl * 260 + (cs >> 2) + fq;
                            atomicAdd(ir, h1[0] + h1[1] + h1[2] + 0.5f * h1[3]);
                            atomicAdd(ir + 1, 0.5f * h1[3]);
                            atomicAdd(ir + 4, h2[0] + h2[1] + h2[2] + 0.5f * h2[3]);
                            atomicAdd(ir + 5, 0.5f * h2[3]);
                        }
                        pv_step(o, vt_ + hf * 32 * KSTR, pack_p(p1, p2), fq, fr);
                    }
                }
            }
            __syncthreads();
            if (pass == 0) {
                lsum += __shfl_xor(lsum, 16);
                lsum += __shfl_xor(lsum, 32);
                inv_l = lsum > 0.f ? 1.f / lsum : 0.f;
            } else {
#pragma unroll
                for (int dt = 0; dt < 4; ++dt)
#pragma unroll
                    for (int r = 0; r < 4; ++r) outacc[dt][r] += g0 * o[dt][r];
            }
        }
    }
#undef NSA_QK
    __syncthreads();

#pragma unroll 1
    for (int tq = 0; tq < 4; ++tq) {
        const int tli = 4 * wave + tq, tk = t0 + tli, cur = tk >> 6;
        int* sl = sel + tli * 16;
        int nf = 0;
        if (lane == 0) {
            sl[0] = 0; int c_ = 1;
            if (cur - 1 >= 1) sl[c_++] = cur - 1;
            if (cur >= 1) sl[c_++] = cur;
            for (int k = c_; k < 16; ++k) sl[k] = -1;
        }
        nf = 1 + (cur - 1 >= 1 ? 1 : 0) + (cur >= 1 ? 1 : 0);
        const int ncand = cur - 2 > 0 ? cur - 2 : 0;
        int need = 16 - nf; need = need < ncand ? need : ncand;
        unsigned long long key[4];
#pragma unroll
        for (int k = 0; k < 4; ++k) {
            const int n = lane + 64 * k;
            const bool c = (n >= 1) && (n <= cur - 2);
            key[k] = c ? (((unsigned long long)__builtin_bit_cast(unsigned, imp[tli * 260 + n]) << 32) | (unsigned long long)(0xFFFFFFFFu - (unsigned)n)) + (1ull << 32) : 0ull;
        }
#pragma unroll 1
        for (int rd = 0; rd < need; ++rd) {
            unsigned long long m = key[0];
            m = key[1] > m ? key[1] : m; m = key[2] > m ? key[2] : m; m = key[3] > m ? key[3] : m;
#pragma unroll
            for (int o_ = 1; o_ < 64; o_ <<= 1) {
                const unsigned lo_ = __shfl_xor((unsigned)m, o_), hi_ = __shfl_xor((unsigned)(m >> 32), o_);
                const unsigned long long other = ((unsigned long long)hi_ << 32) | lo_;
                m = other > m ? other : m;
            }
            const int nstar = (int)(0xFFFFFFFFu - (unsigned)m);
#pragma unroll
            for (int k = 0; k < 4; ++k) if (key[k] == m) key[k] = 0ull;
            if (lane == 0) sl[nf + rd] = nstar;
        }
    }
    __syncthreads();

    {
        int* stp = (int*)(smem + NSA_STP) + wave * 128;
        int nst;
        {
            const int tq = lane >> 4, j = lane & 15;
            const int cur_ = (t0 + 4 * wave) >> 6;
            const int nf_ = 1 + (cur_ - 1 >= 1 ? 1 : 0) + (cur_ >= 1 ? 1 : 0);
            const bool shared = j < nf_;
            const int tk_ = shared ? t0 + 4 * wave + 3 : t0 + 4 * wave + tq;
            const int b = (shared && tq != 0) ? -1 : sel[(4 * wave + tq) * 16 + j];
            const int tqc = shared ? 4 : tq;
            const bool c1 = (b >= 0) && (b * 64 <= tk_), c2 = (b >= 0) && (b * 64 + 32 <= tk_);
            const unsigned long long m1 = __ballot(c1), m2 = __ballot(c2);
            const unsigned long long lt = (1ull << lane) - 1ull;
            const int pos = __builtin_popcountll(m1 & lt) + __builtin_popcountll(m2 & lt);
            if (c1) stp[pos] = (b * 64) | (tqc << 20);
            if (c2) stp[pos + 1] = (b * 64 + 32) | (tqc << 20);
            nst = __builtin_popcountll(m1) + __builtin_popcountll(m2);
        }
        asm volatile("" ::: "memory");
        uint2 oacc_pk[4];
#pragma unroll
        for (int dt = 0; dt < 4; ++dt) { oacc_pk[dt].x = pk2(outacc[dt][0], outacc[dt][1]); oacc_pk[dt].y = pk2(outacc[dt][2], outacc[dt][3]); }
        f32x4 o[4];
#pragma unroll
        for (int dt = 0; dt < 4; ++dt) o[dt] = zero4;
        float lsum = 0.f;
        const int r8 = lane >> 3, c8 = lane & 7;
        bf16_t* slot0 = wv;
        bf16_t* slot1 = wv + 32 * KSTR;
        bf16_t* kslot = (bf16_t*)(smem + NSA_IMP) + wave * 32 * 64;
        uint4 ka0, ka1, ka2, ka3, kb0, kb1, kb2, kb3;
        uint4 va0, va1, va2, va3;
#define SLC_STEP(i_) __builtin_amdgcn_readfirstlane(stp[(i_) < nst ? (i_) : nst - 1])
#define SLC_KLOAD(K_, w_)                                                                                           \
        { const uint4* kp_ = (const uint4*)(kslb + (size_t)(((w_) & 0xFFFFF) + r8) * 64 + c8 * 8);                      \
          K_##0 = kp_[0]; K_##1 = kp_[64]; K_##2 = kp_[128]; K_##3 = kp_[192]; }
#define SLC_VLOAD(V_, w_)                                                                                           \
        { const uint4* vs_ = (const uint4*)(vslb + (size_t)(((w_) & 0xFFFFF) + r8) * 64 + c8 * 8);                      \
          V_##0 = vs_[0]; V_##1 = vs_[64]; V_##2 = vs_[128]; V_##3 = vs_[192]; }
#define SLC_VSTORE(V_, slot_)                                                                                       \
        { bf16_t* vd_ = (slot_) + r8 * KSTR + c8 * 8;                                                               \
          *(uint4*)(vd_) = V_##0; *(uint4*)(vd_ + 8 * KSTR) = V_##1; *(uint4*)(vd_ + 16 * KSTR) = V_##2; *(uint4*)(vd_ + 24 * KSTR) = V_##3; }
#define SLC_KSTORE(K_)                                                                                              \
        { bf16_t* kd_ = kslot + r8 * 64 + ((c8 ^ r8) * 8);                                                          \
          *(uint4*)(kd_) = K_##0; *(uint4*)(kd_ + 8 * 64) = K_##1; *(uint4*)(kd_ + 16 * 64) = K_##2; *(uint4*)(kd_ + 24 * 64) = K_##3; }
#define SLC_STAGE(s_, K_, VW_, slotr_, slotw_)                                                                      \
        {                                                                                                           \
            const int wcur = SLC_STEP(s_), wk = SLC_STEP((s_) + 2);                                                 \
            SLC_KSTORE(K_)                                                            \
            SLC_VSTORE(VW_, slotw_)                                                      \
            asm volatile("" ::: "memory");                                                                          \
            SLC_VLOAD(VW_, wk)                                                                     \
            SLC_KLOAD(K_, wk)                                                                      \
            f32x4 s1 = zero4, s2 = zero4;                                                                           \
            _Pragma("unroll") for (int kh = 0; kh < 2; ++kh) {                                                      \
                const bf16x8 k1 = *(const bf16x8*)(kslot + fr * 64 + (((kh * 4 + fq) ^ (fr & 7)) * 8));             \
                const bf16x8 k2 = *(const bf16x8*)(kslot + (16 + fr) * 64 + (((kh * 4 + fq) ^ (fr & 7)) * 8));      \
                s1 = mfma16(k1, qf[kh], s1); s2 = mfma16(k2, qf[kh], s2);                                           \
            }                                                                                                       \
            const int ks = wcur & 0xFFFFF, tq = wcur >> 20;                                                         \
            const bool mine = (tq == 4) || ((fr >> 2) == tq);                                                       \
            const bool far = (t0 + 4 * wave + (tq == 4 ? 0 : tq)) - (ks + 31) >= 113;                               \
            f32x4 p1, p2;                                                                                           \
            _Pragma("unroll") for (int r = 0; r < 4; ++r) {                                                         \
                const int d1 = tok - (ks + 4 * fq + r), d2 = d1 - 16;                                               \
                const float b1 = far ? lutfar : lutp[d1 < 0 ? 0 : (d1 > 127 ? 127 : d1)];                           \
                const float b2 = far ? lutfar : lutp[d2 < 0 ? 0 : (d2 > 127 ? 127 : d2)];                           \
                p1[r] = (mine && d1 >= 0) ? __builtin_amdgcn_exp2f(s1[r] + b1 - U2) : 0.f;                          \
                p2[r] = (mine && d2 >= 0) ? __builtin_amdgcn_exp2f(s2[r] + b2 - U2) : 0.f;                          \
                lsum += p1[r] + p2[r];                                                                              \
            }                                                                                                       \
            asm volatile("" ::: "memory");                                                                          \
            pv_step(o, slotr_, pack_p(p1, p2), fq, fr);                                                             \
            asm volatile("" ::: "memory");                                                                          \
        }
        {
            const int w0 = SLC_STEP(0), w1 = SLC_STEP(1);
            SLC_VLOAD(va, w0)
            SLC_KLOAD(ka, w0)
            SLC_KLOAD(kb, w1)
            SLC_VSTORE(va, slot0)
            SLC_VLOAD(va, w1)
        }
#pragma unroll 1
        for (int s = 0; s < nst; s += 2) {
            SLC_STAGE(s, ka, va, slot0, slot1)
            if (s + 1 < nst) SLC_STAGE(s + 1, kb, va, slot1, slot0)
        }
#undef SLC_STEP
#undef SLC_KLOAD
#undef SLC_VLOAD
#undef SLC_VSTORE
#undef SLC_KSTORE
#undef SLC_STAGE
        lsum += __shfl_xor(lsum, 16);
        lsum += __shfl_xor(lsum, 32);
        const float sc = lsum > 0.f ? g1 / lsum : 0.f;
#pragma unroll
        for (int dt = 0; dt < 4; ++dt) {
            outacc[dt][0] = __builtin_bit_cast(float, oacc_pk[dt].x << 16) + sc * o[dt][0];
            outacc[dt][1] = __builtin_bit_cast(float, oacc_pk[dt].x & 0xffff0000u) + sc * o[dt][1];
            outacc[dt][2] = __builtin_bit_cast(float, oacc_pk[dt].y << 16) + sc * o[dt][2];
            outacc[dt][3] = __builtin_bit_cast(float, oacc_pk[dt].y & 0xffff0000u) + sc * o[dt][3];
        }
    }
    bf16_t* orow = (bf16_t*)(p.ws + WS_OA) + (size_t)tok * 512 + head * 64 + 4 * fq;
#pragma unroll
    for (int dt = 0; dt < 4; ++dt) {
        uint2 v; v.x = pk2(outacc[dt][0], outacc[dt][1]); v.y = pk2(outacc[dt][2], outacc[dt][3]);
        *(uint2*)(orow + dt * 16) = v;
    }
}

typedef float f32x16 __attribute__((ext_vector_type(16)));
constexpr int DSA_CK = 0;
constexpr int DSA_CI = DSA_CK + 16 * 512 * 4;
constexpr int DSA_LUT = DSA_CI + 16 * 512 * 2;
constexpr int DSA_END = DSA_LUT + 8 * 128 * 4;
static_assert(DSA_END <= SMEM_BYTES, "dsa lds");

__device__ __forceinline__ unsigned mono_key(float s) {
    const unsigned u = __builtin_bit_cast(unsigned, s + 0.0f);
    return (u & 0x80000000u) ? ~u : (u | 0x80000000u);
}
__device__ __forceinline__ unsigned dsa_compact(unsigned* ck, unsigned short* ci, int n, int lane) {
    unsigned kk[8]; unsigned ii[8];
#pragma unroll
    for (int k = 0; k < 8; ++k) { const int e = lane + 64 * k; kk[k] = e < n ? ck[e] : 0u; ii[k] = e < n ? (unsigned)ci[e] : 0xFFFFu; }
    unsigned T = 0;
#pragma unroll 1
    for (int b = 31; b >= 0; --b) {
        const unsigned cand = T | (1u << b);
        int c = 0;
#pragma unroll
        for (int k = 0; k < 8; ++k) c += __builtin_popcountll(__ballot(kk[k] >= cand));
        if (c >= 256) T = cand;
    }
    int cgt = 0, ceq = 0;
#pragma unroll
    for (int k = 0; k < 8; ++k) { cgt += __builtin_popcountll(__ballot(kk[k] > T)); ceq += __builtin_popcountll(__ballot(kk[k] == T)); }
    const int need = 256 - cgt;
    unsigned X = 0xFFFFu;
    if (ceq > need) {
        X = 0;
#pragma unroll 1
        for (int b = 15; b >= 0; --b) {
            const unsigned cand = X | (1u << b);
            int c = 0;
#pragma unroll
            for (int k = 0; k < 8; ++k) c += __builtin_popcountll(__ballot(kk[k] == T && ii[k] < cand));
            if (c < need) X = cand;
        }
    }
    int base = 0;
    const unsigned long long lt = (1ull << lane) - 1ull;
#pragma unroll
    for (int k = 0; k < 8; ++k) {
        const bool keep = (kk[k] > T) || (kk[k] == T && ii[k] <= X);
        const unsigned long long m = __ballot(keep);
        if (keep) { const int pos = base + __builtin_popcountll(m & lt); ck[pos] = kk[k]; ci[pos] = (unsigned short)ii[k]; }
        base += __builtin_popcountll(m);
    }
    return T;
}

__device__ __forceinline__ void dsa_tile(const Params& p, int tt, unsigned char* smem) {
    const int tid = tid_opaque(), lane = tid & 63, wave = tid >> 6, col = lane & 31, hi = lane >> 5;
    unsigned* ckb = (unsigned*)(smem + DSA_CK);
    unsigned short* cib = (unsigned short*)(smem + DSA_CI);
    const bf16_t* iqb = (const bf16_t*)(p.ws + WS_IQB);
    const bf16_t* ikb = (const bf16_t*)(p.ws + WS_IKB);
    const float* iws = (const float*)(p.ws + WS_IWS);
    const int t0 = tt * 16;
    __syncthreads();
    const int tw = t0 + 4 * wave;
    bf16x8 af[2];
    {
        const int rho = col;
        const int tl_ = 2 * ((rho >> 2) & 1) + (rho >> 4), hd = 4 * ((rho >> 3) & 1) + (rho & 3);
#pragma unroll
        for (int ks = 0; ks < 2; ++ks) af[ks] = *(const bf16x8*)(iqb + (size_t)(tw + tl_) * 256 + hd * 32 + ks * 16 + hi * 8);
    }
    const int tokA = tw + 2 * hi, tokB = tokA + 1;
    float wA[8], wB[8];
#pragma unroll
    for (int h = 0; h < 8; ++h) { wA[h] = iws[(size_t)tokA * 8 + h]; wB[h] = iws[(size_t)tokB * 8 + h]; }
    unsigned* ckA = ckb + (4 * wave + 2 * hi) * 512;
    unsigned* ckB = ckA + 512;
    unsigned short* ciA = cib + (4 * wave + 2 * hi) * 512;
    unsigned short* ciB = ciA + 512;
    int cntA = 0, cntB = 0;
    unsigned LA = 0, LB = 0;
    const unsigned ltm = (1u << col) - 1u;
    const int nchunk = (tw + 4 + 31) >> 5;
    const f32x16 zero16 = {0.f, 0.f, 0.f, 0.f, 0.f, 0.f, 0.f, 0.f, 0.f, 0.f, 0.f, 0.f, 0.f, 0.f, 0.f, 0.f};
    bf16x8 nx0[4], nx1[4];
    const bf16_t* ikl = ikb + (size_t)col * 32 + hi * 8;
#pragma unroll
    for (int j = 0; j < 4; ++j) {
        const int cj = j < nchunk ? j : nchunk - 1;
        nx0[j] = *(const bf16x8*)(ikl + (size_t)cj * 1024); nx1[j] = *(const bf16x8*)(ikl + (size_t)cj * 1024 + 16);
    }
#pragma unroll 1
    for (int ch4 = 0; ch4 < nchunk; ch4 += 4) {
#pragma unroll
        for (int j = 0; j < 4; ++j) {
            const int ch = ch4 + j;
            const bf16x8 cu0 = nx0[j], cu1 = nx1[j];
            {
                int cj = ch + 4; cj = cj < nchunk ? cj : nchunk - 1;
                nx0[j] = *(const bf16x8*)(ikl + (size_t)cj * 1024); nx1[j] = *(const bf16x8*)(ikl + (size_t)cj * 1024 + 16);
            }
            if (ch < nchunk) {
                const int kidx = ch * 32 + col;
                f32x16 c = __builtin_amdgcn_mfma_f32_32x32x16_bf16(af[0], cu0, zero16, 0, 0, 0);
                c = __builtin_amdgcn_mfma_f32_32x32x16_bf16(af[1], cu1, c, 0, 0, 0);
                float sA = 0.f, sB = 0.f;
#pragma unroll
                for (int h = 0; h < 8; ++h) { sA += wA[h] * fmaxf(c[h], 0.f); sB += wB[h] * fmaxf(c[8 + h], 0.f); }
                const unsigned keyA = mono_key(sA), keyB = mono_key(sB);
                const bool pA = (kidx <= tokA) && (keyA > LA), pB = (kidx <= tokB) && (keyB > LB);
                const unsigned long long mA = __ballot(pA), mB = __ballot(pB);
                const unsigned hA = hi ? (unsigned)(mA >> 32) : (unsigned)mA, hB = hi ? (unsigned)(mB >> 32) : (unsigned)mB;
                if (pA) { const int pos = cntA + __builtin_popcount(hA & ltm); ckA[pos] = keyA; ciA[pos] = (unsigned short)kidx; }
                if (pB) { const int pos = cntB + __builtin_popcount(hB & ltm); ckB[pos] = keyB; ciB[pos] = (unsigned short)kidx; }
                cntA += __builtin_popcount(hA); cntB += __builtin_popcount(hB);
            }
        }
        if (__any((cntA > 384) || (cntB > 384))) {
#pragma unroll
            for (int tq = 0; tq < 4; ++tq) {
                const int cn = __shfl((tq & 1) ? cntB : cntA, (tq >> 1) * 32);
                if (cn > 384) {
                    const unsigned T = dsa_compact(ckb + (4 * wave + tq) * 512, cib + (4 * wave + tq) * 512, cn, lane);
                    if (hi == (tq >> 1)) { if (tq & 1) { cntB = 256; LB = T; } else { cntA = 256; LA = T; } }
                }
            }
        }
    }
#pragma unroll
    for (int tq = 0; tq < 4; ++tq) {
        const int cn = __shfl((tq & 1) ? cntB : cntA, (tq >> 1) * 32);
        if (cn > 256) {
            (void)dsa_compact(ckb + (4 * wave + tq) * 512, cib + (4 * wave + tq) * 512, cn, lane);
            if (hi == (tq >> 1)) { if (tq & 1) cntB = 256; else cntA = 256; }
        }
    }
    unsigned short* selg = (unsigned short*)(p.ws + WS_SEL);
    int* nselg = (int*)(p.ws + WS_NSEL);
#pragma unroll
    for (int tq = 0; tq < 4; ++tq) {
        int nsel = __shfl((tq & 1) ? cntB : cntA, (tq >> 1) * 32);
        nsel = nsel > 256 ? 256 : nsel;
        const unsigned short* sl = cib + (4 * wave + tq) * 512;
#pragma unroll
        for (int k = 0; k < 4; ++k) { const int e = lane + 64 * k; selg[(size_t)(tw + tq) * 256 + e] = e < nsel ? sl[e] : (unsigned short)0; }
        if (lane == 0) nselg[tw + tq] = nsel;
    }
}

__device__ __forceinline__ void phase_dsa_attn(const Params& p, int bid, int nb, unsigned char* smem) {
    const int tid = tid_opaque(), lane = tid & 63, wave = tid >> 6, slot = lane >> 3, chunk = lane & 7;
    float* lut = (float*)smem;
    const bf16_t* dqb = (const bf16_t*)(p.ws + WS_DQB);
    const bf16_t* dkb = (const bf16_t*)(p.ws + WS_DKB);
    const bf16_t* dvb = (const bf16_t*)(p.ws + WS_DVB);
    const unsigned short* selg = (const unsigned short*)(p.ws + WS_SEL);
    const int* nselg = (const int*)(p.ws + WS_NSEL);
    const float* relb = p.in[17];
    const int h = bid & 7, bh = bid >> 3, nbh = nb >> 3;
    __syncthreads();
    if (tid < 128) lut[tid] = relb[bucket_of(tid) * 16 + 8 + h] * LOG2E;
    float U2;
    {
        const float mq = wave_max(fabsf(p.in[6][lane])), mk = wave_max(fabsf(p.in[7][lane]));
        float mb = 0.f;
#pragma unroll
        for (int k = 0; k < 4; ++k) { const int e = lane + 64 * k; mb = fmaxf(mb, fabsf(relb[(e >> 3) * 16 + 8 + (e & 7)])); }
        mb = wave_max(mb);
        U2 = (8.f * mq * mk + mb) * LOG2E;
    }
    __syncthreads();
    const bf16_t* kbase = dkb + h * 64 + chunk * 8;
    const bf16_t* vbase = dvb + h * 64 + chunk * 8;
#pragma unroll 1
    for (int t = bh * 4 + wave; t < S; t += nbh * 4) {
        const int nsel = nselg[t];
        const uint2* ip = (const uint2*)(selg + (size_t)t * 256 + slot * 32);
        float q[8];
        {
            const uint4 qv = *(const uint4*)(dqb + (size_t)t * 512 + h * 64 + chunk * 8);
            q[0] = __builtin_bit_cast(float, qv.x << 16); q[1] = __builtin_bit_cast(float, qv.x & 0xffff0000u);
            q[2] = __builtin_bit_cast(float, qv.y << 16); q[3] = __builtin_bit_cast(float, qv.y & 0xffff0000u);
            q[4] = __builtin_bit_cast(float, qv.z << 16); q[5] = __builtin_bit_cast(float, qv.z & 0xffff0000u);
            q[6] = __builtin_bit_cast(float, qv.w << 16); q[7] = __builtin_bit_cast(float, qv.w & 0xffff0000u);
        }
        float o[8];
#pragma unroll
        for (int j = 0; j < 8; ++j) o[j] = 0.f;
        float lsum = 0.f;
        int sA_[4], sB_[4];
        uint4 kA_[4], vA_[4], kB_[4], vB_[4];
        uint2 idn = ip[0];
#define DSA_LOADG(S_, K_, V_, I_)                                                        \
        S_[0] = (int)((I_).x & 0xffffu); S_[1] = (int)((I_).x >> 16); S_[2] = (int)((I_).y & 0xffffu); S_[3] = (int)((I_).y >> 16); \
        _Pragma("unroll") for (int j = 0; j < 4; ++j) {                                 \
            K_[j] = *(const uint4*)(kbase + (size_t)S_[j] * 512);                        \
            V_[j] = *(const uint4*)(vbase + (size_t)S_[j] * 512);                        \
        }
#define DSA_COMPG(S_, K_, V_, gi)                                                        \
        _Pragma("unroll") for (int j = 0; j < 4; ++j) {                                 \
            const uint4 kv = K_[j], vv = V_[j];                                          \
            float d = q[0] * __builtin_bit_cast(float, kv.x << 16) + q[1] * __builtin_bit_cast(float, kv.x & 0xffff0000u) \
                    + q[2] * __builtin_bit_cast(float, kv.y << 16) + q[3] * __builtin_bit_cast(float, kv.y & 0xffff0000u) \
                    + q[4] * __builtin_bit_cast(float, kv.z << 16) + q[5] * __builtin_bit_cast(float, kv.z & 0xffff0000u) \
                    + q[6] * __builtin_bit_cast(float, kv.w << 16) + q[7] * __builtin_bit_cast(float, kv.w & 0xffff0000u); \
            d += __shfl_xor(d, 1); d += __shfl_xor(d, 2); d += __shfl_xor(d, 4);       \
            int dist = t - S_[j]; dist = dist > 127 ? 127 : (dist < 0 ? 0 : dist);       \
            float pr = __builtin_amdgcn_exp2f(d + lut[dist] - U2);                       \
            pr = (slot * 32 + (gi) * 4 + j < nsel) ? pr : 0.f;                           \
            lsum += pr;                                                                  \
            o[0] += pr * __builtin_bit_cast(float, vv.x << 16); o[1] += pr * __builtin_bit_cast(float, vv.x & 0xffff0000u); \
            o[2] += pr * __builtin_bit_cast(float, vv.y << 16); o[3] += pr * __builtin_bit_cast(float, vv.y & 0xffff0000u); \
            o[4] += pr * __builtin_bit_cast(float, vv.z << 16); o[5] += pr * __builtin_bit_cast(float, vv.z & 0xffff0000u); \
            o[6] += pr * __builtin_bit_cast(float, vv.w << 16); o[7] += pr * __builtin_bit_cast(float, vv.w & 0xffff0000u); \
        }
        DSA_LOADG(sA_, kA_, vA_, idn)
        idn = ip[1];
#pragma unroll 1
        for (int gi = 0; gi < 8; gi += 2) {
            DSA_LOADG(sB_, kB_, vB_, idn)
            idn = ip[gi + 2 < 8 ? gi + 2 : 7];
            DSA_COMPG(sA_, kA_, vA_, gi)
            DSA_LOADG(sA_, kA_, vA_, idn)
            idn = ip[gi + 3 < 8 ? gi + 3 : 7];
            DSA_COMPG(sB_, kB_, vB_, gi + 1)
        }
#undef DSA_LOADG
#undef DSA_COMPG
#pragma unroll
        for (int j = 0; j < 8; ++j) { o[j] += __shfl_xor(o[j], 8); o[j] += __shfl_xor(o[j], 16); o[j] += __shfl_xor(o[j], 32); }
        lsum += __shfl_xor(lsum, 8); lsum += __shfl_xor(lsum, 16); lsum += __shfl_xor(lsum, 32);
        if (slot == 0) {
            const float inv = lsum > 0.f ? 1.f / lsum : 0.f;
            uint4 ov;
            ov.x = pk2(o[0] * inv, o[1] * inv); ov.y = pk2(o[2] * inv, o[3] * inv); ov.z = pk2(o[4] * inv, o[5] * inv); ov.w = pk2(o[6] * inv, o[7] * inv);
            *(uint4*)((bf16_t*)(p.ws + WS_OB) + (size_t)t * 512 + h * 64 + chunk * 8) = ov;
        }
    }
}

__device__ __forceinline__ void convert_late_weights(const Params& p, int bid, int nb) {
    cvt_weights(p.in[21], (bf16_t*)(p.ws + WB_E1), (size_t)NEXP * D * 2 * DFF, bid, nb);
    cvt_weights(p.in[23], (bf16_t*)(p.ws + WB_E2), (size_t)NEXP * DFF * D, bid, nb);
    cvt_weights(p.in[27], (bf16_t*)(p.ws + WB_PLEG), (size_t)D * D, bid, nb);
}
__device__ __forceinline__ void phase_attn(const Params& p, int bid, int nb, unsigned char* smem) {
    const bool conv_first = bid < (nb >> 1);
    if (conv_first) convert_late_weights(p, bid, nb);
#pragma unroll 1
    for (int part = 0; part < 2; ++part) {
        if ((part == 0) == conv_first) {
#pragma unroll 1
        for (int w = bid, rd = 0; w < 1024; w += nb, ++rd) {
            const int r0 = w - bid;
            const int cnt = (1024 - r0) < nb ? (1024 - r0) : nb;
            const int k = (rd & 1) ? (cnt - 1 - bid) : bid;
            dsa_tile(p, 1023 - (r0 + k), smem);
        }
    }
        else {
#pragma unroll 1
        for (int i = bid, rd = 0; i < 2048; i += nb, ++rd) {
            const int r0 = i - bid;
            const int cnt = (2048 - r0) < nb ? (2048 - r0) : nb;
            const int k = ((rd & 1) && !(cnt & 1)) ? 2 * ((cnt >> 1) - 1 - (bid >> 1)) + (bid & 1) : bid;
            const int j = r0 + k;
            nsa_tile(p, 1023 - (j >> 1), j & 1, smem);
        }
    }
    }
    if (!conv_first) convert_late_weights(p, bid, nb);
}

template <int PASS>
__device__ __forceinline__ void phase_merge(const Params& p, int bid, int nb, unsigned char* smem) {
    const int g2tid = tid_opaque();
    const bf16_t* sg = (const bf16_t*)(p.ws + (PASS ? WS_SGB : WS_SGA));
    bf16_t* merged = (bf16_t*)(p.ws + WS_MERGED);
    float* tmp = (float*)(p.ws + WS_X1);
    const bf16_t* A = (const bf16_t*)(p.ws + (PASS ? WS_OB : WS_OA));
    const bf16_t* Bw = (const bf16_t*)(p.ws + (PASS ? WB_B : WB_A));
    for (int w = bid; w < 128 * 8; w += nb) {
        const int mt = w % 128, nt = w / 128;
        const int m0 = mt * 128, n0 = nt * 128;
        f32x4 acc[4][4];
        gemm2<false, false>(A, 512, nullptr, m0, 128, Bw, D, n0, 128, 512, smem, acc);
#pragma unroll
        for (int i = 0; i < 4; ++i) {
            float vv[4][4];
#pragma unroll
            for (int r = 0; r < 4; ++r) {
                const int row = m0 + G2_ROW(i, r);
                const bf16_t* zr = sg + (size_t)row * D + n0 + G2_COL(0);
                float* tr = tmp + (size_t)row * D + n0 + G2_COL(0);
#pragma unroll
                for (int j = 0; j < 4; ++j) {
                    const float v = bf2f(zr[j * 16]) * acc[i][j][r];
                    if (PASS == 0) tr[j * 16] = v;
                    else vv[j][r] = tr[j * 16] + v;
                }
            }
            if (PASS == 1) {
                bf16_t* mr = merged + (size_t)(m0 + G2_ROW(i, 0)) * D + n0 + G2_COL(0);
#pragma unroll
                for (int j = 0; j < 4; ++j) store_bf16_frag(mr + j * 16, D, vv[j][0], vv[j][1], vv[j][2], vv[j][3], g2tid & 63);
            }
        }
    }
}

__device__ __forceinline__ void phase_outproj(const Params& p, int bid, int nb, unsigned char* smem) {
    const int g2tid = tid_opaque();
    const bf16_t* merged = (const bf16_t*)(p.ws + WS_MERGED);
    const float* x = p.in[0];
    float* x1 = (float*)(p.ws + WS_X1);
    for (int w = bid; w < 128 * 8; w += nb) {
        const int mt = w % 128, nt = w / 128;
        const int m0 = mt * 128, n0 = nt * 128;
        f32x4 acc[4][4];
        gemm2<false, false>(merged, D, nullptr, m0, 128, (const bf16_t*)(p.ws + WB_OUT), D, n0, 128, D, smem, acc);
#pragma unroll
        for (int i = 0; i < 4; ++i)
#pragma unroll
            for (int r = 0; r < 4; ++r) {
                const size_t ro = (size_t)(m0 + G2_ROW(i, r)) * D + n0;
#pragma unroll
                for (int j = 0; j < 4; ++j) { const int c = G2_COL(j); x1[ro + c] = x[ro + c] + acc[i][j][r]; }
            }
    }
}

__device__ __forceinline__ void phase_route(const Params& p, int bid, int nb, unsigned char* smem) {
    const int lane = tid_opaque() & 63, wave = tid_opaque() >> 6;
    const float* x1 = (const float*)(p.ws + WS_X1);
    const float* g = p.in[18];
    const float* wr = p.in[19];
    const float* br = p.in[20];
    bf16_t* hb = (bf16_t*)(p.ws + WS_HB);
    int* topi = (int*)(p.ws + WS_TOPI);
    float* topw = (float*)(p.ws + WS_TOPW);
    int* cnt = (int*)(p.ws + WS_CTL);
    float* hl = (float*)smem + wave * 1056;
    const int ksub = lane >> 3, e4 = lane & 7;
    __syncthreads();
    for (int t = bid * 4 + wave; t < S; t += nb * 4) {
        const float4* xr = (const float4*)(x1 + (size_t)t * D);
        float4 v[4];
        float ss = 0.f;
#pragma unroll
        for (int j = 0; j < 4; ++j) { v[j] = xr[lane + 64 * j]; ss += v[j].x * v[j].x + v[j].y * v[j].y + v[j].z * v[j].z + v[j].w * v[j].w; }
        ss = wave_sum(ss);
        const float rstd = rsqrtf(ss * (1.f / D) + EPS);
#pragma unroll
        for (int j = 0; j < 4; ++j) {
            const float4 gg = ((const float4*)g)[lane + 64 * j];
            const float4 h4 = make_float4(v[j].x * rstd * gg.x, v[j].y * rstd * gg.y, v[j].z * rstd * gg.z, v[j].w * rstd * gg.w);
            uint2 o; o.x = pk2(h4.x, h4.y); o.y = pk2(h4.z, h4.w);
            ((uint2*)(hb + (size_t)t * D))[lane + 64 * j] = o;
            ((float4*)hl)[lane + 64 * j] = h4;
        }
        asm volatile("" ::: "memory");
        float4 acc = make_float4(0.f, 0.f, 0.f, 0.f);
        const float4* wp = (const float4*)(wr + (size_t)ksub * 32) + e4;
#pragma unroll 8
        for (int i = 0; i < 128; ++i) {
            const float hk = hl[8 * i + ksub];
            const float4 w4 = wp[(size_t)i * 64];
            acc.x += hk * w4.x; acc.y += hk * w4.y; acc.z += hk * w4.z; acc.w += hk * w4.w;
        }
#pragma unroll
        for (int o_ = 8; o_ < 64; o_ <<= 1) { acc.x += __shfl_xor(acc.x, o_); acc.y += __shfl_xor(acc.y, o_); acc.z += __shfl_xor(acc.z, o_); acc.w += __shfl_xor(acc.w, o_); }
        if (ksub == 0) {
            const float4 b4 = ((const float4*)br)[e4];
            ((float4*)(hl + 1024))[e4] = make_float4(acc.x + b4.x, acc.y + b4.y, acc.z + b4.z, acc.w + b4.w);
        }
        asm volatile("" ::: "memory");
        float lg[32];
#pragma unroll
        for (int e = 0; e < 8; ++e) { const float4 l4 = ((const float4*)(hl + 1024))[e]; lg[4 * e] = l4.x; lg[4 * e + 1] = l4.y; lg[4 * e + 2] = l4.z; lg[4 * e + 3] = l4.w; }
        asm volatile("" ::: "memory");
        int idx[4]; float val[4];
        unsigned used = 0;
#pragma unroll
        for (int k = 0; k < 4; ++k) {
            float best = -__builtin_inff(); int bi = 0;
#pragma unroll
            for (int e = 0; e < 32; ++e) { const bool ok = !((used >> e) & 1u) && (lg[e] > best); best = ok ? lg[e] : best; bi = ok ? e : bi; }
            idx[k] = bi; val[k] = best; used |= 1u << bi;
        }
        const float e0 = 1.f, e1 = __expf(val[1] - val[0]), e2 = __expf(val[2] - val[0]), e3 = __expf(val[3] - val[0]);
        const float inv = 1.f / (e0 + e1 + e2 + e3);
        if (lane == 0) {
            topi[t * 4 + 0] = idx[0]; topi[t * 4 + 1] = idx[1]; topi[t * 4 + 2] = idx[2]; topi[t * 4 + 3] = idx[3];
            topw[t * 4 + 0] = e0 * inv; topw[t * 4 + 1] = e1 * inv; topw[t * 4 + 2] = e2 * inv; topw[t * 4 + 3] = e3 * inv;
            atomicAdd(&cnt[idx[0]], 1); atomicAdd(&cnt[idx[1]], 1); atomicAdd(&cnt[idx[2]], 1); atomicAdd(&cnt[idx[3]], 1);
        }
    }
}

__device__ __forceinline__ void phase_place(const Params& p, int bid, int nb, unsigned char* smem) {
    int* off = (int*)smem;
    const int* cnt = (const int*)(p.ws + WS_CTL);
    int* cur = (int*)(p.ws + WS_CTL) + 32;
    const int* topi = (const int*)(p.ws + WS_TOPI);
    int* ppos = (int*)(p.ws + WS_PPOS);
    int* rowtok = (int*)(p.ws + WS_ROWTOK);
    __syncthreads();
    if (tid_opaque() == 0) { int a = 0; for (int e = 0; e < NEXP; ++e) { off[e] = a; a += cnt[e]; } }
    __syncthreads();
    for (int i = bid * NT + tid_opaque(); i < S * 4; i += nb * NT) {
        const int e = topi[i];
        const int pos = off[e] + atomicAdd(&cur[e], 1);
        ppos[i] = pos;
        rowtok[pos] = i >> 2;
    }
}

__device__ __forceinline__ void moe_tile_map(const int* cnt, int* sm, int& total_mt) {
    __syncthreads();
    if (tid_opaque() == 0) {
        int a = 0, b = 0;
        for (int e = 0; e < NEXP; ++e) { sm[e] = a; sm[33 + e] = b; a += (cnt[e] + 127) >> 7; b += cnt[e]; }
        sm[32] = a; sm[65] = b;
    }
    __syncthreads();
    total_mt = sm[32];
}
__device__ __forceinline__ void phase_moe1(const Params& p, int bid, int nb, unsigned char* smem) {
    const int g2tid = tid_opaque();
    int* sm = (int*)(smem + 65536);
    const int* cnt = (const int*)(p.ws + WS_CTL);
    const int* rowtok = (const int*)(p.ws + WS_ROWTOK);
    const bf16_t* hb = (const bf16_t*)(p.ws + WS_HB);
    bf16_t* act = (bf16_t*)(p.ws + WS_ACT);
    const int lane = tid_opaque() & 63, wave = tid_opaque() >> 6;
    int total_mt;
    moe_tile_map(cnt, sm, total_mt);
    for (int w = bid; w < total_mt * 16; w += nb) {
        const int tm = w >> 4, nt = w & 15;
        int e = 0;
        while (e < NEXP - 1 && sm[e + 1] <= tm) ++e;
        const int mt = tm - sm[e];
        const int rbase = sm[33 + e] + mt * 128;
        const int mrows = min(128, cnt[e] - mt * 128);
        const int n0 = nt * 64;
        f32x4 acc[4][4];
        gemm2<true, true>(hb, D, rowtok, rbase, mrows, (const bf16_t*)(p.ws + WB_E1) + (size_t)e * D * 2 * DFF, 2 * DFF, n0, 128, D, smem, acc);
        const float* b1 = p.in[22] + (size_t)e * 2 * DFF;
        const int wn_ = (tid_opaque() >> 6) & 1;
#pragma unroll
        for (int i = 0; i < 4; ++i)
#pragma unroll
            for (int jp = 0; jp < 2; ++jp) {
                const int col = n0 + (wn_ * 2 + jp) * 16 + (tid_opaque() & 15);
                const float bg = b1[col], bl = b1[DFF + col];
                float av[4];
                unsigned rmask = 0;
#pragma unroll
                for (int r = 0; r < 4; ++r) {
                    const int rl = G2_ROW(i, r);
                    const float gate = fminf(acc[i][2 * jp][r] + bg, 7.f);
                    const float lin = fminf(fmaxf(acc[i][2 * jp + 1][r] + bl, -7.f), 7.f);
                    av[r] = (lin + 1.f) * gate * sigmoidf_(1.702f * gate);
                    rmask |= (rl < mrows) ? (1u << r) : 0u;
                }
                store_bf16_frag(act + (size_t)(rbase + G2_ROW(i, 0)) * DFF + col, DFF, av[0], av[1], av[2], av[3], g2tid & 63, rmask);
            }
    }
}
__device__ __forceinline__ void phase_moe2(const Params& p, int bid, int nb, unsigned char* smem) {
    const int g2tid = tid_opaque();
    int* sm = (int*)(smem + 65536);
    const int* cnt = (const int*)(p.ws + WS_CTL);
    const bf16_t* act = (const bf16_t*)(p.ws + WS_ACT);
    float* yrows = (float*)(p.ws + WS_YROWS);
    const int lane = tid_opaque() & 63, wave = tid_opaque() >> 6;
    int total_mt;
    moe_tile_map(cnt, sm, total_mt);
    for (int w = bid; w < total_mt * 8; w += nb) {
        const int tm = w >> 3, nt = w & 7;
        int e = 0;
        while (e < NEXP - 1 && sm[e + 1] <= tm) ++e;
        const int mt = tm - sm[e];
        const int rbase = sm[33 + e] + mt * 128;
        const int mrows = min(128, cnt[e] - mt * 128);
        const int n0 = nt * 128;
        f32x4 acc[4][4];
        gemm2<false, false>(act, DFF, nullptr, rbase, mrows, (const bf16_t*)(p.ws + WB_E2) + (size_t)e * DFF * D, D, n0, 128, DFF, smem, acc);
        const float* b2 = p.in[24] + (size_t)e * D + n0;
#pragma unroll
        for (int i = 0; i < 4; ++i)
#pragma unroll
            for (int r = 0; r < 4; ++r) {
                const int rl = G2_ROW(i, r);
                if (rl < mrows) {
                    float* yr = yrows + (size_t)(rbase + rl) * D + n0;
#pragma unroll
                    for (int j = 0; j < 4; ++j) { const int c = G2_COL(j); yr[c] = acc[i][j][r] + b2[c]; }
                }
            }
    }
}

__device__ __forceinline__ void phase_combine(const Params& p, int bid, int nb) {
    const int lane = tid_opaque() & 63, wave = tid_opaque() >> 6;
    const float* x1 = (const float*)(p.ws + WS_X1);
    const float* yrows = (const float*)(p.ws + WS_YROWS);
    const int* ppos = (const int*)(p.ws + WS_PPOS);
    const float* topw = (const float*)(p.ws + WS_TOPW);
    const float* g = p.in[25];
    bf16_t* hb = (bf16_t*)(p.ws + WS_HB);
    bf16_t* pb = (bf16_t*)(p.ws + WS_PB);
    for (int t = bid * 4 + wave; t < S; t += nb * 4) {
        float4 v[4];
#pragma unroll
        for (int j = 0; j < 4; ++j) v[j] = ((const float4*)(x1 + (size_t)t * D))[lane + 64 * j];
#pragma unroll
        for (int k = 0; k < 4; ++k) {
            const float wk = topw[t * 4 + k];
            const float4* yr = (const float4*)(yrows + (size_t)ppos[t * 4 + k] * D);
#pragma unroll
            for (int j = 0; j < 4; ++j) { const float4 y = yr[lane + 64 * j]; v[j].x += wk * y.x; v[j].y += wk * y.y; v[j].z += wk * y.z; v[j].w += wk * y.w; }
        }
        float ss = 0.f;
#pragma unroll
        for (int j = 0; j < 4; ++j) ss += v[j].x * v[j].x + v[j].y * v[j].y + v[j].z * v[j].z + v[j].w * v[j].w;
        ss = wave_sum(ss);
        const float rstd = rsqrtf(ss * (1.f / D) + EPS);
#pragma unroll
        for (int j = 0; j < 4; ++j) {
            ((float4*)(p.out + (size_t)t * D))[lane + 64 * j] = v[j];
            const float4 gg = ((const float4*)g)[lane + 64 * j];
            uint2 o;
            o.x = pk2(v[j].x * rstd * gg.x, v[j].y * rstd * gg.y);
            o.y = pk2(v[j].z * rstd * gg.z, v[j].w * rstd * gg.w);
            ((uint2*)(hb + (size_t)t * D))[lane + 64 * j] = o;
        }
    }
}

__device__ __forceinline__ void phase_ple(const Params& p, int bid, int nb, unsigned char* smem) {
    const int g2tid = tid_opaque();
    const bf16_t* pw = (const bf16_t*)(p.ws + WS_PW);
    for (int w = bid; w < 128 * 8; w += nb) {
        const int mt = w % 128, nt = w / 128;
        const int m0 = mt * 128, n0 = nt * 128;
        f32x4 acc[4][4];
        gemm2<false, false>((const bf16_t*)(p.ws + WS_HB), D, nullptr, m0, 128, (const bf16_t*)(p.ws + WB_PLEG), D, n0, 128, D, smem, acc);
#pragma unroll
        for (int i = 0; i < 4; ++i)
#pragma unroll
            for (int r = 0; r < 4; ++r) {
                const size_t ro = (size_t)(m0 + G2_ROW(i, r)) * D + n0 + G2_COL(0);
                float* orow = p.out + ro;
#pragma unroll
                for (int j = 0; j < 4; ++j) orow[j * 16] = orow[j * 16] + sigmoidf_(acc[i][j][r]) * bf2f(pw[ro + j * 16]);
            }
    }
}

#define LAS __attribute__((address_space(3)))
#define XB_TMO      128
#define XB_XCNT(j)  (256  + 64 * (j))
#define XB_XSUB(j)  (1280 + 64 * (j))
#define XB_XGEN(j)  (2304 + 64 * (j))
#define XB_TOP      3328
#define XB_TOPGEN   3392
#define XCD_BAR_WORDS 3456
#define XB_SPIN_CAP (1u << 22)

__device__ __forceinline__ unsigned xb_ld(unsigned* p)              { return __hip_atomic_load(p, __ATOMIC_RELAXED, __HIP_MEMORY_SCOPE_AGENT); }
__device__ __forceinline__ unsigned xb_add(unsigned* p, unsigned v) { return __hip_atomic_fetch_add(p, v, __ATOMIC_RELAXED, __HIP_MEMORY_SCOPE_AGENT); }
__device__ __forceinline__ unsigned xb_xcc_id() { return (unsigned)__builtin_amdgcn_s_getreg((3 << 11) | 20) & 0xFu; }
#define XB_SPIN(cond, bar) do { unsigned _sp = 0; while (cond) { __builtin_amdgcn_s_sleep(1); \
    if ((++_sp & 255u) == 0u) { if (xb_ld(&(bar)[XB_TMO])) break; if (_sp > XB_SPIN_CAP) { atomicAdd(&(bar)[XB_TMO], 1u); break; } } } } while (0)

struct XcdBarrier {
    unsigned* bar; unsigned x;
    volatile LAS unsigned* st;
};

__device__ __forceinline__ XcdBarrier xcd_barrier_post(unsigned* bar, volatile LAS unsigned* st) {
    XcdBarrier b; b.bar = bar; b.x = xb_xcc_id(); b.st = st;
    if (tid_opaque() == 0) (void)xb_add(&bar[XB_XCNT(b.x)], 1u);
    return b;
}
__device__ __forceinline__ void xcd_barrier_complete(unsigned* bar, unsigned x, unsigned& nloc, unsigned& nx) {
    const unsigned G = gridDim.x * gridDim.y * gridDim.z;
    unsigned sum, cnt, mine, sp = 0u;
    for (;;) {
        sum = 0u; cnt = 0u; mine = 0u;
#pragma unroll
        for (unsigned j = 0; j < 16; ++j) { const unsigned c = xb_ld(&bar[XB_XCNT(j)]); sum += c; cnt += (c > 0u) ? 1u : 0u; mine = (j == x) ? c : mine; }
        if (sum == G) break;
        __builtin_amdgcn_s_sleep(1);
        if ((++sp & 255u) == 0u) { if (xb_ld(&bar[XB_TMO])) break; if (sp > XB_SPIN_CAP) { atomicAdd(&bar[XB_TMO], 1u); break; } }
    }
    nloc = mine > 0u ? mine : 1u; nx = cnt > 0u ? cnt : 1u;
}

__device__ __forceinline__ void xcd_barrier(const XcdBarrier& b) {
    asm volatile("s_waitcnt vmcnt(0)" ::: "memory");
    __syncthreads();
    if (tid_opaque() == 0) {
        unsigned* bar = b.bar;
        __builtin_amdgcn_s_waitcnt(0);
        unsigned nloc = b.st[0], nx = b.st[1];
        if (nloc == 0u) { xcd_barrier_complete(bar, b.x, nloc, nx); b.st[0] = nloc; b.st[1] = nx; }
        const unsigned old = xb_add(&bar[XB_XSUB(b.x)], 1u);
        const unsigned gen = old / nloc;
        if (old + 1u == (gen + 1u) * nloc) {
            __builtin_amdgcn_fence(__ATOMIC_RELEASE, "agent");
            asm volatile("s_waitcnt vmcnt(0)" ::: "memory");
            const unsigned og = xb_add(&bar[XB_TOP], 1u);
            const unsigned tg = og / nx;
            if (og + 1u == (tg + 1u) * nx) xb_add(&bar[XB_TOPGEN], 1u);
            else XB_SPIN(xb_ld(&bar[XB_TOPGEN]) == tg, bar);
            __builtin_amdgcn_fence(__ATOMIC_ACQUIRE, "agent");
            xb_add(&bar[XB_XGEN(b.x)], 1u);
            asm volatile("s_waitcnt vmcnt(0)" ::: "memory");
        } else {
            XB_SPIN(xb_ld(&bar[XB_XGEN(b.x)]) == gen, bar);
            __builtin_amdgcn_fence(__ATOMIC_ACQUIRE, "agent");
            asm volatile("s_waitcnt vmcnt(0)" ::: "memory");
        }
    }
    __syncthreads();
}

template <int PH>
__device__ __forceinline__ void run_phase(const Params& p, int bid, int nb, unsigned char* smem) {
    if (PH == 0) phase_prep(p, bid, nb);
    if (PH == 1) phase_inproj(p, bid, nb, smem);
    if (PH == 3) phase_compress(p, bid, nb, smem);
    if (PH == 4) phase_attn(p, bid, nb, smem);
    if (PH == 15) {
        if (bid < (nb >> 1)) { phase_dsa_attn(p, bid, nb, smem); phase_merge<0>(p, bid, nb, smem); }
        else { phase_merge<0>(p, bid, nb, smem); phase_dsa_attn(p, bid, nb, smem); }
    }
    if (PH == 13) phase_merge<1>(p, bid, nb, smem);
    if (PH == 6) phase_outproj(p, bid, nb, smem);
    if (PH == 7) phase_route(p, bid, nb, smem);
    if (PH == 8) phase_place(p, bid, nb, smem);
    if (PH == 9) phase_moe1(p, bid, nb, smem);
    if (PH == 10) phase_moe2(p, bid, nb, smem);
    if (PH == 11) phase_combine(p, bid, nb);
    if (PH == 12) phase_ple(p, bid, nb, smem);
}

#if SINGLE_LAUNCH
__global__ void __launch_bounds__(NT, 2) fwd_mega(Params p) {
    __shared__ __attribute__((aligned(16))) unsigned char smem[SMEM_BYTES];
    cg::grid_group grid = cg::this_grid();
    const int bid = blockIdx.x, nb = gridDim.x;
    volatile LAS unsigned* bst = (volatile LAS unsigned*)(LAS unsigned char*)(smem + SMEM_BYTES - 16);
    if (tid_opaque() < 2) bst[tid_opaque()] = 0u;
    __syncthreads();
    const XcdBarrier bar = xcd_barrier_post((unsigned*)(p.ws + WS_BAR), bst);
#define GSYNC() xcd_barrier(bar)
    run_phase<0>(p, bid, nb, smem); grid.sync();
    run_phase<1>(p, bid, nb, smem); GSYNC();
    run_phase<3>(p, bid, nb, smem); GSYNC();
    run_phase<4>(p, bid, nb, smem); GSYNC();
    run_phase<15>(p, bid, nb, smem); GSYNC();
    run_phase<13>(p, bid, nb, smem); GSYNC();
    run_phase<6>(p, bid, nb, smem); GSYNC();
    run_phase<7>(p, bid, nb, smem); GSYNC();
    run_phase<8>(p, bid, nb, smem); GSYNC();
    run_phase<9>(p, bid, nb, smem); GSYNC();
    run_phase<10>(p, bid, nb, smem); GSYNC();
    run_phase<11>(p, bid, nb, smem); GSYNC();
    run_phase<12>(p, bid, nb, smem);
#undef GSYNC
}
#else
template <int PH>
__global__ void __launch_bounds__(NT, 2) k_phase(Params p) {
    __shared__ __attribute__((aligned(16))) unsigned char smem[SMEM_BYTES];
    run_phase<PH>(p, blockIdx.x, gridDim.x, smem);
}
#endif

extern "C" void kernel_launch(void* const* d_in, const int* in_sizes, int n_in, void* d_out, int out_size, void* d_ws, size_t ws_size,
                              hipStream_t stream) {
    if (n_in != 28 || ws_size < WS_END) { fprintf(stderr, "kernel_launch: unexpected n_in %d or ws_size %zu (< %zu)\n", n_in, ws_size, (size_t)WS_END); return; }
    Params p{};
    for (int i = 0; i < 28; ++i) p.in[i] = (const float*)d_in[i];
    p.out = (float*)d_out;
    p.ws = (unsigned char*)d_ws;
#if SINGLE_LAUNCH
    static int grid_blocks = 0;
    if (!grid_blocks) {
        int dev = 0, cus = 0, per_cu = 0;
        hipGetDevice(&dev);
        hipDeviceGetAttribute(&cus, hipDeviceAttributeMultiprocessorCount, dev);
        hipOccupancyMaxActiveBlocksPerMultiprocessor(&per_cu, fwd_mega, NT, 0);
        if (per_cu > 2) per_cu = 2;
        if (per_cu < 1) per_cu = 1;
        grid_blocks = cus * per_cu;
    }
    (void)hipMemsetAsync((unsigned char*)d_ws + WS_BAR, 0, XCD_BAR_WORDS * 4, stream);
    void* args[] = {&p};
    hipError_t e = hipLaunchCooperativeKernel((void*)fwd_mega, dim3(grid_blocks), dim3(NT), args, 0, stream);
    if (e != hipSuccess) fprintf(stderr, "cooperative launch failed: %s (grid %d)\n", hipGetErrorString(e), grid_blocks);
#else
    const int G = 512;
    k_phase<0><<<G, NT, 0, stream>>>(p);
    k_phase<1><<<G, NT, 0, stream>>>(p);
    k_phase<3><<<G, NT, 0, stream>>>(p);
    k_phase<4><<<G, NT, 0, stream>>>(p);
    k_phase<15><<<G, NT, 0, stream>>>(p);
    k_phase<13><<<G, NT, 0, stream>>>(p);
    k_phase<6><<<G, NT, 0, stream>>>(p);
    k_phase<7><<<G, NT, 0, stream>>>(p);
    k_phase<8><<<G, NT, 0, stream>>>(p);
    k_phase<9><<<G, NT, 0, stream>>>(p);
    k_phase<10><<<G, NT, 0, stream>>>(p);
    k_phase<11><<<G, NT, 0, stream>>>(p);
    k_phase<12><<<G, NT, 0, stream>>>(p);
#endif
}
```

```cpp
#include <hip/hip_runtime.h>
#include <hip/hip_cooperative_groups.h>
#include <cstdio>
#include <cstdint>
namespace cg = cooperative_groups;

#ifndef SINGLE_LAUNCH
#define SINGLE_LAUNCH 1
#endif

constexpr int S = 16384;
constexpr int D = 1024;
constexpr int DIN = 5184;
constexpr int NCMP = 1023;
constexpr int NSLC = 256;
constexpr int NEXP = 32;
constexpr int DFF = 1024;
constexpr float EPS = 1e-6f;
constexpr float LOG2E = 1.4426950408889634f;
constexpr int Z_NQ = 0, Z_NKV = 512, Z_NGATE = 1280, Z_DQ = 1304, Z_DK = 1816, Z_DV = 2328, Z_IQ = 2840, Z_IK = 3096,
              Z_IW = 3128, Z_GA = 3136, Z_GB = 4160;

constexpr int NT = 256;
constexpr int SMEM_BYTES = 73728;

typedef unsigned short bf16_t;
typedef short bf16x8 __attribute__((ext_vector_type(8)));
typedef float f32x4 __attribute__((ext_vector_type(4)));
typedef short s16x4 __attribute__((ext_vector_type(4)));
typedef __attribute__((address_space(3))) s16x4* lds_s16x4_ptr;
__device__ __forceinline__ s16x4 lds_tr16(const void* p) {
    return __builtin_amdgcn_ds_read_tr16_b64_v4i16((lds_s16x4_ptr)(uintptr_t)p);
}

constexpr size_t MBy = 1ull << 20;
constexpr size_t WS_CTL = 0;
constexpr size_t WS_BAR = 65536;
constexpr size_t WS_HB = 1 * MBy;
constexpr size_t WS_OA = WS_HB + (size_t)S * D * 2;
constexpr size_t WS_OB = WS_OA + (size_t)S * 512 * 2;
constexpr size_t WS_MERGED = WS_OB + (size_t)S * 512 * 2;
constexpr size_t WS_X1 = WS_MERGED + (size_t)S * D * 2;
constexpr size_t WS_TOPI = WS_X1 + (size_t)S * D * 4;
constexpr size_t WS_TOPW = WS_TOPI + (size_t)S * 4 * 4;
constexpr size_t WS_PPOS = WS_TOPW + (size_t)S * 4 * 4;
constexpr size_t WS_ROWTOK = WS_PPOS + (size_t)S * 4 * 4;
constexpr size_t WS_PB = WS_ROWTOK + (size_t)65536 * 4;
constexpr size_t WS_PW = WS_PB + (size_t)S * 256 * 2;
constexpr size_t WS_SEL = WS_PW + (size_t)S * D * 2;
constexpr size_t WS_NSEL = WS_SEL + (size_t)S * 256 * 2;
constexpr size_t WS_REG = WS_NSEL + (size_t)S * 4;
constexpr size_t WS_SGA = WS_REG;
constexpr size_t WS_SGB = WS_SGA + (size_t)S * D * 2;
constexpr size_t WS_GT = WS_SGB + (size_t)S * D * 2;
constexpr size_t WS_IWS = WS_GT + (size_t)S * 32 * 4;
constexpr size_t WS_QNB = WS_IWS + (size_t)S * 8 * 4;
constexpr size_t WS_KSLB = WS_QNB + (size_t)S * 512 * 2;
constexpr size_t WS_VSLB = WS_KSLB + (size_t)S * 128 * 2;
constexpr size_t WS_KWNB = WS_VSLB + (size_t)S * 128 * 2;
constexpr size_t WS_VWNB = WS_KWNB + (size_t)S * 128 * 2;
constexpr size_t WS_KCB = WS_VWNB + (size_t)S * 128 * 2;
constexpr size_t WS_VCB = WS_KCB + (size_t)2 * 1024 * 64 * 2;
constexpr size_t WS_KCR = WS_VCB + (size_t)2 * 1024 * 64 * 2;
constexpr size_t WS_VCR = WS_KCR + (size_t)S * 128 * 2;
constexpr size_t WS_DQB = WS_VCR + (size_t)S * 128 * 2;
constexpr size_t WS_DKB = WS_DQB + (size_t)S * 512 * 2;
constexpr size_t WS_DVB = WS_DKB + (size_t)S * 512 * 2;
constexpr size_t WS_IQB = WS_DVB + (size_t)S * 512 * 2;
constexpr size_t WS_IKB = WS_IQB + (size_t)S * 256 * 2;
constexpr size_t WS_ENDA = WS_IKB + (size_t)S * 32 * 2;
constexpr size_t WS_ACT = WS_REG;
constexpr size_t WS_YROWS = WS_ACT + (size_t)(65536 + 128) * DFF * 2;
constexpr size_t WS_ENDB = WS_YROWS + (size_t)(65536 + 128) * D * 4;
constexpr size_t WS_END0 = WS_ENDA > WS_ENDB ? WS_ENDA : WS_ENDB;
constexpr size_t WB_IN = WS_END0;
constexpr size_t WB_A = WB_IN + (size_t)D * DIN * 2;
constexpr size_t WB_B = WB_A + (size_t)512 * D * 2;
constexpr size_t WB_OUT = WB_B + (size_t)512 * D * 2;
constexpr size_t WB_E1 = WB_OUT + (size_t)D * D * 2;
constexpr size_t WB_E2 = WB_E1 + (size_t)NEXP * D * 2 * DFF * 2;
constexpr size_t WB_PLE = WB_E2 + (size_t)NEXP * DFF * D * 2;
constexpr size_t WB_PLEG = WB_PLE + (size_t)256 * D * 2;
constexpr size_t WB_CK1 = WB_PLEG + (size_t)D * D * 2;
constexpr size_t WB_CV1 = WB_CK1 + (size_t)2048 * 64 * 2;
constexpr size_t WS_END = WB_CV1 + (size_t)2048 * 64 * 2 + 4096;

struct Params {
    const float* in[28];
    float* out;
    unsigned char* ws;
};

__device__ __forceinline__ unsigned f2bf(float f) {
    unsigned u = __builtin_bit_cast(unsigned, f);
    return (u + 0x7fffu + ((u >> 16) & 1u)) >> 16;
}
__device__ __forceinline__ unsigned pk2(float lo, float hi) { return f2bf(lo) | (f2bf(hi) << 16); }
__device__ __forceinline__ float bf2f(unsigned short b) { return __builtin_bit_cast(float, (unsigned)b << 16); }
__device__ __forceinline__ int tid_opaque() { int t = threadIdx.x; asm volatile("" : "+v"(t)); return t; }
__device__ __forceinline__ float wave_sum(float v) {
#pragma unroll
    for (int o = 1; o < 64; o <<= 1) v += __shfl_xor(v, o);
    return v;
}
__device__ __forceinline__ float wave_max(float v) {
#pragma unroll
    for (int o = 1; o < 64; o <<= 1) v = fmaxf(v, __shfl_xor(v, o));
    return v;
}
__device__ __forceinline__ float sigmoidf_(float x) { return 1.f / (1.f + __expf(-x)); }
__device__ __forceinline__ int bucket_of(int n) {
    if (n < 16) return n;
    int b = 16;
    b += (n >= 19) + (n >= 21) + (n >= 24) + (n >= 27) + (n >= 31) + (n >= 35) + (n >= 40) + (n >= 46) + (n >= 52) + (n >= 59) +
         (n >= 67) + (n >= 77) + (n >= 87) + (n >= 99) + (n >= 113);
    return b;
}

constexpr int LDS_STRIDE = 40;
constexpr int BTR_STRIDE = 136;
template <bool A_F32, bool GATHER, bool SPLIT = false, bool BTR = true>
__device__ __forceinline__ void gemm_tile(const void* __restrict__ Aptr, int lda, const int* __restrict__ rowidx, int m0, int mrows,
                                          const float* __restrict__ B, int ldb, int n0, int split_off, int ncols, int K,
                                          unsigned char* smem, f32x4 (&acc)[2][8]) {
    bf16_t* As = (bf16_t*)smem;
    bf16_t* Bs = As + 128 * LDS_STRIDE;
    bf16_t* AsL = Bs + 128 * LDS_STRIDE;
    bf16_t* BsL = AsL + 128 * LDS_STRIDE;
    const int tid = tid_opaque(), lane = tid & 63, wave = tid >> 6;
#pragma unroll
    for (int i = 0; i < 2; ++i)
#pragma unroll
        for (int j = 0; j < 8; ++j) acc[i][j] = (f32x4){0.f, 0.f, 0.f, 0.f};
    auto lo = [](float v) { return v - bf2f((unsigned short)f2bf(v)); };

    const int ar = tid >> 2, ach = tid & 3;
    const unsigned char* arow[2];
    bool aval[2];
#pragma unroll
    for (int i = 0; i < 2; ++i) {
        int r = ar + 64 * i;
        aval[i] = r < mrows;
        long src = 0;
        if (aval[i]) src = GATHER ? (long)rowidx[m0 + r] : (long)(m0 + r);
        arow[i] = (const unsigned char*)Aptr + (size_t)src * lda * (A_F32 ? 4 : 2) + (size_t)ach * 8 * (A_F32 ? 4 : 2);
    }
    const int nq = tid & 31, kq = tid >> 5;
    const int jn = 4 * nq;
    const bool bval = jn < ncols;
    const float* bptr = B + (size_t)(4 * kq) * ldb + n0 + jn + (jn >= 64 ? split_off : 0);

    uint4 areg[2];
    float4 af0a, af0b, af1a, af1b;
    float4 breg[4];
    auto load_g = [&](int k0) {
#pragma unroll
        for (int i = 0; i < 2; ++i) {
            if (A_F32) {
                float4 t0 = make_float4(0, 0, 0, 0), t1 = t0;
                if (aval[i]) {
                    const float4* s = (const float4*)(arow[i] + (size_t)k0 * 4);
                    t0 = s[0]; t1 = s[1];
                }
                if (i == 0) { af0a = t0; af0b = t1; } else { af1a = t0; af1b = t1; }
            } else {
                if (aval[i]) areg[i] = *(const uint4*)(arow[i] + (size_t)k0 * 2);
                else areg[i] = make_uint4(0, 0, 0, 0);
            }
        }
#pragma unroll
        for (int kk = 0; kk < 4; ++kk) {
            if (bval) breg[kk] = *(const float4*)(bptr + (size_t)(k0 + kk) * ldb);
            else breg[kk] = make_float4(0, 0, 0, 0);
        }
    };
    auto store_l = [&]() {
#pragma unroll
        for (int i = 0; i < 2; ++i) {
            uint4 v;
            const float4 t0 = (i == 0) ? af0a : af1a, t1 = (i == 0) ? af0b : af1b;
            if (A_F32) {
                v.x = pk2(t0.x, t0.y); v.y = pk2(t0.z, t0.w);
                v.z = pk2(t1.x, t1.y); v.w = pk2(t1.z, t1.w);
            } else v = areg[i];
            *(uint4*)(As + (ar + 64 * i) * LDS_STRIDE + ach * 8) = v;
            if (SPLIT && A_F32) {
                v.x = pk2(lo(t0.x), lo(t0.y)); v.y = pk2(lo(t0.z), lo(t0.w));
                v.z = pk2(lo(t1.x), lo(t1.y)); v.w = pk2(lo(t1.z), lo(t1.w));
                *(uint4*)(AsL + (ar + 64 * i) * LDS_STRIDE + ach * 8) = v;
            }
        }
        if (SPLIT) {
            uint2 v;
            v.x = pk2(lo(breg[0].x), lo(breg[1].x)); v.y = pk2(lo(breg[2].x), lo(breg[3].x));
            *(uint2*)(BsL + (jn + 0) * LDS_STRIDE + 4 * kq) = v;
            v.x = pk2(lo(breg[0].y), lo(breg[1].y)); v.y = pk2(lo(breg[2].y), lo(breg[3].y));
            *(uint2*)(BsL + (jn + 1) * LDS_STRIDE + 4 * kq) = v;
            v.x = pk2(lo(breg[0].z), lo(breg[1].z)); v.y = pk2(lo(breg[2].z), lo(breg[3].z));
            *(uint2*)(BsL + (jn + 2) * LDS_STRIDE + 4 * kq) = v;
            v.x = pk2(lo(breg[0].w), lo(breg[1].w)); v.y = pk2(lo(breg[2].w), lo(breg[3].w));
            *(uint2*)(BsL + (jn + 3) * LDS_STRIDE + 4 * kq) = v;
        }
        if (BTR && !SPLIT) {
#pragma unroll
            for (int kk = 0; kk < 4; ++kk) {
                uint2 v; v.x = pk2(breg[kk].x, breg[kk].y); v.y = pk2(breg[kk].z, breg[kk].w);
                *(uint2*)(Bs + (4 * kq + kk) * BTR_STRIDE + jn) = v;
            }
        } else {
            uint2 v;
            v.x = pk2(breg[0].x, breg[1].x); v.y = pk2(breg[2].x, breg[3].x);
            *(uint2*)(Bs + (jn + 0) * LDS_STRIDE + 4 * kq) = v;
            v.x = pk2(breg[0].y, breg[1].y); v.y = pk2(breg[2].y, breg[3].y);
            *(uint2*)(Bs + (jn + 1) * LDS_STRIDE + 4 * kq) = v;
            v.x = pk2(breg[0].z, breg[1].z); v.y = pk2(breg[2].z, breg[3].z);
            *(uint2*)(Bs + (jn + 2) * LDS_STRIDE + 4 * kq) = v;
            v.x = pk2(breg[0].w, breg[1].w); v.y = pk2(breg[2].w, breg[3].w);
            *(uint2*)(Bs + (jn + 3) * LDS_STRIDE + 4 * kq) = v;
        }
    };
    const int nk = K / 32;
    __syncthreads();
    load_g(0);
    store_l();
    __syncthreads();
    const int fr = lane & 15, fq = lane >> 4;
    for (int kt = 0; kt < nk; ++kt) {
        if (kt + 1 < nk) load_g((kt + 1) * 32);
        bf16x8 a[2];
#pragma unroll
        for (int i = 0; i < 2; ++i) a[i] = *(const bf16x8*)(As + (wave * 32 + i * 16 + fr) * LDS_STRIDE + fq * 8);
        if (!SPLIT) {
            bf16x8 b[8];
#pragma unroll
            for (int j = 0; j < 8; ++j) {
                if (BTR && !SPLIT) {
                    const bf16_t* bp = Bs + (8 * fq + (fr >> 2)) * BTR_STRIDE + 16 * j + 4 * (fr & 3);
                    const s16x4 lo4 = lds_tr16(bp), hi4 = lds_tr16(bp + 4 * BTR_STRIDE);
                    b[j] = (bf16x8){lo4[0], lo4[1], lo4[2], lo4[3], hi4[0], hi4[1], hi4[2], hi4[3]};
                } else b[j] = *(const bf16x8*)(Bs + (j * 16 + fr) * LDS_STRIDE + fq * 8);
            }
#pragma unroll
            for (int i = 0; i < 2; ++i)
#pragma unroll
                for (int j = 0; j < 8; ++j) acc[i][j] = __builtin_amdgcn_mfma_f32_16x16x32_bf16(a[i], b[j], acc[i][j], 0, 0, 0);
        } else {
            bf16x8 al[2];
#pragma unroll
            for (int i = 0; i < 2; ++i) al[i] = *(const bf16x8*)(AsL + (wave * 32 + i * 16 + fr) * LDS_STRIDE + fq * 8);
#pragma unroll
            for (int j = 0; j < 8; ++j) {
                const bf16x8 bh = *(const bf16x8*)(Bs + (j * 16 + fr) * LDS_STRIDE + fq * 8);
                const bf16x8 bl = *(const bf16x8*)(BsL + (j * 16 + fr) * LDS_STRIDE + fq * 8);
#pragma unroll
                for (int i = 0; i < 2; ++i) {
                    acc[i][j] = __builtin_amdgcn_mfma_f32_16x16x32_bf16(a[i], bh, acc[i][j], 0, 0, 0);
                    acc[i][j] = __builtin_amdgcn_mfma_f32_16x16x32_bf16(a[i], bl, acc[i][j], 0, 0, 0);
                    acc[i][j] = __builtin_amdgcn_mfma_f32_16x16x32_bf16(al[i], bh, acc[i][j], 0, 0, 0);
                }
            }
        }
        __syncthreads();
        if (kt + 1 < nk) {
            store_l();
            __syncthreads();
        }
    }
}


constexpr int ASTR = 72;
constexpr int BSTR = 136;
template <bool GATHER, bool PAIR>
__device__ __forceinline__ void gemm2(const bf16_t* __restrict__ A, int lda, const int* __restrict__ rowidx, int m0, int mrows,
                                      const bf16_t* __restrict__ B, int ldb, int n0, int ncols, int K, unsigned char* smem,
                                      f32x4 (&acc)[4][4]) {
    bf16_t* As = (bf16_t*)smem;
    bf16_t* Bs = As + 128 * ASTR;
    const int tid = tid_opaque(), lane = tid & 63, wave = tid >> 6, wm = wave >> 1, wn = wave & 1;
#pragma unroll
    for (int i = 0; i < 4; ++i)
#pragma unroll
        for (int j = 0; j < 4; ++j) acc[i][j] = (f32x4){0.f, 0.f, 0.f, 0.f};
    const int ar0 = tid >> 3, ach = tid & 7;
    const bf16_t* ap0; const bf16_t* ap1; const bf16_t* ap2; const bf16_t* ap3;
    {
        int r_[4];
#pragma unroll
        for (int i = 0; i < 4; ++i) { const int rl = 32 * i + ar0; r_[i] = rl < mrows ? rl : mrows - 1; }
        ap0 = A + (size_t)(GATHER ? (long)rowidx[m0 + r_[0]] : (long)(m0 + r_[0])) * lda + ach * 8;
        ap1 = A + (size_t)(GATHER ? (long)rowidx[m0 + r_[1]] : (long)(m0 + r_[1])) * lda + ach * 8;
        ap2 = A + (size_t)(GATHER ? (long)rowidx[m0 + r_[2]] : (long)(m0 + r_[2])) * lda + ach * 8;
        ap3 = A + (size_t)(GATHER ? (long)rowidx[m0 + r_[3]] : (long)(m0 + r_[3])) * lda + ach * 8;
    }
    const int br0 = tid >> 4, bch = tid & 15;
    const int bcol = PAIR ? ((bch >> 2) * 16 + (bch & 1) * 8 + ((bch >> 1) & 1) * 1024) : bch * 8;
    const bf16_t* bp = B + (size_t)br0 * ldb + n0 + bcol;
    bf16_t* asd = As + ar0 * ASTR + ach * 8;
    bf16_t* bsd = Bs + br0 * BSTR + bch * 8;
    uint4 a0, a1, a2, a3, b0, b1, b2, b3;
#define G2_LOAD(k0)                                                                                       \
    do {                                                                                                  \
        a0 = *(const uint4*)(ap0 + (k0)); a1 = *(const uint4*)(ap1 + (k0));                               \
        a2 = *(const uint4*)(ap2 + (k0)); a3 = *(const uint4*)(ap3 + (k0));                               \
        const bf16_t* bp_ = bp + (size_t)(k0) * ldb;                                                      \
        b0 = *(const uint4*)(bp_); b1 = *(const uint4*)(bp_ + (size_t)16 * ldb);                          \
        b2 = *(const uint4*)(bp_ + (size_t)32 * ldb); b3 = *(const uint4*)(bp_ + (size_t)48 * ldb);       \
    } while (0)
#define G2_STORE()                                                                                        \
    do {                                                                                                  \
        *(uint4*)(asd) = a0; *(uint4*)(asd + 32 * ASTR) = a1; *(uint4*)(asd + 64 * ASTR) = a2; *(uint4*)(asd + 96 * ASTR) = a3; \
        *(uint4*)(bsd) = b0; *(uint4*)(bsd + 16 * BSTR) = b1; *(uint4*)(bsd + 32 * BSTR) = b2; *(uint4*)(bsd + 48 * BSTR) = b3; \
    } while (0)
    const int nk = K / 64;
    __syncthreads();
    G2_LOAD(0);
    G2_STORE();
    __syncthreads();
    const int fr = lane & 15, fq = lane >> 4;
    const bf16_t* afp = As + (wm * 64 + fr) * ASTR + fq * 8;
    const bf16_t* bfp = Bs + (8 * fq + (fr >> 2)) * BSTR + wn * 64 + 4 * (fr & 3);
    for (int kt = 0; kt < nk; ++kt) {
        if (kt + 1 < nk) G2_LOAD((kt + 1) * 64);
#pragma unroll
        for (int kh = 0; kh < 2; ++kh) {
            bf16x8 a[4], b[4];
#pragma unroll
            for (int i = 0; i < 4; ++i) a[i] = *(const bf16x8*)(afp + i * 16 * ASTR + kh * 32);
#pragma unroll
            for (int j = 0; j < 4; ++j) {
                const bf16_t* q = bfp + kh * 32 * BSTR + j * 16;
                const s16x4 lo4 = lds_tr16(q), hi4 = lds_tr16(q + 4 * BSTR);
                b[j] = (bf16x8){lo4[0], lo4[1], lo4[2], lo4[3], hi4[0], hi4[1], hi4[2], hi4[3]};
            }
#pragma unroll
            for (int i = 0; i < 4; ++i)
#pragma unroll
                for (int j = 0; j < 4; ++j) acc[i][j] = __builtin_amdgcn_mfma_f32_16x16x32_bf16(a[i], b[j], acc[i][j], 0, 0, 0);
        }
        __syncthreads();
        if (kt + 1 < nk) {
            G2_STORE();
            __syncthreads();
        }
    }
#undef G2_LOAD
#undef G2_STORE
}
#define G2_ROW(i, r) ((g2tid >> 7) * 64 + (i) * 16 + 4 * ((g2tid & 63) >> 4) + (r))
#define G2_COL(j) (((((g2tid >> 6) & 1) * 4 + (j)) * 16) + (g2tid & 15))
__device__ __forceinline__ void store_bf16_frag(bf16_t* base, int ld, float v0, float v1, float v2, float v3, int lane, unsigned rowmask = 0xFu) {
    const bool odd = lane & 1;
    const float s0 = odd ? v0 : v2, s1 = odd ? v1 : v3;
    const float r0 = __shfl_xor(s0, 1), r1 = __shfl_xor(s1, 1);
    bf16_t* p0 = odd ? base + 2 * ld - 1 : base;
    const unsigned w0 = odd ? pk2(r0, v2) : pk2(v0, r0);
    const unsigned w1 = odd ? pk2(r1, v3) : pk2(v1, r1);
    const unsigned m = odd ? (rowmask >> 2) : rowmask;
    if (m & 1u) *(unsigned*)p0 = w0;
    if (m & 2u) *(unsigned*)(p0 + ld) = w1;
}

__device__ __forceinline__ void cvt_weights(const float* __restrict__ src, bf16_t* __restrict__ dst, size_t n, int bid, int nb) {
    const size_t n8 = n >> 3;
    for (size_t i = (size_t)bid * NT + tid_opaque(); i < n8; i += (size_t)nb * NT) {
        const float4 u = ((const float4*)src)[2 * i], v = ((const float4*)src)[2 * i + 1];
        uint4 o; o.x = pk2(u.x, u.y); o.y = pk2(u.z, u.w); o.z = pk2(v.x, v.y); o.w = pk2(v.z, v.w);
        ((uint4*)dst)[i] = o;
    }
}
__device__ __forceinline__ void phase_prep(const Params& p, int bid, int nb) {
    const int lane = tid_opaque() & 63, wave = tid_opaque() >> 6;
    if (bid == 0 && tid_opaque() < 64) ((int*)(p.ws + WS_CTL))[tid_opaque()] = 0;
    {
        const float* src_ = p.in[2];
        bf16_t* dst_ = (bf16_t*)(p.ws + WB_IN);
        constexpr int G8 = DIN / 8;
        for (size_t i = (size_t)bid * NT + tid_opaque(); i < (size_t)D * G8; i += (size_t)nb * NT) {
            const int k = (int)(i / G8), nc = (int)(i % G8) * 8;
            int oc;
            if (nc < 1280) oc = nc; else if (nc < 2816) oc = nc + 24; else if (nc < 3072) oc = nc + 24; else if (nc < 5120) oc = nc + 64;
            else if (nc < 5152) oc = nc - 5120 + 3096; else if (nc < 5176) oc = nc - 5152 + 1280; else oc = nc - 5176 + 3128;
            const float4 u = *(const float4*)(src_ + (size_t)k * DIN + oc), v = *(const float4*)(src_ + (size_t)k * DIN + oc + 4);
            uint4 o; o.x = pk2(u.x, u.y); o.y = pk2(u.z, u.w); o.z = pk2(v.x, v.y); o.w = pk2(v.z, v.w);
            *(uint4*)(dst_ + (size_t)k * DIN + nc) = o;
        }
    }
    cvt_weights(p.in[14], (bf16_t*)(p.ws + WB_A), (size_t)512 * D, bid, nb);
    cvt_weights(p.in[15], (bf16_t*)(p.ws + WB_B), (size_t)512 * D, bid, nb);
    cvt_weights(p.in[16], (bf16_t*)(p.ws + WB_OUT), (size_t)D * D, bid, nb);
    cvt_weights(p.in[26], (bf16_t*)(p.ws + WB_PLE), (size_t)256 * D, bid, nb);
    cvt_weights(p.in[1], (bf16_t*)(p.ws + WS_PB), (size_t)S * 256, bid, nb);
    cvt_weights(p.in[9], (bf16_t*)(p.ws + WB_CK1), (size_t)2048 * 64, bid, nb);
    cvt_weights(p.in[12], (bf16_t*)(p.ws + WB_CV1), (size_t)2048 * 64, bid, nb);
    const float* x = p.in[0];
    const float* g = p.in[3];
    bf16_t* hb = (bf16_t*)(p.ws + WS_HB);
    for (int t = bid * 4 + wave; t < S; t += nb * 4) {
        const float4* xr = (const float4*)(x + (size_t)t * D);
        float4 v[4];
        float ss = 0.f;
#pragma unroll
        for (int j = 0; j < 4; ++j) { v[j] = xr[lane + 64 * j]; ss += v[j].x * v[j].x + v[j].y * v[j].y + v[j].z * v[j].z + v[j].w * v[j].w; }
        ss = wave_sum(ss);
        const float rstd = rsqrtf(ss * (1.f / D) + EPS);
#pragma unroll
        for (int j = 0; j < 4; ++j) {
            const float4 gg = ((const float4*)g)[lane + 64 * j];
            uint2 o;
            o.x = pk2(v[j].x * rstd * gg.x, v[j].y * rstd * gg.y);
            o.y = pk2(v[j].z * rstd * gg.z, v[j].w * rstd * gg.w);
            ((uint2*)(hb + (size_t)t * D))[lane + 64 * j] = o;
        }
    }
}

__device__ __forceinline__ void phase_inproj(const Params& p, int bid, int nb, unsigned char* smem) {
    const int g2tid = tid_opaque();
    const bf16_t* hb = (const bf16_t*)(p.ws + WS_HB);
    const int lane = tid_opaque() & 63, fr = lane & 15;
    constexpr int NTN = (DIN + 127) / 128;
    for (int w = bid; w < 128 * NTN; w += nb) {
        const int mt = w % 128, nt = w / 128;
        const int m0 = mt * 128, n0 = nt * 128;
        const int ncols = (DIN - n0) < 128 ? (DIN - n0) : 128;
        f32x4 acc[4][4];
        gemm2<false, false>(hb, D, nullptr, m0, 128, (const bf16_t*)(p.ws + WB_IN), DIN, n0, ncols, D, smem, acc);
        const int cid = __builtin_amdgcn_readfirstlane((n0 >> 6) + ((tid_opaque() >> 6) & 1));
        if (cid > 80) continue;
        int kind; bf16_t* dst; int ld; const float* gain = nullptr; float scale = 1.f;
        if (cid < 8) { kind = 0; dst = (bf16_t*)(p.ws + WS_QNB) + cid * 64; ld = 512; gain = p.in[4]; scale = 0.125f * LOG2E; }
        else if (cid < 20) {
            const int j = cid - 8, kd = j >> 1, g = j & 1;
            ld = 64; kind = (kd == 2 || kd == 4) ? 0 : 1; gain = p.in[5];
            const size_t base = kd == 0 ? WS_KCR : kd == 1 ? WS_VCR : kd == 2 ? WS_KSLB : kd == 3 ? WS_VSLB : kd == 4 ? WS_KWNB : WS_VWNB;
            dst = (bf16_t*)(p.ws + base) + (size_t)g * S * 64;
        }
        else if (cid < 28) { kind = 0; dst = (bf16_t*)(p.ws + WS_DQB) + (cid - 20) * 64; ld = 512; gain = p.in[6]; scale = 0.125f * LOG2E; }
        else if (cid < 36) { kind = 0; dst = (bf16_t*)(p.ws + WS_DKB) + (cid - 28) * 64; ld = 512; gain = p.in[7]; }
        else if (cid < 44) { kind = 1; dst = (bf16_t*)(p.ws + WS_DVB) + (cid - 36) * 64; ld = 512; }
        else if (cid < 48) { kind = 1; dst = (bf16_t*)(p.ws + WS_IQB) + (cid - 44) * 64; ld = 256; scale = 0.17677669529663687f; }
        else if (cid < 64) { kind = 2; dst = (bf16_t*)(p.ws + WS_SGA) + (cid - 48) * 64; ld = D; }
        else if (cid < 80) { kind = 2; dst = (bf16_t*)(p.ws + WS_SGB) + (cid - 64) * 64; ld = D; }
        else { kind = 3; dst = nullptr; ld = 0; }
        if (kind == 0) {
            float gv[4];
#pragma unroll
            for (int j = 0; j < 4; ++j) gv[j] = gain[j * 16 + fr] * scale;
#pragma unroll
            for (int i = 0; i < 4; ++i) {
                float rstd[4];
#pragma unroll
                for (int r = 0; r < 4; ++r) {
                    float ss = acc[i][0][r] * acc[i][0][r] + acc[i][1][r] * acc[i][1][r] + acc[i][2][r] * acc[i][2][r] + acc[i][3][r] * acc[i][3][r];
                    ss += __shfl_xor(ss, 1); ss += __shfl_xor(ss, 2); ss += __shfl_xor(ss, 4); ss += __shfl_xor(ss, 8);
                    rstd[r] = rsqrtf(ss * (1.f / 64.f) + EPS);
                }
                bf16_t* dr = dst + (size_t)(m0 + G2_ROW(i, 0)) * ld + fr;
#pragma unroll
                for (int j = 0; j < 4; ++j)
                    store_bf16_frag(dr + j * 16, ld, acc[i][j][0] * rstd[0] * gv[j], acc[i][j][1] * rstd[1] * gv[j], acc[i][j][2] * rstd[2] * gv[j],
                                    acc[i][j][3] * rstd[3] * gv[j], lane);
            }
        } else if (kind == 1 || kind == 2) {
#pragma unroll
            for (int i = 0; i < 4; ++i) {
                bf16_t* dr = dst + (size_t)(m0 + G2_ROW(i, 0)) * ld + fr;
#pragma unroll
                for (int j = 0; j < 4; ++j) {
                    float v[4];
#pragma unroll
                    for (int r = 0; r < 4; ++r) v[r] = kind == 2 ? sigmoidf_(acc[i][j][r]) : acc[i][j][r] * scale;
                    store_bf16_frag(dr + j * 16, ld, v[0], v[1], v[2], v[3], lane);
                }
            }
        } else {
            bf16_t* ikb = (bf16_t*)(p.ws + WS_IKB);
            float* gt = (float*)(p.ws + WS_GT);
            float* iws = (float*)(p.ws + WS_IWS);
#pragma unroll
            for (int i = 0; i < 4; ++i) {
                bf16_t* ir = ikb + (size_t)(m0 + G2_ROW(i, 0)) * 32 + fr;
                store_bf16_frag(ir, 32, acc[i][0][0], acc[i][0][1], acc[i][0][2], acc[i][0][3], lane);
                store_bf16_frag(ir + 16, 32, acc[i][1][0], acc[i][1][1], acc[i][1][2], acc[i][1][3], lane);
#pragma unroll
                for (int r = 0; r < 4; ++r) {
                    const size_t t = (size_t)(m0 + G2_ROW(i, r));
                    gt[t * 32 + fr] = sigmoidf_(acc[i][2][r]);
                    if (fr < 8) gt[t * 32 + 16 + fr] = sigmoidf_(acc[i][3][r]);
                    else iws[t * 8 + fr - 8] = acc[i][3][r] * 0.35355339059327373f;
                }
            }
        }
    }
}

__device__ __forceinline__ float rms64(float v) { return rsqrtf(wave_sum(v * v) * (1.f / 64.f) + EPS); }

__device__ __forceinline__ void phase_compress(const Params& p, int bid, int nb, unsigned char* smem) {
    const int g2tid = tid_opaque();
    const int tid = tid_opaque(), lane = tid & 63, wave = tid >> 6;
    float* cvec = (float*)(smem + 36864);
    float* hid = (float*)(smem + 36864 + 256);
    bf16_t* pw = (bf16_t*)(p.ws + WS_PW);
    for (int w = bid; w < 32 + 128 * 8; w += nb) {
        const bool is_c = w < 32;
        const int kind = w >> 4, g = (w >> 3) & 1;
        const int w2_ = w - 32;
        const int m0 = is_c ? (w & 7) * 128 : (w2_ % 128) * 128;
        const int n0 = is_c ? 0 : (w2_ / 128) * 128;
        const int mrows = is_c ? ((NCMP - m0) < 128 ? (NCMP - m0) : 128) : 128;
        const bf16_t* Ap = is_c ? (const bf16_t*)(p.ws + (kind ? WS_VCR : WS_KCR)) + (size_t)g * S * 64 : (const bf16_t*)(p.ws + WS_PB);
        const bf16_t* Bp = is_c ? (const bf16_t*)(p.ws + (kind ? WB_CV1 : WB_CK1)) : (const bf16_t*)(p.ws + WB_PLE);
        f32x4 acc[4][4];
        gemm2<false, false>(Ap, is_c ? 16 * 64 : 256, nullptr, m0, mrows, Bp, is_c ? 64 : D, n0, is_c ? 64 : 128, is_c ? 2048 : 256, smem, acc);
        if (!is_c) {
#pragma unroll
            for (int i = 0; i < 4; ++i) {
                bf16_t* pr = pw + (size_t)(m0 + G2_ROW(i, 0)) * D + n0 + G2_COL(0);
#pragma unroll
                for (int j = 0; j < 4; ++j) store_bf16_frag(pr + j * 16, D, acc[i][j][0], acc[i][j][1], acc[i][j][2], acc[i][j][3], lane);
            }
            continue;
        }
        const float* pe = p.in[kind ? 11 : 8];
        const float* w1 = p.in[kind ? 12 : 9];
        const float* w2 = p.in[kind ? 13 : 10];
        {
            const int e = tid & 63, part = tid >> 6;
            float s = 0.f;
            for (int k = part * 512; k < part * 512 + 512; ++k) s += pe[k] * w1[(size_t)k * 64 + e];
            __syncthreads();
            hid[tid] = s;
            __syncthreads();
            if (tid < 64) cvec[tid] = hid[tid] + hid[64 + tid] + hid[128 + tid] + hid[192 + tid];
            __syncthreads();
        }
        if ((wave & 1) == 0) {
#pragma unroll
            for (int i = 0; i < 4; ++i)
#pragma unroll
                for (int j = 0; j < 4; ++j)
#pragma unroll
                    for (int r = 0; r < 4; ++r) {
                        const int row = G2_ROW(i, r), col = j * 16 + (lane & 15);
                        const float a = acc[i][j][r] + cvec[col];
                        hid[row * 65 + col] = a * sigmoidf_(a);
                    }
        }
        __syncthreads();
        const float gkn = p.in[5][lane];
        for (int row = wave; row < mrows; row += 4) {
            float o = 0.f;
#pragma unroll 8
            for (int e = 0; e < 64; ++e) o += hid[row * 65 + e] * w2[e * 64 + lane];
            if (kind == 0) o = o * rms64(o) * gkn;
            ((bf16_t*)(p.ws + (kind ? WS_VCB : WS_KCB)))[((size_t)g * 1024 + m0 + row) * 64 + lane] = (bf16_t)f2bf(o);
        }
        __syncthreads();
    }
    if (bid == nb - 1) {
        if (tid < 128) ((bf16_t*)(p.ws + WS_KCB))[((size_t)(tid >> 6) * 1024 + 1023) * 64 + (tid & 63)] = 0;
        else ((bf16_t*)(p.ws + WS_VCB))[((size_t)((tid - 128) >> 6) * 1024 + 1023) * 64 + (tid & 63)] = 0;
    }
}

constexpr int KSTR = 72;
constexpr int NSA_KT = 0;
constexpr int NSA_VT = NSA_KT + 32 * KSTR * 2;
constexpr int NSA_WV = NSA_VT + 32 * KSTR * 2;
constexpr int NSA_IMP = NSA_WV + 4 * 2 * 32 * KSTR * 2;
constexpr int NSA_LUT = NSA_IMP + 16 * 260 * 4;
constexpr int NSA_SEL = NSA_LUT + 4 * 128 * 4;
constexpr int NSA_STP = NSA_SEL + 16 * 16 * 4;
constexpr int NSA_END = NSA_STP + 4 * 128 * 4;
static_assert(NSA_END <= SMEM_BYTES, "nsa lds");

__device__ __forceinline__ f32x4 mfma16(bf16x8 a, bf16x8 b, f32x4 c) { return __builtin_amdgcn_mfma_f32_16x16x32_bf16(a, b, c, 0, 0, 0); }
__device__ __forceinline__ bf16x8 pack_p(const f32x4& p1, const f32x4& p2) {
    const unsigned a = pk2(p1[0], p1[1]), b = pk2(p1[2], p1[3]), c = pk2(p2[0], p2[1]), d = pk2(p2[2], p2[3]);
    return __builtin_bit_cast(bf16x8, make_uint4(a, b, c, d));
}
__device__ __forceinline__ void pv_step(f32x4 (&o)[4], const bf16_t* vt, bf16x8 pb, int fq, int fr) {
    const bf16_t* base = vt + (4 * fq + (fr >> 2)) * KSTR + 4 * (fr & 3);
#pragma unroll
    for (int dt = 0; dt < 4; ++dt) {
        const s16x4 lo4 = lds_tr16(base + dt * 16), hi4 = lds_tr16(base + 16 * KSTR + dt * 16);
        const bf16x8 va = (bf16x8){lo4[0], lo4[1], lo4[2], lo4[3], hi4[0], hi4[1], hi4[2], hi4[3]};
        o[dt] = mfma16(va, pb, o[dt]);
    }
}
__device__ __forceinline__ float quad_sum(float v) {
    v += __shfl_xor(v, 1);
    v += __shfl_xor(v, 2);
    return v;
}

__device__ __forceinline__ void nsa_tile(const Params& p, int tt, int g, unsigned char* smem) {
    const int tid = tid_opaque(), lane = tid & 63, wave = tid >> 6, fr = lane & 15, fq = lane >> 4;
    bf16_t* kt = (bf16_t*)(smem + NSA_KT);
    bf16_t* vt = (bf16_t*)(smem + NSA_VT);
    bf16_t* wv = (bf16_t*)(smem + NSA_WV) + wave * 2 * 32 * KSTR;
    float* imp = (float*)(smem + NSA_IMP);
    float* lut = (float*)(smem + NSA_LUT);
    int* sel = (int*)(smem + NSA_SEL);
    const bf16_t* qnb = (const bf16_t*)(p.ws + WS_QNB);
    const bf16_t* kslb = (const bf16_t*)(p.ws + WS_KSLB) + (size_t)g * S * 64;
    const bf16_t* vslb = (const bf16_t*)(p.ws + WS_VSLB) + (size_t)g * S * 64;
    const bf16_t* kwnb = (const bf16_t*)(p.ws + WS_KWNB) + (size_t)g * S * 64;
    const bf16_t* vwnb = (const bf16_t*)(p.ws + WS_VWNB) + (size_t)g * S * 64;
    const bf16_t* kcb = (const bf16_t*)(p.ws + WS_KCB) + (size_t)g * 1024 * 64;
    const bf16_t* vcb = (const bf16_t*)(p.ws + WS_VCB) + (size_t)g * 1024 * 64;
    const float* gt = (const float*)(p.ws + WS_GT);
    const float* relb = p.in[17];
    const int t0 = tt * 16;
    const int tl = 4 * wave + (fr >> 2);
    const int tok = t0 + tl;
    const int hl = fr & 3, head = g * 4 + hl;
    __syncthreads();
    for (int i = tid; i < 512; i += NT) { const int hh = i >> 7, n = i & 127; lut[i] = relb[bucket_of(n) * 16 + g * 4 + hh] * LOG2E; }
    for (int i = tid; i < 16 * 260; i += NT) imp[i] = 0.f;
    float U2;
    {
        const float mq = wave_max(fabsf(p.in[4][lane])), mk = wave_max(fabsf(p.in[5][lane]));
        float mb = 0.f;
#pragma unroll
        for (int k = 0; k < 4; ++k) { const int e = lane + 64 * k; mb = fmaxf(mb, fabsf(relb[(e >> 3) * 16 + (e & 7)])); }
        mb = wave_max(mb);
        U2 = (8.f * mq * mk + mb) * LOG2E;
    }
    bf16x8 qf[2];
#pragma unroll
    for (int kh = 0; kh < 2; ++kh) qf[kh] = *(const bf16x8*)(qnb + (size_t)tok * 512 + head * 64 + kh * 32 + fq * 8);
    __syncthreads();
    const float* lutp = lut + hl * 128;
    const float lutfar = lutp[127];
    const f32x4 zero4 = (f32x4){0.f, 0.f, 0.f, 0.f};
    f32x4 outacc[4];
#pragma unroll
    for (int dt = 0; dt < 4; ++dt) outacc[dt] = zero4;
    const float g0 = gt[(size_t)tok * 32 + head * 3 + 0], g1 = gt[(size_t)tok * 32 + head * 3 + 1], g2 = gt[(size_t)tok * 32 + head * 3 + 2];
    const int srow = tid >> 3, sch = tid & 7;

    bf16_t* ktb = (bf16_t*)(smem + NSA_WV);
    bf16_t* vtb = ktb + 2 * 64 * KSTR;
#define NSA_QK(KT_)                                                                                         \
        f32x4 s1 = zero4, s2 = zero4;                                                                       \
        _Pragma("unroll") for (int kh = 0; kh < 2; ++kh) {                                                  \
            const bf16x8 k1 = *(const bf16x8*)((KT_) + fr * KSTR + kh * 32 + fq * 8);                       \
            const bf16x8 k2 = *(const bf16x8*)((KT_) + (16 + fr) * KSTR + kh * 32 + fq * 8);                \
            s1 = mfma16(k1, qf[kh], s1);                                                                    \
            s2 = mfma16(k2, qf[kh], s2);                                                                    \
        }
    {
        int ks0 = (t0 - 511) & ~63; ks0 = ks0 < 0 ? 0 : ks0;
        const int nsteps = (t0 + 16 - ks0 + 63) >> 6;
        f32x4 o[4];
#pragma unroll
        for (int dt = 0; dt < 4; ++dt) o[dt] = zero4;
        float lsum = 0.f;
#define WIN_ROW(r_) ((r_) < S ? (r_) : S - 1)
        uint4 kr0 = *(const uint4*)(kwnb + (size_t)WIN_ROW(ks0 + srow) * 64 + sch * 8);
        uint4 kr1 = *(const uint4*)(kwnb + (size_t)WIN_ROW(ks0 + 32 + srow) * 64 + sch * 8);
        uint4 vr0 = *(const uint4*)(vwnb + (size_t)WIN_ROW(ks0 + srow) * 64 + sch * 8);
        uint4 vr1 = *(const uint4*)(vwnb + (size_t)WIN_ROW(ks0 + 32 + srow) * 64 + sch * 8);
#pragma unroll 1
        for (int st = 0; st < nsteps; ++st) {
            const int ksb = ks0 + st * 64;
            bf16_t* kt_ = ktb + (st & 1) * 64 * KSTR;
            bf16_t* vt_ = vtb + (st & 1) * 64 * KSTR;
            *(uint4*)(kt_ + srow * KSTR + sch * 8) = kr0; *(uint4*)(kt_ + (32 + srow) * KSTR + sch * 8) = kr1;
            *(uint4*)(vt_ + srow * KSTR + sch * 8) = vr0; *(uint4*)(vt_ + (32 + srow) * KSTR + sch * 8) = vr1;
            __syncthreads();
            if (st + 1 < nsteps) {
                kr0 = *(const uint4*)(kwnb + (size_t)WIN_ROW(ksb + 64 + srow) * 64 + sch * 8);
                kr1 = *(const uint4*)(kwnb + (size_t)WIN_ROW(ksb + 96 + srow) * 64 + sch * 8);
                vr0 = *(const uint4*)(vwnb + (size_t)WIN_ROW(ksb + 64 + srow) * 64 + sch * 8);
                vr1 = *(const uint4*)(vwnb + (size_t)WIN_ROW(ksb + 96 + srow) * 64 + sch * 8);
            }
#pragma unroll
            for (int hf = 0; hf < 2; ++hf) {
                const int ks = ksb + 32 * hf;
                if (ks > t0 + 15) continue;
                NSA_QK(kt_ + hf * 32 * KSTR)
                const bool far = (t0 + 4 * wave) - (ks + 31) >= 113;
                f32x4 p1, p2;
#pragma unroll
                for (int r = 0; r < 4; ++r) {
                    const int d1 = tok - (ks + 4 * fq + r), d2 = d1 - 16;
                    const float b1 = far ? lutfar : lutp[d1 < 0 ? 0 : (d1 > 127 ? 127 : d1)];
                    const float b2 = far ? lutfar : lutp[d2 < 0 ? 0 : (d2 > 127 ? 127 : d2)];
                    p1[r] = (d1 >= 0 && d1 < 512) ? __builtin_amdgcn_exp2f(s1[r] + b1 - U2) : 0.f;
                    p2[r] = (d2 >= 0 && d2 < 512) ? __builtin_amdgcn_exp2f(s2[r] + b2 - U2) : 0.f;
                    lsum += p1[r] + p2[r];
                }
                pv_step(o, vt_ + hf * 32 * KSTR, pack_p(p1, p2), fq, fr);
            }
        }
#undef WIN_ROW
        lsum += __shfl_xor(lsum, 16);
        lsum += __shfl_xor(lsum, 32);
        const float sc = lsum > 0.f ? g2 / lsum : 0.f;
#pragma unroll
        for (int dt = 0; dt < 4; ++dt)
#pragma unroll
            for (int r = 0; r < 4; ++r) outacc[dt][r] += sc * o[dt][r];
    }
    __syncthreads();

    {
        const int tlast = t0 + 15;
        const int cmax = (tlast >= 31) ? ((tlast - 31) >> 4) + 1 : 0;
        const int nsteps = (cmax + 63) >> 6;
        float inv_l = 0.f;
#pragma unroll 1
        for (int pass = 0; pass < 2; ++pass) {
            f32x4 o[4];
#pragma unroll
            for (int dt = 0; dt < 4; ++dt) o[dt] = zero4;
            float lsum = 0.f;
            uint4 kr0 = make_uint4(0, 0, 0, 0), kr1 = kr0, vr0 = kr0, vr1 = kr0;
            if (nsteps > 0) {
                kr0 = *(const uint4*)(kcb + (size_t)srow * 64 + sch * 8); kr1 = *(const uint4*)(kcb + (size_t)(32 + srow) * 64 + sch * 8);
                vr0 = *(const uint4*)(vcb + (size_t)srow * 64 + sch * 8); vr1 = *(const uint4*)(vcb + (size_t)(32 + srow) * 64 + sch * 8);
            }
#pragma unroll 1
            for (int st = 0; st < nsteps; ++st) {
                const int csb = st * 64;
                bf16_t* kt_ = ktb + (st & 1) * 64 * KSTR;
                bf16_t* vt_ = vtb + (st & 1) * 64 * KSTR;
                *(uint4*)(kt_ + srow * KSTR + sch * 8) = kr0; *(uint4*)(kt_ + (32 + srow) * KSTR + sch * 8) = kr1;
                *(uint4*)(vt_ + srow * KSTR + sch * 8) = vr0; *(uint4*)(vt_ + (32 + srow) * KSTR + sch * 8) = vr1;
                __syncthreads();
                if (st + 1 < nsteps) {
                    kr0 = *(const uint4*)(kcb + (size_t)(csb + 64 + srow) * 64 + sch * 8); kr1 = *(const uint4*)(kcb + (size_t)(csb + 96 + srow) * 64 + sch * 8);
                    vr0 = *(const uint4*)(vcb + (size_t)(csb + 64 + srow) * 64 + sch * 8); vr1 = *(const uint4*)(vcb + (size_t)(csb + 96 + srow) * 64 + sch * 8);
                }
#pragma unroll
                for (int hf = 0; hf < 2; ++hf) {
                    const int cs = csb + 32 * hf;
                    if (cs >= cmax) continue;
                    NSA_QK(kt_ + hf * 32 * KSTR)
                    const bool far = (t0 + 4 * wave) - (16 * (cs + 31) + 31) >= 113;
                    f32x4 p1, p2;
#pragma unroll
                    for (int r = 0; r < 4; ++r) {
                        const int d1 = tok - (16 * (cs + 4 * fq + r) + 31), d2 = d1 - 256;
                        const float b1 = far ? lutfar : lutp[d1 < 0 ? 0 : (d1 > 127 ? 127 : d1)];
                        const float b2 = far ? lutfar : lutp[d2 < 0 ? 0 : (d2 > 127 ? 127 : d2)];
                        p1[r] = (d1 >= 0) ? __builtin_amdgcn_exp2f(s1[r] + b1 - U2) : 0.f;
                        p2[r] = (d2 >= 0) ? __builtin_amdgcn_exp2f(s2[r] + b2 - U2) : 0.f;
                        lsum += p1[r] + p2[r];
                    }
                    if (pass == 1) {
#pragma unroll
                        for (int r = 0; r < 4; ++r) { p1[r] *= inv_l; p2[r] *= inv_l; }
                        f32x4 h1, h2;
#pragma unroll
                        for (int r = 0; r < 4; ++r) { h1[r] = quad_sum(p1[r]); h2[r] = quad_sum(p2[r]); }
                        if (hl == 0) {
                            float* ir = imp + tl * 260 + (cs >> 2) + fq;
                            atomicAdd(ir, h1[0] + h1[1] + h1[2] + 0.5f * h1[3]);
                            atomicAdd(ir + 1, 0.5f * h1[3]);
                            atomicAdd(ir + 4, h2[0] + h2[1] + h2[2] + 0.5f * h2[3]);
                            atomicAdd(ir + 5, 0.5f * h2[3]);
                        }
                        pv_step(o, vt_ + hf * 32 * KSTR, pack_p(p1, p2), fq, fr);
                    }
                }
            }
            __syncthreads();
            if (pass == 0) {
                lsum += __shfl_xor(lsum, 16);
                lsum += __shfl_xor(lsum, 32);
                inv_l = lsum > 0.f ? 1.f / lsum : 0.f;
            } else {
#pragma unroll
                for (int dt = 0; dt < 4; ++dt)
#pragma unroll
                    for (int r = 0; r < 4; ++r) outacc[dt][r] += g0 * o[dt][r];
            }
        }
    }
#undef NSA_QK
    __syncthreads();

#pragma unroll 1
    for (int tq = 0; tq < 4; ++tq) {
        const int tli = 4 * wave + tq, tk = t0 + tli, cur = tk >> 6;
        int* sl = sel + tli * 16;
        int nf = 0;
        if (lane == 0) {
            sl[0] = 0; int c_ = 1;
            if (cur - 1 >= 1) sl[c_++] = cur - 1;
            if (cur >= 1) sl[c_++] = cur;
            for (int k = c_; k < 16; ++k) sl[k] = -1;
        }
        nf = 1 + (cur - 1 >= 1 ? 1 : 0) + (cur >= 1 ? 1 : 0);
        const int ncand = cur - 2 > 0 ? cur - 2 : 0;
        int need = 16 - nf; need = need < ncand ? need : ncand;
        unsigned long long key[4];
#pragma unroll
        for (int k = 0; k < 4; ++k) {
            const int n = lane + 64 * k;
            const bool c = (n >= 1) && (n <= cur - 2);
            key[k] = c ? (((unsigned long long)__builtin_bit_cast(unsigned, imp[tli * 260 + n]) << 32) | (unsigned long long)(0xFFFFFFFFu - (unsigned)n)) + (1ull << 32) : 0ull;
        }
#pragma unroll 1
        for (int rd = 0; rd < need; ++rd) {
            unsigned long long m = key[0];
            m = key[1] > m ? key[1] : m; m = key[2] > m ? key[2] : m; m = key[3] > m ? key[3] : m;
#pragma unroll
            for (int o_ = 1; o_ < 64; o_ <<= 1) {
                const unsigned lo_ = __shfl_xor((unsigned)m, o_), hi_ = __shfl_xor((unsigned)(m >> 32), o_);
                const unsigned long long other = ((unsigned long long)hi_ << 32) | lo_;
                m = other > m ? other : m;
            }
            const int nstar = (int)(0xFFFFFFFFu - (unsigned)m);
#pragma unroll
            for (int k = 0; k < 4; ++k) if (key[k] == m) key[k] = 0ull;
            if (lane == 0) sl[nf + rd] = nstar;
        }
    }
    __syncthreads();

    {
        int* stp = (int*)(smem + NSA_STP) + wave * 128;
        int nst;
        {
            const int tq = lane >> 4, j = lane & 15;
            const int cur_ = (t0 + 4 * wave) >> 6;
            const int nf_ = 1 + (cur_ - 1 >= 1 ? 1 : 0) + (cur_ >= 1 ? 1 : 0);
            const bool shared = j < nf_;
            const int tk_ = shared ? t0 + 4 * wave + 3 : t0 + 4 * wave + tq;
            const int b = (shared && tq != 0) ? -1 : sel[(4 * wave + tq) * 16 + j];
            const int tqc = shared ? 4 : tq;
            const bool c1 = (b >= 0) && (b * 64 <= tk_), c2 = (b >= 0) && (b * 64 + 32 <= tk_);
            const unsigned long long m1 = __ballot(c1), m2 = __ballot(c2);
            const unsigned long long lt = (1ull << lane) - 1ull;
            const int pos = __builtin_popcountll(m1 & lt) + __builtin_popcountll(m2 & lt);
            if (c1) stp[pos] = (b * 64) | (tqc << 20);
            if (c2) stp[pos + 1] = (b * 64 + 32) | (tqc << 20);
            nst = __builtin_popcountll(m1) + __builtin_popcountll(m2);
        }
        asm volatile("" ::: "memory");
        uint2 oacc_pk[4];
#pragma unroll
        for (int dt = 0; dt < 4; ++dt) { oacc_pk[dt].x = pk2(outacc[dt][0], outacc[dt][1]); oacc_pk[dt].y = pk2(outacc[dt][2], outacc[dt][3]); }
        f32x4 o[4];
#pragma unroll
        for (int dt = 0; dt < 4; ++dt) o[dt] = zero4;
        float lsum = 0.f;
        const int r8 = lane >> 3, c8 = lane & 7;
        bf16_t* slot0 = wv;
        bf16_t* slot1 = wv + 32 * KSTR;
        bf16_t* kslot = (bf16_t*)(smem + NSA_IMP) + wave * 32 * 64;
        uint4 ka0, ka1, ka2, ka3, kb0, kb1, kb2, kb3;
        uint4 va0, va1, va2, va3;
#define SLC_STEP(i_) __builtin_amdgcn_readfirstlane(stp[(i_) < nst ? (i_) : nst - 1])
#define SLC_KLOAD(K_, w_)                                                                                           \
        { const uint4* kp_ = (const uint4*)(kslb + (size_t)(((w_) & 0xFFFFF) + r8) * 64 + c8 * 8);                      \
          K_##0 = kp_[0]; K_##1 = kp_[64]; K_##2 = kp_[128]; K_##3 = kp_[192]; }
#define SLC_VLOAD(V_, w_)                                                                                           \
        { const uint4* vs_ = (const uint4*)(vslb + (size_t)(((w_) & 0xFFFFF) + r8) * 64 + c8 * 8);                      \
          V_##0 = vs_[0]; V_##1 = vs_[64]; V_##2 = vs_[128]; V_##3 = vs_[192]; }
#define SLC_VSTORE(V_, slot_)                                                                                       \
        { bf16_t* vd_ = (slot_) + r8 * KSTR + c8 * 8;                                                               \
          *(uint4*)(vd_) = V_##0; *(uint4*)(vd_ + 8 * KSTR) = V_##1; *(uint4*)(vd_ + 16 * KSTR) = V_##2; *(uint4*)(vd_ + 24 * KSTR) = V_##3; }
#define SLC_KSTORE(K_)                                                                                              \
        { bf16_t* kd_ = kslot + r8 * 64 + ((c8 ^ r8) * 8);                                                          \
          *(uint4*)(kd_) = K_##0; *(uint4*)(kd_ + 8 * 64) = K_##1; *(uint4*)(kd_ + 16 * 64) = K_##2; *(uint4*)(kd_ + 24 * 64) = K_##3; }
#define SLC_STAGE(s_, K_, VW_, slotr_, slotw_)                                                                      \
        {                                                                                                           \
            const int wcur = SLC_STEP(s_), wk = SLC_STEP((s_) + 2);                                                 \
            SLC_KSTORE(K_)                                                            \
            SLC_VSTORE(VW_, slotw_)                                                      \
            asm volatile("" ::: "memory");                                                                          \
            SLC_VLOAD(VW_, wk)                                                                     \
            SLC_KLOAD(K_, wk)                                                                      \
            f32x4 s1 = zero4, s2 = zero4;                                                                           \
            _Pragma("unroll") for (int kh = 0; kh < 2; ++kh) {                                                      \
                const bf16x8 k1 = *(const bf16x8*)(kslot + fr * 64 + (((kh * 4 + fq) ^ (fr & 7)) * 8));             \
                const bf16x8 k2 = *(const bf16x8*)(kslot + (16 + fr) * 64 + (((kh * 4 + fq) ^ (fr & 7)) * 8));      \
                s1 = mfma16(k1, qf[kh], s1); s2 = mfma16(k2, qf[kh], s2);                                           \
            }                                                                                                       \
            const int ks = wcur & 0xFFFFF, tq = wcur >> 20;                                                         \
            const bool mine = (tq == 4) || ((fr >> 2) == tq);                                                       \
            const bool far = (t0 + 4 * wave + (tq == 4 ? 0 : tq)) - (ks + 31) >= 113;                               \
            f32x4 p1, p2;                                                                                           \
            _Pragma("unroll") for (int r = 0; r < 4; ++r) {                                                         \
                const int d1 = tok - (ks + 4 * fq + r), d2 = d1 - 16;                                               \
                const float b1 = far ? lutfar : lutp[d1 < 0 ? 0 : (d1 > 127 ? 127 : d1)];                           \
                const float b2 = far ? lutfar : lutp[d2 < 0 ? 0 : (d2 > 127 ? 127 : d2)];                           \
                p1[r] = (mine && d1 >= 0) ? __builtin_amdgcn_exp2f(s1[r] + b1 - U2) : 0.f;                          \
                p2[r] = (mine && d2 >= 0) ? __builtin_amdgcn_exp2f(s2[r] + b2 - U2) : 0.f;                          \
                lsum += p1[r] + p2[r];                                                                              \
            }                                                                                                       \
            asm volatile("" ::: "memory");                                                                          \
            pv_step(o, slotr_, pack_p(p1, p2), fq, fr);                                                             \
            asm volatile("" ::: "memory");                                                                          \
        }
        {
            const int w0 = SLC_STEP(0), w1 = SLC_STEP(1);
            SLC_VLOAD(va, w0)
            SLC_KLOAD(ka, w0)
            SLC_KLOAD(kb, w1)
            SLC_VSTORE(va, slot0)
            SLC_VLOAD(va, w1)
        }
#pragma unroll 1
        for (int s = 0; s < nst; s += 2) {
            SLC_STAGE(s, ka, va, slot0, slot1)
            if (s + 1 < nst) SLC_STAGE(s + 1, kb, va, slot1, slot0)
        }
#undef SLC_STEP
#undef SLC_KLOAD
#undef SLC_VLOAD
#undef SLC_VSTORE
#undef SLC_KSTORE
#undef SLC_STAGE
        lsum += __shfl_xor(lsum, 16);
        lsum += __shfl_xor(lsum, 32);
        const float sc = lsum > 0.f ? g1 / lsum : 0.f;
#pragma unroll
        for (int dt = 0; dt < 4; ++dt) {
            outacc[dt][0] = __builtin_bit_cast(float, oacc_pk[dt].x << 16) + sc * o[dt][0];
            outacc[dt][1] = __builtin_bit_cast(float, oacc_pk[dt].x & 0xffff0000u) + sc * o[dt][1];
            outacc[dt][2] = __builtin_bit_cast(float, oacc_pk[dt].y << 16) + sc * o[dt][2];
            outacc[dt][3] = __builtin_bit_cast(float, oacc_pk[dt].y & 0xffff0000u) + sc * o[dt][3];
        }
    }
    bf16_t* orow = (bf16_t*)(p.ws + WS_OA) + (size_t)tok * 512 + head * 64 + 4 * fq;
#pragma unroll
    for (int dt = 0; dt < 4; ++dt) {
        uint2 v; v.x = pk2(outacc[dt][0], outacc[dt][1]); v.y = pk2(outacc[dt][2], outacc[dt][3]);
        *(uint2*)(orow + dt * 16) = v;
    }
}

typedef float f32x16 __attribute__((ext_vector_type(16)));
constexpr int DSA_CK = 0;
constexpr int DSA_CI = DSA_CK + 16 * 512 * 4;
constexpr int DSA_LUT = DSA_CI + 16 * 512 * 2;
constexpr int DSA_END = DSA_LUT + 8 * 128 * 4;
static_assert(DSA_END <= SMEM_BYTES, "dsa lds");

__device__ __forceinline__ unsigned mono_key(float s) {
    const unsigned u = __builtin_bit_cast(unsigned, s + 0.0f);
    return (u & 0x80000000u) ? ~u : (u | 0x80000000u);
}
__device__ __forceinline__ unsigned dsa_compact(unsigned* ck, unsigned short* ci, int n, int lane) {
    unsigned kk[8]; unsigned ii[8];
#pragma unroll
    for (int k = 0; k < 8; ++k) { const int e = lane + 64 * k; kk[k] = e < n ? ck[e] : 0u; ii[k] = e < n ? (unsigned)ci[e] : 0xFFFFu; }
    unsigned T = 0;
#pragma unroll 1
    for (int b = 31; b >= 0; --b) {
        const unsigned cand = T | (1u << b);
        int c = 0;
#pragma unroll
        for (int k = 0; k < 8; ++k) c += __builtin_popcountll(__ballot(kk[k] >= cand));
        if (c >= 256) T = cand;
    }
    int cgt = 0, ceq = 0;
#pragma unroll
    for (int k = 0; k < 8; ++k) { cgt += __builtin_popcountll(__ballot(kk[k] > T)); ceq += __builtin_popcountll(__ballot(kk[k] == T)); }
    const int need = 256 - cgt;
    unsigned X = 0xFFFFu;
    if (ceq > need) {
        X = 0;
#pragma unroll 1
        for (int b = 15; b >= 0; --b) {
            const unsigned cand = X | (1u << b);
            int c = 0;
#pragma unroll
            for (int k = 0; k < 8; ++k) c += __builtin_popcountll(__ballot(kk[k] == T && ii[k] < cand));
            if (c < need) X = cand;
        }
    }
    int base = 0;
    const unsigned long long lt = (1ull << lane) - 1ull;
#pragma unroll
    for (int k = 0; k < 8; ++k) {
        const bool keep = (kk[k] > T) || (kk[k] == T && ii[k] <= X);
        const unsigned long long m = __ballot(keep);
        if (keep) { const int pos = base + __builtin_popcountll(m & lt); ck[pos] = kk[k]; ci[pos] = (unsigned short)ii[k]; }
        base += __builtin_popcountll(m);
    }
    return T;
}

__device__ __forceinline__ void dsa_tile(const Params& p, int tt, unsigned char* smem) {
    const int tid = tid_opaque(), lane = tid & 63, wave = tid >> 6, col = lane & 31, hi = lane >> 5;
    unsigned* ckb = (unsigned*)(smem + DSA_CK);
    unsigned short* cib = (unsigned short*)(smem + DSA_CI);
    const bf16_t* iqb = (const bf16_t*)(p.ws + WS_IQB);
    const bf16_t* ikb = (const bf16_t*)(p.ws + WS_IKB);
    const float* iws = (const float*)(p.ws + WS_IWS);
    const int t0 = tt * 16;
    __syncthreads();
    const int tw = t0 + 4 * wave;
    bf16x8 af[2];
    {
        const int rho = col;
        const int tl_ = 2 * ((rho >> 2) & 1) + (rho >> 4), hd = 4 * ((rho >> 3) & 1) + (rho & 3);
#pragma unroll
        for (int ks = 0; ks < 2; ++ks) af[ks] = *(const bf16x8*)(iqb + (size_t)(tw + tl_) * 256 + hd * 32 + ks * 16 + hi * 8);
    }
    const int tokA = tw + 2 * hi, tokB = tokA + 1;
    float wA[8], wB[8];
#pragma unroll
    for (int h = 0; h < 8; ++h) { wA[h] = iws[(size_t)tokA * 8 + h]; wB[h] = iws[(size_t)tokB * 8 + h]; }
    unsigned* ckA = ckb + (4 * wave + 2 * hi) * 512;
    unsigned* ckB = ckA + 512;
    unsigned short* ciA = cib + (4 * wave + 2 * hi) * 512;
    unsigned short* ciB = ciA + 512;
    int cntA = 0, cntB = 0;
    unsigned LA = 0, LB = 0;
    const unsigned ltm = (1u << col) - 1u;
    const int nchunk = (tw + 4 + 31) >> 5;
    const f32x16 zero16 = {0.f, 0.f, 0.f, 0.f, 0.f, 0.f, 0.f, 0.f, 0.f, 0.f, 0.f, 0.f, 0.f, 0.f, 0.f, 0.f};
    bf16x8 nx0[4], nx1[4];
    const bf16_t* ikl = ikb + (size_t)col * 32 + hi * 8;
#pragma unroll
    for (int j = 0; j < 4; ++j) {
        const int cj = j < nchunk ? j : nchunk - 1;
        nx0[j] = *(const bf16x8*)(ikl + (size_t)cj * 1024); nx1[j] = *(const bf16x8*)(ikl + (size_t)cj * 1024 + 16);
    }
#pragma unroll 1
    for (int ch4 = 0; ch4 < nchunk; ch4 += 4) {
#pragma unroll
        for (int j = 0; j < 4; ++j) {
            const int ch = ch4 + j;
            const bf16x8 cu0 = nx0[j], cu1 = nx1[j];
            {
                int cj = ch + 4; cj = cj < nchunk ? cj : nchunk - 1;
                nx0[j] = *(const bf16x8*)(ikl + (size_t)cj * 1024); nx1[j] = *(const bf16x8*)(ikl + (size_t)cj * 1024 + 16);
            }
            if (ch < nchunk) {
                const int kidx = ch * 32 + col;
                f32x16 c = __builtin_amdgcn_mfma_f32_32x32x16_bf16(af[0], cu0, zero16, 0, 0, 0);
                c = __builtin_amdgcn_mfma_f32_32x32x16_bf16(af[1], cu1, c, 0, 0, 0);
                float sA = 0.f, sB = 0.f;
#pragma unroll
                for (int h = 0; h < 8; ++h) { sA += wA[h] * fmaxf(c[h], 0.f); sB += wB[h] * fmaxf(c[8 + h], 0.f); }
                const unsigned keyA = mono_key(sA), keyB = mono_key(sB);
                const bool pA = (kidx <= tokA) && (keyA > LA), pB = (kidx <= tokB) && (keyB > LB);
                const unsigned long long mA = __ballot(pA), mB = __ballot(pB);
                const unsigned hA = hi ? (unsigned)(mA >> 32) : (unsigned)mA, hB = hi ? (unsigned)(mB >> 32) : (unsigned)mB;
                if (pA) { const int pos = cntA + __builtin_popcount(hA & ltm); ckA[pos] = keyA; ciA[pos] = (unsigned short)kidx; }
                if (pB) { const int pos = cntB + __builtin_popcount(hB & ltm); ckB[pos] = keyB; ciB[pos] = (unsigned short)kidx; }
                cntA += __builtin_popcount(hA); cntB += __builtin_popcount(hB);
            }
            if (!(j & 1)) continue;
        if (__any((cntA > 448) || (cntB > 448))) {
#pragma unroll
            for (int tq = 0; tq < 4; ++tq) {
                const int cn = __shfl((tq & 1) ? cntB : cntA, (tq >> 1) * 32);
                if (cn > 448) {
                    const unsigned T = dsa_compact(ckb + (4 * wave + tq) * 512, cib + (4 * wave + tq) * 512, cn, lane);
                    if (hi == (tq >> 1)) { if (tq & 1) { cntB = 256; LB = T; } else { cntA = 256; LA = T; } }
                }
            }
        }
    }
    }
#pragma unroll
    for (int tq = 0; tq < 4; ++tq) {
        const int cn = __shfl((tq & 1) ? cntB : cntA, (tq >> 1) * 32);
        if (cn > 256) {
            (void)dsa_compact(ckb + (4 * wave + tq) * 512, cib + (4 * wave + tq) * 512, cn, lane);
            if (hi == (tq >> 1)) { if (tq & 1) cntB = 256; else cntA = 256; }
        }
    }
    unsigned short* selg = (unsigned short*)(p.ws + WS_SEL);
    int* nselg = (int*)(p.ws + WS_NSEL);
#pragma unroll
    for (int tq = 0; tq < 4; ++tq) {
        int nsel = __shfl((tq & 1) ? cntB : cntA, (tq >> 1) * 32);
        nsel = nsel > 256 ? 256 : nsel;
        const unsigned short* sl = cib + (4 * wave + tq) * 512;
#pragma unroll
        for (int k = 0; k < 4; ++k) { const int e = lane + 64 * k; selg[(size_t)(tw + tq) * 256 + e] = e < nsel ? sl[e] : (unsigned short)0; }
        if (lane == 0) nselg[tw + tq] = nsel;
    }
}

__device__ __forceinline__ void phase_dsa_attn(const Params& p, int bid, int nb, unsigned char* smem) {
    const int tid = tid_opaque(), lane = tid & 63, wave = tid >> 6, slot = lane >> 3, chunk = lane & 7;
    float* lut = (float*)smem;
    const bf16_t* dqb = (const bf16_t*)(p.ws + WS_DQB);
    const bf16_t* dkb = (const bf16_t*)(p.ws + WS_DKB);
    const bf16_t* dvb = (const bf16_t*)(p.ws + WS_DVB);
    const unsigned short* selg = (const unsigned short*)(p.ws + WS_SEL);
    const int* nselg = (const int*)(p.ws + WS_NSEL);
    const float* relb = p.in[17];
    const int h = bid & 7, bh = bid >> 3, nbh = nb >> 3;
    __syncthreads();
    if (tid < 128) lut[tid] = relb[bucket_of(tid) * 16 + 8 + h] * LOG2E;
    float U2;
    {
        const float mq = wave_max(fabsf(p.in[6][lane])), mk = wave_max(fabsf(p.in[7][lane]));
        float mb = 0.f;
#pragma unroll
        for (int k = 0; k < 4; ++k) { const int e = lane + 64 * k; mb = fmaxf(mb, fabsf(relb[(e >> 3) * 16 + 8 + (e & 7)])); }
        mb = wave_max(mb);
        U2 = (8.f * mq * mk + mb) * LOG2E;
    }
    __syncthreads();
    const bf16_t* kbase = dkb + h * 64 + chunk * 8;
    const bf16_t* vbase = dvb + h * 64 + chunk * 8;
#pragma unroll 1
    for (int t = bh * 4 + wave; t < S; t += nbh * 4) {
        const int nsel = nselg[t];
        const uint2* ip = (const uint2*)(selg + (size_t)t * 256 + slot * 32);
        float q[8];
        {
            const uint4 qv = *(const uint4*)(dqb + (size_t)t * 512 + h * 64 + chunk * 8);
            q[0] = __builtin_bit_cast(float, qv.x << 16); q[1] = __builtin_bit_cast(float, qv.x & 0xffff0000u);
            q[2] = __builtin_bit_cast(float, qv.y << 16); q[3] = __builtin_bit_cast(float, qv.y & 0xffff0000u);
            q[4] = __builtin_bit_cast(float, qv.z << 16); q[5] = __builtin_bit_cast(float, qv.z & 0xffff0000u);
            q[6] = __builtin_bit_cast(float, qv.w << 16); q[7] = __builtin_bit_cast(float, qv.w & 0xffff0000u);
        }
        float o[8];
#pragma unroll
        for (int j = 0; j < 8; ++j) o[j] = 0.f;
        float lsum = 0.f;
        int sA_[4], sB_[4];
        uint4 kA_[4], vA_[4], kB_[4], vB_[4];
        uint2 idn = ip[0];
#define DSA_LOADG(S_, K_, V_, I_)                                                        \
        S_[0] = (int)((I_).x & 0xffffu); S_[1] = (int)((I_).x >> 16); S_[2] = (int)((I_).y & 0xffffu); S_[3] = (int)((I_).y >> 16); \
        _Pragma("unroll") for (int j = 0; j < 4; ++j) {                                 \
            K_[j] = *(const uint4*)(kbase + (size_t)S_[j] * 512);                        \
            V_[j] = *(const uint4*)(vbase + (size_t)S_[j] * 512);                        \
        }
#define DSA_COMPG(S_, K_, V_, gi)                                                        \
        _Pragma("unroll") for (int j = 0; j < 4; ++j) {                                 \
            const uint4 kv = K_[j], vv = V_[j];                                          \
            float d = q[0] * __builtin_bit_cast(float, kv.x << 16) + q[1] * __builtin_bit_cast(float, kv.x & 0xffff0000u) \
                    + q[2] * __builtin_bit_cast(float, kv.y << 16) + q[3] * __builtin_bit_cast(float, kv.y & 0xffff0000u) \
                    + q[4] * __builtin_bit_cast(float, kv.z << 16) + q[5] * __builtin_bit_cast(float, kv.z & 0xffff0000u) \
                    + q[6] * __builtin_bit_cast(float, kv.w << 16) + q[7] * __builtin_bit_cast(float, kv.w & 0xffff0000u); \
            d += __shfl_xor(d, 1); d += __shfl_xor(d, 2); d += __shfl_xor(d, 4);       \
            int dist = t - S_[j]; dist = dist > 127 ? 127 : (dist < 0 ? 0 : dist);       \
            float pr = __builtin_amdgcn_exp2f(d + lut[dist] - U2);                       \
            pr = (slot * 32 + (gi) * 4 + j < nsel) ? pr : 0.f;                           \
            lsum += pr;                                                                  \
            o[0] += pr * __builtin_bit_cast(float, vv.x << 16); o[1] += pr * __builtin_bit_cast(float, vv.x & 0xffff0000u); \
            o[2] += pr * __builtin_bit_cast(float, vv.y << 16); o[3] += pr * __builtin_bit_cast(float, vv.y & 0xffff0000u); \
            o[4] += pr * __builtin_bit_cast(float, vv.z << 16); o[5] += pr * __builtin_bit_cast(float, vv.z & 0xffff0000u); \
            o[6] += pr * __builtin_bit_cast(float, vv.w << 16); o[7] += pr * __builtin_bit_cast(float, vv.w & 0xffff0000u); \
        }
        DSA_LOADG(sA_, kA_, vA_, idn)
        idn = ip[1];
#pragma unroll 1
        for (int gi = 0; gi < 8; gi += 2) {
            DSA_LOADG(sB_, kB_, vB_, idn)
            idn = ip[gi + 2 < 8 ? gi + 2 : 7];
            DSA_COMPG(sA_, kA_, vA_, gi)
            DSA_LOADG(sA_, kA_, vA_, idn)
            idn = ip[gi + 3 < 8 ? gi + 3 : 7];
            DSA_COMPG(sB_, kB_, vB_, gi + 1)
        }
#undef DSA_LOADG
#undef DSA_COMPG
#pragma unroll
        for (int j = 0; j < 8; ++j) { o[j] += __shfl_xor(o[j], 8); o[j] += __shfl_xor(o[j], 16); o[j] += __shfl_xor(o[j], 32); }
        lsum += __shfl_xor(lsum, 8); lsum += __shfl_xor(lsum, 16); lsum += __shfl_xor(lsum, 32);
        if (slot == 0) {
            const float inv = lsum > 0.f ? 1.f / lsum : 0.f;
            uint4 ov;
            ov.x = pk2(o[0] * inv, o[1] * inv); ov.y = pk2(o[2] * inv, o[3] * inv); ov.z = pk2(o[4] * inv, o[5] * inv); ov.w = pk2(o[6] * inv, o[7] * inv);
            *(uint4*)((bf16_t*)(p.ws + WS_OB) + (size_t)t * 512 + h * 64 + chunk * 8) = ov;
        }
    }
}

__device__ __forceinline__ void convert_late_weights(const Params& p, int bid, int nb) {
    cvt_weights(p.in[21], (bf16_t*)(p.ws + WB_E1), (size_t)NEXP * D * 2 * DFF, bid, nb);
    cvt_weights(p.in[23], (bf16_t*)(p.ws + WB_E2), (size_t)NEXP * DFF * D, bid, nb);
    cvt_weights(p.in[27], (bf16_t*)(p.ws + WB_PLEG), (size_t)D * D, bid, nb);
}
__device__ __forceinline__ void phase_attn(const Params& p, int bid, int nb, unsigned char* smem) {
    const bool conv_first = bid < (nb >> 1);
    if (conv_first) convert_late_weights(p, bid, nb);
#pragma unroll 1
    for (int part = 0; part < 2; ++part) {
        if ((part == 0) == conv_first) {
#pragma unroll 1
        for (int w = bid, rd = 0; w < 1024; w += nb, ++rd) {
            const int r0 = w - bid;
            const int cnt = (1024 - r0) < nb ? (1024 - r0) : nb;
            const int k = (rd & 1) ? (cnt - 1 - bid) : bid;
            dsa_tile(p, 1023 - (r0 + k), smem);
        }
    }
        else {
#pragma unroll 1
        for (int i = bid, rd = 0; i < 2048; i += nb, ++rd) {
            const int r0 = i - bid;
            const int cnt = (2048 - r0) < nb ? (2048 - r0) : nb;
            const int k = ((rd & 1) && !(cnt & 1)) ? 2 * ((cnt >> 1) - 1 - (bid >> 1)) + (bid & 1) : bid;
            const int j = r0 + k;
            nsa_tile(p, 1023 - (j >> 1), j & 1, smem);
        }
    }
    }
    if (!conv_first) convert_late_weights(p, bid, nb);
}

template <int PASS>
__device__ __forceinline__ void phase_merge(const Params& p, int bid, int nb, unsigned char* smem) {
    const int g2tid = tid_opaque();
    const bf16_t* sg = (const bf16_t*)(p.ws + (PASS ? WS_SGB : WS_SGA));
    bf16_t* merged = (bf16_t*)(p.ws + WS_MERGED);
    float* tmp = (float*)(p.ws + WS_X1);
    const bf16_t* A = (const bf16_t*)(p.ws + (PASS ? WS_OB : WS_OA));
    const bf16_t* Bw = (const bf16_t*)(p.ws + (PASS ? WB_B : WB_A));
    for (int w = bid; w < 128 * 8; w += nb) {
        const int mt = w % 128, nt = w / 128;
        const int m0 = mt * 128, n0 = nt * 128;
        f32x4 acc[4][4];
        gemm2<false, false>(A, 512, nullptr, m0, 128, Bw, D, n0, 128, 512, smem, acc);
#pragma unroll
        for (int i = 0; i < 4; ++i) {
            float vv[4][4];
#pragma unroll
            for (int r = 0; r < 4; ++r) {
                const int row = m0 + G2_ROW(i, r);
                const bf16_t* zr = sg + (size_t)row * D + n0 + G2_COL(0);
                float* tr = tmp + (size_t)row * D + n0 + G2_COL(0);
#pragma unroll
                for (int j = 0; j < 4; ++j) {
                    const float v = bf2f(zr[j * 16]) * acc[i][j][r];
                    if (PASS == 0) tr[j * 16] = v;
                    else vv[j][r] = tr[j * 16] + v;
                }
            }
            if (PASS == 1) {
                bf16_t* mr = merged + (size_t)(m0 + G2_ROW(i, 0)) * D + n0 + G2_COL(0);
#pragma unroll
                for (int j = 0; j < 4; ++j) store_bf16_frag(mr + j * 16, D, vv[j][0], vv[j][1], vv[j][2], vv[j][3], g2tid & 63);
            }
        }
    }
}

__device__ __forceinline__ void phase_outproj(const Params& p, int bid, int nb, unsigned char* smem) {
    const int g2tid = tid_opaque();
    const bf16_t* merged = (const bf16_t*)(p.ws + WS_MERGED);
    const float* x = p.in[0];
    float* x1 = (float*)(p.ws + WS_X1);
    for (int w = bid; w < 128 * 8; w += nb) {
        const int mt = w % 128, nt = w / 128;
        const int m0 = mt * 128, n0 = nt * 128;
        f32x4 acc[4][4];
        gemm2<false, false>(merged, D, nullptr, m0, 128, (const bf16_t*)(p.ws + WB_OUT), D, n0, 128, D, smem, acc);
#pragma unroll
        for (int i = 0; i < 4; ++i)
#pragma unroll
            for (int r = 0; r < 4; ++r) {
                const size_t ro = (size_t)(m0 + G2_ROW(i, r)) * D + n0;
#pragma unroll
                for (int j = 0; j < 4; ++j) { const int c = G2_COL(j); x1[ro + c] = x[ro + c] + acc[i][j][r]; }
            }
    }
}

__device__ __forceinline__ void phase_route(const Params& p, int bid, int nb, unsigned char* smem) {
    const int lane = tid_opaque() & 63, wave = tid_opaque() >> 6;
    const float* x1 = (const float*)(p.ws + WS_X1);
    const float* g = p.in[18];
    const float* wr = p.in[19];
    const float* br = p.in[20];
    bf16_t* hb = (bf16_t*)(p.ws + WS_HB);
    int* topi = (int*)(p.ws + WS_TOPI);
    float* topw = (float*)(p.ws + WS_TOPW);
    int* cnt = (int*)(p.ws + WS_CTL);
    float* hl = (float*)smem + wave * 1056;
    const int ksub = lane >> 3, e4 = lane & 7;
    __syncthreads();
    for (int t = bid * 4 + wave; t < S; t += nb * 4) {
        const float4* xr = (const float4*)(x1 + (size_t)t * D);
        float4 v[4];
        float ss = 0.f;
#pragma unroll
        for (int j = 0; j < 4; ++j) { v[j] = xr[lane + 64 * j]; ss += v[j].x * v[j].x + v[j].y * v[j].y + v[j].z * v[j].z + v[j].w * v[j].w; }
        ss = wave_sum(ss);
        const float rstd = rsqrtf(ss * (1.f / D) + EPS);
#pragma unroll
        for (int j = 0; j < 4; ++j) {
            const float4 gg = ((const float4*)g)[lane + 64 * j];
            const float4 h4 = make_float4(v[j].x * rstd * gg.x, v[j].y * rstd * gg.y, v[j].z * rstd * gg.z, v[j].w * rstd * gg.w);
            uint2 o; o.x = pk2(h4.x, h4.y); o.y = pk2(h4.z, h4.w);
            ((uint2*)(hb + (size_t)t * D))[lane + 64 * j] = o;
            ((float4*)hl)[lane + 64 * j] = h4;
        }
        asm volatile("" ::: "memory");
        float4 acc = make_float4(0.f, 0.f, 0.f, 0.f);
        const float4* wp = (const float4*)(wr + (size_t)ksub * 32) + e4;
#pragma unroll 8
        for (int i = 0; i < 128; ++i) {
            const float hk = hl[8 * i + ksub];
            const float4 w4 = wp[(size_t)i * 64];
            acc.x += hk * w4.x; acc.y += hk * w4.y; acc.z += hk * w4.z; acc.w += hk * w4.w;
        }
#pragma unroll
        for (int o_ = 8; o_ < 64; o_ <<= 1) { acc.x += __shfl_xor(acc.x, o_); acc.y += __shfl_xor(acc.y, o_); acc.z += __shfl_xor(acc.z, o_); acc.w += __shfl_xor(acc.w, o_); }
        if (ksub == 0) {
            const float4 b4 = ((const float4*)br)[e4];
            ((float4*)(hl + 1024))[e4] = make_float4(acc.x + b4.x, acc.y + b4.y, acc.z + b4.z, acc.w + b4.w);
        }
        asm volatile("" ::: "memory");
        float lg[32];
#pragma unroll
        for (int e = 0; e < 8; ++e) { const float4 l4 = ((const float4*)(hl + 1024))[e]; lg[4 * e] = l4.x; lg[4 * e + 1] = l4.y; lg[4 * e + 2] = l4.z; lg[4 * e + 3] = l4.w; }
        asm volatile("" ::: "memory");
        int idx[4]; float val[4];
        unsigned used = 0;
#pragma unroll
        for (int k = 0; k < 4; ++k) {
            float best = -__builtin_inff(); int bi = 0;
#pragma unroll
            for (int e = 0; e < 32; ++e) { const bool ok = !((used >> e) & 1u) && (lg[e] > best); best = ok ? lg[e] : best; bi = ok ? e : bi; }
            idx[k] = bi; val[k] = best; used |= 1u << bi;
        }
        const float e0 = 1.f, e1 = __expf(val[1] - val[0]), e2 = __expf(val[2] - val[0]), e3 = __expf(val[3] - val[0]);
        const float inv = 1.f / (e0 + e1 + e2 + e3);
        if (lane == 0) {
            topi[t * 4 + 0] = idx[0]; topi[t * 4 + 1] = idx[1]; topi[t * 4 + 2] = idx[2]; topi[t * 4 + 3] = idx[3];
            topw[t * 4 + 0] = e0 * inv; topw[t * 4 + 1] = e1 * inv; topw[t * 4 + 2] = e2 * inv; topw[t * 4 + 3] = e3 * inv;
            atomicAdd(&cnt[idx[0]], 1); atomicAdd(&cnt[idx[1]], 1); atomicAdd(&cnt[idx[2]], 1); atomicAdd(&cnt[idx[3]], 1);
        }
    }
}

__device__ __forceinline__ void phase_place(const Params& p, int bid, int nb, unsigned char* smem) {
    int* off = (int*)smem;
    const int* cnt = (const int*)(p.ws + WS_CTL);
    int* cur = (int*)(p.ws + WS_CTL) + 32;
    const int* topi = (const int*)(p.ws + WS_TOPI);
    int* ppos = (int*)(p.ws + WS_PPOS);
    int* rowtok = (int*)(p.ws + WS_ROWTOK);
    __syncthreads();
    if (tid_opaque() == 0) { int a = 0; for (int e = 0; e < NEXP; ++e) { off[e] = a; a += cnt[e]; } }
    __syncthreads();
    for (int i = bid * NT + tid_opaque(); i < S * 4; i += nb * NT) {
        const int e = topi[i];
        const int pos = off[e] + atomicAdd(&cur[e], 1);
        ppos[i] = pos;
        rowtok[pos] = i >> 2;
    }
}

__device__ __forceinline__ void moe_tile_map(const int* cnt, int* sm, int& total_mt) {
    __syncthreads();
    if (tid_opaque() == 0) {
        int a = 0, b = 0;
        for (int e = 0; e < NEXP; ++e) { sm[e] = a; sm[33 + e] = b; a += (cnt[e] + 127) >> 7; b += cnt[e]; }
        sm[32] = a; sm[65] = b;
    }
    __syncthreads();
    total_mt = sm[32];
}
__device__ __forceinline__ void phase_moe1(const Params& p, int bid, int nb, unsigned char* smem) {
    const int g2tid = tid_opaque();
    int* sm = (int*)(smem + 65536);
    const int* cnt = (const int*)(p.ws + WS_CTL);
    const int* rowtok = (const int*)(p.ws + WS_ROWTOK);
    const bf16_t* hb = (const bf16_t*)(p.ws + WS_HB);
    bf16_t* act = (bf16_t*)(p.ws + WS_ACT);
    const int lane = tid_opaque() & 63, wave = tid_opaque() >> 6;
    int total_mt;
    moe_tile_map(cnt, sm, total_mt);
    for (int w = bid; w < total_mt * 16; w += nb) {
        const int tm = w >> 4, nt = w & 15;
        int e = 0;
        while (e < NEXP - 1 && sm[e + 1] <= tm) ++e;
        const int mt = tm - sm[e];
        const int rbase = sm[33 + e] + mt * 128;
        const int mrows = min(128, cnt[e] - mt * 128);
        const int n0 = nt * 64;
        f32x4 acc[4][4];
        gemm2<true, true>(hb, D, rowtok, rbase, mrows, (const bf16_t*)(p.ws + WB_E1) + (size_t)e * D * 2 * DFF, 2 * DFF, n0, 128, D, smem, acc);
        const float* b1 = p.in[22] + (size_t)e * 2 * DFF;
        const int wn_ = (tid_opaque() >> 6) & 1;
#pragma unroll
        for (int i = 0; i < 4; ++i)
#pragma unroll
            for (int jp = 0; jp < 2; ++jp) {
                const int col = n0 + (wn_ * 2 + jp) * 16 + (tid_opaque() & 15);
                const float bg = b1[col], bl = b1[DFF + col];
                float av[4];
                unsigned rmask = 0;
#pragma unroll
                for (int r = 0; r < 4; ++r) {
                    const int rl = G2_ROW(i, r);
                    const float gate = fminf(acc[i][2 * jp][r] + bg, 7.f);
                    const float lin = fminf(fmaxf(acc[i][2 * jp + 1][r] + bl, -7.f), 7.f);
                    av[r] = (lin + 1.f) * gate * sigmoidf_(1.702f * gate);
                    rmask |= (rl < mrows) ? (1u << r) : 0u;
                }
                store_bf16_frag(act + (size_t)(rbase + G2_ROW(i, 0)) * DFF + col, DFF, av[0], av[1], av[2], av[3], g2tid & 63, rmask);
            }
    }
}
__device__ __forceinline__ void phase_moe2(const Params& p, int bid, int nb, unsigned char* smem) {
    const int g2tid = tid_opaque();
    int* sm = (int*)(smem + 65536);
    const int* cnt = (const int*)(p.ws + WS_CTL);
    const bf16_t* act = (const bf16_t*)(p.ws + WS_ACT);
    float* yrows = (float*)(p.ws + WS_YROWS);
    const int lane = tid_opaque() & 63, wave = tid_opaque() >> 6;
    int total_mt;
    moe_tile_map(cnt, sm, total_mt);
    for (int w = bid; w < total_mt * 8; w += nb) {
        const int tm = w >> 3, nt = w & 7;
        int e = 0;
        while (e < NEXP - 1 && sm[e + 1] <= tm) ++e;
        const int mt = tm - sm[e];
        const int rbase = sm[33 + e] + mt * 128;
        const int mrows = min(128, cnt[e] - mt * 128);
        const int n0 = nt * 128;
        f32x4 acc[4][4];
        gemm2<false, false>(act, DFF, nullptr, rbase, mrows, (const bf16_t*)(p.ws + WB_E2) + (size_t)e * DFF * D, D, n0, 128, DFF, smem, acc);
        const float* b2 = p.in[24] + (size_t)e * D + n0;
#pragma unroll
        for (int i = 0; i < 4; ++i)
#pragma unroll
            for (int r = 0; r < 4; ++r) {
                const int rl = G2_ROW(i, r);
                if (rl < mrows) {
                    float* yr = yrows + (size_t)(rbase + rl) * D + n0;
#pragma unroll
                    for (int j = 0; j < 4; ++j) { const int c = G2_COL(j); yr[c] = acc[i][j][r] + b2[c]; }
                }
            }
    }
}

__device__ __forceinline__ void phase_combine(const Params& p, int bid, int nb) {
    const int lane = tid_opaque() & 63, wave = tid_opaque() >> 6;
    const float* x1 = (const float*)(p.ws + WS_X1);
    const float* yrows = (const float*)(p.ws + WS_YROWS);
    const int* ppos = (const int*)(p.ws + WS_PPOS);
    const float* topw = (const float*)(p.ws + WS_TOPW);
    const float* g = p.in[25];
    bf16_t* hb = (bf16_t*)(p.ws + WS_HB);
    bf16_t* pb = (bf16_t*)(p.ws + WS_PB);
    for (int t = bid * 4 + wave; t < S; t += nb * 4) {
        float4 v[4];
#pragma unroll
        for (int j = 0; j < 4; ++j) v[j] = ((const float4*)(x1 + (size_t)t * D))[lane + 64 * j];
#pragma unroll
        for (int k = 0; k < 4; ++k) {
            const float wk = topw[t * 4 + k];
            const float4* yr = (const float4*)(yrows + (size_t)ppos[t * 4 + k] * D);
#pragma unroll
            for (int j = 0; j < 4; ++j) { const float4 y = yr[lane + 64 * j]; v[j].x += wk * y.x; v[j].y += wk * y.y; v[j].z += wk * y.z; v[j].w += wk * y.w; }
        }
        float ss = 0.f;
#pragma unroll
        for (int j = 0; j < 4; ++j) ss += v[j].x * v[j].x + v[j].y * v[j].y + v[j].z * v[j].z + v[j].w * v[j].w;
        ss = wave_sum(ss);
        const float rstd = rsqrtf(ss * (1.f / D) + EPS);
#pragma unroll
        for (int j = 0; j < 4; ++j) {
            ((float4*)(p.out + (size_t)t * D))[lane + 64 * j] = v[j];
            const float4 gg = ((const float4*)g)[lane + 64 * j];
            uint2 o;
            o.x = pk2(v[j].x * rstd * gg.x, v[j].y * rstd * gg.y);
            o.y = pk2(v[j].z * rstd * gg.z, v[j].w * rstd * gg.w);
            ((uint2*)(hb + (size_t)t * D))[lane + 64 * j] = o;
        }
    }
}

__device__ __forceinline__ void phase_ple(const Params& p, int bid, int nb, unsigned char* smem) {
    const int g2tid = tid_opaque();
    const bf16_t* pw = (const bf16_t*)(p.ws + WS_PW);
    for (int w = bid; w < 128 * 8; w += nb) {
        const int mt = w % 128, nt = w / 128;
        const int m0 = mt * 128, n0 = nt * 128;
        f32x4 acc[4][4];
        gemm2<false, false>((const bf16_t*)(p.ws + WS_HB), D, nullptr, m0, 128, (const bf16_t*)(p.ws + WB_PLEG), D, n0, 128, D, smem, acc);
#pragma unroll
        for (int i = 0; i < 4; ++i)
#pragma unroll
            for (int r = 0; r < 4; ++r) {
                const size_t ro = (size_t)(m0 + G2_ROW(i, r)) * D + n0 + G2_COL(0);
                float* orow = p.out + ro;
#pragma unroll
                for (int j = 0; j < 4; ++j) orow[j * 16] = orow[j * 16] + sigmoidf_(acc[i][j][r]) * bf2f(pw[ro + j * 16]);
            }
    }
}

#define LAS __attribute__((address_space(3)))
#define XB_TMO      128
#define XB_XCNT(j)  (256  + 64 * (j))
#define XB_XSUB(j)  (1280 + 64 * (j))
#define XB_XGEN(j)  (2304 + 64 * (j))
#define XB_TOP      3328
#define XB_TOPGEN   3392
#define XCD_BAR_WORDS 3456
#define XB_SPIN_CAP (1u << 22)

__device__ __forceinline__ unsigned xb_ld(unsigned* p)              { return __hip_atomic_load(p, __ATOMIC_RELAXED, __HIP_MEMORY_SCOPE_AGENT); }
__device__ __forceinline__ unsigned xb_add(unsigned* p, unsigned v) { return __hip_atomic_fetch_add(p, v, __ATOMIC_RELAXED, __HIP_MEMORY_SCOPE_AGENT); }
__device__ __forceinline__ unsigned xb_xcc_id() { return (unsigned)__builtin_amdgcn_s_getreg((3 << 11) | 20) & 0xFu; }
#define XB_SPIN(cond, bar) do { unsigned _sp = 0; while (cond) { __builtin_amdgcn_s_sleep(1); \
    if ((++_sp & 255u) == 0u) { if (xb_ld(&(bar)[XB_TMO])) break; if (_sp > XB_SPIN_CAP) { atomicAdd(&(bar)[XB_TMO], 1u); break; } } } } while (0)

struct XcdBarrier {
    unsigned* bar; unsigned x;
    volatile LAS unsigned* st;
};

__device__ __forceinline__ XcdBarrier xcd_barrier_post(unsigned* bar, volatile LAS unsigned* st) {
    XcdBarrier b; b.bar = bar; b.x = xb_xcc_id(); b.st = st;
    if (tid_opaque() == 0) (void)xb_add(&bar[XB_XCNT(b.x)], 1u);
    return b;
}
__device__ __forceinline__ void xcd_barrier_complete(unsigned* bar, unsigned x, unsigned& nloc, unsigned& nx) {
    const unsigned G = gridDim.x * gridDim.y * gridDim.z;
    unsigned sum, cnt, mine, sp = 0u;
    for (;;) {
        sum = 0u; cnt = 0u; mine = 0u;
#pragma unroll
        for (unsigned j = 0; j < 16; ++j) { const unsigned c = xb_ld(&bar[XB_XCNT(j)]); sum += c; cnt += (c > 0u) ? 1u : 0u; mine = (j == x) ? c : mine; }
        if (sum == G) break;
        __builtin_amdgcn_s_sleep(1);
        if ((++sp & 255u) == 0u) { if (xb_ld(&bar[XB_TMO])) break; if (sp > XB_SPIN_CAP) { atomicAdd(&bar[XB_TMO], 1u); break; } }
    }
    nloc = mine > 0u ? mine : 1u; nx = cnt > 0u ? cnt : 1u;
}

__device__ __forceinline__ void xcd_barrier(const XcdBarrier& b) {
    asm volatile("s_waitcnt vmcnt(0)" ::: "memory");
    __syncthreads();
    if (tid_opaque() == 0) {
        unsigned* bar = b.bar;
        __builtin_amdgcn_s_waitcnt(0);
        unsigned nloc = b.st[0], nx = b.st[1];
        if (nloc == 0u) { xcd_barrier_complete(bar, b.x, nloc, nx); b.st[0] = nloc; b.st[1] = nx; }
        const unsigned old = xb_add(&bar[XB_XSUB(b.x)], 1u);
        const unsigned gen = old / nloc;
        if (old + 1u == (gen + 1u) * nloc) {
            __builtin_amdgcn_fence(__ATOMIC_RELEASE, "agent");
            asm volatile("s_waitcnt vmcnt(0)" ::: "memory");
            const unsigned og = xb_add(&bar[XB_TOP], 1u);
            const unsigned tg = og / nx;
            if (og + 1u == (tg + 1u) * nx) xb_add(&bar[XB_TOPGEN], 1u);
            else XB_SPIN(xb_ld(&bar[XB_TOPGEN]) == tg, bar);
            __builtin_amdgcn_fence(__ATOMIC_ACQUIRE, "agent");
            xb_add(&bar[XB_XGEN(b.x)], 1u);
            asm volatile("s_waitcnt vmcnt(0)" ::: "memory");
        } else {
            XB_SPIN(xb_ld(&bar[XB_XGEN(b.x)]) == gen, bar);
            __builtin_amdgcn_fence(__ATOMIC_ACQUIRE, "agent");
            asm volatile("s_waitcnt vmcnt(0)" ::: "memory");
        }
    }
    __syncthreads();
}

template <int PH>
__device__ __forceinline__ void run_phase(const Params& p, int bid, int nb, unsigned char* smem) {
    if (PH == 0) phase_prep(p, bid, nb);
    if (PH == 1) phase_inproj(p, bid, nb, smem);
    if (PH == 3) phase_compress(p, bid, nb, smem);
    if (PH == 4) phase_attn(p, bid, nb, smem);
    if (PH == 15) {
        if (bid < (nb >> 1)) { phase_dsa_attn(p, bid, nb, smem); phase_merge<0>(p, bid, nb, smem); }
        else { phase_merge<0>(p, bid, nb, smem); phase_dsa_attn(p, bid, nb, smem); }
    }
    if (PH == 13) phase_merge<1>(p, bid, nb, smem);
    if (PH == 6) phase_outproj(p, bid, nb, smem);
    if (PH == 7) phase_route(p, bid, nb, smem);
    if (PH == 8) phase_place(p, bid, nb, smem);
    if (PH == 9) phase_moe1(p, bid, nb, smem);
    if (PH == 10) phase_moe2(p, bid, nb, smem);
    if (PH == 11) phase_combine(p, bid, nb);
    if (PH == 12) phase_ple(p, bid, nb, smem);
}

#if SINGLE_LAUNCH
__global__ void __launch_bounds__(NT, 2) fwd_mega(Params p) {
    __shared__ __attribute__((aligned(16))) unsigned char smem[SMEM_BYTES];
    cg::grid_group grid = cg::this_grid();
    const int bid = blockIdx.x, nb = gridDim.x;
    volatile LAS unsigned* bst = (volatile LAS unsigned*)(LAS unsigned char*)(smem + SMEM_BYTES - 16);
    if (tid_opaque() < 2) bst[tid_opaque()] = 0u;
    __syncthreads();
    const XcdBarrier bar = xcd_barrier_post((unsigned*)(p.ws + WS_BAR), bst);
#define GSYNC() xcd_barrier(bar)
    run_phase<0>(p, bid, nb, smem); grid.sync();
    run_phase<1>(p, bid, nb, smem); GSYNC();
    run_phase<3>(p, bid, nb, smem); GSYNC();
    run_phase<4>(p, bid, nb, smem); GSYNC();
    run_phase<15>(p, bid, nb, smem); GSYNC();
    run_phase<13>(p, bid, nb, smem); GSYNC();
    run_phase<6>(p, bid, nb, smem); GSYNC();
    run_phase<7>(p, bid, nb, smem); GSYNC();
    run_phase<8>(p, bid, nb, smem); GSYNC();
    run_phase<9>(p, bid, nb, smem); GSYNC();
    run_phase<10>(p, bid, nb, smem); GSYNC();
    run_phase<11>(p, bid, nb, smem); GSYNC();
    run_phase<12>(p, bid, nb, smem);
#undef GSYNC
}
#else
template <int PH>
__global__ void __launch_bounds__(NT, 2) k_phase(Params p) {
    __shared__ __attribute__((aligned(16))) unsigned char smem[SMEM_BYTES];
    run_phase<PH>(p, blockIdx.x, gridDim.x, smem);
}
#endif

extern "C" void kernel_launch(void* const* d_in, const int* in_sizes, int n_in, void* d_out, int out_size, void* d_ws, size_t ws_size,
                              hipStream_t stream) {
    if (n_in != 28 || ws_size < WS_END) { fprintf(stderr, "kernel_launch: unexpected n_in %d or ws_size %zu (< %zu)\n", n_in, ws_size, (size_t)WS_END); return; }
    Params p{};
    for (int i = 0; i < 28; ++i) p.in[i] = (const float*)d_in[i];
    p.out = (float*)d_out;
    p.ws = (unsigned char*)d_ws;
#if SINGLE_LAUNCH
    static int grid_blocks = 0;
    if (!grid_blocks) {
        int dev = 0, cus = 0, per_cu = 0;
        hipGetDevice(&dev);
        hipDeviceGetAttribute(&cus, hipDeviceAttributeMultiprocessorCount, dev);
        hipOccupancyMaxActiveBlocksPerMultiprocessor(&per_cu, fwd_mega, NT, 0);
        if (per_cu > 2) per_cu = 2;
        if (per_cu < 1) per_cu = 1;
        grid_blocks = cus * per_cu;
    }
    (void)hipMemsetAsync((unsigned char*)d_ws + WS_BAR, 0, XCD_BAR_WORDS * 4, stream);
    void* args[] = {&p};
    hipError_t e = hipLaunchCooperativeKernel((void*)fwd_mega, dim3(grid_blocks), dim3(NT), args, 0, stream);
    if (e != hipSuccess) fprintf(stderr, "cooperative launch failed: %s (grid %d)\n", hipGetErrorString(e), grid_blocks);
#else
    const int G = 512;
    k_phase<0><<<G, NT, 0, stream>>>(p);
    k_phase<1><<<G, NT, 0, stream>>>(p);
    k_phase<3><<<G, NT, 0, stream>>>(p);
    k_phase<4><<<G, NT, 0, stream>>>(p);
    k_phase<15><<<G, NT, 0, stream>>>(p);
    k_phase<13><<<G, NT, 0, stream>>>(p);
    k_phase<6><<<G, NT, 0, stream>>>(p);
    k_phase<7><<<G, NT, 0, stream>>>(p);
    k_phase<8><<<G, NT, 0, stream>>>(p);
    k_phase<9><<<G, NT, 0, stream>>>(p);
    k_phase<10><<<G, NT, 0, stream>>>(p);
    k_phase<11><<<G, NT, 0, stream>>>(p);
    k_phase<12><<<G, NT, 0, stream>>>(p);
#endif
}
```

```cpp
#include <hip/hip_runtime.h>
#include <hip/hip_cooperative_groups.h>
#include <cstdio>
#include <cstdint>
namespace cg = cooperative_groups;

#ifndef SINGLE_LAUNCH
#define SINGLE_LAUNCH 1
#endif

constexpr int S = 16384;
constexpr int D = 1024;
constexpr int DIN = 5184;
constexpr int NCMP = 1023;
constexpr int NSLC = 256;
constexpr int NEXP = 32;
constexpr int DFF = 1024;
constexpr float EPS = 1e-6f;
constexpr float LOG2E = 1.4426950408889634f;
constexpr int Z_NQ = 0, Z_NKV = 512, Z_NGATE = 1280, Z_DQ = 1304, Z_DK = 1816, Z_DV = 2328, Z_IQ = 2840, Z_IK = 3096,
              Z_IW = 3128, Z_GA = 3136, Z_GB = 4160;

constexpr int NT = 256;
constexpr int SMEM_BYTES = 73728;

typedef unsigned short bf16_t;
typedef short bf16x8 __attribute__((ext_vector_type(8)));
typedef float f32x4 __attribute__((ext_vector_type(4)));
typedef short s16x4 __attribute__((ext_vector_type(4)));
typedef __attribute__((address_space(3))) s16x4* lds_s16x4_ptr;
__device__ __forceinline__ s16x4 lds_tr16(const void* p) {
    return __builtin_amdgcn_ds_read_tr16_b64_v4i16((lds_s16x4_ptr)(uintptr_t)p);
}

constexpr size_t MBy = 1ull << 20;
constexpr size_t WS_CTL = 0;
constexpr size_t WS_BAR = 65536;
constexpr size_t WS_HB = 1 * MBy;
constexpr size_t WS_OA = WS_HB + (size_t)S * D * 2;
constexpr size_t WS_OB = WS_OA + (size_t)S * 512 * 2;
constexpr size_t WS_MERGED = WS_OB + (size_t)S * 512 * 2;
constexpr size_t WS_X1 = WS_MERGED + (size_t)S * D * 2;
constexpr size_t WS_TOPI = WS_X1 + (size_t)S * D * 4;
constexpr size_t WS_TOPW = WS_TOPI + (size_t)S * 4 * 4;
constexpr size_t WS_PPOS = WS_TOPW + (size_t)S * 4 * 4;
constexpr size_t WS_ROWTOK = WS_PPOS + (size_t)S * 4 * 4;
constexpr size_t WS_PB = WS_ROWTOK + (size_t)65536 * 4;
constexpr size_t WS_PW = WS_PB + (size_t)S * 256 * 2;
constexpr size_t WS_SEL = WS_PW + (size_t)S * D * 2;
constexpr size_t WS_NSEL = WS_SEL + (size_t)S * 256 * 2;
constexpr size_t WS_REG = WS_NSEL + (size_t)S * 4;
constexpr size_t WS_SGA = WS_REG;
constexpr size_t WS_SGB = WS_SGA + (size_t)S * D * 2;
constexpr size_t WS_GT = WS_SGB + (size_t)S * D * 2;
constexpr size_t WS_IWS = WS_GT + (size_t)S * 32 * 4;
constexpr size_t WS_QNB = WS_IWS + (size_t)S * 8 * 4;
constexpr size_t WS_KSLB = WS_QNB + (size_t)S * 512 * 2;
constexpr size_t WS_VSLB = WS_KSLB + (size_t)S * 128 * 2;
constexpr size_t WS_KWNB = WS_VSLB + (size_t)S * 128 * 2;
constexpr size_t WS_VWNB = WS_KWNB + (size_t)S * 128 * 2;
constexpr size_t WS_KCB = WS_VWNB + (size_t)S * 128 * 2;
constexpr size_t WS_VCB = WS_KCB + (size_t)2 * 1024 * 64 * 2;
constexpr size_t WS_KCR = WS_VCB + (size_t)2 * 1024 * 64 * 2;
constexpr size_t WS_VCR = WS_KCR + (size_t)S * 128 * 2;
constexpr size_t WS_DQB = WS_VCR + (size_t)S * 128 * 2;
constexpr size_t WS_DKB = WS_DQB + (size_t)S * 512 * 2;
constexpr size_t WS_DVB = WS_DKB + (size_t)S * 512 * 2;
constexpr size_t WS_IQB = WS_DVB + (size_t)S * 512 * 2;
constexpr size_t WS_IKB = WS_IQB + (size_t)S * 256 * 2;
constexpr size_t WS_ENDA = WS_IKB + (size_t)S * 32 * 2;
constexpr size_t WS_ACT = WS_REG;
constexpr size_t WS_YROWS = WS_ACT + (size_t)(65536 + 128) * DFF * 2;
constexpr size_t WS_ENDB = WS_YROWS + (size_t)(65536 + 128) * D * 4;
constexpr size_t WS_END0 = WS_ENDA > WS_ENDB ? WS_ENDA : WS_ENDB;
constexpr size_t WB_IN = WS_END0;
constexpr size_t WB_A = WB_IN + (size_t)D * DIN * 2;
constexpr size_t WB_B = WB_A + (size_t)512 * D * 2;
constexpr size_t WB_OUT = WB_B + (size_t)512 * D * 2;
constexpr size_t WB_E1 = WB_OUT + (size_t)D * D * 2;
constexpr size_t WB_E2 = WB_E1 + (size_t)NEXP * D * 2 * DFF * 2;
constexpr size_t WB_PLE = WB_E2 + (size_t)NEXP * DFF * D * 2;
constexpr size_t WB_PLEG = WB_PLE + (size_t)256 * D * 2;
constexpr size_t WB_CK1 = WB_PLEG + (size_t)D * D * 2;
constexpr size_t WB_CV1 = WB_CK1 + (size_t)2048 * 64 * 2;
constexpr size_t WS_END = WB_CV1 + (size_t)2048 * 64 * 2 + 4096;

struct Params {
    const float* in[28];
    float* out;
    unsigned char* ws;
};

__device__ __forceinline__ unsigned f2bf(float f) {
    unsigned u = __builtin_bit_cast(unsigned, f);
    return (u + 0x7fffu + ((u >> 16) & 1u)) >> 16;
}
__device__ __forceinline__ unsigned pk2(float lo, float hi) { return f2bf(lo) | (f2bf(hi) << 16); }
__device__ __forceinline__ float bf2f(unsigned short b) { return __builtin_bit_cast(float, (unsigned)b << 16); }
__device__ __forceinline__ int tid_opaque() { int t = threadIdx.x; asm volatile("" : "+v"(t)); return t; }
__device__ __forceinline__ float wave_sum(float v) {
#pragma unroll
    for (int o = 1; o < 64; o <<= 1) v += __shfl_xor(v, o);
    return v;
}
__device__ __forceinline__ float wave_max(float v) {
#pragma unroll
    for (int o = 1; o < 64; o <<= 1) v = fmaxf(v, __shfl_xor(v, o));
    return v;
}
__device__ __forceinline__ float sigmoidf_(float x) { return 1.f / (1.f + __expf(-x)); }
__device__ __forceinline__ int bucket_of(int n) {
    if (n < 16) return n;
    int b = 16;
    b += (n >= 19) + (n >= 21) + (n >= 24) + (n >= 27) + (n >= 31) + (n >= 35) + (n >= 40) + (n >= 46) + (n >= 52) + (n >= 59) +
         (n >= 67) + (n >= 77) + (n >= 87) + (n >= 99) + (n >= 113);
    return b;
}

constexpr int LDS_STRIDE = 40;
constexpr int BTR_STRIDE = 136;
template <bool A_F32, bool GATHER, bool SPLIT = false, bool BTR = true>
__device__ __forceinline__ void gemm_tile(const void* __restrict__ Aptr, int lda, const int* __restrict__ rowidx, int m0, int mrows,
                                          const float* __restrict__ B, int ldb, int n0, int split_off, int ncols, int K,
                                          unsigned char* smem, f32x4 (&acc)[2][8]) {
    bf16_t* As = (bf16_t*)smem;
    bf16_t* Bs = As + 128 * LDS_STRIDE;
    bf16_t* AsL = Bs + 128 * LDS_STRIDE;
    bf16_t* BsL = AsL + 128 * LDS_STRIDE;
    const int tid = tid_opaque(), lane = tid & 63, wave = tid >> 6;
#pragma unroll
    for (int i = 0; i < 2; ++i)
#pragma unroll
        for (int j = 0; j < 8; ++j) acc[i][j] = (f32x4){0.f, 0.f, 0.f, 0.f};
    auto lo = [](float v) { return v - bf2f((unsigned short)f2bf(v)); };

    const int ar = tid >> 2, ach = tid & 3;
    const unsigned char* arow[2];
    bool aval[2];
#pragma unroll
    for (int i = 0; i < 2; ++i) {
        int r = ar + 64 * i;
        aval[i] = r < mrows;
        long src = 0;
        if (aval[i]) src = GATHER ? (long)rowidx[m0 + r] : (long)(m0 + r);
        arow[i] = (const unsigned char*)Aptr + (size_t)src * lda * (A_F32 ? 4 : 2) + (size_t)ach * 8 * (A_F32 ? 4 : 2);
    }
    const int nq = tid & 31, kq = tid >> 5;
    const int jn = 4 * nq;
    const bool bval = jn < ncols;
    const float* bptr = B + (size_t)(4 * kq) * ldb + n0 + jn + (jn >= 64 ? split_off : 0);

    uint4 areg[2];
    float4 af0a, af0b, af1a, af1b;
    float4 breg[4];
    auto load_g = [&](int k0) {
#pragma unroll
        for (int i = 0; i < 2; ++i) {
            if (A_F32) {
                float4 t0 = make_float4(0, 0, 0, 0), t1 = t0;
                if (aval[i]) {
                    const float4* s = (const float4*)(arow[i] + (size_t)k0 * 4);
                    t0 = s[0]; t1 = s[1];
                }
                if (i == 0) { af0a = t0; af0b = t1; } else { af1a = t0; af1b = t1; }
            } else {
                if (aval[i]) areg[i] = *(const uint4*)(arow[i] + (size_t)k0 * 2);
                else areg[i] = make_uint4(0, 0, 0, 0);
            }
        }
#pragma unroll
        for (int kk = 0; kk < 4; ++kk) {
            if (bval) breg[kk] = *(const float4*)(bptr + (size_t)(k0 + kk) * ldb);
            else breg[kk] = make_float4(0, 0, 0, 0);
        }
    };
    auto store_l = [&]() {
#pragma unroll
        for (int i = 0; i < 2; ++i) {
            uint4 v;
            const float4 t0 = (i == 0) ? af0a : af1a, t1 = (i == 0) ? af0b : af1b;
            if (A_F32) {
                v.x = pk2(t0.x, t0.y); v.y = pk2(t0.z, t0.w);
                v.z = pk2(t1.x, t1.y); v.w = pk2(t1.z, t1.w);
            } else v = areg[i];
            *(uint4*)(As + (ar + 64 * i) * LDS_STRIDE + ach * 8) = v;
            if (SPLIT && A_F32) {
                v.x = pk2(lo(t0.x), lo(t0.y)); v.y = pk2(lo(t0.z), lo(t0.w));
                v.z = pk2(lo(t1.x), lo(t1.y)); v.w = pk2(lo(t1.z), lo(t1.w));
                *(uint4*)(AsL + (ar + 64 * i) * LDS_STRIDE + ach * 8) = v;
            }
        }
        if (SPLIT) {
            uint2 v;
            v.x = pk2(lo(breg[0].x), lo(breg[1].x)); v.y = pk2(lo(breg[2].x), lo(breg[3].x));
            *(uint2*)(BsL + (jn + 0) * LDS_STRIDE + 4 * kq) = v;
            v.x = pk2(lo(breg[0].y), lo(breg[1].y)); v.y = pk2(lo(breg[2].y), lo(breg[3].y));
            *(uint2*)(BsL + (jn + 1) * LDS_STRIDE + 4 * kq) = v;
            v.x = pk2(lo(breg[0].z), lo(breg[1].z)); v.y = pk2(lo(breg[2].z), lo(breg[3].z));
            *(uint2*)(BsL + (jn + 2) * LDS_STRIDE + 4 * kq) = v;
            v.x = pk2(lo(breg[0].w), lo(breg[1].w)); v.y = pk2(lo(breg[2].w), lo(breg[3].w));
            *(uint2*)(BsL + (jn + 3) * LDS_STRIDE + 4 * kq) = v;
        }
        if (BTR && !SPLIT) {
#pragma unroll
            for (int kk = 0; kk < 4; ++kk) {
                uint2 v; v.x = pk2(breg[kk].x, breg[kk].y); v.y = pk2(breg[kk].z, breg[kk].w);
                *(uint2*)(Bs + (4 * kq + kk) * BTR_STRIDE + jn) = v;
            }
        } else {
            uint2 v;
            v.x = pk2(breg[0].x, breg[1].x); v.y = pk2(breg[2].x, breg[3].x);
            *(uint2*)(Bs + (jn + 0) * LDS_STRIDE + 4 * kq) = v;
            v.x = pk2(breg[0].y, breg[1].y); v.y = pk2(breg[2].y, breg[3].y);
            *(uint2*)(Bs + (jn + 1) * LDS_STRIDE + 4 * kq) = v;
            v.x = pk2(breg[0].z, breg[1].z); v.y = pk2(breg[2].z, breg[3].z);
            *(uint2*)(Bs + (jn + 2) * LDS_STRIDE + 4 * kq) = v;
            v.x = pk2(breg[0].w, breg[1].w); v.y = pk2(breg[2].w, breg[3].w);
            *(uint2*)(Bs + (jn + 3) * LDS_STRIDE + 4 * kq) = v;
        }
    };
    const int nk = K / 32;
    __syncthreads();
    load_g(0);
    store_l();
    __syncthreads();
    const int fr = lane & 15, fq = lane >> 4;
    for (int kt = 0; kt < nk; ++kt) {
        if (kt + 1 < nk) load_g((kt + 1) * 32);
        bf16x8 a[2];
#pragma unroll
        for (int i = 0; i < 2; ++i) a[i] = *(const bf16x8*)(As + (wave * 32 + i * 16 + fr) * LDS_STRIDE + fq * 8);
        if (!SPLIT) {
            bf16x8 b[8];
#pragma unroll
            for (int j = 0; j < 8; ++j) {
                if (BTR && !SPLIT) {
                    const bf16_t* bp = Bs + (8 * fq + (fr >> 2)) * BTR_STRIDE + 16 * j + 4 * (fr & 3);
                    const s16x4 lo4 = lds_tr16(bp), hi4 = lds_tr16(bp + 4 * BTR_STRIDE);
                    b[j] = (bf16x8){lo4[0], lo4[1], lo4[2], lo4[3], hi4[0], hi4[1], hi4[2], hi4[3]};
                } else b[j] = *(const bf16x8*)(Bs + (j * 16 + fr) * LDS_STRIDE + fq * 8);
            }
#pragma unroll
            for (int i = 0; i < 2; ++i)
#pragma unroll
                for (int j = 0; j < 8; ++j) acc[i][j] = __builtin_amdgcn_mfma_f32_16x16x32_bf16(a[i], b[j], acc[i][j], 0, 0, 0);
        } else {
            bf16x8 al[2];
#pragma unroll
            for (int i = 0; i < 2; ++i) al[i] = *(const bf16x8*)(AsL + (wave * 32 + i * 16 + fr) * LDS_STRIDE + fq * 8);
#pragma unroll
            for (int j = 0; j < 8; ++j) {
                const bf16x8 bh = *(const bf16x8*)(Bs + (j * 16 + fr) * LDS_STRIDE + fq * 8);
                const bf16x8 bl = *(const bf16x8*)(BsL + (j * 16 + fr) * LDS_STRIDE + fq * 8);
#pragma unroll
                for (int i = 0; i < 2; ++i) {
                    acc[i][j] = __builtin_amdgcn_mfma_f32_16x16x32_bf16(a[i], bh, acc[i][j], 0, 0, 0);
                    acc[i][j] = __builtin_amdgcn_mfma_f32_16x16x32_bf16(a[i], bl, acc[i][j], 0, 0, 0);
                    acc[i][j] = __builtin_amdgcn_mfma_f32_16x16x32_bf16(al[i], bh, acc[i][j], 0, 0, 0);
                }
            }
        }
        __syncthreads();
        if (kt + 1 < nk) {
            store_l();
            __syncthreads();
        }
    }
}


constexpr int ASTR = 72;
constexpr int BSTR = 136;
template <bool GATHER, bool PAIR>
__device__ __forceinline__ void gemm2(const bf16_t* __restrict__ A, int lda, const int* __restrict__ rowidx, int m0, int mrows,
                                      const bf16_t* __restrict__ B, int ldb, int n0, int ncols, int K, unsigned char* smem,
                                      f32x4 (&acc)[4][4]) {
    bf16_t* As = (bf16_t*)smem;
    bf16_t* Bs = As + 128 * ASTR;
    const int tid = tid_opaque(), lane = tid & 63, wave = tid >> 6, wm = wave >> 1, wn = wave & 1;
#pragma unroll
    for (int i = 0; i < 4; ++i)
#pragma unroll
        for (int j = 0; j < 4; ++j) acc[i][j] = (f32x4){0.f, 0.f, 0.f, 0.f};
    const int ar0 = tid >> 3, ach = tid & 7;
    const bf16_t* ap0; const bf16_t* ap1; const bf16_t* ap2; const bf16_t* ap3;
    {
        int r_[4];
#pragma unroll
        for (int i = 0; i < 4; ++i) { const int rl = 32 * i + ar0; r_[i] = rl < mrows ? rl : mrows - 1; }
        ap0 = A + (size_t)(GATHER ? (long)rowidx[m0 + r_[0]] : (long)(m0 + r_[0])) * lda + ach * 8;
        ap1 = A + (size_t)(GATHER ? (long)rowidx[m0 + r_[1]] : (long)(m0 + r_[1])) * lda + ach * 8;
        ap2 = A + (size_t)(GATHER ? (long)rowidx[m0 + r_[2]] : (long)(m0 + r_[2])) * lda + ach * 8;
        ap3 = A + (size_t)(GATHER ? (long)rowidx[m0 + r_[3]] : (long)(m0 + r_[3])) * lda + ach * 8;
    }
    const int br0 = tid >> 4, bch = tid & 15;
    const int bcol = PAIR ? ((bch >> 2) * 16 + (bch & 1) * 8 + ((bch >> 1) & 1) * 1024) : bch * 8;
    const bf16_t* bp = B + (size_t)br0 * ldb + n0 + bcol;
    bf16_t* asd = As + ar0 * ASTR + ach * 8;
    bf16_t* bsd = Bs + br0 * BSTR + bch * 8;
    uint4 a0, a1, a2, a3, b0, b1, b2, b3;
#define G2_LOAD(k0)                                                                                       \
    do {                                                                                                  \
        a0 = *(const uint4*)(ap0 + (k0)); a1 = *(const uint4*)(ap1 + (k0));                               \
        a2 = *(const uint4*)(ap2 + (k0)); a3 = *(const uint4*)(ap3 + (k0));                               \
        const bf16_t* bp_ = bp + (size_t)(k0) * ldb;                                                      \
        b0 = *(const uint4*)(bp_); b1 = *(const uint4*)(bp_ + (size_t)16 * ldb);                          \
        b2 = *(const uint4*)(bp_ + (size_t)32 * ldb); b3 = *(const uint4*)(bp_ + (size_t)48 * ldb);       \
    } while (0)
#define G2_STORE()                                                                                        \
    do {                                                                                                  \
        *(uint4*)(asd) = a0; *(uint4*)(asd + 32 * ASTR) = a1; *(uint4*)(asd + 64 * ASTR) = a2; *(uint4*)(asd + 96 * ASTR) = a3; \
        *(uint4*)(bsd) = b0; *(uint4*)(bsd + 16 * BSTR) = b1; *(uint4*)(bsd + 32 * BSTR) = b2; *(uint4*)(bsd + 48 * BSTR) = b3; \
    } while (0)
    const int nk = K / 64;
    __syncthreads();
    G2_LOAD(0);
    G2_STORE();
    __syncthreads();
    const int fr = lane & 15, fq = lane >> 4;
    const bf16_t* afp = As + (wm * 64 + fr) * ASTR + fq * 8;
    const bf16_t* bfp = Bs + (8 * fq + (fr >> 2)) * BSTR + wn * 64 + 4 * (fr & 3);
    for (int kt = 0; kt < nk; ++kt) {
        if (kt + 1 < nk) G2_LOAD((kt + 1) * 64);
#pragma unroll
        for (int kh = 0; kh < 2; ++kh) {
            bf16x8 a[4], b[4];
#pragma unroll
            for (int i = 0; i < 4; ++i) a[i] = *(const bf16x8*)(afp + i * 16 * ASTR + kh * 32);
#pragma unroll
            for (int j = 0; j < 4; ++j) {
                const bf16_t* q = bfp + kh * 32 * BSTR + j * 16;
                const s16x4 lo4 = lds_tr16(q), hi4 = lds_tr16(q + 4 * BSTR);
                b[j] = (bf16x8){lo4[0], lo4[1], lo4[2], lo4[3], hi4[0], hi4[1], hi4[2], hi4[3]};
            }
#pragma unroll
            for (int i = 0; i < 4; ++i)
#pragma unroll
                for (int j = 0; j < 4; ++j) acc[i][j] = __builtin_amdgcn_mfma_f32_16x16x32_bf16(a[i], b[j], acc[i][j], 0, 0, 0);
        }
        __syncthreads();
        if (kt + 1 < nk) {
            G2_STORE();
            __syncthreads();
        }
    }
#undef G2_LOAD
#undef G2_STORE
}
#define G2_ROW(i, r) ((g2tid >> 7) * 64 + (i) * 16 + 4 * ((g2tid & 63) >> 4) + (r))
#define G2_COL(j) (((((g2tid >> 6) & 1) * 4 + (j)) * 16) + (g2tid & 15))
__device__ __forceinline__ void store_bf16_frag(bf16_t* base, int ld, float v0, float v1, float v2, float v3, int lane, unsigned rowmask = 0xFu) {
    const bool odd = lane & 1;
    const float s0 = odd ? v0 : v2, s1 = odd ? v1 : v3;
    const float r0 = __shfl_xor(s0, 1), r1 = __shfl_xor(s1, 1);
    bf16_t* p0 = odd ? base + 2 * ld - 1 : base;
    const unsigned w0 = odd ? pk2(r0, v2) : pk2(v0, r0);
    const unsigned w1 = odd ? pk2(r1, v3) : pk2(v1, r1);
    const unsigned m = odd ? (rowmask >> 2) : rowmask;
    if (m & 1u) *(unsigned*)p0 = w0;
    if (m & 2u) *(unsigned*)(p0 + ld) = w1;
}

__device__ __forceinline__ void cvt_weights(const float* __restrict__ src, bf16_t* __restrict__ dst, size_t n, int bid, int nb) {
    const size_t n8 = n >> 3;
    for (size_t i = (size_t)bid * NT + tid_opaque(); i < n8; i += (size_t)nb * NT) {
        const float4 u = ((const float4*)src)[2 * i], v = ((const float4*)src)[2 * i + 1];
        uint4 o; o.x = pk2(u.x, u.y); o.y = pk2(u.z, u.w); o.z = pk2(v.x, v.y); o.w = pk2(v.z, v.w);
        ((uint4*)dst)[i] = o;
    }
}
__device__ __forceinline__ void phase_prep(const Params& p, int bid, int nb) {
    const int lane = tid_opaque() & 63, wave = tid_opaque() >> 6;
    if (bid == 0 && tid_opaque() < 64) ((int*)(p.ws + WS_CTL))[tid_opaque()] = 0;
    {
        const float* src_ = p.in[2];
        bf16_t* dst_ = (bf16_t*)(p.ws + WB_IN);
        constexpr int G8 = DIN / 8;
        for (size_t i = (size_t)bid * NT + tid_opaque(); i < (size_t)D * G8; i += (size_t)nb * NT) {
            const int k = (int)(i / G8), nc = (int)(i % G8) * 8;
            int oc;
            if (nc < 1280) oc = nc; else if (nc < 2816) oc = nc + 24; else if (nc < 3072) oc = nc + 24; else if (nc < 5120) oc = nc + 64;
            else if (nc < 5152) oc = nc - 5120 + 3096; else if (nc < 5176) oc = nc - 5152 + 1280; else oc = nc - 5176 + 3128;
            const float4 u = *(const float4*)(src_ + (size_t)k * DIN + oc), v = *(const float4*)(src_ + (size_t)k * DIN + oc + 4);
            uint4 o; o.x = pk2(u.x, u.y); o.y = pk2(u.z, u.w); o.z = pk2(v.x, v.y); o.w = pk2(v.z, v.w);
            *(uint4*)(dst_ + (size_t)k * DIN + nc) = o;
        }
    }
    cvt_weights(p.in[14], (bf16_t*)(p.ws + WB_A), (size_t)512 * D, bid, nb);
    cvt_weights(p.in[15], (bf16_t*)(p.ws + WB_B), (size_t)512 * D, bid, nb);
    cvt_weights(p.in[16], (bf16_t*)(p.ws + WB_OUT), (size_t)D * D, bid, nb);
    cvt_weights(p.in[26], (bf16_t*)(p.ws + WB_PLE), (size_t)256 * D, bid, nb);
    cvt_weights(p.in[1], (bf16_t*)(p.ws + WS_PB), (size_t)S * 256, bid, nb);
    cvt_weights(p.in[9], (bf16_t*)(p.ws + WB_CK1), (size_t)2048 * 64, bid, nb);
    cvt_weights(p.in[12], (bf16_t*)(p.ws + WB_CV1), (size_t)2048 * 64, bid, nb);
    const float* x = p.in[0];
    const float* g = p.in[3];
    bf16_t* hb = (bf16_t*)(p.ws + WS_HB);
    for (int t = bid * 4 + wave; t < S; t += nb * 4) {
        const float4* xr = (const float4*)(x + (size_t)t * D);
        float4 v[4];
        float ss = 0.f;
#pragma unroll
        for (int j = 0; j < 4; ++j) { v[j] = xr[lane + 64 * j]; ss += v[j].x * v[j].x + v[j].y * v[j].y + v[j].z * v[j].z + v[j].w * v[j].w; }
        ss = wave_sum(ss);
        const float rstd = rsqrtf(ss * (1.f / D) + EPS);
#pragma unroll
        for (int j = 0; j < 4; ++j) {
            const float4 gg = ((const float4*)g)[lane + 64 * j];
            uint2 o;
            o.x = pk2(v[j].x * rstd * gg.x, v[j].y * rstd * gg.y);
            o.y = pk2(v[j].z * rstd * gg.z, v[j].w * rstd * gg.w);
            ((uint2*)(hb + (size_t)t * D))[lane + 64 * j] = o;
        }
    }
}

__device__ __forceinline__ void phase_inproj(const Params& p, int bid, int nb, unsigned char* smem) {
    const int g2tid = tid_opaque();
    const bf16_t* hb = (const bf16_t*)(p.ws + WS_HB);
    const int lane = tid_opaque() & 63, fr = lane & 15;
    constexpr int NTN = (DIN + 127) / 128;
    for (int w = bid; w < 128 * NTN; w += nb) {
        const int mt = w % 128, nt = w / 128;
        const int m0 = mt * 128, n0 = nt * 128;
        const int ncols = (DIN - n0) < 128 ? (DIN - n0) : 128;
        f32x4 acc[4][4];
        gemm2<false, false>(hb, D, nullptr, m0, 128, (const bf16_t*)(p.ws + WB_IN), DIN, n0, ncols, D, smem, acc);
        const int cid = __builtin_amdgcn_readfirstlane((n0 >> 6) + ((tid_opaque() >> 6) & 1));
        if (cid > 80) continue;
        int kind; bf16_t* dst; int ld; const float* gain = nullptr; float scale = 1.f;
        if (cid < 8) { kind = 0; dst = (bf16_t*)(p.ws + WS_QNB) + cid * 64; ld = 512; gain = p.in[4]; scale = 0.125f * LOG2E; }
        else if (cid < 20) {
            const int j = cid - 8, kd = j >> 1, g = j & 1;
            ld = 64; kind = (kd == 2 || kd == 4) ? 0 : 1; gain = p.in[5];
            const size_t base = kd == 0 ? WS_KCR : kd == 1 ? WS_VCR : kd == 2 ? WS_KSLB : kd == 3 ? WS_VSLB : kd == 4 ? WS_KWNB : WS_VWNB;
            dst = (bf16_t*)(p.ws + base) + (size_t)g * S * 64;
        }
        else if (cid < 28) { kind = 0; dst = (bf16_t*)(p.ws + WS_DQB) + (cid - 20) * 64; ld = 512; gain = p.in[6]; scale = 0.125f * LOG2E; }
        else if (cid < 36) { kind = 0; dst = (bf16_t*)(p.ws + WS_DKB) + (cid - 28) * 64; ld = 512; gain = p.in[7]; }
        else if (cid < 44) { kind = 1; dst = (bf16_t*)(p.ws + WS_DVB) + (cid - 36) * 64; ld = 512; }
        else if (cid < 48) { kind = 1; dst = (bf16_t*)(p.ws + WS_IQB) + (cid - 44) * 64; ld = 256; scale = 0.17677669529663687f; }
        else if (cid < 64) { kind = 2; dst = (bf16_t*)(p.ws + WS_SGA) + (cid - 48) * 64; ld = D; }
        else if (cid < 80) { kind = 2; dst = (bf16_t*)(p.ws + WS_SGB) + (cid - 64) * 64; ld = D; }
        else { kind = 3; dst = nullptr; ld = 0; }
        if (kind == 0) {
            float gv[4];
#pragma unroll
            for (int j = 0; j < 4; ++j) gv[j] = gain[j * 16 + fr] * scale;
#pragma unroll
            for (int i = 0; i < 4; ++i) {
                float rstd[4];
#pragma unroll
                for (int r = 0; r < 4; ++r) {
                    float ss = acc[i][0][r] * acc[i][0][r] + acc[i][1][r] * acc[i][1][r] + acc[i][2][r] * acc[i][2][r] + acc[i][3][r] * acc[i][3][r];
                    ss += __shfl_xor(ss, 1); ss += __shfl_xor(ss, 2); ss += __shfl_xor(ss, 4); ss += __shfl_xor(ss, 8);
                    rstd[r] = rsqrtf(ss * (1.f / 64.f) + EPS);
                }
                bf16_t* dr = dst + (size_t)(m0 + G2_ROW(i, 0)) * ld + fr;
#pragma unroll
                for (int j = 0; j < 4; ++j)
                    store_bf16_frag(dr + j * 16, ld, acc[i][j][0] * rstd[0] * gv[j], acc[i][j][1] * rstd[1] * gv[j], acc[i][j][2] * rstd[2] * gv[j],
                                    acc[i][j][3] * rstd[3] * gv[j], lane);
            }
        } else if (kind == 1 || kind == 2) {
#pragma unroll
            for (int i = 0; i < 4; ++i) {
                bf16_t* dr = dst + (size_t)(m0 + G2_ROW(i, 0)) * ld + fr;
#pragma unroll
                for (int j = 0; j < 4; ++j) {
                    float v[4];
#pragma unroll
                    for (int r = 0; r < 4; ++r) v[r] = kind == 2 ? sigmoidf_(acc[i][j][r]) : acc[i][j][r] * scale;
                    store_bf16_frag(dr + j * 16, ld, v[0], v[1], v[2], v[3], lane);
                }
            }
        } else {
            bf16_t* ikb = (bf16_t*)(p.ws + WS_IKB);
            float* gt = (float*)(p.ws + WS_GT);
            float* iws = (float*)(p.ws + WS_IWS);
#pragma unroll
            for (int i = 0; i < 4; ++i) {
                bf16_t* ir = ikb + (size_t)(m0 + G2_ROW(i, 0)) * 32 + fr;
                store_bf16_frag(ir, 32, acc[i][0][0], acc[i][0][1], acc[i][0][2], acc[i][0][3], lane);
                store_bf16_frag(ir + 16, 32, acc[i][1][0], acc[i][1][1], acc[i][1][2], acc[i][1][3], lane);
#pragma unroll
                for (int r = 0; r < 4; ++r) {
                    const size_t t = (size_t)(m0 + G2_ROW(i, r));
                    gt[t * 32 + fr] = sigmoidf_(acc[i][2][r]);
                    if (fr < 8) gt[t * 32 + 16 + fr] = sigmoidf_(acc[i][3][r]);
                    else iws[t * 8 + fr - 8] = acc[i][3][r] * 0.35355339059327373f;
                }
            }
        }
    }
}

__device__ __forceinline__ float rms64(float v) { return rsqrtf(wave_sum(v * v) * (1.f / 64.f) + EPS); }

__device__ __forceinline__ void phase_compress(const Params& p, int bid, int nb, unsigned char* smem) {
    const int g2tid = tid_opaque();
    const int tid = tid_opaque(), lane = tid & 63, wave = tid >> 6;
    float* cvec = (float*)(smem + 36864);
    float* hid = (float*)(smem + 36864 + 256);
    bf16_t* pw = (bf16_t*)(p.ws + WS_PW);
    for (int w = bid; w < 32 + 128 * 8; w += nb) {
        const bool is_c = w < 32;
        const int kind = w >> 4, g = (w >> 3) & 1;
        const int w2_ = w - 32;
        const int m0 = is_c ? (w & 7) * 128 : (w2_ % 128) * 128;
        const int n0 = is_c ? 0 : (w2_ / 128) * 128;
        const int mrows = is_c ? ((NCMP - m0) < 128 ? (NCMP - m0) : 128) : 128;
        const bf16_t* Ap = is_c ? (const bf16_t*)(p.ws + (kind ? WS_VCR : WS_KCR)) + (size_t)g * S * 64 : (const bf16_t*)(p.ws + WS_PB);
        const bf16_t* Bp = is_c ? (const bf16_t*)(p.ws + (kind ? WB_CV1 : WB_CK1)) : (const bf16_t*)(p.ws + WB_PLE);
        f32x4 acc[4][4];
        gemm2<false, false>(Ap, is_c ? 16 * 64 : 256, nullptr, m0, mrows, Bp, is_c ? 64 : D, n0, is_c ? 64 : 128, is_c ? 2048 : 256, smem, acc);
        if (!is_c) {
#pragma unroll
            for (int i = 0; i < 4; ++i) {
                bf16_t* pr = pw + (size_t)(m0 + G2_ROW(i, 0)) * D + n0 + G2_COL(0);
#pragma unroll
                for (int j = 0; j < 4; ++j) store_bf16_frag(pr + j * 16, D, acc[i][j][0], acc[i][j][1], acc[i][j][2], acc[i][j][3], lane);
            }
            continue;
        }
        const float* pe = p.in[kind ? 11 : 8];
        const float* w1 = p.in[kind ? 12 : 9];
        const float* w2 = p.in[kind ? 13 : 10];
        {
            const int e = tid & 63, part = tid >> 6;
            float s = 0.f;
            for (int k = part * 512; k < part * 512 + 512; ++k) s += pe[k] * w1[(size_t)k * 64 + e];
            __syncthreads();
            hid[tid] = s;
            __syncthreads();
            if (tid < 64) cvec[tid] = hid[tid] + hid[64 + tid] + hid[128 + tid] + hid[192 + tid];
            __syncthreads();
        }
        if ((wave & 1) == 0) {
#pragma unroll
            for (int i = 0; i < 4; ++i)
#pragma unroll
                for (int j = 0; j < 4; ++j)
#pragma unroll
                    for (int r = 0; r < 4; ++r) {
                        const int row = G2_ROW(i, r), col = j * 16 + (lane & 15);
                        const float a = acc[i][j][r] + cvec[col];
                        hid[row * 65 + col] = a * sigmoidf_(a);
                    }
        }
        __syncthreads();
        const float gkn = p.in[5][lane];
        for (int row = wave; row < mrows; row += 4) {
            float o = 0.f;
#pragma unroll 8
            for (int e = 0; e < 64; ++e) o += hid[row * 65 + e] * w2[e * 64 + lane];
            if (kind == 0) o = o * rms64(o) * gkn;
            ((bf16_t*)(p.ws + (kind ? WS_VCB : WS_KCB)))[((size_t)g * 1024 + m0 + row) * 64 + lane] = (bf16_t)f2bf(o);
        }
        __syncthreads();
    }
    if (bid == nb - 1) {
        if (tid < 128) ((bf16_t*)(p.ws + WS_KCB))[((size_t)(tid >> 6) * 1024 + 1023) * 64 + (tid & 63)] = 0;
        else ((bf16_t*)(p.ws + WS_VCB))[((size_t)((tid - 128) >> 6) * 1024 + 1023) * 64 + (tid & 63)] = 0;
    }
}

constexpr int KSTR = 72;
constexpr int NSA_KT = 0;
constexpr int NSA_VT = NSA_KT + 32 * KSTR * 2;
constexpr int NSA_WV = NSA_VT + 32 * KSTR * 2;
constexpr int NSA_IMP = NSA_WV + 4 * 2 * 32 * KSTR * 2;
constexpr int NSA_LUT = NSA_IMP + 16 * 260 * 4;
constexpr int NSA_SEL = NSA_LUT + 4 * 128 * 4;
constexpr int NSA_STP = NSA_SEL + 16 * 16 * 4;
constexpr int NSA_END = NSA_STP + 4 * 128 * 4;
static_assert(NSA_END <= SMEM_BYTES, "nsa lds");

__device__ __forceinline__ f32x4 mfma16(bf16x8 a, bf16x8 b, f32x4 c) { return __builtin_amdgcn_mfma_f32_16x16x32_bf16(a, b, c, 0, 0, 0); }
__device__ __forceinline__ bf16x8 pack_p(const f32x4& p1, const f32x4& p2) {
    const unsigned a = pk2(p1[0], p1[1]), b = pk2(p1[2], p1[3]), c = pk2(p2[0], p2[1]), d = pk2(p2[2], p2[3]);
    return __builtin_bit_cast(bf16x8, make_uint4(a, b, c, d));
}
__device__ __forceinline__ void pv_step(f32x4 (&o)[4], const bf16_t* vt, bf16x8 pb, int fq, int fr) {
    const bf16_t* base = vt + (4 * fq + (fr >> 2)) * KSTR + 4 * (fr & 3);
#pragma unroll
    for (int dt = 0; dt < 4; ++dt) {
        const s16x4 lo4 = lds_tr16(base + dt * 16), hi4 = lds_tr16(base + 16 * KSTR + dt * 16);
        const bf16x8 va = (bf16x8){lo4[0], lo4[1], lo4[2], lo4[3], hi4[0], hi4[1], hi4[2], hi4[3]};
        o[dt] = mfma16(va, pb, o[dt]);
    }
}
__device__ __forceinline__ float quad_sum(float v) {
    v += __shfl_xor(v, 1);
    v += __shfl_xor(v, 2);
    return v;
}

__device__ __forceinline__ void nsa_tile(const Params& p, int tt, int g, unsigned char* smem) {
    const int tid = tid_opaque(), lane = tid & 63, wave = tid >> 6, fr = lane & 15, fq = lane >> 4;
    bf16_t* kt = (bf16_t*)(smem + NSA_KT);
    bf16_t* vt = (bf16_t*)(smem + NSA_VT);
    bf16_t* wv = (bf16_t*)(smem + NSA_WV) + wave * 2 * 32 * KSTR;
    float* imp = (float*)(smem + NSA_IMP);
    float* lut = (float*)(smem + NSA_LUT);
    int* sel = (int*)(smem + NSA_SEL);
    const bf16_t* qnb = (const bf16_t*)(p.ws + WS_QNB);
    const bf16_t* kslb = (const bf16_t*)(p.ws + WS_KSLB) + (size_t)g * S * 64;
    const bf16_t* vslb = (const bf16_t*)(p.ws + WS_VSLB) + (size_t)g * S * 64;
    const bf16_t* kwnb = (const bf16_t*)(p.ws + WS_KWNB) + (size_t)g * S * 64;
    const bf16_t* vwnb = (const bf16_t*)(p.ws + WS_VWNB) + (size_t)g * S * 64;
    const bf16_t* kcb = (const bf16_t*)(p.ws + WS_KCB) + (size_t)g * 1024 * 64;
    const bf16_t* vcb = (const bf16_t*)(p.ws + WS_VCB) + (size_t)g * 1024 * 64;
    const float* gt = (const float*)(p.ws + WS_GT);
    const float* relb = p.in[17];
    const int t0 = tt * 16;
    const int tl = 4 * wave + (fr >> 2);
    const int tok = t0 + tl;
    const int hl = fr & 3, head = g * 4 + hl;
    __syncthreads();
    for (int i = tid; i < 512; i += NT) { const int hh = i >> 7, n = i & 127; lut[i] = relb[bucket_of(n) * 16 + g * 4 + hh] * LOG2E; }
    for (int i = tid; i < 16 * 260; i += NT) imp[i] = 0.f;
    float U2;
    {
        const float mq = wave_max(fabsf(p.in[4][lane])), mk = wave_max(fabsf(p.in[5][lane]));
        float mb = 0.f;
#pragma unroll
        for (int k = 0; k < 4; ++k) { const int e = lane + 64 * k; mb = fmaxf(mb, fabsf(relb[(e >> 3) * 16 + (e & 7)])); }
        mb = wave_max(mb);
        U2 = (8.f * mq * mk + mb) * LOG2E;
    }
    bf16x8 qf[2];
#pragma unroll
    for (int kh = 0; kh < 2; ++kh) qf[kh] = *(const bf16x8*)(qnb + (size_t)tok * 512 + head * 64 + kh * 32 + fq * 8);
    __syncthreads();
    const float* lutp = lut + hl * 128;
    const float lutfar = lutp[127];
    const f32x4 zero4 = (f32x4){0.f, 0.f, 0.f, 0.f};
    f32x4 outacc[4];
#pragma unroll
    for (int dt = 0; dt < 4; ++dt) outacc[dt] = zero4;
    const float g0 = gt[(size_t)tok * 32 + head * 3 + 0], g1 = gt[(size_t)tok * 32 + head * 3 + 1], g2 = gt[(size_t)tok * 32 + head * 3 + 2];
    const int srow = tid >> 3, sch = tid & 7;

    bf16_t* ktb = (bf16_t*)(smem + NSA_WV);
    bf16_t* vtb = ktb + 2 * 64 * KSTR;
#define NSA_QK(KT_)                                                                                         \
        f32x4 s1 = zero4, s2 = zero4;                                                                       \
        _Pragma("unroll") for (int kh = 0; kh < 2; ++kh) {                                                  \
            const bf16x8 k1 = *(const bf16x8*)((KT_) + fr * KSTR + kh * 32 + fq * 8);                       \
            const bf16x8 k2 = *(const bf16x8*)((KT_) + (16 + fr) * KSTR + kh * 32 + fq * 8);                \
            s1 = mfma16(k1, qf[kh], s1);                                                                    \
            s2 = mfma16(k2, qf[kh], s2);                                                                    \
        }
    {
        int ks0 = (t0 - 511) & ~63; ks0 = ks0 < 0 ? 0 : ks0;
        const int nsteps = (t0 + 16 - ks0 + 63) >> 6;
        f32x4 o[4];
#pragma unroll
        for (int dt = 0; dt < 4; ++dt) o[dt] = zero4;
        float lsum = 0.f;
#define WIN_ROW(r_) ((r_) < S ? (r_) : S - 1)
        uint4 kr0 = *(const uint4*)(kwnb + (size_t)WIN_ROW(ks0 + srow) * 64 + sch * 8);
        uint4 kr1 = *(const uint4*)(kwnb + (size_t)WIN_ROW(ks0 + 32 + srow) * 64 + sch * 8);
        uint4 vr0 = *(const uint4*)(vwnb + (size_t)WIN_ROW(ks0 + srow) * 64 + sch * 8);
        uint4 vr1 = *(const uint4*)(vwnb + (size_t)WIN_ROW(ks0 + 32 + srow) * 64 + sch * 8);
#pragma unroll 1
        for (int st = 0; st < nsteps; ++st) {
            const int ksb = ks0 + st * 64;
            bf16_t* kt_ = ktb + (st & 1) * 64 * KSTR;
            bf16_t* vt_ = vtb + (st & 1) * 64 * KSTR;
            *(uint4*)(kt_ + srow * KSTR + sch * 8) = kr0; *(uint4*)(kt_ + (32 + srow) * KSTR + sch * 8) = kr1;
            *(uint4*)(vt_ + srow * KSTR + sch * 8) = vr0; *(uint4*)(vt_ + (32 + srow) * KSTR + sch * 8) = vr1;
            __syncthreads();
            if (st + 1 < nsteps) {
                kr0 = *(const uint4*)(kwnb + (size_t)WIN_ROW(ksb + 64 + srow) * 64 + sch * 8);
                kr1 = *(const uint4*)(kwnb + (size_t)WIN_ROW(ksb + 96 + srow) * 64 + sch * 8);
                vr0 = *(const uint4*)(vwnb + (size_t)WIN_ROW(ksb + 64 + srow) * 64 + sch * 8);
                vr1 = *(const uint4*)(vwnb + (size_t)WIN_ROW(ksb + 96 + srow) * 64 + sch * 8);
            }
#pragma unroll
            for (int hf = 0; hf < 2; ++hf) {
                const int ks = ksb + 32 * hf;
                if (ks > t0 + 15) continue;
                NSA_QK(kt_ + hf * 32 * KSTR)
                const bool far = (t0 + 4 * wave) - (ks + 31) >= 113;
                f32x4 p1, p2;
#pragma unroll
                for (int r = 0; r < 4; ++r) {
                    const int d1 = tok - (ks + 4 * fq + r), d2 = d1 - 16;
                    const float b1 = far ? lutfar : lutp[d1 < 0 ? 0 : (d1 > 127 ? 127 : d1)];
                    const float b2 = far ? lutfar : lutp[d2 < 0 ? 0 : (d2 > 127 ? 127 : d2)];
                    p1[r] = (d1 >= 0 && d1 < 512) ? __builtin_amdgcn_exp2f(s1[r] + b1 - U2) : 0.f;
                    p2[r] = (d2 >= 0 && d2 < 512) ? __builtin_amdgcn_exp2f(s2[r] + b2 - U2) : 0.f;
                    lsum += p1[r] + p2[r];
                }
                pv_step(o, vt_ + hf * 32 * KSTR, pack_p(p1, p2), fq, fr);
            }
        }
#undef WIN_ROW
        lsum += __shfl_xor(lsum, 16);
        lsum += __shfl_xor(lsum, 32);
        const float sc = lsum > 0.f ? g2 / lsum : 0.f;
#pragma unroll
        for (int dt = 0; dt < 4; ++dt)
#pragma unroll
            for (int r = 0; r < 4; ++r) outacc[dt][r] += sc * o[dt][r];
    }
    __syncthreads();

    {
        const int tlast = t0 + 15;
        const int cmax = (tlast >= 31) ? ((tlast - 31) >> 4) + 1 : 0;
        const int nsteps = (cmax + 63) >> 6;
        float inv_l = 0.f;
#pragma unroll 1
        for (int pass = 0; pass < 2; ++pass) {
            f32x4 o[4];
#pragma unroll
            for (int dt = 0; dt < 4; ++dt) o[dt] = zero4;
            float lsum = 0.f;
            uint4 kr0 = make_uint4(0, 0, 0, 0), kr1 = kr0, vr0 = kr0, vr1 = kr0;
            if (nsteps > 0) {
                kr0 = *(const uint4*)(kcb + (size_t)srow * 64 + sch * 8); kr1 = *(const uint4*)(kcb + (size_t)(32 + srow) * 64 + sch * 8);
                vr0 = *(const uint4*)(vcb + (size_t)srow * 64 + sch * 8); vr1 = *(const uint4*)(vcb + (size_t)(32 + srow) * 64 + sch * 8);
            }
#pragma unroll 1
            for (int st = 0; st < nsteps; ++st) {
                const int csb = st * 64;
                bf16_t* kt_ = ktb + (st & 1) * 64 * KSTR;
                bf16_t* vt_ = vtb + (st & 1) * 64 * KSTR;
                *(uint4*)(kt_ + srow * KSTR + sch * 8) = kr0; *(uint4*)(kt_ + (32 + srow) * KSTR + sch * 8) = kr1;
                *(uint4*)(vt_ + srow * KSTR + sch * 8) = vr0; *(uint4*)(vt_ + (32 + srow) * KSTR + sch * 8) = vr1;
                __syncthreads();
                if (st + 1 < nsteps) {
                    kr0 = *(const uint4*)(kcb + (size_t)(csb + 64 + srow) * 64 + sch * 8); kr1 = *(const uint4*)(kcb + (size_t)(csb + 96 + srow) * 64 + sch * 8);
                    vr0 = *(const uint4*)(vcb + (size_t)(csb + 64 + srow) * 64 + sch * 8); vr1 = *(const uint4*)(vcb + (size_t)(csb + 96 + srow) * 64 + sch * 8);
                }
#pragma unroll
                for (int hf = 0; hf < 2; ++hf) {
                    const int cs = csb + 32 * hf;
                    if (cs >= cmax) continue;
                    NSA_QK(kt_ + hf * 32 * KSTR)
                    const bool far = (t0 + 4 * wave) - (16 * (cs + 31) + 31) >= 113;
                    f32x4 p1, p2;
#pragma unroll
                    for (int r = 0; r < 4; ++r) {
                        const int d1 = tok - (16 * (cs + 4 * fq + r) + 31), d2 = d1 - 256;
                        const float b1 = far ? lutfar : lutp[d1 < 0 ? 0 : (d1 > 127 ? 127 : d1)];
                        const float b2 = far ? lutfar : lutp[d2 < 0 ? 0 : (d2 > 127 ? 127 : d2)];
                        p1[r] = (d1 >= 0) ? __builtin_amdgcn_exp2f(s1[r] + b1 - U2) : 0.f;
                        p2[r] = (d2 >= 0) ? __builtin_amdgcn_exp2f(s2[r] + b2 - U2) : 0.f;
                        lsum += p1[r] + p2[r];
                    }
                    if (pass == 1) {
#pragma unroll
                        for (int r = 0; r < 4; ++r) { p1[r] *= inv_l; p2[r] *= inv_l; }
                        f32x4 h1, h2;
#pragma unroll
                        for (int r = 0; r < 4; ++r) { h1[r] = quad_sum(p1[r]); h2[r] = quad_sum(p2[r]); }
                        if (hl == 0) {
                            float* ir = imp + tl * 260 + (cs >> 2) + fq;
                            atomicAdd(ir, h1[0] + h1[1] + h1[2] + 0.5f * h1[3]);
                            atomicAdd(ir + 1, 0.5f * h1[3]);
                            atomicAdd(ir + 4, h2[0] + h2[1] + h2[2] + 0.5f * h2[3]);
                            atomicAdd(ir + 5, 0.5f * h2[3]);
                        }
                        pv_step(o, vt_ + hf * 32 * KSTR, pack_p(p1, p2), fq, fr);
                    }
                }
            }
            __syncthreads();
            if (pass == 0) {
                lsum += __shfl_xor(lsum, 16);
                lsum += __shfl_xor(lsum, 32);
                inv_l = lsum > 0.f ? 1.f / lsum : 0.f;
            } else {
#pragma unroll
                for (int dt = 0; dt < 4; ++dt)
#pragma unroll
                    for (int r = 0; r < 4; ++r) outacc[dt][r] += g0 * o[dt][r];
            }
        }
    }
#undef NSA_QK
    __syncthreads();

#pragma unroll 1
    for (int tq = 0; tq < 4; ++tq) {
        const int tli = 4 * wave + tq, tk = t0 + tli, cur = tk >> 6;
        int* sl = sel + tli * 16;
        int nf = 0;
        if (lane == 0) {
            sl[0] = 0; int c_ = 1;
            if (cur - 1 >= 1) sl[c_++] = cur - 1;
            if (cur >= 1) sl[c_++] = cur;
            for (int k = c_; k < 16; ++k) sl[k] = -1;
        }
        nf = 1 + (cur - 1 >= 1 ? 1 : 0) + (cur >= 1 ? 1 : 0);
        const int ncand = cur - 2 > 0 ? cur - 2 : 0;
        int need = 16 - nf; need = need < ncand ? need : ncand;
        unsigned long long key[4];
#pragma unroll
        for (int k = 0; k < 4; ++k) {
            const int n = lane + 64 * k;
            const bool c = (n >= 1) && (n <= cur - 2);
            key[k] = c ? (((unsigned long long)__builtin_bit_cast(unsigned, imp[tli * 260 + n]) << 32) | (unsigned long long)(0xFFFFFFFFu - (unsigned)n)) + (1ull << 32) : 0ull;
        }
#pragma unroll 1
        for (int rd = 0; rd < need; ++rd) {
            unsigned long long m = key[0];
            m = key[1] > m ? key[1] : m; m = key[2] > m ? key[2] : m; m = key[3] > m ? key[3] : m;
#pragma unroll
            for (int o_ = 1; o_ < 64; o_ <<= 1) {
                const unsigned lo_ = __shfl_xor((unsigned)m, o_), hi_ = __shfl_xor((unsigned)(m >> 32), o_);
                const unsigned long long other = ((unsigned long long)hi_ << 32) | lo_;
                m = other > m ? other : m;
            }
            const int nstar = (int)(0xFFFFFFFFu - (unsigned)m);
#pragma unroll
            for (int k = 0; k < 4; ++k) if (key[k] == m) key[k] = 0ull;
            if (lane == 0) sl[nf + rd] = nstar;
        }
    }
    __syncthreads();

    {
        int* stp = (int*)(smem + NSA_STP) + wave * 128;
        int nst;
        {
            const int tq = lane >> 4, j = lane & 15;
            const int cur_ = (t0 + 4 * wave) >> 6;
            const int nf_ = 1 + (cur_ - 1 >= 1 ? 1 : 0) + (cur_ >= 1 ? 1 : 0);
            const bool shared = j < nf_;
            const int tk_ = shared ? t0 + 4 * wave + 3 : t0 + 4 * wave + tq;
            const int b = (shared && tq != 0) ? -1 : sel[(4 * wave + tq) * 16 + j];
            const int tqc = shared ? 4 : tq;
            const bool c1 = (b >= 0) && (b * 64 <= tk_), c2 = (b >= 0) && (b * 64 + 32 <= tk_);
            const unsigned long long m1 = __ballot(c1), m2 = __ballot(c2);
            const unsigned long long lt = (1ull << lane) - 1ull;
            const int pos = __builtin_popcountll(m1 & lt) + __builtin_popcountll(m2 & lt);
            if (c1) stp[pos] = (b * 64) | (tqc << 20);
            if (c2) stp[pos + 1] = (b * 64 + 32) | (tqc << 20);
            nst = __builtin_popcountll(m1) + __builtin_popcountll(m2);
        }
        asm volatile("" ::: "memory");
        uint2 oacc_pk[4];
#pragma unroll
        for (int dt = 0; dt < 4; ++dt) { oacc_pk[dt].x = pk2(outacc[dt][0], outacc[dt][1]); oacc_pk[dt].y = pk2(outacc[dt][2], outacc[dt][3]); }
        f32x4 o[4];
#pragma unroll
        for (int dt = 0; dt < 4; ++dt) o[dt] = zero4;
        float lsum = 0.f;
        const int r8 = lane >> 3, c8 = lane & 7;
        bf16_t* slot0 = wv;
        bf16_t* slot1 = wv + 32 * KSTR;
        bf16_t* kslot = (bf16_t*)(smem + NSA_IMP) + wave * 32 * 64;
        uint4 ka0, ka1, ka2, ka3, kb0, kb1, kb2, kb3;
        uint4 va0, va1, va2, va3;
#define SLC_STEP(i_) __builtin_amdgcn_readfirstlane(stp[(i_) < nst ? (i_) : nst - 1])
#define SLC_KLOAD(K_, w_)                                                                                           \
        { const uint4* kp_ = (const uint4*)(kslb + (size_t)(((w_) & 0xFFFFF) + r8) * 64 + c8 * 8);                      \
          K_##0 = kp_[0]; K_##1 = kp_[64]; K_##2 = kp_[128]; K_##3 = kp_[192]; }
#define SLC_VLOAD(V_, w_)                                                                                           \
        { const uint4* vs_ = (const uint4*)(vslb + (size_t)(((w_) & 0xFFFFF) + r8) * 64 + c8 * 8);                      \
          V_##0 = vs_[0]; V_##1 = vs_[64]; V_##2 = vs_[128]; V_##3 = vs_[192]; }
#define SLC_VSTORE(V_, slot_)                                                                                       \
        { bf16_t* vd_ = (slot_) + r8 * KSTR + c8 * 8;                                                               \
          *(uint4*)(vd_) = V_##0; *(uint4*)(vd_ + 8 * KSTR) = V_##1; *(uint4*)(vd_ + 16 * KSTR) = V_##2; *(uint4*)(vd_ + 24 * KSTR) = V_##3; }
#define SLC_KSTORE(K_)                                                                                              \
        { bf16_t* kd_ = kslot + r8 * 64 + ((c8 ^ r8) * 8);                                                          \
          *(uint4*)(kd_) = K_##0; *(uint4*)(kd_ + 8 * 64) = K_##1; *(uint4*)(kd_ + 16 * 64) = K_##2; *(uint4*)(kd_ + 24 * 64) = K_##3; }
#define SLC_STAGE(s_, K_, VW_, slotr_, slotw_)                                                                      \
        {                                                                                                           \
            const int wcur = SLC_STEP(s_), wk = SLC_STEP((s_) + 2);                                                 \
            SLC_KSTORE(K_)                                                            \
            SLC_VSTORE(VW_, slotw_)                                                      \
            asm volatile("" ::: "memory");                                                                          \
            SLC_VLOAD(VW_, wk)                                                                     \
            SLC_KLOAD(K_, wk)                                                                      \
            f32x4 s1 = zero4, s2 = zero4;                                                                           \
            _Pragma("unroll") for (int kh = 0; kh < 2; ++kh) {                                                      \
                const bf16x8 k1 = *(const bf16x8*)(kslot + fr * 64 + (((kh * 4 + fq) ^ (fr & 7)) * 8));             \
                const bf16x8 k2 = *(const bf16x8*)(kslot + (16 + fr) * 64 + (((kh * 4 + fq) ^ (fr & 7)) * 8));      \
                s1 = mfma16(k1, qf[kh], s1); s2 = mfma16(k2, qf[kh], s2);                                           \
            }                                                                                                       \
            const int ks = wcur & 0xFFFFF, tq = wcur >> 20;                                                         \
            const bool mine = (tq == 4) || ((fr >> 2) == tq);                                                       \
            const bool far = (t0 + 4 * wave + (tq == 4 ? 0 : tq)) - (ks + 31) >= 113;                               \
            f32x4 p1, p2;                                                                                           \
            _Pragma("unroll") for (int r = 0; r < 4; ++r) {                                                         \
                const int d1 = tok - (ks + 4 * fq + r), d2 = d1 - 16;                                               \
                const float b1 = far ? lutfar : lutp[d1 < 0 ? 0 : (d1 > 127 ? 127 : d1)];                           \
                const float b2 = far ? lutfar : lutp[d2 < 0 ? 0 : (d2 > 127 ? 127 : d2)];                           \
                p1[r] = (mine && d1 >= 0) ? __builtin_amdgcn_exp2f(s1[r] + b1 - U2) : 0.f;                          \
                p2[r] = (mine && d2 >= 0) ? __builtin_amdgcn_exp2f(s2[r] + b2 - U2) : 0.f;                          \
                lsum += p1[r] + p2[r];                                                                              \
            }                                                                                                       \
            asm volatile("" ::: "memory");                                                                          \
            pv_step(o, slotr_, pack_p(p1, p2), fq, fr);                                                             \
            asm volatile("" ::: "memory");                                                                          \
        }
        {
            const int w0 = SLC_STEP(0), w1 = SLC_STEP(1);
            SLC_VLOAD(va, w0)
            SLC_KLOAD(ka, w0)
            SLC_KLOAD(kb, w1)
            SLC_VSTORE(va, slot0)
            SLC_VLOAD(va, w1)
        }
#pragma unroll 1
        for (int s = 0; s < nst; s += 2) {
            SLC_STAGE(s, ka, va, slot0, slot1)
            if (s + 1 < nst) SLC_STAGE(s + 1, kb, va, slot1, slot0)
        }
#undef SLC_STEP
#undef SLC_KLOAD
#undef SLC_VLOAD
#undef SLC_VSTORE
#undef SLC_KSTORE
#undef SLC_STAGE
        lsum += __shfl_xor(lsum, 16);
        lsum += __shfl_xor(lsum, 32);
        const float sc = lsum > 0.f ? g1 / lsum : 0.f;
#pragma unroll
        for (int dt = 0; dt < 4; ++dt) {
            outacc[dt][0] = __builtin_bit_cast(float, oacc_pk[dt].x << 16) + sc * o[dt][0];
            outacc[dt][1] = __builtin_bit_cast(float, oacc_pk[dt].x & 0xffff0000u) + sc * o[dt][1];
            outacc[dt][2] = __builtin_bit_cast(float, oacc_pk[dt].y << 16) + sc * o[dt][2];
            outacc[dt][3] = __builtin_bit_cast(float, oacc_pk[dt].y & 0xffff0000u) + sc * o[dt][3];
        }
    }
    bf16_t* orow = (bf16_t*)(p.ws + WS_OA) + (size_t)tok * 512 + head * 64 + 4 * fq;
#pragma unroll
    for (int dt = 0; dt < 4; ++dt) {
        uint2 v; v.x = pk2(outacc[dt][0], outacc[dt][1]); v.y = pk2(outacc[dt][2], outacc[dt][3]);
        *(uint2*)(orow + dt * 16) = v;
    }
}

typedef float f32x16 __attribute__((ext_vector_type(16)));
constexpr int DSA_CK = 0;
constexpr int DSA_CI = DSA_CK + 16 * 512 * 4;
constexpr int DSA_LUT = DSA_CI + 16 * 512 * 2;
constexpr int DSA_END = DSA_LUT + 8 * 128 * 4;
static_assert(DSA_END <= SMEM_BYTES, "dsa lds");

__device__ __forceinline__ unsigned mono_key(float s) {
    const unsigned u = __builtin_bit_cast(unsigned, s + 0.0f);
    return (u & 0x80000000u) ? ~u : (u | 0x80000000u);
}
__device__ __forceinline__ unsigned dsa_compact(unsigned* ck, unsigned short* ci, int n, int lane) {
    unsigned kk[8]; unsigned ii[8];
#pragma unroll
    for (int k = 0; k < 8; ++k) { const int e = lane + 64 * k; kk[k] = e < n ? ck[e] : 0u; ii[k] = e < n ? (unsigned)ci[e] : 0xFFFFu; }
    unsigned T = 0;
#pragma unroll 1
    for (int b = 31; b >= 0; --b) {
        const unsigned cand = T | (1u << b);
        int c = 0;
#pragma unroll
        for (int k = 0; k < 8; ++k) c += __builtin_popcountll(__ballot(kk[k] >= cand));
        if (c >= 256) T = cand;
    }
    int cgt = 0, ceq = 0;
#pragma unroll
    for (int k = 0; k < 8; ++k) { cgt += __builtin_popcountll(__ballot(kk[k] > T)); ceq += __builtin_popcountll(__ballot(kk[k] == T)); }
    const int need = 256 - cgt;
    unsigned X = 0xFFFFu;
    if (ceq > need) {
        X = 0;
#pragma unroll 1
        for (int b = 15; b >= 0; --b) {
            const unsigned cand = X | (1u << b);
            int c = 0;
#pragma unroll
            for (int k = 0; k < 8; ++k) c += __builtin_popcountll(__ballot(kk[k] == T && ii[k] < cand));
            if (c < need) X = cand;
        }
    }
    int base = 0;
    const unsigned long long lt = (1ull << lane) - 1ull;
#pragma unroll
    for (int k = 0; k < 8; ++k) {
        const bool keep = (kk[k] > T) || (kk[k] == T && ii[k] <= X);
        const unsigned long long m = __ballot(keep);
        if (keep) { const int pos = base + __builtin_popcountll(m & lt); ck[pos] = kk[k]; ci[pos] = (unsigned short)ii[k]; }
        base += __builtin_popcountll(m);
    }
    return T;
}

__device__ __forceinline__ void dsa_tile(const Params& p, int tt, unsigned char* smem) {
    const int tid = tid_opaque(), lane = tid & 63, wave = tid >> 6, col = lane & 31, hi = lane >> 5;
    unsigned* ckb = (unsigned*)(smem + DSA_CK);
    unsigned short* cib = (unsigned short*)(smem + DSA_CI);
    const bf16_t* iqb = (const bf16_t*)(p.ws + WS_IQB);
    const bf16_t* ikb = (const bf16_t*)(p.ws + WS_IKB);
    const float* iws = (const float*)(p.ws + WS_IWS);
    const int t0 = tt * 16;
    __syncthreads();
    const int tw = t0 + 4 * wave;
    bf16x8 af[2];
    {
        const int rho = col;
        const int tl_ = 2 * ((rho >> 2) & 1) + (rho >> 4), hd = 4 * ((rho >> 3) & 1) + (rho & 3);
#pragma unroll
        for (int ks = 0; ks < 2; ++ks) af[ks] = *(const bf16x8*)(iqb + (size_t)(tw + tl_) * 256 + hd * 32 + ks * 16 + hi * 8);
    }
    const int tokA = tw + 2 * hi, tokB = tokA + 1;
    float wA[8], wB[8];
#pragma unroll
    for (int h = 0; h < 8; ++h) { wA[h] = iws[(size_t)tokA * 8 + h]; wB[h] = iws[(size_t)tokB * 8 + h]; }
    unsigned* ckA = ckb + (4 * wave + 2 * hi) * 512;
    unsigned* ckB = ckA + 512;
    unsigned short* ciA = cib + (4 * wave + 2 * hi) * 512;
    unsigned short* ciB = ciA + 512;
    int cntA = 0, cntB = 0;
    unsigned LA = 0, LB = 0;
    const unsigned ltm = (1u << col) - 1u;
    const int nchunk = (tw + 4 + 31) >> 5;
    const f32x16 zero16 = {0.f, 0.f, 0.f, 0.f, 0.f, 0.f, 0.f, 0.f, 0.f, 0.f, 0.f, 0.f, 0.f, 0.f, 0.f, 0.f};
    bf16x8 nx0[4], nx1[4];
    const bf16_t* ikl = ikb + (size_t)col * 32 + hi * 8;
#pragma unroll
    for (int j = 0; j < 4; ++j) {
        const int cj = j < nchunk ? j : nchunk - 1;
        nx0[j] = *(const bf16x8*)(ikl + (size_t)cj * 1024); nx1[j] = *(const bf16x8*)(ikl + (size_t)cj * 1024 + 16);
    }
#pragma unroll 1
    for (int ch4 = 0; ch4 < nchunk; ch4 += 4) {
#pragma unroll
        for (int j = 0; j < 4; ++j) {
            const int ch = ch4 + j;
            const bf16x8 cu0 = nx0[j], cu1 = nx1[j];
            {
                int cj = ch + 4; cj = cj < nchunk ? cj : nchunk - 1;
                nx0[j] = *(const bf16x8*)(ikl + (size_t)cj * 1024); nx1[j] = *(const bf16x8*)(ikl + (size_t)cj * 1024 + 16);
            }
            if (ch < nchunk) {
                const int kidx = ch * 32 + col;
                f32x16 c = __builtin_amdgcn_mfma_f32_32x32x16_bf16(af[0], cu0, zero16, 0, 0, 0);
                c = __builtin_amdgcn_mfma_f32_32x32x16_bf16(af[1], cu1, c, 0, 0, 0);
                float sA = 0.f, sB = 0.f;
#pragma unroll
                for (int h = 0; h < 8; ++h) { sA += wA[h] * fmaxf(c[h], 0.f); sB += wB[h] * fmaxf(c[8 + h], 0.f); }
                const unsigned keyA = mono_key(sA), keyB = mono_key(sB);
                const bool pA = (kidx <= tokA) && (keyA > LA), pB = (kidx <= tokB) && (keyB > LB);
                const unsigned long long mA = __ballot(pA), mB = __ballot(pB);
                const unsigned hA = hi ? (unsigned)(mA >> 32) : (unsigned)mA, hB = hi ? (unsigned)(mB >> 32) : (unsigned)mB;
                if (pA) { const int pos = cntA + __builtin_popcount(hA & ltm); ckA[pos] = keyA; ciA[pos] = (unsigned short)kidx; }
                if (pB) { const int pos = cntB + __builtin_popcount(hB & ltm); ckB[pos] = keyB; ciB[pos] = (unsigned short)kidx; }
                cntA += __builtin_popcount(hA); cntB += __builtin_popcount(hB);
            }
            if (!(j & 1)) continue;
        if (__any((cntA > 448) || (cntB > 448))) {
#pragma unroll
            for (int tq = 0; tq < 4; ++tq) {
                const int cn = __shfl((tq & 1) ? cntB : cntA, (tq >> 1) * 32);
                if (cn > 448) {
                    const unsigned T = dsa_compact(ckb + (4 * wave + tq) * 512, cib + (4 * wave + tq) * 512, cn, lane);
                    if (hi == (tq >> 1)) { if (tq & 1) { cntB = 256; LB = T; } else { cntA = 256; LA = T; } }
                }
            }
        }
    }
    }
#pragma unroll
    for (int tq = 0; tq < 4; ++tq) {
        const int cn = __shfl((tq & 1) ? cntB : cntA, (tq >> 1) * 32);
        if (cn > 256) {
            (void)dsa_compact(ckb + (4 * wave + tq) * 512, cib + (4 * wave + tq) * 512, cn, lane);
            if (hi == (tq >> 1)) { if (tq & 1) cntB = 256; else cntA = 256; }
        }
    }
    unsigned short* selg = (unsigned short*)(p.ws + WS_SEL);
    int* nselg = (int*)(p.ws + WS_NSEL);
#pragma unroll
    for (int tq = 0; tq < 4; ++tq) {
        int nsel = __shfl((tq & 1) ? cntB : cntA, (tq >> 1) * 32);
        nsel = nsel > 256 ? 256 : nsel;
        const unsigned short* sl = cib + (4 * wave + tq) * 512;
#pragma unroll
        for (int k = 0; k < 4; ++k) { const int e = lane + 64 * k; selg[(size_t)(tw + tq) * 256 + e] = e < nsel ? sl[e] : (unsigned short)0; }
        if (lane == 0) nselg[tw + tq] = nsel;
    }
}

__device__ __forceinline__ void phase_dsa_attn(const Params& p, int bid, int nb, unsigned char* smem) {
    const int tid = tid_opaque(), lane = tid & 63, wave = tid >> 6, slot = lane >> 3, chunk = lane & 7;
    float* lut = (float*)smem;
    const bf16_t* dqb = (const bf16_t*)(p.ws + WS_DQB);
    const bf16_t* dkb = (const bf16_t*)(p.ws + WS_DKB);
    const bf16_t* dvb = (const bf16_t*)(p.ws + WS_DVB);
    const unsigned short* selg = (const unsigned short*)(p.ws + WS_SEL);
    const int* nselg = (const int*)(p.ws + WS_NSEL);
    const float* relb = p.in[17];
    const int h = bid & 7, bh = bid >> 3, nbh = nb >> 3;
    __syncthreads();
    if (tid < 128) lut[tid] = relb[bucket_of(tid) * 16 + 8 + h] * LOG2E;
    float U2;
    {
        const float mq = wave_max(fabsf(p.in[6][lane])), mk = wave_max(fabsf(p.in[7][lane]));
        float mb = 0.f;
#pragma unroll
        for (int k = 0; k < 4; ++k) { const int e = lane + 64 * k; mb = fmaxf(mb, fabsf(relb[(e >> 3) * 16 + 8 + (e & 7)])); }
        mb = wave_max(mb);
        U2 = (8.f * mq * mk + mb) * LOG2E;
    }
    __syncthreads();
    const bf16_t* kbase = dkb + h * 64 + chunk * 8;
    const bf16_t* vbase = dvb + h * 64 + chunk * 8;
#pragma unroll 1
    for (int t = bh * 4 + wave; t < S; t += nbh * 4) {
        const int nsel = nselg[t];
        const uint2* ip = (const uint2*)(selg + (size_t)t * 256 + slot * 32);
        float q[8];
        {
            const uint4 qv = *(const uint4*)(dqb + (size_t)t * 512 + h * 64 + chunk * 8);
            q[0] = __builtin_bit_cast(float, qv.x << 16); q[1] = __builtin_bit_cast(float, qv.x & 0xffff0000u);
            q[2] = __builtin_bit_cast(float, qv.y << 16); q[3] = __builtin_bit_cast(float, qv.y & 0xffff0000u);
            q[4] = __builtin_bit_cast(float, qv.z << 16); q[5] = __builtin_bit_cast(float, qv.z & 0xffff0000u);
            q[6] = __builtin_bit_cast(float, qv.w << 16); q[7] = __builtin_bit_cast(float, qv.w & 0xffff0000u);
        }
        float o[8];
#pragma unroll
        for (int j = 0; j < 8; ++j) o[j] = 0.f;
        float lsum = 0.f;
        int sA_[4], sB_[4];
        uint4 kA_[4], vA_[4], kB_[4], vB_[4];
        uint2 idn = ip[0];
#define DSA_LOADG(S_, K_, V_, I_)                                                        \
        S_[0] = (int)((I_).x & 0xffffu); S_[1] = (int)((I_).x >> 16); S_[2] = (int)((I_).y & 0xffffu); S_[3] = (int)((I_).y >> 16); \
        _Pragma("unroll") for (int j = 0; j < 4; ++j) {                                 \
            K_[j] = *(const uint4*)(kbase + (size_t)S_[j] * 512);                        \
            V_[j] = *(const uint4*)(vbase + (size_t)S_[j] * 512);                        \
        }
#define DSA_COMPG(S_, K_, V_, gi)                                                        \
        _Pragma("unroll") for (int j = 0; j < 4; ++j) {                                 \
            const uint4 kv = K_[j], vv = V_[j];                                          \
            float d = q[0] * __builtin_bit_cast(float, kv.x << 16) + q[1] * __builtin_bit_cast(float, kv.x & 0xffff0000u) \
                    + q[2] * __builtin_bit_cast(float, kv.y << 16) + q[3] * __builtin_bit_cast(float, kv.y & 0xffff0000u) \
                    + q[4] * __builtin_bit_cast(float, kv.z << 16) + q[5] * __builtin_bit_cast(float, kv.z & 0xffff0000u) \
                    + q[6] * __builtin_bit_cast(float, kv.w << 16) + q[7] * __builtin_bit_cast(float, kv.w & 0xffff0000u); \
            d += __shfl_xor(d, 1); d += __shfl_xor(d, 2); d += __shfl_xor(d, 4);       \
            int dist = t - S_[j]; dist = dist > 127 ? 127 : (dist < 0 ? 0 : dist);       \
            float pr = __builtin_amdgcn_exp2f(d + lut[dist] - U2);                       \
            pr = (slot * 32 + (gi) * 4 + j < nsel) ? pr : 0.f;                           \
            lsum += pr;                                                                  \
            o[0] += pr * __builtin_bit_cast(float, vv.x << 16); o[1] += pr * __builtin_bit_cast(float, vv.x & 0xffff0000u); \
            o[2] += pr * __builtin_bit_cast(float, vv.y << 16); o[3] += pr * __builtin_bit_cast(float, vv.y & 0xffff0000u); \
            o[4] += pr * __builtin_bit_cast(float, vv.z << 16); o[5] += pr * __builtin_bit_cast(float, vv.z & 0xffff0000u); \
            o[6] += pr * __builtin_bit_cast(float, vv.w << 16); o[7] += pr * __builtin_bit_cast(float, vv.w & 0xffff0000u); \
        }
        DSA_LOADG(sA_, kA_, vA_, idn)
        idn = ip[1];
#pragma unroll 1
        for (int gi = 0; gi < 8; gi += 2) {
            DSA_LOADG(sB_, kB_, vB_, idn)
            idn = ip[gi + 2 < 8 ? gi + 2 : 7];
            DSA_COMPG(sA_, kA_, vA_, gi)
            DSA_LOADG(sA_, kA_, vA_, idn)
            idn = ip[gi + 3 < 8 ? gi + 3 : 7];
            DSA_COMPG(sB_, kB_, vB_, gi + 1)
        }
#undef DSA_LOADG
#undef DSA_COMPG
#pragma unroll
        for (int j = 0; j < 8; ++j) { o[j] += __shfl_xor(o[j], 8); o[j] += __shfl_xor(o[j], 16); o[j] += __shfl_xor(o[j], 32); }
        lsum += __shfl_xor(lsum, 8); lsum += __shfl_xor(lsum, 16); lsum += __shfl_xor(lsum, 32);
        if (slot == 0) {
            const float inv = lsum > 0.f ? 1.f / lsum : 0.f;
            uint4 ov;
            ov.x = pk2(o[0] * inv, o[1] * inv); ov.y = pk2(o[2] * inv, o[3] * inv); ov.z = pk2(o[4] * inv, o[5] * inv); ov.w = pk2(o[6] * inv, o[7] * inv);
            *(uint4*)((bf16_t*)(p.ws + WS_OB) + (size_t)t * 512 + h * 64 + chunk * 8) = ov;
        }
    }
}

__device__ __forceinline__ void convert_late_weights(const Params& p, int bid, int nb) {
    cvt_weights(p.in[21], (bf16_t*)(p.ws + WB_E1), (size_t)NEXP * D * 2 * DFF, bid, nb);
    cvt_weights(p.in[23], (bf16_t*)(p.ws + WB_E2), (size_t)NEXP * DFF * D, bid, nb);
    cvt_weights(p.in[27], (bf16_t*)(p.ws + WB_PLEG), (size_t)D * D, bid, nb);
}
__device__ __forceinline__ void phase_attn(const Params& p, int bid, int nb, unsigned char* smem) {
    const bool conv_first = bid < (nb >> 1);
    if (conv_first) convert_late_weights(p, bid, nb);
#pragma unroll 1
    for (int part = 0; part < 2; ++part) {
        if ((part == 0) == conv_first) {
#pragma unroll 1
        for (int w = bid, rd = 0; w < 1024; w += nb, ++rd) {
            const int r0 = w - bid;
            const int cnt = (1024 - r0) < nb ? (1024 - r0) : nb;
            const int k = (rd & 1) ? (cnt - 1 - bid) : bid;
            dsa_tile(p, 1023 - (r0 + k), smem);
        }
    }
        else {
#pragma unroll 1
        for (int i = bid, rd = 0; i < 2048; i += nb, ++rd) {
            const int r0 = i - bid;
            const int cnt = (2048 - r0) < nb ? (2048 - r0) : nb;
            const int k = ((rd & 1) && !(cnt & 1)) ? 2 * ((cnt >> 1) - 1 - (bid >> 1)) + (bid & 1) : bid;
            const int j = r0 + k;
            nsa_tile(p, 1023 - (j >> 1), j & 1, smem);
        }
    }
    }
    if (!conv_first) convert_late_weights(p, bid, nb);
}

template <int PASS>
__device__ __forceinline__ void phase_merge(const Params& p, int bid, int nb, unsigned char* smem) {
    const int g2tid = tid_opaque();
    const bf16_t* sg = (const bf16_t*)(p.ws + (PASS ? WS_SGB : WS_SGA));
    bf16_t* merged = (bf16_t*)(p.ws + WS_MERGED);
    float* tmp = (float*)(p.ws + WS_X1);
    const bf16_t* A = (const bf16_t*)(p.ws + (PASS ? WS_OB : WS_OA));
    const bf16_t* Bw = (const bf16_t*)(p.ws + (PASS ? WB_B : WB_A));
    for (int w = bid; w < 128 * 8; w += nb) {
        const int mt = w % 128, nt = w / 128;
        const int m0 = mt * 128, n0 = nt * 128;
        f32x4 acc[4][4];
        gemm2<false, false>(A, 512, nullptr, m0, 128, Bw, D, n0, 128, 512, smem, acc);
#pragma unroll
        for (int i = 0; i < 4; ++i) {
            float vv[4][4];
#pragma unroll
            for (int r = 0; r < 4; ++r) {
                const int row = m0 + G2_ROW(i, r);
                const bf16_t* zr = sg + (size_t)row * D + n0 + G2_COL(0);
                float* tr = tmp + (size_t)row * D + n0 + G2_COL(0);
#pragma unroll
                for (int j = 0; j < 4; ++j) {
                    const float v = bf2f(zr[j * 16]) * acc[i][j][r];
                    if (PASS == 0) tr[j * 16] = v;
                    else vv[j][r] = tr[j * 16] + v;
                }
            }
            if (PASS == 1) {
                bf16_t* mr = merged + (size_t)(m0 + G2_ROW(i, 0)) * D + n0 + G2_COL(0);
#pragma unroll
                for (int j = 0; j < 4; ++j) store_bf16_frag(mr + j * 16, D, vv[j][0], vv[j][1], vv[j][2], vv[j][3], g2tid & 63);
            }
        }
    }
}

__device__ __forceinline__ void phase_outproj(const Params& p, int bid, int nb, unsigned char* smem) {
    const int g2tid = tid_opaque();
    const bf16_t* merged = (const bf16_t*)(p.ws + WS_MERGED);
    const float* x = p.in[0];
    float* x1 = (float*)(p.ws + WS_X1);
    for (int w = bid; w < 128 * 8; w += nb) {
        const int mt = w % 128, nt = w / 128;
        const int m0 = mt * 128, n0 = nt * 128;
        f32x4 acc[4][4];
        gemm2<false, false>(merged, D, nullptr, m0, 128, (const bf16_t*)(p.ws + WB_OUT), D, n0, 128, D, smem, acc);
#pragma unroll
        for (int i = 0; i < 4; ++i)
#pragma unroll
            for (int r = 0; r < 4; ++r) {
                const size_t ro = (size_t)(m0 + G2_ROW(i, r)) * D + n0;
#pragma unroll
                for (int j = 0; j < 4; ++j) { const int c = G2_COL(j); x1[ro + c] = x[ro + c] + acc[i][j][r]; }
            }
    }
}

__device__ __forceinline__ void phase_route(const Params& p, int bid, int nb, unsigned char* smem) {
    const int lane = tid_opaque() & 63, wave = tid_opaque() >> 6;
    const float* x1 = (const float*)(p.ws + WS_X1);
    const float* g = p.in[18];
    const float* wr = p.in[19];
    const float* br = p.in[20];
    bf16_t* hb = (bf16_t*)(p.ws + WS_HB);
    int* topi = (int*)(p.ws + WS_TOPI);
    float* topw = (float*)(p.ws + WS_TOPW);
    int* cnt = (int*)(p.ws + WS_CTL);
    float* hl = (float*)smem + wave * 1056;
    const int ksub = lane >> 3, e4 = lane & 7;
    __syncthreads();
    for (int t = bid * 4 + wave; t < S; t += nb * 4) {
        const float4* xr = (const float4*)(x1 + (size_t)t * D);
        float4 v[4];
        float ss = 0.f;
#pragma unroll
        for (int j = 0; j < 4; ++j) { v[j] = xr[lane + 64 * j]; ss += v[j].x * v[j].x + v[j].y * v[j].y + v[j].z * v[j].z + v[j].w * v[j].w; }
        ss = wave_sum(ss);
        const float rstd = rsqrtf(ss * (1.f / D) + EPS);
#pragma unroll
        for (int j = 0; j < 4; ++j) {
            const float4 gg = ((const float4*)g)[lane + 64 * j];
            const float4 h4 = make_float4(v[j].x * rstd * gg.x, v[j].y * rstd * gg.y, v[j].z * rstd * gg.z, v[j].w * rstd * gg.w);
            uint2 o; o.x = pk2(h4.x, h4.y); o.y = pk2(h4.z, h4.w);
            ((uint2*)(hb + (size_t)t * D))[lane + 64 * j] = o;
            ((float4*)hl)[lane + 64 * j] = h4;
        }
        asm volatile("" ::: "memory");
        float4 acc = make_float4(0.f, 0.f, 0.f, 0.f);
        const float4* wp = (const float4*)(wr + (size_t)ksub * 32) + e4;
#pragma unroll 8
        for (int i = 0; i < 128; ++i) {
            const float hk = hl[8 * i + ksub];
            const float4 w4 = wp[(size_t)i * 64];
            acc.x += hk * w4.x; acc.y += hk * w4.y; acc.z += hk * w4.z; acc.w += hk * w4.w;
        }
#pragma unroll
        for (int o_ = 8; o_ < 64; o_ <<= 1) { acc.x += __shfl_xor(acc.x, o_); acc.y += __shfl_xor(acc.y, o_); acc.z += __shfl_xor(acc.z, o_); acc.w += __shfl_xor(acc.w, o_); }
        if (ksub == 0) {
            const float4 b4 = ((const float4*)br)[e4];
            ((float4*)(hl + 1024))[e4] = make_float4(acc.x + b4.x, acc.y + b4.y, acc.z + b4.z, acc.w + b4.w);
        }
        asm volatile("" ::: "memory");
        float lg[32];
#pragma unroll
        for (int e = 0; e < 8; ++e) { const float4 l4 = ((const float4*)(hl + 1024))[e]; lg[4 * e] = l4.x; lg[4 * e + 1] = l4.y; lg[4 * e + 2] = l4.z; lg[4 * e + 3] = l4.w; }
        asm volatile("" ::: "memory");
        int idx[4]; float val[4];
        unsigned used = 0;
#pragma unroll
        for (int k = 0; k < 4; ++k) {
            float best = -__builtin_inff(); int bi = 0;
#pragma unroll
            for (int e = 0; e < 32; ++e) { const bool ok = !((used >> e) & 1u) && (lg[e] > best); best = ok ? lg[e] : best; bi = ok ? e : bi; }
            idx[k] = bi; val[k] = best; used |= 1u << bi;
        }
        const float e0 = 1.f, e1 = __expf(val[1] - val[0]), e2 = __expf(val[2] - val[0]), e3 = __expf(val[3] - val[0]);
        const float inv = 1.f / (e0 + e1 + e2 + e3);
        if (lane == 0) {
            topi[t * 4 + 0] = idx[0]; topi[t * 4 + 1] = idx[1]; topi[t * 4 + 2] = idx[2]; topi[t * 4 + 3] = idx[3];
            topw[t * 4 + 0] = e0 * inv; topw[t * 4 + 1] = e1 * inv; topw[t * 4 + 2] = e2 * inv; topw[t * 4 + 3] = e3 * inv;
            atomicAdd(&cnt[idx[0]], 1); atomicAdd(&cnt[idx[1]], 1); atomicAdd(&cnt[idx[2]], 1); atomicAdd(&cnt[idx[3]], 1);
        }
    }
}

__device__ __forceinline__ void phase_place(const Params& p, int bid, int nb, unsigned char* smem) {
    int* off = (int*)smem;
    const int* cnt = (const int*)(p.ws + WS_CTL);
    int* cur = (int*)(p.ws + WS_CTL) + 32;
    const int* topi = (const int*)(p.ws + WS_TOPI);
    int* ppos = (int*)(p.ws + WS_PPOS);
    int* rowtok = (int*)(p.ws + WS_ROWTOK);
    __syncthreads();
    if (tid_opaque() == 0) { int a = 0; for (int e = 0; e < NEXP; ++e) { off[e] = a; a += cnt[e]; } }
    __syncthreads();
    for (int i = bid * NT + tid_opaque(); i < S * 4; i += nb * NT) {
        const int e = topi[i];
        const int pos = off[e] + atomicAdd(&cur[e], 1);
        ppos[i] = pos;
        rowtok[pos] = i >> 2;
    }
}

__device__ __forceinline__ void moe_tile_map(const int* cnt, int* sm, int& total_mt) {
    __syncthreads();
    if (tid_opaque() == 0) {
        int a = 0, b = 0;
        for (int e = 0; e < NEXP; ++e) { sm[e] = a; sm[33 + e] = b; a += (cnt[e] + 127) >> 7; b += cnt[e]; }
        sm[32] = a; sm[65] = b;
    }
    __syncthreads();
    total_mt = sm[32];
}
__device__ __forceinline__ void phase_moe1(const Params& p, int bid, int nb, unsigned char* smem) {
    const int g2tid = tid_opaque();
    int* sm = (int*)(smem + 65536);
    const int* cnt = (const int*)(p.ws + WS_CTL);
    const int* rowtok = (const int*)(p.ws + WS_ROWTOK);
    const bf16_t* hb = (const bf16_t*)(p.ws + WS_HB);
    bf16_t* act = (bf16_t*)(p.ws + WS_ACT);
    const int lane = tid_opaque() & 63, wave = tid_opaque() >> 6;
    int total_mt;
    moe_tile_map(cnt, sm, total_mt);
    for (int w = bid; w < total_mt * 16; w += nb) {
        const int tm = w >> 4, nt = w & 15;
        int e = 0;
        while (e < NEXP - 1 && sm[e + 1] <= tm) ++e;
        const int mt = tm - sm[e];
        const int rbase = sm[33 + e] + mt * 128;
        const int mrows = min(128, cnt[e] - mt * 128);
        const int n0 = nt * 64;
        f32x4 acc[4][4];
        gemm2<true, true>(hb, D, rowtok, rbase, mrows, (const bf16_t*)(p.ws + WB_E1) + (size_t)e * D * 2 * DFF, 2 * DFF, n0, 128, D, smem, acc);
        const float* b1 = p.in[22] + (size_t)e * 2 * DFF;
        const int wn_ = (tid_opaque() >> 6) & 1;
#pragma unroll
        for (int i = 0; i < 4; ++i)
#pragma unroll
            for (int jp = 0; jp < 2; ++jp) {
                const int col = n0 + (wn_ * 2 + jp) * 16 + (tid_opaque() & 15);
                const float bg = b1[col], bl = b1[DFF + col];
                float av[4];
                unsigned rmask = 0;
#pragma unroll
                for (int r = 0; r < 4; ++r) {
                    const int rl = G2_ROW(i, r);
                    const float gate = fminf(acc[i][2 * jp][r] + bg, 7.f);
                    const float lin = fminf(fmaxf(acc[i][2 * jp + 1][r] + bl, -7.f), 7.f);
                    av[r] = (lin + 1.f) * gate * sigmoidf_(1.702f * gate);
                    rmask |= (rl < mrows) ? (1u << r) : 0u;
                }
                store_bf16_frag(act + (size_t)(rbase + G2_ROW(i, 0)) * DFF + col, DFF, av[0], av[1], av[2], av[3], g2tid & 63, rmask);
            }
    }
}
__device__ __forceinline__ void phase_moe2(const Params& p, int bid, int nb, unsigned char* smem) {
    const int g2tid = tid_opaque();
    int* sm = (int*)(smem + 65536);
    const int* cnt = (const int*)(p.ws + WS_CTL);
    const bf16_t* act = (const bf16_t*)(p.ws + WS_ACT);
    float* yrows = (float*)(p.ws + WS_YROWS);
    const int lane = tid_opaque() & 63, wave = tid_opaque() >> 6;
    int total_mt;
    moe_tile_map(cnt, sm, total_mt);
    for (int w = bid; w < total_mt * 8; w += nb) {
        const int tm = w >> 3, nt = w & 7;
        int e = 0;
        while (e < NEXP - 1 && sm[e + 1] <= tm) ++e;
        const int mt = tm - sm[e];
        const int rbase = sm[33 + e] + mt * 128;
        const int mrows = min(128, cnt[e] - mt * 128);
        const int n0 = nt * 128;
        f32x4 acc[4][4];
        gemm2<false, false>(act, DFF, nullptr, rbase, mrows, (const bf16_t*)(p.ws + WB_E2) + (size_t)e * DFF * D, D, n0, 128, DFF, smem, acc);
        const float* b2 = p.in[24] + (size_t)e * D + n0;
#pragma unroll
        for (int i = 0; i < 4; ++i)
#pragma unroll
            for (int r = 0; r < 4; ++r) {
                const int rl = G2_ROW(i, r);
                if (rl < mrows) {
                    float* yr = yrows + (size_t)(rbase + rl) * D + n0;
#pragma unroll
                    for (int j = 0; j < 4; ++j) { const int c = G2_COL(j); yr[c] = acc[i][j][r] + b2[c]; }
                }
            }
    }
}

__device__ __forceinline__ void phase_combine(const Params& p, int bid, int nb) {
    const int lane = tid_opaque() & 63, wave = tid_opaque() >> 6;
    const float* x1 = (const float*)(p.ws + WS_X1);
    const float* yrows = (const float*)(p.ws + WS_YROWS);
    const int* ppos = (const int*)(p.ws + WS_PPOS);
    const float* topw = (const float*)(p.ws + WS_TOPW);
    const float* g = p.in[25];
    bf16_t* hb = (bf16_t*)(p.ws + WS_HB);
    bf16_t* pb = (bf16_t*)(p.ws + WS_PB);
    for (int t = bid * 4 + wave; t < S; t += nb * 4) {
        float4 v[4];
#pragma unroll
        for (int j = 0; j < 4; ++j) v[j] = ((const float4*)(x1 + (size_t)t * D))[lane + 64 * j];
#pragma unroll
        for (int k = 0; k < 4; ++k) {
            const float wk = topw[t * 4 + k];
            const float4* yr = (const float4*)(yrows + (size_t)ppos[t * 4 + k] * D);
#pragma unroll
            for (int j = 0; j < 4; ++j) { const float4 y = yr[lane + 64 * j]; v[j].x += wk * y.x; v[j].y += wk * y.y; v[j].z += wk * y.z; v[j].w += wk * y.w; }
        }
        float ss = 0.f;
#pragma unroll
        for (int j = 0; j < 4; ++j) ss += v[j].x * v[j].x + v[j].y * v[j].y + v[j].z * v[j].z + v[j].w * v[j].w;
        ss = wave_sum(ss);
        const float rstd = rsqrtf(ss * (1.f / D) + EPS);
#pragma unroll
        for (int j = 0; j < 4; ++j) {
            ((float4*)(p.out + (size_t)t * D))[lane + 64 * j] = v[j];
            const float4 gg = ((const float4*)g)[lane + 64 * j];
            uint2 o;
            o.x = pk2(v[j].x * rstd * gg.x, v[j].y * rstd * gg.y);
            o.y = pk2(v[j].z * rstd * gg.z, v[j].w * rstd * gg.w);
            ((uint2*)(hb + (size_t)t * D))[lane + 64 * j] = o;
        }
    }
}

__device__ __forceinline__ void phase_ple(const Params& p, int bid, int nb, unsigned char* smem) {
    const int g2tid = tid_opaque();
    const bf16_t* pw = (const bf16_t*)(p.ws + WS_PW);
    for (int w = bid; w < 128 * 8; w += nb) {
        const int mt = w % 128, nt = w / 128;
        const int m0 = mt * 128, n0 = nt * 128;
        f32x4 acc[4][4];
        gemm2<false, false>((const bf16_t*)(p.ws + WS_HB), D, nullptr, m0, 128, (const bf16_t*)(p.ws + WB_PLEG), D, n0, 128, D, smem, acc);
#pragma unroll
        for (int i = 0; i < 4; ++i)
#pragma unroll
            for (int r = 0; r < 4; ++r) {
                const size_t ro = (size_t)(m0 + G2_ROW(i, r)) * D + n0 + G2_COL(0);
                float* orow = p.out + ro;
#pragma unroll
                for (int j = 0; j < 4; ++j) orow[j * 16] = orow[j * 16] + sigmoidf_(acc[i][j][r]) * bf2f(pw[ro + j * 16]);
            }
    }
}

#define LAS __attribute__((address_space(3)))
#define XB_TMO      128
#define XB_XCNT(j)  (256  + 64 * (j))
#define XB_XSUB(j)  (1280 + 64 * (j))
#define XB_XGEN(j)  (2304 + 64 * (j))
#define XB_TOP      3328
#define XB_TOPGEN   3392
#define XCD_BAR_WORDS 3456
#define XB_SPIN_CAP (1u << 22)

__device__ __forceinline__ unsigned xb_ld(unsigned* p)              { return __hip_atomic_load(p, __ATOMIC_RELAXED, __HIP_MEMORY_SCOPE_AGENT); }
__device__ __forceinline__ unsigned xb_add(unsigned* p, unsigned v) { return __hip_atomic_fetch_add(p, v, __ATOMIC_RELAXED, __HIP_MEMORY_SCOPE_AGENT); }
__device__ __forceinline__ unsigned xb_xcc_id() { return (unsigned)__builtin_amdgcn_s_getreg((3 << 11) | 20) & 0xFu; }
#define XB_SPIN(cond, bar) do { unsigned _sp = 0; while (cond) { __builtin_amdgcn_s_sleep(1); \
    if ((++_sp & 255u) == 0u) { if (xb_ld(&(bar)[XB_TMO])) break; if (_sp > XB_SPIN_CAP) { atomicAdd(&(bar)[XB_TMO], 1u); break; } } } } while (0)

struct XcdBarrier {
    unsigned* bar; unsigned x;
    volatile LAS unsigned* st;
};

__device__ __forceinline__ XcdBarrier xcd_barrier_post(unsigned* bar, volatile LAS unsigned* st) {
    XcdBarrier b; b.bar = bar; b.x = xb_xcc_id(); b.st = st;
    if (tid_opaque() == 0) (void)xb_add(&bar[XB_XCNT(b.x)], 1u);
    return b;
}
__device__ __forceinline__ void xcd_barrier_complete(unsigned* bar, unsigned x, unsigned& nloc, unsigned& nx) {
    const unsigned G = gridDim.x * gridDim.y * gridDim.z;
    unsigned sum, cnt, mine, sp = 0u;
    for (;;) {
        sum = 0u; cnt = 0u; mine = 0u;
#pragma unroll
        for (unsigned j = 0; j < 16; ++j) { const unsigned c = xb_ld(&bar[XB_XCNT(j)]); sum += c; cnt += (c > 0u) ? 1u : 0u; mine = (j == x) ? c : mine; }
        if (sum == G) break;
        __builtin_amdgcn_s_sleep(1);
        if ((++sp & 255u) == 0u) { if (xb_ld(&bar[XB_TMO])) break; if (sp > XB_SPIN_CAP) { atomicAdd(&bar[XB_TMO], 1u); break; } }
    }
    nloc = mine > 0u ? mine : 1u; nx = cnt > 0u ? cnt : 1u;
}

__device__ __forceinline__ void xcd_barrier(const XcdBarrier& b) {
    asm volatile("s_waitcnt vmcnt(0)" ::: "memory");
    __syncthreads();
    if (tid_opaque() == 0) {
        unsigned* bar = b.bar;
        __builtin_amdgcn_s_waitcnt(0);
        unsigned nloc = b.st[0], nx = b.st[1];
        if (nloc == 0u) { xcd_barrier_complete(bar, b.x, nloc, nx); b.st[0] = nloc; b.st[1] = nx; }
        const unsigned old = xb_add(&bar[XB_XSUB(b.x)], 1u);
        const unsigned gen = old / nloc;
        if (old + 1u == (gen + 1u) * nloc) {
            __builtin_amdgcn_fence(__ATOMIC_RELEASE, "agent");
            asm volatile("s_waitcnt vmcnt(0)" ::: "memory");
            const unsigned og = xb_add(&bar[XB_TOP], 1u);
            const unsigned tg = og / nx;
            if (og + 1u == (tg + 1u) * nx) xb_add(&bar[XB_TOPGEN], 1u);
            else XB_SPIN(xb_ld(&bar[XB_TOPGEN]) == tg, bar);
            __builtin_amdgcn_fence(__ATOMIC_ACQUIRE, "agent");
            xb_add(&bar[XB_XGEN(b.x)], 1u);
            asm volatile("s_waitcnt vmcnt(0)" ::: "memory");
        } else {
            XB_SPIN(xb_ld(&bar[XB_XGEN(b.x)]) == gen, bar);
            __builtin_amdgcn_fence(__ATOMIC_ACQUIRE, "agent");
            asm volatile("s_waitcnt vmcnt(0)" ::: "memory");
        }
    }
    __syncthreads();
}

template <int PH>
__device__ __forceinline__ void run_phase(const Params& p, int bid, int nb, unsigned char* smem) {
    if (PH == 0) phase_prep(p, bid, nb);
    if (PH == 1) phase_inproj(p, bid, nb, smem);
    if (PH == 3) phase_compress(p, bid, nb, smem);
    if (PH == 4) phase_attn(p, bid, nb, smem);
    if (PH == 15) {
        if (bid < (nb >> 1)) { phase_dsa_attn(p, bid, nb, smem); phase_merge<0>(p, bid, nb, smem); }
        else { phase_merge<0>(p, bid, nb, smem); phase_dsa_attn(p, bid, nb, smem); }
    }
    if (PH == 13) phase_merge<1>(p, bid, nb, smem);
    if (PH == 6) phase_outproj(p, bid, nb, smem);
    if (PH == 7) phase_route(p, bid, nb, smem);
    if (PH == 8) phase_place(p, bid, nb, smem);
    if (PH == 9) phase_moe1(p, bid, nb, smem);
    if (PH == 10) phase_moe2(p, bid, nb, smem);
    if (PH == 11) phase_combine(p, bid, nb);
    if (PH == 12) phase_ple(p, bid, nb, smem);
}

#if SINGLE_LAUNCH
__global__ void __launch_bounds__(NT, 2) fwd_mega(Params p) {
    __shared__ __attribute__((aligned(16))) unsigned char smem[SMEM_BYTES];
    cg::grid_group grid = cg::this_grid();
    const int bid = blockIdx.x, nb = gridDim.x;
    volatile LAS unsigned* bst = (volatile LAS unsigned*)(LAS unsigned char*)(smem + SMEM_BYTES - 16);
    if (tid_opaque() < 2) bst[tid_opaque()] = 0u;
    __syncthreads();
    const XcdBarrier bar = xcd_barrier_post((unsigned*)(p.ws + WS_BAR), bst);
#define GSYNC() xcd_barrier(bar)
    run_phase<0>(p, bid, nb, smem); GSYNC();
    run_phase<1>(p, bid, nb, smem); GSYNC();
    run_phase<3>(p, bid, nb, smem); GSYNC();
    run_phase<4>(p, bid, nb, smem); grid.sync();
    run_phase<15>(p, bid, nb, smem); GSYNC();
    run_phase<13>(p, bid, nb, smem); GSYNC();
    run_phase<6>(p, bid, nb, smem); GSYNC();
    run_phase<7>(p, bid, nb, smem); GSYNC();
    run_phase<8>(p, bid, nb, smem); GSYNC();
    run_phase<9>(p, bid, nb, smem); GSYNC();
    run_phase<10>(p, bid, nb, smem); GSYNC();
    run_phase<11>(p, bid, nb, smem); GSYNC();
    run_phase<12>(p, bid, nb, smem);
#undef GSYNC
}
#else
template <int PH>
__global__ void __launch_bounds__(NT, 2) k_phase(Params p) {
    __shared__ __attribute__((aligned(16))) unsigned char smem[SMEM_BYTES];
    run_phase<PH>(p, blockIdx.x, gridDim.x, smem);
}
#endif

extern "C" void kernel_launch(void* const* d_in, const int* in_sizes, int n_in, void* d_out, int out_size, void* d_ws, size_t ws_size,
                              hipStream_t stream) {
    if (n_in != 28 || ws_size < WS_END) { fprintf(stderr, "kernel_launch: unexpected n_in %d or ws_size %zu (< %zu)\n", n_in, ws_size, (size_t)WS_END); return; }
    Params p{};
    for (int i = 0; i < 28; ++i) p.in[i] = (const float*)d_in[i];
    p.out = (float*)d_out;
    p.ws = (unsigned char*)d_ws;
#if SINGLE_LAUNCH
    static int grid_blocks = 0;
    if (!grid_blocks) {
        int dev = 0, cus = 0, per_cu = 0;
        hipGetDevice(&dev);
        hipDeviceGetAttribute(&cus, hipDeviceAttributeMultiprocessorCount, dev);
        hipOccupancyMaxActiveBlocksPerMultiprocessor(&per_cu, fwd_mega, NT, 0);
        if (per_cu > 2) per_cu = 2;
        if (per_cu < 1) per_cu = 1;
        grid_blocks = cus * per_cu;
    }
    (void)hipMemsetAsync((unsigned char*)d_ws + WS_BAR, 0, XCD_BAR_WORDS * 4, stream);
    void* args[] = {&p};
    hipError_t e = hipLaunchCooperativeKernel((void*)fwd_mega, dim3(grid_blocks), dim3(NT), args, 0, stream);
    if (e != hipSuccess) fprintf(stderr, "cooperative launch failed: %s (grid %d)\n", hipGetErrorString(e), grid_blocks);
#else
    const int G = 512;
    k_phase<0><<<G, NT, 0, stream>>>(p);
    k_phase<1><<<G, NT, 0, stream>>>(p);
    k_phase<3><<<G, NT, 0, stream>>>(p);
    k_phase<4><<<G, NT, 0, stream>>>(p);
    k_phase<15><<<G, NT, 0, stream>>>(p);
    k_phase<13><<<G, NT, 0, stream>>>(p);
    k_phase<6><<<G, NT, 0, stream>>>(p);
    k_phase<7><<<G, NT, 0, stream>>>(p);
    k_phase<8><<<G, NT, 0, stream>>>(p);
    k_phase<9><<<G, NT, 0, stream>>>(p);
    k_phase<10><<<G, NT, 0, stream>>>(p);
    k_phase<11><<<G, NT, 0, stream>>>(p);
    k_phase<12><<<G, NT, 0, stream>>>(p);
#endif
}
```

```cpp
#include <hip/hip_runtime.h>
#include <hip/hip_cooperative_groups.h>
#include <cstdio>
#include <cstdint>
namespace cg = cooperative_groups;

#ifndef SINGLE_LAUNCH
#define SINGLE_LAUNCH 1
#endif

constexpr int S = 16384;
constexpr int D = 1024;
constexpr int DIN = 5184;
constexpr int NCMP = 1023;
constexpr int NSLC = 256;
constexpr int NEXP = 32;
constexpr int DFF = 1024;
constexpr float EPS = 1e-6f;
constexpr float LOG2E = 1.4426950408889634f;
constexpr int Z_NQ = 0, Z_NKV = 512, Z_NGATE = 1280, Z_DQ = 1304, Z_DK = 1816, Z_DV = 2328, Z_IQ = 2840, Z_IK = 3096,
              Z_IW = 3128, Z_GA = 3136, Z_GB = 4160;

constexpr int NT = 256;
constexpr int SMEM_BYTES = 73728;

typedef unsigned short bf16_t;
typedef short bf16x8 __attribute__((ext_vector_type(8)));
typedef float f32x4 __attribute__((ext_vector_type(4)));
typedef short s16x4 __attribute__((ext_vector_type(4)));
typedef __attribute__((address_space(3))) s16x4* lds_s16x4_ptr;
__device__ __forceinline__ s16x4 lds_tr16(const void* p) {
    return __builtin_amdgcn_ds_read_tr16_b64_v4i16((lds_s16x4_ptr)(uintptr_t)p);
}

constexpr size_t MBy = 1ull << 20;
constexpr size_t WS_CTL = 0;
constexpr size_t WS_CNTB = 131072;
constexpr size_t WS_BAR = 65536;
constexpr size_t WS_HB = 1 * MBy;
constexpr size_t WS_OA = WS_HB + (size_t)S * D * 2;
constexpr size_t WS_OB = WS_OA + (size_t)S * 512 * 2;
constexpr size_t WS_MERGED = WS_OB + (size_t)S * 512 * 2;
constexpr size_t WS_X1 = WS_MERGED + (size_t)S * D * 2;
constexpr size_t WS_TOPI = WS_X1 + (size_t)S * D * 4;
constexpr size_t WS_TOPW = WS_TOPI + (size_t)S * 4 * 4;
constexpr size_t WS_PPOS = WS_TOPW + (size_t)S * 4 * 4;
constexpr size_t WS_ROWTOK = WS_PPOS + (size_t)S * 4 * 4;
constexpr size_t WS_PB = WS_ROWTOK + (size_t)65536 * 4;
constexpr size_t WS_PW = WS_PB + (size_t)S * 256 * 2;
constexpr size_t WS_SEL = WS_PW + (size_t)S * D * 2;
constexpr size_t WS_NSEL = WS_SEL + (size_t)S * 256 * 2;
constexpr size_t WS_REG = WS_NSEL + (size_t)S * 4;
constexpr size_t WS_SGA = WS_REG;
constexpr size_t WS_SGB = WS_SGA + (size_t)S * D * 2;
constexpr size_t WS_GT = WS_SGB + (size_t)S * D * 2;
constexpr size_t WS_IWS = WS_GT + (size_t)S * 32 * 4;
constexpr size_t WS_QNB = WS_IWS + (size_t)S * 8 * 4;
constexpr size_t WS_KSLB = WS_QNB + (size_t)S * 512 * 2;
constexpr size_t WS_VSLB = WS_KSLB + (size_t)S * 128 * 2;
constexpr size_t WS_KWNB = WS_VSLB + (size_t)S * 128 * 2;
constexpr size_t WS_VWNB = WS_KWNB + (size_t)S * 128 * 2;
constexpr size_t WS_KCB = WS_VWNB + (size_t)S * 128 * 2;
constexpr size_t WS_VCB = WS_KCB + (size_t)2 * 1024 * 64 * 2;
constexpr size_t WS_KCR = WS_VCB + (size_t)2 * 1024 * 64 * 2;
constexpr size_t WS_VCR = WS_KCR + (size_t)S * 128 * 2;
constexpr size_t WS_DQB = WS_VCR + (size_t)S * 128 * 2;
constexpr size_t WS_DKB = WS_DQB + (size_t)S * 512 * 2;
constexpr size_t WS_DVB = WS_DKB + (size_t)S * 512 * 2;
constexpr size_t WS_IQB = WS_DVB + (size_t)S * 512 * 2;
constexpr size_t WS_IKB = WS_IQB + (size_t)S * 256 * 2;
constexpr size_t WS_ENDA = WS_IKB + (size_t)S * 32 * 2;
constexpr size_t WS_ACT = WS_REG;
constexpr size_t WS_YROWS = WS_ACT + (size_t)(65536 + 128) * DFF * 2;
constexpr size_t WS_ENDB = WS_YROWS + (size_t)(65536 + 128) * D * 4;
constexpr size_t WS_END0 = WS_ENDA > WS_ENDB ? WS_ENDA : WS_ENDB;
constexpr size_t WB_IN = WS_END0;
constexpr size_t WB_A = WB_IN + (size_t)D * DIN * 2;
constexpr size_t WB_B = WB_A + (size_t)512 * D * 2;
constexpr size_t WB_OUT = WB_B + (size_t)512 * D * 2;
constexpr size_t WB_E1 = WB_OUT + (size_t)D * D * 2;
constexpr size_t WB_E2 = WB_E1 + (size_t)NEXP * D * 2 * DFF * 2;
constexpr size_t WB_PLE = WB_E2 + (size_t)NEXP * DFF * D * 2;
constexpr size_t WB_PLEG = WB_PLE + (size_t)256 * D * 2;
constexpr size_t WB_CK1 = WB_PLEG + (size_t)D * D * 2;
constexpr size_t WB_CV1 = WB_CK1 + (size_t)2048 * 64 * 2;
constexpr size_t WS_END = WB_CV1 + (size_t)2048 * 64 * 2 + 4096;

struct Params {
    const float* in[28];
    float* out;
    unsigned char* ws;
};

__device__ __forceinline__ unsigned f2bf(float f) {
    unsigned u = __builtin_bit_cast(unsigned, f);
    return (u + 0x7fffu + ((u >> 16) & 1u)) >> 16;
}
__device__ __forceinline__ unsigned pk2(float lo, float hi) { return f2bf(lo) | (f2bf(hi) << 16); }
__device__ __forceinline__ float bf2f(unsigned short b) { return __builtin_bit_cast(float, (unsigned)b << 16); }
__device__ __forceinline__ int tid_opaque() { int t = threadIdx.x; asm volatile("" : "+v"(t)); return t; }
__device__ __forceinline__ float wave_sum(float v) {
#pragma unroll
    for (int o = 1; o < 64; o <<= 1) v += __shfl_xor(v, o);
    return v;
}
__device__ __forceinline__ float wave_max(float v) {
#pragma unroll
    for (int o = 1; o < 64; o <<= 1) v = fmaxf(v, __shfl_xor(v, o));
    return v;
}
__device__ __forceinline__ float sigmoidf_(float x) { return 1.f / (1.f + __expf(-x)); }
__device__ __forceinline__ int bucket_of(int n) {
    if (n < 16) return n;
    int b = 16;
    b += (n >= 19) + (n >= 21) + (n >= 24) + (n >= 27) + (n >= 31) + (n >= 35) + (n >= 40) + (n >= 46) + (n >= 52) + (n >= 59) +
         (n >= 67) + (n >= 77) + (n >= 87) + (n >= 99) + (n >= 113);
    return b;
}

constexpr int LDS_STRIDE = 40;
constexpr int BTR_STRIDE = 136;
template <bool A_F32, bool GATHER, bool SPLIT = false, bool BTR = true>
__device__ __forceinline__ void gemm_tile(const void* __restrict__ Aptr, int lda, const int* __restrict__ rowidx, int m0, int mrows,
                                          const float* __restrict__ B, int ldb, int n0, int split_off, int ncols, int K,
                                          unsigned char* smem, f32x4 (&acc)[2][8]) {
    bf16_t* As = (bf16_t*)smem;
    bf16_t* Bs = As + 128 * LDS_STRIDE;
    bf16_t* AsL = Bs + 128 * LDS_STRIDE;
    bf16_t* BsL = AsL + 128 * LDS_STRIDE;
    const int tid = tid_opaque(), lane = tid & 63, wave = tid >> 6;
#pragma unroll
    for (int i = 0; i < 2; ++i)
#pragma unroll
        for (int j = 0; j < 8; ++j) acc[i][j] = (f32x4){0.f, 0.f, 0.f, 0.f};
    auto lo = [](float v) { return v - bf2f((unsigned short)f2bf(v)); };

    const int ar = tid >> 2, ach = tid & 3;
    const unsigned char* arow[2];
    bool aval[2];
#pragma unroll
    for (int i = 0; i < 2; ++i) {
        int r = ar + 64 * i;
        aval[i] = r < mrows;
        long src = 0;
        if (aval[i]) src = GATHER ? (long)rowidx[m0 + r] : (long)(m0 + r);
        arow[i] = (const unsigned char*)Aptr + (size_t)src * lda * (A_F32 ? 4 : 2) + (size_t)ach * 8 * (A_F32 ? 4 : 2);
    }
    const int nq = tid & 31, kq = tid >> 5;
    const int jn = 4 * nq;
    const bool bval = jn < ncols;
    const float* bptr = B + (size_t)(4 * kq) * ldb + n0 + jn + (jn >= 64 ? split_off : 0);

    uint4 areg[2];
    float4 af0a, af0b, af1a, af1b;
    float4 breg[4];
    auto load_g = [&](int k0) {
#pragma unroll
        for (int i = 0; i < 2; ++i) {
            if (A_F32) {
                float4 t0 = make_float4(0, 0, 0, 0), t1 = t0;
                if (aval[i]) {
                    const float4* s = (const float4*)(arow[i] + (size_t)k0 * 4);
                    t0 = s[0]; t1 = s[1];
                }
                if (i == 0) { af0a = t0; af0b = t1; } else { af1a = t0; af1b = t1; }
            } else {
                if (aval[i]) areg[i] = *(const uint4*)(arow[i] + (size_t)k0 * 2);
                else areg[i] = make_uint4(0, 0, 0, 0);
            }
        }
#pragma unroll
        for (int kk = 0; kk < 4; ++kk) {
            if (bval) breg[kk] = *(const float4*)(bptr + (size_t)(k0 + kk) * ldb);
            else breg[kk] = make_float4(0, 0, 0, 0);
        }
    };
    auto store_l = [&]() {
#pragma unroll
        for (int i = 0; i < 2; ++i) {
            uint4 v;
            const float4 t0 = (i == 0) ? af0a : af1a, t1 = (i == 0) ? af0b : af1b;
            if (A_F32) {
                v.x = pk2(t0.x, t0.y); v.y = pk2(t0.z, t0.w);
                v.z = pk2(t1.x, t1.y); v.w = pk2(t1.z, t1.w);
            } else v = areg[i];
            *(uint4*)(As + (ar + 64 * i) * LDS_STRIDE + ach * 8) = v;
            if (SPLIT && A_F32) {
                v.x = pk2(lo(t0.x), lo(t0.y)); v.y = pk2(lo(t0.z), lo(t0.w));
                v.z = pk2(lo(t1.x), lo(t1.y)); v.w = pk2(lo(t1.z), lo(t1.w));
                *(uint4*)(AsL + (ar + 64 * i) * LDS_STRIDE + ach * 8) = v;
            }
        }
        if (SPLIT) {
            uint2 v;
            v.x = pk2(lo(breg[0].x), lo(breg[1].x)); v.y = pk2(lo(breg[2].x), lo(breg[3].x));
            *(uint2*)(BsL + (jn + 0) * LDS_STRIDE + 4 * kq) = v;
            v.x = pk2(lo(breg[0].y), lo(breg[1].y)); v.y = pk2(lo(breg[2].y), lo(breg[3].y));
            *(uint2*)(BsL + (jn + 1) * LDS_STRIDE + 4 * kq) = v;
            v.x = pk2(lo(breg[0].z), lo(breg[1].z)); v.y = pk2(lo(breg[2].z), lo(breg[3].z));
            *(uint2*)(BsL + (jn + 2) * LDS_STRIDE + 4 * kq) = v;
            v.x = pk2(lo(breg[0].w), lo(breg[1].w)); v.y = pk2(lo(breg[2].w), lo(breg[3].w));
            *(uint2*)(BsL + (jn + 3) * LDS_STRIDE + 4 * kq) = v;
        }
        if (BTR && !SPLIT) {
#pragma unroll
            for (int kk = 0; kk < 4; ++kk) {
                uint2 v; v.x = pk2(breg[kk].x, breg[kk].y); v.y = pk2(breg[kk].z, breg[kk].w);
                *(uint2*)(Bs + (4 * kq + kk) * BTR_STRIDE + jn) = v;
            }
        } else {
            uint2 v;
            v.x = pk2(breg[0].x, breg[1].x); v.y = pk2(breg[2].x, breg[3].x);
            *(uint2*)(Bs + (jn + 0) * LDS_STRIDE + 4 * kq) = v;
            v.x = pk2(breg[0].y, breg[1].y); v.y = pk2(breg[2].y, breg[3].y);
            *(uint2*)(Bs + (jn + 1) * LDS_STRIDE + 4 * kq) = v;
            v.x = pk2(breg[0].z, breg[1].z); v.y = pk2(breg[2].z, breg[3].z);
            *(uint2*)(Bs + (jn + 2) * LDS_STRIDE + 4 * kq) = v;
            v.x = pk2(breg[0].w, breg[1].w); v.y = pk2(breg[2].w, breg[3].w);
            *(uint2*)(Bs + (jn + 3) * LDS_STRIDE + 4 * kq) = v;
        }
    };
    const int nk = K / 32;
    __syncthreads();
    load_g(0);
    store_l();
    __syncthreads();
    const int fr = lane & 15, fq = lane >> 4;
    for (int kt = 0; kt < nk; ++kt) {
        if (kt + 1 < nk) load_g((kt + 1) * 32);
        bf16x8 a[2];
#pragma unroll
        for (int i = 0; i < 2; ++i) a[i] = *(const bf16x8*)(As + (wave * 32 + i * 16 + fr) * LDS_STRIDE + fq * 8);
        if (!SPLIT) {
            bf16x8 b[8];
#pragma unroll
            for (int j = 0; j < 8; ++j) {
                if (BTR && !SPLIT) {
                    const bf16_t* bp = Bs + (8 * fq + (fr >> 2)) * BTR_STRIDE + 16 * j + 4 * (fr & 3);
                    const s16x4 lo4 = lds_tr16(bp), hi4 = lds_tr16(bp + 4 * BTR_STRIDE);
                    b[j] = (bf16x8){lo4[0], lo4[1], lo4[2], lo4[3], hi4[0], hi4[1], hi4[2], hi4[3]};
                } else b[j] = *(const bf16x8*)(Bs + (j * 16 + fr) * LDS_STRIDE + fq * 8);
            }
#pragma unroll
            for (int i = 0; i < 2; ++i)
#pragma unroll
                for (int j = 0; j < 8; ++j) acc[i][j] = __builtin_amdgcn_mfma_f32_16x16x32_bf16(a[i], b[j], acc[i][j], 0, 0, 0);
        } else {
            bf16x8 al[2];
#pragma unroll
            for (int i = 0; i < 2; ++i) al[i] = *(const bf16x8*)(AsL + (wave * 32 + i * 16 + fr) * LDS_STRIDE + fq * 8);
#pragma unroll
            for (int j = 0; j < 8; ++j) {
                const bf16x8 bh = *(const bf16x8*)(Bs + (j * 16 + fr) * LDS_STRIDE + fq * 8);
                const bf16x8 bl = *(const bf16x8*)(BsL + (j * 16 + fr) * LDS_STRIDE + fq * 8);
#pragma unroll
                for (int i = 0; i < 2; ++i) {
                    acc[i][j] = __builtin_amdgcn_mfma_f32_16x16x32_bf16(a[i], bh, acc[i][j], 0, 0, 0);
                    acc[i][j] = __builtin_amdgcn_mfma_f32_16x16x32_bf16(a[i], bl, acc[i][j], 0, 0, 0);
                    acc[i][j] = __builtin_amdgcn_mfma_f32_16x16x32_bf16(al[i], bh, acc[i][j], 0, 0, 0);
                }
            }
        }
        __syncthreads();
        if (kt + 1 < nk) {
            store_l();
            __syncthreads();
        }
    }
}


constexpr int ASTR = 72;
constexpr int BSTR = 136;
template <bool GATHER, bool PAIR>
__device__ __forceinline__ void gemm2(const bf16_t* __restrict__ A, int lda, const int* __restrict__ rowidx, int m0, int mrows,
                                      const bf16_t* __restrict__ B, int ldb, int n0, int ncols, int K, unsigned char* smem,
                                      f32x4 (&acc)[4][4]) {
    bf16_t* As = (bf16_t*)smem;
    bf16_t* Bs = As + 128 * ASTR;
    const int tid = tid_opaque(), lane = tid & 63, wave = tid >> 6, wm = wave >> 1, wn = wave & 1;
#pragma unroll
    for (int i = 0; i < 4; ++i)
#pragma unroll
        for (int j = 0; j < 4; ++j) acc[i][j] = (f32x4){0.f, 0.f, 0.f, 0.f};
    const int ar0 = tid >> 3, ach = tid & 7;
    const bf16_t* ap0; const bf16_t* ap1; const bf16_t* ap2; const bf16_t* ap3;
    {
        int r_[4];
#pragma unroll
        for (int i = 0; i < 4; ++i) { const int rl = 32 * i + ar0; r_[i] = rl < mrows ? rl : mrows - 1; }
        ap0 = A + (size_t)(GATHER ? (long)rowidx[m0 + r_[0]] : (long)(m0 + r_[0])) * lda + ach * 8;
        ap1 = A + (size_t)(GATHER ? (long)rowidx[m0 + r_[1]] : (long)(m0 + r_[1])) * lda + ach * 8;
        ap2 = A + (size_t)(GATHER ? (long)rowidx[m0 + r_[2]] : (long)(m0 + r_[2])) * lda + ach * 8;
        ap3 = A + (size_t)(GATHER ? (long)rowidx[m0 + r_[3]] : (long)(m0 + r_[3])) * lda + ach * 8;
    }
    const int br0 = tid >> 4, bch = tid & 15;
    const int bcol = PAIR ? ((bch >> 2) * 16 + (bch & 1) * 8 + ((bch >> 1) & 1) * 1024) : bch * 8;
    const bf16_t* bp = B + (size_t)br0 * ldb + n0 + bcol;
    bf16_t* asd = As + ar0 * ASTR + ach * 8;
    bf16_t* bsd = Bs + br0 * BSTR + bch * 8;
    uint4 a0, a1, a2, a3, b0, b1, b2, b3;
#define G2_LOAD(k0)                                                                                       \
    do {                                                                                                  \
        a0 = *(const uint4*)(ap0 + (k0)); a1 = *(const uint4*)(ap1 + (k0));                               \
        a2 = *(const uint4*)(ap2 + (k0)); a3 = *(const uint4*)(ap3 + (k0));                               \
        const bf16_t* bp_ = bp + (size_t)(k0) * ldb;                                                      \
        b0 = *(const uint4*)(bp_); b1 = *(const uint4*)(bp_ + (size_t)16 * ldb);                          \
        b2 = *(const uint4*)(bp_ + (size_t)32 * ldb); b3 = *(const uint4*)(bp_ + (size_t)48 * ldb);       \
    } while (0)
#define G2_STORE()                                                                                        \
    do {                                                                                                  \
        *(uint4*)(asd) = a0; *(uint4*)(asd + 32 * ASTR) = a1; *(uint4*)(asd + 64 * ASTR) = a2; *(uint4*)(asd + 96 * ASTR) = a3; \
        *(uint4*)(bsd) = b0; *(uint4*)(bsd + 16 * BSTR) = b1; *(uint4*)(bsd + 32 * BSTR) = b2; *(uint4*)(bsd + 48 * BSTR) = b3; \
    } while (0)
    const int nk = K / 64;
    __syncthreads();
    G2_LOAD(0);
    G2_STORE();
    __syncthreads();
    const int fr = lane & 15, fq = lane >> 4;
    const bf16_t* afp = As + (wm * 64 + fr) * ASTR + fq * 8;
    const bf16_t* bfp = Bs + (8 * fq + (fr >> 2)) * BSTR + wn * 64 + 4 * (fr & 3);
    for (int kt = 0; kt < nk; ++kt) {
        if (kt + 1 < nk) G2_LOAD((kt + 1) * 64);
#pragma unroll
        for (int kh = 0; kh < 2; ++kh) {
            bf16x8 a[4], b[4];
#pragma unroll
            for (int i = 0; i < 4; ++i) a[i] = *(const bf16x8*)(afp + i * 16 * ASTR + kh * 32);
#pragma unroll
            for (int j = 0; j < 4; ++j) {
                const bf16_t* q = bfp + kh * 32 * BSTR + j * 16;
                const s16x4 lo4 = lds_tr16(q), hi4 = lds_tr16(q + 4 * BSTR);
                b[j] = (bf16x8){lo4[0], lo4[1], lo4[2], lo4[3], hi4[0], hi4[1], hi4[2], hi4[3]};
            }
#pragma unroll
            for (int i = 0; i < 4; ++i)
#pragma unroll
                for (int j = 0; j < 4; ++j) acc[i][j] = __builtin_amdgcn_mfma_f32_16x16x32_bf16(a[i], b[j], acc[i][j], 0, 0, 0);
        }
        __syncthreads();
        if (kt + 1 < nk) {
            G2_STORE();
            __syncthreads();
        }
    }
#undef G2_LOAD
#undef G2_STORE
}
#define G2_ROW(i, r) ((g2tid >> 7) * 64 + (i) * 16 + 4 * ((g2tid & 63) >> 4) + (r))
#define G2_COL(j) (((((g2tid >> 6) & 1) * 4 + (j)) * 16) + (g2tid & 15))
__device__ __forceinline__ void store_bf16_frag(bf16_t* base, int ld, float v0, float v1, float v2, float v3, int lane, unsigned rowmask = 0xFu) {
    const bool odd = lane & 1;
    const float s0 = odd ? v0 : v2, s1 = odd ? v1 : v3;
    const float r0 = __shfl_xor(s0, 1), r1 = __shfl_xor(s1, 1);
    bf16_t* p0 = odd ? base + 2 * ld - 1 : base;
    const unsigned w0 = odd ? pk2(r0, v2) : pk2(v0, r0);
    const unsigned w1 = odd ? pk2(r1, v3) : pk2(v1, r1);
    const unsigned m = odd ? (rowmask >> 2) : rowmask;
    if (m & 1u) *(unsigned*)p0 = w0;
    if (m & 2u) *(unsigned*)(p0 + ld) = w1;
}

__device__ __forceinline__ void cvt_weights(const float* __restrict__ src, bf16_t* __restrict__ dst, size_t n, int bid, int nb) {
    const size_t n8 = n >> 3;
    for (size_t i = (size_t)bid * NT + tid_opaque(); i < n8; i += (size_t)nb * NT) {
        const float4 u = ((const float4*)src)[2 * i], v = ((const float4*)src)[2 * i + 1];
        uint4 o; o.x = pk2(u.x, u.y); o.y = pk2(u.z, u.w); o.z = pk2(v.x, v.y); o.w = pk2(v.z, v.w);
        ((uint4*)dst)[i] = o;
    }
}
__device__ __forceinline__ void phase_prep(const Params& p, int bid, int nb) {
    const int lane = tid_opaque() & 63, wave = tid_opaque() >> 6;
    if (bid == 0 && tid_opaque() < 64) ((int*)(p.ws + WS_CTL))[tid_opaque()] = 0;
    {
        const float* src_ = p.in[2];
        bf16_t* dst_ = (bf16_t*)(p.ws + WB_IN);
        constexpr int G8 = DIN / 8;
        for (size_t i = (size_t)bid * NT + tid_opaque(); i < (size_t)D * G8; i += (size_t)nb * NT) {
            const int k = (int)(i / G8), nc = (int)(i % G8) * 8;
            int oc;
            if (nc < 1280) oc = nc; else if (nc < 2816) oc = nc + 24; else if (nc < 3072) oc = nc + 24; else if (nc < 5120) oc = nc + 64;
            else if (nc < 5152) oc = nc - 5120 + 3096; else if (nc < 5176) oc = nc - 5152 + 1280; else oc = nc - 5176 + 3128;
            const float4 u = *(const float4*)(src_ + (size_t)k * DIN + oc), v = *(const float4*)(src_ + (size_t)k * DIN + oc + 4);
            uint4 o; o.x = pk2(u.x, u.y); o.y = pk2(u.z, u.w); o.z = pk2(v.x, v.y); o.w = pk2(v.z, v.w);
            *(uint4*)(dst_ + (size_t)k * DIN + nc) = o;
        }
    }
    cvt_weights(p.in[14], (bf16_t*)(p.ws + WB_A), (size_t)512 * D, bid, nb);
    cvt_weights(p.in[15], (bf16_t*)(p.ws + WB_B), (size_t)512 * D, bid, nb);
    cvt_weights(p.in[16], (bf16_t*)(p.ws + WB_OUT), (size_t)D * D, bid, nb);
    cvt_weights(p.in[26], (bf16_t*)(p.ws + WB_PLE), (size_t)256 * D, bid, nb);
    cvt_weights(p.in[1], (bf16_t*)(p.ws + WS_PB), (size_t)S * 256, bid, nb);
    cvt_weights(p.in[9], (bf16_t*)(p.ws + WB_CK1), (size_t)2048 * 64, bid, nb);
    cvt_weights(p.in[12], (bf16_t*)(p.ws + WB_CV1), (size_t)2048 * 64, bid, nb);
    const float* x = p.in[0];
    const float* g = p.in[3];
    bf16_t* hb = (bf16_t*)(p.ws + WS_HB);
    for (int t = bid * 4 + wave; t < S; t += nb * 4) {
        const float4* xr = (const float4*)(x + (size_t)t * D);
        float4 v[4];
        float ss = 0.f;
#pragma unroll
        for (int j = 0; j < 4; ++j) { v[j] = xr[lane + 64 * j]; ss += v[j].x * v[j].x + v[j].y * v[j].y + v[j].z * v[j].z + v[j].w * v[j].w; }
        ss = wave_sum(ss);
        const float rstd = rsqrtf(ss * (1.f / D) + EPS);
#pragma unroll
        for (int j = 0; j < 4; ++j) {
            const float4 gg = ((const float4*)g)[lane + 64 * j];
            uint2 o;
            o.x = pk2(v[j].x * rstd * gg.x, v[j].y * rstd * gg.y);
            o.y = pk2(v[j].z * rstd * gg.z, v[j].w * rstd * gg.w);
            ((uint2*)(hb + (size_t)t * D))[lane + 64 * j] = o;
        }
    }
}

__device__ __forceinline__ void phase_inproj(const Params& p, int bid, int nb, unsigned char* smem) {
    const int g2tid = tid_opaque();
    const bf16_t* hb = (const bf16_t*)(p.ws + WS_HB);
    const int lane = tid_opaque() & 63, fr = lane & 15;
    constexpr int NTN = (DIN + 127) / 128;
    for (int w = bid; w < 128 * NTN; w += nb) {
        const int mt = w % 128, nt = w / 128;
        const int m0 = mt * 128, n0 = nt * 128;
        const int ncols = (DIN - n0) < 128 ? (DIN - n0) : 128;
        f32x4 acc[4][4];
        gemm2<false, false>(hb, D, nullptr, m0, 128, (const bf16_t*)(p.ws + WB_IN), DIN, n0, ncols, D, smem, acc);
        const int cid = __builtin_amdgcn_readfirstlane((n0 >> 6) + ((tid_opaque() >> 6) & 1));
        if (cid > 80) continue;
        int kind; bf16_t* dst; int ld; const float* gain = nullptr; float scale = 1.f;
        if (cid < 8) { kind = 0; dst = (bf16_t*)(p.ws + WS_QNB) + cid * 64; ld = 512; gain = p.in[4]; scale = 0.125f * LOG2E; }
        else if (cid < 20) {
            const int j = cid - 8, kd = j >> 1, g = j & 1;
            ld = 64; kind = (kd == 2 || kd == 4) ? 0 : 1; gain = p.in[5];
            const size_t base = kd == 0 ? WS_KCR : kd == 1 ? WS_VCR : kd == 2 ? WS_KSLB : kd == 3 ? WS_VSLB : kd == 4 ? WS_KWNB : WS_VWNB;
            dst = (bf16_t*)(p.ws + base) + (size_t)g * S * 64;
        }
        else if (cid < 28) { kind = 0; dst = (bf16_t*)(p.ws + WS_DQB) + (cid - 20) * 64; ld = 512; gain = p.in[6]; scale = 0.125f * LOG2E; }
        else if (cid < 36) { kind = 0; dst = (bf16_t*)(p.ws + WS_DKB) + (cid - 28) * 64; ld = 512; gain = p.in[7]; }
        else if (cid < 44) { kind = 1; dst = (bf16_t*)(p.ws + WS_DVB) + (cid - 36) * 64; ld = 512; }
        else if (cid < 48) { kind = 1; dst = (bf16_t*)(p.ws + WS_IQB) + (cid - 44) * 64; ld = 256; scale = 0.17677669529663687f; }
        else if (cid < 64) { kind = 2; dst = (bf16_t*)(p.ws + WS_SGA) + (cid - 48) * 64; ld = D; }
        else if (cid < 80) { kind = 2; dst = (bf16_t*)(p.ws + WS_SGB) + (cid - 64) * 64; ld = D; }
        else { kind = 3; dst = nullptr; ld = 0; }
        if (kind == 0) {
            float gv[4];
#pragma unroll
            for (int j = 0; j < 4; ++j) gv[j] = gain[j * 16 + fr] * scale;
#pragma unroll
            for (int i = 0; i < 4; ++i) {
                float rstd[4];
#pragma unroll
                for (int r = 0; r < 4; ++r) {
                    float ss = acc[i][0][r] * acc[i][0][r] + acc[i][1][r] * acc[i][1][r] + acc[i][2][r] * acc[i][2][r] + acc[i][3][r] * acc[i][3][r];
                    ss += __shfl_xor(ss, 1); ss += __shfl_xor(ss, 2); ss += __shfl_xor(ss, 4); ss += __shfl_xor(ss, 8);
                    rstd[r] = rsqrtf(ss * (1.f / 64.f) + EPS);
                }
                bf16_t* dr = dst + (size_t)(m0 + G2_ROW(i, 0)) * ld + fr;
#pragma unroll
                for (int j = 0; j < 4; ++j)
                    store_bf16_frag(dr + j * 16, ld, acc[i][j][0] * rstd[0] * gv[j], acc[i][j][1] * rstd[1] * gv[j], acc[i][j][2] * rstd[2] * gv[j],
                                    acc[i][j][3] * rstd[3] * gv[j], lane);
            }
        } else if (kind == 1 || kind == 2) {
#pragma unroll
            for (int i = 0; i < 4; ++i) {
                bf16_t* dr = dst + (size_t)(m0 + G2_ROW(i, 0)) * ld + fr;
#pragma unroll
                for (int j = 0; j < 4; ++j) {
                    float v[4];
#pragma unroll
                    for (int r = 0; r < 4; ++r) v[r] = kind == 2 ? sigmoidf_(acc[i][j][r]) : acc[i][j][r] * scale;
                    store_bf16_frag(dr + j * 16, ld, v[0], v[1], v[2], v[3], lane);
                }
            }
        } else {
            bf16_t* ikb = (bf16_t*)(p.ws + WS_IKB);
            float* gt = (float*)(p.ws + WS_GT);
            float* iws = (float*)(p.ws + WS_IWS);
#pragma unroll
            for (int i = 0; i < 4; ++i) {
                bf16_t* ir = ikb + (size_t)(m0 + G2_ROW(i, 0)) * 32 + fr;
                store_bf16_frag(ir, 32, acc[i][0][0], acc[i][0][1], acc[i][0][2], acc[i][0][3], lane);
                store_bf16_frag(ir + 16, 32, acc[i][1][0], acc[i][1][1], acc[i][1][2], acc[i][1][3], lane);
#pragma unroll
                for (int r = 0; r < 4; ++r) {
                    const size_t t = (size_t)(m0 + G2_ROW(i, r));
                    gt[t * 32 + fr] = sigmoidf_(acc[i][2][r]);
                    if (fr < 8) gt[t * 32 + 16 + fr] = sigmoidf_(acc[i][3][r]);
                    else iws[t * 8 + fr - 8] = acc[i][3][r] * 0.35355339059327373f;
                }
            }
        }
    }
}

__device__ __forceinline__ float rms64(float v) { return rsqrtf(wave_sum(v * v) * (1.f / 64.f) + EPS); }

__device__ __forceinline__ void phase_compress(const Params& p, int bid, int nb, unsigned char* smem) {
    const int g2tid = tid_opaque();
    const int tid = tid_opaque(), lane = tid & 63, wave = tid >> 6;
    float* cvec = (float*)(smem + 36864);
    float* hid = (float*)(smem + 36864 + 256);
    bf16_t* pw = (bf16_t*)(p.ws + WS_PW);
    for (int w = bid; w < 32 + 128 * 8; w += nb) {
        const bool is_c = w < 32;
        const int kind = w >> 4, g = (w >> 3) & 1;
        const int w2_ = w - 32;
        const int m0 = is_c ? (w & 7) * 128 : (w2_ % 128) * 128;
        const int n0 = is_c ? 0 : (w2_ / 128) * 128;
        const int mrows = is_c ? ((NCMP - m0) < 128 ? (NCMP - m0) : 128) : 128;
        const bf16_t* Ap = is_c ? (const bf16_t*)(p.ws + (kind ? WS_VCR : WS_KCR)) + (size_t)g * S * 64 : (const bf16_t*)(p.ws + WS_PB);
        const bf16_t* Bp = is_c ? (const bf16_t*)(p.ws + (kind ? WB_CV1 : WB_CK1)) : (const bf16_t*)(p.ws + WB_PLE);
        f32x4 acc[4][4];
        gemm2<false, false>(Ap, is_c ? 16 * 64 : 256, nullptr, m0, mrows, Bp, is_c ? 64 : D, n0, is_c ? 64 : 128, is_c ? 2048 : 256, smem, acc);
        if (!is_c) {
#pragma unroll
            for (int i = 0; i < 4; ++i) {
                bf16_t* pr = pw + (size_t)(m0 + G2_ROW(i, 0)) * D + n0 + G2_COL(0);
#pragma unroll
                for (int j = 0; j < 4; ++j) store_bf16_frag(pr + j * 16, D, acc[i][j][0], acc[i][j][1], acc[i][j][2], acc[i][j][3], lane);
            }
            continue;
        }
        const float* pe = p.in[kind ? 11 : 8];
        const float* w1 = p.in[kind ? 12 : 9];
        const float* w2 = p.in[kind ? 13 : 10];
        {
            const int e = tid & 63, part = tid >> 6;
            float s = 0.f;
            for (int k = part * 512; k < part * 512 + 512; ++k) s += pe[k] * w1[(size_t)k * 64 + e];
            __syncthreads();
            hid[tid] = s;
            __syncthreads();
            if (tid < 64) cvec[tid] = hid[tid] + hid[64 + tid] + hid[128 + tid] + hid[192 + tid];
            __syncthreads();
        }
        if ((wave & 1) == 0) {
#pragma unroll
            for (int i = 0; i < 4; ++i)
#pragma unroll
                for (int j = 0; j < 4; ++j)
#pragma unroll
                    for (int r = 0; r < 4; ++r) {
                        const int row = G2_ROW(i, r), col = j * 16 + (lane & 15);
                        const float a = acc[i][j][r] + cvec[col];
                        hid[row * 65 + col] = a * sigmoidf_(a);
                    }
        }
        __syncthreads();
        const float gkn = p.in[5][lane];
        for (int row = wave; row < mrows; row += 4) {
            float o = 0.f;
#pragma unroll 8
            for (int e = 0; e < 64; ++e) o += hid[row * 65 + e] * w2[e * 64 + lane];
            if (kind == 0) o = o * rms64(o) * gkn;
            ((bf16_t*)(p.ws + (kind ? WS_VCB : WS_KCB)))[((size_t)g * 1024 + m0 + row) * 64 + lane] = (bf16_t)f2bf(o);
        }
        __syncthreads();
    }
    if (bid == nb - 1) {
        if (tid < 128) ((bf16_t*)(p.ws + WS_KCB))[((size_t)(tid >> 6) * 1024 + 1023) * 64 + (tid & 63)] = 0;
        else ((bf16_t*)(p.ws + WS_VCB))[((size_t)((tid - 128) >> 6) * 1024 + 1023) * 64 + (tid & 63)] = 0;
    }
}

constexpr int KSTR = 72;
constexpr int NSA_KT = 0;
constexpr int NSA_VT = NSA_KT + 32 * KSTR * 2;
constexpr int NSA_WV = NSA_VT + 32 * KSTR * 2;
constexpr int NSA_IMP = NSA_WV + 4 * 2 * 32 * KSTR * 2;
constexpr int NSA_LUT = NSA_IMP + 16 * 260 * 4;
constexpr int NSA_SEL = NSA_LUT + 4 * 128 * 4;
constexpr int NSA_STP = NSA_SEL + 16 * 16 * 4;
constexpr int NSA_END = NSA_STP + 4 * 128 * 4;
static_assert(NSA_END <= SMEM_BYTES, "nsa lds");

__device__ __forceinline__ f32x4 mfma16(bf16x8 a, bf16x8 b, f32x4 c) { return __builtin_amdgcn_mfma_f32_16x16x32_bf16(a, b, c, 0, 0, 0); }
__device__ __forceinline__ bf16x8 pack_p(const f32x4& p1, const f32x4& p2) {
    const unsigned a = pk2(p1[0], p1[1]), b = pk2(p1[2], p1[3]), c = pk2(p2[0], p2[1]), d = pk2(p2[2], p2[3]);
    return __builtin_bit_cast(bf16x8, make_uint4(a, b, c, d));
}
__device__ __forceinline__ void pv_step(f32x4 (&o)[4], const bf16_t* vt, bf16x8 pb, int fq, int fr) {
    const bf16_t* base = vt + (4 * fq + (fr >> 2)) * KSTR + 4 * (fr & 3);
#pragma unroll
    for (int dt = 0; dt < 4; ++dt) {
        const s16x4 lo4 = lds_tr16(base + dt * 16), hi4 = lds_tr16(base + 16 * KSTR + dt * 16);
        const bf16x8 va = (bf16x8){lo4[0], lo4[1], lo4[2], lo4[3], hi4[0], hi4[1], hi4[2], hi4[3]};
        o[dt] = mfma16(va, pb, o[dt]);
    }
}
__device__ __forceinline__ float quad_sum(float v) {
    v += __shfl_xor(v, 1);
    v += __shfl_xor(v, 2);
    return v;
}

__device__ __forceinline__ void nsa_tile(const Params& p, int tt, int g, unsigned char* smem) {
    const int tid = tid_opaque(), lane = tid & 63, wave = tid >> 6, fr = lane & 15, fq = lane >> 4;
    bf16_t* kt = (bf16_t*)(smem + NSA_KT);
    bf16_t* vt = (bf16_t*)(smem + NSA_VT);
    bf16_t* wv = (bf16_t*)(smem + NSA_WV) + wave * 2 * 32 * KSTR;
    float* imp = (float*)(smem + NSA_IMP);
    float* lut = (float*)(smem + NSA_LUT);
    int* sel = (int*)(smem + NSA_SEL);
    const bf16_t* qnb = (const bf16_t*)(p.ws + WS_QNB);
    const bf16_t* kslb = (const bf16_t*)(p.ws + WS_KSLB) + (size_t)g * S * 64;
    const bf16_t* vslb = (const bf16_t*)(p.ws + WS_VSLB) + (size_t)g * S * 64;
    const bf16_t* kwnb = (const bf16_t*)(p.ws + WS_KWNB) + (size_t)g * S * 64;
    const bf16_t* vwnb = (const bf16_t*)(p.ws + WS_VWNB) + (size_t)g * S * 64;
    const bf16_t* kcb = (const bf16_t*)(p.ws + WS_KCB) + (size_t)g * 1024 * 64;
    const bf16_t* vcb = (const bf16_t*)(p.ws + WS_VCB) + (size_t)g * 1024 * 64;
    const float* gt = (const float*)(p.ws + WS_GT);
    const float* relb = p.in[17];
    const int t0 = tt * 16;
    const int tl = 4 * wave + (fr >> 2);
    const int tok = t0 + tl;
    const int hl = fr & 3, head = g * 4 + hl;
    __syncthreads();
    for (int i = tid; i < 512; i += NT) { const int hh = i >> 7, n = i & 127; lut[i] = relb[bucket_of(n) * 16 + g * 4 + hh] * LOG2E; }
    for (int i = tid; i < 16 * 260; i += NT) imp[i] = 0.f;
    float U2;
    {
        const float mq = wave_max(fabsf(p.in[4][lane])), mk = wave_max(fabsf(p.in[5][lane]));
        float mb = 0.f;
#pragma unroll
        for (int k = 0; k < 4; ++k) { const int e = lane + 64 * k; mb = fmaxf(mb, fabsf(relb[(e >> 3) * 16 + (e & 7)])); }
        mb = wave_max(mb);
        U2 = (8.f * mq * mk + mb) * LOG2E;
    }
    bf16x8 qf[2];
#pragma unroll
    for (int kh = 0; kh < 2; ++kh) qf[kh] = *(const bf16x8*)(qnb + (size_t)tok * 512 + head * 64 + kh * 32 + fq * 8);
    __syncthreads();
    const float* lutp = lut + hl * 128;
    const float lutfar = lutp[127];
    const f32x4 zero4 = (f32x4){0.f, 0.f, 0.f, 0.f};
    f32x4 outacc[4];
#pragma unroll
    for (int dt = 0; dt < 4; ++dt) outacc[dt] = zero4;
    const float g0 = gt[(size_t)tok * 32 + head * 3 + 0], g1 = gt[(size_t)tok * 32 + head * 3 + 1], g2 = gt[(size_t)tok * 32 + head * 3 + 2];
    const int srow = tid >> 3, sch = tid & 7;

    bf16_t* ktb = (bf16_t*)(smem + NSA_WV);
    bf16_t* vtb = ktb + 2 * 64 * KSTR;
#define NSA_QK(KT_)                                                                                         \
        f32x4 s1 = zero4, s2 = zero4;                                                                       \
        _Pragma("unroll") for (int kh = 0; kh < 2; ++kh) {                                                  \
            const bf16x8 k1 = *(const bf16x8*)((KT_) + fr * KSTR + kh * 32 + fq * 8);                       \
            const bf16x8 k2 = *(const bf16x8*)((KT_) + (16 + fr) * KSTR + kh * 32 + fq * 8);                \
            s1 = mfma16(k1, qf[kh], s1);                                                                    \
            s2 = mfma16(k2, qf[kh], s2);                                                                    \
        }
    {
        int ks0 = (t0 - 511) & ~63; ks0 = ks0 < 0 ? 0 : ks0;
        const int nsteps = (t0 + 16 - ks0 + 63) >> 6;
        f32x4 o[4];
#pragma unroll
        for (int dt = 0; dt < 4; ++dt) o[dt] = zero4;
        float lsum = 0.f;
#define WIN_ROW(r_) ((r_) < S ? (r_) : S - 1)
        uint4 kr0 = *(const uint4*)(kwnb + (size_t)WIN_ROW(ks0 + srow) * 64 + sch * 8);
        uint4 kr1 = *(const uint4*)(kwnb + (size_t)WIN_ROW(ks0 + 32 + srow) * 64 + sch * 8);
        uint4 vr0 = *(const uint4*)(vwnb + (size_t)WIN_ROW(ks0 + srow) * 64 + sch * 8);
        uint4 vr1 = *(const uint4*)(vwnb + (size_t)WIN_ROW(ks0 + 32 + srow) * 64 + sch * 8);
#pragma unroll 1
        for (int st = 0; st < nsteps; ++st) {
            const int ksb = ks0 + st * 64;
            bf16_t* kt_ = ktb + (st & 1) * 64 * KSTR;
            bf16_t* vt_ = vtb + (st & 1) * 64 * KSTR;
            *(uint4*)(kt_ + srow * KSTR + sch * 8) = kr0; *(uint4*)(kt_ + (32 + srow) * KSTR + sch * 8) = kr1;
            *(uint4*)(vt_ + srow * KSTR + sch * 8) = vr0; *(uint4*)(vt_ + (32 + srow) * KSTR + sch * 8) = vr1;
            __syncthreads();
            if (st + 1 < nsteps) {
                kr0 = *(const uint4*)(kwnb + (size_t)WIN_ROW(ksb + 64 + srow) * 64 + sch * 8);
                kr1 = *(const uint4*)(kwnb + (size_t)WIN_ROW(ksb + 96 + srow) * 64 + sch * 8);
                vr0 = *(const uint4*)(vwnb + (size_t)WIN_ROW(ksb + 64 + srow) * 64 + sch * 8);
                vr1 = *(const uint4*)(vwnb + (size_t)WIN_ROW(ksb + 96 + srow) * 64 + sch * 8);
            }
#pragma unroll
            for (int hf = 0; hf < 2; ++hf) {
                const int ks = ksb + 32 * hf;
                if (ks > t0 + 15) continue;
                NSA_QK(kt_ + hf * 32 * KSTR)
                const bool far = (t0 + 4 * wave) - (ks + 31) >= 113;
                f32x4 p1, p2;
#pragma unroll
                for (int r = 0; r < 4; ++r) {
                    const int d1 = tok - (ks + 4 * fq + r), d2 = d1 - 16;
                    const float b1 = far ? lutfar : lutp[d1 < 0 ? 0 : (d1 > 127 ? 127 : d1)];
                    const float b2 = far ? lutfar : lutp[d2 < 0 ? 0 : (d2 > 127 ? 127 : d2)];
                    p1[r] = (d1 >= 0 && d1 < 512) ? __builtin_amdgcn_exp2f(s1[r] + b1 - U2) : 0.f;
                    p2[r] = (d2 >= 0 && d2 < 512) ? __builtin_amdgcn_exp2f(s2[r] + b2 - U2) : 0.f;
                    lsum += p1[r] + p2[r];
                }
                pv_step(o, vt_ + hf * 32 * KSTR, pack_p(p1, p2), fq, fr);
            }
        }
#undef WIN_ROW
        lsum += __shfl_xor(lsum, 16);
        lsum += __shfl_xor(lsum, 32);
        const float sc = lsum > 0.f ? g2 / lsum : 0.f;
#pragma unroll
        for (int dt = 0; dt < 4; ++dt)
#pragma unroll
            for (int r = 0; r < 4; ++r) outacc[dt][r] += sc * o[dt][r];
    }
    __syncthreads();

    {
        const int tlast = t0 + 15;
        const int cmax = (tlast >= 31) ? ((tlast - 31) >> 4) + 1 : 0;
        const int nsteps = (cmax + 63) >> 6;
        float inv_l = 0.f;
#pragma unroll 1
        for (int pass = 0; pass < 2; ++pass) {
            f32x4 o[4];
#pragma unroll
            for (int dt = 0; dt < 4; ++dt) o[dt] = zero4;
            float lsum = 0.f;
            uint4 kr0 = make_uint4(0, 0, 0, 0), kr1 = kr0, vr0 = kr0, vr1 = kr0;
            if (nsteps > 0) {
                kr0 = *(const uint4*)(kcb + (size_t)srow * 64 + sch * 8); kr1 = *(const uint4*)(kcb + (size_t)(32 + srow) * 64 + sch * 8);
                vr0 = *(const uint4*)(vcb + (size_t)srow * 64 + sch * 8); vr1 = *(const uint4*)(vcb + (size_t)(32 + srow) * 64 + sch * 8);
            }
#pragma unroll 1
            for (int st = 0; st < nsteps; ++st) {
                const int csb = st * 64;
                bf16_t* kt_ = ktb + (st & 1) * 64 * KSTR;
                bf16_t* vt_ = vtb + (st & 1) * 64 * KSTR;
                *(uint4*)(kt_ + srow * KSTR + sch * 8) = kr0; *(uint4*)(kt_ + (32 + srow) * KSTR + sch * 8) = kr1;
                *(uint4*)(vt_ + srow * KSTR + sch * 8) = vr0; *(uint4*)(vt_ + (32 + srow) * KSTR + sch * 8) = vr1;
                __syncthreads();
                if (st + 1 < nsteps) {
                    kr0 = *(const uint4*)(kcb + (size_t)(csb + 64 + srow) * 64 + sch * 8); kr1 = *(const uint4*)(kcb + (size_t)(csb + 96 + srow) * 64 + sch * 8);
                    vr0 = *(const uint4*)(vcb + (size_t)(csb + 64 + srow) * 64 + sch * 8); vr1 = *(const uint4*)(vcb + (size_t)(csb + 96 + srow) * 64 + sch * 8);
                }
#pragma unroll
                for (int hf = 0; hf < 2; ++hf) {
                    const int cs = csb + 32 * hf;
                    if (cs >= cmax) continue;
                    NSA_QK(kt_ + hf * 32 * KSTR)
                    const bool far = (t0 + 4 * wave) - (16 * (cs + 31) + 31) >= 113;
                    f32x4 p1, p2;
#pragma unroll
                    for (int r = 0; r < 4; ++r) {
                        const int d1 = tok - (16 * (cs + 4 * fq + r) + 31), d2 = d1 - 256;
                        const float b1 = far ? lutfar : lutp[d1 < 0 ? 0 : (d1 > 127 ? 127 : d1)];
                        const float b2 = far ? lutfar : lutp[d2 < 0 ? 0 : (d2 > 127 ? 127 : d2)];
                        p1[r] = (d1 >= 0) ? __builtin_amdgcn_exp2f(s1[r] + b1 - U2) : 0.f;
                        p2[r] = (d2 >= 0) ? __builtin_amdgcn_exp2f(s2[r] + b2 - U2) : 0.f;
                        lsum += p1[r] + p2[r];
                    }
                    if (pass == 1) {
#pragma unroll
                        for (int r = 0; r < 4; ++r) { p1[r] *= inv_l; p2[r] *= inv_l; }
                        f32x4 h1, h2;
#pragma unroll
                        for (int r = 0; r < 4; ++r) { h1[r] = quad_sum(p1[r]); h2[r] = quad_sum(p2[r]); }
                        if (hl == 0) {
                            float* ir = imp + tl * 260 + (cs >> 2) + fq;
                            atomicAdd(ir, h1[0] + h1[1] + h1[2] + 0.5f * h1[3]);
                            atomicAdd(ir + 1, 0.5f * h1[3]);
                            atomicAdd(ir + 4, h2[0] + h2[1] + h2[2] + 0.5f * h2[3]);
                            atomicAdd(ir + 5, 0.5f * h2[3]);
                        }
                        pv_step(o, vt_ + hf * 32 * KSTR, pack_p(p1, p2), fq, fr);
                    }
                }
            }
            __syncthreads();
            if (pass == 0) {
                lsum += __shfl_xor(lsum, 16);
                lsum += __shfl_xor(lsum, 32);
                inv_l = lsum > 0.f ? 1.f / lsum : 0.f;
            } else {
#pragma unroll
                for (int dt = 0; dt < 4; ++dt)
#pragma unroll
                    for (int r = 0; r < 4; ++r) outacc[dt][r] += g0 * o[dt][r];
            }
        }
    }
#undef NSA_QK
    __syncthreads();

#pragma unroll 1
    for (int tq = 0; tq < 4; ++tq) {
        const int tli = 4 * wave + tq, tk = t0 + tli, cur = tk >> 6;
        int* sl = sel + tli * 16;
        int nf = 0;
        if (lane == 0) {
            sl[0] = 0; int c_ = 1;
            if (cur - 1 >= 1) sl[c_++] = cur - 1;
            if (cur >= 1) sl[c_++] = cur;
            for (int k = c_; k < 16; ++k) sl[k] = -1;
        }
        nf = 1 + (cur - 1 >= 1 ? 1 : 0) + (cur >= 1 ? 1 : 0);
        const int ncand = cur - 2 > 0 ? cur - 2 : 0;
        int need = 16 - nf; need = need < ncand ? need : ncand;
        unsigned long long key[4];
#pragma unroll
        for (int k = 0; k < 4; ++k) {
            const int n = lane + 64 * k;
            const bool c = (n >= 1) && (n <= cur - 2);
            key[k] = c ? (((unsigned long long)__builtin_bit_cast(unsigned, imp[tli * 260 + n]) << 32) | (unsigned long long)(0xFFFFFFFFu - (unsigned)n)) + (1ull << 32) : 0ull;
        }
#pragma unroll 1
        for (int rd = 0; rd < need; ++rd) {
            unsigned long long m = key[0];
            m = key[1] > m ? key[1] : m; m = key[2] > m ? key[2] : m; m = key[3] > m ? key[3] : m;
#pragma unroll
            for (int o_ = 1; o_ < 64; o_ <<= 1) {
                const unsigned lo_ = __shfl_xor((unsigned)m, o_), hi_ = __shfl_xor((unsigned)(m >> 32), o_);
                const unsigned long long other = ((unsigned long long)hi_ << 32) | lo_;
                m = other > m ? other : m;
            }
            const int nstar = (int)(0xFFFFFFFFu - (unsigned)m);
#pragma unroll
            for (int k = 0; k < 4; ++k) if (key[k] == m) key[k] = 0ull;
            if (lane == 0) sl[nf + rd] = nstar;
        }
    }
    __syncthreads();

    {
        int* stp = (int*)(smem + NSA_STP) + wave * 128;
        int nst;
        {
            const int tq = lane >> 4, j = lane & 15;
            const int cur_ = (t0 + 4 * wave) >> 6;
            const int nf_ = 1 + (cur_ - 1 >= 1 ? 1 : 0) + (cur_ >= 1 ? 1 : 0);
            const bool shared = j < nf_;
            const int tk_ = shared ? t0 + 4 * wave + 3 : t0 + 4 * wave + tq;
            const int b = (shared && tq != 0) ? -1 : sel[(4 * wave + tq) * 16 + j];
            const int tqc = shared ? 4 : tq;
            const bool c1 = (b >= 0) && (b * 64 <= tk_), c2 = (b >= 0) && (b * 64 + 32 <= tk_);
            const unsigned long long m1 = __ballot(c1), m2 = __ballot(c2);
            const unsigned long long lt = (1ull << lane) - 1ull;
            const int pos = __builtin_popcountll(m1 & lt) + __builtin_popcountll(m2 & lt);
            if (c1) stp[pos] = (b * 64) | (tqc << 20);
            if (c2) stp[pos + 1] = (b * 64 + 32) | (tqc << 20);
            nst = __builtin_popcountll(m1) + __builtin_popcountll(m2);
        }
        asm volatile("" ::: "memory");
        uint2 oacc_pk[4];
#pragma unroll
        for (int dt = 0; dt < 4; ++dt) { oacc_pk[dt].x = pk2(outacc[dt][0], outacc[dt][1]); oacc_pk[dt].y = pk2(outacc[dt][2], outacc[dt][3]); }
        f32x4 o[4];
#pragma unroll
        for (int dt = 0; dt < 4; ++dt) o[dt] = zero4;
        float lsum = 0.f;
        const int r8 = lane >> 3, c8 = lane & 7;
        bf16_t* slot0 = wv;
        bf16_t* slot1 = wv + 32 * KSTR;
        bf16_t* kslot = (bf16_t*)(smem + NSA_IMP) + wave * 32 * 64;
        uint4 ka0, ka1, ka2, ka3, kb0, kb1, kb2, kb3;
        uint4 va0, va1, va2, va3;
#define SLC_STEP(i_) __builtin_amdgcn_readfirstlane(stp[(i_) < nst ? (i_) : nst - 1])
#define SLC_KLOAD(K_, w_)                                                                                           \
        { const uint4* kp_ = (const uint4*)(kslb + (size_t)(((w_) & 0xFFFFF) + r8) * 64 + c8 * 8);                      \
          K_##0 = kp_[0]; K_##1 = kp_[64]; K_##2 = kp_[128]; K_##3 = kp_[192]; }
#define SLC_VLOAD(V_, w_)                                                                                           \
        { const uint4* vs_ = (const uint4*)(vslb + (size_t)(((w_) & 0xFFFFF) + r8) * 64 + c8 * 8);                      \
          V_##0 = vs_[0]; V_##1 = vs_[64]; V_##2 = vs_[128]; V_##3 = vs_[192]; }
#define SLC_VSTORE(V_, slot_)                                                                                       \
        { bf16_t* vd_ = (slot_) + r8 * KSTR + c8 * 8;                                                               \
          *(uint4*)(vd_) = V_##0; *(uint4*)(vd_ + 8 * KSTR) = V_##1; *(uint4*)(vd_ + 16 * KSTR) = V_##2; *(uint4*)(vd_ + 24 * KSTR) = V_##3; }
#define SLC_KSTORE(K_)                                                                                              \
        { bf16_t* kd_ = kslot + r8 * 64 + ((c8 ^ r8) * 8);                                                          \
          *(uint4*)(kd_) = K_##0; *(uint4*)(kd_ + 8 * 64) = K_##1; *(uint4*)(kd_ + 16 * 64) = K_##2; *(uint4*)(kd_ + 24 * 64) = K_##3; }
#define SLC_STAGE(s_, K_, VW_, slotr_, slotw_)                                                                      \
        {                                                                                                           \
            const int wcur = SLC_STEP(s_), wk = SLC_STEP((s_) + 2);                                                 \
            SLC_KSTORE(K_)                                                            \
            SLC_VSTORE(VW_, slotw_)                                                      \
            asm volatile("" ::: "memory");                                                                          \
            SLC_VLOAD(VW_, wk)                                                                     \
            SLC_KLOAD(K_, wk)                                                                      \
            f32x4 s1 = zero4, s2 = zero4;                                                                           \
            _Pragma("unroll") for (int kh = 0; kh < 2; ++kh) {                                                      \
                const bf16x8 k1 = *(const bf16x8*)(kslot + fr * 64 + (((kh * 4 + fq) ^ (fr & 7)) * 8));             \
                const bf16x8 k2 = *(const bf16x8*)(kslot + (16 + fr) * 64 + (((kh * 4 + fq) ^ (fr & 7)) * 8));      \
                s1 = mfma16(k1, qf[kh], s1); s2 = mfma16(k2, qf[kh], s2);                                           \
            }                                                                                                       \
            const int ks = wcur & 0xFFFFF, tq = wcur >> 20;                                                         \
            const bool mine = (tq == 4) || ((fr >> 2) == tq);                                                       \
            const bool far = (t0 + 4 * wave + (tq == 4 ? 0 : tq)) - (ks + 31) >= 113;                               \
            f32x4 p1, p2;                                                                                           \
            _Pragma("unroll") for (int r = 0; r < 4; ++r) {                                                         \
                const int d1 = tok - (ks + 4 * fq + r), d2 = d1 - 16;                                               \
                const float b1 = far ? lutfar : lutp[d1 < 0 ? 0 : (d1 > 127 ? 127 : d1)];                           \
                const float b2 = far ? lutfar : lutp[d2 < 0 ? 0 : (d2 > 127 ? 127 : d2)];                           \
                p1[r] = (mine && d1 >= 0) ? __builtin_amdgcn_exp2f(s1[r] + b1 - U2) : 0.f;                          \
                p2[r] = (mine && d2 >= 0) ? __builtin_amdgcn_exp2f(s2[r] + b2 - U2) : 0.f;                          \
                lsum += p1[r] + p2[r];                                                                              \
            }                                                                                                       \
            asm volatile("" ::: "memory");                                                                          \
            pv_step(o, slotr_, pack_p(p1, p2), fq, fr);                                                             \
            asm volatile("" ::: "memory");                                                                          \
        }
        {
            const int w0 = SLC_STEP(0), w1 = SLC_STEP(1);
            SLC_VLOAD(va, w0)
            SLC_KLOAD(ka, w0)
            SLC_KLOAD(kb, w1)
            SLC_VSTORE(va, slot0)
            SLC_VLOAD(va, w1)
        }
#pragma unroll 1
        for (int s = 0; s < nst; s += 2) {
            SLC_STAGE(s, ka, va, slot0, slot1)
            if (s + 1 < nst) SLC_STAGE(s + 1, kb, va, slot1, slot0)
        }
#undef SLC_STEP
#undef SLC_KLOAD
#undef SLC_VLOAD
#undef SLC_VSTORE
#undef SLC_KSTORE
#undef SLC_STAGE
        lsum += __shfl_xor(lsum, 16);
        lsum += __shfl_xor(lsum, 32);
        const float sc = lsum > 0.f ? g1 / lsum : 0.f;
#pragma unroll
        for (int dt = 0; dt < 4; ++dt) {
            outacc[dt][0] = __builtin_bit_cast(float, oacc_pk[dt].x << 16) + sc * o[dt][0];
            outacc[dt][1] = __builtin_bit_cast(float, oacc_pk[dt].x & 0xffff0000u) + sc * o[dt][1];
            outacc[dt][2] = __builtin_bit_cast(float, oacc_pk[dt].y << 16) + sc * o[dt][2];
            outacc[dt][3] = __builtin_bit_cast(float, oacc_pk[dt].y & 0xffff0000u) + sc * o[dt][3];
        }
    }
    bf16_t* orow = (bf16_t*)(p.ws + WS_OA) + (size_t)tok * 512 + head * 64 + 4 * fq;
#pragma unroll
    for (int dt = 0; dt < 4; ++dt) {
        uint2 v; v.x = pk2(outacc[dt][0], outacc[dt][1]); v.y = pk2(outacc[dt][2], outacc[dt][3]);
        *(uint2*)(orow + dt * 16) = v;
    }
}

typedef float f32x16 __attribute__((ext_vector_type(16)));
constexpr int DSA_CK = 0;
constexpr int DSA_CI = DSA_CK + 16 * 512 * 4;
constexpr int DSA_LUT = DSA_CI + 16 * 512 * 2;
constexpr int DSA_END = DSA_LUT + 8 * 128 * 4;
static_assert(DSA_END <= SMEM_BYTES, "dsa lds");

__device__ __forceinline__ unsigned mono_key(float s) {
    const unsigned u = __builtin_bit_cast(unsigned, s + 0.0f);
    return (u & 0x80000000u) ? ~u : (u | 0x80000000u);
}
__device__ __forceinline__ unsigned dsa_compact(unsigned* ck, unsigned short* ci, int n, int lane) {
    unsigned kk[8]; unsigned ii[8];
#pragma unroll
    for (int k = 0; k < 8; ++k) { const int e = lane + 64 * k; kk[k] = e < n ? ck[e] : 0u; ii[k] = e < n ? (unsigned)ci[e] : 0xFFFFu; }
    unsigned T = 0;
#pragma unroll 1
    for (int b = 31; b >= 0; --b) {
        const unsigned cand = T | (1u << b);
        int c = 0;
#pragma unroll
        for (int k = 0; k < 8; ++k) c += __builtin_popcountll(__ballot(kk[k] >= cand));
        if (c >= 256) T = cand;
    }
    int cgt = 0, ceq = 0;
#pragma unroll
    for (int k = 0; k < 8; ++k) { cgt += __builtin_popcountll(__ballot(kk[k] > T)); ceq += __builtin_popcountll(__ballot(kk[k] == T)); }
    const int need = 256 - cgt;
    unsigned X = 0xFFFFu;
    if (ceq > need) {
        X = 0;
#pragma unroll 1
        for (int b = 15; b >= 0; --b) {
            const unsigned cand = X | (1u << b);
            int c = 0;
#pragma unroll
            for (int k = 0; k < 8; ++k) c += __builtin_popcountll(__ballot(kk[k] == T && ii[k] < cand));
            if (c < need) X = cand;
        }
    }
    int base = 0;
    const unsigned long long lt = (1ull << lane) - 1ull;
#pragma unroll
    for (int k = 0; k < 8; ++k) {
        const bool keep = (kk[k] > T) || (kk[k] == T && ii[k] <= X);
        const unsigned long long m = __ballot(keep);
        if (keep) { const int pos = base + __builtin_popcountll(m & lt); ck[pos] = kk[k]; ci[pos] = (unsigned short)ii[k]; }
        base += __builtin_popcountll(m);
    }
    return T;
}

__device__ __forceinline__ void dsa_tile(const Params& p, int tt, unsigned char* smem) {
    const int tid = tid_opaque(), lane = tid & 63, wave = tid >> 6, col = lane & 31, hi = lane >> 5;
    unsigned* ckb = (unsigned*)(smem + DSA_CK);
    unsigned short* cib = (unsigned short*)(smem + DSA_CI);
    const bf16_t* iqb = (const bf16_t*)(p.ws + WS_IQB);
    const bf16_t* ikb = (const bf16_t*)(p.ws + WS_IKB);
    const float* iws = (const float*)(p.ws + WS_IWS);
    const int t0 = tt * 16;
    __syncthreads();
    const int tw = t0 + 4 * wave;
    bf16x8 af[2];
    {
        const int rho = col;
        const int tl_ = 2 * ((rho >> 2) & 1) + (rho >> 4), hd = 4 * ((rho >> 3) & 1) + (rho & 3);
#pragma unroll
        for (int ks = 0; ks < 2; ++ks) af[ks] = *(const bf16x8*)(iqb + (size_t)(tw + tl_) * 256 + hd * 32 + ks * 16 + hi * 8);
    }
    const int tokA = tw + 2 * hi, tokB = tokA + 1;
    float wA[8], wB[8];
#pragma unroll
    for (int h = 0; h < 8; ++h) { wA[h] = iws[(size_t)tokA * 8 + h]; wB[h] = iws[(size_t)tokB * 8 + h]; }
    unsigned* ckA = ckb + (4 * wave + 2 * hi) * 512;
    unsigned* ckB = ckA + 512;
    unsigned short* ciA = cib + (4 * wave + 2 * hi) * 512;
    unsigned short* ciB = ciA + 512;
    int cntA = 0, cntB = 0;
    unsigned LA = 0, LB = 0;
    const unsigned ltm = (1u << col) - 1u;
    const int nchunk = (tw + 4 + 31) >> 5;
    const f32x16 zero16 = {0.f, 0.f, 0.f, 0.f, 0.f, 0.f, 0.f, 0.f, 0.f, 0.f, 0.f, 0.f, 0.f, 0.f, 0.f, 0.f};
    bf16x8 nx0[4], nx1[4];
    const bf16_t* ikl = ikb + (size_t)col * 32 + hi * 8;
#pragma unroll
    for (int j = 0; j < 4; ++j) {
        const int cj = j < nchunk ? j : nchunk - 1;
        nx0[j] = *(const bf16x8*)(ikl + (size_t)cj * 1024); nx1[j] = *(const bf16x8*)(ikl + (size_t)cj * 1024 + 16);
    }
#pragma unroll 1
    for (int ch4 = 0; ch4 < nchunk; ch4 += 4) {
#pragma unroll
        for (int j = 0; j < 4; ++j) {
            const int ch = ch4 + j;
            const bf16x8 cu0 = nx0[j], cu1 = nx1[j];
            {
                int cj = ch + 4; cj = cj < nchunk ? cj : nchunk - 1;
                nx0[j] = *(const bf16x8*)(ikl + (size_t)cj * 1024); nx1[j] = *(const bf16x8*)(ikl + (size_t)cj * 1024 + 16);
            }
            if (ch < nchunk) {
                const int kidx = ch * 32 + col;
                f32x16 c = __builtin_amdgcn_mfma_f32_32x32x16_bf16(af[0], cu0, zero16, 0, 0, 0);
                c = __builtin_amdgcn_mfma_f32_32x32x16_bf16(af[1], cu1, c, 0, 0, 0);
                float sA = 0.f, sB = 0.f;
#pragma unroll
                for (int h = 0; h < 8; ++h) { sA += wA[h] * fmaxf(c[h], 0.f); sB += wB[h] * fmaxf(c[8 + h], 0.f); }
                const unsigned keyA = mono_key(sA), keyB = mono_key(sB);
                const bool pA = (kidx <= tokA) && (keyA > LA), pB = (kidx <= tokB) && (keyB > LB);
                const unsigned long long mA = __ballot(pA), mB = __ballot(pB);
                const unsigned hA = hi ? (unsigned)(mA >> 32) : (unsigned)mA, hB = hi ? (unsigned)(mB >> 32) : (unsigned)mB;
                if (pA) { const int pos = cntA + __builtin_popcount(hA & ltm); ckA[pos] = keyA; ciA[pos] = (unsigned short)kidx; }
                if (pB) { const int pos = cntB + __builtin_popcount(hB & ltm); ckB[pos] = keyB; ciB[pos] = (unsigned short)kidx; }
                cntA += __builtin_popcount(hA); cntB += __builtin_popcount(hB);
            }
            if (!(j & 1)) continue;
        if (__any((cntA > 448) || (cntB > 448))) {
#pragma unroll
            for (int tq = 0; tq < 4; ++tq) {
                const int cn = __shfl((tq & 1) ? cntB : cntA, (tq >> 1) * 32);
                if (cn > 448) {
                    const unsigned T = dsa_compact(ckb + (4 * wave + tq) * 512, cib + (4 * wave + tq) * 512, cn, lane);
                    if (hi == (tq >> 1)) { if (tq & 1) { cntB = 256; LB = T; } else { cntA = 256; LA = T; } }
                }
            }
        }
    }
    }
#pragma unroll
    for (int tq = 0; tq < 4; ++tq) {
        const int cn = __shfl((tq & 1) ? cntB : cntA, (tq >> 1) * 32);
        if (cn > 256) {
            (void)dsa_compact(ckb + (4 * wave + tq) * 512, cib + (4 * wave + tq) * 512, cn, lane);
            if (hi == (tq >> 1)) { if (tq & 1) cntB = 256; else cntA = 256; }
        }
    }
    unsigned short* selg = (unsigned short*)(p.ws + WS_SEL);
    int* nselg = (int*)(p.ws + WS_NSEL);
#pragma unroll
    for (int tq = 0; tq < 4; ++tq) {
        int nsel = __shfl((tq & 1) ? cntB : cntA, (tq >> 1) * 32);
        nsel = nsel > 256 ? 256 : nsel;
        const unsigned short* sl = cib + (4 * wave + tq) * 512;
#pragma unroll
        for (int k = 0; k < 4; ++k) { const int e = lane + 64 * k; selg[(size_t)(tw + tq) * 256 + e] = e < nsel ? sl[e] : (unsigned short)0; }
        if (lane == 0) nselg[tw + tq] = nsel;
    }
}

__device__ __forceinline__ void phase_dsa_attn(const Params& p, int bid, int nb, unsigned char* smem) {
    const int tid = tid_opaque(), lane = tid & 63, wave = tid >> 6, slot = lane >> 3, chunk = lane & 7;
    float* lut = (float*)smem;
    const bf16_t* dqb = (const bf16_t*)(p.ws + WS_DQB);
    const bf16_t* dkb = (const bf16_t*)(p.ws + WS_DKB);
    const bf16_t* dvb = (const bf16_t*)(p.ws + WS_DVB);
    const unsigned short* selg = (const unsigned short*)(p.ws + WS_SEL);
    const int* nselg = (const int*)(p.ws + WS_NSEL);
    const float* relb = p.in[17];
    const int h = bid & 7, bh = bid >> 3, nbh = nb >> 3;
    __syncthreads();
    if (tid < 128) lut[tid] = relb[bucket_of(tid) * 16 + 8 + h] * LOG2E;
    float U2;
    {
        const float mq = wave_max(fabsf(p.in[6][lane])), mk = wave_max(fabsf(p.in[7][lane]));
        float mb = 0.f;
#pragma unroll
        for (int k = 0; k < 4; ++k) { const int e = lane + 64 * k; mb = fmaxf(mb, fabsf(relb[(e >> 3) * 16 + 8 + (e & 7)])); }
        mb = wave_max(mb);
        U2 = (8.f * mq * mk + mb) * LOG2E;
    }
    __syncthreads();
    const bf16_t* kbase = dkb + h * 64 + chunk * 8;
    const bf16_t* vbase = dvb + h * 64 + chunk * 8;
#pragma unroll 1
    for (int t = bh * 4 + wave; t < S; t += nbh * 4) {
        const int nsel = nselg[t];
        const uint2* ip = (const uint2*)(selg + (size_t)t * 256 + slot * 32);
        float q[8];
        {
            const uint4 qv = *(const uint4*)(dqb + (size_t)t * 512 + h * 64 + chunk * 8);
            q[0] = __builtin_bit_cast(float, qv.x << 16); q[1] = __builtin_bit_cast(float, qv.x & 0xffff0000u);
            q[2] = __builtin_bit_cast(float, qv.y << 16); q[3] = __builtin_bit_cast(float, qv.y & 0xffff0000u);
            q[4] = __builtin_bit_cast(float, qv.z << 16); q[5] = __builtin_bit_cast(float, qv.z & 0xffff0000u);
            q[6] = __builtin_bit_cast(float, qv.w << 16); q[7] = __builtin_bit_cast(float, qv.w & 0xffff0000u);
        }
        float o[8];
#pragma unroll
        for (int j = 0; j < 8; ++j) o[j] = 0.f;
        float lsum = 0.f;
        int sA_[4], sB_[4];
        uint4 kA_[4], vA_[4], kB_[4], vB_[4];
        uint2 idn = ip[0];
#define DSA_LOADG(S_, K_, V_, I_)                                                        \
        S_[0] = (int)((I_).x & 0xffffu); S_[1] = (int)((I_).x >> 16); S_[2] = (int)((I_).y & 0xffffu); S_[3] = (int)((I_).y >> 16); \
        _Pragma("unroll") for (int j = 0; j < 4; ++j) {                                 \
            K_[j] = *(const uint4*)(kbase + (size_t)S_[j] * 512);                        \
            V_[j] = *(const uint4*)(vbase + (size_t)S_[j] * 512);                        \
        }
#define DSA_COMPG(S_, K_, V_, gi)                                                        \
        _Pragma("unroll") for (int j = 0; j < 4; ++j) {                                 \
            const uint4 kv = K_[j], vv = V_[j];                                          \
            float d = q[0] * __builtin_bit_cast(float, kv.x << 16) + q[1] * __builtin_bit_cast(float, kv.x & 0xffff0000u) \
                    + q[2] * __builtin_bit_cast(float, kv.y << 16) + q[3] * __builtin_bit_cast(float, kv.y & 0xffff0000u) \
                    + q[4] * __builtin_bit_cast(float, kv.z << 16) + q[5] * __builtin_bit_cast(float, kv.z & 0xffff0000u) \
                    + q[6] * __builtin_bit_cast(float, kv.w << 16) + q[7] * __builtin_bit_cast(float, kv.w & 0xffff0000u); \
            d += __shfl_xor(d, 1); d += __shfl_xor(d, 2); d += __shfl_xor(d, 4);       \
            int dist = t - S_[j]; dist = dist > 127 ? 127 : (dist < 0 ? 0 : dist);       \
            float pr = __builtin_amdgcn_exp2f(d + lut[dist] - U2);                       \
            pr = (slot * 32 + (gi) * 4 + j < nsel) ? pr : 0.f;                           \
            lsum += pr;                                                                  \
            o[0] += pr * __builtin_bit_cast(float, vv.x << 16); o[1] += pr * __builtin_bit_cast(float, vv.x & 0xffff0000u); \
            o[2] += pr * __builtin_bit_cast(float, vv.y << 16); o[3] += pr * __builtin_bit_cast(float, vv.y & 0xffff0000u); \
            o[4] += pr * __builtin_bit_cast(float, vv.z << 16); o[5] += pr * __builtin_bit_cast(float, vv.z & 0xffff0000u); \
            o[6] += pr * __builtin_bit_cast(float, vv.w << 16); o[7] += pr * __builtin_bit_cast(float, vv.w & 0xffff0000u); \
        }
        DSA_LOADG(sA_, kA_, vA_, idn)
        idn = ip[1];
#pragma unroll 1
        for (int gi = 0; gi < 8; gi += 2) {
            DSA_LOADG(sB_, kB_, vB_, idn)
            idn = ip[gi + 2 < 8 ? gi + 2 : 7];
            DSA_COMPG(sA_, kA_, vA_, gi)
            DSA_LOADG(sA_, kA_, vA_, idn)
            idn = ip[gi + 3 < 8 ? gi + 3 : 7];
            DSA_COMPG(sB_, kB_, vB_, gi + 1)
        }
#undef DSA_LOADG
#undef DSA_COMPG
#pragma unroll
        for (int j = 0; j < 8; ++j) { o[j] += __shfl_xor(o[j], 8); o[j] += __shfl_xor(o[j], 16); o[j] += __shfl_xor(o[j], 32); }
        lsum += __shfl_xor(lsum, 8); lsum += __shfl_xor(lsum, 16); lsum += __shfl_xor(lsum, 32);
        if (slot == 0) {
            const float inv = lsum > 0.f ? 1.f / lsum : 0.f;
            uint4 ov;
            ov.x = pk2(o[0] * inv, o[1] * inv); ov.y = pk2(o[2] * inv, o[3] * inv); ov.z = pk2(o[4] * inv, o[5] * inv); ov.w = pk2(o[6] * inv, o[7] * inv);
            *(uint4*)((bf16_t*)(p.ws + WS_OB) + (size_t)t * 512 + h * 64 + chunk * 8) = ov;
        }
    }
}

__device__ __forceinline__ void convert_late_weights(const Params& p, int bid, int nb) {
    cvt_weights(p.in[21], (bf16_t*)(p.ws + WB_E1), (size_t)NEXP * D * 2 * DFF, bid, nb);
    cvt_weights(p.in[23], (bf16_t*)(p.ws + WB_E2), (size_t)NEXP * DFF * D, bid, nb);
    cvt_weights(p.in[27], (bf16_t*)(p.ws + WB_PLEG), (size_t)D * D, bid, nb);
}
__device__ __forceinline__ void phase_attn(const Params& p, int bid, int nb, unsigned char* smem) {
    const bool conv_first = bid < (nb >> 1);
    if (conv_first) convert_late_weights(p, bid, nb);
#pragma unroll 1
    for (int part = 0; part < 2; ++part) {
        if ((part == 0) == conv_first) {
#pragma unroll 1
        for (int w = bid, rd = 0; w < 1024; w += nb, ++rd) {
            const int r0 = w - bid;
            const int cnt = (1024 - r0) < nb ? (1024 - r0) : nb;
            const int k = (rd & 1) ? (cnt - 1 - bid) : bid;
            dsa_tile(p, 1023 - (r0 + k), smem);
        }
    }
        else {
#pragma unroll 1
        for (int i = bid, rd = 0; i < 2048; i += nb, ++rd) {
            const int r0 = i - bid;
            const int cnt = (2048 - r0) < nb ? (2048 - r0) : nb;
            const int k = ((rd & 1) && !(cnt & 1)) ? 2 * ((cnt >> 1) - 1 - (bid >> 1)) + (bid & 1) : bid;
            const int j = r0 + k;
            nsa_tile(p, 1023 - (j >> 1), j & 1, smem);
        }
    }
    }
    if (!conv_first) convert_late_weights(p, bid, nb);
}

template <int PASS>
__device__ __forceinline__ void phase_merge(const Params& p, int bid, int nb, unsigned char* smem) {
    const int g2tid = tid_opaque();
    const bf16_t* sg = (const bf16_t*)(p.ws + (PASS ? WS_SGB : WS_SGA));
    bf16_t* merged = (bf16_t*)(p.ws + WS_MERGED);
    float* tmp = (float*)(p.ws + WS_X1);
    const bf16_t* A = (const bf16_t*)(p.ws + (PASS ? WS_OB : WS_OA));
    const bf16_t* Bw = (const bf16_t*)(p.ws + (PASS ? WB_B : WB_A));
    for (int w = bid; w < 128 * 8; w += nb) {
        const int mt = w % 128, nt = w / 128;
        const int m0 = mt * 128, n0 = nt * 128;
        f32x4 acc[4][4];
        gemm2<false, false>(A, 512, nullptr, m0, 128, Bw, D, n0, 128, 512, smem, acc);
#pragma unroll
        for (int i = 0; i < 4; ++i) {
            float vv[4][4];
#pragma unroll
            for (int r = 0; r < 4; ++r) {
                const int row = m0 + G2_ROW(i, r);
                const bf16_t* zr = sg + (size_t)row * D + n0 + G2_COL(0);
                float* tr = tmp + (size_t)row * D + n0 + G2_COL(0);
#pragma unroll
                for (int j = 0; j < 4; ++j) {
                    const float v = bf2f(zr[j * 16]) * acc[i][j][r];
                    if (PASS == 0) tr[j * 16] = v;
                    else vv[j][r] = tr[j * 16] + v;
                }
            }
            if (PASS == 1) {
                bf16_t* mr = merged + (size_t)(m0 + G2_ROW(i, 0)) * D + n0 + G2_COL(0);
#pragma unroll
                for (int j = 0; j < 4; ++j) store_bf16_frag(mr + j * 16, D, vv[j][0], vv[j][1], vv[j][2], vv[j][3], g2tid & 63);
            }
        }
    }
}

__device__ __forceinline__ void phase_outproj(const Params& p, int bid, int nb, unsigned char* smem) {
    const int g2tid = tid_opaque();
    const bf16_t* merged = (const bf16_t*)(p.ws + WS_MERGED);
    const float* x = p.in[0];
    float* x1 = (float*)(p.ws + WS_X1);
    for (int w = bid; w < 128 * 8; w += nb) {
        const int mt = w % 128, nt = w / 128;
        const int m0 = mt * 128, n0 = nt * 128;
        f32x4 acc[4][4];
        gemm2<false, false>(merged, D, nullptr, m0, 128, (const bf16_t*)(p.ws + WB_OUT), D, n0, 128, D, smem, acc);
#pragma unroll
        for (int i = 0; i < 4; ++i)
#pragma unroll
            for (int r = 0; r < 4; ++r) {
                const size_t ro = (size_t)(m0 + G2_ROW(i, r)) * D + n0;
#pragma unroll
                for (int j = 0; j < 4; ++j) { const int c = G2_COL(j); x1[ro + c] = x[ro + c] + acc[i][j][r]; }
            }
    }
}

__device__ __forceinline__ void phase_route(const Params& p, int bid, int nb, unsigned char* smem) {
    const int lane = tid_opaque() & 63, wave = tid_opaque() >> 6;
    const float* x1 = (const float*)(p.ws + WS_X1);
    const float* g = p.in[18];
    const float* wr = p.in[19];
    const float* br = p.in[20];
    bf16_t* hb = (bf16_t*)(p.ws + WS_HB);
    int* topi = (int*)(p.ws + WS_TOPI);
    float* topw = (float*)(p.ws + WS_TOPW);
    float* hl = (float*)smem + wave * 1056;
    int* cntl = (int*)(smem + 4 * 1056 * 4);
    const int ksub = lane >> 3, e4 = lane & 7;
    __syncthreads();
    if (tid_opaque() < 32) cntl[tid_opaque()] = 0;
    __syncthreads();
    for (int t = bid * 4 + wave; t < S; t += nb * 4) {
        const float4* xr = (const float4*)(x1 + (size_t)t * D);
        float4 v[4];
        float ss = 0.f;
#pragma unroll
        for (int j = 0; j < 4; ++j) { v[j] = xr[lane + 64 * j]; ss += v[j].x * v[j].x + v[j].y * v[j].y + v[j].z * v[j].z + v[j].w * v[j].w; }
        ss = wave_sum(ss);
        const float rstd = rsqrtf(ss * (1.f / D) + EPS);
#pragma unroll
        for (int j = 0; j < 4; ++j) {
            const float4 gg = ((const float4*)g)[lane + 64 * j];
            const float4 h4 = make_float4(v[j].x * rstd * gg.x, v[j].y * rstd * gg.y, v[j].z * rstd * gg.z, v[j].w * rstd * gg.w);
            uint2 o; o.x = pk2(h4.x, h4.y); o.y = pk2(h4.z, h4.w);
            ((uint2*)(hb + (size_t)t * D))[lane + 64 * j] = o;
            ((float4*)hl)[lane + 64 * j] = h4;
        }
        asm volatile("" ::: "memory");
        float4 acc = make_float4(0.f, 0.f, 0.f, 0.f);
        const float4* wp = (const float4*)(wr + (size_t)ksub * 32) + e4;
#pragma unroll 8
        for (int i = 0; i < 128; ++i) {
            const float hk = hl[8 * i + ksub];
            const float4 w4 = wp[(size_t)i * 64];
            acc.x += hk * w4.x; acc.y += hk * w4.y; acc.z += hk * w4.z; acc.w += hk * w4.w;
        }
#pragma unroll
        for (int o_ = 8; o_ < 64; o_ <<= 1) { acc.x += __shfl_xor(acc.x, o_); acc.y += __shfl_xor(acc.y, o_); acc.z += __shfl_xor(acc.z, o_); acc.w += __shfl_xor(acc.w, o_); }
        if (ksub == 0) {
            const float4 b4 = ((const float4*)br)[e4];
            ((float4*)(hl + 1024))[e4] = make_float4(acc.x + b4.x, acc.y + b4.y, acc.z + b4.z, acc.w + b4.w);
        }
        asm volatile("" ::: "memory");
        float lg[32];
#pragma unroll
        for (int e = 0; e < 8; ++e) { const float4 l4 = ((const float4*)(hl + 1024))[e]; lg[4 * e] = l4.x; lg[4 * e + 1] = l4.y; lg[4 * e + 2] = l4.z; lg[4 * e + 3] = l4.w; }
        asm volatile("" ::: "memory");
        int idx[4]; float val[4];
        unsigned used = 0;
#pragma unroll
        for (int k = 0; k < 4; ++k) {
            float best = -__builtin_inff(); int bi = 0;
#pragma unroll
            for (int e = 0; e < 32; ++e) { const bool ok = !((used >> e) & 1u) && (lg[e] > best); best = ok ? lg[e] : best; bi = ok ? e : bi; }
            idx[k] = bi; val[k] = best; used |= 1u << bi;
        }
        const float e0 = 1.f, e1 = __expf(val[1] - val[0]), e2 = __expf(val[2] - val[0]), e3 = __expf(val[3] - val[0]);
        const float inv = 1.f / (e0 + e1 + e2 + e3);
        if (lane == 0) {
            topi[t * 4 + 0] = idx[0]; topi[t * 4 + 1] = idx[1]; topi[t * 4 + 2] = idx[2]; topi[t * 4 + 3] = idx[3];
            topw[t * 4 + 0] = e0 * inv; topw[t * 4 + 1] = e1 * inv; topw[t * 4 + 2] = e2 * inv; topw[t * 4 + 3] = e3 * inv;
            atomicAdd(&cntl[idx[0]], 1); atomicAdd(&cntl[idx[1]], 1); atomicAdd(&cntl[idx[2]], 1); atomicAdd(&cntl[idx[3]], 1);
        }
    }
    __syncthreads();
    if (tid_opaque() < 32) ((int*)(p.ws + WS_CNTB))[bid * 32 + tid_opaque()] = cntl[tid_opaque()];
}

__device__ __forceinline__ void phase_place(const Params& p, int bid, int nb, unsigned char* smem) {
    const int tid = tid_opaque(), lane = tid & 63, wave = tid >> 6;
    int* part_tot = (int*)smem;
    int* part_bef = part_tot + 256;
    int* base = part_bef + 256;
    int* curl = base + 32;
    const int* cntb = (const int*)(p.ws + WS_CNTB);
    int* cnt = (int*)(p.ws + WS_CTL);
    const int* topi = (const int*)(p.ws + WS_TOPI);
    int* ppos = (int*)(p.ws + WS_PPOS);
    int* rowtok = (int*)(p.ws + WS_ROWTOK);
    __syncthreads();
    {
        const int e = tid & 31, part = tid >> 5;
        int tot = 0, bef = 0;
        for (int b = part; b < nb; b += 8) { const int c = cntb[b * 32 + e]; tot += c; bef += (b < bid) ? c : 0; }
        part_tot[part * 32 + e] = tot; part_bef[part * 32 + e] = bef;
    }
    __syncthreads();
    if (tid < 32) {
        int tot = 0, bef = 0;
#pragma unroll
        for (int k = 0; k < 8; ++k) { tot += part_tot[k * 32 + tid]; bef += part_bef[k * 32 + tid]; }
        part_tot[tid] = tot; part_bef[tid] = bef;
        if (bid == 0) cnt[tid] = tot;
    }
    __syncthreads();
    if (tid == 0) { int a = 0; for (int e = 0; e < NEXP; ++e) { base[e] = a + part_bef[e]; a += part_tot[e]; curl[e] = 0; } }
    __syncthreads();
    for (int t = bid * 4 + wave; t < S; t += nb * 4) {
        if (lane < 4) {
            const int i = t * 4 + lane;
            const int e = topi[i];
            const int pos = base[e] + atomicAdd(&curl[e], 1);
            ppos[i] = pos;
            rowtok[pos] = t;
        }
    }
}

__device__ __forceinline__ void moe_tile_map(const int* cnt, int* sm, int& total_mt) {
    __syncthreads();
    if (tid_opaque() == 0) {
        int a = 0, b = 0;
        for (int e = 0; e < NEXP; ++e) { sm[e] = a; sm[33 + e] = b; a += (cnt[e] + 127) >> 7; b += cnt[e]; }
        sm[32] = a; sm[65] = b;
    }
    __syncthreads();
    total_mt = sm[32];
}
__device__ __forceinline__ void phase_moe1(const Params& p, int bid, int nb, unsigned char* smem) {
    const int g2tid = tid_opaque();
    int* sm = (int*)(smem + 65536);
    const int* cnt = (const int*)(p.ws + WS_CTL);
    const int* rowtok = (const int*)(p.ws + WS_ROWTOK);
    const bf16_t* hb = (const bf16_t*)(p.ws + WS_HB);
    bf16_t* act = (bf16_t*)(p.ws + WS_ACT);
    const int lane = tid_opaque() & 63, wave = tid_opaque() >> 6;
    int total_mt;
    moe_tile_map(cnt, sm, total_mt);
    for (int w = bid; w < total_mt * 16; w += nb) {
        const int tm = w >> 4, nt = w & 15;
        int e = 0;
        while (e < NEXP - 1 && sm[e + 1] <= tm) ++e;
        const int mt = tm - sm[e];
        const int rbase = sm[33 + e] + mt * 128;
        const int mrows = min(128, cnt[e] - mt * 128);
        const int n0 = nt * 64;
        f32x4 acc[4][4];
        gemm2<true, true>(hb, D, rowtok, rbase, mrows, (const bf16_t*)(p.ws + WB_E1) + (size_t)e * D * 2 * DFF, 2 * DFF, n0, 128, D, smem, acc);
        const float* b1 = p.in[22] + (size_t)e * 2 * DFF;
        const int wn_ = (tid_opaque() >> 6) & 1;
#pragma unroll
        for (int i = 0; i < 4; ++i)
#pragma unroll
            for (int jp = 0; jp < 2; ++jp) {
                const int col = n0 + (wn_ * 2 + jp) * 16 + (tid_opaque() & 15);
                const float bg = b1[col], bl = b1[DFF + col];
                float av[4];
                unsigned rmask = 0;
#pragma unroll
                for (int r = 0; r < 4; ++r) {
                    const int rl = G2_ROW(i, r);
                    const float gate = fminf(acc[i][2 * jp][r] + bg, 7.f);
                    const float lin = fminf(fmaxf(acc[i][2 * jp + 1][r] + bl, -7.f), 7.f);
                    av[r] = (lin + 1.f) * gate * sigmoidf_(1.702f * gate);
                    rmask |= (rl < mrows) ? (1u << r) : 0u;
                }
                store_bf16_frag(act + (size_t)(rbase + G2_ROW(i, 0)) * DFF + col, DFF, av[0], av[1], av[2], av[3], g2tid & 63, rmask);
            }
    }
}
__device__ __forceinline__ void phase_moe2(const Params& p, int bid, int nb, unsigned char* smem) {
    const int g2tid = tid_opaque();
    int* sm = (int*)(smem + 65536);
    const int* cnt = (const int*)(p.ws + WS_CTL);
    const bf16_t* act = (const bf16_t*)(p.ws + WS_ACT);
    float* yrows = (float*)(p.ws + WS_YROWS);
    const int lane = tid_opaque() & 63, wave = tid_opaque() >> 6;
    int total_mt;
    moe_tile_map(cnt, sm, total_mt);
    for (int w = bid; w < total_mt * 8; w += nb) {
        const int tm = w >> 3, nt = w & 7;
        int e = 0;
        while (e < NEXP - 1 && sm[e + 1] <= tm) ++e;
        const int mt = tm - sm[e];
        const int rbase = sm[33 + e] + mt * 128;
        const int mrows = min(128, cnt[e] - mt * 128);
        const int n0 = nt * 128;
        f32x4 acc[4][4];
        gemm2<false, false>(act, DFF, nullptr, rbase, mrows, (const bf16_t*)(p.ws + WB_E2) + (size_t)e * DFF * D, D, n0, 128, DFF, smem, acc);
        const float* b2 = p.in[24] + (size_t)e * D + n0;
#pragma unroll
        for (int i = 0; i < 4; ++i)
#pragma unroll
            for (int r = 0; r < 4; ++r) {
                const int rl = G2_ROW(i, r);
                if (rl < mrows) {
                    float* yr = yrows + (size_t)(rbase + rl) * D + n0;
#pragma unroll
                    for (int j = 0; j < 4; ++j) { const int c = G2_COL(j); yr[c] = acc[i][j][r] + b2[c]; }
                }
            }
    }
}

__device__ __forceinline__ void phase_combine(const Params& p, int bid, int nb) {
    const int lane = tid_opaque() & 63, wave = tid_opaque() >> 6;
    const float* x1 = (const float*)(p.ws + WS_X1);
    const float* yrows = (const float*)(p.ws + WS_YROWS);
    const int* ppos = (const int*)(p.ws + WS_PPOS);
    const float* topw = (const float*)(p.ws + WS_TOPW);
    const float* g = p.in[25];
    bf16_t* hb = (bf16_t*)(p.ws + WS_HB);
    bf16_t* pb = (bf16_t*)(p.ws + WS_PB);
    for (int t = bid * 4 + wave; t < S; t += nb * 4) {
        float4 v[4];
#pragma unroll
        for (int j = 0; j < 4; ++j) v[j] = ((const float4*)(x1 + (size_t)t * D))[lane + 64 * j];
#pragma unroll
        for (int k = 0; k < 4; ++k) {
            const float wk = topw[t * 4 + k];
            const float4* yr = (const float4*)(yrows + (size_t)ppos[t * 4 + k] * D);
#pragma unroll
            for (int j = 0; j < 4; ++j) { const float4 y = yr[lane + 64 * j]; v[j].x += wk * y.x; v[j].y += wk * y.y; v[j].z += wk * y.z; v[j].w += wk * y.w; }
        }
        float ss = 0.f;
#pragma unroll
        for (int j = 0; j < 4; ++j) ss += v[j].x * v[j].x + v[j].y * v[j].y + v[j].z * v[j].z + v[j].w * v[j].w;
        ss = wave_sum(ss);
        const float rstd = rsqrtf(ss * (1.f / D) + EPS);
#pragma unroll
        for (int j = 0; j < 4; ++j) {
            ((float4*)(p.out + (size_t)t * D))[lane + 64 * j] = v[j];
            const float4 gg = ((const float4*)g)[lane + 64 * j];
            uint2 o;
            o.x = pk2(v[j].x * rstd * gg.x, v[j].y * rstd * gg.y);
            o.y = pk2(v[j].z * rstd * gg.z, v[j].w * rstd * gg.w);
            ((uint2*)(hb + (size_t)t * D))[lane + 64 * j] = o;
        }
    }
}

__device__ __forceinline__ void phase_ple(const Params& p, int bid, int nb, unsigned char* smem) {
    const int g2tid = tid_opaque();
    const bf16_t* pw = (const bf16_t*)(p.ws + WS_PW);
    for (int w = bid; w < 128 * 8; w += nb) {
        const int mt = w % 128, nt = w / 128;
        const int m0 = mt * 128, n0 = nt * 128;
        f32x4 acc[4][4];
        gemm2<false, false>((const bf16_t*)(p.ws + WS_HB), D, nullptr, m0, 128, (const bf16_t*)(p.ws + WB_PLEG), D, n0, 128, D, smem, acc);
#pragma unroll
        for (int i = 0; i < 4; ++i)
#pragma unroll
            for (int r = 0; r < 4; ++r) {
                const size_t ro = (size_t)(m0 + G2_ROW(i, r)) * D + n0 + G2_COL(0);
                float* orow = p.out + ro;
#pragma unroll
                for (int j = 0; j < 4; ++j) orow[j * 16] = orow[j * 16] + sigmoidf_(acc[i][j][r]) * bf2f(pw[ro + j * 16]);
            }
    }
}

#define LAS __attribute__((address_space(3)))
#define XB_TMO      128
#define XB_XCNT(j)  (256  + 64 * (j))
#define XB_XSUB(j)  (1280 + 64 * (j))
#define XB_XGEN(j)  (2304 + 64 * (j))
#define XB_TOP      3328
#define XB_TOPGEN   3392
#define XCD_BAR_WORDS 3456
#define XB_SPIN_CAP (1u << 22)

__device__ __forceinline__ unsigned xb_ld(unsigned* p)              { return __hip_atomic_load(p, __ATOMIC_RELAXED, __HIP_MEMORY_SCOPE_AGENT); }
__device__ __forceinline__ unsigned xb_add(unsigned* p, unsigned v) { return __hip_atomic_fetch_add(p, v, __ATOMIC_RELAXED, __HIP_MEMORY_SCOPE_AGENT); }
__device__ __forceinline__ unsigned xb_xcc_id() { return (unsigned)__builtin_amdgcn_s_getreg((3 << 11) | 20) & 0xFu; }
#define XB_SPIN(cond, bar) do { unsigned _sp = 0; while (cond) { __builtin_amdgcn_s_sleep(1); \
    if ((++_sp & 255u) == 0u) { if (xb_ld(&(bar)[XB_TMO])) break; if (_sp > XB_SPIN_CAP) { atomicAdd(&(bar)[XB_TMO], 1u); break; } } } } while (0)

struct XcdBarrier {
    unsigned* bar; unsigned x;
    volatile LAS unsigned* st;
};

__device__ __forceinline__ XcdBarrier xcd_barrier_post(unsigned* bar, volatile LAS unsigned* st) {
    XcdBarrier b; b.bar = bar; b.x = xb_xcc_id(); b.st = st;
    if (tid_opaque() == 0) (void)xb_add(&bar[XB_XCNT(b.x)], 1u);
    return b;
}
__device__ __forceinline__ void xcd_barrier_complete(unsigned* bar, unsigned x, unsigned& nloc, unsigned& nx) {
    const unsigned G = gridDim.x * gridDim.y * gridDim.z;
    unsigned sum, cnt, mine, sp = 0u;
    for (;;) {
        sum = 0u; cnt = 0u; mine = 0u;
#pragma unroll
        for (unsigned j = 0; j < 16; ++j) { const unsigned c = xb_ld(&bar[XB_XCNT(j)]); sum += c; cnt += (c > 0u) ? 1u : 0u; mine = (j == x) ? c : mine; }
        if (sum == G) break;
        __builtin_amdgcn_s_sleep(1);
        if ((++sp & 255u) == 0u) { if (xb_ld(&bar[XB_TMO])) break; if (sp > XB_SPIN_CAP) { atomicAdd(&bar[XB_TMO], 1u); break; } }
    }
    nloc = mine > 0u ? mine : 1u; nx = cnt > 0u ? cnt : 1u;
}

__device__ __forceinline__ void xcd_barrier(const XcdBarrier& b) {
    asm volatile("s_waitcnt vmcnt(0)" ::: "memory");
    __syncthreads();
    if (tid_opaque() == 0) {
        unsigned* bar = b.bar;
        __builtin_amdgcn_s_waitcnt(0);
        unsigned nloc = b.st[0], nx = b.st[1];
        if (nloc == 0u) { xcd_barrier_complete(bar, b.x, nloc, nx); b.st[0] = nloc; b.st[1] = nx; }
        const unsigned old = xb_add(&bar[XB_XSUB(b.x)], 1u);
        const unsigned gen = old / nloc;
        if (old + 1u == (gen + 1u) * nloc) {
            __builtin_amdgcn_fence(__ATOMIC_RELEASE, "agent");
            asm volatile("s_waitcnt vmcnt(0)" ::: "memory");
            const unsigned og = xb_add(&bar[XB_TOP], 1u);
            const unsigned tg = og / nx;
            if (og + 1u == (tg + 1u) * nx) xb_add(&bar[XB_TOPGEN], 1u);
            else XB_SPIN(xb_ld(&bar[XB_TOPGEN]) == tg, bar);
            __builtin_amdgcn_fence(__ATOMIC_ACQUIRE, "agent");
            xb_add(&bar[XB_XGEN(b.x)], 1u);
            asm volatile("s_waitcnt vmcnt(0)" ::: "memory");
        } else {
            XB_SPIN(xb_ld(&bar[XB_XGEN(b.x)]) == gen, bar);
            __builtin_amdgcn_fence(__ATOMIC_ACQUIRE, "agent");
            asm volatile("s_waitcnt vmcnt(0)" ::: "memory");
        }
    }
    __syncthreads();
}

template <int PH>
__device__ __forceinline__ void run_phase(const Params& p, int bid, int nb, unsigned char* smem) {
    if (PH == 0) phase_prep(p, bid, nb);
    if (PH == 1) phase_inproj(p, bid, nb, smem);
    if (PH == 3) phase_compress(p, bid, nb, smem);
    if (PH == 4) phase_attn(p, bid, nb, smem);
    if (PH == 15) {
        if (bid < (nb >> 1)) { phase_dsa_attn(p, bid, nb, smem); phase_merge<0>(p, bid, nb, smem); }
        else { phase_merge<0>(p, bid, nb, smem); phase_dsa_attn(p, bid, nb, smem); }
    }
    if (PH == 13) phase_merge<1>(p, bid, nb, smem);
    if (PH == 6) phase_outproj(p, bid, nb, smem);
    if (PH == 7) phase_route(p, bid, nb, smem);
    if (PH == 8) phase_place(p, bid, nb, smem);
    if (PH == 9) phase_moe1(p, bid, nb, smem);
    if (PH == 10) phase_moe2(p, bid, nb, smem);
    if (PH == 11) phase_combine(p, bid, nb);
    if (PH == 12) phase_ple(p, bid, nb, smem);
}

#if SINGLE_LAUNCH
__global__ void __launch_bounds__(NT, 2) fwd_mega(Params p) {
    __shared__ __attribute__((aligned(16))) unsigned char smem[SMEM_BYTES];
    cg::grid_group grid = cg::this_grid();
    const int bid = blockIdx.x, nb = gridDim.x;
    volatile LAS unsigned* bst = (volatile LAS unsigned*)(LAS unsigned char*)(smem + SMEM_BYTES - 16);
    if (tid_opaque() < 2) bst[tid_opaque()] = 0u;
    __syncthreads();
    const XcdBarrier bar = xcd_barrier_post((unsigned*)(p.ws + WS_BAR), bst);
#define GSYNC() xcd_barrier(bar)
    run_phase<0>(p, bid, nb, smem); GSYNC();
    run_phase<1>(p, bid, nb, smem); GSYNC();
    run_phase<3>(p, bid, nb, smem); GSYNC();
    run_phase<4>(p, bid, nb, smem); grid.sync();
    run_phase<15>(p, bid, nb, smem); GSYNC();
    run_phase<13>(p, bid, nb, smem); GSYNC();
    run_phase<6>(p, bid, nb, smem); GSYNC();
    run_phase<7>(p, bid, nb, smem); GSYNC();
    run_phase<8>(p, bid, nb, smem); GSYNC();
    run_phase<9>(p, bid, nb, smem); GSYNC();
    run_phase<10>(p, bid, nb, smem); GSYNC();
    run_phase<11>(p, bid, nb, smem); GSYNC();
    run_phase<12>(p, bid, nb, smem);
#undef GSYNC
}
#else
template <int PH>
__global__ void __launch_bounds__(NT, 2) k_phase(Params p) {
    __shared__ __attribute__((aligned(16))) unsigned char smem[SMEM_BYTES];
    run_phase<PH>(p, blockIdx.x, gridDim.x, smem);
}
#endif

extern "C" void kernel_launch(void* const* d_in, const int* in_sizes, int n_in, void* d_out, int out_size, void* d_ws, size_t ws_size,
                              hipStream_t stream) {
    if (n_in != 28 || ws_size < WS_END) { fprintf(stderr, "kernel_launch: unexpected n_in %d or ws_size %zu (< %zu)\n", n_in, ws_size, (size_t)WS_END); return; }
    Params p{};
    for (int i = 0; i < 28; ++i) p.in[i] = (const float*)d_in[i];
    p.out = (float*)d_out;
    p.ws = (unsigned char*)d_ws;
#if SINGLE_LAUNCH
    static int grid_blocks = 0;
    if (!grid_blocks) {
        int dev = 0, cus = 0, per_cu = 0;
        hipGetDevice(&dev);
        hipDeviceGetAttribute(&cus, hipDeviceAttributeMultiprocessorCount, dev);
        hipOccupancyMaxActiveBlocksPerMultiprocessor(&per_cu, fwd_mega, NT, 0);
        if (per_cu > 2) per_cu = 2;
        if (per_cu < 1) per_cu = 1;
        grid_blocks = cus * per_cu;
    }
    (void)hipMemsetAsync((unsigned char*)d_ws + WS_BAR, 0, XCD_BAR_WORDS * 4, stream);
    void* args[] = {&p};
    hipError_t e = hipLaunchCooperativeKernel((void*)fwd_mega, dim3(grid_blocks), dim3(NT), args, 0, stream);
    if (e != hipSuccess) fprintf(stderr, "cooperative launch failed: %s (grid %d)\n", hipGetErrorString(e), grid_blocks);
#else
    const int G = 512;
    k_phase<0><<<G, NT, 0, stream>>>(p);
    k_phase<1><<<G, NT, 0, stream>>>(p);
    k_phase<3><<<G, NT, 0, stream>>>(p);
    k_phase<4><<<G, NT, 0, stream>>>(p);
    k_phase<15><<<G, NT, 0, stream>>>(p);
    k_phase<13><<<G, NT, 0, stream>>>(p);
    k_phase<6><<<G, NT, 0, stream>>>(p);
    k_phase<7><<<G, NT, 0, stream>>>(p);
    k_phase<8><<<G, NT, 0, stream>>>(p);
    k_phase<9><<<G, NT, 0, stream>>>(p);
    k_phase<10><<<G, NT, 0, stream>>>(p);
    k_phase<11><<<G, NT, 0, stream>>>(p);
    k_phase<12><<<G, NT, 0, stream>>>(p);
#endif
}
```

```cpp
#include <hip/hip_runtime.h>
#include <hip/hip_cooperative_groups.h>
#include <cstdio>
#include <cstdint>
namespace cg = cooperative_groups;

#ifndef SINGLE_LAUNCH
#define SINGLE_LAUNCH 1
#endif

constexpr int S = 16384;
constexpr int D = 1024;
constexpr int DIN = 5184;
constexpr int NCMP = 1023;
constexpr int NSLC = 256;
constexpr int NEXP = 32;
constexpr int DFF = 1024;
constexpr float EPS = 1e-6f;
constexpr float LOG2E = 1.4426950408889634f;
constexpr int Z_NQ = 0, Z_NKV = 512, Z_NGATE = 1280, Z_DQ = 1304, Z_DK = 1816, Z_DV = 2328, Z_IQ = 2840, Z_IK = 3096,
              Z_IW = 3128, Z_GA = 3136, Z_GB = 4160;

constexpr int NT = 256;
constexpr int SMEM_BYTES = 73728;

typedef unsigned short bf16_t;
typedef short bf16x8 __attribute__((ext_vector_type(8)));
typedef float f32x4 __attribute__((ext_vector_type(4)));
typedef short s16x4 __attribute__((ext_vector_type(4)));
typedef __attribute__((address_space(3))) s16x4* lds_s16x4_ptr;
__device__ __forceinline__ s16x4 lds_tr16(const void* p) {
    return __builtin_amdgcn_ds_read_tr16_b64_v4i16((lds_s16x4_ptr)(uintptr_t)p);
}

constexpr size_t MBy = 1ull << 20;
constexpr size_t WS_CTL = 0;
constexpr size_t WS_CNTB = 131072;
constexpr size_t WS_BAR = 65536;
constexpr size_t WS_HB = 1 * MBy;
constexpr size_t WS_OA = WS_HB + (size_t)S * D * 2;
constexpr size_t WS_OB = WS_OA + (size_t)S * 512 * 2;
constexpr size_t WS_MERGED = WS_OB + (size_t)S * 512 * 2;
constexpr size_t WS_X1 = WS_MERGED + (size_t)S * D * 2;
constexpr size_t WS_TOPI = WS_X1 + (size_t)S * D * 4;
constexpr size_t WS_TOPW = WS_TOPI + (size_t)S * 4 * 4;
constexpr size_t WS_PPOS = WS_TOPW + (size_t)S * 4 * 4;
constexpr size_t WS_ROWTOK = WS_PPOS + (size_t)S * 4 * 4;
constexpr size_t WS_PB = WS_ROWTOK + (size_t)65536 * 4;
constexpr size_t WS_PW = WS_PB + (size_t)S * 256 * 2;
constexpr size_t WS_SEL = WS_PW + (size_t)S * D * 2;
constexpr size_t WS_NSEL = WS_SEL + (size_t)S * 256 * 2;
constexpr size_t WS_REG = WS_NSEL + (size_t)S * 4;
constexpr size_t WS_SGA = WS_REG;
constexpr size_t WS_SGB = WS_SGA + (size_t)S * D * 2;
constexpr size_t WS_GT = WS_SGB + (size_t)S * D * 2;
constexpr size_t WS_IWS = WS_GT + (size_t)S * 32 * 4;
constexpr size_t WS_QNB = WS_IWS + (size_t)S * 8 * 4;
constexpr size_t WS_KSLB = WS_QNB + (size_t)S * 512 * 2;
constexpr size_t WS_VSLB = WS_KSLB + (size_t)S * 128 * 2;
constexpr size_t WS_KWNB = WS_VSLB + (size_t)S * 128 * 2;
constexpr size_t WS_VWNB = WS_KWNB + (size_t)S * 128 * 2;
constexpr size_t WS_KCB = WS_VWNB + (size_t)S * 128 * 2;
constexpr size_t WS_VCB = WS_KCB + (size_t)2 * 1024 * 64 * 2;
constexpr size_t WS_KCR = WS_VCB + (size_t)2 * 1024 * 64 * 2;
constexpr size_t WS_VCR = WS_KCR + (size_t)S * 128 * 2;
constexpr size_t WS_DQB = WS_VCR + (size_t)S * 128 * 2;
constexpr size_t WS_DKB = WS_DQB + (size_t)S * 512 * 2;
constexpr size_t WS_DVB = WS_DKB + (size_t)S * 512 * 2;
constexpr size_t WS_IQB = WS_DVB + (size_t)S * 512 * 2;
constexpr size_t WS_IKB = WS_IQB + (size_t)S * 256 * 2;
constexpr size_t WS_ENDA = WS_IKB + (size_t)S * 32 * 2;
constexpr size_t WS_ACT = WS_REG;
constexpr size_t WS_YROWS = WS_ACT + (size_t)(65536 + 128) * DFF * 2;
constexpr size_t WS_ENDB = WS_YROWS + (size_t)(65536 + 128) * D * 4;
constexpr size_t WS_END0 = WS_ENDA > WS_ENDB ? WS_ENDA : WS_ENDB;
constexpr size_t WB_IN = WS_END0;
constexpr size_t WB_A = WB_IN + (size_t)D * DIN * 2;
constexpr size_t WB_B = WB_A + (size_t)512 * D * 2;
constexpr size_t WB_OUT = WB_B + (size_t)512 * D * 2;
constexpr size_t WB_E1 = WB_OUT + (size_t)D * D * 2;
constexpr size_t WB_E2 = WB_E1 + (size_t)NEXP * D * 2 * DFF * 2;
constexpr size_t WB_PLE = WB_E2 + (size_t)NEXP * DFF * D * 2;
constexpr size_t WB_PLEG = WB_PLE + (size_t)256 * D * 2;
constexpr size_t WB_CK1 = WB_PLEG + (size_t)D * D * 2;
constexpr size_t WB_CV1 = WB_CK1 + (size_t)2048 * 64 * 2;
constexpr size_t WS_END = WB_CV1 + (size_t)2048 * 64 * 2 + 4096;

struct Params {
    const float* in[28];
    float* out;
    unsigned char* ws;
};

__device__ __forceinline__ unsigned f2bf(float f) {
    unsigned u = __builtin_bit_cast(unsigned, f);
    return (u + 0x7fffu + ((u >> 16) & 1u)) >> 16;
}
__device__ __forceinline__ unsigned pk2(float lo, float hi) { return f2bf(lo) | (f2bf(hi) << 16); }
__device__ __forceinline__ float bf2f(unsigned short b) { return __builtin_bit_cast(float, (unsigned)b << 16); }
__device__ __forceinline__ int tid_opaque() { int t = threadIdx.x; asm volatile("" : "+v"(t)); return t; }
__device__ __forceinline__ float wave_sum(float v) {
#pragma unroll
    for (int o = 1; o < 64; o <<= 1) v += __shfl_xor(v, o);
    return v;
}
__device__ __forceinline__ float wave_max(float v) {
#pragma unroll
    for (int o = 1; o < 64; o <<= 1) v = fmaxf(v, __shfl_xor(v, o));
    return v;
}
template <int CTRL> __device__ __forceinline__ int dppi(int v) { return __builtin_amdgcn_update_dpp(v, v, CTRL, 0xF, 0xF, false); }
__device__ __forceinline__ int row_sum_i(int v) {
    v += dppi<0xB1>(v); v += dppi<0x4E>(v); v += dppi<0x141>(v); v += dppi<0x140>(v);
    return v;
}
__device__ __forceinline__ int wave_sum_i_uniform(int v) {
    v = row_sum_i(v);
    return __builtin_amdgcn_readlane(v, 0) + __builtin_amdgcn_readlane(v, 16) + __builtin_amdgcn_readlane(v, 32) + __builtin_amdgcn_readlane(v, 48);
}
__device__ __forceinline__ float sigmoidf_(float x) { return 1.f / (1.f + __expf(-x)); }
__device__ __forceinline__ int bucket_of(int n) {
    if (n < 16) return n;
    int b = 16;
    b += (n >= 19) + (n >= 21) + (n >= 24) + (n >= 27) + (n >= 31) + (n >= 35) + (n >= 40) + (n >= 46) + (n >= 52) + (n >= 59) +
         (n >= 67) + (n >= 77) + (n >= 87) + (n >= 99) + (n >= 113);
    return b;
}

constexpr int LDS_STRIDE = 40;
constexpr int BTR_STRIDE = 136;
template <bool A_F32, bool GATHER, bool SPLIT = false, bool BTR = true>
__device__ __forceinline__ void gemm_tile(const void* __restrict__ Aptr, int lda, const int* __restrict__ rowidx, int m0, int mrows,
                                          const float* __restrict__ B, int ldb, int n0, int split_off, int ncols, int K,
                                          unsigned char* smem, f32x4 (&acc)[2][8]) {
    bf16_t* As = (bf16_t*)smem;
    bf16_t* Bs = As + 128 * LDS_STRIDE;
    bf16_t* AsL = Bs + 128 * LDS_STRIDE;
    bf16_t* BsL = AsL + 128 * LDS_STRIDE;
    const int tid = tid_opaque(), lane = tid & 63, wave = tid >> 6;
#pragma unroll
    for (int i = 0; i < 2; ++i)
#pragma unroll
        for (int j = 0; j < 8; ++j) acc[i][j] = (f32x4){0.f, 0.f, 0.f, 0.f};
    auto lo = [](float v) { return v - bf2f((unsigned short)f2bf(v)); };

    const int ar = tid >> 2, ach = tid & 3;
    const unsigned char* arow[2];
    bool aval[2];
#pragma unroll
    for (int i = 0; i < 2; ++i) {
        int r = ar + 64 * i;
        aval[i] = r < mrows;
        long src = 0;
        if (aval[i]) src = GATHER ? (long)rowidx[m0 + r] : (long)(m0 + r);
        arow[i] = (const unsigned char*)Aptr + (size_t)src * lda * (A_F32 ? 4 : 2) + (size_t)ach * 8 * (A_F32 ? 4 : 2);
    }
    const int nq = tid & 31, kq = tid >> 5;
    const int jn = 4 * nq;
    const bool bval = jn < ncols;
    const float* bptr = B + (size_t)(4 * kq) * ldb + n0 + jn + (jn >= 64 ? split_off : 0);

    uint4 areg[2];
    float4 af0a, af0b, af1a, af1b;
    float4 breg[4];
    auto load_g = [&](int k0) {
#pragma unroll
        for (int i = 0; i < 2; ++i) {
            if (A_F32) {
                float4 t0 = make_float4(0, 0, 0, 0), t1 = t0;
                if (aval[i]) {
                    const float4* s = (const float4*)(arow[i] + (size_t)k0 * 4);
                    t0 = s[0]; t1 = s[1];
                }
                if (i == 0) { af0a = t0; af0b = t1; } else { af1a = t0; af1b = t1; }
            } else {
                if (aval[i]) areg[i] = *(const uint4*)(arow[i] + (size_t)k0 * 2);
                else areg[i] = make_uint4(0, 0, 0, 0);
            }
        }
#pragma unroll
        for (int kk = 0; kk < 4; ++kk) {
            if (bval) breg[kk] = *(const float4*)(bptr + (size_t)(k0 + kk) * ldb);
            else breg[kk] = make_float4(0, 0, 0, 0);
        }
    };
    auto store_l = [&]() {
#pragma unroll
        for (int i = 0; i < 2; ++i) {
            uint4 v;
            const float4 t0 = (i == 0) ? af0a : af1a, t1 = (i == 0) ? af0b : af1b;
            if (A_F32) {
                v.x = pk2(t0.x, t0.y); v.y = pk2(t0.z, t0.w);
                v.z = pk2(t1.x, t1.y); v.w = pk2(t1.z, t1.w);
            } else v = areg[i];
            *(uint4*)(As + (ar + 64 * i) * LDS_STRIDE + ach * 8) = v;
            if (SPLIT && A_F32) {
                v.x = pk2(lo(t0.x), lo(t0.y)); v.y = pk2(lo(t0.z), lo(t0.w));
                v.z = pk2(lo(t1.x), lo(t1.y)); v.w = pk2(lo(t1.z), lo(t1.w));
                *(uint4*)(AsL + (ar + 64 * i) * LDS_STRIDE + ach * 8) = v;
            }
        }
        if (SPLIT) {
            uint2 v;
            v.x = pk2(lo(breg[0].x), lo(breg[1].x)); v.y = pk2(lo(breg[2].x), lo(breg[3].x));
            *(uint2*)(BsL + (jn + 0) * LDS_STRIDE + 4 * kq) = v;
            v.x = pk2(lo(breg[0].y), lo(breg[1].y)); v.y = pk2(lo(breg[2].y), lo(breg[3].y));
            *(uint2*)(BsL + (jn + 1) * LDS_STRIDE + 4 * kq) = v;
            v.x = pk2(lo(breg[0].z), lo(breg[1].z)); v.y = pk2(lo(breg[2].z), lo(breg[3].z));
            *(uint2*)(BsL + (jn + 2) * LDS_STRIDE + 4 * kq) = v;
            v.x = pk2(lo(breg[0].w), lo(breg[1].w)); v.y = pk2(lo(breg[2].w), lo(breg[3].w));
            *(uint2*)(BsL + (jn + 3) * LDS_STRIDE + 4 * kq) = v;
        }
        if (BTR && !SPLIT) {
#pragma unroll
            for (int kk = 0; kk < 4; ++kk) {
                uint2 v; v.x = pk2(breg[kk].x, breg[kk].y); v.y = pk2(breg[kk].z, breg[kk].w);
                *(uint2*)(Bs + (4 * kq + kk) * BTR_STRIDE + jn) = v;
            }
        } else {
            uint2 v;
            v.x = pk2(breg[0].x, breg[1].x); v.y = pk2(breg[2].x, breg[3].x);
            *(uint2*)(Bs + (jn + 0) * LDS_STRIDE + 4 * kq) = v;
            v.x = pk2(breg[0].y, breg[1].y); v.y = pk2(breg[2].y, breg[3].y);
            *(uint2*)(Bs + (jn + 1) * LDS_STRIDE + 4 * kq) = v;
            v.x = pk2(breg[0].z, breg[1].z); v.y = pk2(breg[2].z, breg[3].z);
            *(uint2*)(Bs + (jn + 2) * LDS_STRIDE + 4 * kq) = v;
            v.x = pk2(breg[0].w, breg[1].w); v.y = pk2(breg[2].w, breg[3].w);
            *(uint2*)(Bs + (jn + 3) * LDS_STRIDE + 4 * kq) = v;
        }
    };
    const int nk = K / 32;
    __syncthreads();
    load_g(0);
    store_l();
    __syncthreads();
    const int fr = lane & 15, fq = lane >> 4;
    for (int kt = 0; kt < nk; ++kt) {
        if (kt + 1 < nk) load_g((kt + 1) * 32);
        bf16x8 a[2];
#pragma unroll
        for (int i = 0; i < 2; ++i) a[i] = *(const bf16x8*)(As + (wave * 32 + i * 16 + fr) * LDS_STRIDE + fq * 8);
        if (!SPLIT) {
            bf16x8 b[8];
#pragma unroll
            for (int j = 0; j < 8; ++j) {
                if (BTR && !SPLIT) {
                    const bf16_t* bp = Bs + (8 * fq + (fr >> 2)) * BTR_STRIDE + 16 * j + 4 * (fr & 3);
                    const s16x4 lo4 = lds_tr16(bp), hi4 = lds_tr16(bp + 4 * BTR_STRIDE);
                    b[j] = (bf16x8){lo4[0], lo4[1], lo4[2], lo4[3], hi4[0], hi4[1], hi4[2], hi4[3]};
                } else b[j] = *(const bf16x8*)(Bs + (j * 16 + fr) * LDS_STRIDE + fq * 8);
            }
#pragma unroll
            for (int i = 0; i < 2; ++i)
#pragma unroll
                for (int j = 0; j < 8; ++j) acc[i][j] = __builtin_amdgcn_mfma_f32_16x16x32_bf16(a[i], b[j], acc[i][j], 0, 0, 0);
        } else {
            bf16x8 al[2];
#pragma unroll
            for (int i = 0; i < 2; ++i) al[i] = *(const bf16x8*)(AsL + (wave * 32 + i * 16 + fr) * LDS_STRIDE + fq * 8);
#pragma unroll
            for (int j = 0; j < 8; ++j) {
                const bf16x8 bh = *(const bf16x8*)(Bs + (j * 16 + fr) * LDS_STRIDE + fq * 8);
                const bf16x8 bl = *(const bf16x8*)(BsL + (j * 16 + fr) * LDS_STRIDE + fq * 8);
#pragma unroll
                for (int i = 0; i < 2; ++i) {
                    acc[i][j] = __builtin_amdgcn_mfma_f32_16x16x32_bf16(a[i], bh, acc[i][j], 0, 0, 0);
                    acc[i][j] = __builtin_amdgcn_mfma_f32_16x16x32_bf16(a[i], bl, acc[i][j], 0, 0, 0);
                    acc[i][j] = __builtin_amdgcn_mfma_f32_16x16x32_bf16(al[i], bh, acc[i][j], 0, 0, 0);
                }
            }
        }
        __syncthreads();
        if (kt + 1 < nk) {
            store_l();
            __syncthreads();
        }
    }
}


constexpr int ASTR = 72;
constexpr int BSTR = 136;
template <bool GATHER, bool PAIR>
__device__ __forceinline__ void gemm2(const bf16_t* __restrict__ A, int lda, const int* __restrict__ rowidx, int m0, int mrows,
                                      const bf16_t* __restrict__ B, int ldb, int n0, int ncols, int K, unsigned char* smem,
                                      f32x4 (&acc)[4][4]) {
    bf16_t* As = (bf16_t*)smem;
    bf16_t* Bs = As + 128 * ASTR;
    const int tid = tid_opaque(), lane = tid & 63, wave = tid >> 6, wm = wave >> 1, wn = wave & 1;
#pragma unroll
    for (int i = 0; i < 4; ++i)
#pragma unroll
        for (int j = 0; j < 4; ++j) acc[i][j] = (f32x4){0.f, 0.f, 0.f, 0.f};
    const int ar0 = tid >> 3, ach = tid & 7;
    const bf16_t* ap0; const bf16_t* ap1; const bf16_t* ap2; const bf16_t* ap3;
    {
        int r_[4];
#pragma unroll
        for (int i = 0; i < 4; ++i) { const int rl = 32 * i + ar0; r_[i] = rl < mrows ? rl : mrows - 1; }
        ap0 = A + (size_t)(GATHER ? (long)rowidx[m0 + r_[0]] : (long)(m0 + r_[0])) * lda + ach * 8;
        ap1 = A + (size_t)(GATHER ? (long)rowidx[m0 + r_[1]] : (long)(m0 + r_[1])) * lda + ach * 8;
        ap2 = A + (size_t)(GATHER ? (long)rowidx[m0 + r_[2]] : (long)(m0 + r_[2])) * lda + ach * 8;
        ap3 = A + (size_t)(GATHER ? (long)rowidx[m0 + r_[3]] : (long)(m0 + r_[3])) * lda + ach * 8;
    }
    const int br0 = tid >> 4, bch = tid & 15;
    const int bcol = PAIR ? ((bch >> 2) * 16 + (bch & 1) * 8 + ((bch >> 1) & 1) * 1024) : bch * 8;
    const bf16_t* bp = B + (size_t)br0 * ldb + n0 + bcol;
    bf16_t* asd = As + ar0 * ASTR + ach * 8;
    bf16_t* bsd = Bs + br0 * BSTR + bch * 8;
    uint4 a0, a1, a2, a3, b0, b1, b2, b3;
#define G2_LOAD(k0)                                                                                       \
    do {                                                                                                  \
        a0 = *(const uint4*)(ap0 + (k0)); a1 = *(const uint4*)(ap1 + (k0));                               \
        a2 = *(const uint4*)(ap2 + (k0)); a3 = *(const uint4*)(ap3 + (k0));                               \
        const bf16_t* bp_ = bp + (size_t)(k0) * ldb;                                                      \
        b0 = *(const uint4*)(bp_); b1 = *(const uint4*)(bp_ + (size_t)16 * ldb);                          \
        b2 = *(const uint4*)(bp_ + (size_t)32 * ldb); b3 = *(const uint4*)(bp_ + (size_t)48 * ldb);       \
    } while (0)
#define G2_STORE()                                                                                        \
    do {                                                                                                  \
        *(uint4*)(asd) = a0; *(uint4*)(asd + 32 * ASTR) = a1; *(uint4*)(asd + 64 * ASTR) = a2; *(uint4*)(asd + 96 * ASTR) = a3; \
        *(uint4*)(bsd) = b0; *(uint4*)(bsd + 16 * BSTR) = b1; *(uint4*)(bsd + 32 * BSTR) = b2; *(uint4*)(bsd + 48 * BSTR) = b3; \
    } while (0)
    const int nk = K / 64;
    __syncthreads();
    G2_LOAD(0);
    G2_STORE();
    __syncthreads();
    const int fr = lane & 15, fq = lane >> 4;
    const bf16_t* afp = As + (wm * 64 + fr) * ASTR + fq * 8;
    const bf16_t* bfp = Bs + (8 * fq + (fr >> 2)) * BSTR + wn * 64 + 4 * (fr & 3);
    for (int kt = 0; kt < nk; ++kt) {
        if (kt + 1 < nk) G2_LOAD((kt + 1) * 64);
#pragma unroll
        for (int kh = 0; kh < 2; ++kh) {
            bf16x8 a[4], b[4];
#pragma unroll
            for (int i = 0; i < 4; ++i) a[i] = *(const bf16x8*)(afp + i * 16 * ASTR + kh * 32);
#pragma unroll
            for (int j = 0; j < 4; ++j) {
                const bf16_t* q = bfp + kh * 32 * BSTR + j * 16;
                const s16x4 lo4 = lds_tr16(q), hi4 = lds_tr16(q + 4 * BSTR);
                b[j] = (bf16x8){lo4[0], lo4[1], lo4[2], lo4[3], hi4[0], hi4[1], hi4[2], hi4[3]};
            }
#pragma unroll
            for (int i = 0; i < 4; ++i)
#pragma unroll
                for (int j = 0; j < 4; ++j) acc[i][j] = __builtin_amdgcn_mfma_f32_16x16x32_bf16(a[i], b[j], acc[i][j], 0, 0, 0);
        }
        __syncthreads();
        if (kt + 1 < nk) {
            G2_STORE();
            __syncthreads();
        }
    }
#undef G2_LOAD
#undef G2_STORE
}
#define G2_ROW(i, r) ((g2tid >> 7) * 64 + (i) * 16 + 4 * ((g2tid & 63) >> 4) + (r))
#define G2_COL(j) (((((g2tid >> 6) & 1) * 4 + (j)) * 16) + (g2tid & 15))
__device__ __forceinline__ void store_bf16_frag(bf16_t* base, int ld, float v0, float v1, float v2, float v3, int lane, unsigned rowmask = 0xFu) {
    const bool odd = lane & 1;
    const float s0 = odd ? v0 : v2, s1 = odd ? v1 : v3;
    const float r0 = __shfl_xor(s0, 1), r1 = __shfl_xor(s1, 1);
    bf16_t* p0 = odd ? base + 2 * ld - 1 : base;
    const unsigned w0 = odd ? pk2(r0, v2) : pk2(v0, r0);
    const unsigned w1 = odd ? pk2(r1, v3) : pk2(v1, r1);
    const unsigned m = odd ? (rowmask >> 2) : rowmask;
    if (m & 1u) *(unsigned*)p0 = w0;
    if (m & 2u) *(unsigned*)(p0 + ld) = w1;
}

__device__ __forceinline__ void cvt_weights(const float* __restrict__ src, bf16_t* __restrict__ dst, size_t n, int bid, int nb) {
    const size_t n4 = n >> 2;
    const size_t stride = (size_t)nb * NT;
    size_t i = (size_t)bid * NT + tid_opaque();
    for (; i + 7 * stride < n4; i += 8 * stride) {
        float4 v[8];
#pragma unroll
        for (int k = 0; k < 8; ++k) v[k] = ((const float4*)src)[i + k * stride];
#pragma unroll
        for (int k = 0; k < 8; ++k) { uint2 o; o.x = pk2(v[k].x, v[k].y); o.y = pk2(v[k].z, v[k].w); ((uint2*)dst)[i + k * stride] = o; }
    }
    for (; i < n4; i += stride) {
        const float4 v = ((const float4*)src)[i];
        uint2 o; o.x = pk2(v.x, v.y); o.y = pk2(v.z, v.w);
        ((uint2*)dst)[i] = o;
    }
}
__device__ __forceinline__ void phase_prep(const Params& p, int bid, int nb) {
    const int lane = tid_opaque() & 63, wave = tid_opaque() >> 6;
    if (bid == 0 && tid_opaque() < 64) ((int*)(p.ws + WS_CTL))[tid_opaque()] = 0;
    {
        const float* src_ = p.in[2];
        bf16_t* dst_ = (bf16_t*)(p.ws + WB_IN);
        constexpr int G8 = DIN / 8;
        for (size_t i = (size_t)bid * NT + tid_opaque(); i < (size_t)D * G8; i += (size_t)nb * NT) {
            const int k = (int)(i / G8), nc = (int)(i % G8) * 8;
            int oc;
            if (nc < 1280) oc = nc; else if (nc < 2816) oc = nc + 24; else if (nc < 3072) oc = nc + 24; else if (nc < 5120) oc = nc + 64;
            else if (nc < 5152) oc = nc - 5120 + 3096; else if (nc < 5176) oc = nc - 5152 + 1280; else oc = nc - 5176 + 3128;
            const float4 u = *(const float4*)(src_ + (size_t)k * DIN + oc), v = *(const float4*)(src_ + (size_t)k * DIN + oc + 4);
            uint4 o; o.x = pk2(u.x, u.y); o.y = pk2(u.z, u.w); o.z = pk2(v.x, v.y); o.w = pk2(v.z, v.w);
            *(uint4*)(dst_ + (size_t)k * DIN + nc) = o;
        }
    }
    cvt_weights(p.in[14], (bf16_t*)(p.ws + WB_A), (size_t)512 * D, bid, nb);
    cvt_weights(p.in[15], (bf16_t*)(p.ws + WB_B), (size_t)512 * D, bid, nb);
    cvt_weights(p.in[16], (bf16_t*)(p.ws + WB_OUT), (size_t)D * D, bid, nb);
    cvt_weights(p.in[26], (bf16_t*)(p.ws + WB_PLE), (size_t)256 * D, bid, nb);
    cvt_weights(p.in[1], (bf16_t*)(p.ws + WS_PB), (size_t)S * 256, bid, nb);
    cvt_weights(p.in[9], (bf16_t*)(p.ws + WB_CK1), (size_t)2048 * 64, bid, nb);
    cvt_weights(p.in[12], (bf16_t*)(p.ws + WB_CV1), (size_t)2048 * 64, bid, nb);
    const float* x = p.in[0];
    const float* g = p.in[3];
    bf16_t* hb = (bf16_t*)(p.ws + WS_HB);
    for (int t = bid * 4 + wave; t < S; t += nb * 4) {
        const float4* xr = (const float4*)(x + (size_t)t * D);
        float4 v[4];
        float ss = 0.f;
#pragma unroll
        for (int j = 0; j < 4; ++j) { v[j] = xr[lane + 64 * j]; ss += v[j].x * v[j].x + v[j].y * v[j].y + v[j].z * v[j].z + v[j].w * v[j].w; }
        ss = wave_sum(ss);
        const float rstd = rsqrtf(ss * (1.f / D) + EPS);
#pragma unroll
        for (int j = 0; j < 4; ++j) {
            const float4 gg = ((const float4*)g)[lane + 64 * j];
            uint2 o;
            o.x = pk2(v[j].x * rstd * gg.x, v[j].y * rstd * gg.y);
            o.y = pk2(v[j].z * rstd * gg.z, v[j].w * rstd * gg.w);
            ((uint2*)(hb + (size_t)t * D))[lane + 64 * j] = o;
        }
    }
}

__device__ __forceinline__ void phase_inproj(const Params& p, int bid, int nb, unsigned char* smem) {
    const int g2tid = tid_opaque();
    const bf16_t* hb = (const bf16_t*)(p.ws + WS_HB);
    const int lane = tid_opaque() & 63, fr = lane & 15;
    constexpr int NTN = (DIN + 127) / 128;
    for (int w = bid; w < 128 * NTN; w += nb) {
        const int mt = w % 128, nt = w / 128;
        const int m0 = mt * 128, n0 = nt * 128;
        const int ncols = (DIN - n0) < 128 ? (DIN - n0) : 128;
        f32x4 acc[4][4];
        gemm2<false, false>(hb, D, nullptr, m0, 128, (const bf16_t*)(p.ws + WB_IN), DIN, n0, ncols, D, smem, acc);
        const int cid = __builtin_amdgcn_readfirstlane((n0 >> 6) + ((tid_opaque() >> 6) & 1));
        if (cid > 80) continue;
        int kind; bf16_t* dst; int ld; const float* gain = nullptr; float scale = 1.f;
        if (cid < 8) { kind = 0; dst = (bf16_t*)(p.ws + WS_QNB) + cid * 64; ld = 512; gain = p.in[4]; scale = 0.125f * LOG2E; }
        else if (cid < 20) {
            const int j = cid - 8, kd = j >> 1, g = j & 1;
            ld = 64; kind = (kd == 2 || kd == 4) ? 0 : 1; gain = p.in[5];
            const size_t base = kd == 0 ? WS_KCR : kd == 1 ? WS_VCR : kd == 2 ? WS_KSLB : kd == 3 ? WS_VSLB : kd == 4 ? WS_KWNB : WS_VWNB;
            dst = (bf16_t*)(p.ws + base) + (size_t)g * S * 64;
        }
        else if (cid < 28) { kind = 0; dst = (bf16_t*)(p.ws + WS_DQB) + (cid - 20) * 64; ld = 512; gain = p.in[6]; scale = 0.125f * LOG2E; }
        else if (cid < 36) { kind = 0; dst = (bf16_t*)(p.ws + WS_DKB) + (cid - 28) * 64; ld = 512; gain = p.in[7]; }
        else if (cid < 44) { kind = 1; dst = (bf16_t*)(p.ws + WS_DVB) + (cid - 36) * 64; ld = 512; }
        else if (cid < 48) { kind = 1; dst = (bf16_t*)(p.ws + WS_IQB) + (cid - 44) * 64; ld = 256; scale = 0.17677669529663687f; }
        else if (cid < 64) { kind = 2; dst = (bf16_t*)(p.ws + WS_SGA) + (cid - 48) * 64; ld = D; }
        else if (cid < 80) { kind = 2; dst = (bf16_t*)(p.ws + WS_SGB) + (cid - 64) * 64; ld = D; }
        else { kind = 3; dst = nullptr; ld = 0; }
        if (kind == 0) {
            float gv[4];
#pragma unroll
            for (int j = 0; j < 4; ++j) gv[j] = gain[j * 16 + fr] * scale;
#pragma unroll
            for (int i = 0; i < 4; ++i) {
                float rstd[4];
#pragma unroll
                for (int r = 0; r < 4; ++r) {
                    float ss = acc[i][0][r] * acc[i][0][r] + acc[i][1][r] * acc[i][1][r] + acc[i][2][r] * acc[i][2][r] + acc[i][3][r] * acc[i][3][r];
                    ss += __shfl_xor(ss, 1); ss += __shfl_xor(ss, 2); ss += __shfl_xor(ss, 4); ss += __shfl_xor(ss, 8);
                    rstd[r] = rsqrtf(ss * (1.f / 64.f) + EPS);
                }
                bf16_t* dr = dst + (size_t)(m0 + G2_ROW(i, 0)) * ld + fr;
#pragma unroll
                for (int j = 0; j < 4; ++j)
                    store_bf16_frag(dr + j * 16, ld, acc[i][j][0] * rstd[0] * gv[j], acc[i][j][1] * rstd[1] * gv[j], acc[i][j][2] * rstd[2] * gv[j],
                                    acc[i][j][3] * rstd[3] * gv[j], lane);
            }
        } else if (kind == 1 || kind == 2) {
#pragma unroll
            for (int i = 0; i < 4; ++i) {
                bf16_t* dr = dst + (size_t)(m0 + G2_ROW(i, 0)) * ld + fr;
#pragma unroll
                for (int j = 0; j < 4; ++j) {
                    float v[4];
#pragma unroll
                    for (int r = 0; r < 4; ++r) v[r] = kind == 2 ? sigmoidf_(acc[i][j][r]) : acc[i][j][r] * scale;
                    store_bf16_frag(dr + j * 16, ld, v[0], v[1], v[2], v[3], lane);
                }
            }
        } else {
            bf16_t* ikb = (bf16_t*)(p.ws + WS_IKB);
            float* gt = (float*)(p.ws + WS_GT);
            float* iws = (float*)(p.ws + WS_IWS);
#pragma unroll
            for (int i = 0; i < 4; ++i) {
                bf16_t* ir = ikb + (size_t)(m0 + G2_ROW(i, 0)) * 32 + fr;
                store_bf16_frag(ir, 32, acc[i][0][0], acc[i][0][1], acc[i][0][2], acc[i][0][3], lane);
                store_bf16_frag(ir + 16, 32, acc[i][1][0], acc[i][1][1], acc[i][1][2], acc[i][1][3], lane);
#pragma unroll
                for (int r = 0; r < 4; ++r) {
                    const size_t t = (size_t)(m0 + G2_ROW(i, r));
                    gt[t * 32 + fr] = sigmoidf_(acc[i][2][r]);
                    if (fr < 8) gt[t * 32 + 16 + fr] = sigmoidf_(acc[i][3][r]);
                    else iws[t * 8 + fr - 8] = acc[i][3][r] * 0.35355339059327373f;
                }
            }
        }
    }
}

__device__ __forceinline__ float rms64(float v) { return rsqrtf(wave_sum(v * v) * (1.f / 64.f) + EPS); }

__device__ __forceinline__ void phase_compress(const Params& p, int bid, int nb, unsigned char* smem) {
    const int g2tid = tid_opaque();
    const int tid = tid_opaque(), lane = tid & 63, wave = tid >> 6;
    float* cvec = (float*)(smem + 36864);
    float* hid = (float*)(smem + 36864 + 256);
    bf16_t* pw = (bf16_t*)(p.ws + WS_PW);
    for (int w = bid; w < 32 + 128 * 8; w += nb) {
        const bool is_c = w < 32;
        const int kind = w >> 4, g = (w >> 3) & 1;
        const int w2_ = w - 32;
        const int m0 = is_c ? (w & 7) * 128 : (w2_ % 128) * 128;
        const int n0 = is_c ? 0 : (w2_ / 128) * 128;
        const int mrows = is_c ? ((NCMP - m0) < 128 ? (NCMP - m0) : 128) : 128;
        const bf16_t* Ap = is_c ? (const bf16_t*)(p.ws + (kind ? WS_VCR : WS_KCR)) + (size_t)g * S * 64 : (const bf16_t*)(p.ws + WS_PB);
        const bf16_t* Bp = is_c ? (const bf16_t*)(p.ws + (kind ? WB_CV1 : WB_CK1)) : (const bf16_t*)(p.ws + WB_PLE);
        f32x4 acc[4][4];
        gemm2<false, false>(Ap, is_c ? 16 * 64 : 256, nullptr, m0, mrows, Bp, is_c ? 64 : D, n0, is_c ? 64 : 128, is_c ? 2048 : 256, smem, acc);
        if (!is_c) {
#pragma unroll
            for (int i = 0; i < 4; ++i) {
                bf16_t* pr = pw + (size_t)(m0 + G2_ROW(i, 0)) * D + n0 + G2_COL(0);
#pragma unroll
                for (int j = 0; j < 4; ++j) store_bf16_frag(pr + j * 16, D, acc[i][j][0], acc[i][j][1], acc[i][j][2], acc[i][j][3], lane);
            }
            continue;
        }
        const float* pe = p.in[kind ? 11 : 8];
        const float* w1 = p.in[kind ? 12 : 9];
        const float* w2 = p.in[kind ? 13 : 10];
        {
            const int e = tid & 63, part = tid >> 6;
            float s = 0.f;
            for (int k = part * 512; k < part * 512 + 512; ++k) s += pe[k] * w1[(size_t)k * 64 + e];
            __syncthreads();
            hid[tid] = s;
            __syncthreads();
            if (tid < 64) cvec[tid] = hid[tid] + hid[64 + tid] + hid[128 + tid] + hid[192 + tid];
            __syncthreads();
        }
        if ((wave & 1) == 0) {
#pragma unroll
            for (int i = 0; i < 4; ++i)
#pragma unroll
                for (int j = 0; j < 4; ++j)
#pragma unroll
                    for (int r = 0; r < 4; ++r) {
                        const int row = G2_ROW(i, r), col = j * 16 + (lane & 15);
                        const float a = acc[i][j][r] + cvec[col];
                        hid[row * 65 + col] = a * sigmoidf_(a);
                    }
        }
        __syncthreads();
        const float gkn = p.in[5][lane];
        for (int row = wave; row < mrows; row += 4) {
            float o = 0.f;
#pragma unroll 8
            for (int e = 0; e < 64; ++e) o += hid[row * 65 + e] * w2[e * 64 + lane];
            if (kind == 0) o = o * rms64(o) * gkn;
            ((bf16_t*)(p.ws + (kind ? WS_VCB : WS_KCB)))[((size_t)g * 1024 + m0 + row) * 64 + lane] = (bf16_t)f2bf(o);
        }
        __syncthreads();
    }
    if (bid == nb - 1) {
        if (tid < 128) ((bf16_t*)(p.ws + WS_KCB))[((size_t)(tid >> 6) * 1024 + 1023) * 64 + (tid & 63)] = 0;
        else ((bf16_t*)(p.ws + WS_VCB))[((size_t)((tid - 128) >> 6) * 1024 + 1023) * 64 + (tid & 63)] = 0;
    }
}

constexpr int KSTR = 72;
constexpr int NSA_KT = 0;
constexpr int NSA_VT = NSA_KT + 32 * KSTR * 2;
constexpr int NSA_WV = NSA_VT + 32 * KSTR * 2;
constexpr int NSA_IMP = NSA_WV + 4 * 2 * 32 * KSTR * 2;
constexpr int NSA_LUT = NSA_IMP + 16 * 260 * 4;
constexpr int NSA_SEL = NSA_LUT + 4 * 128 * 4;
constexpr int NSA_STP = NSA_SEL + 16 * 16 * 4;
constexpr int NSA_END = NSA_STP + 4 * 128 * 4;
static_assert(NSA_END <= SMEM_BYTES, "nsa lds");

__device__ __forceinline__ f32x4 mfma16(bf16x8 a, bf16x8 b, f32x4 c) { return __builtin_amdgcn_mfma_f32_16x16x32_bf16(a, b, c, 0, 0, 0); }
__device__ __forceinline__ bf16x8 pack_p(const f32x4& p1, const f32x4& p2) {
    const unsigned a = pk2(p1[0], p1[1]), b = pk2(p1[2], p1[3]), c = pk2(p2[0], p2[1]), d = pk2(p2[2], p2[3]);
    return __builtin_bit_cast(bf16x8, make_uint4(a, b, c, d));
}
__device__ __forceinline__ void pv_step(f32x4 (&o)[4], const bf16_t* vt, bf16x8 pb, int fq, int fr) {
    const bf16_t* base = vt + (4 * fq + (fr >> 2)) * KSTR + 4 * (fr & 3);
#pragma unroll
    for (int dt = 0; dt < 4; ++dt) {
        const s16x4 lo4 = lds_tr16(base + dt * 16), hi4 = lds_tr16(base + 16 * KSTR + dt * 16);
        const bf16x8 va = (bf16x8){lo4[0], lo4[1], lo4[2], lo4[3], hi4[0], hi4[1], hi4[2], hi4[3]};
        o[dt] = mfma16(va, pb, o[dt]);
    }
}
__device__ __forceinline__ float quad_sum(float v) {
    v += __shfl_xor(v, 1);
    v += __shfl_xor(v, 2);
    return v;
}

__device__ __forceinline__ void nsa_tile(const Params& p, int tt, int g, unsigned char* smem) {
    const int tid = tid_opaque(), lane = tid & 63, wave = tid >> 6, fr = lane & 15, fq = lane >> 4;
    bf16_t* kt = (bf16_t*)(smem + NSA_KT);
    bf16_t* vt = (bf16_t*)(smem + NSA_VT);
    bf16_t* wv = (bf16_t*)(smem + NSA_WV) + wave * 2 * 32 * KSTR;
    float* imp = (float*)(smem + NSA_IMP);
    float* lut = (float*)(smem + NSA_LUT);
    int* sel = (int*)(smem + NSA_SEL);
    const bf16_t* qnb = (const bf16_t*)(p.ws + WS_QNB);
    const bf16_t* kslb = (const bf16_t*)(p.ws + WS_KSLB) + (size_t)g * S * 64;
    const bf16_t* vslb = (const bf16_t*)(p.ws + WS_VSLB) + (size_t)g * S * 64;
    const bf16_t* kwnb = (const bf16_t*)(p.ws + WS_KWNB) + (size_t)g * S * 64;
    const bf16_t* vwnb = (const bf16_t*)(p.ws + WS_VWNB) + (size_t)g * S * 64;
    const bf16_t* kcb = (const bf16_t*)(p.ws + WS_KCB) + (size_t)g * 1024 * 64;
    const bf16_t* vcb = (const bf16_t*)(p.ws + WS_VCB) + (size_t)g * 1024 * 64;
    const float* gt = (const float*)(p.ws + WS_GT);
    const float* relb = p.in[17];
    const int t0 = tt * 16;
    const int tl = 4 * wave + (fr >> 2);
    const int tok = t0 + tl;
    const int hl = fr & 3, head = g * 4 + hl;
    __syncthreads();
    for (int i = tid; i < 512; i += NT) { const int hh = i >> 7, n = i & 127; lut[i] = relb[bucket_of(n) * 16 + g * 4 + hh] * LOG2E; }
    for (int i = tid; i < 16 * 260; i += NT) imp[i] = 0.f;
    float U2;
    {
        const float mq = wave_max(fabsf(p.in[4][lane])), mk = wave_max(fabsf(p.in[5][lane]));
        float mb = 0.f;
#pragma unroll
        for (int k = 0; k < 4; ++k) { const int e = lane + 64 * k; mb = fmaxf(mb, fabsf(relb[(e >> 3) * 16 + (e & 7)])); }
        mb = wave_max(mb);
        U2 = (8.f * mq * mk + mb) * LOG2E;
    }
    bf16x8 qf[2];
#pragma unroll
    for (int kh = 0; kh < 2; ++kh) qf[kh] = *(const bf16x8*)(qnb + (size_t)tok * 512 + head * 64 + kh * 32 + fq * 8);
    __syncthreads();
    const float* lutp = lut + hl * 128;
    const float lutfar = lutp[127];
    const f32x4 zero4 = (f32x4){0.f, 0.f, 0.f, 0.f};
    f32x4 outacc[4];
#pragma unroll
    for (int dt = 0; dt < 4; ++dt) outacc[dt] = zero4;
    const float g0 = gt[(size_t)tok * 32 + head * 3 + 0], g1 = gt[(size_t)tok * 32 + head * 3 + 1], g2 = gt[(size_t)tok * 32 + head * 3 + 2];
    const int srow = tid >> 3, sch = tid & 7;

    bf16_t* ktb = (bf16_t*)(smem + NSA_WV);
    bf16_t* vtb = ktb + 2 * 64 * KSTR;
#define NSA_QK(KT_)                                                                                         \
        f32x4 s1 = zero4, s2 = zero4;                                                                       \
        _Pragma("unroll") for (int kh = 0; kh < 2; ++kh) {                                                  \
            const bf16x8 k1 = *(const bf16x8*)((KT_) + fr * KSTR + kh * 32 + fq * 8);                       \
            const bf16x8 k2 = *(const bf16x8*)((KT_) + (16 + fr) * KSTR + kh * 32 + fq * 8);                \
            s1 = mfma16(k1, qf[kh], s1);                                                                    \
            s2 = mfma16(k2, qf[kh], s2);                                                                    \
        }
    {
        int ks0 = (t0 - 511) & ~63; ks0 = ks0 < 0 ? 0 : ks0;
        const int nsteps = (t0 + 16 - ks0 + 63) >> 6;
        f32x4 o[4];
#pragma unroll
        for (int dt = 0; dt < 4; ++dt) o[dt] = zero4;
        float lsum = 0.f;
#define WIN_ROW(r_) ((r_) < S ? (r_) : S - 1)
        uint4 kr0 = *(const uint4*)(kwnb + (size_t)WIN_ROW(ks0 + srow) * 64 + sch * 8);
        uint4 kr1 = *(const uint4*)(kwnb + (size_t)WIN_ROW(ks0 + 32 + srow) * 64 + sch * 8);
        uint4 vr0 = *(const uint4*)(vwnb + (size_t)WIN_ROW(ks0 + srow) * 64 + sch * 8);
        uint4 vr1 = *(const uint4*)(vwnb + (size_t)WIN_ROW(ks0 + 32 + srow) * 64 + sch * 8);
#pragma unroll 1
        for (int st = 0; st < nsteps; ++st) {
            const int ksb = ks0 + st * 64;
            bf16_t* kt_ = ktb + (st & 1) * 64 * KSTR;
            bf16_t* vt_ = vtb + (st & 1) * 64 * KSTR;
            *(uint4*)(kt_ + srow * KSTR + sch * 8) = kr0; *(uint4*)(kt_ + (32 + srow) * KSTR + sch * 8) = kr1;
            *(uint4*)(vt_ + srow * KSTR + sch * 8) = vr0; *(uint4*)(vt_ + (32 + srow) * KSTR + sch * 8) = vr1;
            __syncthreads();
            if (st + 1 < nsteps) {
                kr0 = *(const uint4*)(kwnb + (size_t)WIN_ROW(ksb + 64 + srow) * 64 + sch * 8);
                kr1 = *(const uint4*)(kwnb + (size_t)WIN_ROW(ksb + 96 + srow) * 64 + sch * 8);
                vr0 = *(const uint4*)(vwnb + (size_t)WIN_ROW(ksb + 64 + srow) * 64 + sch * 8);
                vr1 = *(const uint4*)(vwnb + (size_t)WIN_ROW(ksb + 96 + srow) * 64 + sch * 8);
            }
#pragma unroll
            for (int hf = 0; hf < 2; ++hf) {
                const int ks = ksb + 32 * hf;
                if (ks > t0 + 15) continue;
                NSA_QK(kt_ + hf * 32 * KSTR)
                const bool far = (t0 + 4 * wave) - (ks + 31) >= 113;
                f32x4 p1, p2;
#pragma unroll
                for (int r = 0; r < 4; ++r) {
                    const int d1 = tok - (ks + 4 * fq + r), d2 = d1 - 16;
                    const float b1 = far ? lutfar : lutp[d1 < 0 ? 0 : (d1 > 127 ? 127 : d1)];
                    const float b2 = far ? lutfar : lutp[d2 < 0 ? 0 : (d2 > 127 ? 127 : d2)];
                    p1[r] = (d1 >= 0 && d1 < 512) ? __builtin_amdgcn_exp2f(s1[r] + b1 - U2) : 0.f;
                    p2[r] = (d2 >= 0 && d2 < 512) ? __builtin_amdgcn_exp2f(s2[r] + b2 - U2) : 0.f;
                    lsum += p1[r] + p2[r];
                }
                pv_step(o, vt_ + hf * 32 * KSTR, pack_p(p1, p2), fq, fr);
            }
        }
#undef WIN_ROW
        lsum += __shfl_xor(lsum, 16);
        lsum += __shfl_xor(lsum, 32);
        const float sc = lsum > 0.f ? g2 / lsum : 0.f;
#pragma unroll
        for (int dt = 0; dt < 4; ++dt)
#pragma unroll
            for (int r = 0; r < 4; ++r) outacc[dt][r] += sc * o[dt][r];
    }
    __syncthreads();

    {
        const int tlast = t0 + 15;
        const int cmax = (tlast >= 31) ? ((tlast - 31) >> 4) + 1 : 0;
        const int nsteps = (cmax + 63) >> 6;
        float inv_l = 0.f;
#pragma unroll 1
        for (int pass = 0; pass < 2; ++pass) {
            f32x4 o[4];
#pragma unroll
            for (int dt = 0; dt < 4; ++dt) o[dt] = zero4;
            float lsum = 0.f;
            uint4 kr0 = make_uint4(0, 0, 0, 0), kr1 = kr0, vr0 = kr0, vr1 = kr0;
            if (nsteps > 0) {
                kr0 = *(const uint4*)(kcb + (size_t)srow * 64 + sch * 8); kr1 = *(const uint4*)(kcb + (size_t)(32 + srow) * 64 + sch * 8);
                vr0 = *(const uint4*)(vcb + (size_t)srow * 64 + sch * 8); vr1 = *(const uint4*)(vcb + (size_t)(32 + srow) * 64 + sch * 8);
            }
#pragma unroll 1
            for (int st = 0; st < nsteps; ++st) {
                const int csb = st * 64;
                bf16_t* kt_ = ktb + (st & 1) * 64 * KSTR;
                bf16_t* vt_ = vtb + (st & 1) * 64 * KSTR;
                *(uint4*)(kt_ + srow * KSTR + sch * 8) = kr0; *(uint4*)(kt_ + (32 + srow) * KSTR + sch * 8) = kr1;
                *(uint4*)(vt_ + srow * KSTR + sch * 8) = vr0; *(uint4*)(vt_ + (32 + srow) * KSTR + sch * 8) = vr1;
                __syncthreads();
                if (st + 1 < nsteps) {
                    kr0 = *(const uint4*)(kcb + (size_t)(csb + 64 + srow) * 64 + sch * 8); kr1 = *(const uint4*)(kcb + (size_t)(csb + 96 + srow) * 64 + sch * 8);
                    vr0 = *(const uint4*)(vcb + (size_t)(csb + 64 + srow) * 64 + sch * 8); vr1 = *(const uint4*)(vcb + (size_t)(csb + 96 + srow) * 64 + sch * 8);
                }
#pragma unroll
                for (int hf = 0; hf < 2; ++hf) {
                    const int cs = csb + 32 * hf;
                    if (cs >= cmax) continue;
                    NSA_QK(kt_ + hf * 32 * KSTR)
                    const bool far = (t0 + 4 * wave) - (16 * (cs + 31) + 31) >= 113;
                    f32x4 p1, p2;
#pragma unroll
                    for (int r = 0; r < 4; ++r) {
                        const int d1 = tok - (16 * (cs + 4 * fq + r) + 31), d2 = d1 - 256;
                        const float b1 = far ? lutfar : lutp[d1 < 0 ? 0 : (d1 > 127 ? 127 : d1)];
                        const float b2 = far ? lutfar : lutp[d2 < 0 ? 0 : (d2 > 127 ? 127 : d2)];
                        p1[r] = (d1 >= 0) ? __builtin_amdgcn_exp2f(s1[r] + b1 - U2) : 0.f;
                        p2[r] = (d2 >= 0) ? __builtin_amdgcn_exp2f(s2[r] + b2 - U2) : 0.f;
                        lsum += p1[r] + p2[r];
                    }
                    if (pass == 1) {
#pragma unroll
                        for (int r = 0; r < 4; ++r) { p1[r] *= inv_l; p2[r] *= inv_l; }
                        f32x4 h1, h2;
#pragma unroll
                        for (int r = 0; r < 4; ++r) { h1[r] = quad_sum(p1[r]); h2[r] = quad_sum(p2[r]); }
                        if (hl == 0) {
                            float* ir = imp + tl * 260 + (cs >> 2) + fq;
                            atomicAdd(ir, h1[0] + h1[1] + h1[2] + 0.5f * h1[3]);
                            atomicAdd(ir + 1, 0.5f * h1[3]);
                            atomicAdd(ir + 4, h2[0] + h2[1] + h2[2] + 0.5f * h2[3]);
                            atomicAdd(ir + 5, 0.5f * h2[3]);
                        }
                        pv_step(o, vt_ + hf * 32 * KSTR, pack_p(p1, p2), fq, fr);
                    }
                }
            }
            __syncthreads();
            if (pass == 0) {
                lsum += __shfl_xor(lsum, 16);
                lsum += __shfl_xor(lsum, 32);
                inv_l = lsum > 0.f ? 1.f / lsum : 0.f;
            } else {
#pragma unroll
                for (int dt = 0; dt < 4; ++dt)
#pragma unroll
                    for (int r = 0; r < 4; ++r) outacc[dt][r] += g0 * o[dt][r];
            }
        }
    }
#undef NSA_QK
    __syncthreads();

    {
        const int tq = lane >> 4, sub = lane & 15;
        const int tli = 4 * wave + tq, cur = (t0 + 4 * wave) >> 6;
        int* sl = sel + tli * 16;
        const int nf = 1 + (cur - 1 >= 1 ? 1 : 0) + (cur >= 1 ? 1 : 0);
        const int ncand = cur - 2 > 0 ? cur - 2 : 0;
        int need = 16 - nf; need = need < ncand ? need : ncand;
        if (sub == 0) {
            sl[0] = 0; int c_ = 1;
            if (cur - 1 >= 1) sl[c_++] = cur - 1;
            if (cur >= 1) sl[c_++] = cur;
            for (int k = c_; k < 16; ++k) sl[k] = -1;
        }
        unsigned key[16];
#pragma unroll
        for (int k = 0; k < 16; ++k) {
            const int n = sub + 16 * k;
            const bool c = (n >= 1) && (n <= cur - 2);
            key[k] = c ? __builtin_bit_cast(unsigned, imp[tli * 260 + n]) + 1u : 0u;
        }
#pragma unroll 1
        for (int rd = 0; rd < need; ++rd) {
            unsigned bk = key[0]; int bn = sub;
#pragma unroll
            for (int k = 1; k < 16; ++k) { const bool g = key[k] > bk; bk = g ? key[k] : bk; bn = g ? sub + 16 * k : bn; }
#define SEL_STEP(CTRL) { const unsigned ok = (unsigned)dppi<CTRL>((int)bk); const int on = dppi<CTRL>(bn); \
                         const bool g = (ok > bk) || (ok == bk && on < bn); bk = g ? ok : bk; bn = g ? on : bn; }
            SEL_STEP(0xB1) SEL_STEP(0x4E) SEL_STEP(0x141) SEL_STEP(0x140)
#undef SEL_STEP
#pragma unroll
            for (int k = 0; k < 16; ++k) key[k] = (sub + 16 * k == bn) ? 0u : key[k];
            if (sub == 0) sl[nf + rd] = bn;
        }
    }
    __syncthreads();

    {
        int* stp = (int*)(smem + NSA_STP) + wave * 128;
        int nst;
        {
            const int tq = lane >> 4, j = lane & 15;
            const int cur_ = (t0 + 4 * wave) >> 6;
            const int nf_ = 1 + (cur_ - 1 >= 1 ? 1 : 0) + (cur_ >= 1 ? 1 : 0);
            const bool shared = j < nf_;
            const int tk_ = shared ? t0 + 4 * wave + 3 : t0 + 4 * wave + tq;
            const int b = (shared && tq != 0) ? -1 : sel[(4 * wave + tq) * 16 + j];
            const int tqc = shared ? 4 : tq;
            const bool c1 = (b >= 0) && (b * 64 <= tk_), c2 = (b >= 0) && (b * 64 + 32 <= tk_);
            const unsigned long long m1 = __ballot(c1), m2 = __ballot(c2);
            const unsigned long long lt = (1ull << lane) - 1ull;
            const int pos = __builtin_popcountll(m1 & lt) + __builtin_popcountll(m2 & lt);
            if (c1) stp[pos] = (b * 64) | (tqc << 20);
            if (c2) stp[pos + 1] = (b * 64 + 32) | (tqc << 20);
            nst = __builtin_popcountll(m1) + __builtin_popcountll(m2);
        }
        asm volatile("" ::: "memory");
        uint2 oacc_pk[4];
#pragma unroll
        for (int dt = 0; dt < 4; ++dt) { oacc_pk[dt].x = pk2(outacc[dt][0], outacc[dt][1]); oacc_pk[dt].y = pk2(outacc[dt][2], outacc[dt][3]); }
        f32x4 o[4];
#pragma unroll
        for (int dt = 0; dt < 4; ++dt) o[dt] = zero4;
        float lsum = 0.f;
        const int r8 = lane >> 3, c8 = lane & 7;
        bf16_t* slot0 = wv;
        bf16_t* slot1 = wv + 32 * KSTR;
        bf16_t* kslot = (bf16_t*)(smem + NSA_IMP) + wave * 32 * 64;
        uint4 ka0, ka1, ka2, ka3, kb0, kb1, kb2, kb3;
        uint4 va0, va1, va2, va3;
#define SLC_STEP(i_) __builtin_amdgcn_readfirstlane(stp[(i_) < nst ? (i_) : nst - 1])
#define SLC_KLOAD(K_, w_)                                                                                           \
        { const uint4* kp_ = (const uint4*)(kslb + (size_t)(((w_) & 0xFFFFF) + r8) * 64 + c8 * 8);                      \
          K_##0 = kp_[0]; K_##1 = kp_[64]; K_##2 = kp_[128]; K_##3 = kp_[192]; }
#define SLC_VLOAD(V_, w_)                                                                                           \
        { const uint4* vs_ = (const uint4*)(vslb + (size_t)(((w_) & 0xFFFFF) + r8) * 64 + c8 * 8);                      \
          V_##0 = vs_[0]; V_##1 = vs_[64]; V_##2 = vs_[128]; V_##3 = vs_[192]; }
#define SLC_VSTORE(V_, slot_)                                                                                       \
        { bf16_t* vd_ = (slot_) + r8 * KSTR + c8 * 8;                                                               \
          *(uint4*)(vd_) = V_##0; *(uint4*)(vd_ + 8 * KSTR) = V_##1; *(uint4*)(vd_ + 16 * KSTR) = V_##2; *(uint4*)(vd_ + 24 * KSTR) = V_##3; }
#define SLC_KSTORE(K_)                                                                                              \
        { bf16_t* kd_ = kslot + r8 * 64 + ((c8 ^ r8) * 8);                                                          \
          *(uint4*)(kd_) = K_##0; *(uint4*)(kd_ + 8 * 64) = K_##1; *(uint4*)(kd_ + 16 * 64) = K_##2; *(uint4*)(kd_ + 24 * 64) = K_##3; }
#define SLC_STAGE(s_, K_, VW_, slotr_, slotw_)                                                                      \
        {                                                                                                           \
            const int wcur = SLC_STEP(s_), wk = SLC_STEP((s_) + 2);                                                 \
            SLC_KSTORE(K_)                                                            \
            SLC_VSTORE(VW_, slotw_)                                                      \
            asm volatile("" ::: "memory");                                                                          \
            SLC_VLOAD(VW_, wk)                                                                     \
            SLC_KLOAD(K_, wk)                                                                      \
            f32x4 s1 = zero4, s2 = zero4;                                                                           \
            _Pragma("unroll") for (int kh = 0; kh < 2; ++kh) {                                                      \
                const bf16x8 k1 = *(const bf16x8*)(kslot + fr * 64 + (((kh * 4 + fq) ^ (fr & 7)) * 8));             \
                const bf16x8 k2 = *(const bf16x8*)(kslot + (16 + fr) * 64 + (((kh * 4 + fq) ^ (fr & 7)) * 8));      \
                s1 = mfma16(k1, qf[kh], s1); s2 = mfma16(k2, qf[kh], s2);                                           \
            }                                                                                                       \
            const int ks = wcur & 0xFFFFF, tq = wcur >> 20;                                                         \
            const bool mine = (tq == 4) || ((fr >> 2) == tq);                                                       \
            const bool far = (t0 + 4 * wave + (tq == 4 ? 0 : tq)) - (ks + 31) >= 113;                               \
            f32x4 p1, p2;                                                                                           \
            _Pragma("unroll") for (int r = 0; r < 4; ++r) {                                                         \
                const int d1 = tok - (ks + 4 * fq + r), d2 = d1 - 16;                                               \
                const float b1 = far ? lutfar : lutp[d1 < 0 ? 0 : (d1 > 127 ? 127 : d1)];                           \
                const float b2 = far ? lutfar : lutp[d2 < 0 ? 0 : (d2 > 127 ? 127 : d2)];                           \
                p1[r] = (mine && d1 >= 0) ? __builtin_amdgcn_exp2f(s1[r] + b1 - U2) : 0.f;                          \
                p2[r] = (mine && d2 >= 0) ? __builtin_amdgcn_exp2f(s2[r] + b2 - U2) : 0.f;                          \
                lsum += p1[r] + p2[r];                                                                              \
            }                                                                                                       \
            asm volatile("" ::: "memory");                                                                          \
            pv_step(o, slotr_, pack_p(p1, p2), fq, fr);                                                             \
            asm volatile("" ::: "memory");                                                                          \
        }
        {
            const int w0 = SLC_STEP(0), w1 = SLC_STEP(1);
            SLC_VLOAD(va, w0)
            SLC_KLOAD(ka, w0)
            SLC_KLOAD(kb, w1)
            SLC_VSTORE(va, slot0)
            SLC_VLOAD(va, w1)
        }
#pragma unroll 1
        for (int s = 0; s < nst; s += 2) {
            SLC_STAGE(s, ka, va, slot0, slot1)
            if (s + 1 < nst) SLC_STAGE(s + 1, kb, va, slot1, slot0)
        }
#undef SLC_STEP
#undef SLC_KLOAD
#undef SLC_VLOAD
#undef SLC_VSTORE
#undef SLC_KSTORE
#undef SLC_STAGE
        lsum += __shfl_xor(lsum, 16);
        lsum += __shfl_xor(lsum, 32);
        const float sc = lsum > 0.f ? g1 / lsum : 0.f;
#pragma unroll
        for (int dt = 0; dt < 4; ++dt) {
            outacc[dt][0] = __builtin_bit_cast(float, oacc_pk[dt].x << 16) + sc * o[dt][0];
            outacc[dt][1] = __builtin_bit_cast(float, oacc_pk[dt].x & 0xffff0000u) + sc * o[dt][1];
            outacc[dt][2] = __builtin_bit_cast(float, oacc_pk[dt].y << 16) + sc * o[dt][2];
            outacc[dt][3] = __builtin_bit_cast(float, oacc_pk[dt].y & 0xffff0000u) + sc * o[dt][3];
        }
    }
    bf16_t* orow = (bf16_t*)(p.ws + WS_OA) + (size_t)tok * 512 + head * 64 + 4 * fq;
#pragma unroll
    for (int dt = 0; dt < 4; ++dt) {
        uint2 v; v.x = pk2(outacc[dt][0], outacc[dt][1]); v.y = pk2(outacc[dt][2], outacc[dt][3]);
        *(uint2*)(orow + dt * 16) = v;
    }
}

typedef float f32x16 __attribute__((ext_vector_type(16)));
constexpr int DSA_CK = 0;
constexpr int DSA_CI = DSA_CK + 16 * 512 * 4;
constexpr int DSA_LUT = DSA_CI + 16 * 512 * 2;
constexpr int DSA_END = DSA_LUT + 8 * 128 * 4;
static_assert(DSA_END <= SMEM_BYTES, "dsa lds");

__device__ __forceinline__ unsigned mono_key(float s) {
    const unsigned u = __builtin_bit_cast(unsigned, s + 0.0f);
    return (u & 0x80000000u) ? ~u : (u | 0x80000000u);
}
__device__ __forceinline__ unsigned dsa_compact(unsigned* ck, unsigned short* ci, int n, int lane) {
    unsigned kk[8]; unsigned ii[8];
#pragma unroll
    for (int k = 0; k < 8; ++k) { const int e = lane + 64 * k; kk[k] = e < n ? ck[e] : 0u; ii[k] = e < n ? (unsigned)ci[e] : 0xFFFFu; }
    unsigned T = 0;
#pragma unroll 1
    for (int b = 31; b >= 0; --b) {
        const unsigned cand = T | (1u << b);
        int c = 0;
#pragma unroll
        for (int k = 0; k < 8; ++k) c += (kk[k] >= cand) ? 1 : 0;
        if (wave_sum_i_uniform(c) >= 256) T = cand;
    }
    int cgt = 0, ceq = 0;
#pragma unroll
    for (int k = 0; k < 8; ++k) { cgt += __builtin_popcountll(__ballot(kk[k] > T)); ceq += __builtin_popcountll(__ballot(kk[k] == T)); }
    const int need = 256 - cgt;
    unsigned X = 0xFFFFu;
    if (ceq > need) {
        X = 0;
#pragma unroll 1
        for (int b = 15; b >= 0; --b) {
            const unsigned cand = X | (1u << b);
            int c = 0;
#pragma unroll
            for (int k = 0; k < 8; ++k) c += __builtin_popcountll(__ballot(kk[k] == T && ii[k] < cand));
            if (c < need) X = cand;
        }
    }
    int base = 0;
    const unsigned long long lt = (1ull << lane) - 1ull;
#pragma unroll
    for (int k = 0; k < 8; ++k) {
        const bool keep = (kk[k] > T) || (kk[k] == T && ii[k] <= X);
        const unsigned long long m = __ballot(keep);
        if (keep) { const int pos = base + __builtin_popcountll(m & lt); ck[pos] = kk[k]; ci[pos] = (unsigned short)ii[k]; }
        base += __builtin_popcountll(m);
    }
    return T;
}

__device__ __forceinline__ void dsa_tile(const Params& p, int tt, unsigned char* smem) {
    const int tid = tid_opaque(), lane = tid & 63, wave = tid >> 6, col = lane & 31, hi = lane >> 5;
    unsigned* ckb = (unsigned*)(smem + DSA_CK);
    unsigned short* cib = (unsigned short*)(smem + DSA_CI);
    const bf16_t* iqb = (const bf16_t*)(p.ws + WS_IQB);
    const bf16_t* ikb = (const bf16_t*)(p.ws + WS_IKB);
    const float* iws = (const float*)(p.ws + WS_IWS);
    const int t0 = tt * 16;
    __syncthreads();
    const int tw = t0 + 4 * wave;
    bf16x8 af[2];
    {
        const int rho = col;
        const int tl_ = 2 * ((rho >> 2) & 1) + (rho >> 4), hd = 4 * ((rho >> 3) & 1) + (rho & 3);
#pragma unroll
        for (int ks = 0; ks < 2; ++ks) af[ks] = *(const bf16x8*)(iqb + (size_t)(tw + tl_) * 256 + hd * 32 + ks * 16 + hi * 8);
    }
    const int tokA = tw + 2 * hi, tokB = tokA + 1;
    float wA[8], wB[8];
#pragma unroll
    for (int h = 0; h < 8; ++h) { wA[h] = iws[(size_t)tokA * 8 + h]; wB[h] = iws[(size_t)tokB * 8 + h]; }
    unsigned* ckA = ckb + (4 * wave + 2 * hi) * 512;
    unsigned* ckB = ckA + 512;
    unsigned short* ciA = cib + (4 * wave + 2 * hi) * 512;
    unsigned short* ciB = ciA + 512;
    int cntA = 0, cntB = 0;
    unsigned LA = 0, LB = 0;
    const unsigned ltm = (1u << col) - 1u;
    const int nchunk = (tw + 4 + 31) >> 5;
    const f32x16 zero16 = {0.f, 0.f, 0.f, 0.f, 0.f, 0.f, 0.f, 0.f, 0.f, 0.f, 0.f, 0.f, 0.f, 0.f, 0.f, 0.f};
    bf16x8 nx0[4], nx1[4];
    const bf16_t* ikl = ikb + (size_t)col * 32 + hi * 8;
#pragma unroll
    for (int j = 0; j < 4; ++j) {
        const int cj = j < nchunk ? j : nchunk - 1;
        nx0[j] = *(const bf16x8*)(ikl + (size_t)cj * 1024); nx1[j] = *(const bf16x8*)(ikl + (size_t)cj * 1024 + 16);
    }
#pragma unroll 1
    for (int ch4 = 0; ch4 < nchunk; ch4 += 4) {
#pragma unroll
        for (int j = 0; j < 4; ++j) {
            const int ch = ch4 + j;
            const bf16x8 cu0 = nx0[j], cu1 = nx1[j];
            {
                int cj = ch + 4; cj = cj < nchunk ? cj : nchunk - 1;
                nx0[j] = *(const bf16x8*)(ikl + (size_t)cj * 1024); nx1[j] = *(const bf16x8*)(ikl + (size_t)cj * 1024 + 16);
            }
            if (ch < nchunk) {
                const int kidx = ch * 32 + col;
                f32x16 c = __builtin_amdgcn_mfma_f32_32x32x16_bf16(af[0], cu0, zero16, 0, 0, 0);
                c = __builtin_amdgcn_mfma_f32_32x32x16_bf16(af[1], cu1, c, 0, 0, 0);
                float sA = 0.f, sB = 0.f;
#pragma unroll
                for (int h = 0; h < 8; ++h) { sA += wA[h] * fmaxf(c[h], 0.f); sB += wB[h] * fmaxf(c[8 + h], 0.f); }
                const unsigned keyA = mono_key(sA), keyB = mono_key(sB);
                const bool pA = (kidx <= tokA) && (keyA > LA), pB = (kidx <= tokB) && (keyB > LB);
                const unsigned long long mA = __ballot(pA), mB = __ballot(pB);
                const unsigned hA = hi ? (unsigned)(mA >> 32) : (unsigned)mA, hB = hi ? (unsigned)(mB >> 32) : (unsigned)mB;
                if (pA) { const int pos = cntA + __builtin_popcount(hA & ltm); ckA[pos] = keyA; ciA[pos] = (unsigned short)kidx; }
                if (pB) { const int pos = cntB + __builtin_popcount(hB & ltm); ckB[pos] = keyB; ciB[pos] = (unsigned short)kidx; }
                cntA += __builtin_popcount(hA); cntB += __builtin_popcount(hB);
            }
            if (!(j & 1)) continue;
        if (__any((cntA > 448) || (cntB > 448))) {
#pragma unroll
            for (int tq = 0; tq < 4; ++tq) {
                const int cn = __shfl((tq & 1) ? cntB : cntA, (tq >> 1) * 32);
                if (cn > 448) {
                    const unsigned T = dsa_compact(ckb + (4 * wave + tq) * 512, cib + (4 * wave + tq) * 512, cn, lane);
                    if (hi == (tq >> 1)) { if (tq & 1) { cntB = 256; LB = T; } else { cntA = 256; LA = T; } }
                }
            }
        }
    }
    }
#pragma unroll
    for (int tq = 0; tq < 4; ++tq) {
        const int cn = __shfl((tq & 1) ? cntB : cntA, (tq >> 1) * 32);
        if (cn > 256) {
            (void)dsa_compact(ckb + (4 * wave + tq) * 512, cib + (4 * wave + tq) * 512, cn, lane);
            if (hi == (tq >> 1)) { if (tq & 1) cntB = 256; else cntA = 256; }
        }
    }
    unsigned short* selg = (unsigned short*)(p.ws + WS_SEL);
    int* nselg = (int*)(p.ws + WS_NSEL);
#pragma unroll
    for (int tq = 0; tq < 4; ++tq) {
        int nsel = __shfl((tq & 1) ? cntB : cntA, (tq >> 1) * 32);
        nsel = nsel > 256 ? 256 : nsel;
        const unsigned short* sl = cib + (4 * wave + tq) * 512;
#pragma unroll
        for (int k = 0; k < 4; ++k) { const int e = lane + 64 * k; selg[(size_t)(tw + tq) * 256 + e] = e < nsel ? sl[e] : (unsigned short)0; }
        if (lane == 0) nselg[tw + tq] = nsel;
    }
}

__device__ __forceinline__ void phase_dsa_attn(const Params& p, int bid, int nb, unsigned char* smem) {
    const int tid = tid_opaque(), lane = tid & 63, wave = tid >> 6, slot = lane >> 3, chunk = lane & 7;
    float* lut = (float*)smem;
    const bf16_t* dqb = (const bf16_t*)(p.ws + WS_DQB);
    const bf16_t* dkb = (const bf16_t*)(p.ws + WS_DKB);
    const bf16_t* dvb = (const bf16_t*)(p.ws + WS_DVB);
    const unsigned short* selg = (const unsigned short*)(p.ws + WS_SEL);
    const int* nselg = (const int*)(p.ws + WS_NSEL);
    const float* relb = p.in[17];
    const int h = bid & 7, bh = bid >> 3, nbh = nb >> 3;
    __syncthreads();
    if (tid < 128) lut[tid] = relb[bucket_of(tid) * 16 + 8 + h] * LOG2E;
    float U2;
    {
        const float mq = wave_max(fabsf(p.in[6][lane])), mk = wave_max(fabsf(p.in[7][lane]));
        float mb = 0.f;
#pragma unroll
        for (int k = 0; k < 4; ++k) { const int e = lane + 64 * k; mb = fmaxf(mb, fabsf(relb[(e >> 3) * 16 + 8 + (e & 7)])); }
        mb = wave_max(mb);
        U2 = (8.f * mq * mk + mb) * LOG2E;
    }
    __syncthreads();
    const bf16_t* kbase = dkb + h * 64 + chunk * 8;
    const bf16_t* vbase = dvb + h * 64 + chunk * 8;
#pragma unroll 1
    for (int t = bh * 4 + wave; t < S; t += nbh * 4) {
        const int nsel = nselg[t];
        const uint2* ip = (const uint2*)(selg + (size_t)t * 256 + slot * 32);
        float q[8];
        {
            const uint4 qv = *(const uint4*)(dqb + (size_t)t * 512 + h * 64 + chunk * 8);
            q[0] = __builtin_bit_cast(float, qv.x << 16); q[1] = __builtin_bit_cast(float, qv.x & 0xffff0000u);
            q[2] = __builtin_bit_cast(float, qv.y << 16); q[3] = __builtin_bit_cast(float, qv.y & 0xffff0000u);
            q[4] = __builtin_bit_cast(float, qv.z << 16); q[5] = __builtin_bit_cast(float, qv.z & 0xffff0000u);
            q[6] = __builtin_bit_cast(float, qv.w << 16); q[7] = __builtin_bit_cast(float, qv.w & 0xffff0000u);
        }
        float o[8];
#pragma unroll
        for (int j = 0; j < 8; ++j) o[j] = 0.f;
        float lsum = 0.f;
        int sA_[4], sB_[4];
        uint4 kA_[4], vA_[4], kB_[4], vB_[4];
        uint2 idn = ip[0];
#define DSA_LOADG(S_, K_, V_, I_)                                                        \
        S_[0] = (int)((I_).x & 0xffffu); S_[1] = (int)((I_).x >> 16); S_[2] = (int)((I_).y & 0xffffu); S_[3] = (int)((I_).y >> 16); \
        _Pragma("unroll") for (int j = 0; j < 4; ++j) {                                 \
            K_[j] = *(const uint4*)(kbase + (size_t)S_[j] * 512);                        \
            V_[j] = *(const uint4*)(vbase + (size_t)S_[j] * 512);                        \
        }
#define DSA_COMPG(S_, K_, V_, gi)                                                        \
        _Pragma("unroll") for (int j = 0; j < 4; ++j) {                                 \
            const uint4 kv = K_[j], vv = V_[j];                                          \
            float d = q[0] * __builtin_bit_cast(float, kv.x << 16) + q[1] * __builtin_bit_cast(float, kv.x & 0xffff0000u) \
                    + q[2] * __builtin_bit_cast(float, kv.y << 16) + q[3] * __builtin_bit_cast(float, kv.y & 0xffff0000u) \
                    + q[4] * __builtin_bit_cast(float, kv.z << 16) + q[5] * __builtin_bit_cast(float, kv.z & 0xffff0000u) \
                    + q[6] * __builtin_bit_cast(float, kv.w << 16) + q[7] * __builtin_bit_cast(float, kv.w & 0xffff0000u); \
            d += __shfl_xor(d, 1); d += __shfl_xor(d, 2); d += __shfl_xor(d, 4);       \
            int dist = t - S_[j]; dist = dist > 127 ? 127 : (dist < 0 ? 0 : dist);       \
            float pr = __builtin_amdgcn_exp2f(d + lut[dist] - U2);                       \
            pr = (slot * 32 + (gi) * 4 + j < nsel) ? pr : 0.f;                           \
            lsum += pr;                                                                  \
            o[0] += pr * __builtin_bit_cast(float, vv.x << 16); o[1] += pr * __builtin_bit_cast(float, vv.x & 0xffff0000u); \
            o[2] += pr * __builtin_bit_cast(float, vv.y << 16); o[3] += pr * __builtin_bit_cast(float, vv.y & 0xffff0000u); \
            o[4] += pr * __builtin_bit_cast(float, vv.z << 16); o[5] += pr * __builtin_bit_cast(float, vv.z & 0xffff0000u); \
            o[6] += pr * __builtin_bit_cast(float, vv.w << 16); o[7] += pr * __builtin_bit_cast(float, vv.w & 0xffff0000u); \
        }
        DSA_LOADG(sA_, kA_, vA_, idn)
        idn = ip[1];
#pragma unroll 1
        for (int gi = 0; gi < 8; gi += 2) {
            DSA_LOADG(sB_, kB_, vB_, idn)
            idn = ip[gi + 2 < 8 ? gi + 2 : 7];
            DSA_COMPG(sA_, kA_, vA_, gi)
            DSA_LOADG(sA_, kA_, vA_, idn)
            idn = ip[gi + 3 < 8 ? gi + 3 : 7];
            DSA_COMPG(sB_, kB_, vB_, gi + 1)
        }
#undef DSA_LOADG
#undef DSA_COMPG
#pragma unroll
        for (int j = 0; j < 8; ++j) { o[j] += __shfl_xor(o[j], 8); o[j] += __shfl_xor(o[j], 16); o[j] += __shfl_xor(o[j], 32); }
        lsum += __shfl_xor(lsum, 8); lsum += __shfl_xor(lsum, 16); lsum += __shfl_xor(lsum, 32);
        if (slot == 0) {
            const float inv = lsum > 0.f ? 1.f / lsum : 0.f;
            uint4 ov;
            ov.x = pk2(o[0] * inv, o[1] * inv); ov.y = pk2(o[2] * inv, o[3] * inv); ov.z = pk2(o[4] * inv, o[5] * inv); ov.w = pk2(o[6] * inv, o[7] * inv);
            *(uint4*)((bf16_t*)(p.ws + WS_OB) + (size_t)t * 512 + h * 64 + chunk * 8) = ov;
        }
    }
}

__device__ __forceinline__ void convert_late_weights(const Params& p, int bid, int nb) {
    cvt_weights(p.in[21], (bf16_t*)(p.ws + WB_E1), (size_t)NEXP * D * 2 * DFF, bid, nb);
    cvt_weights(p.in[23], (bf16_t*)(p.ws + WB_E2), (size_t)NEXP * DFF * D, bid, nb);
    cvt_weights(p.in[27], (bf16_t*)(p.ws + WB_PLEG), (size_t)D * D, bid, nb);
}
constexpr int Q_NCONV = 1024;
constexpr size_t WS_QHEAD = WS_BAR + 16384;
__device__ __forceinline__ void phase_attn(const Params& p, int bid, int nb, unsigned char* smem) {
    volatile int* slot = (volatile int*)(smem + 73600);
    int* heads = (int*)(p.ws + WS_QHEAD);
    const int tid = tid_opaque();
    const int g = bid & 1;
    bool done_d = false, done_n = false, done_c = false;
    int step = (bid < (nb >> 1)) ? 0 : 2;
#pragma unroll 1
    while (!(done_d && done_n && done_c)) {
        const int ty = step & 3; ++step;
        const bool skip = (ty == 0) ? done_d : (ty == 3 ? done_c : done_n);
        if (skip) continue;
        __syncthreads();
        if (tid == 0) {
            int* h = heads + (ty == 0 ? 0 : (ty == 3 ? 48 : 16 + 16 * g));
            slot[0] = __hip_atomic_fetch_add(h, 1, __ATOMIC_RELAXED, __HIP_MEMORY_SCOPE_AGENT);
        }
        __syncthreads();
        const int idx = slot[0];
        if (ty == 0) {
            if (idx >= 1024) { done_d = true; continue; }
            dsa_tile(p, 1023 - idx, smem);
        } else if (ty == 3) {
            if (idx >= Q_NCONV) { done_c = true; continue; }
            convert_late_weights(p, idx, Q_NCONV);
        } else {
            if (idx >= 1024) { done_n = true; continue; }
            nsa_tile(p, 1023 - idx, g, smem);
        }
    }
}

template <int PASS>
__device__ __forceinline__ void phase_merge(const Params& p, int bid, int nb, unsigned char* smem) {
    const int g2tid = tid_opaque();
    const bf16_t* sg = (const bf16_t*)(p.ws + (PASS ? WS_SGB : WS_SGA));
    bf16_t* merged = (bf16_t*)(p.ws + WS_MERGED);
    float* tmp = (float*)(p.ws + WS_X1);
    const bf16_t* A = (const bf16_t*)(p.ws + (PASS ? WS_OB : WS_OA));
    const bf16_t* Bw = (const bf16_t*)(p.ws + (PASS ? WB_B : WB_A));
    for (int w = bid; w < 128 * 8; w += nb) {
        const int mt = w % 128, nt = w / 128;
        const int m0 = mt * 128, n0 = nt * 128;
        f32x4 acc[4][4];
        gemm2<false, false>(A, 512, nullptr, m0, 128, Bw, D, n0, 128, 512, smem, acc);
#pragma unroll
        for (int i = 0; i < 4; ++i) {
            float vv[4][4];
#pragma unroll
            for (int r = 0; r < 4; ++r) {
                const int row = m0 + G2_ROW(i, r);
                const bf16_t* zr = sg + (size_t)row * D + n0 + G2_COL(0);
                float* tr = tmp + (size_t)row * D + n0 + G2_COL(0);
#pragma unroll
                for (int j = 0; j < 4; ++j) {
                    const float v = bf2f(zr[j * 16]) * acc[i][j][r];
                    if (PASS == 0) tr[j * 16] = v;
                    else vv[j][r] = tr[j * 16] + v;
                }
            }
            if (PASS == 1) {
                bf16_t* mr = merged + (size_t)(m0 + G2_ROW(i, 0)) * D + n0 + G2_COL(0);
#pragma unroll
                for (int j = 0; j < 4; ++j) store_bf16_frag(mr + j * 16, D, vv[j][0], vv[j][1], vv[j][2], vv[j][3], g2tid & 63);
            }
        }
    }
}

__device__ __forceinline__ void phase_outproj(const Params& p, int bid, int nb, unsigned char* smem) {
    const int g2tid = tid_opaque();
    const bf16_t* merged = (const bf16_t*)(p.ws + WS_MERGED);
    const float* x = p.in[0];
    float* x1 = (float*)(p.ws + WS_X1);
    for (int w = bid; w < 128 * 8; w += nb) {
        const int mt = w % 128, nt = w / 128;
        const int m0 = mt * 128, n0 = nt * 128;
        f32x4 acc[4][4];
        gemm2<false, false>(merged, D, nullptr, m0, 128, (const bf16_t*)(p.ws + WB_OUT), D, n0, 128, D, smem, acc);
#pragma unroll
        for (int i = 0; i < 4; ++i)
#pragma unroll
            for (int r = 0; r < 4; ++r) {
                const size_t ro = (size_t)(m0 + G2_ROW(i, r)) * D + n0;
#pragma unroll
                for (int j = 0; j < 4; ++j) { const int c = G2_COL(j); x1[ro + c] = x[ro + c] + acc[i][j][r]; }
            }
    }
}

__device__ __forceinline__ void phase_route(const Params& p, int bid, int nb, unsigned char* smem) {
    const int lane = tid_opaque() & 63, wave = tid_opaque() >> 6;
    const float* x1 = (const float*)(p.ws + WS_X1);
    const float* g = p.in[18];
    const float* wr = p.in[19];
    const float* br = p.in[20];
    bf16_t* hb = (bf16_t*)(p.ws + WS_HB);
    int* topi = (int*)(p.ws + WS_TOPI);
    float* topw = (float*)(p.ws + WS_TOPW);
    float* hl = (float*)smem + wave * 1056;
    int* cntl = (int*)(smem + 4 * 1056 * 4);
    const int ksub = lane >> 3, e4 = lane & 7;
    __syncthreads();
    if (tid_opaque() < 32) cntl[tid_opaque()] = 0;
    __syncthreads();
    for (int t = bid * 4 + wave; t < S; t += nb * 4) {
        const float4* xr = (const float4*)(x1 + (size_t)t * D);
        float4 v[4];
        float ss = 0.f;
#pragma unroll
        for (int j = 0; j < 4; ++j) { v[j] = xr[lane + 64 * j]; ss += v[j].x * v[j].x + v[j].y * v[j].y + v[j].z * v[j].z + v[j].w * v[j].w; }
        ss = wave_sum(ss);
        const float rstd = rsqrtf(ss * (1.f / D) + EPS);
#pragma unroll
        for (int j = 0; j < 4; ++j) {
            const float4 gg = ((const float4*)g)[lane + 64 * j];
            const float4 h4 = make_float4(v[j].x * rstd * gg.x, v[j].y * rstd * gg.y, v[j].z * rstd * gg.z, v[j].w * rstd * gg.w);
            uint2 o; o.x = pk2(h4.x, h4.y); o.y = pk2(h4.z, h4.w);
            ((uint2*)(hb + (size_t)t * D))[lane + 64 * j] = o;
            ((float4*)hl)[lane + 64 * j] = h4;
        }
        asm volatile("" ::: "memory");
        float4 acc = make_float4(0.f, 0.f, 0.f, 0.f);
        const float4* wp = (const float4*)(wr + (size_t)ksub * 32) + e4;
#pragma unroll 8
        for (int i = 0; i < 128; ++i) {
            const float hk = hl[8 * i + ksub];
            const float4 w4 = wp[(size_t)i * 64];
            acc.x += hk * w4.x; acc.y += hk * w4.y; acc.z += hk * w4.z; acc.w += hk * w4.w;
        }
#pragma unroll
        for (int o_ = 8; o_ < 64; o_ <<= 1) { acc.x += __shfl_xor(acc.x, o_); acc.y += __shfl_xor(acc.y, o_); acc.z += __shfl_xor(acc.z, o_); acc.w += __shfl_xor(acc.w, o_); }
        if (ksub == 0) {
            const float4 b4 = ((const float4*)br)[e4];
            ((float4*)(hl + 1024))[e4] = make_float4(acc.x + b4.x, acc.y + b4.y, acc.z + b4.z, acc.w + b4.w);
        }
        asm volatile("" ::: "memory");
        float lg[32];
#pragma unroll
        for (int e = 0; e < 8; ++e) { const float4 l4 = ((const float4*)(hl + 1024))[e]; lg[4 * e] = l4.x; lg[4 * e + 1] = l4.y; lg[4 * e + 2] = l4.z; lg[4 * e + 3] = l4.w; }
        asm volatile("" ::: "memory");
        int idx[4]; float val[4];
        unsigned used = 0;
#pragma unroll
        for (int k = 0; k < 4; ++k) {
            float best = -__builtin_inff(); int bi = 0;
#pragma unroll
            for (int e = 0; e < 32; ++e) { const bool ok = !((used >> e) & 1u) && (lg[e] > best); best = ok ? lg[e] : best; bi = ok ? e : bi; }
            idx[k] = bi; val[k] = best; used |= 1u << bi;
        }
        const float e0 = 1.f, e1 = __expf(val[1] - val[0]), e2 = __expf(val[2] - val[0]), e3 = __expf(val[3] - val[0]);
        const float inv = 1.f / (e0 + e1 + e2 + e3);
        if (lane == 0) {
            topi[t * 4 + 0] = idx[0]; topi[t * 4 + 1] = idx[1]; topi[t * 4 + 2] = idx[2]; topi[t * 4 + 3] = idx[3];
            topw[t * 4 + 0] = e0 * inv; topw[t * 4 + 1] = e1 * inv; topw[t * 4 + 2] = e2 * inv; topw[t * 4 + 3] = e3 * inv;
            atomicAdd(&cntl[idx[0]], 1); atomicAdd(&cntl[idx[1]], 1); atomicAdd(&cntl[idx[2]], 1); atomicAdd(&cntl[idx[3]], 1);
        }
    }
    __syncthreads();
    if (tid_opaque() < 32) ((int*)(p.ws + WS_CNTB))[bid * 32 + tid_opaque()] = cntl[tid_opaque()];
}

__device__ __forceinline__ void phase_place(const Params& p, int bid, int nb, unsigned char* smem) {
    const int tid = tid_opaque(), lane = tid & 63, wave = tid >> 6;
    int* part_tot = (int*)smem;
    int* part_bef = part_tot + 256;
    int* base = part_bef + 256;
    int* curl = base + 32;
    const int* cntb = (const int*)(p.ws + WS_CNTB);
    int* cnt = (int*)(p.ws + WS_CTL);
    const int* topi = (const int*)(p.ws + WS_TOPI);
    int* ppos = (int*)(p.ws + WS_PPOS);
    int* rowtok = (int*)(p.ws + WS_ROWTOK);
    __syncthreads();
    {
        const int e = tid & 31, part = tid >> 5;
        int tot = 0, bef = 0;
        for (int b = part; b < nb; b += 8) { const int c = cntb[b * 32 + e]; tot += c; bef += (b < bid) ? c : 0; }
        part_tot[part * 32 + e] = tot; part_bef[part * 32 + e] = bef;
    }
    __syncthreads();
    if (tid < 32) {
        int tot = 0, bef = 0;
#pragma unroll
        for (int k = 0; k < 8; ++k) { tot += part_tot[k * 32 + tid]; bef += part_bef[k * 32 + tid]; }
        part_tot[tid] = tot; part_bef[tid] = bef;
        if (bid == 0) cnt[tid] = tot;
    }
    __syncthreads();
    if (tid == 0) { int a = 0; for (int e = 0; e < NEXP; ++e) { base[e] = a + part_bef[e]; a += part_tot[e]; curl[e] = 0; } }
    __syncthreads();
    for (int t = bid * 4 + wave; t < S; t += nb * 4) {
        if (lane < 4) {
            const int i = t * 4 + lane;
            const int e = topi[i];
            const int pos = base[e] + atomicAdd(&curl[e], 1);
            ppos[i] = pos;
            rowtok[pos] = t;
        }
    }
}

__device__ __forceinline__ void moe_tile_map(const int* cnt, int* sm, int& total_mt) {
    __syncthreads();
    if (tid_opaque() == 0) {
        int a = 0, b = 0;
        for (int e = 0; e < NEXP; ++e) { sm[e] = a; sm[33 + e] = b; a += (cnt[e] + 127) >> 7; b += cnt[e]; }
        sm[32] = a; sm[65] = b;
    }
    __syncthreads();
    total_mt = sm[32];
}
__device__ __forceinline__ void phase_moe1(const Params& p, int bid, int nb, unsigned char* smem) {
    const int g2tid = tid_opaque();
    int* sm = (int*)(smem + 65536);
    const int* cnt = (const int*)(p.ws + WS_CTL);
    const int* rowtok = (const int*)(p.ws + WS_ROWTOK);
    const bf16_t* hb = (const bf16_t*)(p.ws + WS_HB);
    bf16_t* act = (bf16_t*)(p.ws + WS_ACT);
    const int lane = tid_opaque() & 63, wave = tid_opaque() >> 6;
    int total_mt;
    moe_tile_map(cnt, sm, total_mt);
    for (int w = bid; w < total_mt * 16; w += nb) {
        const int tm = w >> 4, nt = w & 15;
        int e = 0;
        while (e < NEXP - 1 && sm[e + 1] <= tm) ++e;
        const int mt = tm - sm[e];
        const int rbase = sm[33 + e] + mt * 128;
        const int mrows = min(128, cnt[e] - mt * 128);
        const int n0 = nt * 64;
        f32x4 acc[4][4];
        gemm2<true, true>(hb, D, rowtok, rbase, mrows, (const bf16_t*)(p.ws + WB_E1) + (size_t)e * D * 2 * DFF, 2 * DFF, n0, 128, D, smem, acc);
        const float* b1 = p.in[22] + (size_t)e * 2 * DFF;
        const int wn_ = (tid_opaque() >> 6) & 1;
#pragma unroll
        for (int i = 0; i < 4; ++i)
#pragma unroll
            for (int jp = 0; jp < 2; ++jp) {
                const int col = n0 + (wn_ * 2 + jp) * 16 + (tid_opaque() & 15);
                const float bg = b1[col], bl = b1[DFF + col];
                float av[4];
                unsigned rmask = 0;
#pragma unroll
                for (int r = 0; r < 4; ++r) {
                    const int rl = G2_ROW(i, r);
                    const float gate = fminf(acc[i][2 * jp][r] + bg, 7.f);
                    const float lin = fminf(fmaxf(acc[i][2 * jp + 1][r] + bl, -7.f), 7.f);
                    av[r] = (lin + 1.f) * gate * sigmoidf_(1.702f * gate);
                    rmask |= (rl < mrows) ? (1u << r) : 0u;
                }
                store_bf16_frag(act + (size_t)(rbase + G2_ROW(i, 0)) * DFF + col, DFF, av[0], av[1], av[2], av[3], g2tid & 63, rmask);
            }
    }
}
__device__ __forceinline__ void phase_moe2(const Params& p, int bid, int nb, unsigned char* smem) {
    const int g2tid = tid_opaque();
    int* sm = (int*)(smem + 65536);
    const int* cnt = (const int*)(p.ws + WS_CTL);
    const bf16_t* act = (const bf16_t*)(p.ws + WS_ACT);
    float* yrows = (float*)(p.ws + WS_YROWS);
    const int lane = tid_opaque() & 63, wave = tid_opaque() >> 6;
    int total_mt;
    moe_tile_map(cnt, sm, total_mt);
    for (int w = bid; w < total_mt * 8; w += nb) {
        const int tm = w >> 3, nt = w & 7;
        int e = 0;
        while (e < NEXP - 1 && sm[e + 1] <= tm) ++e;
        const int mt = tm - sm[e];
        const int rbase = sm[33 + e] + mt * 128;
        const int mrows = min(128, cnt[e] - mt * 128);
        const int n0 = nt * 128;
        f32x4 acc[4][4];
        gemm2<false, false>(act, DFF, nullptr, rbase, mrows, (const bf16_t*)(p.ws + WB_E2) + (size_t)e * DFF * D, D, n0, 128, DFF, smem, acc);
        const float* b2 = p.in[24] + (size_t)e * D + n0;
#pragma unroll
        for (int i = 0; i < 4; ++i)
#pragma unroll
            for (int r = 0; r < 4; ++r) {
                const int rl = G2_ROW(i, r);
                if (rl < mrows) {
                    float* yr = yrows + (size_t)(rbase + rl) * D + n0;
#pragma unroll
                    for (int j = 0; j < 4; ++j) { const int c = G2_COL(j); yr[c] = acc[i][j][r] + b2[c]; }
                }
            }
    }
}

__device__ __forceinline__ void phase_combine(const Params& p, int bid, int nb) {
    const int lane = tid_opaque() & 63, wave = tid_opaque() >> 6;
    const float* x1 = (const float*)(p.ws + WS_X1);
    const float* yrows = (const float*)(p.ws + WS_YROWS);
    const int* ppos = (const int*)(p.ws + WS_PPOS);
    const float* topw = (const float*)(p.ws + WS_TOPW);
    const float* g = p.in[25];
    bf16_t* hb = (bf16_t*)(p.ws + WS_HB);
    bf16_t* pb = (bf16_t*)(p.ws + WS_PB);
    for (int t = bid * 4 + wave; t < S; t += nb * 4) {
        float4 v[4];
#pragma unroll
        for (int j = 0; j < 4; ++j) v[j] = ((const float4*)(x1 + (size_t)t * D))[lane + 64 * j];
#pragma unroll
        for (int k = 0; k < 4; ++k) {
            const float wk = topw[t * 4 + k];
            const float4* yr = (const float4*)(yrows + (size_t)ppos[t * 4 + k] * D);
#pragma unroll
            for (int j = 0; j < 4; ++j) { const float4 y = yr[lane + 64 * j]; v[j].x += wk * y.x; v[j].y += wk * y.y; v[j].z += wk * y.z; v[j].w += wk * y.w; }
        }
        float ss = 0.f;
#pragma unroll
        for (int j = 0; j < 4; ++j) ss += v[j].x * v[j].x + v[j].y * v[j].y + v[j].z * v[j].z + v[j].w * v[j].w;
        ss = wave_sum(ss);
        const float rstd = rsqrtf(ss * (1.f / D) + EPS);
#pragma unroll
        for (int j = 0; j < 4; ++j) {
            ((float4*)(p.out + (size_t)t * D))[lane + 64 * j] = v[j];
            const float4 gg = ((const float4*)g)[lane + 64 * j];
            uint2 o;
            o.x = pk2(v[j].x * rstd * gg.x, v[j].y * rstd * gg.y);
            o.y = pk2(v[j].z * rstd * gg.z, v[j].w * rstd * gg.w);
            ((uint2*)(hb + (size_t)t * D))[lane + 64 * j] = o;
        }
    }
}

__device__ __forceinline__ void phase_ple(const Params& p, int bid, int nb, unsigned char* smem) {
    const int g2tid = tid_opaque();
    const bf16_t* pw = (const bf16_t*)(p.ws + WS_PW);
    for (int w = bid; w < 128 * 8; w += nb) {
        const int mt = w % 128, nt = w / 128;
        const int m0 = mt * 128, n0 = nt * 128;
        f32x4 acc[4][4];
        gemm2<false, false>((const bf16_t*)(p.ws + WS_HB), D, nullptr, m0, 128, (const bf16_t*)(p.ws + WB_PLEG), D, n0, 128, D, smem, acc);
#pragma unroll
        for (int i = 0; i < 4; ++i)
#pragma unroll
            for (int r = 0; r < 4; ++r) {
                const size_t ro = (size_t)(m0 + G2_ROW(i, r)) * D + n0 + G2_COL(0);
                float* orow = p.out + ro;
#pragma unroll
                for (int j = 0; j < 4; ++j) orow[j * 16] = orow[j * 16] + sigmoidf_(acc[i][j][r]) * bf2f(pw[ro + j * 16]);
            }
    }
}

#define LAS __attribute__((address_space(3)))
#define XB_TMO      128
#define XB_XCNT(j)  (256  + 64 * (j))
#define XB_XSUB(j)  (1280 + 64 * (j))
#define XB_XGEN(j)  (2304 + 64 * (j))
#define XB_TOP      3328
#define XB_TOPGEN   3392
#define XCD_BAR_WORDS 3456
#define XB_SPIN_CAP (1u << 22)

__device__ __forceinline__ unsigned xb_ld(unsigned* p)              { return __hip_atomic_load(p, __ATOMIC_RELAXED, __HIP_MEMORY_SCOPE_AGENT); }
__device__ __forceinline__ unsigned xb_add(unsigned* p, unsigned v) { return __hip_atomic_fetch_add(p, v, __ATOMIC_RELAXED, __HIP_MEMORY_SCOPE_AGENT); }
__device__ __forceinline__ unsigned xb_xcc_id() { return (unsigned)__builtin_amdgcn_s_getreg((3 << 11) | 20) & 0xFu; }
#define XB_SPIN(cond, bar) do { unsigned _sp = 0; while (cond) { __builtin_amdgcn_s_sleep(1); \
    if ((++_sp & 255u) == 0u) { if (xb_ld(&(bar)[XB_TMO])) break; if (_sp > XB_SPIN_CAP) { atomicAdd(&(bar)[XB_TMO], 1u); break; } } } } while (0)

struct XcdBarrier {
    unsigned* bar; unsigned x;
    volatile LAS unsigned* st;
};

__device__ __forceinline__ XcdBarrier xcd_barrier_post(unsigned* bar, volatile LAS unsigned* st) {
    XcdBarrier b; b.bar = bar; b.x = xb_xcc_id(); b.st = st;
    if (tid_opaque() == 0) (void)xb_add(&bar[XB_XCNT(b.x)], 1u);
    return b;
}
__device__ __forceinline__ void xcd_barrier_complete(unsigned* bar, unsigned x, unsigned& nloc, unsigned& nx) {
    const unsigned G = gridDim.x * gridDim.y * gridDim.z;
    unsigned sum, cnt, mine, sp = 0u;
    for (;;) {
        sum = 0u; cnt = 0u; mine = 0u;
#pragma unroll
        for (unsigned j = 0; j < 16; ++j) { const unsigned c = xb_ld(&bar[XB_XCNT(j)]); sum += c; cnt += (c > 0u) ? 1u : 0u; mine = (j == x) ? c : mine; }
        if (sum == G) break;
        __builtin_amdgcn_s_sleep(1);
        if ((++sp & 255u) == 0u) { if (xb_ld(&bar[XB_TMO])) break; if (sp > XB_SPIN_CAP) { atomicAdd(&bar[XB_TMO], 1u); break; } }
    }
    nloc = mine > 0u ? mine : 1u; nx = cnt > 0u ? cnt : 1u;
}

__device__ __forceinline__ void xcd_barrier(const XcdBarrier& b) {
    asm volatile("s_waitcnt vmcnt(0)" ::: "memory");
    __syncthreads();
    if (tid_opaque() == 0) {
        unsigned* bar = b.bar;
        __builtin_amdgcn_s_waitcnt(0);
        unsigned nloc = b.st[0], nx = b.st[1];
        if (nloc == 0u) { xcd_barrier_complete(bar, b.x, nloc, nx); b.st[0] = nloc; b.st[1] = nx; }
        const unsigned old = xb_add(&bar[XB_XSUB(b.x)], 1u);
        const unsigned gen = old / nloc;
        if (old + 1u == (gen + 1u) * nloc) {
            __builtin_amdgcn_fence(__ATOMIC_RELEASE, "agent");
            asm volatile("s_waitcnt vmcnt(0)" ::: "memory");
            const unsigned og = xb_add(&bar[XB_TOP], 1u);
            const unsigned tg = og / nx;
            if (og + 1u == (tg + 1u) * nx) xb_add(&bar[XB_TOPGEN], 1u);
            else XB_SPIN(xb_ld(&bar[XB_TOPGEN]) == tg, bar);
            __builtin_amdgcn_fence(__ATOMIC_ACQUIRE, "agent");
            xb_add(&bar[XB_XGEN(b.x)], 1u);
            asm volatile("s_waitcnt vmcnt(0)" ::: "memory");
        } else {
            XB_SPIN(xb_ld(&bar[XB_XGEN(b.x)]) == gen, bar);
            __builtin_amdgcn_fence(__ATOMIC_ACQUIRE, "agent");
            asm volatile("s_waitcnt vmcnt(0)" ::: "memory");
        }
    }
    __syncthreads();
}

template <int PH>
__device__ __forceinline__ void run_phase(const Params& p, int bid, int nb, unsigned char* smem) {
    if (PH == 0) phase_prep(p, bid, nb);
    if (PH == 1) phase_inproj(p, bid, nb, smem);
    if (PH == 3) phase_compress(p, bid, nb, smem);
    if (PH == 4) phase_attn(p, bid, nb, smem);
    if (PH == 15) {
        if (bid < (nb >> 1)) { phase_dsa_attn(p, bid, nb, smem); phase_merge<0>(p, bid, nb, smem); }
        else { phase_merge<0>(p, bid, nb, smem); phase_dsa_attn(p, bid, nb, smem); }
    }
    if (PH == 13) phase_merge<1>(p, bid, nb, smem);
    if (PH == 6) phase_outproj(p, bid, nb, smem);
    if (PH == 7) phase_route(p, bid, nb, smem);
    if (PH == 8) phase_place(p, bid, nb, smem);
    if (PH == 9) phase_moe1(p, bid, nb, smem);
    if (PH == 10) phase_moe2(p, bid, nb, smem);
    if (PH == 11) phase_combine(p, bid, nb);
    if (PH == 12) phase_ple(p, bid, nb, smem);
}

#if SINGLE_LAUNCH
__global__ void __launch_bounds__(NT, 2) fwd_mega(Params p) {
    __shared__ __attribute__((aligned(16))) unsigned char smem[SMEM_BYTES];
    cg::grid_group grid = cg::this_grid();
    const int bid = blockIdx.x, nb = gridDim.x;
    volatile LAS unsigned* bst = (volatile LAS unsigned*)(LAS unsigned char*)(smem + SMEM_BYTES - 16);
    if (tid_opaque() < 2) bst[tid_opaque()] = 0u;
    __syncthreads();
    const XcdBarrier bar = xcd_barrier_post((unsigned*)(p.ws + WS_BAR), bst);
#define GSYNC() xcd_barrier(bar)
    run_phase<0>(p, bid, nb, smem); GSYNC();
    run_phase<1>(p, bid, nb, smem); GSYNC();
    run_phase<3>(p, bid, nb, smem); GSYNC();
    run_phase<4>(p, bid, nb, smem); grid.sync();
    run_phase<15>(p, bid, nb, smem); GSYNC();
    run_phase<13>(p, bid, nb, smem); GSYNC();
    run_phase<6>(p, bid, nb, smem); GSYNC();
    run_phase<7>(p, bid, nb, smem); GSYNC();
    run_phase<8>(p, bid, nb, smem); GSYNC();
    run_phase<9>(p, bid, nb, smem); GSYNC();
    run_phase<10>(p, bid, nb, smem); GSYNC();
    run_phase<11>(p, bid, nb, smem); GSYNC();
    run_phase<12>(p, bid, nb, smem);
#undef GSYNC
}
#else
template <int PH>
__global__ void __launch_bounds__(NT, 2) k_phase(Params p) {
    __shared__ __attribute__((aligned(16))) unsigned char smem[SMEM_BYTES];
    run_phase<PH>(p, blockIdx.x, gridDim.x, smem);
}
#endif

extern "C" void kernel_launch(void* const* d_in, const int* in_sizes, int n_in, void* d_out, int out_size, void* d_ws, size_t ws_size,
                              hipStream_t stream) {
    if (n_in != 28 || ws_size < WS_END) { fprintf(stderr, "kernel_launch: unexpected n_in %d or ws_size %zu (< %zu)\n", n_in, ws_size, (size_t)WS_END); return; }
    Params p{};
    for (int i = 0; i < 28; ++i) p.in[i] = (const float*)d_in[i];
    p.out = (float*)d_out;
    p.ws = (unsigned char*)d_ws;
#if SINGLE_LAUNCH
    static int grid_blocks = 0;
    if (!grid_blocks) {
        int dev = 0, cus = 0, per_cu = 0;
        hipGetDevice(&dev);
        hipDeviceGetAttribute(&cus, hipDeviceAttributeMultiprocessorCount, dev);
        hipOccupancyMaxActiveBlocksPerMultiprocessor(&per_cu, fwd_mega, NT, 0);
        if (per_cu > 2) per_cu = 2;
        if (per_cu < 1) per_cu = 1;
        grid_blocks = cus * per_cu;
    }
    (void)hipMemsetAsync((unsigned char*)d_ws + WS_BAR, 0, 16384 + 256, stream);
    void* args[] = {&p};
    hipError_t e = hipLaunchCooperativeKernel((void*)fwd_mega, dim3(grid_blocks), dim3(NT), args, 0, stream);
    if (e != hipSuccess) fprintf(stderr, "cooperative launch failed: %s (grid %d)\n", hipGetErrorString(e), grid_blocks);
#else
    const int G = 512;
    k_phase<0><<<G, NT, 0, stream>>>(p);
    k_phase<1><<<G, NT, 0, stream>>>(p);
    k_phase<3><<<G, NT, 0, stream>>>(p);
    k_phase<4><<<G, NT, 0, stream>>>(p);
    k_phase<15><<<G, NT, 0, stream>>>(p);
    k_phase<13><<<G, NT, 0, stream>>>(p);
    k_phase<6><<<G, NT, 0, stream>>>(p);
    k_phase<7><<<G, NT, 0, stream>>>(p);
    k_phase<8><<<G, NT, 0, stream>>>(p);
    k_phase<9><<<G, NT, 0, stream>>>(p);
    k_phase<10><<<G, NT, 0, stream>>>(p);
    k_phase<11><<<G, NT, 0, stream>>>(p);
    k_phase<12><<<G, NT, 0, stream>>>(p);
#endif
}
```

```cpp
#include <hip/hip_runtime.h>
#include <hip/hip_cooperative_groups.h>
#include <cstdio>
#include <cstdint>
namespace cg = cooperative_groups;

#ifndef SINGLE_LAUNCH
#define SINGLE_LAUNCH 1
#endif

constexpr int S = 16384;
constexpr int D = 1024;
constexpr int DIN = 5184;
constexpr int NCMP = 1023;
constexpr int NSLC = 256;
constexpr int NEXP = 32;
constexpr int DFF = 1024;
constexpr float EPS = 1e-6f;
constexpr float LOG2E = 1.4426950408889634f;
constexpr int Z_NQ = 0, Z_NKV = 512, Z_NGATE = 1280, Z_DQ = 1304, Z_DK = 1816, Z_DV = 2328, Z_IQ = 2840, Z_IK = 3096,
              Z_IW = 3128, Z_GA = 3136, Z_GB = 4160;

constexpr int NT = 256;
constexpr int SMEM_BYTES = 73728;

typedef unsigned short bf16_t;
typedef short bf16x8 __attribute__((ext_vector_type(8)));
typedef float f32x4 __attribute__((ext_vector_type(4)));
typedef float f32x2 __attribute__((ext_vector_type(2)));
typedef short s16x4 __attribute__((ext_vector_type(4)));
typedef __attribute__((address_space(3))) s16x4* lds_s16x4_ptr;
__device__ __forceinline__ s16x4 lds_tr16(const void* p) {
    return __builtin_amdgcn_ds_read_tr16_b64_v4i16((lds_s16x4_ptr)(uintptr_t)p);
}

constexpr size_t MBy = 1ull << 20;
constexpr size_t WS_CTL = 0;
constexpr size_t WS_CNTB = 131072;
constexpr size_t WS_BAR = 65536;
constexpr size_t WS_HB = 1 * MBy;
constexpr size_t WS_OA = WS_HB + (size_t)S * D * 2;
constexpr size_t WS_OB = WS_OA + (size_t)S * 512 * 2;
constexpr size_t WS_MERGED = WS_OB + (size_t)S * 512 * 2;
constexpr size_t WS_X1 = WS_MERGED + (size_t)S * D * 2;
constexpr size_t WS_TOPI = WS_X1 + (size_t)S * D * 4;
constexpr size_t WS_TOPW = WS_TOPI + (size_t)S * 4 * 4;
constexpr size_t WS_PPOS = WS_TOPW + (size_t)S * 4 * 4;
constexpr size_t WS_ROWTOK = WS_PPOS + (size_t)S * 4 * 4;
constexpr size_t WS_PB = WS_ROWTOK + (size_t)65536 * 4;
constexpr size_t WS_PW = WS_PB + (size_t)S * 256 * 2;
constexpr size_t WS_SEL = WS_PW + (size_t)S * D * 2;
constexpr size_t WS_NSEL = WS_SEL + (size_t)S * 256 * 2;
constexpr size_t WS_REG = WS_NSEL + (size_t)S * 4;
constexpr size_t WS_SGA = WS_REG;
constexpr size_t WS_SGB = WS_SGA + (size_t)S * D * 2;
constexpr size_t WS_GT = WS_SGB + (size_t)S * D * 2;
constexpr size_t WS_IWS = WS_GT + (size_t)S * 32 * 4;
constexpr size_t WS_QNB = WS_IWS + (size_t)S * 8 * 4;
constexpr size_t WS_KSLB = WS_QNB + (size_t)S * 512 * 2;
constexpr size_t WS_VSLB = WS_KSLB + (size_t)S * 128 * 2;
constexpr size_t WS_KWNB = WS_VSLB + (size_t)S * 128 * 2;
constexpr size_t WS_VWNB = WS_KWNB + (size_t)S * 128 * 2;
constexpr size_t WS_KCB = WS_VWNB + (size_t)S * 128 * 2;
constexpr size_t WS_VCB = WS_KCB + (size_t)2 * 1024 * 64 * 2;
constexpr size_t WS_KCR = WS_VCB + (size_t)2 * 1024 * 64 * 2;
constexpr size_t WS_VCR = WS_KCR + (size_t)S * 128 * 2;
constexpr size_t WS_DQB = WS_VCR + (size_t)S * 128 * 2;
constexpr size_t WS_DKB = WS_DQB + (size_t)S * 512 * 2;
constexpr size_t WS_DVB = WS_DKB + (size_t)S * 512 * 2;
constexpr size_t WS_IQB = WS_DVB + (size_t)S * 512 * 2;
constexpr size_t WS_IKB = WS_IQB + (size_t)S * 256 * 2;
constexpr size_t WS_ENDA = WS_IKB + (size_t)S * 32 * 2;
constexpr size_t WS_ACT = WS_REG;
constexpr size_t WS_YROWS = WS_ACT + (size_t)(65536 + 128) * DFF * 2;
constexpr size_t WS_ENDB = WS_YROWS + (size_t)(65536 + 128) * D * 4;
constexpr size_t WS_END0 = WS_ENDA > WS_ENDB ? WS_ENDA : WS_ENDB;
constexpr size_t WB_IN = WS_END0;
constexpr size_t WB_A = WB_IN + (size_t)D * DIN * 2;
constexpr size_t WB_B = WB_A + (size_t)512 * D * 2;
constexpr size_t WB_OUT = WB_B + (size_t)512 * D * 2;
constexpr size_t WB_E1 = WB_OUT + (size_t)D * D * 2;
constexpr size_t WB_E2 = WB_E1 + (size_t)NEXP * D * 2 * DFF * 2;
constexpr size_t WB_PLE = WB_E2 + (size_t)NEXP * DFF * D * 2;
constexpr size_t WB_PLEG = WB_PLE + (size_t)256 * D * 2;
constexpr size_t WB_CK1 = WB_PLEG + (size_t)D * D * 2;
constexpr size_t WB_CV1 = WB_CK1 + (size_t)2048 * 64 * 2;
constexpr size_t WS_END = WB_CV1 + (size_t)2048 * 64 * 2 + 4096;

struct Params {
    const float* in[28];
    float* out;
    unsigned char* ws;
};

typedef __bf16 hwbf16x2 __attribute__((ext_vector_type(2)));
typedef float f32x2c __attribute__((ext_vector_type(2)));
__device__ __forceinline__ unsigned pk2h(float lo, float hi) { return __builtin_bit_cast(unsigned, __builtin_convertvector((f32x2c){lo, hi}, hwbf16x2)); }
__device__ __forceinline__ unsigned f2bf(float f) {
    unsigned u = __builtin_bit_cast(unsigned, f);
    return (u + 0x7fffu + ((u >> 16) & 1u)) >> 16;
}
__device__ __forceinline__ unsigned pk2(float lo, float hi) { return pk2h(lo, hi); }
__device__ __forceinline__ float bf2f(unsigned short b) { return __builtin_bit_cast(float, (unsigned)b << 16); }
__device__ __forceinline__ int tid_opaque() { int t = threadIdx.x; asm volatile("" : "+v"(t)); return t; }
template <int CTRL> __device__ __forceinline__ int dppi(int v) { return __builtin_amdgcn_update_dpp(v, v, CTRL, 0xF, 0xF, false); }
template <int CTRL> __device__ __forceinline__ float dppf(float v) { return __builtin_bit_cast(float, dppi<CTRL>(__builtin_bit_cast(int, v))); }
typedef unsigned u32x2s __attribute__((ext_vector_type(2)));
__device__ __forceinline__ void swap16(float v, float& a, float& b) {
    const unsigned u = __builtin_bit_cast(unsigned, v);
    const u32x2s r = __builtin_amdgcn_permlane16_swap(u, u, false, false);
    const unsigned x = r[0], y = r[1];
    a = __builtin_bit_cast(float, x); b = __builtin_bit_cast(float, y);
}
__device__ __forceinline__ void swap32(float v, float& a, float& b) {
    const unsigned u = __builtin_bit_cast(unsigned, v);
    const u32x2s r = __builtin_amdgcn_permlane32_swap(u, u, false, false);
    const unsigned x = r[0], y = r[1];
    a = __builtin_bit_cast(float, x); b = __builtin_bit_cast(float, y);
}
__device__ __forceinline__ float xadd16(float v) { float a, b; swap16(v, a, b); return a + b; }
__device__ __forceinline__ float xadd32(float v) { float a, b; swap32(v, a, b); return a + b; }
__device__ __forceinline__ float pair32(float u, float v) {
    const u32x2s r = __builtin_amdgcn_permlane32_swap(__builtin_bit_cast(unsigned, u), __builtin_bit_cast(unsigned, v), false, false);
    const unsigned x = r[0], y = r[1];
    return __builtin_bit_cast(float, x) + __builtin_bit_cast(float, y);
}
__device__ __forceinline__ float pair16(float a, float b) {
    const u32x2s r = __builtin_amdgcn_permlane16_swap(__builtin_bit_cast(unsigned, a), __builtin_bit_cast(unsigned, b), false, false);
    const unsigned x = r[0], y = r[1];
    return __builtin_bit_cast(float, x) + __builtin_bit_cast(float, y);
}
__device__ __forceinline__ float wave_sum(float v) {
    v += dppf<0xB1>(v); v += dppf<0x4E>(v); v += dppf<0x141>(v); v += dppf<0x140>(v);
    return xadd32(xadd16(v));
}
__device__ __forceinline__ float wave_max(float v) {
    v = fmaxf(v, dppf<0xB1>(v)); v = fmaxf(v, dppf<0x4E>(v)); v = fmaxf(v, dppf<0x141>(v)); v = fmaxf(v, dppf<0x140>(v));
    float a, b;
    swap16(v, a, b); v = fmaxf(a, b);
    swap32(v, a, b); return fmaxf(a, b);
}
__device__ __forceinline__ int row_sum_i(int v) {
    v += dppi<0xB1>(v); v += dppi<0x4E>(v); v += dppi<0x141>(v); v += dppi<0x140>(v);
    return v;
}
__device__ __forceinline__ int wave_sum_i_uniform(int v) {
    v = row_sum_i(v);
    return __builtin_amdgcn_readlane(v, 0) + __builtin_amdgcn_readlane(v, 16) + __builtin_amdgcn_readlane(v, 32) + __builtin_amdgcn_readlane(v, 48);
}
__device__ __forceinline__ float sigmoidf_(float x) { return __builtin_amdgcn_rcpf(1.f + __expf(-x)); }
__device__ __forceinline__ int bucket_of(int n) {
    if (n < 16) return n;
    int b = 16;
    b += (n >= 19) + (n >= 21) + (n >= 24) + (n >= 27) + (n >= 31) + (n >= 35) + (n >= 40) + (n >= 46) + (n >= 52) + (n >= 59) +
         (n >= 67) + (n >= 77) + (n >= 87) + (n >= 99) + (n >= 113);
    return b;
}

constexpr int LDS_STRIDE = 40;
constexpr int BTR_STRIDE = 136;
template <bool A_F32, bool GATHER, bool SPLIT = false, bool BTR = true>
__device__ __forceinline__ void gemm_tile(const void* __restrict__ Aptr, int lda, const int* __restrict__ rowidx, int m0, int mrows,
                                          const float* __restrict__ B, int ldb, int n0, int split_off, int ncols, int K,
                                          unsigned char* smem, f32x4 (&acc)[2][8]) {
    bf16_t* As = (bf16_t*)smem;
    bf16_t* Bs = As + 128 * LDS_STRIDE;
    bf16_t* AsL = Bs + 128 * LDS_STRIDE;
    bf16_t* BsL = AsL + 128 * LDS_STRIDE;
    const int tid = tid_opaque(), lane = tid & 63, wave = tid >> 6;
#pragma unroll
    for (int i = 0; i < 2; ++i)
#pragma unroll
        for (int j = 0; j < 8; ++j) acc[i][j] = (f32x4){0.f, 0.f, 0.f, 0.f};
    auto lo = [](float v) { return v - bf2f((unsigned short)f2bf(v)); };

    const int ar = tid >> 2, ach = tid & 3;
    const unsigned char* arow[2];
    bool aval[2];
#pragma unroll
    for (int i = 0; i < 2; ++i) {
        int r = ar + 64 * i;
        aval[i] = r < mrows;
        long src = 0;
        if (aval[i]) src = GATHER ? (long)rowidx[m0 + r] : (long)(m0 + r);
        arow[i] = (const unsigned char*)Aptr + (size_t)src * lda * (A_F32 ? 4 : 2) + (size_t)ach * 8 * (A_F32 ? 4 : 2);
    }
    const int nq = tid & 31, kq = tid >> 5;
    const int jn = 4 * nq;
    const bool bval = jn < ncols;
    const float* bptr = B + (size_t)(4 * kq) * ldb + n0 + jn + (jn >= 64 ? split_off : 0);

    uint4 areg[2];
    float4 af0a, af0b, af1a, af1b;
    float4 breg[4];
    auto load_g = [&](int k0) {
#pragma unroll
        for (int i = 0; i < 2; ++i) {
            if (A_F32) {
                float4 t0 = make_float4(0, 0, 0, 0), t1 = t0;
                if (aval[i]) {
                    const float4* s = (const float4*)(arow[i] + (size_t)k0 * 4);
                    t0 = s[0]; t1 = s[1];
                }
                if (i == 0) { af0a = t0; af0b = t1; } else { af1a = t0; af1b = t1; }
            } else {
                if (aval[i]) areg[i] = *(const uint4*)(arow[i] + (size_t)k0 * 2);
                else areg[i] = make_uint4(0, 0, 0, 0);
            }
        }
#pragma unroll
        for (int kk = 0; kk < 4; ++kk) {
            if (bval) breg[kk] = *(const float4*)(bptr + (size_t)(k0 + kk) * ldb);
            else breg[kk] = make_float4(0, 0, 0, 0);
        }
    };
    auto store_l = [&]() {
#pragma unroll
        for (int i = 0; i < 2; ++i) {
            uint4 v;
            const float4 t0 = (i == 0) ? af0a : af1a, t1 = (i == 0) ? af0b : af1b;
            if (A_F32) {
                v.x = pk2(t0.x, t0.y); v.y = pk2(t0.z, t0.w);
                v.z = pk2(t1.x, t1.y); v.w = pk2(t1.z, t1.w);
            } else v = areg[i];
            *(uint4*)(As + (ar + 64 * i) * LDS_STRIDE + ach * 8) = v;
            if (SPLIT && A_F32) {
                v.x = pk2(lo(t0.x), lo(t0.y)); v.y = pk2(lo(t0.z), lo(t0.w));
                v.z = pk2(lo(t1.x), lo(t1.y)); v.w = pk2(lo(t1.z), lo(t1.w));
                *(uint4*)(AsL + (ar + 64 * i) * LDS_STRIDE + ach * 8) = v;
            }
        }
        if (SPLIT) {
            uint2 v;
            v.x = pk2(lo(breg[0].x), lo(breg[1].x)); v.y = pk2(lo(breg[2].x), lo(breg[3].x));
            *(uint2*)(BsL + (jn + 0) * LDS_STRIDE + 4 * kq) = v;
            v.x = pk2(lo(breg[0].y), lo(breg[1].y)); v.y = pk2(lo(breg[2].y), lo(breg[3].y));
            *(uint2*)(BsL + (jn + 1) * LDS_STRIDE + 4 * kq) = v;
            v.x = pk2(lo(breg[0].z), lo(breg[1].z)); v.y = pk2(lo(breg[2].z), lo(breg[3].z));
            *(uint2*)(BsL + (jn + 2) * LDS_STRIDE + 4 * kq) = v;
            v.x = pk2(lo(breg[0].w), lo(breg[1].w)); v.y = pk2(lo(breg[2].w), lo(breg[3].w));
            *(uint2*)(BsL + (jn + 3) * LDS_STRIDE + 4 * kq) = v;
        }
        if (BTR && !SPLIT) {
#pragma unroll
            for (int kk = 0; kk < 4; ++kk) {
                uint2 v; v.x = pk2(breg[kk].x, breg[kk].y); v.y = pk2(breg[kk].z, breg[kk].w);
                *(uint2*)(Bs + (4 * kq + kk) * BTR_STRIDE + jn) = v;
            }
        } else {
            uint2 v;
            v.x = pk2(breg[0].x, breg[1].x); v.y = pk2(breg[2].x, breg[3].x);
            *(uint2*)(Bs + (jn + 0) * LDS_STRIDE + 4 * kq) = v;
            v.x = pk2(breg[0].y, breg[1].y); v.y = pk2(breg[2].y, breg[3].y);
            *(uint2*)(Bs + (jn + 1) * LDS_STRIDE + 4 * kq) = v;
            v.x = pk2(breg[0].z, breg[1].z); v.y = pk2(breg[2].z, breg[3].z);
            *(uint2*)(Bs + (jn + 2) * LDS_STRIDE + 4 * kq) = v;
            v.x = pk2(breg[0].w, breg[1].w); v.y = pk2(breg[2].w, breg[3].w);
            *(uint2*)(Bs + (jn + 3) * LDS_STRIDE + 4 * kq) = v;
        }
    };
    const int nk = K / 32;
    __syncthreads();
    load_g(0);
    store_l();
    __syncthreads();
    const int fr = lane & 15, fq = lane >> 4;
    for (int kt = 0; kt < nk; ++kt) {
        if (kt + 1 < nk) load_g((kt + 1) * 32);
        bf16x8 a[2];
#pragma unroll
        for (int i = 0; i < 2; ++i) a[i] = *(const bf16x8*)(As + (wave * 32 + i * 16 + fr) * LDS_STRIDE + fq * 8);
        if (!SPLIT) {
            bf16x8 b[8];
#pragma unroll
            for (int j = 0; j < 8; ++j) {
                if (BTR && !SPLIT) {
                    const bf16_t* bp = Bs + (8 * fq + (fr >> 2)) * BTR_STRIDE + 16 * j + 4 * (fr & 3);
                    const s16x4 lo4 = lds_tr16(bp), hi4 = lds_tr16(bp + 4 * BTR_STRIDE);
                    b[j] = (bf16x8){lo4[0], lo4[1], lo4[2], lo4[3], hi4[0], hi4[1], hi4[2], hi4[3]};
                } else b[j] = *(const bf16x8*)(Bs + (j * 16 + fr) * LDS_STRIDE + fq * 8);
            }
#pragma unroll
            for (int i = 0; i < 2; ++i)
#pragma unroll
                for (int j = 0; j < 8; ++j) acc[i][j] = __builtin_amdgcn_mfma_f32_16x16x32_bf16(a[i], b[j], acc[i][j], 0, 0, 0);
        } else {
            bf16x8 al[2];
#pragma unroll
            for (int i = 0; i < 2; ++i) al[i] = *(const bf16x8*)(AsL + (wave * 32 + i * 16 + fr) * LDS_STRIDE + fq * 8);
#pragma unroll
            for (int j = 0; j < 8; ++j) {
                const bf16x8 bh = *(const bf16x8*)(Bs + (j * 16 + fr) * LDS_STRIDE + fq * 8);
                const bf16x8 bl = *(const bf16x8*)(BsL + (j * 16 + fr) * LDS_STRIDE + fq * 8);
#pragma unroll
                for (int i = 0; i < 2; ++i) {
                    acc[i][j] = __builtin_amdgcn_mfma_f32_16x16x32_bf16(a[i], bh, acc[i][j], 0, 0, 0);
                    acc[i][j] = __builtin_amdgcn_mfma_f32_16x16x32_bf16(a[i], bl, acc[i][j], 0, 0, 0);
                    acc[i][j] = __builtin_amdgcn_mfma_f32_16x16x32_bf16(al[i], bh, acc[i][j], 0, 0, 0);
                }
            }
        }
        __syncthreads();
        if (kt + 1 < nk) {
            store_l();
            __syncthreads();
        }
    }
}


constexpr int ASTR = 64;
constexpr int BSTR = 144;
template <bool GATHER, bool PAIR>
__device__ __forceinline__ void gemm2(const bf16_t* __restrict__ A, int lda, const int* __restrict__ rowidx, int m0, int mrows,
                                      const bf16_t* __restrict__ B, int ldb, int n0, int ncols, int K, unsigned char* smem,
                                      f32x4 (&acc)[4][4]) {
    bf16_t* As = (bf16_t*)smem;
    bf16_t* Bs = As + 128 * ASTR;
    const int tid = tid_opaque(), lane = tid & 63, wave = tid >> 6, wm = wave >> 1, wn = wave & 1;
#pragma unroll
    for (int i = 0; i < 4; ++i)
#pragma unroll
        for (int j = 0; j < 4; ++j) acc[i][j] = (f32x4){0.f, 0.f, 0.f, 0.f};
    const int ar0 = tid >> 3, ach = tid & 7;
    const bf16_t* ap0; const bf16_t* ap1; const bf16_t* ap2; const bf16_t* ap3;
    {
        int r_[4];
#pragma unroll
        for (int i = 0; i < 4; ++i) { const int rl = 32 * i + ar0; r_[i] = rl < mrows ? rl : mrows - 1; }
        ap0 = A + (size_t)(GATHER ? (long)rowidx[m0 + r_[0]] : (long)(m0 + r_[0])) * lda + ach * 8;
        ap1 = A + (size_t)(GATHER ? (long)rowidx[m0 + r_[1]] : (long)(m0 + r_[1])) * lda + ach * 8;
        ap2 = A + (size_t)(GATHER ? (long)rowidx[m0 + r_[2]] : (long)(m0 + r_[2])) * lda + ach * 8;
        ap3 = A + (size_t)(GATHER ? (long)rowidx[m0 + r_[3]] : (long)(m0 + r_[3])) * lda + ach * 8;
    }
    const int br0 = tid >> 4, bch = tid & 15;
    const int bcol = PAIR ? ((bch >> 3) * 32 + (bch & 3) * 8 + ((bch >> 2) & 1) * 1024) : bch * 8;
    const bf16_t* bp = B + (size_t)br0 * ldb + n0 + bcol;
    bf16_t* asd = As + ar0 * ASTR + ((ach ^ (ar0 & 7)) * 8);
    bf16_t* bsd = Bs + br0 * BSTR + ((bch ^ (((br0 >> 3) & 1) * 8)) * 8);
    uint4 pa0, pa1, pa2, pa3, pb0, pb1, pb2, pb3, qa0, qa1, qa2, qa3, qb0, qb1, qb2, qb3;
    constexpr int G2_BUF = 128 * ASTR + 64 * BSTR;
#define G2_LOAD(S_, k0)                                                                                   \
    do {                                                                                                  \
        S_##a0 = *(const uint4*)(ap0 + (k0)); S_##a1 = *(const uint4*)(ap1 + (k0));                       \
        S_##a2 = *(const uint4*)(ap2 + (k0)); S_##a3 = *(const uint4*)(ap3 + (k0));                       \
        const bf16_t* bp_ = bp + (size_t)(k0) * ldb;                                                      \
        S_##b0 = *(const uint4*)(bp_); S_##b1 = *(const uint4*)(bp_ + (size_t)16 * ldb);                  \
        S_##b2 = *(const uint4*)(bp_ + (size_t)32 * ldb); S_##b3 = *(const uint4*)(bp_ + (size_t)48 * ldb); \
    } while (0)
#define G2_STORE(S_, off_)                                                                                \
    do {                                                                                                  \
        bf16_t* ad_ = asd + (off_); bf16_t* bd_ = bsd + (off_);                                           \
        *(uint4*)(ad_) = S_##a0; *(uint4*)(ad_ + 32 * ASTR) = S_##a1; *(uint4*)(ad_ + 64 * ASTR) = S_##a2; *(uint4*)(ad_ + 96 * ASTR) = S_##a3; \
        *(uint4*)(bd_) = S_##b0; *(uint4*)(bd_ + 16 * BSTR) = S_##b1; *(uint4*)(bd_ + 32 * BSTR) = S_##b2; *(uint4*)(bd_ + 48 * BSTR) = S_##b3; \
    } while (0)
    const int fr = lane & 15, fq = lane >> 4;
    const bf16_t* afp0 = As + (wm * 64 + fr) * ASTR + ((fq ^ (fr & 7)) * 8);
    const bf16_t* afp1 = As + (wm * 64 + fr) * ASTR + (((4 + fq) ^ (fr & 7)) * 8);
    const bf16_t* bfp = Bs + (8 * fq + (fr >> 2)) * BSTR + ((wn ^ (fq & 1)) * 64) + 4 * (fr & 3);
#define G2_COMPUTE(off_)                                                                                  \
    _Pragma("unroll") for (int kh = 0; kh < 2; ++kh) {                                                    \
        bf16x8 a[4];                                                                                      \
        _Pragma("unroll") for (int i = 0; i < 4; ++i) a[i] = *(const bf16x8*)((kh ? afp1 : afp0) + (off_) + i * 16 * ASTR); \
        bf16x8 b[4];                                          \
        _Pragma("unroll") for (int j = 0; j < 4; ++j) {                                                   \
            const bf16_t* q = bfp + (off_) + kh * 32 * BSTR + j * 16;                                     \
            const s16x4 lo4 = lds_tr16(q), hi4 = lds_tr16(q + 4 * BSTR);                                  \
            b[j] = (bf16x8){lo4[0], lo4[1], lo4[2], lo4[3], hi4[0], hi4[1], hi4[2], hi4[3]};              \
        }                                                                                                 \
        _Pragma("unroll") for (int j = 0; j < 4; ++j)                                                     \
            _Pragma("unroll") for (int i = 0; i < 4; ++i) acc[i][j] = __builtin_amdgcn_mfma_f32_16x16x32_bf16(a[i], b[j], acc[i][j], 0, 0, 0); \
    }
    const int nk = K / 64;
    __syncthreads();
    G2_LOAD(p, 0);
    if (nk > 1) G2_LOAD(q, 64);
    G2_STORE(p, 0);
    if (nk > 2) G2_LOAD(p, 128);
    __syncthreads();
#pragma unroll 1
    for (int kt = 0; kt < nk; kt += 2) {
        if (kt + 1 < nk) G2_STORE(q, G2_BUF);
        if (kt + 3 < nk) G2_LOAD(q, (kt + 3) * 64);
        G2_COMPUTE(0)
        __syncthreads();
        if (kt + 1 < nk) {
            if (kt + 2 < nk) G2_STORE(p, 0);
            if (kt + 4 < nk) G2_LOAD(p, (kt + 4) * 64);
            G2_COMPUTE(G2_BUF)
            __syncthreads();
        }
    }
#undef G2_COMPUTE
#undef G2_LOAD
#undef G2_STORE
}
#define G2_ROW(i, r) ((g2tid >> 7) * 64 + (i) * 16 + 4 * ((g2tid & 63) >> 4) + (r))
#define G2_COL(j) (((((g2tid >> 6) & 1) * 4 + (j)) * 16) + (g2tid & 15))
__device__ __forceinline__ void store_fp8_frag(unsigned char* base, int ld, float v0, float v1, float v2, float v3, int lane) {
    const int q = lane & 3;
    const bool odd = q & 1, hi2 = q & 2;
    const float ra = dppf<0xB1>(odd ? v0 : v1);
    const float rb = dppf<0xB1>(odd ? v2 : v3);
    const float a_lo = odd ? ra : v0, a_hi = odd ? v1 : ra;
    const float b_lo = odd ? rb : v2, b_hi = odd ? v3 : rb;
    const float r_lo = dppf<0x4E>(hi2 ? a_lo : b_lo);
    const float r_hi = dppf<0x4E>(hi2 ? a_hi : b_hi);
    const float f0 = hi2 ? r_lo : a_lo, f1 = hi2 ? r_hi : a_hi, f2 = hi2 ? b_lo : r_lo, f3 = hi2 ? b_hi : r_hi;
    int w = __builtin_amdgcn_cvt_pk_fp8_f32(__builtin_amdgcn_fmed3f(f0, -448.f, 448.f), __builtin_amdgcn_fmed3f(f1, -448.f, 448.f), 0, false);
    w = __builtin_amdgcn_cvt_pk_fp8_f32(__builtin_amdgcn_fmed3f(f2, -448.f, 448.f), __builtin_amdgcn_fmed3f(f3, -448.f, 448.f), w, true);
    *(int*)(base + q * ld - q) = w;
}
__device__ __forceinline__ void store_bf16_frag(bf16_t* base, int ld, float v0, float v1, float v2, float v3, int lane, unsigned rowmask = 0xFu) {
    const bool odd = lane & 1;
    const float s0 = odd ? v0 : v2, s1 = odd ? v1 : v3;
    const float r0 = dppf<0xB1>(s0), r1 = dppf<0xB1>(s1);
    bf16_t* p0 = odd ? base + 2 * ld - 1 : base;
    const unsigned w0 = odd ? pk2h(r0, v2) : pk2h(v0, r0);
    const unsigned w1 = odd ? pk2h(r1, v3) : pk2h(v1, r1);
    const unsigned m = odd ? (rowmask >> 2) : rowmask;
    if (m & 1u) *(unsigned*)p0 = w0;
    if (m & 2u) *(unsigned*)(p0 + ld) = w1;
}

typedef float f32x4v __attribute__((ext_vector_type(4)));
typedef unsigned u32x2v __attribute__((ext_vector_type(2)));
__device__ __forceinline__ void cvt_weights(const float* __restrict__ src, bf16_t* __restrict__ dst, size_t n, int bid, int nb) {
    const size_t n4 = n >> 2;
    const size_t stride = (size_t)nb * NT;
    size_t i = (size_t)bid * NT + tid_opaque();
    const f32x4v* s4 = (const f32x4v*)src;
    u32x2v* d2 = (u32x2v*)dst;
    for (; i + 7 * stride < n4; i += 8 * stride) {
        f32x4v v[8];
#pragma unroll
        for (int k = 0; k < 8; ++k) v[k] = __builtin_nontemporal_load(s4 + i + k * stride);
        asm volatile("" :: "v"(v[0][0]), "v"(v[1][0]), "v"(v[2][0]), "v"(v[3][0]), "v"(v[4][0]), "v"(v[5][0]), "v"(v[6][0]), "v"(v[7][0]) : "memory");
#pragma unroll
        for (int k = 0; k < 8; ++k) { u32x2v o; o[0] = pk2(v[k][0], v[k][1]); o[1] = pk2(v[k][2], v[k][3]); __builtin_nontemporal_store(o, d2 + i + k * stride); }
    }
    for (; i < n4; i += stride) {
        const f32x4v v = __builtin_nontemporal_load(s4 + i);
        u32x2v o; o[0] = pk2(v[0], v[1]); o[1] = pk2(v[2], v[3]);
        __builtin_nontemporal_store(o, d2 + i);
    }
}
__device__ __forceinline__ void phase_prep(const Params& p, int bid, int nb) {
    const int lane = tid_opaque() & 63, wave = tid_opaque() >> 6;
    if (bid == 0 && tid_opaque() < 64) ((int*)(p.ws + WS_CTL))[tid_opaque()] = 0;
    if (bid >= nb - 64) {
        const int kind = (bid - (nb - 64)) >> 5, kb = (bid - (nb - 64)) & 31, tid = tid_opaque();
        const float* pe = p.in[kind ? 11 : 8];
        const float* w1 = p.in[kind ? 12 : 9];
        __shared__ float cvp[256];
        const int e = tid & 63, part = tid >> 6;
        float s = 0.f;
#pragma unroll
        for (int i = 0; i < 16; ++i) { const int k = kb * 64 + part * 16 + i; s += pe[k] * w1[(size_t)k * 64 + e]; }
        cvp[tid] = s;
        __syncthreads();
        if (tid < 64) ((float*)(p.ws + WS_CTL + 1024))[(kind * 32 + kb) * 64 + tid] = (cvp[tid] + cvp[64 + tid]) + (cvp[128 + tid] + cvp[192 + tid]);
    }
    {
        const float* src_ = p.in[2];
        bf16_t* dst_ = (bf16_t*)(p.ws + WB_IN);
        constexpr int G8 = DIN / 8;
        for (size_t i = (size_t)bid * NT + tid_opaque(); i < (size_t)D * G8; i += (size_t)nb * NT) {
            const int k = (int)(i / G8), nc = (int)(i % G8) * 8;
            int oc;
            if (nc < 1280) oc = nc; else if (nc < 2816) oc = nc + 24; else if (nc < 3072) oc = nc + 24; else if (nc < 5120) oc = nc + 64;
            else if (nc < 5152) oc = nc - 5120 + 3096; else if (nc < 5176) oc = nc - 5152 + 1280; else oc = nc - 5176 + 3128;
            const float4 u = *(const float4*)(src_ + (size_t)k * DIN + oc), v = *(const float4*)(src_ + (size_t)k * DIN + oc + 4);
            uint4 o; o.x = pk2(u.x, u.y); o.y = pk2(u.z, u.w); o.z = pk2(v.x, v.y); o.w = pk2(v.z, v.w);
            *(uint4*)(dst_ + (size_t)k * DIN + nc) = o;
        }
    }
    cvt_weights(p.in[14], (bf16_t*)(p.ws + WB_A), (size_t)512 * D, bid, nb);
    cvt_weights(p.in[15], (bf16_t*)(p.ws + WB_B), (size_t)512 * D, bid, nb);
    cvt_weights(p.in[16], (bf16_t*)(p.ws + WB_OUT), (size_t)D * D, bid, nb);
    cvt_weights(p.in[26], (bf16_t*)(p.ws + WB_PLE), (size_t)256 * D, bid, nb);
    cvt_weights(p.in[1], (bf16_t*)(p.ws + WS_PB), (size_t)S * 256, bid, nb);
    cvt_weights(p.in[9], (bf16_t*)(p.ws + WB_CK1), (size_t)2048 * 64, bid, nb);
    cvt_weights(p.in[12], (bf16_t*)(p.ws + WB_CV1), (size_t)2048 * 64, bid, nb);
    const float* x = p.in[0];
    bf16_t* hb = (bf16_t*)(p.ws + WS_HB);
    float4 ggm[4];
#pragma unroll
    for (int j = 0; j < 4; ++j) ggm[j] = ((const float4*)p.in[3])[lane + 64 * j];
    for (int t = bid * 4 + wave; t < S; t += nb * 4) {
        const float4* xr = (const float4*)(x + (size_t)t * D);
        float4 v[4];
        float ss = 0.f;
#pragma unroll
        for (int j = 0; j < 4; ++j) { v[j] = xr[lane + 64 * j]; ss += v[j].x * v[j].x + v[j].y * v[j].y + v[j].z * v[j].z + v[j].w * v[j].w; }
        ss = wave_sum(ss);
        const float rstd = rsqrtf(ss * (1.f / D) + EPS);
#pragma unroll
        for (int j = 0; j < 4; ++j) {
            const float4 gg = ggm[j];
            uint2 o;
            o.x = pk2(v[j].x * rstd * gg.x, v[j].y * rstd * gg.y);
            o.y = pk2(v[j].z * rstd * gg.z, v[j].w * rstd * gg.w);
            ((uint2*)(hb + (size_t)t * D))[lane + 64 * j] = o;
        }
    }
}

__device__ __forceinline__ void phase_inproj(const Params& p, int bid, int nb, unsigned char* smem) {
    const int g2tid = tid_opaque();
    const bf16_t* hb = (const bf16_t*)(p.ws + WS_HB);
    const int lane = tid_opaque() & 63, fr = lane & 15;
    constexpr int NTN = (DIN + 127) / 128;
    for (int w = bid; w < 128 * NTN; w += nb) {
        const int mt = w % 128, nt = w / 128;
        const int m0 = mt * 128, n0 = nt * 128;
        const int ncols = (DIN - n0) < 128 ? (DIN - n0) : 128;
        f32x4 acc[4][4];
        gemm2<false, false>(hb, D, nullptr, m0, 128, (const bf16_t*)(p.ws + WB_IN), DIN, n0, ncols, D, smem, acc);
        const int cid = __builtin_amdgcn_readfirstlane((n0 >> 6) + ((tid_opaque() >> 6) & 1));
        if (cid > 80) continue;
        int kind; bf16_t* dst; unsigned char* dst8 = nullptr; int ld; const float* gain = nullptr; float scale = 1.f;
        if (cid < 8) { kind = 0; dst = (bf16_t*)(p.ws + WS_QNB) + cid * 64; ld = 512; gain = p.in[4]; scale = 0.125f * LOG2E; }
        else if (cid < 20) {
            const int j = cid - 8, kd = j >> 1, g = j & 1;
            ld = 64; kind = (kd == 2 || kd == 4) ? 0 : 1; gain = p.in[5];
            const size_t base = kd == 0 ? WS_KCR : kd == 1 ? WS_VCR : kd == 2 ? WS_KSLB : kd == 3 ? WS_VSLB : kd == 4 ? WS_KWNB : WS_VWNB;
            dst = (bf16_t*)(p.ws + base) + (size_t)g * S * 64;
        }
        else if (cid < 28) { kind = 0; dst = (bf16_t*)(p.ws + WS_DQB) + (cid - 20) * 64; ld = 512; gain = p.in[6]; scale = 0.125f * LOG2E; }
        else if (cid < 36) { kind = 0; dst = nullptr; dst8 = p.ws + WS_DKB + (size_t)(cid - 28) * S * 128; ld = 128; gain = p.in[7]; }
        else if (cid < 44) { kind = 1; dst = nullptr; dst8 = p.ws + WS_DKB + (size_t)(cid - 36) * S * 128 + 64; ld = 128; }
        else if (cid < 48) { kind = 1; dst = (bf16_t*)(p.ws + WS_IQB) + (cid - 44) * 64; ld = 256; scale = 0.17677669529663687f; }
        else if (cid < 64) { kind = 2; dst = (bf16_t*)(p.ws + WS_SGA) + (cid - 48) * 64; ld = D; }
        else if (cid < 80) { kind = 2; dst = (bf16_t*)(p.ws + WS_SGB) + (cid - 64) * 64; ld = D; }
        else { kind = 3; dst = nullptr; ld = 0; }
        if (kind == 0) {
            float gv[4];
#pragma unroll
            for (int j = 0; j < 4; ++j) gv[j] = gain[j * 16 + fr] * scale;
#pragma unroll
            for (int i = 0; i < 4; ++i) {
                float rstd[4];
#pragma unroll
                for (int r = 0; r < 4; ++r) {
                    float ss = acc[i][0][r] * acc[i][0][r] + acc[i][1][r] * acc[i][1][r] + acc[i][2][r] * acc[i][2][r] + acc[i][3][r] * acc[i][3][r];
                    ss += dppf<0xB1>(ss); ss += dppf<0x4E>(ss); ss += dppf<0x141>(ss); ss += dppf<0x140>(ss);
                    rstd[r] = rsqrtf(ss * (1.f / 64.f) + EPS);
                }
                if (dst8) {
                    unsigned char* dr8 = dst8 + (size_t)(m0 + G2_ROW(i, 0)) * ld + fr;
#pragma unroll
                    for (int j = 0; j < 4; ++j)
                        store_fp8_frag(dr8 + j * 16, ld, acc[i][j][0] * rstd[0] * gv[j], acc[i][j][1] * rstd[1] * gv[j], acc[i][j][2] * rstd[2] * gv[j],
                                       acc[i][j][3] * rstd[3] * gv[j], lane);
                } else {
                    bf16_t* dr = dst + (size_t)(m0 + G2_ROW(i, 0)) * ld + fr;
#pragma unroll
                    for (int j = 0; j < 4; ++j)
                        store_bf16_frag(dr + j * 16, ld, acc[i][j][0] * rstd[0] * gv[j], acc[i][j][1] * rstd[1] * gv[j], acc[i][j][2] * rstd[2] * gv[j],
                                        acc[i][j][3] * rstd[3] * gv[j], lane);
                }
            }
        } else if (kind == 1 || kind == 2) {
#pragma unroll
            for (int i = 0; i < 4; ++i) {
                if (dst8) {
                    unsigned char* dr8 = dst8 + (size_t)(m0 + G2_ROW(i, 0)) * ld + fr;
#pragma unroll
                    for (int j = 0; j < 4; ++j) store_fp8_frag(dr8 + j * 16, ld, acc[i][j][0], acc[i][j][1], acc[i][j][2], acc[i][j][3], lane);
                } else {
                    bf16_t* dr = dst + (size_t)(m0 + G2_ROW(i, 0)) * ld + fr;
#pragma unroll
                    for (int j = 0; j < 4; ++j) {
                        float v[4];
#pragma unroll
                        for (int r = 0; r < 4; ++r) v[r] = kind == 2 ? sigmoidf_(acc[i][j][r]) : acc[i][j][r] * scale;
                        store_bf16_frag(dr + j * 16, ld, v[0], v[1], v[2], v[3], lane);
                    }
                }
            }
        } else {
            bf16_t* ikb = (bf16_t*)(p.ws + WS_IKB);
            float* gt = (float*)(p.ws + WS_GT);
            float* iws = (float*)(p.ws + WS_IWS);
#pragma unroll
            for (int i = 0; i < 4; ++i) {
                bf16_t* ir = ikb + (size_t)(m0 + G2_ROW(i, 0)) * 32 + fr;
                store_bf16_frag(ir, 32, acc[i][0][0], acc[i][0][1], acc[i][0][2], acc[i][0][3], lane);
                store_bf16_frag(ir + 16, 32, acc[i][1][0], acc[i][1][1], acc[i][1][2], acc[i][1][3], lane);
#pragma unroll
                for (int r = 0; r < 4; ++r) {
                    const size_t t = (size_t)(m0 + G2_ROW(i, r));
                    gt[t * 32 + fr] = sigmoidf_(acc[i][2][r]);
                    if (fr < 8) gt[t * 32 + 16 + fr] = sigmoidf_(acc[i][3][r]);
                    else iws[t * 8 + fr - 8] = acc[i][3][r] * 0.35355339059327373f;
                }
            }
        }
    }
}

__device__ __forceinline__ float rms64(float v) { return rsqrtf(wave_sum(v * v) * (1.f / 64.f) + EPS); }

__device__ __forceinline__ void phase_compress(const Params& p, int bid, int nb, unsigned char* smem) {
    const int g2tid = tid_opaque();
    const int tid = tid_opaque(), lane = tid & 63, wave = tid >> 6;
    float* cvec = (float*)(smem + 36864);
    float* hid = (float*)(smem + 36864 + 256);
    bf16_t* pw = (bf16_t*)(p.ws + WS_PW);
    for (int w = bid; w < 32 + 128 * 8; w += (bid < 32 ? 32 + 128 * 8 : nb - 32)) {
        const bool is_c = w < 32;
        const int kind = w >> 4, g = (w >> 3) & 1;
        const int w2_ = w - 32;
        const int m0 = is_c ? (w & 7) * 128 : (w2_ % 128) * 128;
        const int n0 = is_c ? 0 : (w2_ / 128) * 128;
        const int mrows = is_c ? ((NCMP - m0) < 128 ? (NCMP - m0) : 128) : 128;
        const bf16_t* Ap = is_c ? (const bf16_t*)(p.ws + (kind ? WS_VCR : WS_KCR)) + (size_t)g * S * 64 : (const bf16_t*)(p.ws + WS_PB);
        const bf16_t* Bp = is_c ? (const bf16_t*)(p.ws + (kind ? WB_CV1 : WB_CK1)) : (const bf16_t*)(p.ws + WB_PLE);
        f32x4 acc[4][4];
        gemm2<false, false>(Ap, is_c ? 16 * 64 : 256, nullptr, m0, mrows, Bp, is_c ? 64 : D, n0, is_c ? 64 : 128, is_c ? 2048 : 256, smem, acc);
        if (!is_c) {
#pragma unroll
            for (int i = 0; i < 4; ++i) {
                bf16_t* pr = pw + (size_t)(m0 + G2_ROW(i, 0)) * D + n0 + G2_COL(0);
#pragma unroll
                for (int j = 0; j < 4; ++j) store_bf16_frag(pr + j * 16, D, acc[i][j][0], acc[i][j][1], acc[i][j][2], acc[i][j][3], lane);
            }
            continue;
        }
        const float* w2 = p.in[kind ? 13 : 10];
        __syncthreads();
        if (tid < 64) {
            const float* cp = (const float*)(p.ws + WS_CTL + 1024) + kind * 32 * 64 + tid;
            float s = 0.f;
#pragma unroll
            for (int b = 0; b < 32; ++b) s += cp[b * 64];
            cvec[tid] = s;
        }
        __syncthreads();
        if ((wave & 1) == 0) {
#pragma unroll
            for (int i = 0; i < 4; ++i)
#pragma unroll
                for (int j = 0; j < 4; ++j)
#pragma unroll
                    for (int r = 0; r < 4; ++r) {
                        const int row = G2_ROW(i, r), col = j * 16 + (lane & 15);
                        const float a = acc[i][j][r] + cvec[col];
                        hid[row * 65 + col] = a * sigmoidf_(a);
                    }
        }
        __syncthreads();
        const float gkn = p.in[5][lane];
        float w2r[64];
#pragma unroll
        for (int e = 0; e < 64; ++e) w2r[e] = w2[e * 64 + lane];
#pragma unroll 1
        for (int row = wave; row < mrows; row += 4) {
            float o = 0.f;
#pragma unroll
            for (int e = 0; e < 64; ++e) o += hid[row * 65 + e] * w2r[e];
            if (kind == 0) o = o * rms64(o) * gkn;
            ((bf16_t*)(p.ws + (kind ? WS_VCB : WS_KCB)))[((size_t)g * 1024 + m0 + row) * 64 + lane] = (bf16_t)f2bf(o);
        }
        __syncthreads();
    }
    if (bid == nb - 1) {
        if (tid < 128) ((bf16_t*)(p.ws + WS_KCB))[((size_t)(tid >> 6) * 1024 + 1023) * 64 + (tid & 63)] = 0;
        else ((bf16_t*)(p.ws + WS_VCB))[((size_t)((tid - 128) >> 6) * 1024 + 1023) * 64 + (tid & 63)] = 0;
    }
}

constexpr int KSTR = 72;
constexpr int NSA_KT = 0;
constexpr int NSA_VT = NSA_KT + 32 * KSTR * 2;
constexpr int NSA_WV = NSA_VT + 32 * KSTR * 2;
constexpr int NSA_IMP = NSA_WV + 4 * 2 * 32 * KSTR * 2;
constexpr int NSA_LUT = NSA_IMP + 16 * 260 * 4;
constexpr int NSA_SEL = NSA_LUT + 4 * 128 * 4;
constexpr int NSA_STP = NSA_SEL + 16 * 16 * 4;
constexpr int NSA_END = NSA_STP + 4 * 128 * 4;
static_assert(NSA_END <= SMEM_BYTES, "nsa lds");

__device__ __forceinline__ f32x4 mfma16(bf16x8 a, bf16x8 b, f32x4 c) { return __builtin_amdgcn_mfma_f32_16x16x32_bf16(a, b, c, 0, 0, 0); }
__device__ __forceinline__ bf16x8 pack_p(const f32x4& p1, const f32x4& p2) {
    const unsigned a = pk2h(p1[0], p1[1]), b = pk2h(p1[2], p1[3]), c = pk2h(p2[0], p2[1]), d = pk2h(p2[2], p2[3]);
    return __builtin_bit_cast(bf16x8, make_uint4(a, b, c, d));
}
__device__ __forceinline__ void pv_step(f32x4 (&o)[4], const bf16_t* vt, bf16x8 pb, int fq, int fr) {
    const bf16_t* base = vt + (4 * fq + (fr >> 2)) * KSTR + 4 * (fr & 3);
#pragma unroll
    for (int dt = 0; dt < 4; ++dt) {
        const s16x4 lo4 = lds_tr16(base + dt * 16), hi4 = lds_tr16(base + 16 * KSTR + dt * 16);
        const bf16x8 va = (bf16x8){lo4[0], lo4[1], lo4[2], lo4[3], hi4[0], hi4[1], hi4[2], hi4[3]};
        o[dt] = mfma16(va, pb, o[dt]);
    }
}
__device__ __forceinline__ float quad_sum(float v) {
    v += dppf<0xB1>(v);
    v += dppf<0x4E>(v);
    return v;
}

__device__ __forceinline__ void nsa_tile(const Params& p, int tt, int g, unsigned char* smem) {
    const int tid = tid_opaque(), lane = tid & 63, wave = tid >> 6, fr = lane & 15, fq = lane >> 4;
    bf16_t* kt = (bf16_t*)(smem + NSA_KT);
    bf16_t* vt = (bf16_t*)(smem + NSA_VT);
    bf16_t* wv = (bf16_t*)(smem + NSA_WV) + wave * 2 * 32 * KSTR;
    float* imp = (float*)(smem + NSA_IMP);
    float* lut = (float*)(smem + NSA_LUT);
    int* sel = (int*)(smem + NSA_SEL);
    const bf16_t* qnb = (const bf16_t*)(p.ws + WS_QNB);
    const bf16_t* kslb = (const bf16_t*)(p.ws + WS_KSLB) + (size_t)g * S * 64;
    const bf16_t* vslb = (const bf16_t*)(p.ws + WS_VSLB) + (size_t)g * S * 64;
    const bf16_t* kwnb = (const bf16_t*)(p.ws + WS_KWNB) + (size_t)g * S * 64;
    const bf16_t* vwnb = (const bf16_t*)(p.ws + WS_VWNB) + (size_t)g * S * 64;
    const bf16_t* kcb = (const bf16_t*)(p.ws + WS_KCB) + (size_t)g * 1024 * 64;
    const bf16_t* vcb = (const bf16_t*)(p.ws + WS_VCB) + (size_t)g * 1024 * 64;
    const float* gt = (const float*)(p.ws + WS_GT);
    const float* relb = p.in[17];
    const int t0 = tt * 16;
    const int tl = 4 * wave + (fr >> 2);
    const int tok = t0 + tl;
    const int hl = fr & 3, head = g * 4 + hl;
    __syncthreads();
    for (int i = tid; i < 512; i += NT) { const int hh = i >> 7, n = i & 127; lut[i] = relb[bucket_of(n) * 16 + g * 4 + hh] * LOG2E; }
    for (int i = tid; i < 16 * 260; i += NT) imp[i] = 0.f;
    float U2;
    {
        const float mq = wave_max(fabsf(p.in[4][lane])), mk = wave_max(fabsf(p.in[5][lane]));
        float mb = 0.f;
#pragma unroll
        for (int k = 0; k < 4; ++k) { const int e = lane + 64 * k; mb = fmaxf(mb, fabsf(relb[(e >> 3) * 16 + (e & 7)])); }
        mb = wave_max(mb);
        U2 = (8.f * mq * mk + mb) * LOG2E;
    }
    bf16x8 qf[2];
#pragma unroll
    for (int kh = 0; kh < 2; ++kh) qf[kh] = *(const bf16x8*)(qnb + (size_t)tok * 512 + head * 64 + kh * 32 + fq * 8);
    __syncthreads();
    const float* lutp = lut + hl * 128;
    const float cfar = lutp[127] - U2;
    const f32x4 zero4 = (f32x4){0.f, 0.f, 0.f, 0.f};
    f32x4 outacc[4];
#pragma unroll
    for (int dt = 0; dt < 4; ++dt) outacc[dt] = zero4;
    const float g0 = gt[(size_t)tok * 32 + head * 3 + 0], g1 = gt[(size_t)tok * 32 + head * 3 + 1], g2 = gt[(size_t)tok * 32 + head * 3 + 2];
    const int srow = tid >> 3, sch = tid & 7;

    bf16_t* ktb = (bf16_t*)(smem + NSA_WV);
    bf16_t* vtb = ktb + 2 * 64 * KSTR;
#define NSA_QK(KT_)                                                                                         \
        f32x4 s1 = zero4, s2 = zero4;                                                                       \
        _Pragma("unroll") for (int kh = 0; kh < 2; ++kh) {                                                  \
            const bf16x8 k1 = *(const bf16x8*)((KT_) + fr * KSTR + kh * 32 + fq * 8);                       \
            const bf16x8 k2 = *(const bf16x8*)((KT_) + (16 + fr) * KSTR + kh * 32 + fq * 8);                \
            s1 = mfma16(k1, qf[kh], s1);                                                                    \
            s2 = mfma16(k2, qf[kh], s2);                                                                    \
        }
    {
        int ks0 = (t0 - 511) & ~63; ks0 = ks0 < 0 ? 0 : ks0;
        const int nsteps = (t0 + 16 - ks0 + 63) >> 6;
        f32x4 o[4];
#pragma unroll
        for (int dt = 0; dt < 4; ++dt) o[dt] = zero4;
        float lsum = 0.f;
#define WIN_ROW(r_) ((r_) < S ? (r_) : S - 1)
        uint4 kr0 = *(const uint4*)(kwnb + (size_t)WIN_ROW(ks0 + srow) * 64 + sch * 8);
        uint4 kr1 = *(const uint4*)(kwnb + (size_t)WIN_ROW(ks0 + 32 + srow) * 64 + sch * 8);
        uint4 vr0 = *(const uint4*)(vwnb + (size_t)WIN_ROW(ks0 + srow) * 64 + sch * 8);
        uint4 vr1 = *(const uint4*)(vwnb + (size_t)WIN_ROW(ks0 + 32 + srow) * 64 + sch * 8);
#pragma unroll 1
        for (int st = 0; st < nsteps; ++st) {
            const int ksb = ks0 + st * 64;
            bf16_t* kt_ = ktb + (st & 1) * 64 * KSTR;
            bf16_t* vt_ = vtb + (st & 1) * 64 * KSTR;
            *(uint4*)(kt_ + srow * KSTR + sch * 8) = kr0; *(uint4*)(kt_ + (32 + srow) * KSTR + sch * 8) = kr1;
            *(uint4*)(vt_ + srow * KSTR + sch * 8) = vr0; *(uint4*)(vt_ + (32 + srow) * KSTR + sch * 8) = vr1;
            __syncthreads();
            if (st + 1 < nsteps) {
                kr0 = *(const uint4*)(kwnb + (size_t)WIN_ROW(ksb + 64 + srow) * 64 + sch * 8);
                kr1 = *(const uint4*)(kwnb + (size_t)WIN_ROW(ksb + 96 + srow) * 64 + sch * 8);
                vr0 = *(const uint4*)(vwnb + (size_t)WIN_ROW(ksb + 64 + srow) * 64 + sch * 8);
                vr1 = *(const uint4*)(vwnb + (size_t)WIN_ROW(ksb + 96 + srow) * 64 + sch * 8);
            }
#pragma unroll
            for (int hf = 0; hf < 2; ++hf) {
                const int ks = ksb + 32 * hf;
                if (ks > t0 + 15) continue;
                NSA_QK(kt_ + hf * 32 * KSTR)
                const bool far = (t0 + 4 * wave) - (ks + 31) >= 113;
                f32x4 p1, p2;
                if (far) {
#pragma unroll
                    for (int r = 0; r < 4; ++r) {
                        const int d1 = tok - (ks + 4 * fq + r), d2 = d1 - 16;
                        p1[r] = d1 < 512 ? __builtin_amdgcn_exp2f(s1[r] + cfar) : 0.f;
                        p2[r] = d2 < 512 ? __builtin_amdgcn_exp2f(s2[r] + cfar) : 0.f;
                        lsum += p1[r] + p2[r];
                    }
                } else {
#pragma unroll
                    for (int r = 0; r < 4; ++r) {
                        const int d1 = tok - (ks + 4 * fq + r), d2 = d1 - 16;
                        const float b1 = lutp[d1 < 0 ? 0 : (d1 > 127 ? 127 : d1)];
                        const float b2 = lutp[d2 < 0 ? 0 : (d2 > 127 ? 127 : d2)];
                        p1[r] = (d1 >= 0 && d1 < 512) ? __builtin_amdgcn_exp2f(s1[r] + b1 - U2) : 0.f;
                        p2[r] = (d2 >= 0 && d2 < 512) ? __builtin_amdgcn_exp2f(s2[r] + b2 - U2) : 0.f;
                        lsum += p1[r] + p2[r];
                    }
                }
                pv_step(o, vt_ + hf * 32 * KSTR, pack_p(p1, p2), fq, fr);
            }
        }
#undef WIN_ROW
        lsum = xadd32(xadd16(lsum));
        const float sc = lsum > 0.f ? g2 / lsum : 0.f;
#pragma unroll
        for (int dt = 0; dt < 4; ++dt)
#pragma unroll
            for (int r = 0; r < 4; ++r) outacc[dt][r] += sc * o[dt][r];
    }
    __syncthreads();

    {
        const int tlast = t0 + 15;
        const int cmax = (tlast >= 31) ? ((tlast - 31) >> 4) + 1 : 0;
        const int nsteps = (cmax + 63) >> 6;
        float inv_l = 0.f;
#pragma unroll 1
        for (int pass = 0; pass < 2; ++pass) {
            f32x4 o[4];
#pragma unroll
            for (int dt = 0; dt < 4; ++dt) o[dt] = zero4;
            float lsum = 0.f;
            uint4 kr0 = make_uint4(0, 0, 0, 0), kr1 = kr0, vr0 = kr0, vr1 = kr0;
            if (nsteps > 0) {
                kr0 = *(const uint4*)(kcb + (size_t)srow * 64 + sch * 8); kr1 = *(const uint4*)(kcb + (size_t)(32 + srow) * 64 + sch * 8);
                vr0 = *(const uint4*)(vcb + (size_t)srow * 64 + sch * 8); vr1 = *(const uint4*)(vcb + (size_t)(32 + srow) * 64 + sch * 8);
            }
#pragma unroll 1
            for (int st = 0; st < nsteps; ++st) {
                const int csb = st * 64;
                bf16_t* kt_ = ktb + (st & 1) * 64 * KSTR;
                bf16_t* vt_ = vtb + (st & 1) * 64 * KSTR;
                *(uint4*)(kt_ + srow * KSTR + sch * 8) = kr0; *(uint4*)(kt_ + (32 + srow) * KSTR + sch * 8) = kr1;
                *(uint4*)(vt_ + srow * KSTR + sch * 8) = vr0; *(uint4*)(vt_ + (32 + srow) * KSTR + sch * 8) = vr1;
                __syncthreads();
                if (st + 1 < nsteps) {
                    kr0 = *(const uint4*)(kcb + (size_t)(csb + 64 + srow) * 64 + sch * 8); kr1 = *(const uint4*)(kcb + (size_t)(csb + 96 + srow) * 64 + sch * 8);
                    vr0 = *(const uint4*)(vcb + (size_t)(csb + 64 + srow) * 64 + sch * 8); vr1 = *(const uint4*)(vcb + (size_t)(csb + 96 + srow) * 64 + sch * 8);
                }
#pragma unroll
                for (int hf = 0; hf < 2; ++hf) {
                    const int cs = csb + 32 * hf;
                    if (cs >= cmax) continue;
                    NSA_QK(kt_ + hf * 32 * KSTR)
                    const bool far = (t0 + 4 * wave) - (16 * (cs + 31) + 31) >= 113;
                    f32x4 p1, p2;
                    if (far) {
#pragma unroll
                        for (int r = 0; r < 4; ++r) {
                            p1[r] = __builtin_amdgcn_exp2f(s1[r] + cfar);
                            p2[r] = __builtin_amdgcn_exp2f(s2[r] + cfar);
                            lsum += p1[r] + p2[r];
                        }
                    } else {
#pragma unroll
                        for (int r = 0; r < 4; ++r) {
                            const int d1 = tok - (16 * (cs + 4 * fq + r) + 31), d2 = d1 - 256;
                            const float b1 = lutp[d1 < 0 ? 0 : (d1 > 127 ? 127 : d1)];
                            const float b2 = lutp[d2 < 0 ? 0 : (d2 > 127 ? 127 : d2)];
                            p1[r] = (d1 >= 0) ? __builtin_amdgcn_exp2f(s1[r] + b1 - U2) : 0.f;
                            p2[r] = (d2 >= 0) ? __builtin_amdgcn_exp2f(s2[r] + b2 - U2) : 0.f;
                            lsum += p1[r] + p2[r];
                        }
                    }
                    if (pass == 1) {
#pragma unroll
                        for (int r = 0; r < 4; ++r) { p1[r] *= inv_l; p2[r] *= inv_l; }
                        f32x4 h1, h2;
#pragma unroll
                        for (int r = 0; r < 4; ++r) { h1[r] = quad_sum(p1[r]); h2[r] = quad_sum(p2[r]); }
                        if (hl == 0) {
                            float* ir = imp + tl * 260 + (cs >> 2) + fq;
                            atomicAdd(ir, h1[0] + h1[1] + h1[2] + 0.5f * h1[3]);
                            atomicAdd(ir + 1, 0.5f * h1[3]);
                            atomicAdd(ir + 4, h2[0] + h2[1] + h2[2] + 0.5f * h2[3]);
                            atomicAdd(ir + 5, 0.5f * h2[3]);
                        }
                        pv_step(o, vt_ + hf * 32 * KSTR, pack_p(p1, p2), fq, fr);
                    }
                }
            }
            __syncthreads();
            if (pass == 0) {
                lsum = xadd32(xadd16(lsum));
                inv_l = lsum > 0.f ? 1.f / lsum : 0.f;
            } else {
#pragma unroll
                for (int dt = 0; dt < 4; ++dt)
#pragma unroll
                    for (int r = 0; r < 4; ++r) outacc[dt][r] += g0 * o[dt][r];
            }
        }
    }
#undef NSA_QK
    __syncthreads();

    {
        const int tq = lane >> 4, sub = lane & 15;
        const int tli = 4 * wave + tq, cur = (t0 + 4 * wave) >> 6;
        int* sl = sel + tli * 16;
        const int nf = 1 + (cur - 1 >= 1 ? 1 : 0) + (cur >= 1 ? 1 : 0);
        const int ncand = cur - 2 > 0 ? cur - 2 : 0;
        int need = 16 - nf; need = need < ncand ? need : ncand;
        if (sub == 0) {
            sl[0] = 0; int c_ = 1;
            if (cur - 1 >= 1) sl[c_++] = cur - 1;
            if (cur >= 1) sl[c_++] = cur;
            for (int k = c_; k < 16; ++k) sl[k] = -1;
        }
        unsigned key[16];
#pragma unroll
        for (int k = 0; k < 16; ++k) {
            const int n = sub + 16 * k;
            const bool c = (n >= 1) && (n <= cur - 2);
            key[k] = c ? __builtin_bit_cast(unsigned, imp[tli * 260 + n]) + 1u : 0u;
        }
#pragma unroll 1
        for (int rd = 0; rd < need; ++rd) {
            unsigned bk = key[0]; int bn = sub;
#pragma unroll
            for (int k = 1; k < 16; ++k) { const bool g = key[k] > bk; bk = g ? key[k] : bk; bn = g ? sub + 16 * k : bn; }
#define SEL_STEP(CTRL) { const unsigned ok = (unsigned)dppi<CTRL>((int)bk); const int on = dppi<CTRL>(bn); \
                         const bool g = (ok > bk) || (ok == bk && on < bn); bk = g ? ok : bk; bn = g ? on : bn; }
            SEL_STEP(0xB1) SEL_STEP(0x4E) SEL_STEP(0x141) SEL_STEP(0x140)
#undef SEL_STEP
#pragma unroll
            for (int k = 0; k < 16; ++k) key[k] = (sub + 16 * k == bn) ? 0u : key[k];
            if (sub == 0) sl[nf + rd] = bn;
        }
    }
    __syncthreads();

    {
        int* stp = (int*)(smem + NSA_STP) + wave * 128;
        int nst;
        {
            const int tq = lane >> 4, j = lane & 15;
            const int cur_ = (t0 + 4 * wave) >> 6;
            const int nf_ = 1 + (cur_ - 1 >= 1 ? 1 : 0) + (cur_ >= 1 ? 1 : 0);
            const bool shared = j < nf_;
            const int tk_ = shared ? t0 + 4 * wave + 3 : t0 + 4 * wave + tq;
            const int b = (shared && tq != 0) ? -1 : sel[(4 * wave + tq) * 16 + j];
            const int tqc = shared ? 4 : tq;
            const bool c1 = (b >= 0) && (b * 64 <= tk_), c2 = (b >= 0) && (b * 64 + 32 <= tk_);
            const unsigned long long m1 = __ballot(c1), m2 = __ballot(c2);
            const unsigned long long lt = (1ull << lane) - 1ull;
            const int pos = __builtin_popcountll(m1 & lt) + __builtin_popcountll(m2 & lt);
            if (c1) stp[pos] = (b * 64) | (tqc << 20);
            if (c2) stp[pos + 1] = (b * 64 + 32) | (tqc << 20);
            nst = __builtin_popcountll(m1) + __builtin_popcountll(m2);
        }
        asm volatile("" ::: "memory");
        uint2 oacc_pk[4];
#pragma unroll
        for (int dt = 0; dt < 4; ++dt) { oacc_pk[dt].x = pk2(outacc[dt][0], outacc[dt][1]); oacc_pk[dt].y = pk2(outacc[dt][2], outacc[dt][3]); }
        f32x4 o[4];
#pragma unroll
        for (int dt = 0; dt < 4; ++dt) o[dt] = zero4;
        float lsum = 0.f;
        const int r8 = lane >> 3, c8 = lane & 7;
        bf16_t* slot0 = wv;
        bf16_t* slot1 = wv + 32 * KSTR;
        bf16_t* kslot = (bf16_t*)(smem + NSA_IMP) + wave * 32 * 64;
        uint4 ka0, ka1, ka2, ka3, kb0, kb1, kb2, kb3;
        uint4 va0, va1, va2, va3;
#define SLC_STEP(i_) __builtin_amdgcn_readfirstlane(stp[(i_) < nst ? (i_) : nst - 1])
#define SLC_KLOAD(K_, w_)                                                                                           \
        { const uint4* kp_ = (const uint4*)(kslb + (size_t)(((w_) & 0xFFFFF) + r8) * 64 + c8 * 8);                      \
          K_##0 = kp_[0]; K_##1 = kp_[64]; K_##2 = kp_[128]; K_##3 = kp_[192]; }
#define SLC_VLOAD(V_, w_)                                                                                           \
        { const uint4* vs_ = (const uint4*)(vslb + (size_t)(((w_) & 0xFFFFF) + r8) * 64 + c8 * 8);                      \
          V_##0 = vs_[0]; V_##1 = vs_[64]; V_##2 = vs_[128]; V_##3 = vs_[192]; }
#define SLC_VSTORE(V_, slot_)                                                                                       \
        { bf16_t* vd_ = (slot_) + r8 * KSTR + c8 * 8;                                                               \
          *(uint4*)(vd_) = V_##0; *(uint4*)(vd_ + 8 * KSTR) = V_##1; *(uint4*)(vd_ + 16 * KSTR) = V_##2; *(uint4*)(vd_ + 24 * KSTR) = V_##3; }
#define SLC_KSTORE(K_)                                                                                              \
        { bf16_t* kd_ = kslot + r8 * 64 + ((c8 ^ r8) * 8);                                                          \
          *(uint4*)(kd_) = K_##0; *(uint4*)(kd_ + 8 * 64) = K_##1; *(uint4*)(kd_ + 16 * 64) = K_##2; *(uint4*)(kd_ + 24 * 64) = K_##3; }
#define SLC_STAGE(s_, K_, VW_, slotr_, slotw_)                                                                      \
        {                                                                                                           \
            const int wcur = SLC_STEP(s_), wk = SLC_STEP((s_) + 2);                                                 \
            SLC_KSTORE(K_)                                                            \
            SLC_VSTORE(VW_, slotw_)                                                      \
            asm volatile("" ::: "memory");                                                                          \
            SLC_VLOAD(VW_, wk)                                                                     \
            SLC_KLOAD(K_, wk)                                                                      \
              \
            bf16x8 vf_[4];                                                                                          \
            {                                                                                                       \
                const bf16_t* vb_ = (slotr_) + (4 * fq + (fr >> 2)) * KSTR + 4 * (fr & 3);                          \
                _Pragma("unroll") for (int dt = 0; dt < 4; ++dt) {                                                  \
                    const s16x4 lo4 = lds_tr16(vb_ + dt * 16), hi4 = lds_tr16(vb_ + 16 * KSTR + dt * 16);           \
                    vf_[dt] = (bf16x8){lo4[0], lo4[1], lo4[2], lo4[3], hi4[0], hi4[1], hi4[2], hi4[3]};             \
                }                                                                                                   \
            }                                                                                                       \
            f32x4 s1 = zero4, s2 = zero4;                                                                           \
            _Pragma("unroll") for (int kh = 0; kh < 2; ++kh) {                                                      \
                const bf16x8 k1 = *(const bf16x8*)(kslot + fr * 64 + (((kh * 4 + fq) ^ (fr & 7)) * 8));             \
                const bf16x8 k2 = *(const bf16x8*)(kslot + (16 + fr) * 64 + (((kh * 4 + fq) ^ (fr & 7)) * 8));      \
                s1 = mfma16(k1, qf[kh], s1); s2 = mfma16(k2, qf[kh], s2);                                           \
            }                                                                                                       \
            const int ks = wcur & 0xFFFFF, tq = wcur >> 20;                                                         \
            const bool mine = (tq == 4) || ((fr >> 2) == tq);                                                       \
            const bool far = (t0 + 4 * wave + (tq == 4 ? 0 : tq)) - (ks + 31) >= 113;                               \
            f32x4 p1, p2;                                                                                           \
            if (far) {                                                                                              \
                _Pragma("unroll") for (int r = 0; r < 4; ++r) {                                                     \
                    p1[r] = mine ? __builtin_amdgcn_exp2f(s1[r] + cfar) : 0.f;                                      \
                    p2[r] = mine ? __builtin_amdgcn_exp2f(s2[r] + cfar) : 0.f;                                      \
                    lsum += p1[r] + p2[r];                                                                          \
                }                                                                                                   \
            } else {                                                                                                \
                _Pragma("unroll") for (int r = 0; r < 4; ++r) {                                                     \
                    const int d1 = tok - (ks + 4 * fq + r), d2 = d1 - 16;                                           \
                    const float b1 = lutp[d1 < 0 ? 0 : (d1 > 127 ? 127 : d1)];                                      \
                    const float b2 = lutp[d2 < 0 ? 0 : (d2 > 127 ? 127 : d2)];                                      \
                    p1[r] = (mine && d1 >= 0) ? __builtin_amdgcn_exp2f(s1[r] + b1 - U2) : 0.f;                      \
                    p2[r] = (mine && d2 >= 0) ? __builtin_amdgcn_exp2f(s2[r] + b2 - U2) : 0.f;                      \
                    lsum += p1[r] + p2[r];                                                                          \
                }                                                                                                   \
            }                                                                                                       \
            {                                                                                                       \
                const bf16x8 pb_ = pack_p(p1, p2);                                                                  \
                _Pragma("unroll") for (int dt = 0; dt < 4; ++dt) o[dt] = mfma16(vf_[dt], pb_, o[dt]);               \
            }                                                                                                       \
            asm volatile("" ::: "memory");                                                                          \
        }
        {
            const int w0 = SLC_STEP(0), w1 = SLC_STEP(1);
            SLC_VLOAD(va, w0)
            SLC_KLOAD(ka, w0)
            SLC_KLOAD(kb, w1)
            SLC_VSTORE(va, slot0)
            SLC_VLOAD(va, w1)
        }
#pragma unroll 1
        for (int s = 0; s < nst; s += 2) {
            SLC_STAGE(s, ka, va, slot0, slot1)
            if (s + 1 < nst) SLC_STAGE(s + 1, kb, va, slot1, slot0)
        }
#undef SLC_STEP
#undef SLC_KLOAD
#undef SLC_VLOAD
#undef SLC_VSTORE
#undef SLC_KSTORE
#undef SLC_STAGE
        lsum = xadd32(xadd16(lsum));
        const float sc = lsum > 0.f ? g1 / lsum : 0.f;
#pragma unroll
        for (int dt = 0; dt < 4; ++dt) {
            outacc[dt][0] = __builtin_bit_cast(float, oacc_pk[dt].x << 16) + sc * o[dt][0];
            outacc[dt][1] = __builtin_bit_cast(float, oacc_pk[dt].x & 0xffff0000u) + sc * o[dt][1];
            outacc[dt][2] = __builtin_bit_cast(float, oacc_pk[dt].y << 16) + sc * o[dt][2];
            outacc[dt][3] = __builtin_bit_cast(float, oacc_pk[dt].y & 0xffff0000u) + sc * o[dt][3];
        }
    }
    bf16_t* orow = (bf16_t*)(p.ws + WS_OA) + (size_t)tok * 512 + head * 64 + 4 * fq;
#pragma unroll
    for (int dt = 0; dt < 4; ++dt) {
        uint2 v; v.x = pk2(outacc[dt][0], outacc[dt][1]); v.y = pk2(outacc[dt][2], outacc[dt][3]);
        *(uint2*)(orow + dt * 16) = v;
    }
}

typedef float f32x16 __attribute__((ext_vector_type(16)));
constexpr int DSA_CK = 0;
constexpr int DSA_CI = DSA_CK + 16 * 512 * 4;
constexpr int DSA_LUT = DSA_CI + 16 * 512 * 2;
constexpr int DSA_END = DSA_LUT + 8 * 128 * 4;
static_assert(DSA_END <= SMEM_BYTES, "dsa lds");

__device__ __forceinline__ float relu_i(float x) { const int b = __builtin_bit_cast(int, x); return __builtin_bit_cast(float, b > 0 ? b : 0); }
__device__ __forceinline__ unsigned mono_key(float s) {
    const unsigned u = __builtin_bit_cast(unsigned, s + 0.0f);
    return (u & 0x80000000u) ? ~u : (u | 0x80000000u);
}
#define DSA_COUNT_GE(x_, out_) { int c_ = 0; _Pragma("unroll") for (int k = 0; k < 8; ++k) c_ += __builtin_popcountll(__ballot(kk[k] >= (x_))); out_ = c_; }
template <bool EXACT>
__device__ __forceinline__ int dsa_trim(unsigned* ck, unsigned short* ci, int n, int lane, unsigned L, unsigned& Lout) {
    constexpr int CAP = EXACT ? 256 : 320;
    unsigned kk[8]; unsigned ii[8];
#pragma unroll
    for (int k = 0; k < 8; ++k) { const int e = lane + 64 * k; kk[k] = e < n ? ck[e] : 0u; ii[k] = e < n ? (unsigned)ci[e] : 0xFFFFu; }
    unsigned mx = kk[0];
#pragma unroll
    for (int k = 1; k < 8; ++k) mx = kk[k] > mx ? kk[k] : mx;
    {
        int m = (int)(mx ^ 0x80000000u);
        int o;
        o = dppi<0xB1>(m); m = o > m ? o : m; o = dppi<0x4E>(m); m = o > m ? o : m; o = dppi<0x141>(m); m = o > m ? o : m; o = dppi<0x140>(m); m = o > m ? o : m;
        const int r0 = __builtin_amdgcn_readlane(m, 0), r1 = __builtin_amdgcn_readlane(m, 16), r2 = __builtin_amdgcn_readlane(m, 32), r3 = __builtin_amdgcn_readlane(m, 48);
        const int ra = r0 > r1 ? r0 : r1, rb = r2 > r3 ? r2 : r3;
        mx = (unsigned)(ra > rb ? ra : rb) ^ 0x80000000u;
    }
    unsigned lo = L + 1u, hi = mx + 1u;
    int clo = n;
#pragma unroll 1
    while (clo > CAP && hi - lo > 1u) {
        const unsigned mid = lo + ((hi - lo) >> 1);
        int c;
        DSA_COUNT_GE(mid, c)
        if (c >= 256) { lo = mid; clo = c; } else hi = mid;
    }
    unsigned X = 0xFFFFu;
    bool ties = false;
    if (clo > CAP) {
        int cgt = 0, ceq = 0;
#pragma unroll
        for (int k = 0; k < 8; ++k) { cgt += __builtin_popcountll(__ballot(kk[k] > lo)); ceq += __builtin_popcountll(__ballot(kk[k] == lo)); }
        const int need = 256 - cgt;
        if (ceq > need) {
            X = 0;
#pragma unroll 1
            for (int b = 15; b >= 0; --b) {
                const unsigned cand = X | (1u << b);
                int c = 0;
#pragma unroll
                for (int k = 0; k < 8; ++k) c += __builtin_popcountll(__ballot(kk[k] == lo && ii[k] < cand));
                if (c < need) X = cand;
            }
        }
        ties = true; clo = 256;
    }
    int base = 0;
    unsigned mn = 0xFFFFFFFFu;
    const unsigned long long lt = (1ull << lane) - 1ull;
#pragma unroll
    for (int k = 0; k < 8; ++k) {
        const bool keep = (kk[k] > lo) || (kk[k] == lo && ii[k] <= X);
        const unsigned long long m = __ballot(keep);
        if (keep) { const int pos = base + __builtin_popcountll(m & lt); ck[pos] = kk[k]; ci[pos] = (unsigned short)ii[k]; mn = kk[k] < mn ? kk[k] : mn; }
        base += __builtin_popcountll(m);
    }
    if (ties) Lout = lo;
    else if (clo == 256) {
        int m = (int)(mn ^ 0x80000000u);
        int o;
        o = dppi<0xB1>(m); m = o < m ? o : m; o = dppi<0x4E>(m); m = o < m ? o : m; o = dppi<0x141>(m); m = o < m ? o : m; o = dppi<0x140>(m); m = o < m ? o : m;
        const int r0 = __builtin_amdgcn_readlane(m, 0), r1 = __builtin_amdgcn_readlane(m, 16), r2 = __builtin_amdgcn_readlane(m, 32), r3 = __builtin_amdgcn_readlane(m, 48);
        const int ra = r0 < r1 ? r0 : r1, rb = r2 < r3 ? r2 : r3;
        Lout = (unsigned)(ra < rb ? ra : rb) ^ 0x80000000u;
    } else Lout = lo - 1u;
    return clo;
}

__device__ __forceinline__ void dsa_tile(const Params& p, int tt, unsigned char* smem) {
    const int tid = tid_opaque(), lane = tid & 63, wave = tid >> 6, col = lane & 31, hi = lane >> 5;
    unsigned* ckb = (unsigned*)(smem + DSA_CK);
    unsigned short* cib = (unsigned short*)(smem + DSA_CI);
    const bf16_t* iqb = (const bf16_t*)(p.ws + WS_IQB);
    const bf16_t* ikb = (const bf16_t*)(p.ws + WS_IKB);
    const float* iws = (const float*)(p.ws + WS_IWS);
    const int t0 = tt * 16;
    __syncthreads();
    const int tw = t0 + 4 * wave;
    bf16x8 af[2];
    {
        const int rho = col;
        const int tl_ = 2 * ((rho >> 2) & 1) + (rho >> 4), hd = 4 * ((rho >> 3) & 1) + (rho & 3);
#pragma unroll
        for (int ks = 0; ks < 2; ++ks) af[ks] = *(const bf16x8*)(iqb + (size_t)(tw + tl_) * 256 + hd * 32 + ks * 16 + hi * 8);
    }
    const int tokA = tw + 2 * hi, tokB = tokA + 1;
    float wA[8], wB[8];
#pragma unroll
    for (int h = 0; h < 8; ++h) { wA[h] = iws[(size_t)tokA * 8 + h]; wB[h] = iws[(size_t)tokB * 8 + h]; }
    unsigned* ckA = ckb + (4 * wave + 2 * hi) * 512;
    unsigned* ckB = ckA + 512;
    unsigned short* ciA = cib + (4 * wave + 2 * hi) * 512;
    unsigned short* ciB = ciA + 512;
    int cntA = 0, cntB = 0;
    unsigned LA = 0, LB = 0;
    const unsigned ltm = (1u << col) - 1u;
    const int nchunk = (tw + 4 + 31) >> 5;
    const f32x16 zero16 = {0.f, 0.f, 0.f, 0.f, 0.f, 0.f, 0.f, 0.f, 0.f, 0.f, 0.f, 0.f, 0.f, 0.f, 0.f, 0.f};
    bf16x8 nx0[4], nx1[4];
    const bf16_t* ikl = ikb + (size_t)col * 32 + hi * 8;
#pragma unroll
    for (int j = 0; j < 4; ++j) {
        const int cj = j < nchunk ? j : nchunk - 1;
        nx0[j] = *(const bf16x8*)(ikl + (size_t)cj * 1024); nx1[j] = *(const bf16x8*)(ikl + (size_t)cj * 1024 + 16);
    }
#pragma unroll 1
    for (int ch4 = 0; ch4 < nchunk; ch4 += 4) {
#pragma unroll
        for (int j = 0; j < 4; ++j) {
            const int ch = ch4 + j;
            const bf16x8 cu0 = nx0[j], cu1 = nx1[j];
            {
                int cj = ch + 4; cj = cj < nchunk ? cj : nchunk - 1;
                nx0[j] = *(const bf16x8*)(ikl + (size_t)cj * 1024); nx1[j] = *(const bf16x8*)(ikl + (size_t)cj * 1024 + 16);
            }
            if (ch < nchunk) {
                const int kidx = ch * 32 + col;
                f32x16 c = __builtin_amdgcn_mfma_f32_32x32x16_bf16(af[0], cu0, zero16, 0, 0, 0);
                c = __builtin_amdgcn_mfma_f32_32x32x16_bf16(af[1], cu1, c, 0, 0, 0);
                f32x2 aA = {0.f, 0.f}, aB = {0.f, 0.f};
#pragma unroll
                for (int k = 0; k < 4; ++k) {
                    aA += (f32x2){relu_i(c[2 * k]), relu_i(c[2 * k + 1])} * (f32x2){wA[2 * k], wA[2 * k + 1]};
                    aB += (f32x2){relu_i(c[8 + 2 * k]), relu_i(c[9 + 2 * k])} * (f32x2){wB[2 * k], wB[2 * k + 1]};
                }
                const float sA = aA[0] + aA[1], sB = aB[0] + aB[1];
                const unsigned keyA = mono_key(sA), keyB = mono_key(sB);
                const bool pA = (kidx <= tokA) && (keyA > LA), pB = (kidx <= tokB) && (keyB > LB);
                const unsigned long long mA = __ballot(pA), mB = __ballot(pB);
                const unsigned hA = hi ? (unsigned)(mA >> 32) : (unsigned)mA, hB = hi ? (unsigned)(mB >> 32) : (unsigned)mB;
                if (pA) { const int pos = cntA + __builtin_popcount(hA & ltm); ckA[pos] = keyA; ciA[pos] = (unsigned short)kidx; }
                if (pB) { const int pos = cntB + __builtin_popcount(hB & ltm); ckB[pos] = keyB; ciB[pos] = (unsigned short)kidx; }
                cntA += __builtin_popcount(hA); cntB += __builtin_popcount(hB);
            }
            if (!(j & 1)) continue;
        if (__any((cntA > 448) || (cntB > 448))) {
#pragma unroll 1
            for (int tq = 0; tq < 4; ++tq) {
                const int cn = __builtin_amdgcn_readlane((tq & 1) ? cntB : cntA, (tq >> 1) * 32);
                if (cn > 448) {
                    const unsigned Lc = (unsigned)__builtin_amdgcn_readlane((int)((tq & 1) ? LB : LA), (tq >> 1) * 32);
                    unsigned Ln;
                    const int nc = dsa_trim<false>(ckb + (4 * wave + tq) * 512, cib + (4 * wave + tq) * 512, cn, lane, Lc, Ln);
                    if (hi == (tq >> 1)) { if (tq & 1) { cntB = nc; LB = Ln; } else { cntA = nc; LA = Ln; } }
                }
            }
        }
    }
    }
#pragma unroll 1
    for (int tq = 0; tq < 4; ++tq) {
        const int cn = __builtin_amdgcn_readlane((tq & 1) ? cntB : cntA, (tq >> 1) * 32);
        if (cn > 256) {
            const unsigned Lc = (unsigned)__builtin_amdgcn_readlane((int)((tq & 1) ? LB : LA), (tq >> 1) * 32);
            unsigned Ln;
            (void)dsa_trim<true>(ckb + (4 * wave + tq) * 512, cib + (4 * wave + tq) * 512, cn, lane, Lc, Ln);
            if (hi == (tq >> 1)) { if (tq & 1) cntB = 256; else cntA = 256; }
        }
    }
    unsigned short* selg = (unsigned short*)(p.ws + WS_SEL);
    int* nselg = (int*)(p.ws + WS_NSEL);
#pragma unroll
    for (int tq = 0; tq < 4; ++tq) {
        int nsel = __builtin_amdgcn_readlane((tq & 1) ? cntB : cntA, (tq >> 1) * 32);
        nsel = nsel > 256 ? 256 : nsel;
        const unsigned short* sl = cib + (4 * wave + tq) * 512;
#pragma unroll
        for (int k = 0; k < 4; ++k) { const int e = lane + 64 * k; selg[(size_t)(tw + tq) * 256 + e] = e < nsel ? sl[e] : (unsigned short)0; }
        if (lane == 0) nselg[tw + tq] = nsel;
    }
}

typedef unsigned u32x4 __attribute__((ext_vector_type(4)));
__device__ __forceinline__ float dot2bf(unsigned a, unsigned b, float c) {
    return __builtin_amdgcn_fdot2_f32_bf16(__builtin_bit_cast(hwbf16x2, a), __builtin_bit_cast(hwbf16x2, b), c, false);
}
__device__ __forceinline__ void phase_dsa_attn(const Params& p, int bid, int nb, unsigned char* smem) {
    const int tid = tid_opaque(), lane = tid & 63, wave = tid >> 6, slot = lane >> 2, chunk = lane & 3;
    float* lut = (float*)smem;
    const bf16_t* dqb = (const bf16_t*)(p.ws + WS_DQB);
    const unsigned short* selg = (const unsigned short*)(p.ws + WS_SEL);
    const int* nselg = (const int*)(p.ws + WS_NSEL);
    const float* relb = p.in[17];
    const int h = bid & 7, bh = bid >> 3, nbh = nb >> 3;
    __syncthreads();
    {
        const float mq = wave_max(fabsf(p.in[6][lane])), mk = wave_max(fabsf(p.in[7][lane]));
        float mb = 0.f;
#pragma unroll
        for (int k = 0; k < 4; ++k) { const int e = lane + 64 * k; mb = fmaxf(mb, fabsf(relb[(e >> 3) * 16 + 8 + (e & 7)])); }
        mb = wave_max(mb);
        const float U2 = (8.f * mq * mk + mb) * LOG2E;
        if (tid < 128) lut[tid] = relb[bucket_of(tid) * 16 + 8 + h] * LOG2E - U2;
    }
    __syncthreads();
    const char* kuni = (const char*)(p.ws + WS_DKB) + (size_t)h * S * 128;
    const char* vuni = kuni + 64;
    const unsigned c32 = (unsigned)chunk * 32u, c16 = (unsigned)chunk * 16u, sl32 = (unsigned)slot * 32u;
    const int tstride = nbh * 4;
    int t = __builtin_amdgcn_readfirstlane(bh * 4 + wave);
    if (t < S) {
        unsigned pwA, pwB, pwC, pwD, pwE, pwF, pwG, pwH;
        u32x4 k0A, k1A, v0A, v1A, k0B, k1B, v0B, v1B, k0C, k1C, v0C, v1C, k0D, k1D, v0D, v1D;
        u32x4 k0E, k1E, v0E, v1E, k0F, k1F, v0F, v1F, k0G, k1G, v0G, v1G, k0H, k1H, v0H, v1H;
#define DS_LOAD(S_, PW_) {                                                                                    \
            pw##S_ = (PW_);                                                                                   \
            const unsigned o0_ = ((pw##S_ & 0xffffu) << 7) + c16, o1_ = ((pw##S_ >> 16) << 7) + c16;          \
            k0##S_ = *(const u32x4*)(kuni + (size_t)o0_); k1##S_ = *(const u32x4*)(kuni + (size_t)o1_);       \
            v0##S_ = *(const u32x4*)(vuni + (size_t)o0_); v1##S_ = *(const u32x4*)(vuni + (size_t)o1_); }
#define F8LO(x_) __builtin_bit_cast(unsigned, __builtin_amdgcn_cvt_scalef32_pk_bf16_fp8((x_), 1.0f, false))
#define F8HI(x_) __builtin_bit_cast(unsigned, __builtin_amdgcn_cvt_scalef32_pk_bf16_fp8((x_), 1.0f, true))
#define DS_PV1(V_, P_)                                                                                        \
            _Pragma("unroll") for (int m = 0; m < 4; ++m) {                                                   \
                const f32x2 lo_ = __builtin_amdgcn_cvt_pk_f32_fp8((int)V_[m], false), hi_ = __builtin_amdgcn_cvt_pk_f32_fp8((int)V_[m], true); \
                o2[2 * m] += lo_ * (f32x2){P_, P_}; o2[2 * m + 1] += hi_ * (f32x2){P_, P_}; }
#define DS_DOT(K_, D_)                                                                                        \
            _Pragma("unroll") for (int m = 0; m < 4; ++m) { D_ = dot2bf(qq_(2 * m), F8LO(K_[m]), D_); D_ = dot2bf(qq_(2 * m + 1), F8HI(K_[m]), D_); }
#define DS_COMP2(S1_, S2_, gi) {                                                                              \
            float d0_ = 0.f, d1_ = 0.f, d2_ = 0.f, d3_ = 0.f;                                                 \
            DS_DOT(k0##S1_, d0_) DS_DOT(k1##S1_, d1_) DS_DOT(k0##S2_, d2_) DS_DOT(k1##S2_, d3_)               \
            const float a_ = (odd ? d1_ : d0_) + dppf<0xB1>(odd ? d0_ : d1_);         \
            const float b_ = (odd ? d3_ : d2_) + dppf<0xB1>(odd ? d2_ : d3_);             \
            const float dk_ = (hi2 ? b_ : a_) + dppf<0x4E>(hi2 ? a_ : b_);            \
            const unsigned w_ = hi2 ? pw##S2_ : pw##S1_;                                                      \
            int e_ = t - (int)__builtin_amdgcn_ubfe(w_, sh16, 16u);                                           \
            e_ = e_ > 127 ? 127 : (e_ < 0 ? 0 : e_);                                                          \
            float p_ = __builtin_amdgcn_exp2f(dk_ + lut[e_]);                                                 \
            p_ = (2 * (gi) < nremc) ? p_ : 0.f;                                        \
            lsum += p_;                                                                                       \
            const float p0_ = dppf<0x00>(p_), p1_ = dppf<0x55>(p_), p2_ = dppf<0xAA>(p_), p3_ = dppf<0xFF>(p_); \
            DS_PV1(v0##S1_, p0_) DS_PV1(v1##S1_, p1_) DS_PV1(v0##S2_, p2_) DS_PV1(v1##S2_, p3_) }
#define DS_IP(T_) ((const u32x4*)((const char*)(selg + (size_t)(T_) * 256) + sl32))
#define DS_QP(T_) ((const u32x4*)((const char*)(dqb + (size_t)(T_) * 512 + h * 64) + c32))
        const bool odd = chunk & 1, hi2 = chunk & 2;
        const unsigned sh16 = (unsigned)(chunk & 1) * 16u;
        u32x4 q0 = DS_QP(t)[0], q1 = DS_QP(t)[1];
#define qq_(i_) ((i_) < 4 ? q0[(i_)] : q1[(i_) - 4])
        int nrem = nselg[t] - slot * 16;
        {
            const u32x4 cw0 = DS_IP(t)[0], cw1 = DS_IP(t)[1];
            DS_LOAD(A, cw0[0]) DS_LOAD(B, cw0[1]) DS_LOAD(C, cw0[2]) DS_LOAD(D, cw0[3])
            DS_LOAD(E, cw1[0]) DS_LOAD(F, cw1[1]) DS_LOAD(G, cw1[2]) DS_LOAD(H, cw1[3])
        }
        int tn = t + tstride;
        int tp = tn < S ? tn : t;
        u32x4 nw0 = DS_IP(tp)[0], nw1 = DS_IP(tp)[1];
#pragma unroll 1
        for (;;) {
            const int tn2 = tn + tstride;
            const int tp2 = tn2 < S ? tn2 : tp;
            const u32x4 nn0 = DS_IP(tp2)[0], nn1 = DS_IP(tp2)[1];
            f32x2 o2[8];
#pragma unroll
            for (int j = 0; j < 8; ++j) o2[j] = (f32x2){0.f, 0.f};
            float lsum = 0.f;
            const int nremc = nrem - chunk;
            DS_COMP2(A, B, 0) DS_LOAD(A, nw0[0]) DS_LOAD(B, nw0[1])
            DS_COMP2(C, D, 2) DS_LOAD(C, nw0[2]) DS_LOAD(D, nw0[3])
            DS_COMP2(E, F, 4) DS_LOAD(E, nw1[0]) DS_LOAD(F, nw1[1])
            DS_COMP2(G, H, 6) DS_LOAD(G, nw1[2]) DS_LOAD(H, nw1[3])
            q0 = DS_QP(tp)[0]; q1 = DS_QP(tp)[1];
            nrem = nselg[tp] - slot * 16;
#define OV(j_) o2[(j_) >> 1][(j_) & 1]
            float z[4];
#pragma unroll
            for (int n = 0; n < 4; ++n) {
                const float w1 = pair32(OV(n), OV(8 + n));
                const float w2 = pair32(OV(4 + n), OV(12 + n));
                float v = pair16(w1, w2);
                v += dppf<0x124>(v); v += dppf<0x128>(v);
                z[n] = v;
            }
#undef OV
            lsum += dppf<0xB1>(lsum); lsum += dppf<0x4E>(lsum);
            lsum += dppf<0x124>(lsum); lsum += dppf<0x128>(lsum);
            lsum = xadd32(xadd16(lsum));
            if ((lane & 12) == 0) {
                const float inv = lsum > 0.f ? __builtin_amdgcn_rcpf(lsum) : 0.f;
                uint2 ov; ov.x = pk2h(z[0] * inv, z[1] * inv); ov.y = pk2h(z[2] * inv, z[3] * inv);
                *(uint2*)((bf16_t*)(p.ws + WS_OB) + (size_t)t * 512 + h * 64 + chunk * 16 + 4 * (lane >> 4)) = ov;
            }
            if (tn >= S) break;
            t = tn; tn = tn2; tp = tp2; nw0 = nn0; nw1 = nn1;
        }
#undef DS_DOT
#undef DS_COMP2
#undef DS_LOAD
#undef DS_PV1
#undef DS_IP
#undef DS_QP
#undef F8LO
#undef F8HI
#undef qq_
    }
}

__device__ __forceinline__ void convert_late_weights(const Params& p, int bid, int nb) {
    cvt_weights(p.in[21], (bf16_t*)(p.ws + WB_E1), (size_t)NEXP * D * 2 * DFF, bid, nb);
    cvt_weights(p.in[23], (bf16_t*)(p.ws + WB_E2), (size_t)NEXP * DFF * D, bid, nb);
    cvt_weights(p.in[27], (bf16_t*)(p.ws + WB_PLEG), (size_t)D * D, bid, nb);
}
constexpr int Q_NCONV = 1024;
constexpr size_t WS_QHEAD = WS_BAR + 16384;
__device__ __forceinline__ void phase_attn(const Params& p, int bid, int nb, unsigned char* smem) {
    volatile int* slot = (volatile int*)(smem + 73600);
    int* heads = (int*)(p.ws + WS_QHEAD);
    const int tid = tid_opaque();
    const int g = bid & 1;
    bool done_d = false, done_n = false, done_c = false;
    int step = (bid < (nb >> 1)) ? 0 : 1;
#pragma unroll 1
    while (!(done_d && done_n && done_c)) {
        const int ty = step & 3; ++step;
        const bool skip = (ty == 0) ? done_d : (ty == 3 ? done_c : done_n);
        if (skip) continue;
        __syncthreads();
        if (tid == 0) {
            int* h = heads + (ty == 0 ? 0 : (ty == 3 ? 48 : 16 + 16 * g));
            slot[0] = __hip_atomic_fetch_add(h, 1, __ATOMIC_RELAXED, __HIP_MEMORY_SCOPE_AGENT);
        }
        __syncthreads();
        const int idx = slot[0];
        if (ty == 0) {
            if (idx >= 1024) { done_d = true; continue; }
            dsa_tile(p, 1023 - idx, smem);
        } else if (ty == 3) {
            if (idx >= Q_NCONV) { done_c = true; continue; }
            convert_late_weights(p, idx, Q_NCONV);
        } else {
            if (idx >= 1024) { done_n = true; continue; }
            nsa_tile(p, 1023 - idx, g, smem);
        }
    }
}

template <int PASS>
__device__ __forceinline__ void phase_merge(const Params& p, int bid, int nb, unsigned char* smem) {
    const int g2tid = tid_opaque();
    const bf16_t* sg = (const bf16_t*)(p.ws + (PASS ? WS_SGB : WS_SGA));
    bf16_t* merged = (bf16_t*)(p.ws + WS_MERGED);
    float* tmp = (float*)(p.ws + WS_X1);
    const bf16_t* A = (const bf16_t*)(p.ws + (PASS ? WS_OB : WS_OA));
    const bf16_t* Bw = (const bf16_t*)(p.ws + (PASS ? WB_B : WB_A));
    for (int w = bid; w < 128 * 8; w += nb) {
        const int mt = w % 128, nt = w / 128;
        const int m0 = mt * 128, n0 = nt * 128;
        f32x4 acc[4][4];
        gemm2<false, false>(A, 512, nullptr, m0, 128, Bw, D, n0, 128, 512, smem, acc);
#pragma unroll
        for (int i = 0; i < 4; ++i) {
            float vv[4][4], gv[4][4], tv[4][4];
#pragma unroll
            for (int r = 0; r < 4; ++r) {
                const size_t ro = (size_t)(m0 + G2_ROW(i, r)) * D + n0 + G2_COL(0);
#pragma unroll
                for (int j = 0; j < 4; ++j) { gv[r][j] = bf2f(sg[ro + j * 16]); tv[r][j] = (PASS == 1) ? tmp[ro + j * 16] : 0.f; }
            }
#pragma unroll
            for (int r = 0; r < 4; ++r) {
                float* tr = tmp + (size_t)(m0 + G2_ROW(i, r)) * D + n0 + G2_COL(0);
#pragma unroll
                for (int j = 0; j < 4; ++j) {
                    const float v = gv[r][j] * acc[i][j][r];
                    if (PASS == 0) tr[j * 16] = v;
                    else vv[j][r] = tv[r][j] + v;
                }
            }
            if (PASS == 1) {
                bf16_t* mr = merged + (size_t)(m0 + G2_ROW(i, 0)) * D + n0 + G2_COL(0);
#pragma unroll
                for (int j = 0; j < 4; ++j) store_bf16_frag(mr + j * 16, D, vv[j][0], vv[j][1], vv[j][2], vv[j][3], g2tid & 63);
            }
        }
    }
}

__device__ __forceinline__ void phase_outproj(const Params& p, int bid, int nb, unsigned char* smem) {
    const int g2tid = tid_opaque();
    const bf16_t* merged = (const bf16_t*)(p.ws + WS_MERGED);
    const float* x = p.in[0];
    float* x1 = (float*)(p.ws + WS_X1);
    for (int w = bid; w < 128 * 8; w += nb) {
        const int mt = w % 128, nt = w / 128;
        const int m0 = mt * 128, n0 = nt * 128;
        f32x4 acc[4][4];
        gemm2<false, false>(merged, D, nullptr, m0, 128, (const bf16_t*)(p.ws + WB_OUT), D, n0, 128, D, smem, acc);
        float xv[4][4][4];
#pragma unroll
        for (int i = 0; i < 4; ++i)
#pragma unroll
            for (int r = 0; r < 4; ++r) {
                const float* xr = x + (size_t)(m0 + G2_ROW(i, r)) * D + n0 + G2_COL(0);
#pragma unroll
                for (int j = 0; j < 4; ++j) xv[i][r][j] = xr[j * 16];
            }
#pragma unroll
        for (int i = 0; i < 4; ++i)
#pragma unroll
            for (int r = 0; r < 4; ++r) {
                float* yr = x1 + (size_t)(m0 + G2_ROW(i, r)) * D + n0 + G2_COL(0);
#pragma unroll
                for (int j = 0; j < 4; ++j) yr[j * 16] = xv[i][r][j] + acc[i][j][r];
            }
    }
}

__device__ __forceinline__ void phase_route(const Params& p, int bid, int nb, unsigned char* smem) {
    const int lane = tid_opaque() & 63, wave = tid_opaque() >> 6;
    const float* x1 = (const float*)(p.ws + WS_X1);
    const float* g = p.in[18];
    const float* wr = p.in[19];
    const float* br = p.in[20];
    bf16_t* hb = (bf16_t*)(p.ws + WS_HB);
    int* topi = (int*)(p.ws + WS_TOPI);
    float* topw = (float*)(p.ws + WS_TOPW);
    float* hl = (float*)smem + wave * 4 * 1056;
    int* cntl = (int*)(smem + 16 * 1056 * 4);
    const int ksub = lane >> 3, e4 = lane & 7;
    float4 ggf[4];
#pragma unroll
    for (int j = 0; j < 4; ++j) ggf[j] = ((const float4*)g)[lane + 64 * j];
    __syncthreads();
    if (tid_opaque() < 32) cntl[tid_opaque()] = 0;
    __syncthreads();
    const int tstep = nb * 4;
    for (int t0 = bid * 4 + wave; t0 < S; t0 += 4 * tstep) {
#pragma unroll 1
        for (int q = 0; q < 4; ++q) {
            const int t = t0 + q * tstep;
            if (t >= S) break;
            const float4* xr = (const float4*)(x1 + (size_t)t * D);
            float4 v[4];
            float ss = 0.f;
#pragma unroll
            for (int j = 0; j < 4; ++j) { v[j] = xr[lane + 64 * j]; ss += v[j].x * v[j].x + v[j].y * v[j].y + v[j].z * v[j].z + v[j].w * v[j].w; }
            ss = wave_sum(ss);
            const float rstd = rsqrtf(ss * (1.f / D) + EPS);
#pragma unroll
            for (int j = 0; j < 4; ++j) {
                const float4 gg = ggf[j];
                const float4 h4 = make_float4(v[j].x * rstd * gg.x, v[j].y * rstd * gg.y, v[j].z * rstd * gg.z, v[j].w * rstd * gg.w);
                uint2 o; o.x = pk2(h4.x, h4.y); o.y = pk2(h4.z, h4.w);
                ((uint2*)(hb + (size_t)t * D))[lane + 64 * j] = o;
                ((float4*)(hl + q * 1056))[lane + 64 * j] = h4;
            }
        }
        asm volatile("" ::: "memory");
        float4 acc0 = make_float4(0.f, 0.f, 0.f, 0.f), acc1 = acc0, acc2 = acc0, acc3 = acc0;
        const float4* wp = (const float4*)(wr + (size_t)ksub * 32) + e4;
#pragma unroll 4
        for (int i = 0; i < 128; ++i) {
            const float4 w4 = wp[(size_t)i * 64];
            const float h0 = hl[8 * i + ksub], h1 = hl[1056 + 8 * i + ksub], h2 = hl[2 * 1056 + 8 * i + ksub], h3 = hl[3 * 1056 + 8 * i + ksub];
            acc0.x += h0 * w4.x; acc0.y += h0 * w4.y; acc0.z += h0 * w4.z; acc0.w += h0 * w4.w;
            acc1.x += h1 * w4.x; acc1.y += h1 * w4.y; acc1.z += h1 * w4.z; acc1.w += h1 * w4.w;
            acc2.x += h2 * w4.x; acc2.y += h2 * w4.y; acc2.z += h2 * w4.z; acc2.w += h2 * w4.w;
            acc3.x += h3 * w4.x; acc3.y += h3 * w4.y; acc3.z += h3 * w4.z; acc3.w += h3 * w4.w;
        }
#define RT_RED(A_) { A_.x = xadd32(xadd16(A_.x + dppf<0x128>(A_.x))); A_.y = xadd32(xadd16(A_.y + dppf<0x128>(A_.y))); \
                     A_.z = xadd32(xadd16(A_.z + dppf<0x128>(A_.z))); A_.w = xadd32(xadd16(A_.w + dppf<0x128>(A_.w))); }
        RT_RED(acc0) RT_RED(acc1) RT_RED(acc2) RT_RED(acc3)
#undef RT_RED
        if (ksub == 0) {
            const float4 b4 = ((const float4*)br)[e4];
            ((float4*)(hl + 1024))[e4] = make_float4(acc0.x + b4.x, acc0.y + b4.y, acc0.z + b4.z, acc0.w + b4.w);
            ((float4*)(hl + 1056 + 1024))[e4] = make_float4(acc1.x + b4.x, acc1.y + b4.y, acc1.z + b4.z, acc1.w + b4.w);
            ((float4*)(hl + 2 * 1056 + 1024))[e4] = make_float4(acc2.x + b4.x, acc2.y + b4.y, acc2.z + b4.z, acc2.w + b4.w);
            ((float4*)(hl + 3 * 1056 + 1024))[e4] = make_float4(acc3.x + b4.x, acc3.y + b4.y, acc3.z + b4.z, acc3.w + b4.w);
        }
        asm volatile("" ::: "memory");
#pragma unroll 1
        for (int q = 0; q < 4; ++q) {
            const int t = t0 + q * tstep;
            if (t >= S) break;
            float lg[32];
#pragma unroll
            for (int e = 0; e < 8; ++e) { const float4 l4 = ((const float4*)(hl + q * 1056 + 1024))[e]; lg[4 * e] = l4.x; lg[4 * e + 1] = l4.y; lg[4 * e + 2] = l4.z; lg[4 * e + 3] = l4.w; }
            asm volatile("" ::: "memory");
            int idx[4]; float val[4];
            unsigned used = 0;
#pragma unroll
            for (int k = 0; k < 4; ++k) {
                float best = -__builtin_inff(); int bi = 0;
#pragma unroll
                for (int e = 0; e < 32; ++e) { const bool ok = !((used >> e) & 1u) && (lg[e] > best); best = ok ? lg[e] : best; bi = ok ? e : bi; }
                idx[k] = bi; val[k] = best; used |= 1u << bi;
            }
            const float e0 = 1.f, e1 = __expf(val[1] - val[0]), e2 = __expf(val[2] - val[0]), e3 = __expf(val[3] - val[0]);
            const float inv = 1.f / (e0 + e1 + e2 + e3);
            if (lane == 0) {
                topi[t * 4 + 0] = idx[0]; topi[t * 4 + 1] = idx[1]; topi[t * 4 + 2] = idx[2]; topi[t * 4 + 3] = idx[3];
                topw[t * 4 + 0] = e0 * inv; topw[t * 4 + 1] = e1 * inv; topw[t * 4 + 2] = e2 * inv; topw[t * 4 + 3] = e3 * inv;
                atomicAdd(&cntl[idx[0]], 1); atomicAdd(&cntl[idx[1]], 1); atomicAdd(&cntl[idx[2]], 1); atomicAdd(&cntl[idx[3]], 1);
            }
        }
        asm volatile("" ::: "memory");
    }
    __syncthreads();
    if (tid_opaque() < 32) ((int*)(p.ws + WS_CNTB))[bid * 32 + tid_opaque()] = cntl[tid_opaque()];
}

__device__ __forceinline__ void phase_place(const Params& p, int bid, int nb, unsigned char* smem) {
    const int tid = tid_opaque(), lane = tid & 63, wave = tid >> 6;
    int* part_tot = (int*)smem;
    int* part_bef = part_tot + 256;
    int* base = part_bef + 256;
    int* curl = base + 32;
    const int* cntb = (const int*)(p.ws + WS_CNTB);
    int* cnt = (int*)(p.ws + WS_CTL);
    const int* topi = (const int*)(p.ws + WS_TOPI);
    int* ppos = (int*)(p.ws + WS_PPOS);
    int* rowtok = (int*)(p.ws + WS_ROWTOK);
    __syncthreads();
    {
        const int e = tid & 31, part = tid >> 5;
        int tot = 0, bef = 0;
        for (int b = part; b < nb; b += 8) { const int c = cntb[b * 32 + e]; tot += c; bef += (b < bid) ? c : 0; }
        part_tot[part * 32 + e] = tot; part_bef[part * 32 + e] = bef;
    }
    __syncthreads();
    if (tid < 32) {
        int tot = 0, bef = 0;
#pragma unroll
        for (int k = 0; k < 8; ++k) { tot += part_tot[k * 32 + tid]; bef += part_bef[k * 32 + tid]; }
        part_tot[tid] = tot; part_bef[tid] = bef;
        if (bid == 0) cnt[tid] = tot;
    }
    __syncthreads();
    if (tid == 0) { int a = 0; for (int e = 0; e < NEXP; ++e) { base[e] = a + part_bef[e]; a += part_tot[e]; curl[e] = 0; } }
    __syncthreads();
    for (int t = bid * 4 + wave; t < S; t += nb * 4) {
        if (lane < 4) {
            const int i = t * 4 + lane;
            const int e = topi[i];
            const int pos = base[e] + atomicAdd(&curl[e], 1);
            ppos[i] = pos;
            rowtok[pos] = t;
        }
    }
}

__device__ __forceinline__ void moe_tile_map(const int* cnt, int* sm, int& total_mt) {
    __syncthreads();
    if (tid_opaque() == 0) {
        int a = 0, b = 0;
        for (int e = 0; e < NEXP; ++e) { sm[e] = a; sm[33 + e] = b; a += (cnt[e] + 127) >> 7; b += cnt[e]; }
        sm[32] = a; sm[65] = b;
    }
    __syncthreads();
    total_mt = sm[32];
}
__device__ __forceinline__ void phase_moe1(const Params& p, int bid, int nb, unsigned char* smem) {
    const int g2tid = tid_opaque();
    int* sm = (int*)(smem + 72704);
    const int* cnt = (const int*)(p.ws + WS_CTL);
    const int* rowtok = (const int*)(p.ws + WS_ROWTOK);
    const bf16_t* hb = (const bf16_t*)(p.ws + WS_HB);
    bf16_t* act = (bf16_t*)(p.ws + WS_ACT);
    const int lane = tid_opaque() & 63, wave = tid_opaque() >> 6;
    int total_mt;
    moe_tile_map(cnt, sm, total_mt);
    for (int w = bid; w < total_mt * 16; w += nb) {
        const int tm = w >> 4, nt = w & 15;
        int e = 0;
        while (e < NEXP - 1 && sm[e + 1] <= tm) ++e;
        const int mt = tm - sm[e];
        const int rbase = sm[33 + e] + mt * 128;
        const int mrows = min(128, cnt[e] - mt * 128);
        const int n0 = nt * 64;
        f32x4 acc[4][4];
        gemm2<true, true>(hb, D, rowtok, rbase, mrows, (const bf16_t*)(p.ws + WB_E1) + (size_t)e * D * 2 * DFF, 2 * DFF, n0, 128, D, smem, acc);
        const float* b1 = p.in[22] + (size_t)e * 2 * DFF;
        const int wn_ = (tid_opaque() >> 6) & 1;
        float bgv[2], blv[2];
#pragma unroll
        for (int jp = 0; jp < 2; ++jp) { const int col = n0 + wn_ * 32 + jp * 16 + (g2tid & 15); bgv[jp] = b1[col]; blv[jp] = b1[DFF + col]; }
#pragma unroll
        for (int i = 0; i < 4; ++i)
#pragma unroll
            for (int jp = 0; jp < 2; ++jp) {
                const int col = n0 + wn_ * 32 + jp * 16 + (g2tid & 15);
                const float bg = bgv[jp], bl = blv[jp];
                float av[4];
                unsigned rmask = 0;
#pragma unroll
                for (int r = 0; r < 4; ++r) {
                    const int rl = G2_ROW(i, r);
                    const float gate = fminf(acc[i][jp][r] + bg, 7.f);
                    const float lin = fminf(fmaxf(acc[i][jp + 2][r] + bl, -7.f), 7.f);
                    av[r] = (lin + 1.f) * gate * sigmoidf_(1.702f * gate);
                    rmask |= (rl < mrows) ? (1u << r) : 0u;
                }
                store_bf16_frag(act + (size_t)(rbase + G2_ROW(i, 0)) * DFF + col, DFF, av[0], av[1], av[2], av[3], g2tid & 63, rmask);
            }
    }
}
__device__ __forceinline__ void phase_moe2(const Params& p, int bid, int nb, unsigned char* smem) {
    const int g2tid = tid_opaque();
    int* sm = (int*)(smem + 72704);
    const int* cnt = (const int*)(p.ws + WS_CTL);
    const bf16_t* act = (const bf16_t*)(p.ws + WS_ACT);
    bf16_t* yrows = (bf16_t*)(p.ws + WS_YROWS);
    const int lane = tid_opaque() & 63, wave = tid_opaque() >> 6;
    int total_mt;
    moe_tile_map(cnt, sm, total_mt);
    for (int w = bid; w < total_mt * 8; w += nb) {
        const int tm = w >> 3, nt = w & 7;
        int e = 0;
        while (e < NEXP - 1 && sm[e + 1] <= tm) ++e;
        const int mt = tm - sm[e];
        const int rbase = sm[33 + e] + mt * 128;
        const int mrows = min(128, cnt[e] - mt * 128);
        const int n0 = nt * 128;
        f32x4 acc[4][4];
        gemm2<false, false>(act, DFF, nullptr, rbase, mrows, (const bf16_t*)(p.ws + WB_E2) + (size_t)e * DFF * D, D, n0, 128, DFF, smem, acc);
        const float* b2 = p.in[24] + (size_t)e * D + n0;
        float bv[4];
#pragma unroll
        for (int j = 0; j < 4; ++j) bv[j] = b2[G2_COL(j)];
#pragma unroll
        for (int i = 0; i < 4; ++i) {
            const int rl0 = G2_ROW(i, 0);
            const unsigned rmask = (rl0 < mrows ? 1u : 0u) | (rl0 + 1 < mrows ? 2u : 0u) | (rl0 + 2 < mrows ? 4u : 0u) | (rl0 + 3 < mrows ? 8u : 0u);
            bf16_t* yr = yrows + (size_t)(rbase + rl0) * D + n0;
#pragma unroll
            for (int j = 0; j < 4; ++j)
                store_bf16_frag(yr + G2_COL(j), D, acc[i][j][0] + bv[j], acc[i][j][1] + bv[j], acc[i][j][2] + bv[j], acc[i][j][3] + bv[j], lane, rmask);
        }
    }
}

__device__ __forceinline__ void phase_combine(const Params& p, int bid, int nb) {
    const int lane = tid_opaque() & 63, wave = tid_opaque() >> 6;
    const float* x1 = (const float*)(p.ws + WS_X1);
    const bf16_t* yrows = (const bf16_t*)(p.ws + WS_YROWS);
    const int* ppos = (const int*)(p.ws + WS_PPOS);
    const float* topw = (const float*)(p.ws + WS_TOPW);
    bf16_t* hb = (bf16_t*)(p.ws + WS_HB);
    float4 gg[4];
#pragma unroll
    for (int j = 0; j < 4; ++j) gg[j] = ((const float4*)p.in[25])[lane + 64 * j];
    for (int t = bid * 4 + wave; t < S; t += nb * 4) {
        const int4 pp = *(const int4*)(ppos + t * 4);
        const float4 ww = *(const float4*)(topw + t * 4);
        float4 v[4];
        uint2 y0[4], y1[4], y2[4], y3[4];
#pragma unroll
        for (int j = 0; j < 4; ++j) {
            v[j] = ((const float4*)(x1 + (size_t)t * D))[lane + 64 * j];
            y0[j] = ((const uint2*)(yrows + (size_t)pp.x * D))[lane + 64 * j];
            y1[j] = ((const uint2*)(yrows + (size_t)pp.y * D))[lane + 64 * j];
            y2[j] = ((const uint2*)(yrows + (size_t)pp.z * D))[lane + 64 * j];
            y3[j] = ((const uint2*)(yrows + (size_t)pp.w * D))[lane + 64 * j];
        }
#define CMB_ADD(W_, Y_) { v[j].x += (W_) * __builtin_bit_cast(float, (Y_).x << 16); v[j].y += (W_) * __builtin_bit_cast(float, (Y_).x & 0xffff0000u); \
                          v[j].z += (W_) * __builtin_bit_cast(float, (Y_).y << 16); v[j].w += (W_) * __builtin_bit_cast(float, (Y_).y & 0xffff0000u); }
#pragma unroll
        for (int j = 0; j < 4; ++j) { CMB_ADD(ww.x, y0[j]) CMB_ADD(ww.y, y1[j]) CMB_ADD(ww.z, y2[j]) CMB_ADD(ww.w, y3[j]) }
#undef CMB_ADD
        float ss = 0.f;
#pragma unroll
        for (int j = 0; j < 4; ++j) ss += v[j].x * v[j].x + v[j].y * v[j].y + v[j].z * v[j].z + v[j].w * v[j].w;
        ss = wave_sum(ss);
        const float rstd = rsqrtf(ss * (1.f / D) + EPS);
#pragma unroll
        for (int j = 0; j < 4; ++j) {
            ((float4*)(p.out + (size_t)t * D))[lane + 64 * j] = v[j];
            uint2 o;
            o.x = pk2(v[j].x * rstd * gg[j].x, v[j].y * rstd * gg[j].y);
            o.y = pk2(v[j].z * rstd * gg[j].z, v[j].w * rstd * gg[j].w);
            ((uint2*)(hb + (size_t)t * D))[lane + 64 * j] = o;
        }
    }
}

__device__ __forceinline__ void phase_ple(const Params& p, int bid, int nb, unsigned char* smem) {
    const int g2tid = tid_opaque();
    const bf16_t* pw = (const bf16_t*)(p.ws + WS_PW);
    for (int w = bid; w < 128 * 8; w += nb) {
        const int mt = w % 128, nt = w / 128;
        const int m0 = mt * 128, n0 = nt * 128;
        f32x4 acc[4][4];
        gemm2<false, false>((const bf16_t*)(p.ws + WS_HB), D, nullptr, m0, 128, (const bf16_t*)(p.ws + WB_PLEG), D, n0, 128, D, smem, acc);
#pragma unroll
        for (int i = 0; i < 4; ++i) {
            float ov[4][4], pv[4][4];
#pragma unroll
            for (int r = 0; r < 4; ++r) {
                const size_t ro = (size_t)(m0 + G2_ROW(i, r)) * D + n0 + G2_COL(0);
#pragma unroll
                for (int j = 0; j < 4; ++j) { ov[r][j] = p.out[ro + j * 16]; pv[r][j] = bf2f(pw[ro + j * 16]); }
            }
#pragma unroll
            for (int r = 0; r < 4; ++r) {
                float* orow = p.out + (size_t)(m0 + G2_ROW(i, r)) * D + n0 + G2_COL(0);
#pragma unroll
                for (int j = 0; j < 4; ++j) orow[j * 16] = ov[r][j] + sigmoidf_(acc[i][j][r]) * pv[r][j];
            }
        }
    }
}

#define LAS __attribute__((address_space(3)))
#define XB_TMO      128
#define XB_XCNT(j)  (256  + 64 * (j))
#define XB_XSUB(j)  (1280 + 64 * (j))
#define XB_XGEN(j)  (2304 + 64 * (j))
#define XB_TOP      3328
#define XB_TOPGEN   3392
#define XCD_BAR_WORDS 3456
#define XB_SPIN_CAP (1u << 22)

__device__ __forceinline__ unsigned xb_ld(unsigned* p)              { return __hip_atomic_load(p, __ATOMIC_RELAXED, __HIP_MEMORY_SCOPE_AGENT); }
__device__ __forceinline__ unsigned xb_add(unsigned* p, unsigned v) { return __hip_atomic_fetch_add(p, v, __ATOMIC_RELAXED, __HIP_MEMORY_SCOPE_AGENT); }
__device__ __forceinline__ unsigned xb_xcc_id() { return (unsigned)__builtin_amdgcn_s_getreg((3 << 11) | 20) & 0xFu; }
#define XB_SPIN(cond, bar) do { unsigned _sp = 0; while (cond) { __builtin_amdgcn_s_sleep(1); \
    if ((++_sp & 255u) == 0u) { if (xb_ld(&(bar)[XB_TMO])) break; if (_sp > XB_SPIN_CAP) { atomicAdd(&(bar)[XB_TMO], 1u); break; } } } } while (0)

struct XcdBarrier {
    unsigned* bar; unsigned x;
    volatile LAS unsigned* st;
};

__device__ __forceinline__ XcdBarrier xcd_barrier_post(unsigned* bar, volatile LAS unsigned* st) {
    XcdBarrier b; b.bar = bar; b.x = xb_xcc_id(); b.st = st;
    if (tid_opaque() == 0) (void)xb_add(&bar[XB_XCNT(b.x)], 1u);
    return b;
}
__device__ __forceinline__ void xcd_barrier_complete(unsigned* bar, unsigned x, unsigned& nloc, unsigned& nx) {
    const unsigned G = gridDim.x * gridDim.y * gridDim.z;
    unsigned sum, cnt, mine, sp = 0u;
    for (;;) {
        sum = 0u; cnt = 0u; mine = 0u;
#pragma unroll
        for (unsigned j = 0; j < 16; ++j) { const unsigned c = xb_ld(&bar[XB_XCNT(j)]); sum += c; cnt += (c > 0u) ? 1u : 0u; mine = (j == x) ? c : mine; }
        if (sum == G) break;
        __builtin_amdgcn_s_sleep(1);
        if ((++sp & 255u) == 0u) { if (xb_ld(&bar[XB_TMO])) break; if (sp > XB_SPIN_CAP) { atomicAdd(&bar[XB_TMO], 1u); break; } }
    }
    nloc = mine > 0u ? mine : 1u; nx = cnt > 0u ? cnt : 1u;
}

__device__ __forceinline__ void xcd_barrier(const XcdBarrier& b) {
    asm volatile("s_waitcnt vmcnt(0)" ::: "memory");
    __syncthreads();
    if (tid_opaque() == 0) {
        unsigned* bar = b.bar;
        __builtin_amdgcn_s_waitcnt(0);
        unsigned nloc = b.st[0], nx = b.st[1];
        if (nloc == 0u) { xcd_barrier_complete(bar, b.x, nloc, nx); b.st[0] = nloc; b.st[1] = nx; }
        const unsigned old = xb_add(&bar[XB_XSUB(b.x)], 1u);
        const unsigned gen = old / nloc;
        if (old + 1u == (gen + 1u) * nloc) {
            __builtin_amdgcn_fence(__ATOMIC_RELEASE, "agent");
            asm volatile("s_waitcnt vmcnt(0)" ::: "memory");
            const unsigned og = xb_add(&bar[XB_TOP], 1u);
            const unsigned tg = og / nx;
            if (og + 1u == (tg + 1u) * nx) xb_add(&bar[XB_TOPGEN], 1u);
            else XB_SPIN(xb_ld(&bar[XB_TOPGEN]) == tg, bar);
            __builtin_amdgcn_fence(__ATOMIC_ACQUIRE, "agent");
            xb_add(&bar[XB_XGEN(b.x)], 1u);
            asm volatile("s_waitcnt vmcnt(0)" ::: "memory");
        } else {
            XB_SPIN(xb_ld(&bar[XB_XGEN(b.x)]) == gen, bar);
            __builtin_amdgcn_fence(__ATOMIC_ACQUIRE, "agent");
            asm volatile("s_waitcnt vmcnt(0)" ::: "memory");
        }
    }
    __syncthreads();
}

template <int PH>
__device__ __forceinline__ void run_phase(const Params& p, int bid, int nb, unsigned char* smem) {
    if (PH == 0) phase_prep(p, bid, nb);
    if (PH == 1) phase_inproj(p, bid, nb, smem);
    if (PH == 3) phase_compress(p, bid, nb, smem);
    if (PH == 4) phase_attn(p, bid, nb, smem);
    if (PH == 15) {
        if (bid < (nb >> 1)) { phase_dsa_attn(p, bid, nb, smem); phase_merge<0>(p, bid, nb, smem); }
        else { phase_merge<0>(p, bid, nb, smem); phase_dsa_attn(p, bid, nb, smem); }
    }
    if (PH == 13) phase_merge<1>(p, bid, nb, smem);
    if (PH == 6) phase_outproj(p, bid, nb, smem);
    if (PH == 7) phase_route(p, bid, nb, smem);
    if (PH == 8) phase_place(p, bid, nb, smem);
    if (PH == 9) phase_moe1(p, bid, nb, smem);
    if (PH == 10) phase_moe2(p, bid, nb, smem);
    if (PH == 11) phase_combine(p, bid, nb);
    if (PH == 12) phase_ple(p, bid, nb, smem);
}

#if SINGLE_LAUNCH
__global__ void __launch_bounds__(NT, 2) fwd_mega(Params p) {
    __shared__ __attribute__((aligned(16))) unsigned char smem[SMEM_BYTES];
    cg::grid_group grid = cg::this_grid();
    const int bid = blockIdx.x, nb = gridDim.x;
    volatile LAS unsigned* bst = (volatile LAS unsigned*)(LAS unsigned char*)(smem + SMEM_BYTES - 16);
    if (tid_opaque() < 2) bst[tid_opaque()] = 0u;
    __syncthreads();
    const XcdBarrier bar = xcd_barrier_post((unsigned*)(p.ws + WS_BAR), bst);
#define GSYNC() xcd_barrier(bar)
    run_phase<0>(p, bid, nb, smem); GSYNC();
    run_phase<1>(p, bid, nb, smem); GSYNC();
    run_phase<3>(p, bid, nb, smem); GSYNC();
    run_phase<4>(p, bid, nb, smem); grid.sync();
    run_phase<15>(p, bid, nb, smem); GSYNC();
    run_phase<13>(p, bid, nb, smem); GSYNC();
    run_phase<6>(p, bid, nb, smem); GSYNC();
    run_phase<7>(p, bid, nb, smem); GSYNC();
    run_phase<8>(p, bid, nb, smem); GSYNC();
    run_phase<9>(p, bid, nb, smem); GSYNC();
    run_phase<10>(p, bid, nb, smem); GSYNC();
    run_phase<11>(p, bid, nb, smem); GSYNC();
    run_phase<12>(p, bid, nb, smem);
#undef GSYNC
}
#else
template <int PH>
__global__ void __launch_bounds__(NT, 2) k_phase(Params p) {
    __shared__ __attribute__((aligned(16))) unsigned char smem[SMEM_BYTES];
    run_phase<PH>(p, blockIdx.x, gridDim.x, smem);
}
#endif

extern "C" void kernel_launch(void* const* d_in, const int* in_sizes, int n_in, void* d_out, int out_size, void* d_ws, size_t ws_size,
                              hipStream_t stream) {
    if (n_in != 28 || ws_size < WS_END) { fprintf(stderr, "kernel_launch: unexpected n_in %d or ws_size %zu (< %zu)\n", n_in, ws_size, (size_t)WS_END); return; }
    Params p{};
    for (int i = 0; i < 28; ++i) p.in[i] = (const float*)d_in[i];
    p.out = (float*)d_out;
    p.ws = (unsigned char*)d_ws;
#if SINGLE_LAUNCH
    static int grid_blocks = 0;
    if (!grid_blocks) {
        int dev = 0, cus = 0, per_cu = 0;
        hipGetDevice(&dev);
        hipDeviceGetAttribute(&cus, hipDeviceAttributeMultiprocessorCount, dev);
        hipOccupancyMaxActiveBlocksPerMultiprocessor(&per_cu, fwd_mega, NT, 0);
        if (per_cu > 2) per_cu = 2;
        if (per_cu < 1) per_cu = 1;
        grid_blocks = cus * per_cu;
    }
    (void)hipMemsetAsync((unsigned char*)d_ws + WS_BAR, 0, 16384 + 256, stream);
    void* args[] = {&p};
    hipError_t e = hipLaunchCooperativeKernel((void*)fwd_mega, dim3(grid_blocks), dim3(NT), args, 0, stream);
    if (e != hipSuccess) fprintf(stderr, "cooperative launch failed: %s (grid %d)\n", hipGetErrorString(e), grid_blocks);
#else
    const int G = 512;
    k_phase<0><<<G, NT, 0, stream>>>(p);
    k_phase<1><<<G, NT, 0, stream>>>(p);
    k_phase<3><<<G, NT, 0, stream>>>(p);
    k_phase<4><<<G, NT, 0, stream>>>(p);
    k_phase<15><<<G, NT, 0, stream>>>(p);
    k_phase<13><<<G, NT, 0, stream>>>(p);
    k_phase<6><<<G, NT, 0, stream>>>(p);
    k_phase<7><<<G, NT, 0, stream>>>(p);
    k_phase<8><<<G, NT, 0, stream>>>(p);
    k_phase<9><<<G, NT, 0, stream>>>(p);
    k_phase<10><<<G, NT, 0, stream>>>(p);
    k_phase<11><<<G, NT, 0, stream>>>(p);
    k_phase<12><<<G, NT, 0, stream>>>(p);
#endif
}
```
